# Optimizing an MI355X kernel written in HIP

```python
import jax
import jax.numpy as jnp
from jax import lax
import numpy as np

D_MODEL = 1024
BATCH = 8
SEQ = 4096
DEPTH = 1

GRID_W = 64
CTX_LEN = 256
MIX_WIDTH = D_MODEL
HG_WIDTH = MIX_WIDTH // 2
HG_HEADS = 4
HG_KDIM = 128
HG_KEYS = HG_HEADS * HG_KDIM
HG_VDIM = HG_WIDTH // HG_HEADS
SC_WIDTH = MIX_WIDTH - HG_WIDTH
CONV_W = 3
CHUNK = 32
N_EXPERTS = 16
EC_CAPACITY = 2
EXPERT_DFF = 2 * D_MODEL
N_MOD = 6
EPS = 1e-6
IN_COLS = 3 * HG_KEYS + 2 * HG_WIDTH + 3 * SC_WIDTH

kernel_name = 'hybrid_hgrn2_shortconv_ec_moe_dit'


def rms_norm(x, gain):
    xf = x.astype(jnp.float32)
    y = xf * lax.rsqrt(jnp.mean(xf * xf, axis=-1, keepdims=True) + EPS)
    return (y * gain.astype(jnp.float32)).astype(x.dtype)


def modulate(h, shift, scale):
    return h * (1 + scale) + shift


def adaln(cond, w, b):
    return jnp.split(jax.nn.silu(cond) @ w + b, N_MOD, axis=-1)


def dwconv3(u, w):
    pad = [(0, 0)] * (u.ndim - 2) + [(1, 1), (0, 0)]
    up = jnp.pad(u, pad)
    return w[0] * up[..., :-2, :] + w[1] * up[..., 1:-1, :] + w[2] * up[..., 2:, :]


def split_proj(z):
    cuts = [HG_KEYS, 2 * HG_KEYS, 3 * HG_KEYS, 3 * HG_KEYS + HG_WIDTH, 3 * HG_KEYS + 2 * HG_WIDTH,
            3 * HG_KEYS + 2 * HG_WIDTH + SC_WIDTH, 3 * HG_KEYS + 2 * HG_WIDTH + 2 * SC_WIDTH]
    return jnp.split(z, cuts, axis=-1)


def hgrn2_gates(zf, lb):
    b, t, _ = zf.shape
    f = lb + (1.0 - lb) * jax.nn.sigmoid(zf.astype(jnp.float32))
    return jnp.log(f).reshape(b, t, HG_HEADS, HG_KDIM), (1.0 - f).reshape(b, t, HG_HEADS, HG_KDIM)


def gla_chunked(q, k, v, log_f, s0):
    b, t, h, _ = q.shape
    dv = v.shape[-1]
    n = t // CHUNK
    q, k, v, log_f = [a.astype(jnp.float32).reshape(b, n, CHUNK, h, a.shape[-1]) for a in (q, k, v, log_f)]
    cum = jnp.cumsum(log_f, axis=2)
    last = cum[:, :, -1:]
    q_dec = q * jnp.exp(cum)
    k_inv = k * jnp.exp(-cum)
    k_end = k * jnp.exp(last - cum)
    lower = jnp.tril(jnp.ones((CHUNK, CHUNK), jnp.bool_))
    scores = jnp.where(lower, jnp.einsum('bnihd,bnjhd->bnhij', q_dec, k_inv), 0.0)
    o_intra = jnp.einsum('bnhij,bnjhv->bnihv', scores, v)
    kv = jnp.einsum('bnjhd,bnjhv->bnhdv', k_end, v)
    decay = jnp.exp(last[:, :, 0])

    def step(s, inp):
        dec, kv_n = inp
        return dec[..., None] * s + kv_n, s

    s_final, s_prev = lax.scan(step, s0.astype(jnp.float32),
                               (jnp.moveaxis(decay, 1, 0), jnp.moveaxis(kv, 1, 0)))
    o_inter = jnp.einsum('bnihd,nbhdv->bnihv', q_dec, s_prev)
    return (o_intra + o_inter).reshape(b, t, h, dv), s_final


def gla_final_state(k, v, log_f):
    cum = jnp.cumsum(log_f, axis=1)
    return jnp.einsum('bthd,bthv->bhdv', k * jnp.exp(cum[:, -1:] - cum), v)


def hgrn2_mix(q, i, zf_f, zf_b, g, lb_f, lb_b, s0_f, s0_b, gain):
    b, t, _ = q.shape
    qh = q.reshape(b, t, HG_HEADS, HG_KDIM)
    vh = i.reshape(b, t, HG_HEADS, HG_VDIM)
    logf_f, k_f = hgrn2_gates(zf_f, lb_f)
    logf_b, k_b = hgrn2_gates(zf_b, lb_b)
    rev = lambda a: jnp.flip(a, axis=1)
    o_f, s_f = gla_chunked(qh, k_f, vh, logf_f, s0_f)
    o_b, s_b = gla_chunked(rev(qh), rev(k_b), rev(vh), rev(logf_b), s0_b)
    o = (o_f + rev(o_b)).astype(q.dtype)
    o = rms_norm(o, gain) * jax.nn.silu(g.reshape(b, t, HG_HEADS, HG_VDIM))
    return o.reshape(b, t, HG_WIDTH), s_f, s_b


def hgrn2_context_states(zf_f, zf_b, i, lb_f, lb_b):
    b, t, _ = i.shape
    vh = i.astype(jnp.float32).reshape(b, t, HG_HEADS, HG_VDIM)
    logf_f, k_f = hgrn2_gates(zf_f, lb_f)
    logf_b, k_b = hgrn2_gates(zf_b, lb_b)
    s_f = gla_final_state(k_f, vh, logf_f)
    s_b = gla_final_state(jnp.flip(k_b, 1), jnp.flip(vh, 1), jnp.flip(logf_b, 1))
    return s_f, s_b


def token_mix(h, w_in_l, w_out_l, lb_f, lb_b, hg_gain, conv_l, s0_f, s0_b, grid_rows):
    b, t, _ = h.shape
    q, zf_f, zf_b, i, g, gate_b, gate_c, v = split_proj(h @ w_in_l)
    o_hg, s_f, s_b = hgrn2_mix(q, i, zf_f, zf_b, g, lb_f, lb_b, s0_f, s0_b, hg_gain)
    u = gate_c * v
    if grid_rows is None:
        y = dwconv3(u, conv_l)
    else:
        y = dwconv3(u.reshape(b, grid_rows, GRID_W, SC_WIDTH), conv_l).reshape(b, t, SC_WIDTH)
    y = gate_b * y
    return jnp.concatenate([o_hg, y], axis=-1) @ w_out_l, s_f, s_b


def expert_choice_ffn(h, w_router, w_gate, w_up, w_down):
    b, t, d = h.shape
    cap = EC_CAPACITY * t // N_EXPERTS
    aff = jax.nn.softmax(jnp.einsum('btd,de->bte', h, w_router).astype(jnp.float32), axis=-1)
    gate, idx = lax.top_k(jnp.swapaxes(aff, 1, 2), cap)
    xs = jax.vmap(lambda hb, ib: hb[ib])(h, idx)
    hid = jax.nn.silu(jnp.einsum('becd,edf->becf', xs, w_gate)) * jnp.einsum('becd,edf->becf', xs, w_up)
    ys = jnp.einsum('becf,efd->becd', hid, w_down) * gate[..., None].astype(h.dtype)
    return jax.vmap(lambda ib, yb: jnp.zeros((t, d), yb.dtype).at[ib.reshape(-1)].add(yb.reshape(-1, d)))(idx, ys)


def setup_inputs(seed: int = 0) -> dict:
    key = jax.random.key(seed)
    ks = jax.random.split(key, 20)
    nrm = lambda k, shape, s: jax.random.normal(k, shape, jnp.float32) * s
    return {
        'x': nrm(ks[0], (BATCH, SEQ, D_MODEL), 1.0),
        'c': nrm(ks[1], (BATCH, D_MODEL), 1.0),
        'ctx': nrm(ks[2], (BATCH, CTX_LEN, D_MODEL), 1.0),
        'c_ctx': nrm(ks[3], (D_MODEL,), 1.0),
        'w_ada': nrm(ks[4], (DEPTH, D_MODEL, N_MOD * D_MODEL), 0.5 * D_MODEL ** -0.5),
        'b_ada': nrm(ks[5], (DEPTH, N_MOD * D_MODEL), 0.02),
        'norm_mix': 1.0 + nrm(ks[6], (DEPTH, D_MODEL), 0.02),
        'norm_ffn': 1.0 + nrm(ks[7], (DEPTH, D_MODEL), 0.02),
        'w_in': nrm(ks[8], (DEPTH, D_MODEL, IN_COLS), D_MODEL ** -0.5),
        'lb_logits': nrm(ks[9], (DEPTH + 1, 2, HG_KEYS), 0.3),
        'hg_norm': 1.0 + nrm(ks[10], (DEPTH, HG_VDIM), 0.02),
        'conv_w': nrm(ks[11], (DEPTH, CONV_W, SC_WIDTH), CONV_W ** -0.5),
        'w_out': nrm(ks[12], (DEPTH, MIX_WIDTH, D_MODEL), MIX_WIDTH ** -0.5),
        'w_router': nrm(ks[13], (DEPTH, D_MODEL, N_EXPERTS), D_MODEL ** -0.5),
        'w_gate': nrm(ks[14], (DEPTH, N_EXPERTS, D_MODEL, EXPERT_DFF), D_MODEL ** -0.5),
        'w_up': nrm(ks[15], (DEPTH, N_EXPERTS, D_MODEL, EXPERT_DFF), D_MODEL ** -0.5),
        'w_down': nrm(ks[16], (DEPTH, N_EXPERTS, EXPERT_DFF, D_MODEL), EXPERT_DFF ** -0.5),
        'norm_final': 1.0 + nrm(ks[17], (D_MODEL,), 0.02),
    }


def reference(x, c, ctx, c_ctx, w_ada, b_ada, norm_mix, norm_ffn, w_in, lb_logits, hg_norm, conv_w,
              w_out, w_router, w_gate, w_up, w_down, norm_final):
    b = x.shape[0]
    rows = x.shape[1] // GRID_W
    lower_bounds = jnp.cumsum(jax.nn.softmax(lb_logits.astype(jnp.float32), axis=0), axis=0)
    cx = ctx
    for l in range(DEPTH):
        sh1, sc1, g1, sh2, sc2, g2 = [m[:, None] for m in adaln(c, w_ada[l], b_ada[l])]
        csh1, csc1, cg1, csh2, csc2, cg2 = adaln(c_ctx, w_ada[l], b_ada[l])
        lb_f, lb_b = lower_bounds[l, 0], lower_bounds[l, 1]
        hc = modulate(rms_norm(cx, norm_mix[l]), csh1, csc1)
        if l == DEPTH - 1:
            zf_f, zf_b, i_c = jnp.split(hc @ w_in[l][:, HG_KEYS:3 * HG_KEYS + HG_WIDTH],
                                        [HG_KEYS, 2 * HG_KEYS], axis=-1)
            s_f, s_b = hgrn2_context_states(zf_f, zf_b, i_c, lb_f, lb_b)
        else:
            zero = jnp.zeros((b, HG_HEADS, HG_KDIM, HG_VDIM), jnp.float32)
            mc, s_f, s_b = token_mix(hc, w_in[l], w_out[l], lb_f, lb_b, hg_norm[l], conv_w[l],
                                     zero, zero, None)
            cx = cx + cg1 * mc
            hc2 = modulate(rms_norm(cx, norm_ffn[l]), csh2, csc2)
            cx = cx + cg2 * expert_choice_ffn(hc2, w_router[l], w_gate[l], w_up[l], w_down[l])
        hx = modulate(rms_norm(x, norm_mix[l]), sh1, sc1)
        mx, _, _ = token_mix(hx, w_in[l], w_out[l], lb_f, lb_b, hg_norm[l], conv_w[l], s_f, s_b, rows)
        x = x + g1 * mx
        hx2 = modulate(rms_norm(x, norm_ffn[l]), sh2, sc2)
        x = x + g2 * expert_choice_ffn(hx2, w_router[l], w_gate[l], w_up[l], w_down[l])
    return rms_norm(x, norm_final)
```

```cpp
#include <hip/hip_runtime.h>
#include <hip/hip_cooperative_groups.h>
#include <cstdio>
namespace cg = cooperative_groups;

#define LAS __attribute__((address_space(3)))
#define GAS __attribute__((address_space(1)))
typedef unsigned short bf16_t;
typedef short bf16x8 __attribute__((ext_vector_type(8)));
typedef float f32x4 __attribute__((ext_vector_type(4)));
typedef float f32x2 __attribute__((ext_vector_type(2)));
typedef unsigned u32x4 __attribute__((ext_vector_type(4)));
typedef unsigned u32x2 __attribute__((ext_vector_type(2)));
typedef unsigned char uchar;

constexpr int D = 1024, NB = 8, T = 4096, M = NB * T, CT = 256, MC = NB * CT;
constexpr int NIN = 4096, HK = 512, NH = 4, NE = 16, CAP = 512, DFF = 2048, NMOD = 6 * D;
constexpr float EPS = 1e-6f;
constexpr int NPHASE = 12;

constexpr size_t MiB = 1u << 20;
constexpr size_t WS_ACT = 0;
constexpr size_t WS_WIN = 64 * MiB;
constexpr size_t WS_WOUT = 72 * MiB;
constexpr size_t WS_MODP = 74 * MiB;
constexpr size_t WS_MODF = 76 * MiB;
constexpr size_t WS_LB = 76 * MiB + 512 * 1024;
constexpr size_t WS_HC = 77 * MiB;
constexpr size_t WS_CLF = 81 * MiB;
constexpr size_t WS_CLB = 85 * MiB;
constexpr size_t WS_CI = 89 * MiB;
constexpr size_t WS_S0 = 91 * MiB;
constexpr size_t WS_AFF = 95 * MiB;
constexpr size_t WS_SELTOK = 97 * MiB;
constexpr size_t WS_SELGATE = 97 * MiB + 256 * 1024;
constexpr size_t WS_POS = 98 * MiB;
constexpr size_t WS_ZQ = 104 * MiB;
constexpr size_t WS_LF = 136 * MiB;
constexpr size_t WS_LBW = 200 * MiB;
constexpr size_t WS_ZI = 264 * MiB;
constexpr size_t WS_ZG = 296 * MiB;
constexpr size_t WS_ZGB = 328 * MiB;
constexpr size_t WS_ZGC = 360 * MiB;
constexpr size_t WS_ZV = 392 * MiB;
constexpr size_t WS_OF = 424 * MiB;
constexpr size_t WS_OB = 456 * MiB;
constexpr size_t WS_WGU = 104 * MiB;
constexpr size_t WS_WDN = 232 * MiB;
constexpr size_t WS_HID = 296 * MiB;
constexpr size_t WS_YS = WS_WGU;
constexpr size_t WS_END = 552 * MiB;
static_assert(WS_ZI == WS_ZQ + 160 * MiB && WS_ZG == WS_ZI + 32 * MiB && WS_ZGB == WS_ZG + 32 * MiB && WS_ZGC == WS_ZGB + 32 * MiB && WS_ZV == WS_ZGC + 32 * MiB, "z segment map");

constexpr int LDS_BYTES = 147456;

typedef __bf16 bf16x2_t __attribute__((ext_vector_type(2)));
__device__ __forceinline__ unsigned cvt_pk_bf16_safe(float lo, float hi) { typedef float f2_t __attribute__((ext_vector_type(2))); const bf16x2_t v = __builtin_convertvector((f2_t){lo, hi}, bf16x2_t); return __builtin_bit_cast(unsigned, v); }
__device__ __forceinline__ unsigned cvt_pk_bf16(float lo, float hi) { unsigned r; asm volatile("v_cvt_pk_bf16_f32 %0, %1, %2" : "=v"(r) : "v"(lo), "v"(hi)); return r; }
__device__ __forceinline__ float bf_lo(unsigned u) { return __uint_as_float(u << 16); }
__device__ __forceinline__ float bf_hi(unsigned u) { return __uint_as_float(u & 0xffff0000u); }
__device__ __forceinline__ float wave_sum(float v) {
#pragma unroll
    for (int o = 1; o < 64; o <<= 1) v += __shfl_xor(v, o);
    return v;
}
__device__ __forceinline__ float silu_f(float x) { return x / (1.f + __expf(-x)); }
#define LDS_WAIT() asm volatile("s_waitcnt lgkmcnt(0)" ::: "memory")

namespace pg8 {
constexpr int BM = 256, BK = 64, HALF = 128, HTB = HALF * BK * 2, STAGE_BYTES = 8 * HTB, NXCD = 8, WGM = 8;
__device__ __forceinline__ int lds_byte(int r, int c) { const int st = (r >> 4) * 2 + (c >> 5), rr = r & 15, cc = c & 31, ob = rr * 64 + cc * 2; return st * 1024 + (ob ^ (((ob >> 9) & 1) << 5)); }
__device__ __forceinline__ void stage_rc(int b, int& R, int& C) { const int st = b / 1024, sb = b % 1024, swz = sb ^ (((sb >> 9) & 1) << 5); R = (st >> 1) * 16 + swz / 64; C = (st & 1) * 32 + (swz % 64) / 2; }
__device__ __forceinline__ int perm32(int rho) { const int n = rho >> 4, i = rho & 15; return 8 * (i >> 2) + 4 * n + (i & 3); }

struct Unit { int pm, pn, e; };
struct GroupOrder {
    int nM, nN, ng, G, c;
    __device__ __forceinline__ void init(int nM_, int nN_, int ng_, int G_, int c_) { nM = nM_; nN = nN_; ng = ng_; G = G_; c = c_; }
    __device__ __forceinline__ bool next(int i, Unit& u) const {
        const int nwg = nM * nN; const long L = (long)i * G + c; if (L >= (long)nwg * ng) return false;
        const int grp = (int)(L / nwg); int wgid = (int)(L % nwg);
        { const int q = nwg / NXCD, r = nwg % NXCD, xcd = wgid % NXCD, off = wgid / NXCD; wgid = (xcd < r ? xcd * (q + 1) : r * (q + 1) + (xcd - r) * q) + off; }
        const int nig = WGM * nN, gid = wgid / nig, fm = gid * WGM, gsz = (nM - fm) < WGM ? (nM - fm) : WGM;
        u.pm = grp * nM + fm + ((wgid % nig) % gsz); u.pn = (wgid % nig) / gsz; u.e = grp; return true;
    }
};
struct Gemm { const bf16_t* A; const bf16_t* Bt; int K; size_t bgs; const int* rowidx; };

template <class Epi, bool GATHER>
__device__ __forceinline__ void gemm_phase(LAS uchar* lds, const Gemm g, const GroupOrder& S, const Epi& E) {
    const int tid = threadIdx.x, wid = __builtin_amdgcn_readfirstlane(tid >> 6), lane = tid & 63, wr = wid >> 2, wc = wid & 3, fr = lane & 15, fq = lane >> 4;
    const int K = g.K, nt = K / BK;
    unsigned voffA[2], voffB[2]; int Rr[2], Cc[2];
#pragma unroll
    for (int i = 0; i < 2; ++i) { int R, C; stage_rc(tid * 16 + i * 8192, R, C); const int Rb = Epi::PERM ? ((R & ~31) + perm32(R & 31)) : R; Rr[i] = R; Cc[i] = C;
        voffA[i] = (unsigned)(R * K + C) * 2u; voffB[i] = (unsigned)(Rb * K + C) * 2u; }
    const size_t kstep = (size_t)(BK * 2);
    const size_t hstep = (size_t)HALF * K * 2;
    const size_t tstep = 2 * hstep;
    const unsigned ldsw = (unsigned)wid * 1024u;
    const int aoff = lds_byte(wr * 64 + fr, fq * 8), boff = lds_byte(wc * 32 + fr, fq * 8);
#define PG8_SA(b, h) (((b) * 2 + (h)) * HTB)
#define PG8_SB(b, h) ((4 + (b) * 2 + (h)) * HTB)
#define PG8_STAGE(bufoff, gbase, voff) do { _Pragma("unroll") for (int _i = 0; _i < 2; ++_i) \
        __builtin_amdgcn_global_load_lds((const unsigned*)((const char*)(gbase) + (voff)[_i]), (LAS unsigned*)(lds + (bufoff) + ldsw + _i * 8192), 16, 0, 0); } while (0)
#define PG8_STAGE_A(bufoff, p, ofs, h) do { if constexpr (GATHER) { PG8_STAGE(bufoff, p, (ofs)[h]); } else { PG8_STAGE(bufoff, (p) + (h) * hstep, voffA); } } while (0)
#define PG8_LDA(dst, b, h) do { _Pragma("unroll") for (int m = 0; m < 4; ++m) _Pragma("unroll") for (int k = 0; k < 2; ++k) dst[m][k] = *(const LAS bf16x8*)(lds + PG8_SA(b, h) + aoff + m * 2048 + k * 1024); } while (0)
#define PG8_LDB(dst, b, h) do { _Pragma("unroll") for (int n = 0; n < 2; ++n) _Pragma("unroll") for (int k = 0; k < 2; ++k) dst[n][k] = *(const LAS bf16x8*)(lds + PG8_SB(b, h) + boff + n * 2048 + k * 1024); } while (0)
#define PG8_MMA(ai, bj, At, Bt) do { __builtin_amdgcn_s_setprio(1); _Pragma("unroll") for (int m = 0; m < 4; ++m) _Pragma("unroll") for (int n = 0; n < 2; ++n) _Pragma("unroll") for (int k = 0; k < 2; ++k) \
        acc[ai][bj][m][n] = __builtin_amdgcn_mfma_f32_16x16x32_bf16(Bt[n][k], At[m][k], acc[ai][bj][m][n], 0, 0, 0); __builtin_amdgcn_s_setprio(0); } while (0)
#define PG8_WAIT_V(n) asm volatile("s_waitcnt vmcnt(" #n ")" ::: "memory")
#define PG8_WAIT_L(n) asm volatile("s_waitcnt lgkmcnt(" #n ")" ::: "memory")
#define PG8_BAR __builtin_amdgcn_s_barrier()
#define PG8_SCHED __builtin_amdgcn_sched_barrier(0)
    Unit cur, nxt; int ui = 0;
    if (!S.next(0, cur)) return;
    f32x4 acc[2][2][4][2];
#pragma unroll
    for (int a = 0; a < 2; ++a)
#pragma unroll
        for (int b = 0; b < 2; ++b)
#pragma unroll
            for (int m = 0; m < 4; ++m)
#pragma unroll
                for (int n = 0; n < 2; ++n) acc[a][b][m][n] = (f32x4){0.f, 0.f, 0.f, 0.f};
    bf16x8 At[4][2], B0[2][2], B1[2][2];
    unsigned cofs[2][2], nofs[2][2];
    if constexpr (GATHER) {
#pragma unroll
        for (int h = 0; h < 2; ++h)
#pragma unroll
            for (int i = 0; i < 2; ++i) { const int row = g.rowidx[cur.pm * BM + h * HALF + Rr[i]]; cofs[h][i] = (unsigned)(row * K + Cc[i]) * 2u; nofs[h][i] = cofs[h][i]; }
    }
    const char* cA = GATHER ? (const char*)g.A : (const char*)g.A + (size_t)cur.pm * tstep;
    const char* cB = (const char*)g.Bt + (size_t)cur.e * g.bgs + (size_t)cur.pn * tstep;
    PG8_STAGE(PG8_SB(0, 0), cB, voffB); PG8_STAGE(PG8_SB(0, 1), cB + hstep, voffB); PG8_STAGE_A(PG8_SA(0, 0), cA, cofs, 0); PG8_STAGE_A(PG8_SA(0, 1), cA, cofs, 1);
    if (wr == 1) PG8_BAR;
    PG8_WAIT_V(2); PG8_BAR;
    PG8_STAGE(PG8_SB(1, 0), cB + kstep, voffB); PG8_STAGE_A(PG8_SA(1, 0), cA + kstep, cofs, 0); PG8_STAGE(PG8_SB(1, 1), cB + hstep + kstep, voffB);
    PG8_WAIT_V(6); PG8_BAR;
    for (;;) {
        const bool has_next = S.next(ui + 1, nxt);
        const char* nA = GATHER ? (const char*)g.A : (has_next ? (const char*)g.A + (size_t)nxt.pm * tstep : cA);
        const char* nB = has_next ? (const char*)g.Bt + (size_t)nxt.e * g.bgs + (size_t)nxt.pn * tstep : cB;
        for (int t = 0; t < nt; t += 2) {
            const bool last = (t == nt - 2);
            const char* a1 = cA + (size_t)(t + 1) * kstep;
            const char* a2 = last ? nA : cA + (size_t)(t + 2) * kstep; const char* b2 = last ? nB : cB + (size_t)(t + 2) * kstep;
            const char* a3 = a2 + kstep; const char* b3 = b2 + kstep;
            if constexpr (GATHER) {
                if (last && has_next) {
#pragma unroll
                    for (int h = 0; h < 2; ++h)
#pragma unroll
                        for (int i = 0; i < 2; ++i) { const int row = g.rowidx[nxt.pm * BM + h * HALF + Rr[i]]; nofs[h][i] = (unsigned)(row * K + Cc[i]) * 2u; }
                }
            }
            PG8_LDB(B0, 0, 0); PG8_LDB(B1, 0, 1); PG8_SCHED; PG8_LDA(At, 0, 0); PG8_STAGE_A(PG8_SA(1, 1), a1, cofs, 1);
            PG8_WAIT_V(8); PG8_WAIT_L(0); PG8_BAR; PG8_MMA(0, 0, At, B0); PG8_MMA(0, 1, At, B1); PG8_BAR; PG8_SCHED;
            PG8_LDA(At, 0, 1); PG8_STAGE(PG8_SB(0, 0), b2, voffB); PG8_STAGE(PG8_SB(0, 1), b2 + hstep, voffB);
            if (last) { PG8_STAGE_A(PG8_SA(0, 0), a2, nofs, 0); } else { PG8_STAGE_A(PG8_SA(0, 0), a2, cofs, 0); }
            PG8_WAIT_V(8); PG8_WAIT_L(0); PG8_BAR; PG8_MMA(1, 0, At, B0); PG8_MMA(1, 1, At, B1); PG8_BAR; PG8_SCHED;
            PG8_LDB(B0, 1, 0); PG8_LDB(B1, 1, 1); PG8_SCHED; PG8_LDA(At, 1, 0);
            if (last) { PG8_STAGE_A(PG8_SA(0, 1), a2, nofs, 1); } else { PG8_STAGE_A(PG8_SA(0, 1), a2, cofs, 1); }
            PG8_WAIT_V(8); PG8_WAIT_L(0); PG8_BAR; PG8_MMA(0, 0, At, B0); PG8_MMA(0, 1, At, B1); PG8_BAR; PG8_SCHED;
            PG8_LDA(At, 1, 1); PG8_STAGE(PG8_SB(1, 0), b3, voffB); PG8_STAGE(PG8_SB(1, 1), b3 + hstep, voffB);
            if (last) { PG8_STAGE_A(PG8_SA(1, 0), a3, nofs, 0); } else { PG8_STAGE_A(PG8_SA(1, 0), a3, cofs, 0); }
            PG8_WAIT_V(8); PG8_WAIT_L(0); PG8_BAR; PG8_MMA(1, 0, At, B0); PG8_MMA(1, 1, At, B1); PG8_BAR; PG8_SCHED;
        }
        if (wr == 0) PG8_BAR;
        E(acc, cur, wr, wc, fr, fq);
        if (!has_next) break;
#pragma unroll
        for (int a = 0; a < 2; ++a)
#pragma unroll
            for (int b = 0; b < 2; ++b)
#pragma unroll
                for (int m = 0; m < 4; ++m)
#pragma unroll
                    for (int n = 0; n < 2; ++n) acc[a][b][m][n] = (f32x4){0.f, 0.f, 0.f, 0.f};
        cur = nxt; cA = nA; cB = nB; ++ui;
        if constexpr (GATHER) {
#pragma unroll
            for (int h = 0; h < 2; ++h)
#pragma unroll
                for (int i = 0; i < 2; ++i) cofs[h][i] = nofs[h][i];
        }
        if (wr == 1) PG8_BAR;
    }
    PG8_WAIT_V(0);
    PG8_BAR;
#undef PG8_SA
#undef PG8_SB
#undef PG8_STAGE
#undef PG8_STAGE_A
#undef PG8_LDA
#undef PG8_LDB
#undef PG8_MMA
#undef PG8_WAIT_V
#undef PG8_WAIT_L
#undef PG8_BAR
#undef PG8_SCHED
}


struct EpiInproj {
    static constexpr bool PERM = true;
    uchar* zbase; bf16_t* ci; float* olog0; float* olog1; const float* lb; int seg0;
    __device__ __forceinline__ void operator()(const f32x4 (&acc)[2][2][4][2], const Unit& u, int wr, int wc, int fr, int fq) const {
        const int seg = seg0 + (u.pn >> 1);
        const int row0 = u.pm * BM + wr * 64 + fr, col0 = (u.pn & 1) * 256 + wc * 32 + 8 * fq;
        if (seg == 1 || seg == 2) {
            float* O = (seg == 1) ? olog0 : olog1; const float* lbp = lb + (seg - 1) * 512;
#pragma unroll
            for (int bj = 0; bj < 2; ++bj) {
                const f32x4 l0 = *(const f32x4*)(lbp + col0 + bj * HALF), l1 = *(const f32x4*)(lbp + col0 + bj * HALF + 4);
#pragma unroll
                for (int ai = 0; ai < 2; ++ai)
#pragma unroll
                    for (int m = 0; m < 4; ++m) { float* rowp = O + (size_t)(row0 + ai * HALF + m * 16) * 512 + col0 + bj * HALF;
                        f32x4 v0 = acc[ai][bj][m][0], v1 = acc[ai][bj][m][1], o0, o1;
#pragma unroll
                        for (int j = 0; j < 4; ++j) { const float s0 = 1.f / (1.f + __expf(-v0[j])), s1 = 1.f / (1.f + __expf(-v1[j]));
                            o0[j] = __logf(l0[j] + (1.f - l0[j]) * s0); o1[j] = __logf(l1[j] + (1.f - l1[j]) * s1); }
                        *(f32x4*)rowp = o0; *(f32x4*)(rowp + 4) = o1; }
            }
        } else {
            bf16_t* O = zbase ? (bf16_t*)(zbase + (size_t)(32 * seg + (seg >= 3 ? 64 : 0)) * MiB) : ci;
#pragma unroll
            for (int ai = 0; ai < 2; ++ai)
#pragma unroll
                for (int m = 0; m < 4; ++m) { bf16_t* rowp = O + (size_t)(row0 + ai * HALF + m * 16) * 512 + col0;
#pragma unroll
                    for (int bj = 0; bj < 2; ++bj) { const f32x4 v0 = acc[ai][bj][m][0], v1 = acc[ai][bj][m][1];
                        u32x4 w; w.x = cvt_pk_bf16(v0[0], v0[1]); w.y = cvt_pk_bf16(v0[2], v0[3]); w.z = cvt_pk_bf16(v1[0], v1[1]); w.w = cvt_pk_bf16(v1[2], v1[3]);
                        *(u32x4*)(rowp + bj * HALF) = w; } }
        }
    }
};
struct EpiOut {
    static constexpr bool PERM = false;
    const float* x; float* x1; const float* modf;
    __device__ __forceinline__ void operator()(const f32x4 (&acc)[2][2][4][2], const Unit& u, int wr, int wc, int fr, int fq) const {
        const int row0 = u.pm * BM + wr * 64 + fr, col0 = u.pn * BM + wc * 32 + 4 * fq;
        const int b = (u.pm * BM) / T;
        const float* g1 = modf + (size_t)b * NMOD + 2 * D;
        f32x4 gv[2][2];
#pragma unroll
        for (int bj = 0; bj < 2; ++bj)
#pragma unroll
            for (int n = 0; n < 2; ++n) gv[bj][n] = *(const f32x4*)(g1 + col0 + bj * HALF + n * 16);
#pragma unroll
        for (int ai = 0; ai < 2; ++ai)
#pragma unroll
            for (int m = 0; m < 4; ++m) { const size_t off = (size_t)(row0 + ai * HALF + m * 16) * D + col0;
#pragma unroll
                for (int bj = 0; bj < 2; ++bj)
#pragma unroll
                    for (int n = 0; n < 2; ++n) { const f32x4 xs = *(const f32x4*)(x + off + bj * HALF + n * 16); *(f32x4*)(x1 + off + bj * HALF + n * 16) = xs + gv[bj][n] * acc[ai][bj][m][n]; }
                asm volatile("" ::: "memory"); }
    }
};
struct EpiMoe1 {
    static constexpr bool PERM = true;
    bf16_t* hid;
    __device__ __forceinline__ void operator()(const f32x4 (&acc)[2][2][4][2], const Unit& u, int wr, int wc, int fr, int fq) const {
        const int row0 = u.pm * BM + wr * 64 + fr, col0 = u.pn * 128 + wc * 32 + 8 * fq;
#pragma unroll
        for (int ai = 0; ai < 2; ++ai)
#pragma unroll
            for (int m = 0; m < 4; ++m) { bf16_t* rowp = hid + (size_t)(row0 + ai * HALF + m * 16) * DFF + col0;
                float o[8];
#pragma unroll
                for (int n = 0; n < 2; ++n)
#pragma unroll
                    for (int j = 0; j < 4; ++j) { const float gt = acc[ai][0][m][n][j], up = acc[ai][1][m][n][j]; o[n * 4 + j] = gt * up / (1.f + __expf(-gt)); }
                u32x4 w; w.x = cvt_pk_bf16(o[0], o[1]); w.y = cvt_pk_bf16(o[2], o[3]); w.z = cvt_pk_bf16(o[4], o[5]); w.w = cvt_pk_bf16(o[6], o[7]);
                *(u32x4*)rowp = w; }
    }
};
struct EpiMoe2 {
    static constexpr bool PERM = true;
    bf16_t* ys; const float* gate;
    __device__ __forceinline__ void operator()(const f32x4 (&acc)[2][2][4][2], const Unit& u, int wr, int wc, int fr, int fq) const {
        const int row0 = u.pm * BM + wr * 64 + fr, col0 = u.pn * BM + wc * 32 + 8 * fq;
#pragma unroll
        for (int ai = 0; ai < 2; ++ai)
#pragma unroll
            for (int m = 0; m < 4; ++m) { const int row = row0 + ai * HALF + m * 16; const float gt = gate[row]; bf16_t* rowp = ys + (size_t)row * D + col0;
#pragma unroll
                for (int bj = 0; bj < 2; ++bj) { const f32x4 v0 = acc[ai][bj][m][0] * gt, v1 = acc[ai][bj][m][1] * gt;
                    u32x4 w; w.x = cvt_pk_bf16(v0[0], v0[1]); w.y = cvt_pk_bf16(v0[2], v0[3]); w.z = cvt_pk_bf16(v1[0], v1[1]); w.w = cvt_pk_bf16(v1[2], v1[3]);
                    *(u32x4*)(rowp + bj * HALF) = w; } }
    }
};
}

struct Args {
    const float *x, *c, *ctx, *c_ctx, *w_ada, *b_ada, *norm_mix, *norm_ffn, *w_in, *lb_logits, *hg_norm, *conv_w, *w_out, *w_router, *w_gate, *w_up, *w_down, *norm_final;
    float* out; uchar* ws; int ph_lo, ph_hi;
};

__device__ __forceinline__ void cvt_item(const float* W, int ldw, bf16_t* WT, int ldt, int k0, int n0, int nrow0, LAS float* scr, int lane) {
#pragma unroll 8
    for (int i = 0; i < 32; ++i) { const int kk = 2 * i + (lane >> 5); scr[kk * 33 + (lane & 31)] = W[(size_t)(k0 + kk) * ldw + n0 + (lane & 31)]; }
    LDS_WAIT(); asm volatile("" ::: "memory");
    const int c = lane & 7;
#pragma unroll
    for (int j = 0; j < 4; ++j) { const int n = (lane >> 3) + 8 * j; const LAS float* s = scr + (8 * c) * 33 + n;
        u32x4 o; o.x = cvt_pk_bf16(s[0 * 33], s[1 * 33]); o.y = cvt_pk_bf16(s[2 * 33], s[3 * 33]); o.z = cvt_pk_bf16(s[4 * 33], s[5 * 33]); o.w = cvt_pk_bf16(s[6 * 33], s[7 * 33]);
        *(u32x4*)(WT + (size_t)(nrow0 + n) * ldt + k0 + 8 * c) = o; }
    LDS_WAIT(); asm volatile("" ::: "memory");
}

__device__ __forceinline__ void phase_prep(const Args& a, LAS uchar* lds, int bid, int G, int tid, int wid, int lane) {
    float* modp = (float*)(a.ws + WS_MODP);
    if (bid < 192) {
        const int cgp = bid % 24, ks = bid / 24, n0 = cgp * 256 + lane * 4, k0 = ks * 128 + wid * 16;
        f32x4 acc[9];
#pragma unroll
        for (int r = 0; r < 9; ++r) acc[r] = (f32x4){0.f, 0.f, 0.f, 0.f};
#pragma unroll 4
        for (int kk = 0; kk < 16; ++kk) { const int k = k0 + kk; const f32x4 w = *(const f32x4*)(a.w_ada + (size_t)k * NMOD + n0);
#pragma unroll
            for (int r = 0; r < 9; ++r) { const float cv = (r < 8) ? a.c[r * D + k] : a.c_ctx[k]; const float s = silu_f(cv); acc[r] += w * s; } }
        LAS f32x4* red = (LAS f32x4*)lds;
#pragma unroll
        for (int r = 0; r < 9; ++r) red[(wid * 9 + r) * 64 + lane] = acc[r];
        __syncthreads();
        for (int o = tid; o < 9 * 64; o += 512) { const int r = o / 64, l = o % 64; f32x4 s = red[(0 * 9 + r) * 64 + l];
#pragma unroll
            for (int w = 1; w < 8; ++w) s += red[(w * 9 + r) * 64 + l];
            if (ks == 0) s += *(const f32x4*)(a.b_ada + cgp * 256 + l * 4);
            *(f32x4*)(modp + ((size_t)ks * 9 + r) * NMOD + cgp * 256 + l * 4) = s; }
        __syncthreads();
    }
    if (bid == 255) {
        float* lb = (float*)(a.ws + WS_LB);
        for (int i = tid; i < 1024; i += 512) { const float l0 = a.lb_logits[i], l1 = a.lb_logits[1024 + i]; lb[i] = 1.f / (1.f + __expf(l1 - l0)); }
    }
    LAS float* scr = (LAS float*)lds + wid * (64 * 33);
    const int gw = (G - 1 - bid) * 8 + wid, NGW = G * 8;
    constexpr int I_IN = (D / 64) * (NIN / 32), I_OUT = (D / 64) * (D / 32);
    for (int it = gw; it < I_IN + I_OUT; it += NGW) {
        if (it < I_IN) { const int nblk = NIN / 32, kb = it / nblk, nb = it % nblk; cvt_item(a.w_in, NIN, (bf16_t*)(a.ws + WS_WIN), D, kb * 64, nb * 32, nb * 32, scr, lane); }
        else { const int r = it - I_IN, nblk = D / 32, kb = r / nblk, nb = r % nblk; cvt_item(a.w_out, D, (bf16_t*)(a.ws + WS_WOUT), D, kb * 64, nb * 32, nb * 32, scr, lane); }
    }
}

__device__ __forceinline__ float modp_sum(const float* modp, int r, int col) { float s = 0.f;
#pragma unroll
    for (int ks = 0; ks < 8; ++ks) s += modp[((size_t)ks * 9 + r) * NMOD + col];
    return s; }
__device__ __forceinline__ void norm_row(const float* xrow, bf16_t* orow, const LAS float* gm, const LAS float* sh, int lane) {
    f32x4 v[4]; float ss = 0.f;
#pragma unroll
    for (int j = 0; j < 4; ++j) { v[j] = *((const f32x4*)xrow + lane + 64 * j); ss += (v[j].x * v[j].x + v[j].y * v[j].y) + (v[j].z * v[j].z + v[j].w * v[j].w); }
    const float rstd = rsqrtf(wave_sum(ss) * (1.f / D) + EPS);
#pragma unroll
    for (int j = 0; j < 4; ++j) { const f32x4 g4 = *((const LAS f32x4*)gm + lane + 64 * j), s4 = *((const LAS f32x4*)sh + lane + 64 * j); const f32x4 o = v[j] * rstd * g4 + s4;
        u32x2 w; w.x = cvt_pk_bf16(o.x, o.y); w.y = cvt_pk_bf16(o.z, o.w); *((u32x2*)orow + lane + 64 * j) = w; }
}
__device__ __forceinline__ void phase_norm(const Args& a, LAS uchar* lds, int bid, int G, int tid, int wid, int lane) {
    const float* modp = (const float*)(a.ws + WS_MODP); float* modf = (float*)(a.ws + WS_MODF);
    { const int gt = bid * 512 + tid; if (gt < 9 * NMOD) modf[gt] = modp_sum(modp, gt / NMOD, gt % NMOD); }
    LAS float* gm = (LAS float*)lds; LAS float* sh = gm + D; LAS float* cgm = sh + D; LAS float* csh = cgm + D;
    const int b = bid / 32;
    for (int cidx = tid; cidx < D; cidx += 512) { const float nm = a.norm_mix[cidx];
        sh[cidx] = modp_sum(modp, b, cidx); gm[cidx] = nm * (1.f + modp_sum(modp, b, D + cidx));
        csh[cidx] = modp_sum(modp, 8, cidx); cgm[cidx] = nm * (1.f + modp_sum(modp, 8, D + cidx)); }
    __syncthreads();
    bf16_t* hx = (bf16_t*)(a.ws + WS_ACT); bf16_t* hc = (bf16_t*)(a.ws + WS_HC);
    for (int j = 0; j < 16; ++j) { const int row = bid * 128 + wid * 16 + j; norm_row(a.x + (size_t)row * D, hx + (size_t)row * D, gm, sh, lane); }
    { const int row = bid * 8 + wid; norm_row(a.ctx + (size_t)row * D, hc + (size_t)row * D, cgm, csh, lane); }
    __syncthreads();
}

constexpr int GL_QDP = 0, GL_KIP = 8704, GL_KETP = 17408, GL_VTP = 27648, GL_DEC = 37888, GL_TOT = 38400;
template <bool FULL>
__device__ __forceinline__ void gla_item(LAS uchar* lds, const bf16_t* qb, const float* lfb, const bf16_t* vb, bf16_t* ob, const float* s_in, float* s_out,
                                         int row_base, int Tn, int h, int dir, int tid, int wid, int lane) {
    const int fr = lane & 15, fq = lane >> 4, nch = Tn / 32;
    f32x4 S[8];
    if (s_in) {
#pragma unroll
        for (int t8 = 0; t8 < 8; ++t8)
#pragma unroll
            for (int r = 0; r < 4; ++r) S[t8][r] = s_in[(size_t)(16 * t8 + 4 * fq + r) * 128 + 16 * wid + fr];
    } else {
#pragma unroll
        for (int t8 = 0; t8 < 8; ++t8) S[t8] = (f32x4){0.f, 0.f, 0.f, 0.f};
    }
    const int colq = h * 128 + 2 * lane;
    f32x2 lf[4]; unsigned qv[4], vv[4];
#define GLA_LOAD(n) do { _Pragma("unroll") for (int rr = 0; rr < 4; ++rr) { const int tau = 32 * (n) + 4 * wid + rr; const size_t row = (size_t)(row_base + (dir ? (Tn - 1 - tau) : tau)); \
        lf[rr] = *(const f32x2*)(lfb + row * 512 + colq); vv[rr] = *(const unsigned*)(vb + row * 512 + colq); if (FULL) qv[rr] = *(const unsigned*)(qb + row * 512 + colq); } } while (0)
    GLA_LOAD(0);
    const int d0 = 2 * lane, pos0 = (d0 & ~31) + 8 * ((d0 >> 2) & 3) + 4 * ((d0 >> 4) & 1) + (d0 & 3);
    const int spos = 8 * (wid & 3) + 4 * (wid >> 2);
    for (int n = 0; n < nch; ++n) {
        f32x2 c[4]; c[0] = lf[0]; c[1] = c[0] + lf[1]; c[2] = c[1] + lf[2]; c[3] = c[2] + lf[3];
        LAS f32x2* tot = (LAS f32x2*)(lds + GL_TOT);
        tot[wid * 64 + lane] = c[3];
        f32x2 lfc[4]; unsigned qc[4], vc[4];
#pragma unroll
        for (int rr = 0; rr < 4; ++rr) { lfc[rr] = lf[rr]; qc[rr] = qv[rr]; vc[rr] = vv[rr]; }
        __syncthreads();
        if (n + 1 < nch) GLA_LOAD(n + 1);
        f32x2 pre = (f32x2){0.f, 0.f}, all = (f32x2){0.f, 0.f};
#pragma unroll
        for (int w = 0; w < 8; ++w) { const f32x2 tw = tot[w * 64 + lane]; all += tw; if (w < wid) pre += tw; }
        unsigned ke0[4], ke1[4];
#pragma unroll
        for (int rr = 0; rr < 4; ++rr) {
            const f32x2 cum = pre + c[rr];
            const float k0 = 1.f - __expf(lfc[rr].x), k1 = 1.f - __expf(lfc[rr].y);
            const float ki0 = k0 * __expf(-cum.x), ki1 = k1 * __expf(-cum.y);
            const float kE0 = k0 * __expf(all.x - cum.x), kE1 = k1 * __expf(all.y - cum.y);
            const int s = 4 * wid + rr;
            if (FULL) { const float e0 = __expf(cum.x), e1 = __expf(cum.y);
                *(LAS unsigned*)(lds + GL_QDP + s * 272 + pos0 * 2) = cvt_pk_bf16(bf_lo(qc[rr]) * e0, bf_hi(qc[rr]) * e1);
                *(LAS unsigned*)(lds + GL_KIP + s * 272 + pos0 * 2) = cvt_pk_bf16(ki0, ki1); }
            ke0[rr] = __float_as_uint(kE0); ke1[rr] = __float_as_uint(kE1);
        }
        { u32x2 w0, w1; w0.x = cvt_pk_bf16(__uint_as_float(ke0[0]), __uint_as_float(ke0[1])); w0.y = cvt_pk_bf16(__uint_as_float(ke0[2]), __uint_as_float(ke0[3]));
          w1.x = cvt_pk_bf16(__uint_as_float(ke1[0]), __uint_as_float(ke1[1])); w1.y = cvt_pk_bf16(__uint_as_float(ke1[2]), __uint_as_float(ke1[3]));
          *(LAS u32x2*)(lds + GL_KETP + (d0) * 80 + spos * 2) = w0; *(LAS u32x2*)(lds + GL_KETP + (d0 + 1) * 80 + spos * 2) = w1;
          u32x2 v0, v1; v0.x = (vc[0] & 0xffffu) | (vc[1] << 16); v0.y = (vc[2] & 0xffffu) | (vc[3] << 16);
          v1.x = (vc[0] >> 16) | (vc[1] & 0xffff0000u); v1.y = (vc[2] >> 16) | (vc[3] & 0xffff0000u);
          *(LAS u32x2*)(lds + GL_VTP + (d0) * 80 + spos * 2) = v0; *(LAS u32x2*)(lds + GL_VTP + (d0 + 1) * 80 + spos * 2) = v1; }
        if (wid == 0) *(LAS f32x2*)(lds + GL_DEC + lane * 8) = (f32x2){__expf(all.x), __expf(all.y)};
        __syncthreads();
        const bf16x8 vt = *(const LAS bf16x8*)(lds + GL_VTP + (16 * wid + fr) * 80 + fq * 16);
        if (FULL) {
            bf16x8 qf[2][4];
#pragma unroll
            for (int ti = 0; ti < 2; ++ti)
#pragma unroll
                for (int kk = 0; kk < 4; ++kk) qf[ti][kk] = *(const LAS bf16x8*)(lds + GL_QDP + (16 * ti + fr) * 272 + kk * 64 + fq * 16);
            f32x4 oT[2] = {(f32x4){0.f, 0.f, 0.f, 0.f}, (f32x4){0.f, 0.f, 0.f, 0.f}};
            f32x4 p00 = (f32x4){0.f, 0.f, 0.f, 0.f}, p01 = p00, p11 = p00;
#pragma unroll
            for (int kk = 0; kk < 4; ++kk) {
                const bf16x8 kj0 = *(const LAS bf16x8*)(lds + GL_KIP + (fr) * 272 + kk * 64 + fq * 16);
                const bf16x8 kj1 = *(const LAS bf16x8*)(lds + GL_KIP + (16 + fr) * 272 + kk * 64 + fq * 16);
                p00 = __builtin_amdgcn_mfma_f32_16x16x32_bf16(kj0, qf[0][kk], p00, 0, 0, 0);
                p01 = __builtin_amdgcn_mfma_f32_16x16x32_bf16(kj0, qf[1][kk], p01, 0, 0, 0);
                p11 = __builtin_amdgcn_mfma_f32_16x16x32_bf16(kj1, qf[1][kk], p11, 0, 0, 0);
                u32x4 sa; sa.x = cvt_pk_bf16_safe(S[2 * kk][0], S[2 * kk][1]); sa.y = cvt_pk_bf16_safe(S[2 * kk][2], S[2 * kk][3]);
                sa.z = cvt_pk_bf16_safe(S[2 * kk + 1][0], S[2 * kk + 1][1]); sa.w = cvt_pk_bf16_safe(S[2 * kk + 1][2], S[2 * kk + 1][3]);
                const bf16x8 sA = __builtin_bit_cast(bf16x8, sa);
                oT[0] = __builtin_amdgcn_mfma_f32_16x16x32_bf16(sA, qf[0][kk], oT[0], 0, 0, 0);
                oT[1] = __builtin_amdgcn_mfma_f32_16x16x32_bf16(sA, qf[1][kk], oT[1], 0, 0, 0);
            }
            u32x4 pb0, pb1;
            { float m0[4], m1[4];
#pragma unroll
              for (int r = 0; r < 4; ++r) { const bool ok = (4 * fq + r) <= fr; m0[r] = ok ? p00[r] : 0.f; m1[r] = ok ? p11[r] : 0.f; }
              pb0.x = cvt_pk_bf16_safe(m0[0], m0[1]); pb0.y = cvt_pk_bf16_safe(m0[2], m0[3]); pb0.z = 0u; pb0.w = 0u;
              pb1.x = cvt_pk_bf16_safe(p01[0], p01[1]); pb1.y = cvt_pk_bf16_safe(p01[2], p01[3]); pb1.z = cvt_pk_bf16_safe(m1[0], m1[1]); pb1.w = cvt_pk_bf16_safe(m1[2], m1[3]); }
            oT[0] = __builtin_amdgcn_mfma_f32_16x16x32_bf16(vt, __builtin_bit_cast(bf16x8, pb0), oT[0], 0, 0, 0);
            oT[1] = __builtin_amdgcn_mfma_f32_16x16x32_bf16(vt, __builtin_bit_cast(bf16x8, pb1), oT[1], 0, 0, 0);
#pragma unroll
            for (int ti = 0; ti < 2; ++ti) { const int tau = 32 * n + 16 * ti + fr; const size_t row = (size_t)(row_base + (dir ? (Tn - 1 - tau) : tau));
                u32x2 w; w.x = cvt_pk_bf16_safe(oT[ti][0], oT[ti][1]); w.y = cvt_pk_bf16_safe(oT[ti][2], oT[ti][3]);
                *(u32x2*)(ob + row * 512 + h * 128 + 16 * wid + 4 * fq) = w; }
        }
#pragma unroll
        for (int t8 = 0; t8 < 8; ++t8) {
            const f32x4 dc = *(const LAS f32x4*)(lds + GL_DEC + (16 * t8 + 4 * fq) * 4);
            const bf16x8 ka = *(const LAS bf16x8*)(lds + GL_KETP + (16 * t8 + fr) * 80 + fq * 16);
            S[t8] = __builtin_amdgcn_mfma_f32_16x16x32_bf16(ka, vt, S[t8] * dc, 0, 0, 0);
        }
    }
#undef GLA_LOAD
    if (s_out) {
#pragma unroll
        for (int t8 = 0; t8 < 8; ++t8)
#pragma unroll
            for (int r = 0; r < 4; ++r) s_out[(size_t)(16 * t8 + 4 * fq + r) * 128 + 16 * wid + fr] = S[t8][r];
    }
    __syncthreads();
}

__device__ __forceinline__ void unpack8(const u32x4 w, float (&f)[8]) { f[0] = bf_lo(w.x); f[1] = bf_hi(w.x); f[2] = bf_lo(w.y); f[3] = bf_hi(w.y); f[4] = bf_lo(w.z); f[5] = bf_hi(w.z); f[6] = bf_lo(w.w); f[7] = bf_hi(w.w); }
__device__ __forceinline__ void phase_mixfin(const Args& a, int bid, int G, int wid, int lane) {
    const bf16_t* of = (const bf16_t*)(a.ws + WS_OF); const bf16_t* obw = (const bf16_t*)(a.ws + WS_OB); const bf16_t* zg = (const bf16_t*)(a.ws + WS_ZG);
    const bf16_t* zgb = (const bf16_t*)(a.ws + WS_ZGB); const bf16_t* zgc = (const bf16_t*)(a.ws + WS_ZGC); const bf16_t* zv = (const bf16_t*)(a.ws + WS_ZV);
    bf16_t* A2 = (bf16_t*)(a.ws + WS_ACT);
    const int c0 = 8 * lane;
    float gain[8], cw0[8], cw1[8], cw2[8];
#pragma unroll
    for (int j = 0; j < 8; ++j) { gain[j] = a.hg_norm[(c0 + j) & 127]; cw0[j] = a.conv_w[c0 + j]; cw1[j] = a.conv_w[512 + c0 + j]; cw2[j] = a.conv_w[1024 + c0 + j]; }
    for (int row = bid * 8 + wid; row < M; row += G * 8) {
        const size_t ro = (size_t)row * 512 + c0;
        float f0[8], f1[8], gg[8], o[8];
        unpack8(*(const u32x4*)(of + ro), f0); unpack8(*(const u32x4*)(obw + ro), f1); unpack8(*(const u32x4*)(zg + ro), gg);
        float ss = 0.f;
#pragma unroll
        for (int j = 0; j < 8; ++j) { o[j] = f0[j] + f1[j]; ss += o[j] * o[j]; }
        ss += __shfl_xor(ss, 1); ss += __shfl_xor(ss, 2); ss += __shfl_xor(ss, 4); ss += __shfl_xor(ss, 8);
        const float rstd = rsqrtf(ss * (1.f / 128.f) + EPS);
#pragma unroll
        for (int j = 0; j < 8; ++j) o[j] = o[j] * rstd * gain[j] * silu_f(gg[j]);
        u32x4 w; w.x = cvt_pk_bf16(o[0], o[1]); w.y = cvt_pk_bf16(o[2], o[3]); w.z = cvt_pk_bf16(o[4], o[5]); w.w = cvt_pk_bf16(o[6], o[7]);
        *(u32x4*)(A2 + (size_t)row * D + c0) = w;
        const int tw = row & 63;
        float gcm[8], vm[8], gc0[8], v0[8], gcp[8], vp[8], gb[8], y[8];
        unpack8(*(const u32x4*)(zgc + ro), gc0); unpack8(*(const u32x4*)(zv + ro), v0); unpack8(*(const u32x4*)(zgb + ro), gb);
        if (tw > 0) { unpack8(*(const u32x4*)(zgc + ro - 512), gcm); unpack8(*(const u32x4*)(zv + ro - 512), vm); }
        else {
#pragma unroll
            for (int j = 0; j < 8; ++j) { gcm[j] = 0.f; vm[j] = 0.f; } }
        if (tw < 63) { unpack8(*(const u32x4*)(zgc + ro + 512), gcp); unpack8(*(const u32x4*)(zv + ro + 512), vp); }
        else {
#pragma unroll
            for (int j = 0; j < 8; ++j) { gcp[j] = 0.f; vp[j] = 0.f; } }
#pragma unroll
        for (int j = 0; j < 8; ++j) y[j] = gb[j] * (cw0[j] * (gcm[j] * vm[j]) + cw1[j] * (gc0[j] * v0[j]) + cw2[j] * (gcp[j] * vp[j]));
        w.x = cvt_pk_bf16(y[0], y[1]); w.y = cvt_pk_bf16(y[2], y[3]); w.z = cvt_pk_bf16(y[4], y[5]); w.w = cvt_pk_bf16(y[6], y[7]);
        *(u32x4*)(A2 + (size_t)row * D + 512 + c0) = w;
    }
}

__device__ __forceinline__ void phase_router(const Args& a, LAS uchar* lds, int bid, int tid, int wid, int lane) {
    const float* modf = (const float*)(a.ws + WS_MODF);
    LAS float* gm = (LAS float*)lds; LAS float* sh = gm + D;
    LAS uchar* wrl = lds + 8192;
    const int b = bid / 32;
    for (int cidx = tid; cidx < D; cidx += 512) { sh[cidx] = modf[(size_t)b * NMOD + 3 * D + cidx]; gm[cidx] = a.norm_ffn[cidx] * (1.f + modf[(size_t)b * NMOD + 4 * D + cidx]); }
    for (int i = tid; i < D * 4; i += 512) { const int col = i >> 2, q4 = i & 3; *(LAS f32x4*)(wrl + col * 64 + (col >> 2) * 16 + q4 * 16) = *(const f32x4*)(a.w_router + col * 16 + q4 * 4); }
    __syncthreads();
    bf16_t* hx2 = (bf16_t*)(a.ws + WS_ACT); float* aff = (float*)(a.ws + WS_AFF);
    for (int j = 0; j < 16; ++j) {
        const int row = bid * 128 + wid * 16 + j; const float* xrow = a.out + (size_t)row * D;
        f32x4 v[4]; float ss = 0.f;
#pragma unroll
        for (int jj = 0; jj < 4; ++jj) { v[jj] = *((const f32x4*)xrow + lane + 64 * jj); ss += (v[jj].x * v[jj].x + v[jj].y * v[jj].y) + (v[jj].z * v[jj].z + v[jj].w * v[jj].w); }
        const float rstd = rsqrtf(wave_sum(ss) * (1.f / D) + EPS);
        float pl[16];
#pragma unroll
        for (int e = 0; e < 16; ++e) pl[e] = 0.f;
#pragma unroll
        for (int jj = 0; jj < 4; ++jj) { const f32x4 g4 = *((const LAS f32x4*)gm + lane + 64 * jj), s4 = *((const LAS f32x4*)sh + lane + 64 * jj); const f32x4 hv = v[jj] * rstd * g4 + s4;
            u32x2 w; w.x = cvt_pk_bf16(hv.x, hv.y); w.y = cvt_pk_bf16(hv.z, hv.w); *((u32x2*)(hx2 + (size_t)row * D) + lane + 64 * jj) = w;
            const int colb = 4 * lane + 256 * jj;
#pragma unroll
            for (int cc = 0; cc < 4; ++cc) { const int col = colb + cc; const LAS uchar* wp = wrl + col * 64 + (col >> 2) * 16; const float hvv = hv[cc];
#pragma unroll
                for (int q4 = 0; q4 < 4; ++q4) { const f32x4 w4 = *(const LAS f32x4*)(wp + q4 * 16); pl[q4 * 4 + 0] += hvv * w4.x; pl[q4 * 4 + 1] += hvv * w4.y; pl[q4 * 4 + 2] += hvv * w4.z; pl[q4 * 4 + 3] += hvv * w4.w; } } }
#pragma unroll
        for (int e = 0; e < 16; ++e) pl[e] = wave_sum(pl[e]);
        float mx = pl[0];
#pragma unroll
        for (int e = 1; e < 16; ++e) mx = fmaxf(mx, pl[e]);
        float den = 0.f;
#pragma unroll
        for (int e = 0; e < 16; ++e) { pl[e] = __expf(pl[e] - mx); den += pl[e]; }
        const float inv = 1.f / den; float mine = 0.f;
#pragma unroll
        for (int e = 0; e < 16; ++e) mine = (lane == e) ? pl[e] * inv : mine;
        const int t = row & (T - 1);
        if (lane < 16) aff[((size_t)b * NE + lane) * T + t] = mine;
    }
    __syncthreads();
}

__device__ __forceinline__ void topk_item(const Args& a, LAS uchar* lds, int b, int e, int tid, int wid, int lane) {
    LAS unsigned* key = (LAS unsigned*)lds;
    LAS unsigned* hist = key + 4096;
    LAS unsigned* ctl = hist + 256;
    LAS unsigned* wsum = ctl + 8;
    const float* affp = (const float*)(a.ws + WS_AFF) + ((size_t)b * NE + e) * T;
    unsigned kv[8];
    { const u32x4 k0 = *(const u32x4*)(affp + tid * 8), k1 = *(const u32x4*)(affp + tid * 8 + 4); kv[0] = k0.x; kv[1] = k0.y; kv[2] = k0.z; kv[3] = k0.w; kv[4] = k1.x; kv[5] = k1.y; kv[6] = k1.z; kv[7] = k1.w; }
    unsigned prefix = 0u, mask = 0u, need = CAP;
    for (int shift = 24; shift >= 0; shift -= 8) {
        if (tid < 256) hist[tid] = 0u;
        __syncthreads();
#pragma unroll
        for (int j = 0; j < 8; ++j) if ((kv[j] & mask) == prefix) __hip_atomic_fetch_add(&hist[(kv[j] >> shift) & 255u], 1u, __ATOMIC_RELAXED, __HIP_MEMORY_SCOPE_WORKGROUP);
        __syncthreads();
        if (tid < 256) { unsigned above = 0u; for (int bb = tid + 1; bb < 256; ++bb) above += hist[bb]; const unsigned mine = hist[tid];
            if (above < need && need <= above + mine) { ctl[0] = (unsigned)tid; ctl[1] = need - above; } }
        __syncthreads();
        prefix |= ctl[0] << shift; mask |= 255u << shift; need = ctl[1];
        __syncthreads();
    }
    unsigned cg_ = 0u, ce_ = 0u;
#pragma unroll
    for (int j = 0; j < 8; ++j) { cg_ += kv[j] > prefix; ce_ += kv[j] == prefix; }
    unsigned pk = cg_ | (ce_ << 16), incl = pk;
#pragma unroll
    for (int o = 1; o < 64; o <<= 1) { const unsigned t2 = __shfl_up(incl, o); if (lane >= o) incl += t2; }
    if (lane == 63) wsum[wid] = incl;
    __syncthreads();
    unsigned base = 0u;
    for (int w = 0; w < wid; ++w) base += wsum[w];
    unsigned excl = base + incl - pk; unsigned ng = excl & 0xffffu, neq = excl >> 16;
    int* seltok = (int*)(a.ws + WS_SELTOK); float* selgate = (float*)(a.ws + WS_SELGATE); short* pos = (short*)(a.ws + WS_POS);
#pragma unroll
    for (int j = 0; j < 8; ++j) { const int t = tid * 8 + j; const bool gt = kv[j] > prefix, eq = kv[j] == prefix; const bool sel = gt || (eq && neq < need);
        int slot = -1;
        if (sel) slot = (int)(ng + (neq < need ? neq : need));
        if (sel) { seltok[e * 4096 + b * 512 + slot] = b * T + t; selgate[e * 4096 + b * 512 + slot] = __uint_as_float(kv[j]); }
        pos[((size_t)b * T + t) * 16 + e] = (short)slot;
        ng += gt; neq += eq; }
    __syncthreads();
}
__device__ __forceinline__ void phase_topk_cvt(const Args& a, LAS uchar* lds, int bid, int G, int tid, int wid, int lane) {
    if (bid < 128) topk_item(a, lds, bid / 16, bid % 16, tid, wid, lane);
    LAS float* scr = (LAS float*)(lds + 32768) + wid * (64 * 33);
    bf16_t* wgu = (bf16_t*)(a.ws + WS_WGU); bf16_t* wdn = (bf16_t*)(a.ws + WS_WDN);
    constexpr int I_G = (D / 64) * (DFF / 32);
    constexpr int I_D = (DFF / 64) * (D / 32);
    constexpr int PER_E = 2 * I_G + I_D, TOTAL = NE * PER_E;
    const int gw = (G - 1 - bid) * 8 + wid, NGW = G * 8;
    for (int it = gw; it < TOTAL; it += NGW) {
        const int e = it / PER_E; int r = it % PER_E;
        if (r < 2 * I_G) { const int up = r >= I_G; if (up) r -= I_G; const int nblk = DFF / 32, kb = r / nblk, nb = r % nblk, n0 = nb * 32;
            const float* W = (up ? a.w_up : a.w_gate) + (size_t)e * D * DFF;
            cvt_item(W, DFF, wgu + (size_t)e * 4096 * D, D, kb * 64, n0, (n0 >> 7) * 256 + (n0 & 127) + (up ? 128 : 0), scr, lane); }
        else { r -= 2 * I_G; const int nblk = D / 32, kb = r / nblk, nb = r % nblk;
            cvt_item(a.w_down + (size_t)e * DFF * D, D, wdn + (size_t)e * D * DFF, DFF, kb * 64, nb * 32, nb * 32, scr, lane); }
    }
    __syncthreads();
}

__device__ __forceinline__ void phase_final(const Args& a, int bid, int G, int wid, int lane) {
    const float* modf = (const float*)(a.ws + WS_MODF); const short* pos = (const short*)(a.ws + WS_POS); const bf16_t* ys = (const bf16_t*)(a.ws + WS_YS);
    for (int row = bid * 8 + wid; row < M; row += G * 8) {
        const int b = row / T; float* xrow = a.out + (size_t)row * D;
        f32x4 v[4], acc[4];
#pragma unroll
        for (int jj = 0; jj < 4; ++jj) { v[jj] = *((const f32x4*)xrow + lane + 64 * jj); acc[jj] = (f32x4){0.f, 0.f, 0.f, 0.f}; }
        const u32x4 p0 = *(const u32x4*)(pos + (size_t)row * 16), p1 = *(const u32x4*)(pos + (size_t)row * 16 + 8);
        const unsigned pw[8] = {p0.x, p0.y, p0.z, p0.w, p1.x, p1.y, p1.z, p1.w};
#pragma unroll
        for (int e = 0; e < 16; ++e) { const int sl = (int)(short)((e & 1) ? (pw[e >> 1] >> 16) : (pw[e >> 1] & 0xffffu));
            if (sl >= 0) { const bf16_t* yr = ys + ((size_t)e * 4096 + b * 512 + sl) * D;
#pragma unroll
                for (int jj = 0; jj < 4; ++jj) { const u32x2 w = *((const u32x2*)yr + lane + 64 * jj); acc[jj].x += bf_lo(w.x); acc[jj].y += bf_hi(w.x); acc[jj].z += bf_lo(w.y); acc[jj].w += bf_hi(w.y); } } }
        float ss = 0.f;
#pragma unroll
        for (int jj = 0; jj < 4; ++jj) { const f32x4 g2 = *((const f32x4*)(modf + (size_t)b * NMOD + 5 * D) + lane + 64 * jj); v[jj] = v[jj] + g2 * acc[jj];
            ss += (v[jj].x * v[jj].x + v[jj].y * v[jj].y) + (v[jj].z * v[jj].z + v[jj].w * v[jj].w); }
        const float rstd = rsqrtf(wave_sum(ss) * (1.f / D) + EPS);
#pragma unroll
        for (int jj = 0; jj < 4; ++jj) { const f32x4 nf = *((const f32x4*)a.norm_final + lane + 64 * jj); *((f32x4*)xrow + lane + 64 * jj) = v[jj] * rstd * nf; }
    }
}

__global__ void __launch_bounds__(512, 2) mega_fwd(Args a) {
    extern __shared__ __attribute__((aligned(16))) uchar lds_raw[];
    LAS uchar* lds = (LAS uchar*)lds_raw;
    cg::grid_group grid = cg::this_grid();
    const int tid = threadIdx.x, lane = tid & 63, wid = __builtin_amdgcn_readfirstlane(tid >> 6), bid = blockIdx.x, G = gridDim.x;
    const int lo = a.ph_lo, hi = a.ph_hi;
    uchar* ws = a.ws;
#define IN(k) (lo <= (k) && (k) < hi)
#define GSYNC() do { asm volatile("s_waitcnt vmcnt(0)" ::: "memory"); __syncthreads(); \
    if (threadIdx.x == 0) { __builtin_amdgcn_fence(__ATOMIC_RELEASE, "agent"); asm volatile("s_waitcnt vmcnt(0)" ::: "memory"); } \
    grid.sync(); __builtin_amdgcn_fence(__ATOMIC_ACQUIRE, "agent"); asm volatile("s_waitcnt vmcnt(0)" ::: "memory"); __syncthreads(); } while (0)
#define SEAM(k) do { if (IN(k) && IN((k) + 1)) GSYNC(); } while (0)
    if (IN(0)) phase_prep(a, lds, bid, G, tid, wid, lane);
    SEAM(0);
    if (IN(1)) phase_norm(a, lds, bid, G, tid, wid, lane);
    SEAM(1);
    if (IN(2)) {
        {
            pg8::Gemm g{(const bf16_t*)(ws + WS_HC), (const bf16_t*)(ws + WS_WIN) + (size_t)512 * D, D, 0, nullptr};
            pg8::GroupOrder S; S.init(MC / 256, 1536 / 256, 1, G, bid);
            pg8::EpiInproj E{nullptr, (bf16_t*)(ws + WS_CI), (float*)(ws + WS_CLF), (float*)(ws + WS_CLB), (const float*)(ws + WS_LB), 1};
            pg8::gemm_phase<pg8::EpiInproj, false>(lds, g, S, E);
        }
        {
            pg8::Gemm g{(const bf16_t*)(ws + WS_ACT), (const bf16_t*)(ws + WS_WIN), D, 0, nullptr};
            pg8::GroupOrder S; S.init(M / 256, NIN / 256, 1, G, bid);
            pg8::EpiInproj E{ws + WS_ZQ, nullptr, (float*)(ws + WS_LF), (float*)(ws + WS_LBW), (const float*)(ws + WS_LB), 0};
            pg8::gemm_phase<pg8::EpiInproj, false>(lds, g, S, E);
        }
    }
    SEAM(2);
    if (IN(3)) {
        if (bid < 64) { const int b = bid >> 3, h = (bid >> 1) & 3, dir = bid & 1;
            gla_item<false>(lds, nullptr, (const float*)(ws + (dir ? WS_CLB : WS_CLF)), (const bf16_t*)(ws + WS_CI), nullptr, nullptr,
                            (float*)(ws + WS_S0) + (size_t)bid * 16384, b * CT, CT, h, dir, tid, wid, lane); }
    }
    SEAM(3);
    if (IN(4)) {
        if (bid < 64) { const int b = bid >> 3, h = (bid >> 1) & 3, dir = bid & 1;
            gla_item<true>(lds, (const bf16_t*)(ws + WS_ZQ), (const float*)(ws + (dir ? WS_LBW : WS_LF)), (const bf16_t*)(ws + WS_ZI), (bf16_t*)(ws + (dir ? WS_OB : WS_OF)),
                           (const float*)(ws + WS_S0) + (size_t)bid * 16384, nullptr, b * T, T, h, dir, tid, wid, lane); }
    }
    SEAM(4);
    if (IN(5)) phase_mixfin(a, bid, G, wid, lane);
    SEAM(5);
    if (IN(6)) {
        pg8::Gemm g{(const bf16_t*)(ws + WS_ACT), (const bf16_t*)(ws + WS_WOUT), D, 0, nullptr};
        pg8::GroupOrder S; S.init(M / 256, D / 256, 1, G, bid);
        pg8::EpiOut E{a.x, a.out, (const float*)(ws + WS_MODF)};
        pg8::gemm_phase<pg8::EpiOut, false>(lds, g, S, E);
    }
    SEAM(6);
    if (IN(7)) phase_router(a, lds, bid, tid, wid, lane);
    SEAM(7);
    if (IN(8)) phase_topk_cvt(a, lds, bid, G, tid, wid, lane);
    SEAM(8);
    if (IN(9)) {
        pg8::Gemm g{(const bf16_t*)(ws + WS_ACT), (const bf16_t*)(ws + WS_WGU), D, (size_t)4096 * D * 2, (const int*)(ws + WS_SELTOK)};
        pg8::GroupOrder S; S.init(16, 16, NE, G, bid);
        pg8::EpiMoe1 E{(bf16_t*)(ws + WS_HID)};
        pg8::gemm_phase<pg8::EpiMoe1, true>(lds, g, S, E);
    }
    SEAM(9);
    if (IN(10)) {
        pg8::Gemm g{(const bf16_t*)(ws + WS_HID), (const bf16_t*)(ws + WS_WDN), DFF, (size_t)D * DFF * 2, nullptr};
        pg8::GroupOrder S; S.init(16, 4, NE, G, bid);
        pg8::EpiMoe2 E{(bf16_t*)(ws + WS_YS), (const float*)(ws + WS_SELGATE)};
        pg8::gemm_phase<pg8::EpiMoe2, false>(lds, g, S, E);
    }
    SEAM(10);
    if (IN(11)) phase_final(a, bid, G, wid, lane);

#ifdef DBG_DUMP
    GSYNC();
    {
        for (size_t i = (size_t)bid * 512 + tid; i < (size_t)M * D; i += (size_t)G * 512) { const size_t row = i / D; const int c = (int)(i % D); float v = 0.f;
            if (DBG_DUMP == 1) v = bf_lo(((const bf16_t*)(ws + WS_ACT))[i]);
            if (DBG_DUMP == 2) v = bf_lo(((const bf16_t*)(ws + (c < 512 ? WS_ZQ : WS_ZI)))[row * 512 + (c & 511)]);
            if (DBG_DUMP == 3) v = ((const float*)(ws + (c < 512 ? WS_LF : WS_LBW)))[row * 512 + (c & 511)];
            if (DBG_DUMP == 4) v = bf_lo(((const bf16_t*)(ws + (c < 512 ? WS_OF : WS_OB)))[row * 512 + (c & 511)]);
            if (DBG_DUMP == 5) v = bf_lo(((const bf16_t*)(ws + (c < 512 ? WS_ZG : WS_ZV)))[row * 512 + (c & 511)]);
            if (DBG_DUMP == 6) v = ((const float*)(ws + WS_S0))[i % (64 * 16384)];
            if (DBG_DUMP == 7) v = ((const float*)(ws + WS_MODF))[i % (9 * NMOD)];
            a.out[i] = v; }
    }
#endif
#undef IN
#undef SEAM
}

#ifndef N_LAUNCHES
#define N_LAUNCHES 1
#endif
extern "C" void kernel_launch(void* const* d_in, const int* in_sizes, int n_in, void* d_out, int out_size, void* d_ws, size_t ws_size, hipStream_t stream) {
    static int grid = 0;
    if (grid == 0) {
        if (n_in != 18 || out_size != M * D || ws_size < WS_END) { fprintf(stderr, "kernel_launch: unexpected shapes (n_in %d out %d ws %zu)\n", n_in, out_size, ws_size); grid = -1; return; }
        int dev = 0, cus = 0, per_cu = 0;
        (void)hipGetDevice(&dev); (void)hipDeviceGetAttribute(&cus, hipDeviceAttributeMultiprocessorCount, dev);
        (void)hipFuncSetAttribute((const void*)mega_fwd, hipFuncAttributeMaxDynamicSharedMemorySize, LDS_BYTES);
        (void)hipOccupancyMaxActiveBlocksPerMultiprocessor(&per_cu, (const void*)mega_fwd, 512, LDS_BYTES);
        if (per_cu < 1) { fprintf(stderr, "kernel_launch: occupancy query says %d blocks per CU\n", per_cu); grid = -1; return; }
        grid = 256;
        if (cus != 256) fprintf(stderr, "kernel_launch: note: %d CUs (built for 256)\n", cus);
    }
    if (grid < 0) return;
    Args a{};
    a.x = (const float*)d_in[0]; a.c = (const float*)d_in[1]; a.ctx = (const float*)d_in[2]; a.c_ctx = (const float*)d_in[3]; a.w_ada = (const float*)d_in[4]; a.b_ada = (const float*)d_in[5];
    a.norm_mix = (const float*)d_in[6]; a.norm_ffn = (const float*)d_in[7]; a.w_in = (const float*)d_in[8]; a.lb_logits = (const float*)d_in[9]; a.hg_norm = (const float*)d_in[10];
    a.conv_w = (const float*)d_in[11]; a.w_out = (const float*)d_in[12]; a.w_router = (const float*)d_in[13]; a.w_gate = (const float*)d_in[14]; a.w_up = (const float*)d_in[15];
    a.w_down = (const float*)d_in[16]; a.norm_final = (const float*)d_in[17]; a.out = (float*)d_out; a.ws = (uchar*)d_ws;
    if (N_LAUNCHES == 1) {
#ifndef DBG_HI
#define DBG_HI NPHASE
#endif
        a.ph_lo = 0; a.ph_hi = DBG_HI; void* args[] = {&a};
        hipError_t e = hipLaunchCooperativeKernel((const void*)mega_fwd, dim3(grid), dim3(512), args, LDS_BYTES, stream);
        if (e != hipSuccess) fprintf(stderr, "cooperative launch failed: %s\n", hipGetErrorString(e));
    } else {
        for (int p = 0; p < NPHASE; ++p) { a.ph_lo = p; a.ph_hi = p + 1; void* args[] = {&a};
            hipError_t e = hipLaunchCooperativeKernel((const void*)mega_fwd, dim3(grid), dim3(512), args, LDS_BYTES, stream);
            if (e != hipSuccess) { fprintf(stderr, "launch %d failed: %s\n", p, hipGetErrorString(e)); break; } }
    }
}
```

```cpp
#include <hip/hip_runtime.h>
#include <hip/hip_cooperative_groups.h>
#include <cstdio>
namespace cg = cooperative_groups;

#define LAS __attribute__((address_space(3)))
#define GAS __attribute__((address_space(1)))
typedef unsigned short bf16_t;
typedef short bf16x8 __attribute__((ext_vector_type(8)));
typedef float f32x4 __attribute__((ext_vector_type(4)));
typedef float f32x2 __attribute__((ext_vector_type(2)));
typedef unsigned u32x4 __attribute__((ext_vector_type(4)));
typedef unsigned u32x2 __attribute__((ext_vector_type(2)));
typedef unsigned char uchar;

constexpr int D = 1024, NB = 8, T = 4096, M = NB * T, CT = 256, MC = NB * CT;
constexpr int NIN = 4096, HK = 512, NH = 4, NE = 16, CAP = 512, DFF = 2048, NMOD = 6 * D;
constexpr float EPS = 1e-6f;
constexpr int NPHASE = 12;

constexpr size_t MiB = 1u << 20;
constexpr size_t WS_ACT = 0;
constexpr size_t WS_WIN = 64 * MiB;
constexpr size_t WS_WOUT = 72 * MiB;
constexpr size_t WS_MODP = 74 * MiB;
constexpr size_t WS_MODF = 76 * MiB;
constexpr size_t WS_LB = 76 * MiB + 512 * 1024;
constexpr size_t WS_HC = 77 * MiB;
constexpr size_t WS_CLF = 81 * MiB;
constexpr size_t WS_CLB = 85 * MiB;
constexpr size_t WS_CI = 89 * MiB;
constexpr size_t WS_S0 = 91 * MiB;
constexpr size_t WS_AFF = 95 * MiB;
constexpr size_t WS_SELTOK = 97 * MiB;
constexpr size_t WS_SELGATE = 97 * MiB + 256 * 1024;
constexpr size_t WS_POS = 98 * MiB;
constexpr size_t WS_BAR = 100 * MiB;
constexpr size_t WS_ZQ = 104 * MiB;
constexpr size_t WS_LF = 136 * MiB;
constexpr size_t WS_LBW = 200 * MiB;
constexpr size_t WS_ZI = 264 * MiB;
constexpr size_t WS_ZG = 296 * MiB;
constexpr size_t WS_ZGB = 328 * MiB;
constexpr size_t WS_ZGC = 360 * MiB;
constexpr size_t WS_ZV = 392 * MiB;
constexpr size_t WS_OF = 424 * MiB;
constexpr size_t WS_OB = 456 * MiB;
constexpr size_t WS_WGU = 104 * MiB;
constexpr size_t WS_WDN = 232 * MiB;
constexpr size_t WS_HID = 296 * MiB;
constexpr size_t WS_YS = WS_WGU;
constexpr size_t WS_END = 552 * MiB;
static_assert(WS_ZI == WS_ZQ + 160 * MiB && WS_ZG == WS_ZI + 32 * MiB && WS_ZGB == WS_ZG + 32 * MiB && WS_ZGC == WS_ZGB + 32 * MiB && WS_ZV == WS_ZGC + 32 * MiB, "z segment map");

constexpr int LDS_BYTES = 147456;

typedef __bf16 bf16x2_t __attribute__((ext_vector_type(2)));
__device__ __forceinline__ unsigned cvt_pk_bf16_safe(float lo, float hi) { typedef float f2_t __attribute__((ext_vector_type(2))); const bf16x2_t v = __builtin_convertvector((f2_t){lo, hi}, bf16x2_t); return __builtin_bit_cast(unsigned, v); }
__device__ __forceinline__ unsigned cvt_pk_bf16(float lo, float hi) { unsigned r; asm volatile("v_cvt_pk_bf16_f32 %0, %1, %2" : "=v"(r) : "v"(lo), "v"(hi)); return r; }
__device__ __forceinline__ float bf_lo(unsigned u) { return __uint_as_float(u << 16); }
__device__ __forceinline__ float bf_hi(unsigned u) { return __uint_as_float(u & 0xffff0000u); }
__device__ __forceinline__ float wave_sum(float v) {
#pragma unroll
    for (int o = 1; o < 64; o <<= 1) v += __shfl_xor(v, o);
    return v;
}
__device__ __forceinline__ float silu_f(float x) { return x / (1.f + __expf(-x)); }
#define LDS_WAIT() asm volatile("s_waitcnt lgkmcnt(0)" ::: "memory")


#define XB_TMO      128
#define XB_XCNT(j)  (256  + 64 * (j))
#define XB_XSUB(j)  (1280 + 64 * (j))
#define XB_XGEN(j)  (2304 + 64 * (j))
#define XB_TOP      3328
#define XB_TOPGEN   3392
#define XCD_BAR_WORDS 3456
#define XB_SPIN_CAP (1u << 20)
__device__ __forceinline__ unsigned xb_ld(unsigned* p)              { return __hip_atomic_load(p, __ATOMIC_RELAXED, __HIP_MEMORY_SCOPE_AGENT); }
__device__ __forceinline__ unsigned xb_add(unsigned* p, unsigned v) { return __hip_atomic_fetch_add(p, v, __ATOMIC_RELAXED, __HIP_MEMORY_SCOPE_AGENT); }
__device__ __forceinline__ unsigned xb_xcc_id() { return (unsigned)__builtin_amdgcn_s_getreg((3 << 11) | 20) & 0xFu; }
#define XB_SPIN(cond, bar) do { unsigned _sp = 0; while (cond) { __builtin_amdgcn_s_sleep(1); \
    if ((++_sp & 255u) == 0u) { if (xb_ld(&(bar)[XB_TMO])) break; if (_sp > XB_SPIN_CAP) { atomicAdd(&(bar)[XB_TMO], 1u); break; } } } } while (0)
struct XcdBarrier { unsigned* bar; unsigned x; volatile LAS unsigned* st; };
__device__ __forceinline__ XcdBarrier xcd_barrier_post(unsigned* bar, volatile LAS unsigned* st) {
    XcdBarrier b; b.bar = bar; b.x = xb_xcc_id(); b.st = st;
    if (threadIdx.x == 0) (void)xb_add(&bar[XB_XCNT(b.x)], 1u);
    return b;
}
__device__ __forceinline__ void xcd_barrier_complete(unsigned* bar, unsigned x, unsigned& nloc, unsigned& nx) {
    const unsigned G = gridDim.x * gridDim.y * gridDim.z;
    unsigned sum, cnt, mine, sp = 0u;
    for (;;) {
        sum = 0u; cnt = 0u; mine = 0u;
#pragma unroll
        for (unsigned j = 0; j < 16; ++j) { const unsigned c = xb_ld(&bar[XB_XCNT(j)]); sum += c; cnt += (c > 0u) ? 1u : 0u; mine = (j == x) ? c : mine; }
        if (sum == G) break;
        __builtin_amdgcn_s_sleep(1);
        if ((++sp & 255u) == 0u) { if (xb_ld(&bar[XB_TMO])) break; if (sp > XB_SPIN_CAP) { atomicAdd(&bar[XB_TMO], 1u); break; } }
    }
    nloc = mine > 0u ? mine : 1u; nx = cnt > 0u ? cnt : 1u;
}
__device__ __forceinline__ void xcd_barrier(const XcdBarrier& b) {
    asm volatile("s_waitcnt vmcnt(0)" ::: "memory");
    __syncthreads();
    if (threadIdx.x == 0) {
        unsigned* bar = b.bar;
        __builtin_amdgcn_s_waitcnt(0);
        unsigned nloc = b.st[0], nx = b.st[1];
        if (nloc == 0u) { xcd_barrier_complete(bar, b.x, nloc, nx); b.st[0] = nloc; b.st[1] = nx; }
        const unsigned old = xb_add(&bar[XB_XSUB(b.x)], 1u);
        const unsigned gen = old / nloc;
        if (old + 1u == (gen + 1u) * nloc) {
            __builtin_amdgcn_fence(__ATOMIC_RELEASE, "agent");
            asm volatile("s_waitcnt vmcnt(0)" ::: "memory");
            const unsigned og = xb_add(&bar[XB_TOP], 1u);
            const unsigned tg = og / nx;
            if (og + 1u == (tg + 1u) * nx) xb_add(&bar[XB_TOPGEN], 1u);
            else XB_SPIN(xb_ld(&bar[XB_TOPGEN]) == tg, bar);
            __builtin_amdgcn_fence(__ATOMIC_ACQUIRE, "agent");
            xb_add(&bar[XB_XGEN(b.x)], 1u);
            asm volatile("s_waitcnt vmcnt(0)" ::: "memory");
        } else {
            XB_SPIN(xb_ld(&bar[XB_XGEN(b.x)]) == gen, bar);
            __builtin_amdgcn_fence(__ATOMIC_ACQUIRE, "agent");
            asm volatile("s_waitcnt vmcnt(0)" ::: "memory");
        }
    }
    __syncthreads();
}

namespace pg8 {
constexpr int BM = 256, BK = 64, HALF = 128, HTB = HALF * BK * 2, STAGE_BYTES = 8 * HTB, NXCD = 8, WGM = 8;
__device__ __forceinline__ int lds_byte(int r, int c) { const int st = (r >> 4) * 2 + (c >> 5), rr = r & 15, cc = c & 31, ob = rr * 64 + cc * 2; return st * 1024 + (ob ^ (((ob >> 9) & 1) << 5)); }
__device__ __forceinline__ void stage_rc(int b, int& R, int& C) { const int st = b / 1024, sb = b % 1024, swz = sb ^ (((sb >> 9) & 1) << 5); R = (st >> 1) * 16 + swz / 64; C = (st & 1) * 32 + (swz % 64) / 2; }
__device__ __forceinline__ int perm32(int rho) { const int n = rho >> 4, i = rho & 15; return 8 * (i >> 2) + 4 * n + (i & 3); }

struct Unit { int pm, pn, e; };
struct GroupOrder {
    int nM, nN, ng, G, c;
    __device__ __forceinline__ void init(int nM_, int nN_, int ng_, int G_, int c_) { nM = nM_; nN = nN_; ng = ng_; G = G_; c = c_; }
    __device__ __forceinline__ bool next(int i, Unit& u) const {
        const int nwg = nM * nN; const long L = (long)i * G + c; if (L >= (long)nwg * ng) return false;
        const int grp = (int)(L / nwg); int wgid = (int)(L % nwg);
        { const int q = nwg / NXCD, r = nwg % NXCD, xcd = wgid % NXCD, off = wgid / NXCD; wgid = (xcd < r ? xcd * (q + 1) : r * (q + 1) + (xcd - r) * q) + off; }
        const int nig = WGM * nN, gid = wgid / nig, fm = gid * WGM, gsz = (nM - fm) < WGM ? (nM - fm) : WGM;
        u.pm = grp * nM + fm + ((wgid % nig) % gsz); u.pn = (wgid % nig) / gsz; u.e = grp; return true;
    }
};
struct Gemm { const bf16_t* A; const bf16_t* Bt; int K; size_t bgs; const int* rowidx; };

template <class Epi, bool GATHER>
__device__ __forceinline__ void gemm_phase(LAS uchar* lds, const Gemm g, const GroupOrder& S, const Epi& E) {
    const int tid = threadIdx.x, wid = __builtin_amdgcn_readfirstlane(tid >> 6), lane = tid & 63, wr = wid >> 2, wc = wid & 3, fr = lane & 15, fq = lane >> 4;
    const int K = g.K, nt = K / BK;
    unsigned voffA[2], voffB[2]; int Rr[2], Cc[2];
#pragma unroll
    for (int i = 0; i < 2; ++i) { int R, C; stage_rc(tid * 16 + i * 8192, R, C); const int Rb = Epi::PERM ? ((R & ~31) + perm32(R & 31)) : R; Rr[i] = R; Cc[i] = C;
        voffA[i] = (unsigned)(R * K + C) * 2u; voffB[i] = (unsigned)(Rb * K + C) * 2u; }
    const size_t kstep = (size_t)(BK * 2);
    const size_t hstep = (size_t)HALF * K * 2;
    const size_t tstep = 2 * hstep;
    const unsigned ldsw = (unsigned)wid * 1024u;
    const int aoff = lds_byte(wr * 64 + fr, fq * 8), boff = lds_byte(wc * 32 + fr, fq * 8);
#define PG8_SA(b, h) (((b) * 2 + (h)) * HTB)
#define PG8_SB(b, h) ((4 + (b) * 2 + (h)) * HTB)
#define PG8_STAGE(bufoff, gbase, voff) do { _Pragma("unroll") for (int _i = 0; _i < 2; ++_i) \
        __builtin_amdgcn_global_load_lds((const unsigned*)((const char*)(gbase) + (voff)[_i]), (LAS unsigned*)(lds + (bufoff) + ldsw + _i * 8192), 16, 0, 0); } while (0)
#define PG8_STAGE_A(bufoff, p, ofs, h) do { if constexpr (GATHER) { PG8_STAGE(bufoff, p, (ofs)[h]); } else { PG8_STAGE(bufoff, (p) + (h) * hstep, voffA); } } while (0)
#define PG8_LDA(dst, b, h) do { _Pragma("unroll") for (int m = 0; m < 4; ++m) _Pragma("unroll") for (int k = 0; k < 2; ++k) dst[m][k] = *(const LAS bf16x8*)(lds + PG8_SA(b, h) + aoff + m * 2048 + k * 1024); } while (0)
#define PG8_LDB(dst, b, h) do { _Pragma("unroll") for (int n = 0; n < 2; ++n) _Pragma("unroll") for (int k = 0; k < 2; ++k) dst[n][k] = *(const LAS bf16x8*)(lds + PG8_SB(b, h) + boff + n * 2048 + k * 1024); } while (0)
#define PG8_MMA(ai, bj, At, Bt) do { __builtin_amdgcn_s_setprio(1); _Pragma("unroll") for (int m = 0; m < 4; ++m) _Pragma("unroll") for (int n = 0; n < 2; ++n) _Pragma("unroll") for (int k = 0; k < 2; ++k) \
        acc[ai][bj][m][n] = __builtin_amdgcn_mfma_f32_16x16x32_bf16(Bt[n][k], At[m][k], acc[ai][bj][m][n], 0, 0, 0); __builtin_amdgcn_s_setprio(0); } while (0)
#define PG8_WAIT_V(n) asm volatile("s_waitcnt vmcnt(" #n ")" ::: "memory")
#define PG8_WAIT_L(n) asm volatile("s_waitcnt lgkmcnt(" #n ")" ::: "memory")
#define PG8_BAR __builtin_amdgcn_s_barrier()
#define PG8_SCHED __builtin_amdgcn_sched_barrier(0)
    Unit cur, nxt; int ui = 0;
    if (!S.next(0, cur)) return;
    f32x4 acc[2][2][4][2];
#pragma unroll
    for (int a = 0; a < 2; ++a)
#pragma unroll
        for (int b = 0; b < 2; ++b)
#pragma unroll
            for (int m = 0; m < 4; ++m)
#pragma unroll
                for (int n = 0; n < 2; ++n) acc[a][b][m][n] = (f32x4){0.f, 0.f, 0.f, 0.f};
    bf16x8 At[4][2], B0[2][2], B1[2][2];
    unsigned cofs[2][2], nofs[2][2];
    if constexpr (GATHER) {
#pragma unroll
        for (int h = 0; h < 2; ++h)
#pragma unroll
            for (int i = 0; i < 2; ++i) { const int row = g.rowidx[cur.pm * BM + h * HALF + Rr[i]]; cofs[h][i] = (unsigned)(row * K + Cc[i]) * 2u; nofs[h][i] = cofs[h][i]; }
    }
    const char* cA = GATHER ? (const char*)g.A : (const char*)g.A + (size_t)cur.pm * tstep;
    const char* cB = (const char*)g.Bt + (size_t)cur.e * g.bgs + (size_t)cur.pn * tstep;
    PG8_STAGE(PG8_SB(0, 0), cB, voffB); PG8_STAGE(PG8_SB(0, 1), cB + hstep, voffB); PG8_STAGE_A(PG8_SA(0, 0), cA, cofs, 0); PG8_STAGE_A(PG8_SA(0, 1), cA, cofs, 1);
    if (wr == 1) PG8_BAR;
    PG8_WAIT_V(2); PG8_BAR;
    PG8_STAGE(PG8_SB(1, 0), cB + kstep, voffB); PG8_STAGE_A(PG8_SA(1, 0), cA + kstep, cofs, 0); PG8_STAGE(PG8_SB(1, 1), cB + hstep + kstep, voffB);
    PG8_WAIT_V(6); PG8_BAR;
    for (;;) {
        const bool has_next = S.next(ui + 1, nxt);
        const char* nA = GATHER ? (const char*)g.A : (has_next ? (const char*)g.A + (size_t)nxt.pm * tstep : cA);
        const char* nB = has_next ? (const char*)g.Bt + (size_t)nxt.e * g.bgs + (size_t)nxt.pn * tstep : cB;
        for (int t = 0; t < nt; t += 2) {
            const bool last = (t == nt - 2);
            const char* a1 = cA + (size_t)(t + 1) * kstep;
            const char* a2 = last ? nA : cA + (size_t)(t + 2) * kstep; const char* b2 = last ? nB : cB + (size_t)(t + 2) * kstep;
            const char* a3 = a2 + kstep; const char* b3 = b2 + kstep;
            if constexpr (GATHER) {
                if (last && has_next) {
#pragma unroll
                    for (int h = 0; h < 2; ++h)
#pragma unroll
                        for (int i = 0; i < 2; ++i) { const int row = g.rowidx[nxt.pm * BM + h * HALF + Rr[i]]; nofs[h][i] = (unsigned)(row * K + Cc[i]) * 2u; }
                }
            }
            PG8_LDB(B0, 0, 0); PG8_LDB(B1, 0, 1); PG8_SCHED; PG8_LDA(At, 0, 0); PG8_STAGE_A(PG8_SA(1, 1), a1, cofs, 1);
            PG8_WAIT_V(8); PG8_WAIT_L(0); PG8_BAR; PG8_MMA(0, 0, At, B0); PG8_MMA(0, 1, At, B1); PG8_BAR; PG8_SCHED;
            PG8_LDA(At, 0, 1); PG8_STAGE(PG8_SB(0, 0), b2, voffB); PG8_STAGE(PG8_SB(0, 1), b2 + hstep, voffB);
            if (last) { PG8_STAGE_A(PG8_SA(0, 0), a2, nofs, 0); } else { PG8_STAGE_A(PG8_SA(0, 0), a2, cofs, 0); }
            PG8_WAIT_V(8); PG8_WAIT_L(0); PG8_BAR; PG8_MMA(1, 0, At, B0); PG8_MMA(1, 1, At, B1); PG8_BAR; PG8_SCHED;
            PG8_LDB(B0, 1, 0); PG8_LDB(B1, 1, 1); PG8_SCHED; PG8_LDA(At, 1, 0);
            if (last) { PG8_STAGE_A(PG8_SA(0, 1), a2, nofs, 1); } else { PG8_STAGE_A(PG8_SA(0, 1), a2, cofs, 1); }
            PG8_WAIT_V(8); PG8_WAIT_L(0); PG8_BAR; PG8_MMA(0, 0, At, B0); PG8_MMA(0, 1, At, B1); PG8_BAR; PG8_SCHED;
            PG8_LDA(At, 1, 1); PG8_STAGE(PG8_SB(1, 0), b3, voffB); PG8_STAGE(PG8_SB(1, 1), b3 + hstep, voffB);
            if (last) { PG8_STAGE_A(PG8_SA(1, 0), a3, nofs, 0); } else { PG8_STAGE_A(PG8_SA(1, 0), a3, cofs, 0); }
            PG8_WAIT_V(8); PG8_WAIT_L(0); PG8_BAR; PG8_MMA(1, 0, At, B0); PG8_MMA(1, 1, At, B1); PG8_BAR; PG8_SCHED;
        }
        if (wr == 0) PG8_BAR;
        E(acc, cur, wr, wc, fr, fq);
        if (!has_next) break;
#pragma unroll
        for (int a = 0; a < 2; ++a)
#pragma unroll
            for (int b = 0; b < 2; ++b)
#pragma unroll
                for (int m = 0; m < 4; ++m)
#pragma unroll
                    for (int n = 0; n < 2; ++n) acc[a][b][m][n] = (f32x4){0.f, 0.f, 0.f, 0.f};
        cur = nxt; cA = nA; cB = nB; ++ui;
        if constexpr (GATHER) {
#pragma unroll
            for (int h = 0; h < 2; ++h)
#pragma unroll
                for (int i = 0; i < 2; ++i) cofs[h][i] = nofs[h][i];
        }
        if (wr == 1) PG8_BAR;
    }
    PG8_WAIT_V(0);
    PG8_BAR;
#undef PG8_SA
#undef PG8_SB
#undef PG8_STAGE
#undef PG8_STAGE_A
#undef PG8_LDA
#undef PG8_LDB
#undef PG8_MMA
#undef PG8_WAIT_V
#undef PG8_WAIT_L
#undef PG8_BAR
#undef PG8_SCHED
}


struct EpiInproj {
    static constexpr bool PERM = true;
    uchar* zbase; bf16_t* ci; float* olog0; float* olog1; const float* lb; int seg0;
    __device__ __forceinline__ void operator()(const f32x4 (&acc)[2][2][4][2], const Unit& u, int wr, int wc, int fr, int fq) const {
        const int seg = seg0 + (u.pn >> 1);
        const int row0 = u.pm * BM + wr * 64 + fr, col0 = (u.pn & 1) * 256 + wc * 32 + 8 * fq;
        if (seg == 1 || seg == 2) {
            float* O = (seg == 1) ? olog0 : olog1; const float* lbp = lb + (seg - 1) * 512;
#pragma unroll
            for (int bj = 0; bj < 2; ++bj) {
                const f32x4 l0 = *(const f32x4*)(lbp + col0 + bj * HALF), l1 = *(const f32x4*)(lbp + col0 + bj * HALF + 4);
#pragma unroll
                for (int ai = 0; ai < 2; ++ai)
#pragma unroll
                    for (int m = 0; m < 4; ++m) { float* rowp = O + (size_t)(row0 + ai * HALF + m * 16) * 512 + col0 + bj * HALF;
                        f32x4 v0 = acc[ai][bj][m][0], v1 = acc[ai][bj][m][1], o0, o1;
#pragma unroll
                        for (int j = 0; j < 4; ++j) { const float s0 = 1.f / (1.f + __expf(-v0[j])), s1 = 1.f / (1.f + __expf(-v1[j]));
                            o0[j] = __logf(l0[j] + (1.f - l0[j]) * s0); o1[j] = __logf(l1[j] + (1.f - l1[j]) * s1); }
                        *(f32x4*)rowp = o0; *(f32x4*)(rowp + 4) = o1; }
            }
        } else {
            bf16_t* O = zbase ? (bf16_t*)(zbase + (size_t)(32 * seg + (seg >= 3 ? 64 : 0)) * MiB) : ci;
#pragma unroll
            for (int ai = 0; ai < 2; ++ai)
#pragma unroll
                for (int m = 0; m < 4; ++m) { bf16_t* rowp = O + (size_t)(row0 + ai * HALF + m * 16) * 512 + col0;
#pragma unroll
                    for (int bj = 0; bj < 2; ++bj) { const f32x4 v0 = acc[ai][bj][m][0], v1 = acc[ai][bj][m][1];
                        u32x4 w; w.x = cvt_pk_bf16(v0[0], v0[1]); w.y = cvt_pk_bf16(v0[2], v0[3]); w.z = cvt_pk_bf16(v1[0], v1[1]); w.w = cvt_pk_bf16(v1[2], v1[3]);
                        *(u32x4*)(rowp + bj * HALF) = w; } }
        }
    }
};
struct EpiOut {
    static constexpr bool PERM = false;
    const float* x; float* x1; const float* modf;
    __device__ __forceinline__ void operator()(const f32x4 (&acc)[2][2][4][2], const Unit& u, int wr, int wc, int fr, int fq) const {
        const int row0 = u.pm * BM + wr * 64 + fr, col0 = u.pn * BM + wc * 32 + 4 * fq;
        const int b = (u.pm * BM) / T;
        const float* g1 = modf + (size_t)b * NMOD + 2 * D;
        f32x4 gv[2][2];
#pragma unroll
        for (int bj = 0; bj < 2; ++bj)
#pragma unroll
            for (int n = 0; n < 2; ++n) gv[bj][n] = *(const f32x4*)(g1 + col0 + bj * HALF + n * 16);
#pragma unroll
        for (int ai = 0; ai < 2; ++ai)
#pragma unroll
            for (int m = 0; m < 4; ++m) { const size_t off = (size_t)(row0 + ai * HALF + m * 16) * D + col0;
#pragma unroll
                for (int bj = 0; bj < 2; ++bj)
#pragma unroll
                    for (int n = 0; n < 2; ++n) { const f32x4 xs = *(const f32x4*)(x + off + bj * HALF + n * 16); *(f32x4*)(x1 + off + bj * HALF + n * 16) = xs + gv[bj][n] * acc[ai][bj][m][n]; }
                asm volatile("" ::: "memory"); }
    }
};
struct EpiMoe1 {
    static constexpr bool PERM = true;
    bf16_t* hid;
    __device__ __forceinline__ void operator()(const f32x4 (&acc)[2][2][4][2], const Unit& u, int wr, int wc, int fr, int fq) const {
        const int row0 = u.pm * BM + wr * 64 + fr, col0 = u.pn * 128 + wc * 32 + 8 * fq;
#pragma unroll
        for (int ai = 0; ai < 2; ++ai)
#pragma unroll
            for (int m = 0; m < 4; ++m) { bf16_t* rowp = hid + (size_t)(row0 + ai * HALF + m * 16) * DFF + col0;
                float o[8];
#pragma unroll
                for (int n = 0; n < 2; ++n)
#pragma unroll
                    for (int j = 0; j < 4; ++j) { const float gt = acc[ai][0][m][n][j], up = acc[ai][1][m][n][j]; o[n * 4 + j] = gt * up / (1.f + __expf(-gt)); }
                u32x4 w; w.x = cvt_pk_bf16(o[0], o[1]); w.y = cvt_pk_bf16(o[2], o[3]); w.z = cvt_pk_bf16(o[4], o[5]); w.w = cvt_pk_bf16(o[6], o[7]);
                *(u32x4*)rowp = w; }
    }
};
struct EpiMoe2 {
    static constexpr bool PERM = true;
    bf16_t* ys; const float* gate;
    __device__ __forceinline__ void operator()(const f32x4 (&acc)[2][2][4][2], const Unit& u, int wr, int wc, int fr, int fq) const {
        const int row0 = u.pm * BM + wr * 64 + fr, col0 = u.pn * BM + wc * 32 + 8 * fq;
#pragma unroll
        for (int ai = 0; ai < 2; ++ai)
#pragma unroll
            for (int m = 0; m < 4; ++m) { const int row = row0 + ai * HALF + m * 16; const float gt = gate[row]; bf16_t* rowp = ys + (size_t)row * D + col0;
#pragma unroll
                for (int bj = 0; bj < 2; ++bj) { const f32x4 v0 = acc[ai][bj][m][0] * gt, v1 = acc[ai][bj][m][1] * gt;
                    u32x4 w; w.x = cvt_pk_bf16(v0[0], v0[1]); w.y = cvt_pk_bf16(v0[2], v0[3]); w.z = cvt_pk_bf16(v1[0], v1[1]); w.w = cvt_pk_bf16(v1[2], v1[3]);
                    *(u32x4*)(rowp + bj * HALF) = w; } }
    }
};
}

struct Args {
    const float *x, *c, *ctx, *c_ctx, *w_ada, *b_ada, *norm_mix, *norm_ffn, *w_in, *lb_logits, *hg_norm, *conv_w, *w_out, *w_router, *w_gate, *w_up, *w_down, *norm_final;
    float* out; uchar* ws; int ph_lo, ph_hi;
};

__device__ __forceinline__ void cvt_item(const float* W, int ldw, bf16_t* WT, int ldt, int k0, int n0, int nrow0, LAS float* scr, int lane) {
#pragma unroll 8
    for (int i = 0; i < 32; ++i) { const int kk = 2 * i + (lane >> 5); scr[kk * 33 + (lane & 31)] = W[(size_t)(k0 + kk) * ldw + n0 + (lane & 31)]; }
    LDS_WAIT(); asm volatile("" ::: "memory");
    const int c = lane & 7;
#pragma unroll
    for (int j = 0; j < 4; ++j) { const int n = (lane >> 3) + 8 * j; const LAS float* s = scr + (8 * c) * 33 + n;
        u32x4 o; o.x = cvt_pk_bf16(s[0 * 33], s[1 * 33]); o.y = cvt_pk_bf16(s[2 * 33], s[3 * 33]); o.z = cvt_pk_bf16(s[4 * 33], s[5 * 33]); o.w = cvt_pk_bf16(s[6 * 33], s[7 * 33]);
        *(u32x4*)(WT + (size_t)(nrow0 + n) * ldt + k0 + 8 * c) = o; }
    LDS_WAIT(); asm volatile("" ::: "memory");
}

__device__ __forceinline__ void phase_prep(const Args& a, LAS uchar* lds, int bid, int G, int tid, int wid, int lane) {
    float* modp = (float*)(a.ws + WS_MODP);
    if (bid < 192) {
        const int cgp = bid % 24, ks = bid / 24, n0 = cgp * 256 + lane * 4, k0 = ks * 128 + wid * 16;
        f32x4 acc[9];
#pragma unroll
        for (int r = 0; r < 9; ++r) acc[r] = (f32x4){0.f, 0.f, 0.f, 0.f};
#pragma unroll 4
        for (int kk = 0; kk < 16; ++kk) { const int k = k0 + kk; const f32x4 w = *(const f32x4*)(a.w_ada + (size_t)k * NMOD + n0);
#pragma unroll
            for (int r = 0; r < 9; ++r) { const float cv = (r < 8) ? a.c[r * D + k] : a.c_ctx[k]; const float s = silu_f(cv); acc[r] += w * s; } }
        LAS f32x4* red = (LAS f32x4*)lds;
#pragma unroll
        for (int r = 0; r < 9; ++r) red[(wid * 9 + r) * 64 + lane] = acc[r];
        __syncthreads();
        for (int o = tid; o < 9 * 64; o += 512) { const int r = o / 64, l = o % 64; f32x4 s = red[(0 * 9 + r) * 64 + l];
#pragma unroll
            for (int w = 1; w < 8; ++w) s += red[(w * 9 + r) * 64 + l];
            if (ks == 0) s += *(const f32x4*)(a.b_ada + cgp * 256 + l * 4);
            *(f32x4*)(modp + ((size_t)ks * 9 + r) * NMOD + cgp * 256 + l * 4) = s; }
        __syncthreads();
    }
    if (bid == 255) {
        float* lb = (float*)(a.ws + WS_LB);
        for (int i = tid; i < 1024; i += 512) { const float l0 = a.lb_logits[i], l1 = a.lb_logits[1024 + i]; lb[i] = 1.f / (1.f + __expf(l1 - l0)); }
    }
    LAS float* scr = (LAS float*)lds + wid * (64 * 33);
    const int gw = (G - 1 - bid) * 8 + wid, NGW = G * 8;
    constexpr int I_IN = (D / 64) * (NIN / 32), I_OUT = (D / 64) * (D / 32);
    for (int it = gw; it < I_IN + I_OUT; it += NGW) {
        if (it < I_IN) { const int nblk = NIN / 32, kb = it / nblk, nb = it % nblk; cvt_item(a.w_in, NIN, (bf16_t*)(a.ws + WS_WIN), D, kb * 64, nb * 32, nb * 32, scr, lane); }
        else { const int r = it - I_IN, nblk = D / 32, kb = r / nblk, nb = r % nblk; cvt_item(a.w_out, D, (bf16_t*)(a.ws + WS_WOUT), D, kb * 64, nb * 32, nb * 32, scr, lane); }
    }
}

__device__ __forceinline__ float modp_sum(const float* modp, int r, int col) { float s = 0.f;
#pragma unroll
    for (int ks = 0; ks < 8; ++ks) s += modp[((size_t)ks * 9 + r) * NMOD + col];
    return s; }
__device__ __forceinline__ void norm_row(const float* xrow, bf16_t* orow, const LAS float* gm, const LAS float* sh, int lane) {
    f32x4 v[4]; float ss = 0.f;
#pragma unroll
    for (int j = 0; j < 4; ++j) { v[j] = *((const f32x4*)xrow + lane + 64 * j); ss += (v[j].x * v[j].x + v[j].y * v[j].y) + (v[j].z * v[j].z + v[j].w * v[j].w); }
    const float rstd = rsqrtf(wave_sum(ss) * (1.f / D) + EPS);
#pragma unroll
    for (int j = 0; j < 4; ++j) { const f32x4 g4 = *((const LAS f32x4*)gm + lane + 64 * j), s4 = *((const LAS f32x4*)sh + lane + 64 * j); const f32x4 o = v[j] * rstd * g4 + s4;
        u32x2 w; w.x = cvt_pk_bf16(o.x, o.y); w.y = cvt_pk_bf16(o.z, o.w); *((u32x2*)orow + lane + 64 * j) = w; }
}
__device__ __forceinline__ void phase_norm(const Args& a, LAS uchar* lds, int bid, int G, int tid, int wid, int lane) {
    const float* modp = (const float*)(a.ws + WS_MODP); float* modf = (float*)(a.ws + WS_MODF);
    { const int gt = bid * 512 + tid; if (gt < 9 * NMOD) modf[gt] = modp_sum(modp, gt / NMOD, gt % NMOD); }
    LAS float* gm = (LAS float*)lds; LAS float* sh = gm + D; LAS float* cgm = sh + D; LAS float* csh = cgm + D;
    const int b = bid / 32;
    for (int cidx = tid; cidx < D; cidx += 512) { const float nm = a.norm_mix[cidx];
        sh[cidx] = modp_sum(modp, b, cidx); gm[cidx] = nm * (1.f + modp_sum(modp, b, D + cidx));
        csh[cidx] = modp_sum(modp, 8, cidx); cgm[cidx] = nm * (1.f + modp_sum(modp, 8, D + cidx)); }
    __syncthreads();
    bf16_t* hx = (bf16_t*)(a.ws + WS_ACT); bf16_t* hc = (bf16_t*)(a.ws + WS_HC);
    for (int j = 0; j < 16; ++j) { const int row = bid * 128 + wid * 16 + j; norm_row(a.x + (size_t)row * D, hx + (size_t)row * D, gm, sh, lane); }
    { const int row = bid * 8 + wid; norm_row(a.ctx + (size_t)row * D, hc + (size_t)row * D, cgm, csh, lane); }
    __syncthreads();
}

constexpr int GL_QDP = 0, GL_KIP = 8704, GL_KETP = 17408, GL_VTP = 27648, GL_DEC = 37888, GL_TOT = 38400;
template <bool FULL>
__device__ __forceinline__ void gla_item(LAS uchar* lds, const bf16_t* qb, const float* lfb, const bf16_t* vb, bf16_t* ob, const float* s_in, float* s_out,
                                         int row_base, int Tn, int h, int dir, int tid, int wid, int lane) {
    const int fr = lane & 15, fq = lane >> 4, nch = Tn / 32;
    f32x4 S[8];
    if (s_in) {
#pragma unroll
        for (int t8 = 0; t8 < 8; ++t8)
#pragma unroll
            for (int r = 0; r < 4; ++r) S[t8][r] = s_in[(size_t)(16 * t8 + 4 * fq + r) * 128 + 16 * wid + fr];
    } else {
#pragma unroll
        for (int t8 = 0; t8 < 8; ++t8) S[t8] = (f32x4){0.f, 0.f, 0.f, 0.f};
    }
    const int colq = h * 128 + 2 * lane;
    f32x2 lf[4]; unsigned qv[4], vv[4];
#define GLA_LOAD(n) do { _Pragma("unroll") for (int rr = 0; rr < 4; ++rr) { const int tau = 32 * (n) + 4 * wid + rr; const size_t row = (size_t)(row_base + (dir ? (Tn - 1 - tau) : tau)); \
        lf[rr] = *(const f32x2*)(lfb + row * 512 + colq); vv[rr] = *(const unsigned*)(vb + row * 512 + colq); if (FULL) qv[rr] = *(const unsigned*)(qb + row * 512 + colq); } } while (0)
    GLA_LOAD(0);
    const int d0 = 2 * lane, pos0 = (d0 & ~31) + 8 * ((d0 >> 2) & 3) + 4 * ((d0 >> 4) & 1) + (d0 & 3);
    const int spos = 8 * (wid & 3) + 4 * (wid >> 2);
    for (int n = 0; n < nch; ++n) {
        f32x2 c[4]; c[0] = lf[0]; c[1] = c[0] + lf[1]; c[2] = c[1] + lf[2]; c[3] = c[2] + lf[3];
        LAS f32x2* tot = (LAS f32x2*)(lds + GL_TOT);
        tot[wid * 64 + lane] = c[3];
        f32x2 lfc[4]; unsigned qc[4], vc[4];
#pragma unroll
        for (int rr = 0; rr < 4; ++rr) { lfc[rr] = lf[rr]; qc[rr] = qv[rr]; vc[rr] = vv[rr]; }
        __syncthreads();
        if (n + 1 < nch) GLA_LOAD(n + 1);
        f32x2 pre = (f32x2){0.f, 0.f}, all = (f32x2){0.f, 0.f};
#pragma unroll
        for (int w = 0; w < 8; ++w) { const f32x2 tw = tot[w * 64 + lane]; all += tw; if (w < wid) pre += tw; }
        unsigned ke0[4], ke1[4];
#pragma unroll
        for (int rr = 0; rr < 4; ++rr) {
            const f32x2 cum = pre + c[rr];
            const float k0 = 1.f - __expf(lfc[rr].x), k1 = 1.f - __expf(lfc[rr].y);
            const float ki0 = k0 * __expf(-cum.x), ki1 = k1 * __expf(-cum.y);
            const float kE0 = k0 * __expf(all.x - cum.x), kE1 = k1 * __expf(all.y - cum.y);
            const int s = 4 * wid + rr;
            if (FULL) { const float e0 = __expf(cum.x), e1 = __expf(cum.y);
                *(LAS unsigned*)(lds + GL_QDP + s * 272 + pos0 * 2) = cvt_pk_bf16(bf_lo(qc[rr]) * e0, bf_hi(qc[rr]) * e1);
                *(LAS unsigned*)(lds + GL_KIP + s * 272 + pos0 * 2) = cvt_pk_bf16(ki0, ki1); }
            ke0[rr] = __float_as_uint(kE0); ke1[rr] = __float_as_uint(kE1);
        }
        { u32x2 w0, w1; w0.x = cvt_pk_bf16(__uint_as_float(ke0[0]), __uint_as_float(ke0[1])); w0.y = cvt_pk_bf16(__uint_as_float(ke0[2]), __uint_as_float(ke0[3]));
          w1.x = cvt_pk_bf16(__uint_as_float(ke1[0]), __uint_as_float(ke1[1])); w1.y = cvt_pk_bf16(__uint_as_float(ke1[2]), __uint_as_float(ke1[3]));
          *(LAS u32x2*)(lds + GL_KETP + (d0) * 80 + spos * 2) = w0; *(LAS u32x2*)(lds + GL_KETP + (d0 + 1) * 80 + spos * 2) = w1;
          u32x2 v0, v1; v0.x = (vc[0] & 0xffffu) | (vc[1] << 16); v0.y = (vc[2] & 0xffffu) | (vc[3] << 16);
          v1.x = (vc[0] >> 16) | (vc[1] & 0xffff0000u); v1.y = (vc[2] >> 16) | (vc[3] & 0xffff0000u);
          *(LAS u32x2*)(lds + GL_VTP + (d0) * 80 + spos * 2) = v0; *(LAS u32x2*)(lds + GL_VTP + (d0 + 1) * 80 + spos * 2) = v1; }
        if (wid == 0) *(LAS f32x2*)(lds + GL_DEC + lane * 8) = (f32x2){__expf(all.x), __expf(all.y)};
        __syncthreads();
        const bf16x8 vt = *(const LAS bf16x8*)(lds + GL_VTP + (16 * wid + fr) * 80 + fq * 16);
        if (FULL) {
            bf16x8 qf[2][4];
#pragma unroll
            for (int ti = 0; ti < 2; ++ti)
#pragma unroll
                for (int kk = 0; kk < 4; ++kk) qf[ti][kk] = *(const LAS bf16x8*)(lds + GL_QDP + (16 * ti + fr) * 272 + kk * 64 + fq * 16);
            f32x4 oT[2] = {(f32x4){0.f, 0.f, 0.f, 0.f}, (f32x4){0.f, 0.f, 0.f, 0.f}};
            f32x4 p00 = (f32x4){0.f, 0.f, 0.f, 0.f}, p01 = p00, p11 = p00;
#pragma unroll
            for (int kk = 0; kk < 4; ++kk) {
                const bf16x8 kj0 = *(const LAS bf16x8*)(lds + GL_KIP + (fr) * 272 + kk * 64 + fq * 16);
                const bf16x8 kj1 = *(const LAS bf16x8*)(lds + GL_KIP + (16 + fr) * 272 + kk * 64 + fq * 16);
                p00 = __builtin_amdgcn_mfma_f32_16x16x32_bf16(kj0, qf[0][kk], p00, 0, 0, 0);
                p01 = __builtin_amdgcn_mfma_f32_16x16x32_bf16(kj0, qf[1][kk], p01, 0, 0, 0);
                p11 = __builtin_amdgcn_mfma_f32_16x16x32_bf16(kj1, qf[1][kk], p11, 0, 0, 0);
                u32x4 sa; sa.x = cvt_pk_bf16_safe(S[2 * kk][0], S[2 * kk][1]); sa.y = cvt_pk_bf16_safe(S[2 * kk][2], S[2 * kk][3]);
                sa.z = cvt_pk_bf16_safe(S[2 * kk + 1][0], S[2 * kk + 1][1]); sa.w = cvt_pk_bf16_safe(S[2 * kk + 1][2], S[2 * kk + 1][3]);
                const bf16x8 sA = __builtin_bit_cast(bf16x8, sa);
                oT[0] = __builtin_amdgcn_mfma_f32_16x16x32_bf16(sA, qf[0][kk], oT[0], 0, 0, 0);
                oT[1] = __builtin_amdgcn_mfma_f32_16x16x32_bf16(sA, qf[1][kk], oT[1], 0, 0, 0);
            }
            u32x4 pb0, pb1;
            { float m0[4], m1[4];
#pragma unroll
              for (int r = 0; r < 4; ++r) { const bool ok = (4 * fq + r) <= fr; m0[r] = ok ? p00[r] : 0.f; m1[r] = ok ? p11[r] : 0.f; }
              pb0.x = cvt_pk_bf16_safe(m0[0], m0[1]); pb0.y = cvt_pk_bf16_safe(m0[2], m0[3]); pb0.z = 0u; pb0.w = 0u;
              pb1.x = cvt_pk_bf16_safe(p01[0], p01[1]); pb1.y = cvt_pk_bf16_safe(p01[2], p01[3]); pb1.z = cvt_pk_bf16_safe(m1[0], m1[1]); pb1.w = cvt_pk_bf16_safe(m1[2], m1[3]); }
            oT[0] = __builtin_amdgcn_mfma_f32_16x16x32_bf16(vt, __builtin_bit_cast(bf16x8, pb0), oT[0], 0, 0, 0);
            oT[1] = __builtin_amdgcn_mfma_f32_16x16x32_bf16(vt, __builtin_bit_cast(bf16x8, pb1), oT[1], 0, 0, 0);
#pragma unroll
            for (int ti = 0; ti < 2; ++ti) { const int tau = 32 * n + 16 * ti + fr; const size_t row = (size_t)(row_base + (dir ? (Tn - 1 - tau) : tau));
                u32x2 w; w.x = cvt_pk_bf16_safe(oT[ti][0], oT[ti][1]); w.y = cvt_pk_bf16_safe(oT[ti][2], oT[ti][3]);
                *(u32x2*)(ob + row * 512 + h * 128 + 16 * wid + 4 * fq) = w; }
        }
#pragma unroll
        for (int t8 = 0; t8 < 8; ++t8) {
            const f32x4 dc = *(const LAS f32x4*)(lds + GL_DEC + (16 * t8 + 4 * fq) * 4);
            const bf16x8 ka = *(const LAS bf16x8*)(lds + GL_KETP + (16 * t8 + fr) * 80 + fq * 16);
            S[t8] = __builtin_amdgcn_mfma_f32_16x16x32_bf16(ka, vt, S[t8] * dc, 0, 0, 0);
        }
    }
#undef GLA_LOAD
    if (s_out) {
#pragma unroll
        for (int t8 = 0; t8 < 8; ++t8)
#pragma unroll
            for (int r = 0; r < 4; ++r) s_out[(size_t)(16 * t8 + 4 * fq + r) * 128 + 16 * wid + fr] = S[t8][r];
    }
    __syncthreads();
}

__device__ __forceinline__ void unpack8(const u32x4 w, float (&f)[8]) { f[0] = bf_lo(w.x); f[1] = bf_hi(w.x); f[2] = bf_lo(w.y); f[3] = bf_hi(w.y); f[4] = bf_lo(w.z); f[5] = bf_hi(w.z); f[6] = bf_lo(w.w); f[7] = bf_hi(w.w); }
__device__ __forceinline__ void phase_mixfin(const Args& a, int bid, int G, int wid, int lane) {
    const bf16_t* of = (const bf16_t*)(a.ws + WS_OF); const bf16_t* obw = (const bf16_t*)(a.ws + WS_OB); const bf16_t* zg = (const bf16_t*)(a.ws + WS_ZG);
    const bf16_t* zgb = (const bf16_t*)(a.ws + WS_ZGB); const bf16_t* zgc = (const bf16_t*)(a.ws + WS_ZGC); const bf16_t* zv = (const bf16_t*)(a.ws + WS_ZV);
    bf16_t* A2 = (bf16_t*)(a.ws + WS_ACT);
    const int c0 = 8 * lane;
    float gain[8], cw0[8], cw1[8], cw2[8];
#pragma unroll
    for (int j = 0; j < 8; ++j) { gain[j] = a.hg_norm[(c0 + j) & 127]; cw0[j] = a.conv_w[c0 + j]; cw1[j] = a.conv_w[512 + c0 + j]; cw2[j] = a.conv_w[1024 + c0 + j]; }
    for (int row = bid * 8 + wid; row < M; row += G * 8) {
        const size_t ro = (size_t)row * 512 + c0;
        float f0[8], f1[8], gg[8], o[8];
        unpack8(*(const u32x4*)(of + ro), f0); unpack8(*(const u32x4*)(obw + ro), f1); unpack8(*(const u32x4*)(zg + ro), gg);
        float ss = 0.f;
#pragma unroll
        for (int j = 0; j < 8; ++j) { o[j] = f0[j] + f1[j]; ss += o[j] * o[j]; }
        ss += __shfl_xor(ss, 1); ss += __shfl_xor(ss, 2); ss += __shfl_xor(ss, 4); ss += __shfl_xor(ss, 8);
        const float rstd = rsqrtf(ss * (1.f / 128.f) + EPS);
#pragma unroll
        for (int j = 0; j < 8; ++j) o[j] = o[j] * rstd * gain[j] * silu_f(gg[j]);
        u32x4 w; w.x = cvt_pk_bf16(o[0], o[1]); w.y = cvt_pk_bf16(o[2], o[3]); w.z = cvt_pk_bf16(o[4], o[5]); w.w = cvt_pk_bf16(o[6], o[7]);
        *(u32x4*)(A2 + (size_t)row * D + c0) = w;
        const int tw = row & 63;
        float gcm[8], vm[8], gc0[8], v0[8], gcp[8], vp[8], gb[8], y[8];
        unpack8(*(const u32x4*)(zgc + ro), gc0); unpack8(*(const u32x4*)(zv + ro), v0); unpack8(*(const u32x4*)(zgb + ro), gb);
        if (tw > 0) { unpack8(*(const u32x4*)(zgc + ro - 512), gcm); unpack8(*(const u32x4*)(zv + ro - 512), vm); }
        else {
#pragma unroll
            for (int j = 0; j < 8; ++j) { gcm[j] = 0.f; vm[j] = 0.f; } }
        if (tw < 63) { unpack8(*(const u32x4*)(zgc + ro + 512), gcp); unpack8(*(const u32x4*)(zv + ro + 512), vp); }
        else {
#pragma unroll
            for (int j = 0; j < 8; ++j) { gcp[j] = 0.f; vp[j] = 0.f; } }
#pragma unroll
        for (int j = 0; j < 8; ++j) y[j] = gb[j] * (cw0[j] * (gcm[j] * vm[j]) + cw1[j] * (gc0[j] * v0[j]) + cw2[j] * (gcp[j] * vp[j]));
        w.x = cvt_pk_bf16(y[0], y[1]); w.y = cvt_pk_bf16(y[2], y[3]); w.z = cvt_pk_bf16(y[4], y[5]); w.w = cvt_pk_bf16(y[6], y[7]);
        *(u32x4*)(A2 + (size_t)row * D + 512 + c0) = w;
    }
}

__device__ __forceinline__ void phase_router(const Args& a, LAS uchar* lds, int bid, int tid, int wid, int lane) {
    const float* modf = (const float*)(a.ws + WS_MODF);
    LAS float* gm = (LAS float*)lds; LAS float* sh = gm + D;
    LAS uchar* wrl = lds + 8192;
    const int b = bid / 32;
    for (int cidx = tid; cidx < D; cidx += 512) { sh[cidx] = modf[(size_t)b * NMOD + 3 * D + cidx]; gm[cidx] = a.norm_ffn[cidx] * (1.f + modf[(size_t)b * NMOD + 4 * D + cidx]); }
    for (int i = tid; i < D * 4; i += 512) { const int col = i >> 2, q4 = i & 3; *(LAS f32x4*)(wrl + col * 64 + (col >> 2) * 16 + q4 * 16) = *(const f32x4*)(a.w_router + col * 16 + q4 * 4); }
    __syncthreads();
    bf16_t* hx2 = (bf16_t*)(a.ws + WS_ACT); float* aff = (float*)(a.ws + WS_AFF);
    for (int j = 0; j < 16; ++j) {
        const int row = bid * 128 + wid * 16 + j; const float* xrow = a.out + (size_t)row * D;
        f32x4 v[4]; float ss = 0.f;
#pragma unroll
        for (int jj = 0; jj < 4; ++jj) { v[jj] = *((const f32x4*)xrow + lane + 64 * jj); ss += (v[jj].x * v[jj].x + v[jj].y * v[jj].y) + (v[jj].z * v[jj].z + v[jj].w * v[jj].w); }
        const float rstd = rsqrtf(wave_sum(ss) * (1.f / D) + EPS);
        float pl[16];
#pragma unroll
        for (int e = 0; e < 16; ++e) pl[e] = 0.f;
#pragma unroll
        for (int jj = 0; jj < 4; ++jj) { const f32x4 g4 = *((const LAS f32x4*)gm + lane + 64 * jj), s4 = *((const LAS f32x4*)sh + lane + 64 * jj); const f32x4 hv = v[jj] * rstd * g4 + s4;
            u32x2 w; w.x = cvt_pk_bf16(hv.x, hv.y); w.y = cvt_pk_bf16(hv.z, hv.w); *((u32x2*)(hx2 + (size_t)row * D) + lane + 64 * jj) = w;
            const int colb = 4 * lane + 256 * jj;
#pragma unroll
            for (int cc = 0; cc < 4; ++cc) { const int col = colb + cc; const LAS uchar* wp = wrl + col * 64 + (col >> 2) * 16; const float hvv = hv[cc];
#pragma unroll
                for (int q4 = 0; q4 < 4; ++q4) { const f32x4 w4 = *(const LAS f32x4*)(wp + q4 * 16); pl[q4 * 4 + 0] += hvv * w4.x; pl[q4 * 4 + 1] += hvv * w4.y; pl[q4 * 4 + 2] += hvv * w4.z; pl[q4 * 4 + 3] += hvv * w4.w; } } }
#pragma unroll
        for (int e = 0; e < 16; ++e) pl[e] = wave_sum(pl[e]);
        float mx = pl[0];
#pragma unroll
        for (int e = 1; e < 16; ++e) mx = fmaxf(mx, pl[e]);
        float den = 0.f;
#pragma unroll
        for (int e = 0; e < 16; ++e) { pl[e] = __expf(pl[e] - mx); den += pl[e]; }
        const float inv = 1.f / den; float mine = 0.f;
#pragma unroll
        for (int e = 0; e < 16; ++e) mine = (lane == e) ? pl[e] * inv : mine;
        const int t = row & (T - 1);
        if (lane < 16) aff[((size_t)b * NE + lane) * T + t] = mine;
    }
    __syncthreads();
}

__device__ __forceinline__ void topk_item(const Args& a, LAS uchar* lds, int b, int e, int tid, int wid, int lane) {
    LAS unsigned* key = (LAS unsigned*)lds;
    LAS unsigned* hist = key + 4096;
    LAS unsigned* ctl = hist + 256;
    LAS unsigned* wsum = ctl + 8;
    const float* affp = (const float*)(a.ws + WS_AFF) + ((size_t)b * NE + e) * T;
    unsigned kv[8];
    { const u32x4 k0 = *(const u32x4*)(affp + tid * 8), k1 = *(const u32x4*)(affp + tid * 8 + 4); kv[0] = k0.x; kv[1] = k0.y; kv[2] = k0.z; kv[3] = k0.w; kv[4] = k1.x; kv[5] = k1.y; kv[6] = k1.z; kv[7] = k1.w; }
    unsigned prefix = 0u, mask = 0u, need = CAP;
    for (int shift = 24; shift >= 0; shift -= 8) {
        if (tid < 256) hist[tid] = 0u;
        __syncthreads();
#pragma unroll
        for (int j = 0; j < 8; ++j) if ((kv[j] & mask) == prefix) __hip_atomic_fetch_add(&hist[(kv[j] >> shift) & 255u], 1u, __ATOMIC_RELAXED, __HIP_MEMORY_SCOPE_WORKGROUP);
        __syncthreads();
        if (tid < 256) { unsigned above = 0u; for (int bb = tid + 1; bb < 256; ++bb) above += hist[bb]; const unsigned mine = hist[tid];
            if (above < need && need <= above + mine) { ctl[0] = (unsigned)tid; ctl[1] = need - above; } }
        __syncthreads();
        prefix |= ctl[0] << shift; mask |= 255u << shift; need = ctl[1];
        __syncthreads();
    }
    unsigned cg_ = 0u, ce_ = 0u;
#pragma unroll
    for (int j = 0; j < 8; ++j) { cg_ += kv[j] > prefix; ce_ += kv[j] == prefix; }
    unsigned pk = cg_ | (ce_ << 16), incl = pk;
#pragma unroll
    for (int o = 1; o < 64; o <<= 1) { const unsigned t2 = __shfl_up(incl, o); if (lane >= o) incl += t2; }
    if (lane == 63) wsum[wid] = incl;
    __syncthreads();
    unsigned base = 0u;
    for (int w = 0; w < wid; ++w) base += wsum[w];
    unsigned excl = base + incl - pk; unsigned ng = excl & 0xffffu, neq = excl >> 16;
    int* seltok = (int*)(a.ws + WS_SELTOK); float* selgate = (float*)(a.ws + WS_SELGATE); short* pos = (short*)(a.ws + WS_POS);
#pragma unroll
    for (int j = 0; j < 8; ++j) { const int t = tid * 8 + j; const bool gt = kv[j] > prefix, eq = kv[j] == prefix; const bool sel = gt || (eq && neq < need);
        int slot = -1;
        if (sel) slot = (int)(ng + (neq < need ? neq : need));
        if (sel) { seltok[e * 4096 + b * 512 + slot] = b * T + t; selgate[e * 4096 + b * 512 + slot] = __uint_as_float(kv[j]); }
        pos[((size_t)b * T + t) * 16 + e] = (short)slot;
        ng += gt; neq += eq; }
    __syncthreads();
}
__device__ __forceinline__ void phase_topk_cvt(const Args& a, LAS uchar* lds, int bid, int G, int tid, int wid, int lane) {
    if (bid < 128) topk_item(a, lds, bid / 16, bid % 16, tid, wid, lane);
    LAS float* scr = (LAS float*)(lds + 32768) + wid * (64 * 33);
    bf16_t* wgu = (bf16_t*)(a.ws + WS_WGU); bf16_t* wdn = (bf16_t*)(a.ws + WS_WDN);
    constexpr int I_G = (D / 64) * (DFF / 32);
    constexpr int I_D = (DFF / 64) * (D / 32);
    constexpr int PER_E = 2 * I_G + I_D, TOTAL = NE * PER_E;
    const int gw = (G - 1 - bid) * 8 + wid, NGW = G * 8;
    for (int it = gw; it < TOTAL; it += NGW) {
        const int e = it / PER_E; int r = it % PER_E;
        if (r < 2 * I_G) { const int up = r >= I_G; if (up) r -= I_G; const int nblk = DFF / 32, kb = r / nblk, nb = r % nblk, n0 = nb * 32;
            const float* W = (up ? a.w_up : a.w_gate) + (size_t)e * D * DFF;
            cvt_item(W, DFF, wgu + (size_t)e * 4096 * D, D, kb * 64, n0, (n0 >> 7) * 256 + (n0 & 127) + (up ? 128 : 0), scr, lane); }
        else { r -= 2 * I_G; const int nblk = D / 32, kb = r / nblk, nb = r % nblk;
            cvt_item(a.w_down + (size_t)e * DFF * D, D, wdn + (size_t)e * D * DFF, DFF, kb * 64, nb * 32, nb * 32, scr, lane); }
    }
    __syncthreads();
}

__device__ __forceinline__ void phase_final(const Args& a, int bid, int G, int wid, int lane) {
    const float* modf = (const float*)(a.ws + WS_MODF); const short* pos = (const short*)(a.ws + WS_POS); const bf16_t* ys = (const bf16_t*)(a.ws + WS_YS);
    for (int row = bid * 8 + wid; row < M; row += G * 8) {
        const int b = row / T; float* xrow = a.out + (size_t)row * D;
        f32x4 v[4], acc[4];
#pragma unroll
        for (int jj = 0; jj < 4; ++jj) { v[jj] = *((const f32x4*)xrow + lane + 64 * jj); acc[jj] = (f32x4){0.f, 0.f, 0.f, 0.f}; }
        const u32x4 p0 = *(const u32x4*)(pos + (size_t)row * 16), p1 = *(const u32x4*)(pos + (size_t)row * 16 + 8);
        const unsigned pw[8] = {p0.x, p0.y, p0.z, p0.w, p1.x, p1.y, p1.z, p1.w};
#pragma unroll
        for (int e = 0; e < 16; ++e) { const int sl = (int)(short)((e & 1) ? (pw[e >> 1] >> 16) : (pw[e >> 1] & 0xffffu));
            if (sl >= 0) { const bf16_t* yr = ys + ((size_t)e * 4096 + b * 512 + sl) * D;
#pragma unroll
                for (int jj = 0; jj < 4; ++jj) { const u32x2 w = *((const u32x2*)yr + lane + 64 * jj); acc[jj].x += bf_lo(w.x); acc[jj].y += bf_hi(w.x); acc[jj].z += bf_lo(w.y); acc[jj].w += bf_hi(w.y); } } }
        float ss = 0.f;
#pragma unroll
        for (int jj = 0; jj < 4; ++jj) { const f32x4 g2 = *((const f32x4*)(modf + (size_t)b * NMOD + 5 * D) + lane + 64 * jj); v[jj] = v[jj] + g2 * acc[jj];
            ss += (v[jj].x * v[jj].x + v[jj].y * v[jj].y) + (v[jj].z * v[jj].z + v[jj].w * v[jj].w); }
        const float rstd = rsqrtf(wave_sum(ss) * (1.f / D) + EPS);
#pragma unroll
        for (int jj = 0; jj < 4; ++jj) { const f32x4 nf = *((const f32x4*)a.norm_final + lane + 64 * jj); *((f32x4*)xrow + lane + 64 * jj) = v[jj] * rstd * nf; }
    }
}

__global__ void __launch_bounds__(512, 2) mega_fwd(Args a) {
    extern __shared__ __attribute__((aligned(16))) uchar lds_raw[];
    LAS uchar* lds = (LAS uchar*)lds_raw;
    cg::grid_group grid = cg::this_grid();
    const int tid = threadIdx.x, lane = tid & 63, wid = __builtin_amdgcn_readfirstlane(tid >> 6), bid = blockIdx.x, G = gridDim.x;
    const int lo = a.ph_lo, hi = a.ph_hi;
    uchar* ws = a.ws;
#define IN(k) (lo <= (k) && (k) < hi)
#define GSYNC() do { asm volatile("s_waitcnt vmcnt(0)" ::: "memory"); __syncthreads(); \
    if (threadIdx.x == 0) { __builtin_amdgcn_fence(__ATOMIC_RELEASE, "agent"); asm volatile("s_waitcnt vmcnt(0)" ::: "memory"); } \
    grid.sync(); __builtin_amdgcn_fence(__ATOMIC_ACQUIRE, "agent"); asm volatile("s_waitcnt vmcnt(0)" ::: "memory"); __syncthreads(); } while (0)
#define SEAM(k) do { if (IN(k) && IN((k) + 1)) { if ((k) == 0) { GSYNC(); xbar = xcd_barrier_post((unsigned*)(ws + WS_BAR), (volatile LAS unsigned*)(lds + 131072)); } else xcd_barrier(xbar); } } while (0)
    XcdBarrier xbar; xbar.bar = (unsigned*)(ws + WS_BAR); xbar.x = 0; xbar.st = (volatile LAS unsigned*)(lds + 131072);
    if (tid < 2) ((volatile LAS unsigned*)(lds + 131072))[tid] = 0u;
    if (bid == 0) { for (int i = tid; i < XCD_BAR_WORDS; i += 512) ((unsigned*)(ws + WS_BAR))[i] = 0u; }
    __syncthreads();
    if (IN(0)) phase_prep(a, lds, bid, G, tid, wid, lane);
    SEAM(0);
    if (IN(1)) phase_norm(a, lds, bid, G, tid, wid, lane);
    SEAM(1);
    if (IN(2)) {
        {
            pg8::Gemm g{(const bf16_t*)(ws + WS_HC), (const bf16_t*)(ws + WS_WIN) + (size_t)512 * D, D, 0, nullptr};
            pg8::GroupOrder S; S.init(MC / 256, 1536 / 256, 1, G, bid);
            pg8::EpiInproj E{nullptr, (bf16_t*)(ws + WS_CI), (float*)(ws + WS_CLF), (float*)(ws + WS_CLB), (const float*)(ws + WS_LB), 1};
            pg8::gemm_phase<pg8::EpiInproj, false>(lds, g, S, E);
        }
        {
            pg8::Gemm g{(const bf16_t*)(ws + WS_ACT), (const bf16_t*)(ws + WS_WIN), D, 0, nullptr};
            pg8::GroupOrder S; S.init(M / 256, NIN / 256, 1, G, bid);
            pg8::EpiInproj E{ws + WS_ZQ, nullptr, (float*)(ws + WS_LF), (float*)(ws + WS_LBW), (const float*)(ws + WS_LB), 0};
            pg8::gemm_phase<pg8::EpiInproj, false>(lds, g, S, E);
        }
    }
    SEAM(2);
    if (IN(3)) {
        if (bid < 64) { const int b = bid >> 3, h = (bid >> 1) & 3, dir = bid & 1;
            gla_item<false>(lds, nullptr, (const float*)(ws + (dir ? WS_CLB : WS_CLF)), (const bf16_t*)(ws + WS_CI), nullptr, nullptr,
                            (float*)(ws + WS_S0) + (size_t)bid * 16384, b * CT, CT, h, dir, tid, wid, lane); }
    }
    SEAM(3);
    if (IN(4)) {
        if (bid < 64) { const int b = bid >> 3, h = (bid >> 1) & 3, dir = bid & 1;
            gla_item<true>(lds, (const bf16_t*)(ws + WS_ZQ), (const float*)(ws + (dir ? WS_LBW : WS_LF)), (const bf16_t*)(ws + WS_ZI), (bf16_t*)(ws + (dir ? WS_OB : WS_OF)),
                           (const float*)(ws + WS_S0) + (size_t)bid * 16384, nullptr, b * T, T, h, dir, tid, wid, lane); }
    }
    SEAM(4);
    if (IN(5)) phase_mixfin(a, bid, G, wid, lane);
    SEAM(5);
    if (IN(6)) {
        pg8::Gemm g{(const bf16_t*)(ws + WS_ACT), (const bf16_t*)(ws + WS_WOUT), D, 0, nullptr};
        pg8::GroupOrder S; S.init(M / 256, D / 256, 1, G, bid);
        pg8::EpiOut E{a.x, a.out, (const float*)(ws + WS_MODF)};
        pg8::gemm_phase<pg8::EpiOut, false>(lds, g, S, E);
    }
    SEAM(6);
    if (IN(7)) phase_router(a, lds, bid, tid, wid, lane);
    SEAM(7);
    if (IN(8)) phase_topk_cvt(a, lds, bid, G, tid, wid, lane);
    SEAM(8);
    if (IN(9)) {
        pg8::Gemm g{(const bf16_t*)(ws + WS_ACT), (const bf16_t*)(ws + WS_WGU), D, (size_t)4096 * D * 2, (const int*)(ws + WS_SELTOK)};
        pg8::GroupOrder S; S.init(16, 16, NE, G, bid);
        pg8::EpiMoe1 E{(bf16_t*)(ws + WS_HID)};
        pg8::gemm_phase<pg8::EpiMoe1, true>(lds, g, S, E);
    }
    SEAM(9);
    if (IN(10)) {
        pg8::Gemm g{(const bf16_t*)(ws + WS_HID), (const bf16_t*)(ws + WS_WDN), DFF, (size_t)D * DFF * 2, nullptr};
        pg8::GroupOrder S; S.init(16, 4, NE, G, bid);
        pg8::EpiMoe2 E{(bf16_t*)(ws + WS_YS), (const float*)(ws + WS_SELGATE)};
        pg8::gemm_phase<pg8::EpiMoe2, false>(lds, g, S, E);
    }
    SEAM(10);
    if (IN(11)) phase_final(a, bid, G, wid, lane);

#ifdef DBG_DUMP
    GSYNC();
    {
        for (size_t i = (size_t)bid * 512 + tid; i < (size_t)M * D; i += (size_t)G * 512) { const size_t row = i / D; const int c = (int)(i % D); float v = 0.f;
            if (DBG_DUMP == 1) v = bf_lo(((const bf16_t*)(ws + WS_ACT))[i]);
            if (DBG_DUMP == 2) v = bf_lo(((const bf16_t*)(ws + (c < 512 ? WS_ZQ : WS_ZI)))[row * 512 + (c & 511)]);
            if (DBG_DUMP == 3) v = ((const float*)(ws + (c < 512 ? WS_LF : WS_LBW)))[row * 512 + (c & 511)];
            if (DBG_DUMP == 4) v = bf_lo(((const bf16_t*)(ws + (c < 512 ? WS_OF : WS_OB)))[row * 512 + (c & 511)]);
            if (DBG_DUMP == 5) v = bf_lo(((const bf16_t*)(ws + (c < 512 ? WS_ZG : WS_ZV)))[row * 512 + (c & 511)]);
            if (DBG_DUMP == 6) v = ((const float*)(ws + WS_S0))[i % (64 * 16384)];
            if (DBG_DUMP == 7) v = ((const float*)(ws + WS_MODF))[i % (9 * NMOD)];
            a.out[i] = v; }
    }
#endif
#undef IN
#undef SEAM
}

#ifndef N_LAUNCHES
#define N_LAUNCHES 1
#endif
extern "C" void kernel_launch(void* const* d_in, const int* in_sizes, int n_in, void* d_out, int out_size, void* d_ws, size_t ws_size, hipStream_t stream) {
    static int grid = 0;
    if (grid == 0) {
        if (n_in != 18 || out_size != M * D || ws_size < WS_END) { fprintf(stderr, "kernel_launch: unexpected shapes (n_in %d out %d ws %zu)\n", n_in, out_size, ws_size); grid = -1; return; }
        int dev = 0, cus = 0, per_cu = 0;
        (void)hipGetDevice(&dev); (void)hipDeviceGetAttribute(&cus, hipDeviceAttributeMultiprocessorCount, dev);
        (void)hipFuncSetAttribute((const void*)mega_fwd, hipFuncAttributeMaxDynamicSharedMemorySize, LDS_BYTES);
        (void)hipOccupancyMaxActiveBlocksPerMultiprocessor(&per_cu, (const void*)mega_fwd, 512, LDS_BYTES);
        if (per_cu < 1) { fprintf(stderr, "kernel_launch: occupancy query says %d blocks per CU\n", per_cu); grid = -1; return; }
        grid = 256;
        if (cus != 256) fprintf(stderr, "kernel_launch: note: %d CUs (built for 256)\n", cus);
    }
    if (grid < 0) return;
    Args a{};
    a.x = (const float*)d_in[0]; a.c = (const float*)d_in[1]; a.ctx = (const float*)d_in[2]; a.c_ctx = (const float*)d_in[3]; a.w_ada = (const float*)d_in[4]; a.b_ada = (const float*)d_in[5];
    a.norm_mix = (const float*)d_in[6]; a.norm_ffn = (const float*)d_in[7]; a.w_in = (const float*)d_in[8]; a.lb_logits = (const float*)d_in[9]; a.hg_norm = (const float*)d_in[10];
    a.conv_w = (const float*)d_in[11]; a.w_out = (const float*)d_in[12]; a.w_router = (const float*)d_in[13]; a.w_gate = (const float*)d_in[14]; a.w_up = (const float*)d_in[15];
    a.w_down = (const float*)d_in[16]; a.norm_final = (const float*)d_in[17]; a.out = (float*)d_out; a.ws = (uchar*)d_ws;
    if (N_LAUNCHES == 1) {
#ifndef DBG_HI
#define DBG_HI NPHASE
#endif
        a.ph_lo = 0; a.ph_hi = DBG_HI; void* args[] = {&a};
        hipError_t e = hipLaunchCooperativeKernel((const void*)mega_fwd, dim3(grid), dim3(512), args, LDS_BYTES, stream);
        if (e != hipSuccess) fprintf(stderr, "cooperative launch failed: %s\n", hipGetErrorString(e));
    } else {
        for (int p = 0; p < NPHASE; ++p) { a.ph_lo = p; a.ph_hi = p + 1; void* args[] = {&a};
            hipError_t e = hipLaunchCooperativeKernel((const void*)mega_fwd, dim3(grid), dim3(512), args, LDS_BYTES, stream);
            if (e != hipSuccess) { fprintf(stderr, "launch %d failed: %s\n", p, hipGetErrorString(e)); break; } }
    }
}
```

```cpp
#include <hip/hip_runtime.h>
#include <hip/hip_cooperative_groups.h>
#include <cstdio>
namespace cg = cooperative_groups;

#define LAS __attribute__((address_space(3)))
#define GAS __attribute__((address_space(1)))
typedef unsigned short bf16_t;
typedef short bf16x8 __attribute__((ext_vector_type(8)));
typedef float f32x4 __attribute__((ext_vector_type(4)));
typedef float f32x2 __attribute__((ext_vector_type(2)));
typedef unsigned u32x4 __attribute__((ext_vector_type(4)));
typedef unsigned u32x2 __attribute__((ext_vector_type(2)));
typedef unsigned char uchar;

constexpr int D = 1024, NB = 8, T = 4096, M = NB * T, CT = 256, MC = NB * CT;
constexpr int NIN = 4096, HK = 512, NH = 4, NE = 16, CAP = 512, DFF = 2048, NMOD = 6 * D;
constexpr float EPS = 1e-6f;
constexpr int NPHASE = 12;

constexpr size_t MiB = 1u << 20;
constexpr size_t WS_ACT = 0;
constexpr size_t WS_WIN = 64 * MiB;
constexpr size_t WS_WOUT = 72 * MiB;
constexpr size_t WS_MODP = 74 * MiB;
constexpr size_t WS_MODF = 76 * MiB;
constexpr size_t WS_LB = 76 * MiB + 512 * 1024;
constexpr size_t WS_HC = 77 * MiB;
constexpr size_t WS_CLF = 81 * MiB;
constexpr size_t WS_CLB = 85 * MiB;
constexpr size_t WS_CI = 89 * MiB;
constexpr size_t WS_S0 = 91 * MiB;
constexpr size_t WS_AFF = 95 * MiB;
constexpr size_t WS_SELTOK = 97 * MiB;
constexpr size_t WS_SELGATE = 97 * MiB + 256 * 1024;
constexpr size_t WS_POS = 98 * MiB;
constexpr size_t WS_BAR = 100 * MiB;
constexpr size_t WS_SL = 488 * MiB;
constexpr size_t WS_DL = 500 * MiB;
constexpr size_t WS_ZQ = 104 * MiB;
constexpr size_t WS_LF = 136 * MiB;
constexpr size_t WS_LBW = 200 * MiB;
constexpr size_t WS_ZI = 264 * MiB;
constexpr size_t WS_ZG = 296 * MiB;
constexpr size_t WS_ZGB = 328 * MiB;
constexpr size_t WS_ZGC = 360 * MiB;
constexpr size_t WS_ZV = 392 * MiB;
constexpr size_t WS_OF = 424 * MiB;
constexpr size_t WS_OB = 456 * MiB;
constexpr size_t WS_WGU = 104 * MiB;
constexpr size_t WS_WDN = 232 * MiB;
constexpr size_t WS_HID = 296 * MiB;
constexpr size_t WS_YS = WS_WGU;
constexpr size_t WS_END = 552 * MiB;
static_assert(WS_ZI == WS_ZQ + 160 * MiB && WS_ZG == WS_ZI + 32 * MiB && WS_ZGB == WS_ZG + 32 * MiB && WS_ZGC == WS_ZGB + 32 * MiB && WS_ZV == WS_ZGC + 32 * MiB, "z segment map");

constexpr int LDS_BYTES = 147456;

typedef __bf16 bf16x2_t __attribute__((ext_vector_type(2)));
__device__ __forceinline__ unsigned cvt_pk_bf16_safe(float lo, float hi) { typedef float f2_t __attribute__((ext_vector_type(2))); const bf16x2_t v = __builtin_convertvector((f2_t){lo, hi}, bf16x2_t); return __builtin_bit_cast(unsigned, v); }
__device__ __forceinline__ unsigned cvt_pk_bf16(float lo, float hi) { unsigned r; asm volatile("v_cvt_pk_bf16_f32 %0, %1, %2" : "=v"(r) : "v"(lo), "v"(hi)); return r; }
__device__ __forceinline__ float bf_lo(unsigned u) { return __uint_as_float(u << 16); }
__device__ __forceinline__ float bf_hi(unsigned u) { return __uint_as_float(u & 0xffff0000u); }
__device__ __forceinline__ float wave_sum(float v) {
#pragma unroll
    for (int o = 1; o < 64; o <<= 1) v += __shfl_xor(v, o);
    return v;
}
__device__ __forceinline__ float silu_f(float x) { return x / (1.f + __expf(-x)); }
#define LDS_WAIT() asm volatile("s_waitcnt lgkmcnt(0)" ::: "memory")


#define XB_TMO      128
#define XB_XCNT(j)  (256  + 64 * (j))
#define XB_XSUB(j)  (1280 + 64 * (j))
#define XB_XGEN(j)  (2304 + 64 * (j))
#define XB_TOP      3328
#define XB_TOPGEN   3392
#define XCD_BAR_WORDS 3456
#define XB_SPIN_CAP (1u << 20)
__device__ __forceinline__ unsigned xb_ld(unsigned* p)              { return __hip_atomic_load(p, __ATOMIC_RELAXED, __HIP_MEMORY_SCOPE_AGENT); }
__device__ __forceinline__ unsigned xb_add(unsigned* p, unsigned v) { return __hip_atomic_fetch_add(p, v, __ATOMIC_RELAXED, __HIP_MEMORY_SCOPE_AGENT); }
__device__ __forceinline__ unsigned xb_xcc_id() { return (unsigned)__builtin_amdgcn_s_getreg((3 << 11) | 20) & 0xFu; }
#define XB_SPIN(cond, bar) do { unsigned _sp = 0; while (cond) { __builtin_amdgcn_s_sleep(1); \
    if ((++_sp & 255u) == 0u) { if (xb_ld(&(bar)[XB_TMO])) break; if (_sp > XB_SPIN_CAP) { atomicAdd(&(bar)[XB_TMO], 1u); break; } } } } while (0)
struct XcdBarrier { unsigned* bar; unsigned x; volatile LAS unsigned* st; };
__device__ __forceinline__ XcdBarrier xcd_barrier_post(unsigned* bar, volatile LAS unsigned* st) {
    XcdBarrier b; b.bar = bar; b.x = xb_xcc_id(); b.st = st;
    if (threadIdx.x == 0) (void)xb_add(&bar[XB_XCNT(b.x)], 1u);
    return b;
}
__device__ __forceinline__ void xcd_barrier_complete(unsigned* bar, unsigned x, unsigned& nloc, unsigned& nx) {
    const unsigned G = gridDim.x * gridDim.y * gridDim.z;
    unsigned sum, cnt, mine, sp = 0u;
    for (;;) {
        sum = 0u; cnt = 0u; mine = 0u;
#pragma unroll
        for (unsigned j = 0; j < 16; ++j) { const unsigned c = xb_ld(&bar[XB_XCNT(j)]); sum += c; cnt += (c > 0u) ? 1u : 0u; mine = (j == x) ? c : mine; }
        if (sum == G) break;
        __builtin_amdgcn_s_sleep(1);
        if ((++sp & 255u) == 0u) { if (xb_ld(&bar[XB_TMO])) break; if (sp > XB_SPIN_CAP) { atomicAdd(&bar[XB_TMO], 1u); break; } }
    }
    nloc = mine > 0u ? mine : 1u; nx = cnt > 0u ? cnt : 1u;
}
__device__ __forceinline__ void xcd_barrier(const XcdBarrier& b) {
    asm volatile("s_waitcnt vmcnt(0)" ::: "memory");
    __syncthreads();
    if (threadIdx.x == 0) {
        unsigned* bar = b.bar;
        __builtin_amdgcn_s_waitcnt(0);
        unsigned nloc = b.st[0], nx = b.st[1];
        if (nloc == 0u) { xcd_barrier_complete(bar, b.x, nloc, nx); b.st[0] = nloc; b.st[1] = nx; }
        const unsigned old = xb_add(&bar[XB_XSUB(b.x)], 1u);
        const unsigned gen = old / nloc;
        if (old + 1u == (gen + 1u) * nloc) {
            __builtin_amdgcn_fence(__ATOMIC_RELEASE, "agent");
            asm volatile("s_waitcnt vmcnt(0)" ::: "memory");
            const unsigned og = xb_add(&bar[XB_TOP], 1u);
            const unsigned tg = og / nx;
            if (og + 1u == (tg + 1u) * nx) xb_add(&bar[XB_TOPGEN], 1u);
            else XB_SPIN(xb_ld(&bar[XB_TOPGEN]) == tg, bar);
            __builtin_amdgcn_fence(__ATOMIC_ACQUIRE, "agent");
            xb_add(&bar[XB_XGEN(b.x)], 1u);
            asm volatile("s_waitcnt vmcnt(0)" ::: "memory");
        } else {
            XB_SPIN(xb_ld(&bar[XB_XGEN(b.x)]) == gen, bar);
            __builtin_amdgcn_fence(__ATOMIC_ACQUIRE, "agent");
            asm volatile("s_waitcnt vmcnt(0)" ::: "memory");
        }
    }
    __syncthreads();
}

namespace pg8 {
constexpr int BM = 256, BK = 64, HALF = 128, HTB = HALF * BK * 2, STAGE_BYTES = 8 * HTB, NXCD = 8, WGM = 8;
__device__ __forceinline__ int lds_byte(int r, int c) { const int st = (r >> 4) * 2 + (c >> 5), rr = r & 15, cc = c & 31, ob = rr * 64 + cc * 2; return st * 1024 + (ob ^ (((ob >> 9) & 1) << 5)); }
__device__ __forceinline__ void stage_rc(int b, int& R, int& C) { const int st = b / 1024, sb = b % 1024, swz = sb ^ (((sb >> 9) & 1) << 5); R = (st >> 1) * 16 + swz / 64; C = (st & 1) * 32 + (swz % 64) / 2; }
__device__ __forceinline__ int perm32(int rho) { const int n = rho >> 4, i = rho & 15; return 8 * (i >> 2) + 4 * n + (i & 3); }

struct Unit { int pm, pn, e; };
struct GroupOrder {
    int nM, nN, ng, G, c;
    __device__ __forceinline__ void init(int nM_, int nN_, int ng_, int G_, int c_) { nM = nM_; nN = nN_; ng = ng_; G = G_; c = c_; }
    __device__ __forceinline__ bool next(int i, Unit& u) const {
        const int nwg = nM * nN; const long L = (long)i * G + c; if (L >= (long)nwg * ng) return false;
        const int grp = (int)(L / nwg); int wgid = (int)(L % nwg);
        { const int q = nwg / NXCD, r = nwg % NXCD, xcd = wgid % NXCD, off = wgid / NXCD; wgid = (xcd < r ? xcd * (q + 1) : r * (q + 1) + (xcd - r) * q) + off; }
        const int nig = WGM * nN, gid = wgid / nig, fm = gid * WGM, gsz = (nM - fm) < WGM ? (nM - fm) : WGM;
        u.pm = grp * nM + fm + ((wgid % nig) % gsz); u.pn = (wgid % nig) / gsz; u.e = grp; return true;
    }
};
struct Gemm { const bf16_t* A; const bf16_t* Bt; int K; size_t bgs; const int* rowidx; };

template <class Epi, bool GATHER>
__device__ __forceinline__ void gemm_phase(LAS uchar* lds, const Gemm g, const GroupOrder& S, const Epi& E) {
    const int tid = threadIdx.x, wid = __builtin_amdgcn_readfirstlane(tid >> 6), lane = tid & 63, wr = wid >> 2, wc = wid & 3, fr = lane & 15, fq = lane >> 4;
    const int K = g.K, nt = K / BK;
    unsigned voffA[2], voffB[2]; int Rr[2], Cc[2];
#pragma unroll
    for (int i = 0; i < 2; ++i) { int R, C; stage_rc(tid * 16 + i * 8192, R, C); const int Rb = Epi::PERM ? ((R & ~31) + perm32(R & 31)) : R; Rr[i] = R; Cc[i] = C;
        voffA[i] = (unsigned)(R * K + C) * 2u; voffB[i] = (unsigned)(Rb * K + C) * 2u; }
    const size_t kstep = (size_t)(BK * 2);
    const size_t hstep = (size_t)HALF * K * 2;
    const size_t tstep = 2 * hstep;
    const unsigned ldsw = (unsigned)wid * 1024u;
    const int aoff = lds_byte(wr * 64 + fr, fq * 8), boff = lds_byte(wc * 32 + fr, fq * 8);
#define PG8_SA(b, h) (((b) * 2 + (h)) * HTB)
#define PG8_SB(b, h) ((4 + (b) * 2 + (h)) * HTB)
#define PG8_STAGE(bufoff, gbase, voff) do { _Pragma("unroll") for (int _i = 0; _i < 2; ++_i) \
        __builtin_amdgcn_global_load_lds((const unsigned*)((const char*)(gbase) + (voff)[_i]), (LAS unsigned*)(lds + (bufoff) + ldsw + _i * 8192), 16, 0, 0); } while (0)
#define PG8_STAGE_A(bufoff, p, ofs, h) do { if constexpr (GATHER) { PG8_STAGE(bufoff, p, (ofs)[h]); } else { PG8_STAGE(bufoff, (p) + (h) * hstep, voffA); } } while (0)
#define PG8_LDA(dst, b, h) do { _Pragma("unroll") for (int m = 0; m < 4; ++m) _Pragma("unroll") for (int k = 0; k < 2; ++k) dst[m][k] = *(const LAS bf16x8*)(lds + PG8_SA(b, h) + aoff + m * 2048 + k * 1024); } while (0)
#define PG8_LDB(dst, b, h) do { _Pragma("unroll") for (int n = 0; n < 2; ++n) _Pragma("unroll") for (int k = 0; k < 2; ++k) dst[n][k] = *(const LAS bf16x8*)(lds + PG8_SB(b, h) + boff + n * 2048 + k * 1024); } while (0)
#define PG8_MMA(ai, bj, At, Bt) do { __builtin_amdgcn_s_setprio(1); _Pragma("unroll") for (int m = 0; m < 4; ++m) _Pragma("unroll") for (int n = 0; n < 2; ++n) _Pragma("unroll") for (int k = 0; k < 2; ++k) \
        acc[ai][bj][m][n] = __builtin_amdgcn_mfma_f32_16x16x32_bf16(Bt[n][k], At[m][k], acc[ai][bj][m][n], 0, 0, 0); __builtin_amdgcn_s_setprio(0); } while (0)
#define PG8_WAIT_V(n) asm volatile("s_waitcnt vmcnt(" #n ")" ::: "memory")
#define PG8_WAIT_L(n) asm volatile("s_waitcnt lgkmcnt(" #n ")" ::: "memory")
#define PG8_BAR __builtin_amdgcn_s_barrier()
#define PG8_SCHED __builtin_amdgcn_sched_barrier(0)
    Unit cur, nxt; int ui = 0;
    if (!S.next(0, cur)) return;
    f32x4 acc[2][2][4][2];
#pragma unroll
    for (int a = 0; a < 2; ++a)
#pragma unroll
        for (int b = 0; b < 2; ++b)
#pragma unroll
            for (int m = 0; m < 4; ++m)
#pragma unroll
                for (int n = 0; n < 2; ++n) acc[a][b][m][n] = (f32x4){0.f, 0.f, 0.f, 0.f};
    bf16x8 At[4][2], B0[2][2], B1[2][2];
    unsigned cofs[2][2], nofs[2][2];
    if constexpr (GATHER) {
#pragma unroll
        for (int h = 0; h < 2; ++h)
#pragma unroll
            for (int i = 0; i < 2; ++i) { const int row = g.rowidx[cur.pm * BM + h * HALF + Rr[i]]; cofs[h][i] = (unsigned)(row * K + Cc[i]) * 2u; nofs[h][i] = cofs[h][i]; }
    }
    const char* cA = GATHER ? (const char*)g.A : (const char*)g.A + (size_t)cur.pm * tstep;
    const char* cB = (const char*)g.Bt + (size_t)cur.e * g.bgs + (size_t)cur.pn * tstep;
    PG8_STAGE(PG8_SB(0, 0), cB, voffB); PG8_STAGE(PG8_SB(0, 1), cB + hstep, voffB); PG8_STAGE_A(PG8_SA(0, 0), cA, cofs, 0); PG8_STAGE_A(PG8_SA(0, 1), cA, cofs, 1);
    if (wr == 1) PG8_BAR;
    PG8_WAIT_V(2); PG8_BAR;
    PG8_STAGE(PG8_SB(1, 0), cB + kstep, voffB); PG8_STAGE_A(PG8_SA(1, 0), cA + kstep, cofs, 0); PG8_STAGE(PG8_SB(1, 1), cB + hstep + kstep, voffB);
    PG8_WAIT_V(6); PG8_BAR;
    for (;;) {
        const bool has_next = S.next(ui + 1, nxt);
        const char* nA = GATHER ? (const char*)g.A : (has_next ? (const char*)g.A + (size_t)nxt.pm * tstep : cA);
        const char* nB = has_next ? (const char*)g.Bt + (size_t)nxt.e * g.bgs + (size_t)nxt.pn * tstep : cB;
        for (int t = 0; t < nt; t += 2) {
            const bool last = (t == nt - 2);
            const char* a1 = cA + (size_t)(t + 1) * kstep;
            const char* a2 = last ? nA : cA + (size_t)(t + 2) * kstep; const char* b2 = last ? nB : cB + (size_t)(t + 2) * kstep;
            const char* a3 = a2 + kstep; const char* b3 = b2 + kstep;
            if constexpr (GATHER) {
                if (last && has_next) {
#pragma unroll
                    for (int h = 0; h < 2; ++h)
#pragma unroll
                        for (int i = 0; i < 2; ++i) { const int row = g.rowidx[nxt.pm * BM + h * HALF + Rr[i]]; nofs[h][i] = (unsigned)(row * K + Cc[i]) * 2u; }
                }
            }
            PG8_LDB(B0, 0, 0); PG8_LDB(B1, 0, 1); PG8_SCHED; PG8_LDA(At, 0, 0); PG8_STAGE_A(PG8_SA(1, 1), a1, cofs, 1);
            PG8_WAIT_V(8); PG8_WAIT_L(0); PG8_BAR; PG8_MMA(0, 0, At, B0); PG8_MMA(0, 1, At, B1); PG8_BAR; PG8_SCHED;
            PG8_LDA(At, 0, 1); PG8_STAGE(PG8_SB(0, 0), b2, voffB); PG8_STAGE(PG8_SB(0, 1), b2 + hstep, voffB);
            if (last) { PG8_STAGE_A(PG8_SA(0, 0), a2, nofs, 0); } else { PG8_STAGE_A(PG8_SA(0, 0), a2, cofs, 0); }
            PG8_WAIT_V(8); PG8_WAIT_L(0); PG8_BAR; PG8_MMA(1, 0, At, B0); PG8_MMA(1, 1, At, B1); PG8_BAR; PG8_SCHED;
            PG8_LDB(B0, 1, 0); PG8_LDB(B1, 1, 1); PG8_SCHED; PG8_LDA(At, 1, 0);
            if (last) { PG8_STAGE_A(PG8_SA(0, 1), a2, nofs, 1); } else { PG8_STAGE_A(PG8_SA(0, 1), a2, cofs, 1); }
            PG8_WAIT_V(8); PG8_WAIT_L(0); PG8_BAR; PG8_MMA(0, 0, At, B0); PG8_MMA(0, 1, At, B1); PG8_BAR; PG8_SCHED;
            PG8_LDA(At, 1, 1); PG8_STAGE(PG8_SB(1, 0), b3, voffB); PG8_STAGE(PG8_SB(1, 1), b3 + hstep, voffB);
            if (last) { PG8_STAGE_A(PG8_SA(1, 0), a3, nofs, 0); } else { PG8_STAGE_A(PG8_SA(1, 0), a3, cofs, 0); }
            PG8_WAIT_V(8); PG8_WAIT_L(0); PG8_BAR; PG8_MMA(1, 0, At, B0); PG8_MMA(1, 1, At, B1); PG8_BAR; PG8_SCHED;
        }
        if (wr == 0) PG8_BAR;
        E(acc, cur, wr, wc, fr, fq);
        if (!has_next) break;
#pragma unroll
        for (int a = 0; a < 2; ++a)
#pragma unroll
            for (int b = 0; b < 2; ++b)
#pragma unroll
                for (int m = 0; m < 4; ++m)
#pragma unroll
                    for (int n = 0; n < 2; ++n) acc[a][b][m][n] = (f32x4){0.f, 0.f, 0.f, 0.f};
        cur = nxt; cA = nA; cB = nB; ++ui;
        if constexpr (GATHER) {
#pragma unroll
            for (int h = 0; h < 2; ++h)
#pragma unroll
                for (int i = 0; i < 2; ++i) cofs[h][i] = nofs[h][i];
        }
        if (wr == 1) PG8_BAR;
    }
    PG8_WAIT_V(0);
    PG8_BAR;
#undef PG8_SA
#undef PG8_SB
#undef PG8_STAGE
#undef PG8_STAGE_A
#undef PG8_LDA
#undef PG8_LDB
#undef PG8_MMA
#undef PG8_WAIT_V
#undef PG8_WAIT_L
#undef PG8_BAR
#undef PG8_SCHED
}


struct EpiInproj {
    static constexpr bool PERM = true;
    uchar* zbase; bf16_t* ci; float* olog0; float* olog1; const float* lb; int seg0;
    __device__ __forceinline__ void operator()(const f32x4 (&acc)[2][2][4][2], const Unit& u, int wr, int wc, int fr, int fq) const {
        const int seg = seg0 + (u.pn >> 1);
        const int row0 = u.pm * BM + wr * 64 + fr, col0 = (u.pn & 1) * 256 + wc * 32 + 8 * fq;
        if (seg == 1 || seg == 2) {
            float* O = (seg == 1) ? olog0 : olog1; const float* lbp = lb + (seg - 1) * 512;
#pragma unroll
            for (int bj = 0; bj < 2; ++bj) {
                const f32x4 l0 = *(const f32x4*)(lbp + col0 + bj * HALF), l1 = *(const f32x4*)(lbp + col0 + bj * HALF + 4);
#pragma unroll
                for (int ai = 0; ai < 2; ++ai)
#pragma unroll
                    for (int m = 0; m < 4; ++m) { float* rowp = O + (size_t)(row0 + ai * HALF + m * 16) * 512 + col0 + bj * HALF;
                        f32x4 v0 = acc[ai][bj][m][0], v1 = acc[ai][bj][m][1], o0, o1;
#pragma unroll
                        for (int j = 0; j < 4; ++j) { const float s0 = 1.f / (1.f + __expf(-v0[j])), s1 = 1.f / (1.f + __expf(-v1[j]));
                            o0[j] = __logf(l0[j] + (1.f - l0[j]) * s0); o1[j] = __logf(l1[j] + (1.f - l1[j]) * s1); }
                        *(f32x4*)rowp = o0; *(f32x4*)(rowp + 4) = o1; }
            }
        } else {
            bf16_t* O = zbase ? (bf16_t*)(zbase + (size_t)(32 * seg + (seg >= 3 ? 64 : 0)) * MiB) : ci;
#pragma unroll
            for (int ai = 0; ai < 2; ++ai)
#pragma unroll
                for (int m = 0; m < 4; ++m) { bf16_t* rowp = O + (size_t)(row0 + ai * HALF + m * 16) * 512 + col0;
#pragma unroll
                    for (int bj = 0; bj < 2; ++bj) { const f32x4 v0 = acc[ai][bj][m][0], v1 = acc[ai][bj][m][1];
                        u32x4 w; w.x = cvt_pk_bf16(v0[0], v0[1]); w.y = cvt_pk_bf16(v0[2], v0[3]); w.z = cvt_pk_bf16(v1[0], v1[1]); w.w = cvt_pk_bf16(v1[2], v1[3]);
                        *(u32x4*)(rowp + bj * HALF) = w; } }
        }
    }
};
struct EpiOut {
    static constexpr bool PERM = false;
    const float* x; float* x1; const float* modf;
    __device__ __forceinline__ void operator()(const f32x4 (&acc)[2][2][4][2], const Unit& u, int wr, int wc, int fr, int fq) const {
        const int row0 = u.pm * BM + wr * 64 + fr, col0 = u.pn * BM + wc * 32 + 4 * fq;
        const int b = (u.pm * BM) / T;
        const float* g1 = modf + (size_t)b * NMOD + 2 * D;
        f32x4 gv[2][2];
#pragma unroll
        for (int bj = 0; bj < 2; ++bj)
#pragma unroll
            for (int n = 0; n < 2; ++n) gv[bj][n] = *(const f32x4*)(g1 + col0 + bj * HALF + n * 16);
#pragma unroll
        for (int ai = 0; ai < 2; ++ai)
#pragma unroll
            for (int m = 0; m < 4; ++m) { const size_t off = (size_t)(row0 + ai * HALF + m * 16) * D + col0;
#pragma unroll
                for (int bj = 0; bj < 2; ++bj)
#pragma unroll
                    for (int n = 0; n < 2; ++n) { const f32x4 xs = *(const f32x4*)(x + off + bj * HALF + n * 16); *(f32x4*)(x1 + off + bj * HALF + n * 16) = xs + gv[bj][n] * acc[ai][bj][m][n]; }
                asm volatile("" ::: "memory"); }
    }
};
struct EpiMoe1 {
    static constexpr bool PERM = true;
    bf16_t* hid;
    __device__ __forceinline__ void operator()(const f32x4 (&acc)[2][2][4][2], const Unit& u, int wr, int wc, int fr, int fq) const {
        const int row0 = u.pm * BM + wr * 64 + fr, col0 = u.pn * 128 + wc * 32 + 8 * fq;
#pragma unroll
        for (int ai = 0; ai < 2; ++ai)
#pragma unroll
            for (int m = 0; m < 4; ++m) { bf16_t* rowp = hid + (size_t)(row0 + ai * HALF + m * 16) * DFF + col0;
                float o[8];
#pragma unroll
                for (int n = 0; n < 2; ++n)
#pragma unroll
                    for (int j = 0; j < 4; ++j) { const float gt = acc[ai][0][m][n][j], up = acc[ai][1][m][n][j]; o[n * 4 + j] = gt * up / (1.f + __expf(-gt)); }
                u32x4 w; w.x = cvt_pk_bf16(o[0], o[1]); w.y = cvt_pk_bf16(o[2], o[3]); w.z = cvt_pk_bf16(o[4], o[5]); w.w = cvt_pk_bf16(o[6], o[7]);
                *(u32x4*)rowp = w; }
    }
};
struct EpiMoe2 {
    static constexpr bool PERM = true;
    bf16_t* ys; const float* gate;
    __device__ __forceinline__ void operator()(const f32x4 (&acc)[2][2][4][2], const Unit& u, int wr, int wc, int fr, int fq) const {
        const int row0 = u.pm * BM + wr * 64 + fr, col0 = u.pn * BM + wc * 32 + 8 * fq;
#pragma unroll
        for (int ai = 0; ai < 2; ++ai)
#pragma unroll
            for (int m = 0; m < 4; ++m) { const int row = row0 + ai * HALF + m * 16; const float gt = gate[row]; bf16_t* rowp = ys + (size_t)row * D + col0;
#pragma unroll
                for (int bj = 0; bj < 2; ++bj) { const f32x4 v0 = acc[ai][bj][m][0] * gt, v1 = acc[ai][bj][m][1] * gt;
                    u32x4 w; w.x = cvt_pk_bf16(v0[0], v0[1]); w.y = cvt_pk_bf16(v0[2], v0[3]); w.z = cvt_pk_bf16(v1[0], v1[1]); w.w = cvt_pk_bf16(v1[2], v1[3]);
                    *(u32x4*)(rowp + bj * HALF) = w; } }
    }
};
}

struct Args {
    const float *x, *c, *ctx, *c_ctx, *w_ada, *b_ada, *norm_mix, *norm_ffn, *w_in, *lb_logits, *hg_norm, *conv_w, *w_out, *w_router, *w_gate, *w_up, *w_down, *norm_final;
    float* out; uchar* ws; int ph_lo, ph_hi;
};

__device__ __forceinline__ void cvt_item(const float* W, int ldw, bf16_t* WT, int ldt, int k0, int n0, int nrow0, LAS float* scr, int lane) {
#pragma unroll 8
    for (int i = 0; i < 32; ++i) { const int kk = 2 * i + (lane >> 5); scr[kk * 33 + (lane & 31)] = W[(size_t)(k0 + kk) * ldw + n0 + (lane & 31)]; }
    LDS_WAIT(); asm volatile("" ::: "memory");
    const int c = lane & 7;
#pragma unroll
    for (int j = 0; j < 4; ++j) { const int n = (lane >> 3) + 8 * j; const LAS float* s = scr + (8 * c) * 33 + n;
        u32x4 o; o.x = cvt_pk_bf16(s[0 * 33], s[1 * 33]); o.y = cvt_pk_bf16(s[2 * 33], s[3 * 33]); o.z = cvt_pk_bf16(s[4 * 33], s[5 * 33]); o.w = cvt_pk_bf16(s[6 * 33], s[7 * 33]);
        *(u32x4*)(WT + (size_t)(nrow0 + n) * ldt + k0 + 8 * c) = o; }
    LDS_WAIT(); asm volatile("" ::: "memory");
}

__device__ __forceinline__ void phase_prep(const Args& a, LAS uchar* lds, int bid, int G, int tid, int wid, int lane) {
    float* modp = (float*)(a.ws + WS_MODP);
    if (bid < 192) {
        const int cgp = bid % 24, ks = bid / 24, n0 = cgp * 256 + lane * 4, k0 = ks * 128 + wid * 16;
        f32x4 acc[9];
#pragma unroll
        for (int r = 0; r < 9; ++r) acc[r] = (f32x4){0.f, 0.f, 0.f, 0.f};
#pragma unroll 4
        for (int kk = 0; kk < 16; ++kk) { const int k = k0 + kk; const f32x4 w = *(const f32x4*)(a.w_ada + (size_t)k * NMOD + n0);
#pragma unroll
            for (int r = 0; r < 9; ++r) { const float cv = (r < 8) ? a.c[r * D + k] : a.c_ctx[k]; const float s = silu_f(cv); acc[r] += w * s; } }
        LAS f32x4* red = (LAS f32x4*)lds;
#pragma unroll
        for (int r = 0; r < 9; ++r) red[(wid * 9 + r) * 64 + lane] = acc[r];
        __syncthreads();
        for (int o = tid; o < 9 * 64; o += 512) { const int r = o / 64, l = o % 64; f32x4 s = red[(0 * 9 + r) * 64 + l];
#pragma unroll
            for (int w = 1; w < 8; ++w) s += red[(w * 9 + r) * 64 + l];
            if (ks == 0) s += *(const f32x4*)(a.b_ada + cgp * 256 + l * 4);
            *(f32x4*)(modp + ((size_t)ks * 9 + r) * NMOD + cgp * 256 + l * 4) = s; }
        __syncthreads();
    }
    if (bid == 255) {
        float* lb = (float*)(a.ws + WS_LB);
        for (int i = tid; i < 1024; i += 512) { const float l0 = a.lb_logits[i], l1 = a.lb_logits[1024 + i]; lb[i] = 1.f / (1.f + __expf(l1 - l0)); }
    }
    LAS float* scr = (LAS float*)lds + wid * (64 * 33);
    const int gw = (G - 1 - bid) * 8 + wid, NGW = G * 8;
    constexpr int I_IN = (D / 64) * (NIN / 32), I_OUT = (D / 64) * (D / 32);
    for (int it = gw; it < I_IN + I_OUT; it += NGW) {
        if (it < I_IN) { const int nblk = NIN / 32, kb = it / nblk, nb = it % nblk; cvt_item(a.w_in, NIN, (bf16_t*)(a.ws + WS_WIN), D, kb * 64, nb * 32, nb * 32, scr, lane); }
        else { const int r = it - I_IN, nblk = D / 32, kb = r / nblk, nb = r % nblk; cvt_item(a.w_out, D, (bf16_t*)(a.ws + WS_WOUT), D, kb * 64, nb * 32, nb * 32, scr, lane); }
    }
}

__device__ __forceinline__ float modp_sum(const float* modp, int r, int col) { float s = 0.f;
#pragma unroll
    for (int ks = 0; ks < 8; ++ks) s += modp[((size_t)ks * 9 + r) * NMOD + col];
    return s; }
__device__ __forceinline__ void norm_row(const float* xrow, bf16_t* orow, const LAS float* gm, const LAS float* sh, int lane) {
    f32x4 v[4]; float ss = 0.f;
#pragma unroll
    for (int j = 0; j < 4; ++j) { v[j] = *((const f32x4*)xrow + lane + 64 * j); ss += (v[j].x * v[j].x + v[j].y * v[j].y) + (v[j].z * v[j].z + v[j].w * v[j].w); }
    const float rstd = rsqrtf(wave_sum(ss) * (1.f / D) + EPS);
#pragma unroll
    for (int j = 0; j < 4; ++j) { const f32x4 g4 = *((const LAS f32x4*)gm + lane + 64 * j), s4 = *((const LAS f32x4*)sh + lane + 64 * j); const f32x4 o = v[j] * rstd * g4 + s4;
        u32x2 w; w.x = cvt_pk_bf16(o.x, o.y); w.y = cvt_pk_bf16(o.z, o.w); *((u32x2*)orow + lane + 64 * j) = w; }
}
__device__ __forceinline__ void phase_norm(const Args& a, LAS uchar* lds, int bid, int G, int tid, int wid, int lane) {
    const float* modp = (const float*)(a.ws + WS_MODP); float* modf = (float*)(a.ws + WS_MODF);
    { const int gt = bid * 512 + tid; if (gt < 9 * NMOD) modf[gt] = modp_sum(modp, gt / NMOD, gt % NMOD); }
    LAS float* gm = (LAS float*)lds; LAS float* sh = gm + D; LAS float* cgm = sh + D; LAS float* csh = cgm + D;
    const int b = bid / 32;
    for (int cidx = tid; cidx < D; cidx += 512) { const float nm = a.norm_mix[cidx];
        sh[cidx] = modp_sum(modp, b, cidx); gm[cidx] = nm * (1.f + modp_sum(modp, b, D + cidx));
        csh[cidx] = modp_sum(modp, 8, cidx); cgm[cidx] = nm * (1.f + modp_sum(modp, 8, D + cidx)); }
    __syncthreads();
    bf16_t* hx = (bf16_t*)(a.ws + WS_ACT); bf16_t* hc = (bf16_t*)(a.ws + WS_HC);
    for (int j = 0; j < 16; ++j) { const int row = bid * 128 + wid * 16 + j; norm_row(a.x + (size_t)row * D, hx + (size_t)row * D, gm, sh, lane); }
    { const int row = bid * 8 + wid; norm_row(a.ctx + (size_t)row * D, hc + (size_t)row * D, cgm, csh, lane); }
    __syncthreads();
}

constexpr int GL_QDP = 0, GL_KIP = 8704, GL_KETP = 17408, GL_VTP = 27648, GL_DEC = 37888, GL_TOT = 38400, GL_RING = 43008, GL_SLOT = 32768;
#define GLA_BAR() do { asm volatile("s_waitcnt lgkmcnt(0)" ::: "memory"); __builtin_amdgcn_s_barrier(); asm volatile("" ::: "memory"); } while (0)
template <bool FULL>
__device__ __forceinline__ void gla_item(LAS uchar* lds, const bf16_t* qb, const float* lfb, const bf16_t* vb, bf16_t* ob, f32x4 (&S)[8], float* dl_out,
                                         int row_base, int Tn, int tau0, int nch, int h, int dir, int wid, int lane) {
    const int fr = lane & 15, fq = lane >> 4;
#define GLA_ISSUE(c) do { LAS uchar* _sl = lds + GL_RING + ((c) % 3) * GL_SLOT + wid * 4096; \
        _Pragma("unroll") for (int _i = 0; _i < 2; ++_i) { const int _tau = tau0 + 32 * (c) + 4 * wid + 2 * _i + (lane >> 5); const size_t _row = (size_t)(row_base + (dir ? (Tn - 1 - _tau) : _tau)); \
            __builtin_amdgcn_global_load_lds((const unsigned*)(lfb + _row * 512 + h * 128 + (lane & 31) * 4), (LAS unsigned*)(_sl + _i * 1024), 16, 0, 0); } \
        { const int _tau = tau0 + 32 * (c) + 4 * wid + (lane >> 4); const size_t _row = (size_t)(row_base + (dir ? (Tn - 1 - _tau) : _tau)); \
            if (FULL) __builtin_amdgcn_global_load_lds((const unsigned*)(qb + _row * 512 + h * 128 + (lane & 15) * 8), (LAS unsigned*)(_sl + 2048), 16, 0, 0); \
            __builtin_amdgcn_global_load_lds((const unsigned*)(vb + _row * 512 + h * 128 + (lane & 15) * 8), (LAS unsigned*)(_sl + 3072), 16, 0, 0); } } while (0)
    GLA_ISSUE(0);
    if (nch > 1) GLA_ISSUE(1);
    const int d0 = 2 * lane, pos0 = (d0 & ~31) + 8 * ((d0 >> 2) & 3) + 4 * ((d0 >> 4) & 1) + (d0 & 3);
    const int spos = 8 * (wid & 3) + 4 * (wid >> 2);
    f32x2 dsum = (f32x2){0.f, 0.f};
    for (int n = 0; n < nch; ++n) {
        if (n + 1 < nch) { if (FULL) asm volatile("s_waitcnt vmcnt(4)" ::: "memory"); else asm volatile("s_waitcnt vmcnt(3)" ::: "memory"); }
        else asm volatile("s_waitcnt vmcnt(0)" ::: "memory");
        const LAS uchar* sl = lds + GL_RING + (n % 3) * GL_SLOT + wid * 4096;
        f32x2 lf[4];
#pragma unroll
        for (int rr = 0; rr < 4; ++rr) lf[rr] = *(const LAS f32x2*)(sl + rr * 512 + lane * 8);
        f32x2 c[4]; c[0] = lf[0]; c[1] = c[0] + lf[1]; c[2] = c[1] + lf[2]; c[3] = c[2] + lf[3];
        LAS f32x2* tot = (LAS f32x2*)(lds + GL_TOT);
        tot[wid * 64 + lane] = c[3];
        unsigned qv[4], vv[4];
#pragma unroll
        for (int rr = 0; rr < 4; ++rr) { vv[rr] = *(const LAS unsigned*)(sl + 3072 + rr * 256 + lane * 4); qv[rr] = FULL ? *(const LAS unsigned*)(sl + 2048 + rr * 256 + lane * 4) : 0u; }
        GLA_BAR();
        if (n + 2 < nch) GLA_ISSUE(n + 2);
        f32x2 pre = (f32x2){0.f, 0.f}, all = (f32x2){0.f, 0.f};
#pragma unroll
        for (int w = 0; w < 8; ++w) { const f32x2 tw = tot[w * 64 + lane]; all += tw; if (w < wid) pre += tw; }
        dsum += all;
        float kE0[4], kE1[4];
#pragma unroll
        for (int rr = 0; rr < 4; ++rr) {
            const f32x2 cum = pre + c[rr];
            const float k0 = 1.f - __expf(lf[rr].x), k1 = 1.f - __expf(lf[rr].y);
            kE0[rr] = k0 * __expf(all.x - cum.x); kE1[rr] = k1 * __expf(all.y - cum.y);
            if (FULL) { const int s = 4 * wid + rr; const float e0 = __expf(cum.x), e1 = __expf(cum.y);
                *(LAS unsigned*)(lds + GL_QDP + s * 272 + pos0 * 2) = cvt_pk_bf16(bf_lo(qv[rr]) * e0, bf_hi(qv[rr]) * e1);
                *(LAS unsigned*)(lds + GL_KIP + s * 272 + pos0 * 2) = cvt_pk_bf16(k0 * __expf(-cum.x), k1 * __expf(-cum.y)); }
        }
        { u32x2 w0, w1; w0.x = cvt_pk_bf16(kE0[0], kE0[1]); w0.y = cvt_pk_bf16(kE0[2], kE0[3]); w1.x = cvt_pk_bf16(kE1[0], kE1[1]); w1.y = cvt_pk_bf16(kE1[2], kE1[3]);
          *(LAS u32x2*)(lds + GL_KETP + (d0) * 80 + spos * 2) = w0; *(LAS u32x2*)(lds + GL_KETP + (d0 + 1) * 80 + spos * 2) = w1;
          u32x2 v0, v1; v0.x = (vv[0] & 0xffffu) | (vv[1] << 16); v0.y = (vv[2] & 0xffffu) | (vv[3] << 16);
          v1.x = (vv[0] >> 16) | (vv[1] & 0xffff0000u); v1.y = (vv[2] >> 16) | (vv[3] & 0xffff0000u);
          *(LAS u32x2*)(lds + GL_VTP + (d0) * 80 + spos * 2) = v0; *(LAS u32x2*)(lds + GL_VTP + (d0 + 1) * 80 + spos * 2) = v1; }
        if (wid == 0) *(LAS f32x2*)(lds + GL_DEC + lane * 8) = (f32x2){__expf(all.x), __expf(all.y)};
        GLA_BAR();
        const bf16x8 vt = *(const LAS bf16x8*)(lds + GL_VTP + (16 * wid + fr) * 80 + fq * 16);
        if (FULL) {
            bf16x8 qf[2][4];
#pragma unroll
            for (int ti = 0; ti < 2; ++ti)
#pragma unroll
                for (int kk = 0; kk < 4; ++kk) qf[ti][kk] = *(const LAS bf16x8*)(lds + GL_QDP + (16 * ti + fr) * 272 + kk * 64 + fq * 16);
            f32x4 oT[2] = {(f32x4){0.f, 0.f, 0.f, 0.f}, (f32x4){0.f, 0.f, 0.f, 0.f}};
            f32x4 p00 = (f32x4){0.f, 0.f, 0.f, 0.f}, p01 = p00, p11 = p00;
#pragma unroll
            for (int kk = 0; kk < 4; ++kk) {
                const bf16x8 kj0 = *(const LAS bf16x8*)(lds + GL_KIP + (fr) * 272 + kk * 64 + fq * 16);
                const bf16x8 kj1 = *(const LAS bf16x8*)(lds + GL_KIP + (16 + fr) * 272 + kk * 64 + fq * 16);
                p00 = __builtin_amdgcn_mfma_f32_16x16x32_bf16(kj0, qf[0][kk], p00, 0, 0, 0);
                p01 = __builtin_amdgcn_mfma_f32_16x16x32_bf16(kj0, qf[1][kk], p01, 0, 0, 0);
                p11 = __builtin_amdgcn_mfma_f32_16x16x32_bf16(kj1, qf[1][kk], p11, 0, 0, 0);
                u32x4 sa; sa.x = cvt_pk_bf16_safe(S[2 * kk][0], S[2 * kk][1]); sa.y = cvt_pk_bf16_safe(S[2 * kk][2], S[2 * kk][3]);
                sa.z = cvt_pk_bf16_safe(S[2 * kk + 1][0], S[2 * kk + 1][1]); sa.w = cvt_pk_bf16_safe(S[2 * kk + 1][2], S[2 * kk + 1][3]);
                const bf16x8 sA = __builtin_bit_cast(bf16x8, sa);
                oT[0] = __builtin_amdgcn_mfma_f32_16x16x32_bf16(sA, qf[0][kk], oT[0], 0, 0, 0);
                oT[1] = __builtin_amdgcn_mfma_f32_16x16x32_bf16(sA, qf[1][kk], oT[1], 0, 0, 0);
            }
            u32x4 pb0, pb1;
            { float m0[4], m1[4];
#pragma unroll
              for (int r = 0; r < 4; ++r) { const bool ok = (4 * fq + r) <= fr; m0[r] = ok ? p00[r] : 0.f; m1[r] = ok ? p11[r] : 0.f; }
              pb0.x = cvt_pk_bf16_safe(m0[0], m0[1]); pb0.y = cvt_pk_bf16_safe(m0[2], m0[3]); pb0.z = 0u; pb0.w = 0u;
              pb1.x = cvt_pk_bf16_safe(p01[0], p01[1]); pb1.y = cvt_pk_bf16_safe(p01[2], p01[3]); pb1.z = cvt_pk_bf16_safe(m1[0], m1[1]); pb1.w = cvt_pk_bf16_safe(m1[2], m1[3]); }
            oT[0] = __builtin_amdgcn_mfma_f32_16x16x32_bf16(vt, __builtin_bit_cast(bf16x8, pb0), oT[0], 0, 0, 0);
            oT[1] = __builtin_amdgcn_mfma_f32_16x16x32_bf16(vt, __builtin_bit_cast(bf16x8, pb1), oT[1], 0, 0, 0);
#pragma unroll
            for (int ti = 0; ti < 2; ++ti) { const int tau = tau0 + 32 * n + 16 * ti + fr; const size_t row = (size_t)(row_base + (dir ? (Tn - 1 - tau) : tau));
                u32x2 w; w.x = cvt_pk_bf16_safe(oT[ti][0], oT[ti][1]); w.y = cvt_pk_bf16_safe(oT[ti][2], oT[ti][3]);
                *(u32x2*)(ob + row * 512 + h * 128 + 16 * wid + 4 * fq) = w; }
        }
#pragma unroll
        for (int t8 = 0; t8 < 8; ++t8) {
            const f32x4 dc = *(const LAS f32x4*)(lds + GL_DEC + (16 * t8 + 4 * fq) * 4);
            const bf16x8 ka = *(const LAS bf16x8*)(lds + GL_KETP + (16 * t8 + fr) * 80 + fq * 16);
            S[t8] = __builtin_amdgcn_mfma_f32_16x16x32_bf16(ka, vt, S[t8] * dc, 0, 0, 0);
        }
    }
#undef GLA_ISSUE
    if (dl_out && wid == 0) *(f32x2*)(dl_out + 2 * lane) = dsum;
    asm volatile("s_waitcnt vmcnt(0)" ::: "memory");
    GLA_BAR();
}
__device__ __forceinline__ void gla_state_store(float* p, const f32x4 (&S)[8], int wid, int fr, int fq) {
#pragma unroll
    for (int t8 = 0; t8 < 8; ++t8)
#pragma unroll
        for (int r = 0; r < 4; ++r) p[(size_t)(16 * t8 + 4 * fq + r) * 128 + 16 * wid + fr] = S[t8][r];
}
__device__ __forceinline__ void phase_gla_states(const Args& a, LAS uchar* lds, int bid, int wid, int lane) {
    uchar* ws = a.ws; const int fr = lane & 15, fq = lane >> 4;
    f32x4 S[8];
#pragma unroll
    for (int t8 = 0; t8 < 8; ++t8) S[t8] = (f32x4){0.f, 0.f, 0.f, 0.f};
    if (bid < 192) { const int bhd = bid / 3, seg = bid % 3, b = bhd >> 3, h = (bhd >> 1) & 3, dir = bhd & 1;
        gla_item<false>(lds, nullptr, (const float*)(ws + (dir ? WS_LBW : WS_LF)), (const bf16_t*)(ws + WS_ZI), nullptr, S, (float*)(ws + WS_DL) + (size_t)bid * 128,
                        b * T, T, seg * 1024, 32, h, dir, wid, lane);
        gla_state_store((float*)(ws + WS_SL) + (size_t)bid * 16384, S, wid, fr, fq);
    } else { const int bhd = bid - 192, b = bhd >> 3, h = (bhd >> 1) & 3, dir = bhd & 1;
        gla_item<false>(lds, nullptr, (const float*)(ws + (dir ? WS_CLB : WS_CLF)), (const bf16_t*)(ws + WS_CI), nullptr, S, nullptr, b * CT, CT, 0, CT / 32, h, dir, wid, lane);
        gla_state_store((float*)(ws + WS_S0) + (size_t)bhd * 16384, S, wid, fr, fq);
    }
}
__device__ __forceinline__ void phase_gla_out(const Args& a, LAS uchar* lds, int bid, int wid, int lane) {
    uchar* ws = a.ws; const int fr = lane & 15, fq = lane >> 4;
    const int bhd = bid >> 2, seg = bid & 3, b = bhd >> 3, h = (bhd >> 1) & 3, dir = bhd & 1;
    f32x4 S[8];
    { const float* p = (const float*)(ws + WS_S0) + (size_t)bhd * 16384;
#pragma unroll
      for (int t8 = 0; t8 < 8; ++t8)
#pragma unroll
          for (int r = 0; r < 4; ++r) S[t8][r] = p[(size_t)(16 * t8 + 4 * fq + r) * 128 + 16 * wid + fr]; }
    for (int j = 0; j < seg; ++j) { const float* p = (const float*)(ws + WS_SL) + (size_t)(bhd * 3 + j) * 16384; const float* dl = (const float*)(ws + WS_DL) + (size_t)(bhd * 3 + j) * 128;
#pragma unroll
        for (int t8 = 0; t8 < 8; ++t8) { const f32x4 dv = *(const f32x4*)(dl + 16 * t8 + 4 * fq);
#pragma unroll
            for (int r = 0; r < 4; ++r) S[t8][r] = __expf(dv[r]) * S[t8][r] + p[(size_t)(16 * t8 + 4 * fq + r) * 128 + 16 * wid + fr]; } }
    asm volatile("s_waitcnt vmcnt(0)" ::: "memory");
    gla_item<true>(lds, (const bf16_t*)(ws + WS_ZQ), (const float*)(ws + (dir ? WS_LBW : WS_LF)), (const bf16_t*)(ws + WS_ZI), (bf16_t*)(ws + (dir ? WS_OB : WS_OF)), S, nullptr,
                   b * T, T, seg * 1024, 32, h, dir, wid, lane);
}

__device__ __forceinline__ void unpack8(const u32x4 w, float (&f)[8]) { f[0] = bf_lo(w.x); f[1] = bf_hi(w.x); f[2] = bf_lo(w.y); f[3] = bf_hi(w.y); f[4] = bf_lo(w.z); f[5] = bf_hi(w.z); f[6] = bf_lo(w.w); f[7] = bf_hi(w.w); }
__device__ __forceinline__ void phase_mixfin(const Args& a, int bid, int G, int wid, int lane) {
    const bf16_t* of = (const bf16_t*)(a.ws + WS_OF); const bf16_t* obw = (const bf16_t*)(a.ws + WS_OB); const bf16_t* zg = (const bf16_t*)(a.ws + WS_ZG);
    const bf16_t* zgb = (const bf16_t*)(a.ws + WS_ZGB); const bf16_t* zgc = (const bf16_t*)(a.ws + WS_ZGC); const bf16_t* zv = (const bf16_t*)(a.ws + WS_ZV);
    bf16_t* A2 = (bf16_t*)(a.ws + WS_ACT);
    const int c0 = 8 * lane;
    float gain[8], cw0[8], cw1[8], cw2[8];
#pragma unroll
    for (int j = 0; j < 8; ++j) { gain[j] = a.hg_norm[(c0 + j) & 127]; cw0[j] = a.conv_w[c0 + j]; cw1[j] = a.conv_w[512 + c0 + j]; cw2[j] = a.conv_w[1024 + c0 + j]; }
    for (int row = bid * 8 + wid; row < M; row += G * 8) {
        const size_t ro = (size_t)row * 512 + c0;
        float f0[8], f1[8], gg[8], o[8];
        unpack8(*(const u32x4*)(of + ro), f0); unpack8(*(const u32x4*)(obw + ro), f1); unpack8(*(const u32x4*)(zg + ro), gg);
        float ss = 0.f;
#pragma unroll
        for (int j = 0; j < 8; ++j) { o[j] = f0[j] + f1[j]; ss += o[j] * o[j]; }
        ss += __shfl_xor(ss, 1); ss += __shfl_xor(ss, 2); ss += __shfl_xor(ss, 4); ss += __shfl_xor(ss, 8);
        const float rstd = rsqrtf(ss * (1.f / 128.f) + EPS);
#pragma unroll
        for (int j = 0; j < 8; ++j) o[j] = o[j] * rstd * gain[j] * silu_f(gg[j]);
        u32x4 w; w.x = cvt_pk_bf16(o[0], o[1]); w.y = cvt_pk_bf16(o[2], o[3]); w.z = cvt_pk_bf16(o[4], o[5]); w.w = cvt_pk_bf16(o[6], o[7]);
        *(u32x4*)(A2 + (size_t)row * D + c0) = w;
        const int tw = row & 63;
        float gcm[8], vm[8], gc0[8], v0[8], gcp[8], vp[8], gb[8], y[8];
        unpack8(*(const u32x4*)(zgc + ro), gc0); unpack8(*(const u32x4*)(zv + ro), v0); unpack8(*(const u32x4*)(zgb + ro), gb);
        if (tw > 0) { unpack8(*(const u32x4*)(zgc + ro - 512), gcm); unpack8(*(const u32x4*)(zv + ro - 512), vm); }
        else {
#pragma unroll
            for (int j = 0; j < 8; ++j) { gcm[j] = 0.f; vm[j] = 0.f; } }
        if (tw < 63) { unpack8(*(const u32x4*)(zgc + ro + 512), gcp); unpack8(*(const u32x4*)(zv + ro + 512), vp); }
        else {
#pragma unroll
            for (int j = 0; j < 8; ++j) { gcp[j] = 0.f; vp[j] = 0.f; } }
#pragma unroll
        for (int j = 0; j < 8; ++j) y[j] = gb[j] * (cw0[j] * (gcm[j] * vm[j]) + cw1[j] * (gc0[j] * v0[j]) + cw2[j] * (gcp[j] * vp[j]));
        w.x = cvt_pk_bf16(y[0], y[1]); w.y = cvt_pk_bf16(y[2], y[3]); w.z = cvt_pk_bf16(y[4], y[5]); w.w = cvt_pk_bf16(y[6], y[7]);
        *(u32x4*)(A2 + (size_t)row * D + 512 + c0) = w;
    }
}

__device__ __forceinline__ void phase_router(const Args& a, LAS uchar* lds, int bid, int tid, int wid, int lane) {
    const float* modf = (const float*)(a.ws + WS_MODF);
    LAS float* gm = (LAS float*)lds; LAS float* sh = gm + D;
    LAS uchar* wrl = lds + 8192;
    const int b = bid / 32;
    for (int cidx = tid; cidx < D; cidx += 512) { sh[cidx] = modf[(size_t)b * NMOD + 3 * D + cidx]; gm[cidx] = a.norm_ffn[cidx] * (1.f + modf[(size_t)b * NMOD + 4 * D + cidx]); }
    for (int i = tid; i < D * 4; i += 512) { const int col = i >> 2, q4 = i & 3; *(LAS f32x4*)(wrl + col * 64 + (col >> 2) * 16 + q4 * 16) = *(const f32x4*)(a.w_router + col * 16 + q4 * 4); }
    __syncthreads();
    bf16_t* hx2 = (bf16_t*)(a.ws + WS_ACT); float* aff = (float*)(a.ws + WS_AFF);
    for (int j = 0; j < 16; ++j) {
        const int row = bid * 128 + wid * 16 + j; const float* xrow = a.out + (size_t)row * D;
        f32x4 v[4]; float ss = 0.f;
#pragma unroll
        for (int jj = 0; jj < 4; ++jj) { v[jj] = *((const f32x4*)xrow + lane + 64 * jj); ss += (v[jj].x * v[jj].x + v[jj].y * v[jj].y) + (v[jj].z * v[jj].z + v[jj].w * v[jj].w); }
        const float rstd = rsqrtf(wave_sum(ss) * (1.f / D) + EPS);
        float pl[16];
#pragma unroll
        for (int e = 0; e < 16; ++e) pl[e] = 0.f;
#pragma unroll
        for (int jj = 0; jj < 4; ++jj) { const f32x4 g4 = *((const LAS f32x4*)gm + lane + 64 * jj), s4 = *((const LAS f32x4*)sh + lane + 64 * jj); const f32x4 hv = v[jj] * rstd * g4 + s4;
            u32x2 w; w.x = cvt_pk_bf16(hv.x, hv.y); w.y = cvt_pk_bf16(hv.z, hv.w); *((u32x2*)(hx2 + (size_t)row * D) + lane + 64 * jj) = w;
            const int colb = 4 * lane + 256 * jj;
#pragma unroll
            for (int cc = 0; cc < 4; ++cc) { const int col = colb + cc; const LAS uchar* wp = wrl + col * 64 + (col >> 2) * 16; const float hvv = hv[cc];
#pragma unroll
                for (int q4 = 0; q4 < 4; ++q4) { const f32x4 w4 = *(const LAS f32x4*)(wp + q4 * 16); pl[q4 * 4 + 0] += hvv * w4.x; pl[q4 * 4 + 1] += hvv * w4.y; pl[q4 * 4 + 2] += hvv * w4.z; pl[q4 * 4 + 3] += hvv * w4.w; } } }
#pragma unroll
        for (int e = 0; e < 16; ++e) pl[e] = wave_sum(pl[e]);
        float mx = pl[0];
#pragma unroll
        for (int e = 1; e < 16; ++e) mx = fmaxf(mx, pl[e]);
        float den = 0.f;
#pragma unroll
        for (int e = 0; e < 16; ++e) { pl[e] = __expf(pl[e] - mx); den += pl[e]; }
        const float inv = 1.f / den; float mine = 0.f;
#pragma unroll
        for (int e = 0; e < 16; ++e) mine = (lane == e) ? pl[e] * inv : mine;
        const int t = row & (T - 1);
        if (lane < 16) aff[((size_t)b * NE + lane) * T + t] = mine;
    }
    __syncthreads();
}

__device__ __forceinline__ void topk_item(const Args& a, LAS uchar* lds, int b, int e, int tid, int wid, int lane) {
    LAS unsigned* key = (LAS unsigned*)lds;
    LAS unsigned* hist = key + 4096;
    LAS unsigned* ctl = hist + 256;
    LAS unsigned* wsum = ctl + 8;
    const float* affp = (const float*)(a.ws + WS_AFF) + ((size_t)b * NE + e) * T;
    unsigned kv[8];
    { const u32x4 k0 = *(const u32x4*)(affp + tid * 8), k1 = *(const u32x4*)(affp + tid * 8 + 4); kv[0] = k0.x; kv[1] = k0.y; kv[2] = k0.z; kv[3] = k0.w; kv[4] = k1.x; kv[5] = k1.y; kv[6] = k1.z; kv[7] = k1.w; }
    unsigned prefix = 0u, mask = 0u, need = CAP;
    for (int shift = 24; shift >= 0; shift -= 8) {
        if (tid < 256) hist[tid] = 0u;
        __syncthreads();
#pragma unroll
        for (int j = 0; j < 8; ++j) if ((kv[j] & mask) == prefix) __hip_atomic_fetch_add(&hist[(kv[j] >> shift) & 255u], 1u, __ATOMIC_RELAXED, __HIP_MEMORY_SCOPE_WORKGROUP);
        __syncthreads();
        if (tid < 256) { unsigned above = 0u; for (int bb = tid + 1; bb < 256; ++bb) above += hist[bb]; const unsigned mine = hist[tid];
            if (above < need && need <= above + mine) { ctl[0] = (unsigned)tid; ctl[1] = need - above; } }
        __syncthreads();
        prefix |= ctl[0] << shift; mask |= 255u << shift; need = ctl[1];
        __syncthreads();
    }
    unsigned cg_ = 0u, ce_ = 0u;
#pragma unroll
    for (int j = 0; j < 8; ++j) { cg_ += kv[j] > prefix; ce_ += kv[j] == prefix; }
    unsigned pk = cg_ | (ce_ << 16), incl = pk;
#pragma unroll
    for (int o = 1; o < 64; o <<= 1) { const unsigned t2 = __shfl_up(incl, o); if (lane >= o) incl += t2; }
    if (lane == 63) wsum[wid] = incl;
    __syncthreads();
    unsigned base = 0u;
    for (int w = 0; w < wid; ++w) base += wsum[w];
    unsigned excl = base + incl - pk; unsigned ng = excl & 0xffffu, neq = excl >> 16;
    int* seltok = (int*)(a.ws + WS_SELTOK); float* selgate = (float*)(a.ws + WS_SELGATE); short* pos = (short*)(a.ws + WS_POS);
#pragma unroll
    for (int j = 0; j < 8; ++j) { const int t = tid * 8 + j; const bool gt = kv[j] > prefix, eq = kv[j] == prefix; const bool sel = gt || (eq && neq < need);
        int slot = -1;
        if (sel) slot = (int)(ng + (neq < need ? neq : need));
        if (sel) { seltok[e * 4096 + b * 512 + slot] = b * T + t; selgate[e * 4096 + b * 512 + slot] = __uint_as_float(kv[j]); }
        pos[((size_t)b * T + t) * 16 + e] = (short)slot;
        ng += gt; neq += eq; }
    __syncthreads();
}
__device__ __forceinline__ void phase_topk_cvt(const Args& a, LAS uchar* lds, int bid, int G, int tid, int wid, int lane) {
    if (bid < 128) topk_item(a, lds, bid / 16, bid % 16, tid, wid, lane);
    LAS float* scr = (LAS float*)(lds + 32768) + wid * (64 * 33);
    bf16_t* wgu = (bf16_t*)(a.ws + WS_WGU); bf16_t* wdn = (bf16_t*)(a.ws + WS_WDN);
    constexpr int I_G = (D / 64) * (DFF / 32);
    constexpr int I_D = (DFF / 64) * (D / 32);
    constexpr int PER_E = 2 * I_G + I_D, TOTAL = NE * PER_E;
    const int gw = (G - 1 - bid) * 8 + wid, NGW = G * 8;
    for (int it = gw; it < TOTAL; it += NGW) {
        const int e = it / PER_E; int r = it % PER_E;
        if (r < 2 * I_G) { const int up = r >= I_G; if (up) r -= I_G; const int nblk = DFF / 32, kb = r / nblk, nb = r % nblk, n0 = nb * 32;
            const float* W = (up ? a.w_up : a.w_gate) + (size_t)e * D * DFF;
            cvt_item(W, DFF, wgu + (size_t)e * 4096 * D, D, kb * 64, n0, (n0 >> 7) * 256 + (n0 & 127) + (up ? 128 : 0), scr, lane); }
        else { r -= 2 * I_G; const int nblk = D / 32, kb = r / nblk, nb = r % nblk;
            cvt_item(a.w_down + (size_t)e * DFF * D, D, wdn + (size_t)e * D * DFF, DFF, kb * 64, nb * 32, nb * 32, scr, lane); }
    }
    __syncthreads();
}

__device__ __forceinline__ void phase_final(const Args& a, int bid, int G, int wid, int lane) {
    const float* modf = (const float*)(a.ws + WS_MODF); const short* pos = (const short*)(a.ws + WS_POS); const bf16_t* ys = (const bf16_t*)(a.ws + WS_YS);
    for (int row = bid * 8 + wid; row < M; row += G * 8) {
        const int b = row / T; float* xrow = a.out + (size_t)row * D;
        f32x4 v[4], acc[4];
#pragma unroll
        for (int jj = 0; jj < 4; ++jj) { v[jj] = *((const f32x4*)xrow + lane + 64 * jj); acc[jj] = (f32x4){0.f, 0.f, 0.f, 0.f}; }
        const u32x4 p0 = *(const u32x4*)(pos + (size_t)row * 16), p1 = *(const u32x4*)(pos + (size_t)row * 16 + 8);
        const unsigned pw[8] = {p0.x, p0.y, p0.z, p0.w, p1.x, p1.y, p1.z, p1.w};
#pragma unroll
        for (int e = 0; e < 16; ++e) { const int sl = (int)(short)((e & 1) ? (pw[e >> 1] >> 16) : (pw[e >> 1] & 0xffffu));
            if (sl >= 0) { const bf16_t* yr = ys + ((size_t)e * 4096 + b * 512 + sl) * D;
#pragma unroll
                for (int jj = 0; jj < 4; ++jj) { const u32x2 w = *((const u32x2*)yr + lane + 64 * jj); acc[jj].x += bf_lo(w.x); acc[jj].y += bf_hi(w.x); acc[jj].z += bf_lo(w.y); acc[jj].w += bf_hi(w.y); } } }
        float ss = 0.f;
#pragma unroll
        for (int jj = 0; jj < 4; ++jj) { const f32x4 g2 = *((const f32x4*)(modf + (size_t)b * NMOD + 5 * D) + lane + 64 * jj); v[jj] = v[jj] + g2 * acc[jj];
            ss += (v[jj].x * v[jj].x + v[jj].y * v[jj].y) + (v[jj].z * v[jj].z + v[jj].w * v[jj].w); }
        const float rstd = rsqrtf(wave_sum(ss) * (1.f / D) + EPS);
#pragma unroll
        for (int jj = 0; jj < 4; ++jj) { const f32x4 nf = *((const f32x4*)a.norm_final + lane + 64 * jj); *((f32x4*)xrow + lane + 64 * jj) = v[jj] * rstd * nf; }
    }
}

__global__ void __launch_bounds__(512, 2) mega_fwd(Args a) {
    extern __shared__ __attribute__((aligned(16))) uchar lds_raw[];
    LAS uchar* lds = (LAS uchar*)lds_raw;
    cg::grid_group grid = cg::this_grid();
    const int tid = threadIdx.x, lane = tid & 63, wid = __builtin_amdgcn_readfirstlane(tid >> 6), bid = blockIdx.x, G = gridDim.x;
    const int lo = a.ph_lo, hi = a.ph_hi;
    uchar* ws = a.ws;
#define IN(k) (lo <= (k) && (k) < hi)
#define GSYNC() do { asm volatile("s_waitcnt vmcnt(0)" ::: "memory"); __syncthreads(); \
    if (threadIdx.x == 0) { __builtin_amdgcn_fence(__ATOMIC_RELEASE, "agent"); asm volatile("s_waitcnt vmcnt(0)" ::: "memory"); } \
    grid.sync(); __builtin_amdgcn_fence(__ATOMIC_ACQUIRE, "agent"); asm volatile("s_waitcnt vmcnt(0)" ::: "memory"); __syncthreads(); } while (0)
#define SEAM(k) do { if (IN(k) && IN((k) + 1)) { if ((k) == 0) { GSYNC(); xbar = xcd_barrier_post((unsigned*)(ws + WS_BAR), (volatile LAS unsigned*)(lds + (LDS_BYTES - 16))); } else xcd_barrier(xbar); } } while (0)
    XcdBarrier xbar; xbar.bar = (unsigned*)(ws + WS_BAR); xbar.x = 0; xbar.st = (volatile LAS unsigned*)(lds + (LDS_BYTES - 16));
    if (tid < 2) ((volatile LAS unsigned*)(lds + (LDS_BYTES - 16)))[tid] = 0u;
    if (bid == 0) { for (int i = tid; i < XCD_BAR_WORDS; i += 512) ((unsigned*)(ws + WS_BAR))[i] = 0u; }
    __syncthreads();
    if (IN(0)) phase_prep(a, lds, bid, G, tid, wid, lane);
    SEAM(0);
    if (IN(1)) phase_norm(a, lds, bid, G, tid, wid, lane);
    SEAM(1);
    if (IN(2)) {
        {
            pg8::Gemm g{(const bf16_t*)(ws + WS_HC), (const bf16_t*)(ws + WS_WIN) + (size_t)512 * D, D, 0, nullptr};
            pg8::GroupOrder S; S.init(MC / 256, 1536 / 256, 1, G, bid);
            pg8::EpiInproj E{nullptr, (bf16_t*)(ws + WS_CI), (float*)(ws + WS_CLF), (float*)(ws + WS_CLB), (const float*)(ws + WS_LB), 1};
            pg8::gemm_phase<pg8::EpiInproj, false>(lds, g, S, E);
        }
        {
            pg8::Gemm g{(const bf16_t*)(ws + WS_ACT), (const bf16_t*)(ws + WS_WIN), D, 0, nullptr};
            pg8::GroupOrder S; S.init(M / 256, NIN / 256, 1, G, bid);
            pg8::EpiInproj E{ws + WS_ZQ, nullptr, (float*)(ws + WS_LF), (float*)(ws + WS_LBW), (const float*)(ws + WS_LB), 0};
            pg8::gemm_phase<pg8::EpiInproj, false>(lds, g, S, E);
        }
    }
    SEAM(2);
    if (IN(3)) phase_gla_states(a, lds, bid, wid, lane);
    SEAM(3);
    if (IN(4)) phase_gla_out(a, lds, bid, wid, lane);
    SEAM(4);
    if (IN(5)) phase_mixfin(a, bid, G, wid, lane);
    SEAM(5);
    if (IN(6)) {
        pg8::Gemm g{(const bf16_t*)(ws + WS_ACT), (const bf16_t*)(ws + WS_WOUT), D, 0, nullptr};
        pg8::GroupOrder S; S.init(M / 256, D / 256, 1, G, bid);
        pg8::EpiOut E{a.x, a.out, (const float*)(ws + WS_MODF)};
        pg8::gemm_phase<pg8::EpiOut, false>(lds, g, S, E);
    }
    SEAM(6);
    if (IN(7)) phase_router(a, lds, bid, tid, wid, lane);
    SEAM(7);
    if (IN(8)) phase_topk_cvt(a, lds, bid, G, tid, wid, lane);
    SEAM(8);
    if (IN(9)) {
        pg8::Gemm g{(const bf16_t*)(ws + WS_ACT), (const bf16_t*)(ws + WS_WGU), D, (size_t)4096 * D * 2, (const int*)(ws + WS_SELTOK)};
        pg8::GroupOrder S; S.init(16, 16, NE, G, bid);
        pg8::EpiMoe1 E{(bf16_t*)(ws + WS_HID)};
        pg8::gemm_phase<pg8::EpiMoe1, true>(lds, g, S, E);
    }
    SEAM(9);
    if (IN(10)) {
        pg8::Gemm g{(const bf16_t*)(ws + WS_HID), (const bf16_t*)(ws + WS_WDN), DFF, (size_t)D * DFF * 2, nullptr};
        pg8::GroupOrder S; S.init(16, 4, NE, G, bid);
        pg8::EpiMoe2 E{(bf16_t*)(ws + WS_YS), (const float*)(ws + WS_SELGATE)};
        pg8::gemm_phase<pg8::EpiMoe2, false>(lds, g, S, E);
    }
    SEAM(10);
    if (IN(11)) phase_final(a, bid, G, wid, lane);

#ifdef DBG_DUMP
    GSYNC();
    {
        for (size_t i = (size_t)bid * 512 + tid; i < (size_t)M * D; i += (size_t)G * 512) { const size_t row = i / D; const int c = (int)(i % D); float v = 0.f;
            if (DBG_DUMP == 1) v = bf_lo(((const bf16_t*)(ws + WS_ACT))[i]);
            if (DBG_DUMP == 2) v = bf_lo(((const bf16_t*)(ws + (c < 512 ? WS_ZQ : WS_ZI)))[row * 512 + (c & 511)]);
            if (DBG_DUMP == 3) v = ((const float*)(ws + (c < 512 ? WS_LF : WS_LBW)))[row * 512 + (c & 511)];
            if (DBG_DUMP == 4) v = bf_lo(((const bf16_t*)(ws + (c < 512 ? WS_OF : WS_OB)))[row * 512 + (c & 511)]);
            if (DBG_DUMP == 5) v = bf_lo(((const bf16_t*)(ws + (c < 512 ? WS_ZG : WS_ZV)))[row * 512 + (c & 511)]);
            if (DBG_DUMP == 6) v = ((const float*)(ws + WS_S0))[i % (64 * 16384)];
            if (DBG_DUMP == 7) v = ((const float*)(ws + WS_MODF))[i % (9 * NMOD)];
            a.out[i] = v; }
    }
#endif
#undef IN
#undef SEAM
}

#ifndef N_LAUNCHES
#define N_LAUNCHES 1
#endif
extern "C" void kernel_launch(void* const* d_in, const int* in_sizes, int n_in, void* d_out, int out_size, void* d_ws, size_t ws_size, hipStream_t stream) {
    static int grid = 0;
    if (grid == 0) {
        if (n_in != 18 || out_size != M * D || ws_size < WS_END) { fprintf(stderr, "kernel_launch: unexpected shapes (n_in %d out %d ws %zu)\n", n_in, out_size, ws_size); grid = -1; return; }
        int dev = 0, cus = 0, per_cu = 0;
        (void)hipGetDevice(&dev); (void)hipDeviceGetAttribute(&cus, hipDeviceAttributeMultiprocessorCount, dev);
        (void)hipFuncSetAttribute((const void*)mega_fwd, hipFuncAttributeMaxDynamicSharedMemorySize, LDS_BYTES);
        (void)hipOccupancyMaxActiveBlocksPerMultiprocessor(&per_cu, (const void*)mega_fwd, 512, LDS_BYTES);
        if (per_cu < 1) { fprintf(stderr, "kernel_launch: occupancy query says %d blocks per CU\n", per_cu); grid = -1; return; }
        grid = 256;
        if (cus != 256) fprintf(stderr, "kernel_launch: note: %d CUs (built for 256)\n", cus);
    }
    if (grid < 0) return;
    Args a{};
    a.x = (const float*)d_in[0]; a.c = (const float*)d_in[1]; a.ctx = (const float*)d_in[2]; a.c_ctx = (const float*)d_in[3]; a.w_ada = (const float*)d_in[4]; a.b_ada = (const float*)d_in[5];
    a.norm_mix = (const float*)d_in[6]; a.norm_ffn = (const float*)d_in[7]; a.w_in = (const float*)d_in[8]; a.lb_logits = (const float*)d_in[9]; a.hg_norm = (const float*)d_in[10];
    a.conv_w = (const float*)d_in[11]; a.w_out = (const float*)d_in[12]; a.w_router = (const float*)d_in[13]; a.w_gate = (const float*)d_in[14]; a.w_up = (const float*)d_in[15];
    a.w_down = (const float*)d_in[16]; a.norm_final = (const float*)d_in[17]; a.out = (float*)d_out; a.ws = (uchar*)d_ws;
    if (N_LAUNCHES == 1) {
#ifndef DBG_HI
#define DBG_HI NPHASE
#endif
        a.ph_lo = 0; a.ph_hi = DBG_HI; void* args[] = {&a};
        hipError_t e = hipLaunchCooperativeKernel((const void*)mega_fwd, dim3(grid), dim3(512), args, LDS_BYTES, stream);
        if (e != hipSuccess) fprintf(stderr, "cooperative launch failed: %s\n", hipGetErrorString(e));
    } else {
        for (int p = 0; p < NPHASE; ++p) { a.ph_lo = p; a.ph_hi = p + 1; void* args[] = {&a};
            hipError_t e = hipLaunchCooperativeKernel((const void*)mega_fwd, dim3(grid), dim3(512), args, LDS_BYTES, stream);
            if (e != hipSuccess) { fprintf(stderr, "launch %d failed: %s\n", p, hipGetErrorString(e)); break; } }
    }
}
```

```cpp
#include <hip/hip_runtime.h>
#include <cstdio>

#define LAS __attribute__((address_space(3)))
#define GAS __attribute__((address_space(1)))
typedef unsigned short bf16_t;
typedef short bf16x8 __attribute__((ext_vector_type(8)));
typedef float f32x4 __attribute__((ext_vector_type(4)));
typedef float f32x2 __attribute__((ext_vector_type(2)));
typedef unsigned u32x4 __attribute__((ext_vector_type(4)));
typedef unsigned u32x2 __attribute__((ext_vector_type(2)));
typedef unsigned char uchar;

constexpr int D = 1024, NB = 8, T = 4096, M = NB * T, CT = 256, MC = NB * CT;
constexpr int NIN = 4096, HK = 512, NH = 4, NE = 16, CAP = 512, DFF = 2048, NMOD = 6 * D;
constexpr float EPS = 1e-6f;
constexpr int NPHASE = 12;

constexpr size_t MiB = 1u << 20;
constexpr size_t WS_ACT = 0;
constexpr size_t WS_WIN = 64 * MiB;
constexpr size_t WS_WOUT = 72 * MiB;
constexpr size_t WS_MODP = 74 * MiB;
constexpr size_t WS_MODF = 76 * MiB;
constexpr size_t WS_LB = 76 * MiB + 512 * 1024;
constexpr size_t WS_HC = 77 * MiB;
constexpr size_t WS_CLF = 81 * MiB;
constexpr size_t WS_CLB = 85 * MiB;
constexpr size_t WS_CI = 89 * MiB;
constexpr size_t WS_S0 = 91 * MiB;
constexpr size_t WS_AFF = 95 * MiB;
constexpr size_t WS_SELTOK = 97 * MiB;
constexpr size_t WS_SELGATE = 97 * MiB + 256 * 1024;
constexpr size_t WS_POS = 98 * MiB;
constexpr size_t WS_BAR = 100 * MiB;
constexpr size_t WS_SL = 488 * MiB;
constexpr size_t WS_DL = 500 * MiB;
constexpr size_t WS_ZQ = 104 * MiB;
constexpr size_t WS_LF = 136 * MiB;
constexpr size_t WS_LBW = 200 * MiB;
constexpr size_t WS_ZI = 264 * MiB;
constexpr size_t WS_ZG = 296 * MiB;
constexpr size_t WS_ZGB = 328 * MiB;
constexpr size_t WS_ZGC = 360 * MiB;
constexpr size_t WS_ZV = 392 * MiB;
constexpr size_t WS_OF = 424 * MiB;
constexpr size_t WS_OB = 456 * MiB;
constexpr size_t WS_WGU = 104 * MiB;
constexpr size_t WS_WDN = 232 * MiB;
constexpr size_t WS_HID = 296 * MiB;
constexpr size_t WS_YS = WS_WGU;
constexpr size_t WS_END = 552 * MiB;
static_assert(WS_ZI == WS_ZQ + 160 * MiB && WS_ZG == WS_ZI + 32 * MiB && WS_ZGB == WS_ZG + 32 * MiB && WS_ZGC == WS_ZGB + 32 * MiB && WS_ZV == WS_ZGC + 32 * MiB, "z segment map");

constexpr int LDS_BYTES = 147456;

typedef __bf16 bf16x2_t __attribute__((ext_vector_type(2)));
__device__ __forceinline__ unsigned cvt_pk_bf16_safe(float lo, float hi) { typedef float f2_t __attribute__((ext_vector_type(2))); const bf16x2_t v = __builtin_convertvector((f2_t){lo, hi}, bf16x2_t); return __builtin_bit_cast(unsigned, v); }
__device__ __forceinline__ unsigned cvt_pk_bf16(float lo, float hi) { unsigned r; asm volatile("v_cvt_pk_bf16_f32 %0, %1, %2" : "=v"(r) : "v"(lo), "v"(hi)); return r; }
__device__ __forceinline__ float bf_lo(unsigned u) { return __uint_as_float(u << 16); }
__device__ __forceinline__ float bf_hi(unsigned u) { return __uint_as_float(u & 0xffff0000u); }
__device__ __forceinline__ float wave_sum(float v) {
#pragma unroll
    for (int o = 1; o < 64; o <<= 1) v += __shfl_xor(v, o);
    return v;
}
__device__ __forceinline__ float silu_f(float x) { return x / (1.f + __expf(-x)); }
#define LDS_WAIT() asm volatile("s_waitcnt lgkmcnt(0)" ::: "memory")


#define XB_TMO      128
#define XB_XCNT(j)  (256  + 64 * (j))
#define XB_XSUB(j)  (1280 + 64 * (j))
#define XB_XGEN(j)  (2304 + 64 * (j))
#define XB_TOP      3328
#define XB_TOPGEN   3392
#define XCD_BAR_WORDS 3456
#define XB_SPIN_CAP (1u << 20)
__device__ __forceinline__ unsigned xb_ld(unsigned* p)              { return __hip_atomic_load(p, __ATOMIC_RELAXED, __HIP_MEMORY_SCOPE_AGENT); }
__device__ __forceinline__ unsigned xb_add(unsigned* p, unsigned v) { return __hip_atomic_fetch_add(p, v, __ATOMIC_RELAXED, __HIP_MEMORY_SCOPE_AGENT); }
__device__ __forceinline__ unsigned xb_xcc_id() { return (unsigned)__builtin_amdgcn_s_getreg((3 << 11) | 20) & 0xFu; }
#define XB_SPIN(cond, bar) do { unsigned _sp = 0; while (cond) { __builtin_amdgcn_s_sleep(1); \
    if ((++_sp & 255u) == 0u) { if (xb_ld(&(bar)[XB_TMO])) break; if (_sp > XB_SPIN_CAP) { atomicAdd(&(bar)[XB_TMO], 1u); break; } } } } while (0)
struct XcdBarrier { unsigned* bar; unsigned x; volatile LAS unsigned* st; };
__device__ __forceinline__ XcdBarrier xcd_barrier_post(unsigned* bar, volatile LAS unsigned* st) {
    XcdBarrier b; b.bar = bar; b.x = xb_xcc_id(); b.st = st;
    if (threadIdx.x == 0) (void)xb_add(&bar[XB_XCNT(b.x)], 1u);
    return b;
}
__device__ __forceinline__ void xcd_barrier_complete(unsigned* bar, unsigned x, unsigned& nloc, unsigned& nx) {
    const unsigned G = gridDim.x * gridDim.y * gridDim.z;
    unsigned sum, cnt, mine, sp = 0u;
    for (;;) {
        sum = 0u; cnt = 0u; mine = 0u;
#pragma unroll
        for (unsigned j = 0; j < 16; ++j) { const unsigned c = xb_ld(&bar[XB_XCNT(j)]); sum += c; cnt += (c > 0u) ? 1u : 0u; mine = (j == x) ? c : mine; }
        if (sum == G) break;
        __builtin_amdgcn_s_sleep(1);
        if ((++sp & 255u) == 0u) { if (xb_ld(&bar[XB_TMO])) break; if (sp > XB_SPIN_CAP) { atomicAdd(&bar[XB_TMO], 1u); break; } }
    }
    nloc = mine > 0u ? mine : 1u; nx = cnt > 0u ? cnt : 1u;
}
__device__ __forceinline__ void xcd_barrier(const XcdBarrier& b) {
    asm volatile("s_waitcnt vmcnt(0)" ::: "memory");
    __syncthreads();
    if (threadIdx.x == 0) {
        unsigned* bar = b.bar;
        __builtin_amdgcn_s_waitcnt(0);
        unsigned nloc = b.st[0], nx = b.st[1];
        if (nloc == 0u) { xcd_barrier_complete(bar, b.x, nloc, nx); b.st[0] = nloc; b.st[1] = nx; }
        const unsigned old = xb_add(&bar[XB_XSUB(b.x)], 1u);
        const unsigned gen = old / nloc;
        if (old + 1u == (gen + 1u) * nloc) {
            __builtin_amdgcn_fence(__ATOMIC_RELEASE, "agent");
            asm volatile("s_waitcnt vmcnt(0)" ::: "memory");
            const unsigned og = xb_add(&bar[XB_TOP], 1u);
            const unsigned tg = og / nx;
            if (og + 1u == (tg + 1u) * nx) xb_add(&bar[XB_TOPGEN], 1u);
            else XB_SPIN(xb_ld(&bar[XB_TOPGEN]) == tg, bar);
            __builtin_amdgcn_fence(__ATOMIC_ACQUIRE, "agent");
            xb_add(&bar[XB_XGEN(b.x)], 1u);
            asm volatile("s_waitcnt vmcnt(0)" ::: "memory");
        } else {
            XB_SPIN(xb_ld(&bar[XB_XGEN(b.x)]) == gen, bar);
            __builtin_amdgcn_fence(__ATOMIC_ACQUIRE, "agent");
            asm volatile("s_waitcnt vmcnt(0)" ::: "memory");
        }
    }
    __syncthreads();
}

namespace pg8 {
constexpr int BM = 256, BK = 64, HALF = 128, HTB = HALF * BK * 2, STAGE_BYTES = 8 * HTB, NXCD = 8, WGM = 8;
__device__ __forceinline__ int lds_byte(int r, int c) { const int st = (r >> 4) * 2 + (c >> 5), rr = r & 15, cc = c & 31, ob = rr * 64 + cc * 2; return st * 1024 + (ob ^ (((ob >> 9) & 1) << 5)); }
__device__ __forceinline__ void stage_rc(int b, int& R, int& C) { const int st = b / 1024, sb = b % 1024, swz = sb ^ (((sb >> 9) & 1) << 5); R = (st >> 1) * 16 + swz / 64; C = (st & 1) * 32 + (swz % 64) / 2; }
__device__ __forceinline__ int perm32(int rho) { const int n = rho >> 4, i = rho & 15; return 8 * (i >> 2) + 4 * n + (i & 3); }

struct Unit { int pm, pn, e; };
struct GroupOrder {
    int nM, nN, ng, G, c;
    __device__ __forceinline__ void init(int nM_, int nN_, int ng_, int G_, int c_) { nM = nM_; nN = nN_; ng = ng_; G = G_; c = c_; }
    __device__ __forceinline__ bool next(int i, Unit& u) const {
        const int nwg = nM * nN; const long L = (long)i * G + c; if (L >= (long)nwg * ng) return false;
        const int grp = (int)(L / nwg); int wgid = (int)(L % nwg);
        { const int q = nwg / NXCD, r = nwg % NXCD, xcd = wgid % NXCD, off = wgid / NXCD; wgid = (xcd < r ? xcd * (q + 1) : r * (q + 1) + (xcd - r) * q) + off; }
        const int nig = WGM * nN, gid = wgid / nig, fm = gid * WGM, gsz = (nM - fm) < WGM ? (nM - fm) : WGM;
        u.pm = grp * nM + fm + ((wgid % nig) % gsz); u.pn = (wgid % nig) / gsz; u.e = grp; return true;
    }
};
struct Gemm { const bf16_t* A; const bf16_t* Bt; int K; size_t bgs; const int* rowidx; };

template <class Epi, bool GATHER>
__device__ __forceinline__ void gemm_phase(LAS uchar* lds, const Gemm g, const GroupOrder& S, const Epi& E) {
    const int tid = threadIdx.x, wid = __builtin_amdgcn_readfirstlane(tid >> 6), lane = tid & 63, wr = wid >> 2, wc = wid & 3, fr = lane & 15, fq = lane >> 4;
    const int K = g.K, nt = K / BK;
    unsigned voffA[2], voffB[2]; int Rr[2], Cc[2];
#pragma unroll
    for (int i = 0; i < 2; ++i) { int R, C; stage_rc(tid * 16 + i * 8192, R, C); const int Rb = Epi::PERM ? ((R & ~31) + perm32(R & 31)) : R; Rr[i] = R; Cc[i] = C;
        voffA[i] = (unsigned)(R * K + C) * 2u; voffB[i] = (unsigned)(Rb * K + C) * 2u; }
    const size_t kstep = (size_t)(BK * 2);
    const size_t hstep = (size_t)HALF * K * 2;
    const size_t tstep = 2 * hstep;
    const unsigned ldsw = (unsigned)wid * 1024u;
    const int aoff = lds_byte(wr * 64 + fr, fq * 8), boff = lds_byte(wc * 32 + fr, fq * 8);
#define PG8_SA(b, h) (((b) * 2 + (h)) * HTB)
#define PG8_SB(b, h) ((4 + (b) * 2 + (h)) * HTB)
#define PG8_STAGE(bufoff, gbase, voff) do { _Pragma("unroll") for (int _i = 0; _i < 2; ++_i) \
        __builtin_amdgcn_global_load_lds((const unsigned*)((const char*)(gbase) + (voff)[_i]), (LAS unsigned*)(lds + (bufoff) + ldsw + _i * 8192), 16, 0, 0); } while (0)
#define PG8_STAGE_A(bufoff, p, ofs, h) do { if constexpr (GATHER) { PG8_STAGE(bufoff, p, (ofs)[h]); } else { PG8_STAGE(bufoff, (p) + (h) * hstep, voffA); } } while (0)
#define PG8_LDA(dst, b, h) do { _Pragma("unroll") for (int m = 0; m < 4; ++m) _Pragma("unroll") for (int k = 0; k < 2; ++k) dst[m][k] = *(const LAS bf16x8*)(lds + PG8_SA(b, h) + aoff + m * 2048 + k * 1024); } while (0)
#define PG8_LDB(dst, b, h) do { _Pragma("unroll") for (int n = 0; n < 2; ++n) _Pragma("unroll") for (int k = 0; k < 2; ++k) dst[n][k] = *(const LAS bf16x8*)(lds + PG8_SB(b, h) + boff + n * 2048 + k * 1024); } while (0)
#define PG8_MMA(ai, bj, At, Bt) do { __builtin_amdgcn_s_setprio(1); _Pragma("unroll") for (int m = 0; m < 4; ++m) _Pragma("unroll") for (int n = 0; n < 2; ++n) _Pragma("unroll") for (int k = 0; k < 2; ++k) \
        acc[ai][bj][m][n] = __builtin_amdgcn_mfma_f32_16x16x32_bf16(Bt[n][k], At[m][k], acc[ai][bj][m][n], 0, 0, 0); __builtin_amdgcn_s_setprio(0); } while (0)
#define PG8_WAIT_V(n) asm volatile("s_waitcnt vmcnt(" #n ")" ::: "memory")
#define PG8_WAIT_L(n) asm volatile("s_waitcnt lgkmcnt(" #n ")" ::: "memory")
#define PG8_BAR __builtin_amdgcn_s_barrier()
#define PG8_SCHED __builtin_amdgcn_sched_barrier(0)
    Unit cur, nxt; int ui = 0;
    if (!S.next(0, cur)) return;
    f32x4 acc[2][2][4][2];
#pragma unroll
    for (int a = 0; a < 2; ++a)
#pragma unroll
        for (int b = 0; b < 2; ++b)
#pragma unroll
            for (int m = 0; m < 4; ++m)
#pragma unroll
                for (int n = 0; n < 2; ++n) acc[a][b][m][n] = (f32x4){0.f, 0.f, 0.f, 0.f};
    bf16x8 At[4][2], B0[2][2], B1[2][2];
    unsigned cofs[2][2], nofs[2][2];
    if constexpr (GATHER) {
#pragma unroll
        for (int h = 0; h < 2; ++h)
#pragma unroll
            for (int i = 0; i < 2; ++i) { const int row = g.rowidx[cur.pm * BM + h * HALF + Rr[i]]; cofs[h][i] = (unsigned)(row * K + Cc[i]) * 2u; nofs[h][i] = cofs[h][i]; }
    }
    const char* cA = GATHER ? (const char*)g.A : (const char*)g.A + (size_t)cur.pm * tstep;
    const char* cB = (const char*)g.Bt + (size_t)cur.e * g.bgs + (size_t)cur.pn * tstep;
    PG8_STAGE(PG8_SB(0, 0), cB, voffB); PG8_STAGE(PG8_SB(0, 1), cB + hstep, voffB); PG8_STAGE_A(PG8_SA(0, 0), cA, cofs, 0); PG8_STAGE_A(PG8_SA(0, 1), cA, cofs, 1);
    if (wr == 1) PG8_BAR;
    PG8_WAIT_V(2); PG8_BAR;
    PG8_STAGE(PG8_SB(1, 0), cB + kstep, voffB); PG8_STAGE_A(PG8_SA(1, 0), cA + kstep, cofs, 0); PG8_STAGE(PG8_SB(1, 1), cB + hstep + kstep, voffB);
    PG8_WAIT_V(6); PG8_BAR;
    for (;;) {
        const bool has_next = S.next(ui + 1, nxt);
        const char* nA = GATHER ? (const char*)g.A : (has_next ? (const char*)g.A + (size_t)nxt.pm * tstep : cA);
        const char* nB = has_next ? (const char*)g.Bt + (size_t)nxt.e * g.bgs + (size_t)nxt.pn * tstep : cB;
        for (int t = 0; t < nt; t += 2) {
            const bool last = (t == nt - 2);
            const char* a1 = cA + (size_t)(t + 1) * kstep;
            const char* a2 = last ? nA : cA + (size_t)(t + 2) * kstep; const char* b2 = last ? nB : cB + (size_t)(t + 2) * kstep;
            const char* a3 = a2 + kstep; const char* b3 = b2 + kstep;
            if constexpr (GATHER) {
                if (last && has_next) {
#pragma unroll
                    for (int h = 0; h < 2; ++h)
#pragma unroll
                        for (int i = 0; i < 2; ++i) { const int row = g.rowidx[nxt.pm * BM + h * HALF + Rr[i]]; nofs[h][i] = (unsigned)(row * K + Cc[i]) * 2u; }
                }
            }
            PG8_LDB(B0, 0, 0); PG8_LDB(B1, 0, 1); PG8_SCHED; PG8_LDA(At, 0, 0); PG8_STAGE_A(PG8_SA(1, 1), a1, cofs, 1);
            PG8_WAIT_V(8); PG8_WAIT_L(0); PG8_BAR; PG8_MMA(0, 0, At, B0); PG8_MMA(0, 1, At, B1); PG8_BAR; PG8_SCHED;
            PG8_LDA(At, 0, 1); PG8_STAGE(PG8_SB(0, 0), b2, voffB); PG8_STAGE(PG8_SB(0, 1), b2 + hstep, voffB);
            if (last) { PG8_STAGE_A(PG8_SA(0, 0), a2, nofs, 0); } else { PG8_STAGE_A(PG8_SA(0, 0), a2, cofs, 0); }
            PG8_WAIT_V(8); PG8_WAIT_L(0); PG8_BAR; PG8_MMA(1, 0, At, B0); PG8_MMA(1, 1, At, B1); PG8_BAR; PG8_SCHED;
            PG8_LDB(B0, 1, 0); PG8_LDB(B1, 1, 1); PG8_SCHED; PG8_LDA(At, 1, 0);
            if (last) { PG8_STAGE_A(PG8_SA(0, 1), a2, nofs, 1); } else { PG8_STAGE_A(PG8_SA(0, 1), a2, cofs, 1); }
            PG8_WAIT_V(8); PG8_WAIT_L(0); PG8_BAR; PG8_MMA(0, 0, At, B0); PG8_MMA(0, 1, At, B1); PG8_BAR; PG8_SCHED;
            PG8_LDA(At, 1, 1); PG8_STAGE(PG8_SB(1, 0), b3, voffB); PG8_STAGE(PG8_SB(1, 1), b3 + hstep, voffB);
            if (last) { PG8_STAGE_A(PG8_SA(1, 0), a3, nofs, 0); } else { PG8_STAGE_A(PG8_SA(1, 0), a3, cofs, 0); }
            PG8_WAIT_V(8); PG8_WAIT_L(0); PG8_BAR; PG8_MMA(1, 0, At, B0); PG8_MMA(1, 1, At, B1); PG8_BAR; PG8_SCHED;
        }
        if (wr == 0) PG8_BAR;
        E(acc, cur, wr, wc, fr, fq);
        if (!has_next) break;
#pragma unroll
        for (int a = 0; a < 2; ++a)
#pragma unroll
            for (int b = 0; b < 2; ++b)
#pragma unroll
                for (int m = 0; m < 4; ++m)
#pragma unroll
                    for (int n = 0; n < 2; ++n) acc[a][b][m][n] = (f32x4){0.f, 0.f, 0.f, 0.f};
        cur = nxt; cA = nA; cB = nB; ++ui;
        if constexpr (GATHER) {
#pragma unroll
            for (int h = 0; h < 2; ++h)
#pragma unroll
                for (int i = 0; i < 2; ++i) cofs[h][i] = nofs[h][i];
        }
        if (wr == 1) PG8_BAR;
    }
    PG8_WAIT_V(0);
    PG8_BAR;
#undef PG8_SA
#undef PG8_SB
#undef PG8_STAGE
#undef PG8_STAGE_A
#undef PG8_LDA
#undef PG8_LDB
#undef PG8_MMA
#undef PG8_WAIT_V
#undef PG8_WAIT_L
#undef PG8_BAR
#undef PG8_SCHED
}


struct EpiInproj {
    static constexpr bool PERM = true;
    uchar* zbase; bf16_t* ci; float* olog0; float* olog1; const float* lb; int seg0;
    __device__ __forceinline__ void operator()(const f32x4 (&acc)[2][2][4][2], const Unit& u, int wr, int wc, int fr, int fq) const {
        const int seg = seg0 + (u.pn >> 1);
        const int row0 = u.pm * BM + wr * 64 + fr, col0 = (u.pn & 1) * 256 + wc * 32 + 8 * fq;
        if (seg == 1 || seg == 2) {
            float* O = (seg == 1) ? olog0 : olog1; const float* lbp = lb + (seg - 1) * 512;
#pragma unroll
            for (int bj = 0; bj < 2; ++bj) {
                const f32x4 l0 = *(const f32x4*)(lbp + col0 + bj * HALF), l1 = *(const f32x4*)(lbp + col0 + bj * HALF + 4);
#pragma unroll
                for (int ai = 0; ai < 2; ++ai)
#pragma unroll
                    for (int m = 0; m < 4; ++m) { float* rowp = O + (size_t)(row0 + ai * HALF + m * 16) * 512 + col0 + bj * HALF;
                        f32x4 v0 = acc[ai][bj][m][0], v1 = acc[ai][bj][m][1], o0, o1;
#pragma unroll
                        for (int j = 0; j < 4; ++j) { const float s0 = 1.f / (1.f + __expf(-v0[j])), s1 = 1.f / (1.f + __expf(-v1[j]));
                            o0[j] = __logf(l0[j] + (1.f - l0[j]) * s0); o1[j] = __logf(l1[j] + (1.f - l1[j]) * s1); }
                        *(f32x4*)rowp = o0; *(f32x4*)(rowp + 4) = o1; }
            }
        } else {
            bf16_t* O = zbase ? (bf16_t*)(zbase + (size_t)(32 * seg + (seg >= 3 ? 64 : 0)) * MiB) : ci;
#pragma unroll
            for (int ai = 0; ai < 2; ++ai)
#pragma unroll
                for (int m = 0; m < 4; ++m) { bf16_t* rowp = O + (size_t)(row0 + ai * HALF + m * 16) * 512 + col0;
#pragma unroll
                    for (int bj = 0; bj < 2; ++bj) { const f32x4 v0 = acc[ai][bj][m][0], v1 = acc[ai][bj][m][1];
                        u32x4 w; w.x = cvt_pk_bf16(v0[0], v0[1]); w.y = cvt_pk_bf16(v0[2], v0[3]); w.z = cvt_pk_bf16(v1[0], v1[1]); w.w = cvt_pk_bf16(v1[2], v1[3]);
                        *(u32x4*)(rowp + bj * HALF) = w; } }
        }
    }
};
struct EpiOut {
    static constexpr bool PERM = false;
    const float* x; float* x1; const float* modf;
    __device__ __forceinline__ void operator()(const f32x4 (&acc)[2][2][4][2], const Unit& u, int wr, int wc, int fr, int fq) const {
        const int row0 = u.pm * BM + wr * 64 + fr, col0 = u.pn * BM + wc * 32 + 4 * fq;
        const int b = (u.pm * BM) / T;
        const float* g1 = modf + (size_t)b * NMOD + 2 * D;
        f32x4 gv[2][2];
#pragma unroll
        for (int bj = 0; bj < 2; ++bj)
#pragma unroll
            for (int n = 0; n < 2; ++n) gv[bj][n] = *(const f32x4*)(g1 + col0 + bj * HALF + n * 16);
#pragma unroll
        for (int ai = 0; ai < 2; ++ai)
#pragma unroll
            for (int m = 0; m < 4; ++m) { const size_t off = (size_t)(row0 + ai * HALF + m * 16) * D + col0;
#pragma unroll
                for (int bj = 0; bj < 2; ++bj)
#pragma unroll
                    for (int n = 0; n < 2; ++n) { const f32x4 xs = *(const f32x4*)(x + off + bj * HALF + n * 16); *(f32x4*)(x1 + off + bj * HALF + n * 16) = xs + gv[bj][n] * acc[ai][bj][m][n]; }
                asm volatile("" ::: "memory"); }
    }
};
struct EpiMoe1 {
    static constexpr bool PERM = true;
    bf16_t* hid;
    __device__ __forceinline__ void operator()(const f32x4 (&acc)[2][2][4][2], const Unit& u, int wr, int wc, int fr, int fq) const {
        const int row0 = u.pm * BM + wr * 64 + fr, col0 = u.pn * 128 + wc * 32 + 8 * fq;
#pragma unroll
        for (int ai = 0; ai < 2; ++ai)
#pragma unroll
            for (int m = 0; m < 4; ++m) { bf16_t* rowp = hid + (size_t)(row0 + ai * HALF + m * 16) * DFF + col0;
                float o[8];
#pragma unroll
                for (int n = 0; n < 2; ++n)
#pragma unroll
                    for (int j = 0; j < 4; ++j) { const float gt = acc[ai][0][m][n][j], up = acc[ai][1][m][n][j]; o[n * 4 + j] = gt * up / (1.f + __expf(-gt)); }
                u32x4 w; w.x = cvt_pk_bf16(o[0], o[1]); w.y = cvt_pk_bf16(o[2], o[3]); w.z = cvt_pk_bf16(o[4], o[5]); w.w = cvt_pk_bf16(o[6], o[7]);
                *(u32x4*)rowp = w; }
    }
};
struct EpiMoe2 {
    static constexpr bool PERM = true;
    bf16_t* ys; const float* gate;
    __device__ __forceinline__ void operator()(const f32x4 (&acc)[2][2][4][2], const Unit& u, int wr, int wc, int fr, int fq) const {
        const int row0 = u.pm * BM + wr * 64 + fr, col0 = u.pn * BM + wc * 32 + 8 * fq;
#pragma unroll
        for (int ai = 0; ai < 2; ++ai)
#pragma unroll
            for (int m = 0; m < 4; ++m) { const int row = row0 + ai * HALF + m * 16; const float gt = gate[row]; bf16_t* rowp = ys + (size_t)row * D + col0;
#pragma unroll
                for (int bj = 0; bj < 2; ++bj) { const f32x4 v0 = acc[ai][bj][m][0] * gt, v1 = acc[ai][bj][m][1] * gt;
                    u32x4 w; w.x = cvt_pk_bf16(v0[0], v0[1]); w.y = cvt_pk_bf16(v0[2], v0[3]); w.z = cvt_pk_bf16(v1[0], v1[1]); w.w = cvt_pk_bf16(v1[2], v1[3]);
                    *(u32x4*)(rowp + bj * HALF) = w; } }
    }
};
}

struct Args {
    const float *x, *c, *ctx, *c_ctx, *w_ada, *b_ada, *norm_mix, *norm_ffn, *w_in, *lb_logits, *hg_norm, *conv_w, *w_out, *w_router, *w_gate, *w_up, *w_down, *norm_final;
    float* out; uchar* ws; int ph_lo, ph_hi;
};

__device__ __forceinline__ void cvt_item(const float* W, int ldw, bf16_t* WT, int ldt, int k0, int n0, int nrow0, LAS float* scr, int lane) {
#pragma unroll 8
    for (int i = 0; i < 32; ++i) { const int kk = 2 * i + (lane >> 5); scr[kk * 33 + (lane & 31)] = W[(size_t)(k0 + kk) * ldw + n0 + (lane & 31)]; }
    LDS_WAIT(); asm volatile("" ::: "memory");
    const int c = lane & 7;
#pragma unroll
    for (int j = 0; j < 4; ++j) { const int n = (lane >> 3) + 8 * j; const LAS float* s = scr + (8 * c) * 33 + n;
        u32x4 o; o.x = cvt_pk_bf16(s[0 * 33], s[1 * 33]); o.y = cvt_pk_bf16(s[2 * 33], s[3 * 33]); o.z = cvt_pk_bf16(s[4 * 33], s[5 * 33]); o.w = cvt_pk_bf16(s[6 * 33], s[7 * 33]);
        *(u32x4*)(WT + (size_t)(nrow0 + n) * ldt + k0 + 8 * c) = o; }
    LDS_WAIT(); asm volatile("" ::: "memory");
}

__device__ __forceinline__ void phase_prep(const Args& a, LAS uchar* lds, int bid, int G, int tid, int wid, int lane) {
    float* modp = (float*)(a.ws + WS_MODP);
    if (bid < 192) {
        const int cgp = bid % 24, ks = bid / 24, n0 = cgp * 256 + lane * 4, k0 = ks * 128 + wid * 16;
        f32x4 acc[9];
#pragma unroll
        for (int r = 0; r < 9; ++r) acc[r] = (f32x4){0.f, 0.f, 0.f, 0.f};
#pragma unroll 4
        for (int kk = 0; kk < 16; ++kk) { const int k = k0 + kk; const f32x4 w = *(const f32x4*)(a.w_ada + (size_t)k * NMOD + n0);
#pragma unroll
            for (int r = 0; r < 9; ++r) { const float cv = (r < 8) ? a.c[r * D + k] : a.c_ctx[k]; const float s = silu_f(cv); acc[r] += w * s; } }
        LAS f32x4* red = (LAS f32x4*)lds;
#pragma unroll
        for (int r = 0; r < 9; ++r) red[(wid * 9 + r) * 64 + lane] = acc[r];
        __syncthreads();
        for (int o = tid; o < 9 * 64; o += 512) { const int r = o / 64, l = o % 64; f32x4 s = red[(0 * 9 + r) * 64 + l];
#pragma unroll
            for (int w = 1; w < 8; ++w) s += red[(w * 9 + r) * 64 + l];
            if (ks == 0) s += *(const f32x4*)(a.b_ada + cgp * 256 + l * 4);
            *(f32x4*)(modp + ((size_t)ks * 9 + r) * NMOD + cgp * 256 + l * 4) = s; }
        __syncthreads();
    }
    if (bid == 255) {
        float* lb = (float*)(a.ws + WS_LB);
        for (int i = tid; i < 1024; i += 512) { const float l0 = a.lb_logits[i], l1 = a.lb_logits[1024 + i]; lb[i] = 1.f / (1.f + __expf(l1 - l0)); }
    }
    LAS float* scr = (LAS float*)lds + wid * (64 * 33);
    const int gw = (G - 1 - bid) * 8 + wid, NGW = G * 8;
    constexpr int I_IN = (D / 64) * (NIN / 32), I_OUT = (D / 64) * (D / 32);
    for (int it = gw; it < I_IN + I_OUT; it += NGW) {
        if (it < I_IN) { const int nblk = NIN / 32, kb = it / nblk, nb = it % nblk; cvt_item(a.w_in, NIN, (bf16_t*)(a.ws + WS_WIN), D, kb * 64, nb * 32, nb * 32, scr, lane); }
        else { const int r = it - I_IN, nblk = D / 32, kb = r / nblk, nb = r % nblk; cvt_item(a.w_out, D, (bf16_t*)(a.ws + WS_WOUT), D, kb * 64, nb * 32, nb * 32, scr, lane); }
    }
}

__device__ __forceinline__ float modp_sum(const float* modp, int r, int col) { float s = 0.f;
#pragma unroll
    for (int ks = 0; ks < 8; ++ks) s += modp[((size_t)ks * 9 + r) * NMOD + col];
    return s; }
__device__ __forceinline__ void norm_row(const float* xrow, bf16_t* orow, const LAS float* gm, const LAS float* sh, int lane) {
    f32x4 v[4]; float ss = 0.f;
#pragma unroll
    for (int j = 0; j < 4; ++j) { v[j] = *((const f32x4*)xrow + lane + 64 * j); ss += (v[j].x * v[j].x + v[j].y * v[j].y) + (v[j].z * v[j].z + v[j].w * v[j].w); }
    const float rstd = rsqrtf(wave_sum(ss) * (1.f / D) + EPS);
#pragma unroll
    for (int j = 0; j < 4; ++j) { const f32x4 g4 = *((const LAS f32x4*)gm + lane + 64 * j), s4 = *((const LAS f32x4*)sh + lane + 64 * j); const f32x4 o = v[j] * rstd * g4 + s4;
        u32x2 w; w.x = cvt_pk_bf16(o.x, o.y); w.y = cvt_pk_bf16(o.z, o.w); *((u32x2*)orow + lane + 64 * j) = w; }
}
__device__ __forceinline__ void phase_norm(const Args& a, LAS uchar* lds, int bid, int G, int tid, int wid, int lane) {
    const float* modp = (const float*)(a.ws + WS_MODP); float* modf = (float*)(a.ws + WS_MODF);
    { const int gt = bid * 512 + tid; if (gt < 9 * NMOD) modf[gt] = modp_sum(modp, gt / NMOD, gt % NMOD); }
    LAS float* gm = (LAS float*)lds; LAS float* sh = gm + D; LAS float* cgm = sh + D; LAS float* csh = cgm + D;
    const int b = bid / 32;
    for (int cidx = tid; cidx < D; cidx += 512) { const float nm = a.norm_mix[cidx];
        sh[cidx] = modp_sum(modp, b, cidx); gm[cidx] = nm * (1.f + modp_sum(modp, b, D + cidx));
        csh[cidx] = modp_sum(modp, 8, cidx); cgm[cidx] = nm * (1.f + modp_sum(modp, 8, D + cidx)); }
    __syncthreads();
    bf16_t* hx = (bf16_t*)(a.ws + WS_ACT); bf16_t* hc = (bf16_t*)(a.ws + WS_HC);
    for (int j = 0; j < 16; ++j) { const int row = bid * 128 + wid * 16 + j; norm_row(a.x + (size_t)row * D, hx + (size_t)row * D, gm, sh, lane); }
    { const int row = bid * 8 + wid; norm_row(a.ctx + (size_t)row * D, hc + (size_t)row * D, cgm, csh, lane); }
    __syncthreads();
}

constexpr int GL_QDP = 0, GL_KIP = 8704, GL_KETP = 17408, GL_VTP = 27648, GL_DEC = 37888, GL_TOT = 38400, GL_RING = 43008, GL_SLOT = 32768;
#define GLA_BAR() do { asm volatile("s_waitcnt lgkmcnt(0)" ::: "memory"); __builtin_amdgcn_s_barrier(); asm volatile("" ::: "memory"); } while (0)
template <bool FULL>
__device__ __forceinline__ void gla_item(LAS uchar* lds, const bf16_t* qb, const float* lfb, const bf16_t* vb, bf16_t* ob, f32x4 (&S)[8], float* dl_out,
                                         int row_base, int Tn, int tau0, int nch, int h, int dir, int wid, int lane) {
    const int fr = lane & 15, fq = lane >> 4;
#define GLA_ISSUE(c) do { LAS uchar* _sl = lds + GL_RING + ((c) % 3) * GL_SLOT + wid * 4096; \
        _Pragma("unroll") for (int _i = 0; _i < 2; ++_i) { const int _tau = tau0 + 32 * (c) + 4 * wid + 2 * _i + (lane >> 5); const size_t _row = (size_t)(row_base + (dir ? (Tn - 1 - _tau) : _tau)); \
            __builtin_amdgcn_global_load_lds((const unsigned*)(lfb + _row * 512 + h * 128 + (lane & 31) * 4), (LAS unsigned*)(_sl + _i * 1024), 16, 0, 0); } \
        { const int _tau = tau0 + 32 * (c) + 4 * wid + (lane >> 4); const size_t _row = (size_t)(row_base + (dir ? (Tn - 1 - _tau) : _tau)); \
            if (FULL) __builtin_amdgcn_global_load_lds((const unsigned*)(qb + _row * 512 + h * 128 + (lane & 15) * 8), (LAS unsigned*)(_sl + 2048), 16, 0, 0); \
            __builtin_amdgcn_global_load_lds((const unsigned*)(vb + _row * 512 + h * 128 + (lane & 15) * 8), (LAS unsigned*)(_sl + 3072), 16, 0, 0); } } while (0)
    GLA_ISSUE(0);
    if (nch > 1) GLA_ISSUE(1);
    const int d0 = 2 * lane, pos0 = (d0 & ~31) + 8 * ((d0 >> 2) & 3) + 4 * ((d0 >> 4) & 1) + (d0 & 3);
    const int spos = 8 * (wid & 3) + 4 * (wid >> 2);
    f32x2 dsum = (f32x2){0.f, 0.f};
    for (int n = 0; n < nch; ++n) {
        if (n + 1 < nch) { if (FULL) asm volatile("s_waitcnt vmcnt(4)" ::: "memory"); else asm volatile("s_waitcnt vmcnt(3)" ::: "memory"); }
        else asm volatile("s_waitcnt vmcnt(0)" ::: "memory");
        const LAS uchar* sl = lds + GL_RING + (n % 3) * GL_SLOT + wid * 4096;
        f32x2 lf[4];
#pragma unroll
        for (int rr = 0; rr < 4; ++rr) lf[rr] = *(const LAS f32x2*)(sl + rr * 512 + lane * 8);
        f32x2 c[4]; c[0] = lf[0]; c[1] = c[0] + lf[1]; c[2] = c[1] + lf[2]; c[3] = c[2] + lf[3];
        LAS f32x2* tot = (LAS f32x2*)(lds + GL_TOT);
        tot[wid * 64 + lane] = c[3];
        unsigned qv[4], vv[4];
#pragma unroll
        for (int rr = 0; rr < 4; ++rr) { vv[rr] = *(const LAS unsigned*)(sl + 3072 + rr * 256 + lane * 4); qv[rr] = FULL ? *(const LAS unsigned*)(sl + 2048 + rr * 256 + lane * 4) : 0u; }
        GLA_BAR();
        if (n + 2 < nch) GLA_ISSUE(n + 2);
        f32x2 pre = (f32x2){0.f, 0.f}, all = (f32x2){0.f, 0.f};
#pragma unroll
        for (int w = 0; w < 8; ++w) { const f32x2 tw = tot[w * 64 + lane]; all += tw; if (w < wid) pre += tw; }
        dsum += all;
        float kE0[4], kE1[4];
#pragma unroll
        for (int rr = 0; rr < 4; ++rr) {
            const f32x2 cum = pre + c[rr];
            const float k0 = 1.f - __expf(lf[rr].x), k1 = 1.f - __expf(lf[rr].y);
            kE0[rr] = k0 * __expf(all.x - cum.x); kE1[rr] = k1 * __expf(all.y - cum.y);
            if (FULL) { const int s = 4 * wid + rr; const float e0 = __expf(cum.x), e1 = __expf(cum.y);
                *(LAS unsigned*)(lds + GL_QDP + s * 272 + pos0 * 2) = cvt_pk_bf16(bf_lo(qv[rr]) * e0, bf_hi(qv[rr]) * e1);
                *(LAS unsigned*)(lds + GL_KIP + s * 272 + pos0 * 2) = cvt_pk_bf16(k0 * __expf(-cum.x), k1 * __expf(-cum.y)); }
        }
        { u32x2 w0, w1; w0.x = cvt_pk_bf16(kE0[0], kE0[1]); w0.y = cvt_pk_bf16(kE0[2], kE0[3]); w1.x = cvt_pk_bf16(kE1[0], kE1[1]); w1.y = cvt_pk_bf16(kE1[2], kE1[3]);
          *(LAS u32x2*)(lds + GL_KETP + (d0) * 80 + spos * 2) = w0; *(LAS u32x2*)(lds + GL_KETP + (d0 + 1) * 80 + spos * 2) = w1;
          u32x2 v0, v1; v0.x = (vv[0] & 0xffffu) | (vv[1] << 16); v0.y = (vv[2] & 0xffffu) | (vv[3] << 16);
          v1.x = (vv[0] >> 16) | (vv[1] & 0xffff0000u); v1.y = (vv[2] >> 16) | (vv[3] & 0xffff0000u);
          *(LAS u32x2*)(lds + GL_VTP + (d0) * 80 + spos * 2) = v0; *(LAS u32x2*)(lds + GL_VTP + (d0 + 1) * 80 + spos * 2) = v1; }
        if (wid == 0) *(LAS f32x2*)(lds + GL_DEC + lane * 8) = (f32x2){__expf(all.x), __expf(all.y)};
        GLA_BAR();
        const bf16x8 vt = *(const LAS bf16x8*)(lds + GL_VTP + (16 * wid + fr) * 80 + fq * 16);
        if (FULL) {
            bf16x8 qf[2][4];
#pragma unroll
            for (int ti = 0; ti < 2; ++ti)
#pragma unroll
                for (int kk = 0; kk < 4; ++kk) qf[ti][kk] = *(const LAS bf16x8*)(lds + GL_QDP + (16 * ti + fr) * 272 + kk * 64 + fq * 16);
            f32x4 oT[2] = {(f32x4){0.f, 0.f, 0.f, 0.f}, (f32x4){0.f, 0.f, 0.f, 0.f}};
            f32x4 p00 = (f32x4){0.f, 0.f, 0.f, 0.f}, p01 = p00, p11 = p00;
#pragma unroll
            for (int kk = 0; kk < 4; ++kk) {
                const bf16x8 kj0 = *(const LAS bf16x8*)(lds + GL_KIP + (fr) * 272 + kk * 64 + fq * 16);
                const bf16x8 kj1 = *(const LAS bf16x8*)(lds + GL_KIP + (16 + fr) * 272 + kk * 64 + fq * 16);
                p00 = __builtin_amdgcn_mfma_f32_16x16x32_bf16(kj0, qf[0][kk], p00, 0, 0, 0);
                p01 = __builtin_amdgcn_mfma_f32_16x16x32_bf16(kj0, qf[1][kk], p01, 0, 0, 0);
                p11 = __builtin_amdgcn_mfma_f32_16x16x32_bf16(kj1, qf[1][kk], p11, 0, 0, 0);
                u32x4 sa; sa.x = cvt_pk_bf16_safe(S[2 * kk][0], S[2 * kk][1]); sa.y = cvt_pk_bf16_safe(S[2 * kk][2], S[2 * kk][3]);
                sa.z = cvt_pk_bf16_safe(S[2 * kk + 1][0], S[2 * kk + 1][1]); sa.w = cvt_pk_bf16_safe(S[2 * kk + 1][2], S[2 * kk + 1][3]);
                const bf16x8 sA = __builtin_bit_cast(bf16x8, sa);
                oT[0] = __builtin_amdgcn_mfma_f32_16x16x32_bf16(sA, qf[0][kk], oT[0], 0, 0, 0);
                oT[1] = __builtin_amdgcn_mfma_f32_16x16x32_bf16(sA, qf[1][kk], oT[1], 0, 0, 0);
            }
            u32x4 pb0, pb1;
            { float m0[4], m1[4];
#pragma unroll
              for (int r = 0; r < 4; ++r) { const bool ok = (4 * fq + r) <= fr; m0[r] = ok ? p00[r] : 0.f; m1[r] = ok ? p11[r] : 0.f; }
              pb0.x = cvt_pk_bf16_safe(m0[0], m0[1]); pb0.y = cvt_pk_bf16_safe(m0[2], m0[3]); pb0.z = 0u; pb0.w = 0u;
              pb1.x = cvt_pk_bf16_safe(p01[0], p01[1]); pb1.y = cvt_pk_bf16_safe(p01[2], p01[3]); pb1.z = cvt_pk_bf16_safe(m1[0], m1[1]); pb1.w = cvt_pk_bf16_safe(m1[2], m1[3]); }
            oT[0] = __builtin_amdgcn_mfma_f32_16x16x32_bf16(vt, __builtin_bit_cast(bf16x8, pb0), oT[0], 0, 0, 0);
            oT[1] = __builtin_amdgcn_mfma_f32_16x16x32_bf16(vt, __builtin_bit_cast(bf16x8, pb1), oT[1], 0, 0, 0);
#pragma unroll
            for (int ti = 0; ti < 2; ++ti) { const int tau = tau0 + 32 * n + 16 * ti + fr; const size_t row = (size_t)(row_base + (dir ? (Tn - 1 - tau) : tau));
                u32x2 w; w.x = cvt_pk_bf16_safe(oT[ti][0], oT[ti][1]); w.y = cvt_pk_bf16_safe(oT[ti][2], oT[ti][3]);
                *(u32x2*)(ob + row * 512 + h * 128 + 16 * wid + 4 * fq) = w; }
        }
#pragma unroll
        for (int t8 = 0; t8 < 8; ++t8) {
            const f32x4 dc = *(const LAS f32x4*)(lds + GL_DEC + (16 * t8 + 4 * fq) * 4);
            const bf16x8 ka = *(const LAS bf16x8*)(lds + GL_KETP + (16 * t8 + fr) * 80 + fq * 16);
            S[t8] = __builtin_amdgcn_mfma_f32_16x16x32_bf16(ka, vt, S[t8] * dc, 0, 0, 0);
        }
    }
#undef GLA_ISSUE
    if (dl_out && wid == 0) *(f32x2*)(dl_out + 2 * lane) = dsum;
    asm volatile("s_waitcnt vmcnt(0)" ::: "memory");
    GLA_BAR();
}
__device__ __forceinline__ void gla_state_store(float* p, const f32x4 (&S)[8], int wid, int fr, int fq) {
#pragma unroll
    for (int t8 = 0; t8 < 8; ++t8)
#pragma unroll
        for (int r = 0; r < 4; ++r) p[(size_t)(16 * t8 + 4 * fq + r) * 128 + 16 * wid + fr] = S[t8][r];
}
__device__ __forceinline__ void phase_gla_states(const Args& a, LAS uchar* lds, int bid, int wid, int lane) {
    uchar* ws = a.ws; const int fr = lane & 15, fq = lane >> 4;
    f32x4 S[8];
#pragma unroll
    for (int t8 = 0; t8 < 8; ++t8) S[t8] = (f32x4){0.f, 0.f, 0.f, 0.f};
    if (bid < 192) { const int bhd = bid / 3, seg = bid % 3, b = bhd >> 3, h = (bhd >> 1) & 3, dir = bhd & 1;
        gla_item<false>(lds, nullptr, (const float*)(ws + (dir ? WS_LBW : WS_LF)), (const bf16_t*)(ws + WS_ZI), nullptr, S, (float*)(ws + WS_DL) + (size_t)bid * 128,
                        b * T, T, seg * 1024, 32, h, dir, wid, lane);
        gla_state_store((float*)(ws + WS_SL) + (size_t)bid * 16384, S, wid, fr, fq);
    } else { const int bhd = bid - 192, b = bhd >> 3, h = (bhd >> 1) & 3, dir = bhd & 1;
        gla_item<false>(lds, nullptr, (const float*)(ws + (dir ? WS_CLB : WS_CLF)), (const bf16_t*)(ws + WS_CI), nullptr, S, nullptr, b * CT, CT, 0, CT / 32, h, dir, wid, lane);
        gla_state_store((float*)(ws + WS_S0) + (size_t)bhd * 16384, S, wid, fr, fq);
    }
}
__device__ __forceinline__ void phase_gla_out(const Args& a, LAS uchar* lds, int bid, int wid, int lane) {
    uchar* ws = a.ws; const int fr = lane & 15, fq = lane >> 4;
    const int bhd = bid >> 2, seg = bid & 3, b = bhd >> 3, h = (bhd >> 1) & 3, dir = bhd & 1;
    f32x4 S[8];
    { const float* p = (const float*)(ws + WS_S0) + (size_t)bhd * 16384;
#pragma unroll
      for (int t8 = 0; t8 < 8; ++t8)
#pragma unroll
          for (int r = 0; r < 4; ++r) S[t8][r] = p[(size_t)(16 * t8 + 4 * fq + r) * 128 + 16 * wid + fr]; }
    for (int j = 0; j < seg; ++j) { const float* p = (const float*)(ws + WS_SL) + (size_t)(bhd * 3 + j) * 16384; const float* dl = (const float*)(ws + WS_DL) + (size_t)(bhd * 3 + j) * 128;
#pragma unroll
        for (int t8 = 0; t8 < 8; ++t8) { const f32x4 dv = *(const f32x4*)(dl + 16 * t8 + 4 * fq);
#pragma unroll
            for (int r = 0; r < 4; ++r) S[t8][r] = __expf(dv[r]) * S[t8][r] + p[(size_t)(16 * t8 + 4 * fq + r) * 128 + 16 * wid + fr]; } }
    asm volatile("s_waitcnt vmcnt(0)" ::: "memory");
    gla_item<true>(lds, (const bf16_t*)(ws + WS_ZQ), (const float*)(ws + (dir ? WS_LBW : WS_LF)), (const bf16_t*)(ws + WS_ZI), (bf16_t*)(ws + (dir ? WS_OB : WS_OF)), S, nullptr,
                   b * T, T, seg * 1024, 32, h, dir, wid, lane);
}

__device__ __forceinline__ void unpack8(const u32x4 w, float (&f)[8]) { f[0] = bf_lo(w.x); f[1] = bf_hi(w.x); f[2] = bf_lo(w.y); f[3] = bf_hi(w.y); f[4] = bf_lo(w.z); f[5] = bf_hi(w.z); f[6] = bf_lo(w.w); f[7] = bf_hi(w.w); }
__device__ __forceinline__ void phase_mixfin(const Args& a, int bid, int G, int wid, int lane) {
    const bf16_t* of = (const bf16_t*)(a.ws + WS_OF); const bf16_t* obw = (const bf16_t*)(a.ws + WS_OB); const bf16_t* zg = (const bf16_t*)(a.ws + WS_ZG);
    const bf16_t* zgb = (const bf16_t*)(a.ws + WS_ZGB); const bf16_t* zgc = (const bf16_t*)(a.ws + WS_ZGC); const bf16_t* zv = (const bf16_t*)(a.ws + WS_ZV);
    bf16_t* A2 = (bf16_t*)(a.ws + WS_ACT);
    const int c0 = 8 * lane;
    float gain[8], cw0[8], cw1[8], cw2[8];
#pragma unroll
    for (int j = 0; j < 8; ++j) { gain[j] = a.hg_norm[(c0 + j) & 127]; cw0[j] = a.conv_w[c0 + j]; cw1[j] = a.conv_w[512 + c0 + j]; cw2[j] = a.conv_w[1024 + c0 + j]; }
    for (int row = bid * 8 + wid; row < M; row += G * 8) {
        const size_t ro = (size_t)row * 512 + c0;
        float f0[8], f1[8], gg[8], o[8];
        unpack8(*(const u32x4*)(of + ro), f0); unpack8(*(const u32x4*)(obw + ro), f1); unpack8(*(const u32x4*)(zg + ro), gg);
        float ss = 0.f;
#pragma unroll
        for (int j = 0; j < 8; ++j) { o[j] = f0[j] + f1[j]; ss += o[j] * o[j]; }
        ss += __shfl_xor(ss, 1); ss += __shfl_xor(ss, 2); ss += __shfl_xor(ss, 4); ss += __shfl_xor(ss, 8);
        const float rstd = rsqrtf(ss * (1.f / 128.f) + EPS);
#pragma unroll
        for (int j = 0; j < 8; ++j) o[j] = o[j] * rstd * gain[j] * silu_f(gg[j]);
        u32x4 w; w.x = cvt_pk_bf16(o[0], o[1]); w.y = cvt_pk_bf16(o[2], o[3]); w.z = cvt_pk_bf16(o[4], o[5]); w.w = cvt_pk_bf16(o[6], o[7]);
        *(u32x4*)(A2 + (size_t)row * D + c0) = w;
        const int tw = row & 63;
        float gcm[8], vm[8], gc0[8], v0[8], gcp[8], vp[8], gb[8], y[8];
        unpack8(*(const u32x4*)(zgc + ro), gc0); unpack8(*(const u32x4*)(zv + ro), v0); unpack8(*(const u32x4*)(zgb + ro), gb);
        if (tw > 0) { unpack8(*(const u32x4*)(zgc + ro - 512), gcm); unpack8(*(const u32x4*)(zv + ro - 512), vm); }
        else {
#pragma unroll
            for (int j = 0; j < 8; ++j) { gcm[j] = 0.f; vm[j] = 0.f; } }
        if (tw < 63) { unpack8(*(const u32x4*)(zgc + ro + 512), gcp); unpack8(*(const u32x4*)(zv + ro + 512), vp); }
        else {
#pragma unroll
            for (int j = 0; j < 8; ++j) { gcp[j] = 0.f; vp[j] = 0.f; } }
#pragma unroll
        for (int j = 0; j < 8; ++j) y[j] = gb[j] * (cw0[j] * (gcm[j] * vm[j]) + cw1[j] * (gc0[j] * v0[j]) + cw2[j] * (gcp[j] * vp[j]));
        w.x = cvt_pk_bf16(y[0], y[1]); w.y = cvt_pk_bf16(y[2], y[3]); w.z = cvt_pk_bf16(y[4], y[5]); w.w = cvt_pk_bf16(y[6], y[7]);
        *(u32x4*)(A2 + (size_t)row * D + 512 + c0) = w;
    }
}

__device__ __forceinline__ void phase_router(const Args& a, LAS uchar* lds, int bid, int tid, int wid, int lane) {
    const float* modf = (const float*)(a.ws + WS_MODF);
    LAS float* gm = (LAS float*)lds; LAS float* sh = gm + D;
    LAS uchar* wrl = lds + 8192;
    const int b = bid / 32;
    for (int cidx = tid; cidx < D; cidx += 512) { sh[cidx] = modf[(size_t)b * NMOD + 3 * D + cidx]; gm[cidx] = a.norm_ffn[cidx] * (1.f + modf[(size_t)b * NMOD + 4 * D + cidx]); }
    for (int i = tid; i < D * 4; i += 512) { const int col = i >> 2, q4 = i & 3; *(LAS f32x4*)(wrl + col * 64 + (col >> 2) * 16 + q4 * 16) = *(const f32x4*)(a.w_router + col * 16 + q4 * 4); }
    __syncthreads();
    bf16_t* hx2 = (bf16_t*)(a.ws + WS_ACT); float* aff = (float*)(a.ws + WS_AFF);
    for (int j = 0; j < 16; ++j) {
        const int row = bid * 128 + wid * 16 + j; const float* xrow = a.out + (size_t)row * D;
        f32x4 v[4]; float ss = 0.f;
#pragma unroll
        for (int jj = 0; jj < 4; ++jj) { v[jj] = *((const f32x4*)xrow + lane + 64 * jj); ss += (v[jj].x * v[jj].x + v[jj].y * v[jj].y) + (v[jj].z * v[jj].z + v[jj].w * v[jj].w); }
        const float rstd = rsqrtf(wave_sum(ss) * (1.f / D) + EPS);
        float pl[16];
#pragma unroll
        for (int e = 0; e < 16; ++e) pl[e] = 0.f;
#pragma unroll
        for (int jj = 0; jj < 4; ++jj) { const f32x4 g4 = *((const LAS f32x4*)gm + lane + 64 * jj), s4 = *((const LAS f32x4*)sh + lane + 64 * jj); const f32x4 hv = v[jj] * rstd * g4 + s4;
            u32x2 w; w.x = cvt_pk_bf16(hv.x, hv.y); w.y = cvt_pk_bf16(hv.z, hv.w); *((u32x2*)(hx2 + (size_t)row * D) + lane + 64 * jj) = w;
            const int colb = 4 * lane + 256 * jj;
#pragma unroll
            for (int cc = 0; cc < 4; ++cc) { const int col = colb + cc; const LAS uchar* wp = wrl + col * 64 + (col >> 2) * 16; const float hvv = hv[cc];
#pragma unroll
                for (int q4 = 0; q4 < 4; ++q4) { const f32x4 w4 = *(const LAS f32x4*)(wp + q4 * 16); pl[q4 * 4 + 0] += hvv * w4.x; pl[q4 * 4 + 1] += hvv * w4.y; pl[q4 * 4 + 2] += hvv * w4.z; pl[q4 * 4 + 3] += hvv * w4.w; } } }
#pragma unroll
        for (int e = 0; e < 16; ++e) pl[e] = wave_sum(pl[e]);
        float mx = pl[0];
#pragma unroll
        for (int e = 1; e < 16; ++e) mx = fmaxf(mx, pl[e]);
        float den = 0.f;
#pragma unroll
        for (int e = 0; e < 16; ++e) { pl[e] = __expf(pl[e] - mx); den += pl[e]; }
        const float inv = 1.f / den; float mine = 0.f;
#pragma unroll
        for (int e = 0; e < 16; ++e) mine = (lane == e) ? pl[e] * inv : mine;
        const int t = row & (T - 1);
        if (lane < 16) aff[((size_t)b * NE + lane) * T + t] = mine;
    }
    __syncthreads();
}

__device__ __forceinline__ void topk_item(const Args& a, LAS uchar* lds, int b, int e, int tid, int wid, int lane) {
    LAS unsigned* key = (LAS unsigned*)lds;
    LAS unsigned* hist = key + 4096;
    LAS unsigned* ctl = hist + 256;
    LAS unsigned* wsum = ctl + 8;
    const float* affp = (const float*)(a.ws + WS_AFF) + ((size_t)b * NE + e) * T;
    unsigned kv[8];
    { const u32x4 k0 = *(const u32x4*)(affp + tid * 8), k1 = *(const u32x4*)(affp + tid * 8 + 4); kv[0] = k0.x; kv[1] = k0.y; kv[2] = k0.z; kv[3] = k0.w; kv[4] = k1.x; kv[5] = k1.y; kv[6] = k1.z; kv[7] = k1.w; }
    unsigned prefix = 0u, mask = 0u, need = CAP;
    for (int shift = 24; shift >= 0; shift -= 8) {
        if (tid < 256) hist[tid] = 0u;
        __syncthreads();
#pragma unroll
        for (int j = 0; j < 8; ++j) if ((kv[j] & mask) == prefix) __hip_atomic_fetch_add(&hist[(kv[j] >> shift) & 255u], 1u, __ATOMIC_RELAXED, __HIP_MEMORY_SCOPE_WORKGROUP);
        __syncthreads();
        if (tid < 256) { unsigned above = 0u; for (int bb = tid + 1; bb < 256; ++bb) above += hist[bb]; const unsigned mine = hist[tid];
            if (above < need && need <= above + mine) { ctl[0] = (unsigned)tid; ctl[1] = need - above; } }
        __syncthreads();
        prefix |= ctl[0] << shift; mask |= 255u << shift; need = ctl[1];
        __syncthreads();
    }
    unsigned cg_ = 0u, ce_ = 0u;
#pragma unroll
    for (int j = 0; j < 8; ++j) { cg_ += kv[j] > prefix; ce_ += kv[j] == prefix; }
    unsigned pk = cg_ | (ce_ << 16), incl = pk;
#pragma unroll
    for (int o = 1; o < 64; o <<= 1) { const unsigned t2 = __shfl_up(incl, o); if (lane >= o) incl += t2; }
    if (lane == 63) wsum[wid] = incl;
    __syncthreads();
    unsigned base = 0u;
    for (int w = 0; w < wid; ++w) base += wsum[w];
    unsigned excl = base + incl - pk; unsigned ng = excl & 0xffffu, neq = excl >> 16;
    int* seltok = (int*)(a.ws + WS_SELTOK); float* selgate = (float*)(a.ws + WS_SELGATE); short* pos = (short*)(a.ws + WS_POS);
#pragma unroll
    for (int j = 0; j < 8; ++j) { const int t = tid * 8 + j; const bool gt = kv[j] > prefix, eq = kv[j] == prefix; const bool sel = gt || (eq && neq < need);
        int slot = -1;
        if (sel) slot = (int)(ng + (neq < need ? neq : need));
        if (sel) { seltok[e * 4096 + b * 512 + slot] = b * T + t; selgate[e * 4096 + b * 512 + slot] = __uint_as_float(kv[j]); }
        pos[((size_t)b * T + t) * 16 + e] = (short)slot;
        ng += gt; neq += eq; }
    __syncthreads();
}
__device__ __forceinline__ void phase_topk_cvt(const Args& a, LAS uchar* lds, int bid, int G, int tid, int wid, int lane) {
    if (bid < 128) topk_item(a, lds, bid / 16, bid % 16, tid, wid, lane);
    LAS float* scr = (LAS float*)(lds + 32768) + wid * (64 * 33);
    bf16_t* wgu = (bf16_t*)(a.ws + WS_WGU); bf16_t* wdn = (bf16_t*)(a.ws + WS_WDN);
    constexpr int I_G = (D / 64) * (DFF / 32);
    constexpr int I_D = (DFF / 64) * (D / 32);
    constexpr int PER_E = 2 * I_G + I_D, TOTAL = NE * PER_E;
    const int gw = (G - 1 - bid) * 8 + wid, NGW = G * 8;
    for (int it = gw; it < TOTAL; it += NGW) {
        const int e = it / PER_E; int r = it % PER_E;
        if (r < 2 * I_G) { const int up = r >= I_G; if (up) r -= I_G; const int nblk = DFF / 32, kb = r / nblk, nb = r % nblk, n0 = nb * 32;
            const float* W = (up ? a.w_up : a.w_gate) + (size_t)e * D * DFF;
            cvt_item(W, DFF, wgu + (size_t)e * 4096 * D, D, kb * 64, n0, (n0 >> 7) * 256 + (n0 & 127) + (up ? 128 : 0), scr, lane); }
        else { r -= 2 * I_G; const int nblk = D / 32, kb = r / nblk, nb = r % nblk;
            cvt_item(a.w_down + (size_t)e * DFF * D, D, wdn + (size_t)e * D * DFF, DFF, kb * 64, nb * 32, nb * 32, scr, lane); }
    }
    __syncthreads();
}

__device__ __forceinline__ void phase_final(const Args& a, int bid, int G, int wid, int lane) {
    const float* modf = (const float*)(a.ws + WS_MODF); const short* pos = (const short*)(a.ws + WS_POS); const bf16_t* ys = (const bf16_t*)(a.ws + WS_YS);
    for (int row = bid * 8 + wid; row < M; row += G * 8) {
        const int b = row / T; float* xrow = a.out + (size_t)row * D;
        f32x4 v[4], acc[4];
#pragma unroll
        for (int jj = 0; jj < 4; ++jj) { v[jj] = *((const f32x4*)xrow + lane + 64 * jj); acc[jj] = (f32x4){0.f, 0.f, 0.f, 0.f}; }
        const u32x4 p0 = *(const u32x4*)(pos + (size_t)row * 16), p1 = *(const u32x4*)(pos + (size_t)row * 16 + 8);
        const unsigned pw[8] = {p0.x, p0.y, p0.z, p0.w, p1.x, p1.y, p1.z, p1.w};
#pragma unroll
        for (int e = 0; e < 16; ++e) { const int sl = (int)(short)((e & 1) ? (pw[e >> 1] >> 16) : (pw[e >> 1] & 0xffffu));
            if (sl >= 0) { const bf16_t* yr = ys + ((size_t)e * 4096 + b * 512 + sl) * D;
#pragma unroll
                for (int jj = 0; jj < 4; ++jj) { const u32x2 w = *((const u32x2*)yr + lane + 64 * jj); acc[jj].x += bf_lo(w.x); acc[jj].y += bf_hi(w.x); acc[jj].z += bf_lo(w.y); acc[jj].w += bf_hi(w.y); } } }
        float ss = 0.f;
#pragma unroll
        for (int jj = 0; jj < 4; ++jj) { const f32x4 g2 = *((const f32x4*)(modf + (size_t)b * NMOD + 5 * D) + lane + 64 * jj); v[jj] = v[jj] + g2 * acc[jj];
            ss += (v[jj].x * v[jj].x + v[jj].y * v[jj].y) + (v[jj].z * v[jj].z + v[jj].w * v[jj].w); }
        const float rstd = rsqrtf(wave_sum(ss) * (1.f / D) + EPS);
#pragma unroll
        for (int jj = 0; jj < 4; ++jj) { const f32x4 nf = *((const f32x4*)a.norm_final + lane + 64 * jj); *((f32x4*)xrow + lane + 64 * jj) = v[jj] * rstd * nf; }
    }
}

__global__ void __launch_bounds__(512, 2) mega_fwd(Args a) {
    extern __shared__ __attribute__((aligned(16))) uchar lds_raw[];
    LAS uchar* lds = (LAS uchar*)lds_raw;
    const int tid = threadIdx.x, lane = tid & 63, wid = __builtin_amdgcn_readfirstlane(tid >> 6), bid = blockIdx.x, G = gridDim.x;
    const int lo = a.ph_lo, hi = a.ph_hi;
    uchar* ws = a.ws;
#define IN(k) (lo <= (k) && (k) < hi)
#define SEAM(k) do { if (IN(k) && IN((k) + 1)) xcd_barrier(xbar); } while (0)
    if (tid < 2) ((volatile LAS unsigned*)(lds + (LDS_BYTES - 16)))[tid] = 0u;
    __syncthreads();
    XcdBarrier xbar = xcd_barrier_post((unsigned*)(ws + WS_BAR), (volatile LAS unsigned*)(lds + (LDS_BYTES - 16)));
    if (IN(0)) phase_prep(a, lds, bid, G, tid, wid, lane);
    SEAM(0);
    if (IN(1)) phase_norm(a, lds, bid, G, tid, wid, lane);
    SEAM(1);
    if (IN(2)) {
        {
            pg8::Gemm g{(const bf16_t*)(ws + WS_HC), (const bf16_t*)(ws + WS_WIN) + (size_t)512 * D, D, 0, nullptr};
            pg8::GroupOrder S; S.init(MC / 256, 1536 / 256, 1, G, bid);
            pg8::EpiInproj E{nullptr, (bf16_t*)(ws + WS_CI), (float*)(ws + WS_CLF), (float*)(ws + WS_CLB), (const float*)(ws + WS_LB), 1};
            pg8::gemm_phase<pg8::EpiInproj, false>(lds, g, S, E);
        }
        {
            pg8::Gemm g{(const bf16_t*)(ws + WS_ACT), (const bf16_t*)(ws + WS_WIN), D, 0, nullptr};
            pg8::GroupOrder S; S.init(M / 256, NIN / 256, 1, G, bid);
            pg8::EpiInproj E{ws + WS_ZQ, nullptr, (float*)(ws + WS_LF), (float*)(ws + WS_LBW), (const float*)(ws + WS_LB), 0};
            pg8::gemm_phase<pg8::EpiInproj, false>(lds, g, S, E);
        }
    }
    SEAM(2);
    if (IN(3)) phase_gla_states(a, lds, bid, wid, lane);
    SEAM(3);
    if (IN(4)) phase_gla_out(a, lds, bid, wid, lane);
    SEAM(4);
    if (IN(5)) phase_mixfin(a, bid, G, wid, lane);
    SEAM(5);
    if (IN(6)) {
        pg8::Gemm g{(const bf16_t*)(ws + WS_ACT), (const bf16_t*)(ws + WS_WOUT), D, 0, nullptr};
        pg8::GroupOrder S; S.init(M / 256, D / 256, 1, G, bid);
        pg8::EpiOut E{a.x, a.out, (const float*)(ws + WS_MODF)};
        pg8::gemm_phase<pg8::EpiOut, false>(lds, g, S, E);
    }
    SEAM(6);
    if (IN(7)) phase_router(a, lds, bid, tid, wid, lane);
    SEAM(7);
    if (IN(8)) phase_topk_cvt(a, lds, bid, G, tid, wid, lane);
    SEAM(8);
    if (IN(9)) {
        pg8::Gemm g{(const bf16_t*)(ws + WS_ACT), (const bf16_t*)(ws + WS_WGU), D, (size_t)4096 * D * 2, (const int*)(ws + WS_SELTOK)};
        pg8::GroupOrder S; S.init(16, 16, NE, G, bid);
        pg8::EpiMoe1 E{(bf16_t*)(ws + WS_HID)};
        pg8::gemm_phase<pg8::EpiMoe1, true>(lds, g, S, E);
    }
    SEAM(9);
    if (IN(10)) {
        pg8::Gemm g{(const bf16_t*)(ws + WS_HID), (const bf16_t*)(ws + WS_WDN), DFF, (size_t)D * DFF * 2, nullptr};
        pg8::GroupOrder S; S.init(16, 4, NE, G, bid);
        pg8::EpiMoe2 E{(bf16_t*)(ws + WS_YS), (const float*)(ws + WS_SELGATE)};
        pg8::gemm_phase<pg8::EpiMoe2, false>(lds, g, S, E);
    }
    SEAM(10);
    if (IN(11)) phase_final(a, bid, G, wid, lane);

#undef IN
#undef SEAM
}

#ifndef N_LAUNCHES
#define N_LAUNCHES 1
#endif
extern "C" void kernel_launch(void* const* d_in, const int* in_sizes, int n_in, void* d_out, int out_size, void* d_ws, size_t ws_size, hipStream_t stream) {
    static int grid = 0;
    if (grid == 0) {
        if (n_in != 18 || out_size != M * D || ws_size < WS_END) { fprintf(stderr, "kernel_launch: unexpected shapes (n_in %d out %d ws %zu)\n", n_in, out_size, ws_size); grid = -1; return; }
        int dev = 0, cus = 0, per_cu = 0;
        (void)hipGetDevice(&dev); (void)hipDeviceGetAttribute(&cus, hipDeviceAttributeMultiprocessorCount, dev);
        (void)hipFuncSetAttribute((const void*)mega_fwd, hipFuncAttributeMaxDynamicSharedMemorySize, LDS_BYTES);
        (void)hipOccupancyMaxActiveBlocksPerMultiprocessor(&per_cu, (const void*)mega_fwd, 512, LDS_BYTES);
        if (per_cu < 1) { fprintf(stderr, "kernel_launch: occupancy query says %d blocks per CU\n", per_cu); grid = -1; return; }
        grid = 256;
        if (cus != 256) fprintf(stderr, "kernel_launch: note: %d CUs (built for 256)\n", cus);
    }
    if (grid < 0) return;
    Args a{};
    a.x = (const float*)d_in[0]; a.c = (const float*)d_in[1]; a.ctx = (const float*)d_in[2]; a.c_ctx = (const float*)d_in[3]; a.w_ada = (const float*)d_in[4]; a.b_ada = (const float*)d_in[5];
    a.norm_mix = (const float*)d_in[6]; a.norm_ffn = (const float*)d_in[7]; a.w_in = (const float*)d_in[8]; a.lb_logits = (const float*)d_in[9]; a.hg_norm = (const float*)d_in[10];
    a.conv_w = (const float*)d_in[11]; a.w_out = (const float*)d_in[12]; a.w_router = (const float*)d_in[13]; a.w_gate = (const float*)d_in[14]; a.w_up = (const float*)d_in[15];
    a.w_down = (const float*)d_in[16]; a.norm_final = (const float*)d_in[17]; a.out = (float*)d_out; a.ws = (uchar*)d_ws;
    if (N_LAUNCHES == 1) {
        (void)hipMemsetAsync((char*)d_ws + WS_BAR, 0, 16384, stream);
        a.ph_lo = 0; a.ph_hi = NPHASE;
        hipLaunchKernelGGL(mega_fwd, dim3(grid), dim3(512), LDS_BYTES, stream, a);
    } else {
        for (int p = 0; p < NPHASE; ++p) { a.ph_lo = p; a.ph_hi = p + 1; void* args[] = {&a};
            hipError_t e = hipLaunchCooperativeKernel((const void*)mega_fwd, dim3(grid), dim3(512), args, LDS_BYTES, stream);
            if (e != hipSuccess) { fprintf(stderr, "launch %d failed: %s\n", p, hipGetErrorString(e)); break; } }
    }
}
```

```cpp
#include <hip/hip_runtime.h>
#include <cstdio>

#define LAS __attribute__((address_space(3)))
#define GAS __attribute__((address_space(1)))
typedef unsigned short bf16_t;
typedef short bf16x8 __attribute__((ext_vector_type(8)));
typedef float f32x4 __attribute__((ext_vector_type(4)));
typedef float f32x2 __attribute__((ext_vector_type(2)));
typedef unsigned u32x4 __attribute__((ext_vector_type(4)));
typedef unsigned u32x2 __attribute__((ext_vector_type(2)));
typedef unsigned char uchar;

constexpr int D = 1024, NB = 8, T = 4096, M = NB * T, CT = 256, MC = NB * CT;
constexpr int NIN = 4096, HK = 512, NH = 4, NE = 16, CAP = 512, DFF = 2048, NMOD = 6 * D;
constexpr float EPS = 1e-6f;
constexpr int NPHASE = 12;

constexpr size_t MiB = 1u << 20;
constexpr size_t WS_ACT = 0;
constexpr size_t WS_WIN = 64 * MiB;
constexpr size_t WS_WOUT = 72 * MiB;
constexpr size_t WS_MODP = 74 * MiB;
constexpr size_t WS_MODF = 76 * MiB;
constexpr size_t WS_LB = 76 * MiB + 512 * 1024;
constexpr size_t WS_HC = 77 * MiB;
constexpr size_t WS_CLF = 81 * MiB;
constexpr size_t WS_CLB = 85 * MiB;
constexpr size_t WS_CI = 89 * MiB;
constexpr size_t WS_S0 = 91 * MiB;
constexpr size_t WS_AFF = 95 * MiB;
constexpr size_t WS_SELTOK = 97 * MiB;
constexpr size_t WS_SELGATE = 97 * MiB + 256 * 1024;
constexpr size_t WS_POS = 98 * MiB;
constexpr size_t WS_BAR = 100 * MiB;
constexpr size_t WS_SL = 488 * MiB;
constexpr size_t WS_DL = 500 * MiB;
constexpr size_t WS_ZQ = 104 * MiB;
constexpr size_t WS_LF = 136 * MiB;
constexpr size_t WS_LBW = 200 * MiB;
constexpr size_t WS_ZI = 264 * MiB;
constexpr size_t WS_ZG = 296 * MiB;
constexpr size_t WS_ZGB = 328 * MiB;
constexpr size_t WS_ZGC = 360 * MiB;
constexpr size_t WS_ZV = 392 * MiB;
constexpr size_t WS_OF = 424 * MiB;
constexpr size_t WS_OB = 456 * MiB;
constexpr size_t WS_WGU = 104 * MiB;
constexpr size_t WS_WDN = 232 * MiB;
constexpr size_t WS_HID = 296 * MiB;
constexpr size_t WS_YS = WS_WGU;
constexpr size_t WS_END = 552 * MiB;
static_assert(WS_ZI == WS_ZQ + 160 * MiB && WS_ZG == WS_ZI + 32 * MiB && WS_ZGB == WS_ZG + 32 * MiB && WS_ZGC == WS_ZGB + 32 * MiB && WS_ZV == WS_ZGC + 32 * MiB, "z segment map");

constexpr int LDS_BYTES = 147456;

typedef __bf16 bf16x2_t __attribute__((ext_vector_type(2)));
__device__ __forceinline__ unsigned cvt_pk_bf16_safe(float lo, float hi) { typedef float f2_t __attribute__((ext_vector_type(2))); const bf16x2_t v = __builtin_convertvector((f2_t){lo, hi}, bf16x2_t); return __builtin_bit_cast(unsigned, v); }
__device__ __forceinline__ unsigned cvt_pk_bf16(float lo, float hi) { unsigned r; asm volatile("v_cvt_pk_bf16_f32 %0, %1, %2" : "=v"(r) : "v"(lo), "v"(hi)); return r; }
__device__ __forceinline__ float bf_lo(unsigned u) { return __uint_as_float(u << 16); }
__device__ __forceinline__ float bf_hi(unsigned u) { return __uint_as_float(u & 0xffff0000u); }
__device__ __forceinline__ float wave_sum(float v) {
#pragma unroll
    for (int o = 1; o < 64; o <<= 1) v += __shfl_xor(v, o);
    return v;
}
__device__ __forceinline__ float silu_f(float x) { return x / (1.f + __expf(-x)); }
#define LDS_WAIT() asm volatile("s_waitcnt lgkmcnt(0)" ::: "memory")


#define XB_TMO      128
#define XB_XCNT(j)  (256  + 64 * (j))
#define XB_XSUB(j)  (1280 + 64 * (j))
#define XB_XGEN(j)  (2304 + 64 * (j))
#define XB_TOP      3328
#define XB_TOPGEN   3392
#define XCD_BAR_WORDS 3456
#define XB_SPIN_CAP (1u << 20)
__device__ __forceinline__ unsigned xb_ld(unsigned* p)              { return __hip_atomic_load(p, __ATOMIC_RELAXED, __HIP_MEMORY_SCOPE_AGENT); }
__device__ __forceinline__ unsigned xb_add(unsigned* p, unsigned v) { return __hip_atomic_fetch_add(p, v, __ATOMIC_RELAXED, __HIP_MEMORY_SCOPE_AGENT); }
__device__ __forceinline__ unsigned xb_xcc_id() { return (unsigned)__builtin_amdgcn_s_getreg((3 << 11) | 20) & 0xFu; }
#define XB_SPIN(cond, bar) do { unsigned _sp = 0; while (cond) { __builtin_amdgcn_s_sleep(1); \
    if ((++_sp & 255u) == 0u) { if (xb_ld(&(bar)[XB_TMO])) break; if (_sp > XB_SPIN_CAP) { atomicAdd(&(bar)[XB_TMO], 1u); break; } } } } while (0)
struct XcdBarrier { unsigned* bar; unsigned x; volatile LAS unsigned* st; };
__device__ __forceinline__ XcdBarrier xcd_barrier_post(unsigned* bar, volatile LAS unsigned* st) {
    XcdBarrier b; b.bar = bar; b.x = xb_xcc_id(); b.st = st;
    if (threadIdx.x == 0) (void)xb_add(&bar[XB_XCNT(b.x)], 1u);
    return b;
}
__device__ __forceinline__ void xcd_barrier_complete(unsigned* bar, unsigned x, unsigned& nloc, unsigned& nx) {
    const unsigned G = gridDim.x * gridDim.y * gridDim.z;
    unsigned sum, cnt, mine, sp = 0u;
    for (;;) {
        sum = 0u; cnt = 0u; mine = 0u;
#pragma unroll
        for (unsigned j = 0; j < 16; ++j) { const unsigned c = xb_ld(&bar[XB_XCNT(j)]); sum += c; cnt += (c > 0u) ? 1u : 0u; mine = (j == x) ? c : mine; }
        if (sum == G) break;
        __builtin_amdgcn_s_sleep(1);
        if ((++sp & 255u) == 0u) { if (xb_ld(&bar[XB_TMO])) break; if (sp > XB_SPIN_CAP) { atomicAdd(&bar[XB_TMO], 1u); break; } }
    }
    nloc = mine > 0u ? mine : 1u; nx = cnt > 0u ? cnt : 1u;
}
__device__ __forceinline__ void xcd_barrier(const XcdBarrier& b) {
    asm volatile("s_waitcnt vmcnt(0)" ::: "memory");
    __syncthreads();
    if (threadIdx.x == 0) {
        unsigned* bar = b.bar;
        __builtin_amdgcn_s_waitcnt(0);
        unsigned nloc = b.st[0], nx = b.st[1];
        if (nloc == 0u) { xcd_barrier_complete(bar, b.x, nloc, nx); b.st[0] = nloc; b.st[1] = nx; }
        const unsigned old = xb_add(&bar[XB_XSUB(b.x)], 1u);
        const unsigned gen = old / nloc;
        if (old + 1u == (gen + 1u) * nloc) {
            __builtin_amdgcn_fence(__ATOMIC_RELEASE, "agent");
            asm volatile("s_waitcnt vmcnt(0)" ::: "memory");
            const unsigned og = xb_add(&bar[XB_TOP], 1u);
            const unsigned tg = og / nx;
            if (og + 1u == (tg + 1u) * nx) xb_add(&bar[XB_TOPGEN], 1u);
            else XB_SPIN(xb_ld(&bar[XB_TOPGEN]) == tg, bar);
            __builtin_amdgcn_fence(__ATOMIC_ACQUIRE, "agent");
            xb_add(&bar[XB_XGEN(b.x)], 1u);
            asm volatile("s_waitcnt vmcnt(0)" ::: "memory");
        } else {
            XB_SPIN(xb_ld(&bar[XB_XGEN(b.x)]) == gen, bar);
            __builtin_amdgcn_fence(__ATOMIC_ACQUIRE, "agent");
            asm volatile("s_waitcnt vmcnt(0)" ::: "memory");
        }
    }
    __syncthreads();
}

namespace pg8 {
constexpr int BM = 256, BK = 64, HALF = 128, HTB = HALF * BK * 2, STAGE_BYTES = 8 * HTB, NXCD = 8, WGM = 8;
__device__ __forceinline__ int lds_byte(int r, int c) { const int st = (r >> 4) * 2 + (c >> 5), rr = r & 15, cc = c & 31, ob = rr * 64 + cc * 2; return st * 1024 + (ob ^ (((ob >> 9) & 1) << 5)); }
__device__ __forceinline__ void stage_rc(int b, int& R, int& C) { const int st = b / 1024, sb = b % 1024, swz = sb ^ (((sb >> 9) & 1) << 5); R = (st >> 1) * 16 + swz / 64; C = (st & 1) * 32 + (swz % 64) / 2; }
__device__ __forceinline__ int perm32(int rho) { const int n = rho >> 4, i = rho & 15; return 8 * (i >> 2) + 4 * n + (i & 3); }

struct Unit { int pm, pn, e; };
struct GroupOrder {
    int nM, nN, ng, G, c;
    __device__ __forceinline__ void init(int nM_, int nN_, int ng_, int G_, int c_) { nM = nM_; nN = nN_; ng = ng_; G = G_; c = c_; }
    __device__ __forceinline__ bool next(int i, Unit& u) const {
        const int nwg = nM * nN; const long L = (long)i * G + c; if (L >= (long)nwg * ng) return false;
        const int grp = (int)(L / nwg); int wgid = (int)(L % nwg);
        { const int q = nwg / NXCD, r = nwg % NXCD, xcd = wgid % NXCD, off = wgid / NXCD; wgid = (xcd < r ? xcd * (q + 1) : r * (q + 1) + (xcd - r) * q) + off; }
        const int nig = WGM * nN, gid = wgid / nig, fm = gid * WGM, gsz = (nM - fm) < WGM ? (nM - fm) : WGM;
        u.pm = grp * nM + fm + ((wgid % nig) % gsz); u.pn = (wgid % nig) / gsz; u.e = grp; return true;
    }
};
struct Gemm { const bf16_t* A; const bf16_t* Bt; int K; size_t bgs; const int* rowidx; };

template <class Epi, bool GATHER>
__device__ __forceinline__ void gemm_phase(LAS uchar* lds, const Gemm g, const GroupOrder& S, const Epi& E) {
    const int tid = threadIdx.x, wid = __builtin_amdgcn_readfirstlane(tid >> 6), lane = tid & 63, wr = wid >> 2, wc = wid & 3, fr = lane & 15, fq = lane >> 4;
    const int K = g.K, nt = K / BK;
    unsigned voffA[2], voffB[2]; int Rr[2], Cc[2];
#pragma unroll
    for (int i = 0; i < 2; ++i) { int R, C; stage_rc(tid * 16 + i * 8192, R, C); const int Rb = Epi::PERM ? ((R & ~31) + perm32(R & 31)) : R; Rr[i] = R; Cc[i] = C;
        voffA[i] = (unsigned)(R * K + C) * 2u; voffB[i] = (unsigned)(Rb * K + C) * 2u; }
    const size_t kstep = (size_t)(BK * 2);
    const size_t hstep = (size_t)HALF * K * 2;
    const size_t tstep = 2 * hstep;
    const unsigned ldsw = (unsigned)wid * 1024u;
    const int aoff = lds_byte(wr * 64 + fr, fq * 8), boff = lds_byte(wc * 32 + fr, fq * 8);
#define PG8_SA(b, h) (((b) * 2 + (h)) * HTB)
#define PG8_SB(b, h) ((4 + (b) * 2 + (h)) * HTB)
#define PG8_STAGE(bufoff, gbase, voff) do { _Pragma("unroll") for (int _i = 0; _i < 2; ++_i) \
        __builtin_amdgcn_global_load_lds((const unsigned*)((const char*)(gbase) + (voff)[_i]), (LAS unsigned*)(lds + (bufoff) + ldsw + _i * 8192), 16, 0, 0); } while (0)
#define PG8_STAGE_A(bufoff, p, ofs, h) do { if constexpr (GATHER) { PG8_STAGE(bufoff, p, (ofs)[h]); } else { PG8_STAGE(bufoff, (p) + (h) * hstep, voffA); } } while (0)
#define PG8_LDA(dst, b, h) do { _Pragma("unroll") for (int m = 0; m < 4; ++m) _Pragma("unroll") for (int k = 0; k < 2; ++k) dst[m][k] = *(const LAS bf16x8*)(lds + PG8_SA(b, h) + aoff + m * 2048 + k * 1024); } while (0)
#define PG8_LDB(dst, b, h) do { _Pragma("unroll") for (int n = 0; n < 2; ++n) _Pragma("unroll") for (int k = 0; k < 2; ++k) dst[n][k] = *(const LAS bf16x8*)(lds + PG8_SB(b, h) + boff + n * 2048 + k * 1024); } while (0)
#define PG8_MMA(ai, bj, At, Bt) do { __builtin_amdgcn_s_setprio(1); _Pragma("unroll") for (int m = 0; m < 4; ++m) _Pragma("unroll") for (int n = 0; n < 2; ++n) _Pragma("unroll") for (int k = 0; k < 2; ++k) \
        acc[ai][bj][m][n] = __builtin_amdgcn_mfma_f32_16x16x32_bf16(Bt[n][k], At[m][k], acc[ai][bj][m][n], 0, 0, 0); __builtin_amdgcn_s_setprio(0); } while (0)
#define PG8_WAIT_V(n) asm volatile("s_waitcnt vmcnt(" #n ")" ::: "memory")
#define PG8_WAIT_L(n) asm volatile("s_waitcnt lgkmcnt(" #n ")" ::: "memory")
#define PG8_BAR __builtin_amdgcn_s_barrier()
#define PG8_SCHED __builtin_amdgcn_sched_barrier(0)
    Unit cur, nxt; int ui = 0;
    if (!S.next(0, cur)) return;
    f32x4 acc[2][2][4][2];
#pragma unroll
    for (int a = 0; a < 2; ++a)
#pragma unroll
        for (int b = 0; b < 2; ++b)
#pragma unroll
            for (int m = 0; m < 4; ++m)
#pragma unroll
                for (int n = 0; n < 2; ++n) acc[a][b][m][n] = (f32x4){0.f, 0.f, 0.f, 0.f};
    bf16x8 At[4][2], B0[2][2], B1[2][2];
    unsigned cofs[2][2], nofs[2][2];
    if constexpr (GATHER) {
#pragma unroll
        for (int h = 0; h < 2; ++h)
#pragma unroll
            for (int i = 0; i < 2; ++i) { const int row = g.rowidx[cur.pm * BM + h * HALF + Rr[i]]; cofs[h][i] = (unsigned)(row * K + Cc[i]) * 2u; nofs[h][i] = cofs[h][i]; }
    }
    const char* cA = GATHER ? (const char*)g.A : (const char*)g.A + (size_t)cur.pm * tstep;
    const char* cB = (const char*)g.Bt + (size_t)cur.e * g.bgs + (size_t)cur.pn * tstep;
    PG8_STAGE(PG8_SB(0, 0), cB, voffB); PG8_STAGE(PG8_SB(0, 1), cB + hstep, voffB); PG8_STAGE_A(PG8_SA(0, 0), cA, cofs, 0); PG8_STAGE_A(PG8_SA(0, 1), cA, cofs, 1);
    if (wr == 1) PG8_BAR;
    PG8_WAIT_V(2); PG8_BAR;
    PG8_STAGE(PG8_SB(1, 0), cB + kstep, voffB); PG8_STAGE_A(PG8_SA(1, 0), cA + kstep, cofs, 0); PG8_STAGE(PG8_SB(1, 1), cB + hstep + kstep, voffB);
    PG8_WAIT_V(6); PG8_BAR;
    for (;;) {
        const bool has_next = S.next(ui + 1, nxt);
        const char* nA = GATHER ? (const char*)g.A : (has_next ? (const char*)g.A + (size_t)nxt.pm * tstep : cA);
        const char* nB = has_next ? (const char*)g.Bt + (size_t)nxt.e * g.bgs + (size_t)nxt.pn * tstep : cB;
        for (int t = 0; t < nt; t += 2) {
            const bool last = (t == nt - 2);
            const char* a1 = cA + (size_t)(t + 1) * kstep;
            const char* a2 = last ? nA : cA + (size_t)(t + 2) * kstep; const char* b2 = last ? nB : cB + (size_t)(t + 2) * kstep;
            const char* a3 = a2 + kstep; const char* b3 = b2 + kstep;
            if constexpr (GATHER) {
                if (last && has_next) {
#pragma unroll
                    for (int h = 0; h < 2; ++h)
#pragma unroll
                        for (int i = 0; i < 2; ++i) { const int row = g.rowidx[nxt.pm * BM + h * HALF + Rr[i]]; nofs[h][i] = (unsigned)(row * K + Cc[i]) * 2u; }
                }
            }
            PG8_LDB(B0, 0, 0); PG8_LDB(B1, 0, 1); PG8_SCHED; PG8_LDA(At, 0, 0); PG8_STAGE_A(PG8_SA(1, 1), a1, cofs, 1);
            PG8_WAIT_V(8); PG8_WAIT_L(0); PG8_BAR; PG8_MMA(0, 0, At, B0); PG8_MMA(0, 1, At, B1); PG8_BAR; PG8_SCHED;
            PG8_LDA(At, 0, 1); PG8_STAGE(PG8_SB(0, 0), b2, voffB); PG8_STAGE(PG8_SB(0, 1), b2 + hstep, voffB);
            if (last) { PG8_STAGE_A(PG8_SA(0, 0), a2, nofs, 0); } else { PG8_STAGE_A(PG8_SA(0, 0), a2, cofs, 0); }
            PG8_WAIT_V(8); PG8_WAIT_L(0); PG8_BAR; PG8_MMA(1, 0, At, B0); PG8_MMA(1, 1, At, B1); PG8_BAR; PG8_SCHED;
            PG8_LDB(B0, 1, 0); PG8_LDB(B1, 1, 1); PG8_SCHED; PG8_LDA(At, 1, 0);
            if (last) { PG8_STAGE_A(PG8_SA(0, 1), a2, nofs, 1); } else { PG8_STAGE_A(PG8_SA(0, 1), a2, cofs, 1); }
            PG8_WAIT_V(8); PG8_WAIT_L(0); PG8_BAR; PG8_MMA(0, 0, At, B0); PG8_MMA(0, 1, At, B1); PG8_BAR; PG8_SCHED;
            PG8_LDA(At, 1, 1); PG8_STAGE(PG8_SB(1, 0), b3, voffB); PG8_STAGE(PG8_SB(1, 1), b3 + hstep, voffB);
            if (last) { PG8_STAGE_A(PG8_SA(1, 0), a3, nofs, 0); } else { PG8_STAGE_A(PG8_SA(1, 0), a3, cofs, 0); }
            PG8_WAIT_V(8); PG8_WAIT_L(0); PG8_BAR; PG8_MMA(1, 0, At, B0); PG8_MMA(1, 1, At, B1); PG8_BAR; PG8_SCHED;
        }
        if (wr == 0) PG8_BAR;
        E(acc, cur, wr, wc, fr, fq);
        if (!has_next) break;
#pragma unroll
        for (int a = 0; a < 2; ++a)
#pragma unroll
            for (int b = 0; b < 2; ++b)
#pragma unroll
                for (int m = 0; m < 4; ++m)
#pragma unroll
                    for (int n = 0; n < 2; ++n) acc[a][b][m][n] = (f32x4){0.f, 0.f, 0.f, 0.f};
        cur = nxt; cA = nA; cB = nB; ++ui;
        if constexpr (GATHER) {
#pragma unroll
            for (int h = 0; h < 2; ++h)
#pragma unroll
                for (int i = 0; i < 2; ++i) cofs[h][i] = nofs[h][i];
        }
        if (wr == 1) PG8_BAR;
    }
    PG8_WAIT_V(0);
    PG8_BAR;
#undef PG8_SA
#undef PG8_SB
#undef PG8_STAGE
#undef PG8_STAGE_A
#undef PG8_LDA
#undef PG8_LDB
#undef PG8_MMA
#undef PG8_WAIT_V
#undef PG8_WAIT_L
#undef PG8_BAR
#undef PG8_SCHED
}


struct EpiInproj {
    static constexpr bool PERM = true;
    uchar* zbase; bf16_t* ci; _Float16* olog0; _Float16* olog1; const float* lb; int seg0; int Tn;
    __device__ __forceinline__ void operator()(const f32x4 (&acc)[2][2][4][2], const Unit& u, int wr, int wc, int fr, int fq) const {
        const int seg = seg0 + (u.pn >> 1);
        const int row0 = u.pm * BM + wr * 64 + fr;
        if (seg <= 3) {
            const int b = (u.pm * BM) / Tn, t0 = row0 - b * Tn, dcol = wc * 32 + 8 * fq;
#pragma unroll
            for (int bj = 0; bj < 2; ++bj) { const int hh = (u.pn & 1) * 2 + bj; const size_t plane = (size_t)(b * NH + hh) * Tn;
                if (seg == 1 || seg == 2) {
                    _Float16* O = (seg == 1) ? olog0 : olog1; const float* lbp = lb + (seg - 1) * 512 + hh * 128 + dcol;
                    const f32x4 l0 = *(const f32x4*)lbp, l1 = *(const f32x4*)(lbp + 4);
#pragma unroll
                    for (int ai = 0; ai < 2; ++ai)
#pragma unroll
                        for (int m = 0; m < 4; ++m) { const f32x4 v0 = acc[ai][bj][m][0], v1 = acc[ai][bj][m][1]; _Float16 o[8];
#pragma unroll
                            for (int j = 0; j < 4; ++j) { const float s0 = 1.f / (1.f + __expf(-v0[j])), s1 = 1.f / (1.f + __expf(-v1[j]));
                                o[j] = (_Float16)__builtin_amdgcn_logf(l0[j] + (1.f - l0[j]) * s0); o[4 + j] = (_Float16)__builtin_amdgcn_logf(l1[j] + (1.f - l1[j]) * s1); }
                            *(u32x4*)(O + (plane + t0 + ai * HALF + m * 16) * 128 + dcol) = __builtin_bit_cast(u32x4, o); }
                } else {
                    bf16_t* O = zbase ? (bf16_t*)(zbase + (size_t)(seg == 0 ? 0 : 160) * MiB) : ci;
#pragma unroll
                    for (int ai = 0; ai < 2; ++ai)
#pragma unroll
                        for (int m = 0; m < 4; ++m) { const f32x4 v0 = acc[ai][bj][m][0], v1 = acc[ai][bj][m][1];
                            u32x4 w; w.x = cvt_pk_bf16(v0[0], v0[1]); w.y = cvt_pk_bf16(v0[2], v0[3]); w.z = cvt_pk_bf16(v1[0], v1[1]); w.w = cvt_pk_bf16(v1[2], v1[3]);
                            *(u32x4*)(O + (plane + t0 + ai * HALF + m * 16) * 128 + dcol) = w; }
                }
            }
        } else {
            const int col0 = (u.pn & 1) * 256 + wc * 32 + 8 * fq;
            bf16_t* O = (bf16_t*)(zbase + (size_t)(32 * seg + 64) * MiB);
#pragma unroll
            for (int ai = 0; ai < 2; ++ai)
#pragma unroll
                for (int m = 0; m < 4; ++m) { bf16_t* rowp = O + (size_t)(row0 + ai * HALF + m * 16) * 512 + col0;
#pragma unroll
                    for (int bj = 0; bj < 2; ++bj) { const f32x4 v0 = acc[ai][bj][m][0], v1 = acc[ai][bj][m][1];
                        u32x4 w; w.x = cvt_pk_bf16(v0[0], v0[1]); w.y = cvt_pk_bf16(v0[2], v0[3]); w.z = cvt_pk_bf16(v1[0], v1[1]); w.w = cvt_pk_bf16(v1[2], v1[3]);
                        *(u32x4*)(rowp + bj * HALF) = w; } }
        }
    }
};
struct EpiOut {
    static constexpr bool PERM = false;
    const float* x; float* x1; const float* modf;
    __device__ __forceinline__ void operator()(const f32x4 (&acc)[2][2][4][2], const Unit& u, int wr, int wc, int fr, int fq) const {
        const int row0 = u.pm * BM + wr * 64 + fr, col0 = u.pn * BM + wc * 32 + 4 * fq;
        const int b = (u.pm * BM) / T;
        const float* g1 = modf + (size_t)b * NMOD + 2 * D;
        f32x4 gv[2][2];
#pragma unroll
        for (int bj = 0; bj < 2; ++bj)
#pragma unroll
            for (int n = 0; n < 2; ++n) gv[bj][n] = *(const f32x4*)(g1 + col0 + bj * HALF + n * 16);
#pragma unroll
        for (int ai = 0; ai < 2; ++ai)
#pragma unroll
            for (int m = 0; m < 4; ++m) { const size_t off = (size_t)(row0 + ai * HALF + m * 16) * D + col0;
#pragma unroll
                for (int bj = 0; bj < 2; ++bj)
#pragma unroll
                    for (int n = 0; n < 2; ++n) { const f32x4 xs = *(const f32x4*)(x + off + bj * HALF + n * 16); *(f32x4*)(x1 + off + bj * HALF + n * 16) = xs + gv[bj][n] * acc[ai][bj][m][n]; }
                asm volatile("" ::: "memory"); }
    }
};
struct EpiMoe1 {
    static constexpr bool PERM = true;
    bf16_t* hid;
    __device__ __forceinline__ void operator()(const f32x4 (&acc)[2][2][4][2], const Unit& u, int wr, int wc, int fr, int fq) const {
        const int row0 = u.pm * BM + wr * 64 + fr, col0 = u.pn * 128 + wc * 32 + 8 * fq;
#pragma unroll
        for (int ai = 0; ai < 2; ++ai)
#pragma unroll
            for (int m = 0; m < 4; ++m) { bf16_t* rowp = hid + (size_t)(row0 + ai * HALF + m * 16) * DFF + col0;
                float o[8];
#pragma unroll
                for (int n = 0; n < 2; ++n)
#pragma unroll
                    for (int j = 0; j < 4; ++j) { const float gt = acc[ai][0][m][n][j], up = acc[ai][1][m][n][j]; o[n * 4 + j] = gt * up / (1.f + __expf(-gt)); }
                u32x4 w; w.x = cvt_pk_bf16(o[0], o[1]); w.y = cvt_pk_bf16(o[2], o[3]); w.z = cvt_pk_bf16(o[4], o[5]); w.w = cvt_pk_bf16(o[6], o[7]);
                *(u32x4*)rowp = w; }
    }
};
struct EpiMoe2 {
    static constexpr bool PERM = true;
    bf16_t* ys; const float* gate;
    __device__ __forceinline__ void operator()(const f32x4 (&acc)[2][2][4][2], const Unit& u, int wr, int wc, int fr, int fq) const {
        const int row0 = u.pm * BM + wr * 64 + fr, col0 = u.pn * BM + wc * 32 + 8 * fq;
#pragma unroll
        for (int ai = 0; ai < 2; ++ai)
#pragma unroll
            for (int m = 0; m < 4; ++m) { const int row = row0 + ai * HALF + m * 16; const float gt = gate[row]; bf16_t* rowp = ys + (size_t)row * D + col0;
#pragma unroll
                for (int bj = 0; bj < 2; ++bj) { const f32x4 v0 = acc[ai][bj][m][0] * gt, v1 = acc[ai][bj][m][1] * gt;
                    u32x4 w; w.x = cvt_pk_bf16(v0[0], v0[1]); w.y = cvt_pk_bf16(v0[2], v0[3]); w.z = cvt_pk_bf16(v1[0], v1[1]); w.w = cvt_pk_bf16(v1[2], v1[3]);
                    *(u32x4*)(rowp + bj * HALF) = w; } }
    }
};
}

struct Args {
    const float *x, *c, *ctx, *c_ctx, *w_ada, *b_ada, *norm_mix, *norm_ffn, *w_in, *lb_logits, *hg_norm, *conv_w, *w_out, *w_router, *w_gate, *w_up, *w_down, *norm_final;
    float* out; uchar* ws; int ph_lo, ph_hi;
};

__device__ __forceinline__ void cvt_item(const float* W, int ldw, bf16_t* WT, int ldt, int k0, int n0, int nrow0, LAS float* scr, int lane) {
#pragma unroll 8
    for (int i = 0; i < 32; ++i) { const int kk = 2 * i + (lane >> 5); scr[kk * 33 + (lane & 31)] = W[(size_t)(k0 + kk) * ldw + n0 + (lane & 31)]; }
    LDS_WAIT(); asm volatile("" ::: "memory");
    const int c = lane & 7;
#pragma unroll
    for (int j = 0; j < 4; ++j) { const int n = (lane >> 3) + 8 * j; const LAS float* s = scr + (8 * c) * 33 + n;
        u32x4 o; o.x = cvt_pk_bf16(s[0 * 33], s[1 * 33]); o.y = cvt_pk_bf16(s[2 * 33], s[3 * 33]); o.z = cvt_pk_bf16(s[4 * 33], s[5 * 33]); o.w = cvt_pk_bf16(s[6 * 33], s[7 * 33]);
        *(u32x4*)(WT + (size_t)(nrow0 + n) * ldt + k0 + 8 * c) = o; }
    LDS_WAIT(); asm volatile("" ::: "memory");
}

__device__ __forceinline__ void phase_prep(const Args& a, LAS uchar* lds, int bid, int G, int tid, int wid, int lane) {
    float* modp = (float*)(a.ws + WS_MODP);
    if (bid < 192) {
        const int cgp = bid % 24, ks = bid / 24, n0 = cgp * 256 + lane * 4, k0 = ks * 128 + wid * 16;
        f32x4 acc[9];
#pragma unroll
        for (int r = 0; r < 9; ++r) acc[r] = (f32x4){0.f, 0.f, 0.f, 0.f};
#pragma unroll 4
        for (int kk = 0; kk < 16; ++kk) { const int k = k0 + kk; const f32x4 w = *(const f32x4*)(a.w_ada + (size_t)k * NMOD + n0);
#pragma unroll
            for (int r = 0; r < 9; ++r) { const float cv = (r < 8) ? a.c[r * D + k] : a.c_ctx[k]; const float s = silu_f(cv); acc[r] += w * s; } }
        LAS f32x4* red = (LAS f32x4*)lds;
#pragma unroll
        for (int r = 0; r < 9; ++r) red[(wid * 9 + r) * 64 + lane] = acc[r];
        __syncthreads();
        for (int o = tid; o < 9 * 64; o += 512) { const int r = o / 64, l = o % 64; f32x4 s = red[(0 * 9 + r) * 64 + l];
#pragma unroll
            for (int w = 1; w < 8; ++w) s += red[(w * 9 + r) * 64 + l];
            if (ks == 0) s += *(const f32x4*)(a.b_ada + cgp * 256 + l * 4);
            *(f32x4*)(modp + ((size_t)ks * 9 + r) * NMOD + cgp * 256 + l * 4) = s; }
        __syncthreads();
    }
    if (bid == 255) {
        float* lb = (float*)(a.ws + WS_LB);
        for (int i = tid; i < 1024; i += 512) { const float l0 = a.lb_logits[i], l1 = a.lb_logits[1024 + i]; lb[i] = 1.f / (1.f + __expf(l1 - l0)); }
    }
    LAS float* scr = (LAS float*)lds + wid * (64 * 33);
    const int gw = (G - 1 - bid) * 8 + wid, NGW = G * 8;
    constexpr int I_IN = (D / 64) * (NIN / 32), I_OUT = (D / 64) * (D / 32);
    for (int it = gw; it < I_IN + I_OUT; it += NGW) {
        if (it < I_IN) { const int nblk = NIN / 32, kb = it / nblk, nb = it % nblk; cvt_item(a.w_in, NIN, (bf16_t*)(a.ws + WS_WIN), D, kb * 64, nb * 32, nb * 32, scr, lane); }
        else { const int r = it - I_IN, nblk = D / 32, kb = r / nblk, nb = r % nblk; cvt_item(a.w_out, D, (bf16_t*)(a.ws + WS_WOUT), D, kb * 64, nb * 32, nb * 32, scr, lane); }
    }
}

__device__ __forceinline__ float modp_sum(const float* modp, int r, int col) { float s = 0.f;
#pragma unroll
    for (int ks = 0; ks < 8; ++ks) s += modp[((size_t)ks * 9 + r) * NMOD + col];
    return s; }
__device__ __forceinline__ void norm_row(const float* xrow, bf16_t* orow, const LAS float* gm, const LAS float* sh, int lane) {
    f32x4 v[4]; float ss = 0.f;
#pragma unroll
    for (int j = 0; j < 4; ++j) { v[j] = *((const f32x4*)xrow + lane + 64 * j); ss += (v[j].x * v[j].x + v[j].y * v[j].y) + (v[j].z * v[j].z + v[j].w * v[j].w); }
    const float rstd = rsqrtf(wave_sum(ss) * (1.f / D) + EPS);
#pragma unroll
    for (int j = 0; j < 4; ++j) { const f32x4 g4 = *((const LAS f32x4*)gm + lane + 64 * j), s4 = *((const LAS f32x4*)sh + lane + 64 * j); const f32x4 o = v[j] * rstd * g4 + s4;
        u32x2 w; w.x = cvt_pk_bf16(o.x, o.y); w.y = cvt_pk_bf16(o.z, o.w); *((u32x2*)orow + lane + 64 * j) = w; }
}
__device__ __forceinline__ void phase_norm(const Args& a, LAS uchar* lds, int bid, int G, int tid, int wid, int lane) {
    const float* modp = (const float*)(a.ws + WS_MODP); float* modf = (float*)(a.ws + WS_MODF);
    { const int gt = bid * 512 + tid; if (gt < 9 * NMOD) modf[gt] = modp_sum(modp, gt / NMOD, gt % NMOD); }
    LAS float* gm = (LAS float*)lds; LAS float* sh = gm + D; LAS float* cgm = sh + D; LAS float* csh = cgm + D;
    const int b = bid / 32;
    for (int cidx = tid; cidx < D; cidx += 512) { const float nm = a.norm_mix[cidx];
        sh[cidx] = modp_sum(modp, b, cidx); gm[cidx] = nm * (1.f + modp_sum(modp, b, D + cidx));
        csh[cidx] = modp_sum(modp, 8, cidx); cgm[cidx] = nm * (1.f + modp_sum(modp, 8, D + cidx)); }
    __syncthreads();
    bf16_t* hx = (bf16_t*)(a.ws + WS_ACT); bf16_t* hc = (bf16_t*)(a.ws + WS_HC);
    for (int j = 0; j < 16; ++j) { const int row = bid * 128 + wid * 16 + j; norm_row(a.x + (size_t)row * D, hx + (size_t)row * D, gm, sh, lane); }
    { const int row = bid * 8 + wid; norm_row(a.ctx + (size_t)row * D, hc + (size_t)row * D, cgm, csh, lane); }
    __syncthreads();
}

constexpr int GL_QDP = 0, GL_KIP = 8704, GL_KETP = 17408, GL_VTP = 27648, GL_DEC = 37888, GL_TOT = 38400, GL_RING = 43008, GL_SLOT = 24576;
#define GLA_BAR() do { asm volatile("s_waitcnt lgkmcnt(0)" ::: "memory"); __builtin_amdgcn_s_barrier(); asm volatile("" ::: "memory"); } while (0)
template <bool FULL>
__device__ __forceinline__ void gla_item(LAS uchar* lds, const bf16_t* qb, const _Float16* lfb, const bf16_t* vb, bf16_t* ob, f32x4 (&S)[8], float* dl_out,
                                         int row_base, int Tn, int tau0, int nch, int h, int dir, int wid, int lane) {
    const int fr = lane & 15, fq = lane >> 4;
#define GLA_ISSUE(c) do { LAS uchar* _sl = lds + GL_RING + ((c) & 3) * GL_SLOT + wid * 3072; \
        const int _tau = tau0 + 32 * (c) + 4 * wid + (lane >> 4); const size_t _o = (size_t)(dir ? (Tn - 1 - _tau) : _tau) * 128 + (lane & 15) * 8; \
        __builtin_amdgcn_global_load_lds((const unsigned*)(lfb + _o), (LAS unsigned*)(_sl), 16, 0, 0); \
        if (FULL) __builtin_amdgcn_global_load_lds((const unsigned*)(qb + _o), (LAS unsigned*)(_sl + 1024), 16, 0, 0); \
        __builtin_amdgcn_global_load_lds((const unsigned*)(vb + _o), (LAS unsigned*)(_sl + 2048), 16, 0, 0); } while (0)
    GLA_ISSUE(0);
    if (nch > 1) GLA_ISSUE(1);
    if (nch > 2) GLA_ISSUE(2);
    const int d0 = 2 * lane, pos0 = (d0 & ~31) + 8 * ((d0 >> 2) & 3) + 4 * ((d0 >> 4) & 1) + (d0 & 3);
    const int spos = 8 * (wid & 3) + 4 * (wid >> 2);
    f32x2 dsum = (f32x2){0.f, 0.f};
    for (int n = 0; n < nch; ++n) {
        if (n + 2 < nch) { if (FULL) asm volatile("s_waitcnt vmcnt(6)" ::: "memory"); else asm volatile("s_waitcnt vmcnt(4)" ::: "memory"); }
        else if (n + 1 < nch) { if (FULL) asm volatile("s_waitcnt vmcnt(3)" ::: "memory"); else asm volatile("s_waitcnt vmcnt(2)" ::: "memory"); }
        else asm volatile("s_waitcnt vmcnt(0)" ::: "memory");
        const LAS uchar* sl = lds + GL_RING + (n & 3) * GL_SLOT + wid * 3072;
        f32x2 lf[4];
#pragma unroll
        for (int rr = 0; rr < 4; ++rr) { typedef _Float16 h2_t __attribute__((ext_vector_type(2))); const h2_t hv = *(const LAS h2_t*)(sl + rr * 256 + lane * 4); lf[rr] = (f32x2){(float)hv.x, (float)hv.y}; }
        f32x2 c[4]; c[0] = lf[0]; c[1] = c[0] + lf[1]; c[2] = c[1] + lf[2]; c[3] = c[2] + lf[3];
        LAS f32x2* tot = (LAS f32x2*)(lds + GL_TOT);
        tot[wid * 64 + lane] = c[3];
        unsigned qv[4], vv[4];
#pragma unroll
        for (int rr = 0; rr < 4; ++rr) { vv[rr] = *(const LAS unsigned*)(sl + 2048 + rr * 256 + lane * 4); qv[rr] = FULL ? *(const LAS unsigned*)(sl + 1024 + rr * 256 + lane * 4) : 0u; }
        GLA_BAR();
        if (n + 3 < nch) GLA_ISSUE(n + 3);
        f32x2 pre = (f32x2){0.f, 0.f}, all = (f32x2){0.f, 0.f};
#pragma unroll
        for (int w = 0; w < 8; ++w) { const f32x2 tw = tot[w * 64 + lane]; all += tw; if (w < wid) pre += tw; }
        dsum += all;
        const f32x2 decall = (f32x2){__builtin_amdgcn_exp2f(all.x), __builtin_amdgcn_exp2f(all.y)};
        f32x2 kE[4];
#pragma unroll
        for (int rr = 0; rr < 4; ++rr) {
            const f32x2 cum = pre + c[rr];
            const f32x2 k = 1.f - (f32x2){__builtin_amdgcn_exp2f(lf[rr].x), __builtin_amdgcn_exp2f(lf[rr].y)};
            const f32x2 ki = k * (f32x2){__builtin_amdgcn_exp2f(-cum.x), __builtin_amdgcn_exp2f(-cum.y)};
            kE[rr] = ki * decall;
            if (FULL) { const int s = 4 * wid + rr; const f32x2 qd = (f32x2){bf_lo(qv[rr]), bf_hi(qv[rr])} * (f32x2){__builtin_amdgcn_exp2f(cum.x), __builtin_amdgcn_exp2f(cum.y)};
                *(LAS unsigned*)(lds + GL_QDP + s * 272 + pos0 * 2) = cvt_pk_bf16(qd.x, qd.y);
                *(LAS unsigned*)(lds + GL_KIP + s * 272 + pos0 * 2) = cvt_pk_bf16(ki.x, ki.y); }
        }
        { u32x2 w0, w1; w0.x = cvt_pk_bf16(kE[0].x, kE[1].x); w0.y = cvt_pk_bf16(kE[2].x, kE[3].x); w1.x = cvt_pk_bf16(kE[0].y, kE[1].y); w1.y = cvt_pk_bf16(kE[2].y, kE[3].y);
          *(LAS u32x2*)(lds + GL_KETP + (d0) * 80 + spos * 2) = w0; *(LAS u32x2*)(lds + GL_KETP + (d0 + 1) * 80 + spos * 2) = w1;
          u32x2 v0, v1; v0.x = (vv[0] & 0xffffu) | (vv[1] << 16); v0.y = (vv[2] & 0xffffu) | (vv[3] << 16);
          v1.x = (vv[0] >> 16) | (vv[1] & 0xffff0000u); v1.y = (vv[2] >> 16) | (vv[3] & 0xffff0000u);
          *(LAS u32x2*)(lds + GL_VTP + (d0) * 80 + spos * 2) = v0; *(LAS u32x2*)(lds + GL_VTP + (d0 + 1) * 80 + spos * 2) = v1; }
        if (wid == 0) *(LAS f32x2*)(lds + GL_DEC + lane * 8) = decall;
        GLA_BAR();
        const bf16x8 vt = *(const LAS bf16x8*)(lds + GL_VTP + (16 * wid + fr) * 80 + fq * 16);
        if (FULL) {
            bf16x8 qf[2][4];
#pragma unroll
            for (int ti = 0; ti < 2; ++ti)
#pragma unroll
                for (int kk = 0; kk < 4; ++kk) qf[ti][kk] = *(const LAS bf16x8*)(lds + GL_QDP + (16 * ti + fr) * 272 + kk * 64 + fq * 16);
            f32x4 oT[2] = {(f32x4){0.f, 0.f, 0.f, 0.f}, (f32x4){0.f, 0.f, 0.f, 0.f}};
            f32x4 p00 = (f32x4){0.f, 0.f, 0.f, 0.f}, p01 = p00, p11 = p00;
#pragma unroll
            for (int kk = 0; kk < 4; ++kk) {
                const bf16x8 kj0 = *(const LAS bf16x8*)(lds + GL_KIP + (fr) * 272 + kk * 64 + fq * 16);
                const bf16x8 kj1 = *(const LAS bf16x8*)(lds + GL_KIP + (16 + fr) * 272 + kk * 64 + fq * 16);
                p00 = __builtin_amdgcn_mfma_f32_16x16x32_bf16(kj0, qf[0][kk], p00, 0, 0, 0);
                p01 = __builtin_amdgcn_mfma_f32_16x16x32_bf16(kj0, qf[1][kk], p01, 0, 0, 0);
                p11 = __builtin_amdgcn_mfma_f32_16x16x32_bf16(kj1, qf[1][kk], p11, 0, 0, 0);
                u32x4 sa; sa.x = cvt_pk_bf16_safe(S[2 * kk][0], S[2 * kk][1]); sa.y = cvt_pk_bf16_safe(S[2 * kk][2], S[2 * kk][3]);
                sa.z = cvt_pk_bf16_safe(S[2 * kk + 1][0], S[2 * kk + 1][1]); sa.w = cvt_pk_bf16_safe(S[2 * kk + 1][2], S[2 * kk + 1][3]);
                const bf16x8 sA = __builtin_bit_cast(bf16x8, sa);
                oT[0] = __builtin_amdgcn_mfma_f32_16x16x32_bf16(sA, qf[0][kk], oT[0], 0, 0, 0);
                oT[1] = __builtin_amdgcn_mfma_f32_16x16x32_bf16(sA, qf[1][kk], oT[1], 0, 0, 0);
            }
            u32x4 pb0, pb1;
            { float m0[4], m1[4];
#pragma unroll
              for (int r = 0; r < 4; ++r) { const bool ok = (4 * fq + r) <= fr; m0[r] = ok ? p00[r] : 0.f; m1[r] = ok ? p11[r] : 0.f; }
              pb0.x = cvt_pk_bf16_safe(m0[0], m0[1]); pb0.y = cvt_pk_bf16_safe(m0[2], m0[3]); pb0.z = 0u; pb0.w = 0u;
              pb1.x = cvt_pk_bf16_safe(p01[0], p01[1]); pb1.y = cvt_pk_bf16_safe(p01[2], p01[3]); pb1.z = cvt_pk_bf16_safe(m1[0], m1[1]); pb1.w = cvt_pk_bf16_safe(m1[2], m1[3]); }
            oT[0] = __builtin_amdgcn_mfma_f32_16x16x32_bf16(vt, __builtin_bit_cast(bf16x8, pb0), oT[0], 0, 0, 0);
            oT[1] = __builtin_amdgcn_mfma_f32_16x16x32_bf16(vt, __builtin_bit_cast(bf16x8, pb1), oT[1], 0, 0, 0);
#pragma unroll
            for (int ti = 0; ti < 2; ++ti) { const int tau = tau0 + 32 * n + 16 * ti + fr; const size_t row = (size_t)(row_base + (dir ? (Tn - 1 - tau) : tau));
                u32x2 w; w.x = cvt_pk_bf16_safe(oT[ti][0], oT[ti][1]); w.y = cvt_pk_bf16_safe(oT[ti][2], oT[ti][3]);
                *(u32x2*)(ob + row * 512 + h * 128 + 16 * wid + 4 * fq) = w; }
        }
#pragma unroll
        for (int t8 = 0; t8 < 8; ++t8) {
            const f32x4 dc = *(const LAS f32x4*)(lds + GL_DEC + (16 * t8 + 4 * fq) * 4);
            const bf16x8 ka = *(const LAS bf16x8*)(lds + GL_KETP + (16 * t8 + fr) * 80 + fq * 16);
            S[t8] = __builtin_amdgcn_mfma_f32_16x16x32_bf16(ka, vt, S[t8] * dc, 0, 0, 0);
        }
    }
#undef GLA_ISSUE
    if (dl_out && wid == 0) *(f32x2*)(dl_out + 2 * lane) = dsum;
    asm volatile("s_waitcnt vmcnt(0)" ::: "memory");
    GLA_BAR();
}
__device__ __forceinline__ void gla_state_store(float* p, const f32x4 (&S)[8], int wid, int fr, int fq) {
#pragma unroll
    for (int t8 = 0; t8 < 8; ++t8)
#pragma unroll
        for (int r = 0; r < 4; ++r) p[(size_t)(16 * t8 + 4 * fq + r) * 128 + 16 * wid + fr] = S[t8][r];
}
__device__ __forceinline__ void phase_gla_states(const Args& a, LAS uchar* lds, int bid, int wid, int lane) {
    uchar* ws = a.ws; const int fr = lane & 15, fq = lane >> 4;
    f32x4 S[8];
#pragma unroll
    for (int t8 = 0; t8 < 8; ++t8) S[t8] = (f32x4){0.f, 0.f, 0.f, 0.f};
    if (bid < 192) { const int bhd = bid / 3, seg = bid % 3, b = bhd >> 3, h = (bhd >> 1) & 3, dir = bhd & 1;
        const size_t pl = (size_t)(b * NH + h) * T * 128;
        gla_item<false>(lds, nullptr, (const _Float16*)(ws + (dir ? WS_LBW : WS_LF)) + pl, (const bf16_t*)(ws + WS_ZI) + pl, nullptr, S, (float*)(ws + WS_DL) + (size_t)bid * 128,
                        b * T, T, seg * 1024, 32, h, dir, wid, lane);
        gla_state_store((float*)(ws + WS_SL) + (size_t)bid * 16384, S, wid, fr, fq);
    } else { const int bhd = bid - 192, b = bhd >> 3, h = (bhd >> 1) & 3, dir = bhd & 1;
        const size_t pl = (size_t)(b * NH + h) * CT * 128;
        gla_item<false>(lds, nullptr, (const _Float16*)(ws + (dir ? WS_CLB : WS_CLF)) + pl, (const bf16_t*)(ws + WS_CI) + pl, nullptr, S, nullptr, b * CT, CT, 0, CT / 32, h, dir, wid, lane);
        gla_state_store((float*)(ws + WS_S0) + (size_t)bhd * 16384, S, wid, fr, fq);
    }
}
__device__ __forceinline__ void phase_gla_out(const Args& a, LAS uchar* lds, int bid, int wid, int lane) {
    uchar* ws = a.ws; const int fr = lane & 15, fq = lane >> 4;
    const int bhd = bid >> 2, seg = bid & 3, b = bhd >> 3, h = (bhd >> 1) & 3, dir = bhd & 1;
    f32x4 S[8];
    { const float* p = (const float*)(ws + WS_S0) + (size_t)bhd * 16384;
#pragma unroll
      for (int t8 = 0; t8 < 8; ++t8)
#pragma unroll
          for (int r = 0; r < 4; ++r) S[t8][r] = p[(size_t)(16 * t8 + 4 * fq + r) * 128 + 16 * wid + fr]; }
    for (int j = 0; j < seg; ++j) { const float* p = (const float*)(ws + WS_SL) + (size_t)(bhd * 3 + j) * 16384; const float* dl = (const float*)(ws + WS_DL) + (size_t)(bhd * 3 + j) * 128;
#pragma unroll
        for (int t8 = 0; t8 < 8; ++t8) { const f32x4 dv = *(const f32x4*)(dl + 16 * t8 + 4 * fq);
#pragma unroll
            for (int r = 0; r < 4; ++r) S[t8][r] = __builtin_amdgcn_exp2f(dv[r]) * S[t8][r] + p[(size_t)(16 * t8 + 4 * fq + r) * 128 + 16 * wid + fr]; } }
    asm volatile("s_waitcnt vmcnt(0)" ::: "memory");
    const size_t pl = (size_t)(b * NH + h) * T * 128;
    gla_item<true>(lds, (const bf16_t*)(ws + WS_ZQ) + pl, (const _Float16*)(ws + (dir ? WS_LBW : WS_LF)) + pl, (const bf16_t*)(ws + WS_ZI) + pl, (bf16_t*)(ws + (dir ? WS_OB : WS_OF)), S, nullptr,
                   b * T, T, seg * 1024, 32, h, dir, wid, lane);
}

__device__ __forceinline__ void unpack8(const u32x4 w, float (&f)[8]) { f[0] = bf_lo(w.x); f[1] = bf_hi(w.x); f[2] = bf_lo(w.y); f[3] = bf_hi(w.y); f[4] = bf_lo(w.z); f[5] = bf_hi(w.z); f[6] = bf_lo(w.w); f[7] = bf_hi(w.w); }
__device__ __forceinline__ void phase_mixfin(const Args& a, int bid, int G, int wid, int lane) {
    const bf16_t* of = (const bf16_t*)(a.ws + WS_OF); const bf16_t* obw = (const bf16_t*)(a.ws + WS_OB); const bf16_t* zg = (const bf16_t*)(a.ws + WS_ZG);
    const bf16_t* zgb = (const bf16_t*)(a.ws + WS_ZGB); const bf16_t* zgc = (const bf16_t*)(a.ws + WS_ZGC); const bf16_t* zv = (const bf16_t*)(a.ws + WS_ZV);
    bf16_t* A2 = (bf16_t*)(a.ws + WS_ACT);
    const int c0 = 8 * lane;
    float gain[8], cw0[8], cw1[8], cw2[8];
#pragma unroll
    for (int j = 0; j < 8; ++j) { gain[j] = a.hg_norm[(c0 + j) & 127]; cw0[j] = a.conv_w[c0 + j]; cw1[j] = a.conv_w[512 + c0 + j]; cw2[j] = a.conv_w[1024 + c0 + j]; }
    for (int row = bid * 8 + wid; row < M; row += G * 8) {
        const size_t ro = (size_t)row * 512 + c0;
        float f0[8], f1[8], gg[8], o[8];
        unpack8(*(const u32x4*)(of + ro), f0); unpack8(*(const u32x4*)(obw + ro), f1); unpack8(*(const u32x4*)(zg + ro), gg);
        float ss = 0.f;
#pragma unroll
        for (int j = 0; j < 8; ++j) { o[j] = f0[j] + f1[j]; ss += o[j] * o[j]; }
        ss += __shfl_xor(ss, 1); ss += __shfl_xor(ss, 2); ss += __shfl_xor(ss, 4); ss += __shfl_xor(ss, 8);
        const float rstd = rsqrtf(ss * (1.f / 128.f) + EPS);
#pragma unroll
        for (int j = 0; j < 8; ++j) o[j] = o[j] * rstd * gain[j] * silu_f(gg[j]);
        u32x4 w; w.x = cvt_pk_bf16(o[0], o[1]); w.y = cvt_pk_bf16(o[2], o[3]); w.z = cvt_pk_bf16(o[4], o[5]); w.w = cvt_pk_bf16(o[6], o[7]);
        *(u32x4*)(A2 + (size_t)row * D + c0) = w;
        const int tw = row & 63;
        float gcm[8], vm[8], gc0[8], v0[8], gcp[8], vp[8], gb[8], y[8];
        unpack8(*(const u32x4*)(zgc + ro), gc0); unpack8(*(const u32x4*)(zv + ro), v0); unpack8(*(const u32x4*)(zgb + ro), gb);
        if (tw > 0) { unpack8(*(const u32x4*)(zgc + ro - 512), gcm); unpack8(*(const u32x4*)(zv + ro - 512), vm); }
        else {
#pragma unroll
            for (int j = 0; j < 8; ++j) { gcm[j] = 0.f; vm[j] = 0.f; } }
        if (tw < 63) { unpack8(*(const u32x4*)(zgc + ro + 512), gcp); unpack8(*(const u32x4*)(zv + ro + 512), vp); }
        else {
#pragma unroll
            for (int j = 0; j < 8; ++j) { gcp[j] = 0.f; vp[j] = 0.f; } }
#pragma unroll
        for (int j = 0; j < 8; ++j) y[j] = gb[j] * (cw0[j] * (gcm[j] * vm[j]) + cw1[j] * (gc0[j] * v0[j]) + cw2[j] * (gcp[j] * vp[j]));
        w.x = cvt_pk_bf16(y[0], y[1]); w.y = cvt_pk_bf16(y[2], y[3]); w.z = cvt_pk_bf16(y[4], y[5]); w.w = cvt_pk_bf16(y[6], y[7]);
        *(u32x4*)(A2 + (size_t)row * D + 512 + c0) = w;
    }
}

__device__ __forceinline__ void phase_router(const Args& a, LAS uchar* lds, int bid, int tid, int wid, int lane) {
    const float* modf = (const float*)(a.ws + WS_MODF);
    LAS float* gm = (LAS float*)lds; LAS float* sh = gm + D;
    LAS uchar* wrl = lds + 8192;
    const int b = bid / 32;
    for (int cidx = tid; cidx < D; cidx += 512) { sh[cidx] = modf[(size_t)b * NMOD + 3 * D + cidx]; gm[cidx] = a.norm_ffn[cidx] * (1.f + modf[(size_t)b * NMOD + 4 * D + cidx]); }
    for (int i = tid; i < D * 4; i += 512) { const int col = i >> 2, q4 = i & 3; *(LAS f32x4*)(wrl + col * 64 + (col >> 2) * 16 + q4 * 16) = *(const f32x4*)(a.w_router + col * 16 + q4 * 4); }
    __syncthreads();
    bf16_t* hx2 = (bf16_t*)(a.ws + WS_ACT); float* aff = (float*)(a.ws + WS_AFF);
    for (int jb = 0; jb < 4; ++jb) {
        const int row0 = bid * 128 + wid * 16 + jb * 4;
        f32x4 v[4][4]; float rstd[4];
#pragma unroll
        for (int i = 0; i < 4; ++i) { const float* xrow = a.out + (size_t)(row0 + i) * D; float ss = 0.f;
#pragma unroll
            for (int jj = 0; jj < 4; ++jj) { v[i][jj] = *((const f32x4*)xrow + lane + 64 * jj); ss += (v[i][jj].x * v[i][jj].x + v[i][jj].y * v[i][jj].y) + (v[i][jj].z * v[i][jj].z + v[i][jj].w * v[i][jj].w); }
            rstd[i] = ss; }
#pragma unroll
        for (int i = 0; i < 4; ++i) rstd[i] = rsqrtf(wave_sum(rstd[i]) * (1.f / D) + EPS);
        float pl[64];
#pragma unroll
        for (int e = 0; e < 64; ++e) pl[e] = 0.f;
#pragma unroll
        for (int jj = 0; jj < 4; ++jj) { const f32x4 g4 = *((const LAS f32x4*)gm + lane + 64 * jj), s4 = *((const LAS f32x4*)sh + lane + 64 * jj);
#pragma unroll
            for (int i = 0; i < 4; ++i) { v[i][jj] = v[i][jj] * rstd[i] * g4 + s4;
                u32x2 w; w.x = cvt_pk_bf16(v[i][jj].x, v[i][jj].y); w.y = cvt_pk_bf16(v[i][jj].z, v[i][jj].w); *((u32x2*)(hx2 + (size_t)(row0 + i) * D) + lane + 64 * jj) = w; }
            const int colb = 4 * lane + 256 * jj;
#pragma unroll
            for (int cc = 0; cc < 4; ++cc) { const int col = colb + cc; const LAS uchar* wp = wrl + col * 64 + (col >> 2) * 16;
#pragma unroll
                for (int q4 = 0; q4 < 4; ++q4) { const f32x4 w4 = *(const LAS f32x4*)(wp + q4 * 16);
#pragma unroll
                    for (int i = 0; i < 4; ++i) { const float hvv = v[i][jj][cc]; pl[i * 16 + q4 * 4 + 0] += hvv * w4.x; pl[i * 16 + q4 * 4 + 1] += hvv * w4.y; pl[i * 16 + q4 * 4 + 2] += hvv * w4.z; pl[i * 16 + q4 * 4 + 3] += hvv * w4.w; } } } }
#pragma unroll
        for (int k = 0; k < 32; ++k) { const bool hi = (lane & 32) != 0; const float keep = hi ? pl[32 + k] : pl[k], send = hi ? pl[k] : pl[32 + k]; pl[k] = keep + __shfl_xor(send, 32); }
#pragma unroll
        for (int k = 0; k < 16; ++k) { const bool hi = (lane & 16) != 0; const float keep = hi ? pl[16 + k] : pl[k], send = hi ? pl[k] : pl[16 + k]; pl[k] = keep + __shfl_xor(send, 16); }
#pragma unroll
        for (int k = 0; k < 8; ++k) { const bool hi = (lane & 8) != 0; const float keep = hi ? pl[8 + k] : pl[k], send = hi ? pl[k] : pl[8 + k]; pl[k] = keep + __shfl_xor(send, 8); }
#pragma unroll
        for (int k = 0; k < 4; ++k) { const bool hi = (lane & 4) != 0; const float keep = hi ? pl[4 + k] : pl[k], send = hi ? pl[k] : pl[4 + k]; pl[k] = keep + __shfl_xor(send, 4); }
#pragma unroll
        for (int k = 0; k < 2; ++k) { const bool hi = (lane & 2) != 0; const float keep = hi ? pl[2 + k] : pl[k], send = hi ? pl[k] : pl[2 + k]; pl[k] = keep + __shfl_xor(send, 2); }
        { const bool hi = (lane & 1) != 0; const float keep = hi ? pl[1] : pl[0], send = hi ? pl[0] : pl[1]; pl[0] = keep + __shfl_xor(send, 1); }
        const float lg = pl[0];
        float mx = lg;
#pragma unroll
        for (int o = 1; o < 16; o <<= 1) mx = fmaxf(mx, __shfl_xor(mx, o));
        const float ex = __expf(lg - mx); float den = ex;
#pragma unroll
        for (int o = 1; o < 16; o <<= 1) den += __shfl_xor(den, o);
        const int t = (row0 + (lane >> 4)) & (T - 1);
        aff[((size_t)b * NE + (lane & 15)) * T + t] = ex / den;
    }
    __syncthreads();
}

__device__ __forceinline__ void topk_item(const Args& a, LAS uchar* lds, int b, int e, int tid, int wid, int lane) {
    LAS unsigned* key = (LAS unsigned*)lds;
    LAS unsigned* hist = key + 4096;
    LAS unsigned* ctl = hist + 256;
    LAS unsigned* wsum = ctl + 8;
    const float* affp = (const float*)(a.ws + WS_AFF) + ((size_t)b * NE + e) * T;
    unsigned kv[8];
    { const u32x4 k0 = *(const u32x4*)(affp + tid * 8), k1 = *(const u32x4*)(affp + tid * 8 + 4); kv[0] = k0.x; kv[1] = k0.y; kv[2] = k0.z; kv[3] = k0.w; kv[4] = k1.x; kv[5] = k1.y; kv[6] = k1.z; kv[7] = k1.w; }
    unsigned prefix = 0u, mask = 0u, need = CAP;
    for (int shift = 24; shift >= 0; shift -= 8) {
        if (tid < 256) hist[tid] = 0u;
        __syncthreads();
#pragma unroll
        for (int j = 0; j < 8; ++j) if ((kv[j] & mask) == prefix) __hip_atomic_fetch_add(&hist[(kv[j] >> shift) & 255u], 1u, __ATOMIC_RELAXED, __HIP_MEMORY_SCOPE_WORKGROUP);
        __syncthreads();
        if (tid < 256) { unsigned above = 0u; for (int bb = tid + 1; bb < 256; ++bb) above += hist[bb]; const unsigned mine = hist[tid];
            if (above < need && need <= above + mine) { ctl[0] = (unsigned)tid; ctl[1] = need - above; } }
        __syncthreads();
        prefix |= ctl[0] << shift; mask |= 255u << shift; need = ctl[1];
        __syncthreads();
    }
    unsigned cg_ = 0u, ce_ = 0u;
#pragma unroll
    for (int j = 0; j < 8; ++j) { cg_ += kv[j] > prefix; ce_ += kv[j] == prefix; }
    unsigned pk = cg_ | (ce_ << 16), incl = pk;
#pragma unroll
    for (int o = 1; o < 64; o <<= 1) { const unsigned t2 = __shfl_up(incl, o); if (lane >= o) incl += t2; }
    if (lane == 63) wsum[wid] = incl;
    __syncthreads();
    unsigned base = 0u;
    for (int w = 0; w < wid; ++w) base += wsum[w];
    unsigned excl = base + incl - pk; unsigned ng = excl & 0xffffu, neq = excl >> 16;
    int* seltok = (int*)(a.ws + WS_SELTOK); float* selgate = (float*)(a.ws + WS_SELGATE); short* pos = (short*)(a.ws + WS_POS);
#pragma unroll
    for (int j = 0; j < 8; ++j) { const int t = tid * 8 + j; const bool gt = kv[j] > prefix, eq = kv[j] == prefix; const bool sel = gt || (eq && neq < need);
        int slot = -1;
        if (sel) slot = (int)(ng + (neq < need ? neq : need));
        if (sel) { seltok[e * 4096 + b * 512 + slot] = b * T + t; selgate[e * 4096 + b * 512 + slot] = __uint_as_float(kv[j]); }
        pos[((size_t)b * T + t) * 16 + e] = (short)slot;
        ng += gt; neq += eq; }
    __syncthreads();
}
__device__ __forceinline__ void phase_topk_cvt(const Args& a, LAS uchar* lds, int bid, int G, int tid, int wid, int lane) {
    if (bid < 128) topk_item(a, lds, bid / 16, bid % 16, tid, wid, lane);
    LAS float* scr = (LAS float*)(lds + 32768) + wid * (64 * 33);
    bf16_t* wgu = (bf16_t*)(a.ws + WS_WGU); bf16_t* wdn = (bf16_t*)(a.ws + WS_WDN);
    constexpr int I_G = (D / 64) * (DFF / 32);
    constexpr int I_D = (DFF / 64) * (D / 32);
    constexpr int PER_E = 2 * I_G + I_D, TOTAL = NE * PER_E;
    const int gw = (G - 1 - bid) * 8 + wid, NGW = G * 8;
    for (int it = gw; it < TOTAL; it += NGW) {
        const int e = it / PER_E; int r = it % PER_E;
        if (r < 2 * I_G) { const int up = r >= I_G; if (up) r -= I_G; const int nblk = DFF / 32, kb = r / nblk, nb = r % nblk, n0 = nb * 32;
            const float* W = (up ? a.w_up : a.w_gate) + (size_t)e * D * DFF;
            cvt_item(W, DFF, wgu + (size_t)e * 4096 * D, D, kb * 64, n0, (n0 >> 7) * 256 + (n0 & 127) + (up ? 128 : 0), scr, lane); }
        else { r -= 2 * I_G; const int nblk = D / 32, kb = r / nblk, nb = r % nblk;
            cvt_item(a.w_down + (size_t)e * DFF * D, D, wdn + (size_t)e * D * DFF, DFF, kb * 64, nb * 32, nb * 32, scr, lane); }
    }
    __syncthreads();
}

__device__ __forceinline__ void phase_final(const Args& a, int bid, int G, int wid, int lane) {
    const float* modf = (const float*)(a.ws + WS_MODF); const short* pos = (const short*)(a.ws + WS_POS); const bf16_t* ys = (const bf16_t*)(a.ws + WS_YS);
    for (int row = bid * 8 + wid; row < M; row += G * 8) {
        const int b = row / T; float* xrow = a.out + (size_t)row * D;
        f32x4 v[4], acc[4];
#pragma unroll
        for (int jj = 0; jj < 4; ++jj) { v[jj] = *((const f32x4*)xrow + lane + 64 * jj); acc[jj] = (f32x4){0.f, 0.f, 0.f, 0.f}; }
        const u32x4 p0 = *(const u32x4*)(pos + (size_t)row * 16), p1 = *(const u32x4*)(pos + (size_t)row * 16 + 8);
        const unsigned pw[8] = {p0.x, p0.y, p0.z, p0.w, p1.x, p1.y, p1.z, p1.w};
#pragma unroll
        for (int e = 0; e < 16; ++e) { const int sl = (int)(short)((e & 1) ? (pw[e >> 1] >> 16) : (pw[e >> 1] & 0xffffu));
            if (sl >= 0) { const bf16_t* yr = ys + ((size_t)e * 4096 + b * 512 + sl) * D;
#pragma unroll
                for (int jj = 0; jj < 4; ++jj) { const u32x2 w = *((const u32x2*)yr + lane + 64 * jj); acc[jj].x += bf_lo(w.x); acc[jj].y += bf_hi(w.x); acc[jj].z += bf_lo(w.y); acc[jj].w += bf_hi(w.y); } } }
        float ss = 0.f;
#pragma unroll
        for (int jj = 0; jj < 4; ++jj) { const f32x4 g2 = *((const f32x4*)(modf + (size_t)b * NMOD + 5 * D) + lane + 64 * jj); v[jj] = v[jj] + g2 * acc[jj];
            ss += (v[jj].x * v[jj].x + v[jj].y * v[jj].y) + (v[jj].z * v[jj].z + v[jj].w * v[jj].w); }
        const float rstd = rsqrtf(wave_sum(ss) * (1.f / D) + EPS);
#pragma unroll
        for (int jj = 0; jj < 4; ++jj) { const f32x4 nf = *((const f32x4*)a.norm_final + lane + 64 * jj); *((f32x4*)xrow + lane + 64 * jj) = v[jj] * rstd * nf; }
    }
}

__global__ void __launch_bounds__(512, 2) mega_fwd(Args a) {
    extern __shared__ __attribute__((aligned(16))) uchar lds_raw[];
    LAS uchar* lds = (LAS uchar*)lds_raw;
    const int tid = threadIdx.x, lane = tid & 63, wid = __builtin_amdgcn_readfirstlane(tid >> 6), bid = blockIdx.x, G = gridDim.x;
    const int lo = a.ph_lo, hi = a.ph_hi;
    uchar* ws = a.ws;
#define IN(k) (lo <= (k) && (k) < hi)
#define SEAM(k) do { if (IN(k) && IN((k) + 1)) xcd_barrier(xbar); } while (0)
    if (tid < 2) ((volatile LAS unsigned*)(lds + (LDS_BYTES - 16)))[tid] = 0u;
    __syncthreads();
    XcdBarrier xbar = xcd_barrier_post((unsigned*)(ws + WS_BAR), (volatile LAS unsigned*)(lds + (LDS_BYTES - 16)));
    if (IN(0)) phase_prep(a, lds, bid, G, tid, wid, lane);
    SEAM(0);
    if (IN(1)) phase_norm(a, lds, bid, G, tid, wid, lane);
    SEAM(1);
    if (IN(2)) {
        {
            pg8::Gemm g{(const bf16_t*)(ws + WS_ACT), (const bf16_t*)(ws + WS_WIN), D, 0, nullptr};
            pg8::GroupOrder S; S.init(M / 256, NIN / 256, 1, G, bid);
            pg8::EpiInproj E{ws + WS_ZQ, nullptr, (_Float16*)(ws + WS_LF), (_Float16*)(ws + WS_LBW), (const float*)(ws + WS_LB), 0, T};
            pg8::gemm_phase<pg8::EpiInproj, false>(lds, g, S, E);
        }
    }
    SEAM(2);
    if (IN(3)) {
        unsigned* cnt = (unsigned*)(ws + WS_BAR + 14336);
        if (bid >= 192 && bid < 240) {
            pg8::Gemm g{(const bf16_t*)(ws + WS_HC), (const bf16_t*)(ws + WS_WIN) + (size_t)512 * D, D, 0, nullptr};
            pg8::GroupOrder S; S.init(MC / 256, 1536 / 256, 1, 48, bid - 192);
            pg8::EpiInproj E{nullptr, (bf16_t*)(ws + WS_CI), (_Float16*)(ws + WS_CLF), (_Float16*)(ws + WS_CLB), (const float*)(ws + WS_LB), 1, CT};
            pg8::gemm_phase<pg8::EpiInproj, false>(lds, g, S, E);
            pg8::Unit u; S.next(0, u);
            asm volatile("s_waitcnt vmcnt(0)" ::: "memory"); __syncthreads();
            if (tid == 0) { __builtin_amdgcn_fence(__ATOMIC_RELEASE, "agent"); asm volatile("s_waitcnt vmcnt(0)" ::: "memory");
                __hip_atomic_fetch_add(cnt + 64 * u.pm, 1u, __ATOMIC_RELAXED, __HIP_MEMORY_SCOPE_AGENT); }
        }
        if (bid >= 192) {
            const int b = (bid - 192) >> 3;
            if (tid == 0) { unsigned sp = 0; while (__hip_atomic_load(cnt + 64 * b, __ATOMIC_RELAXED, __HIP_MEMORY_SCOPE_AGENT) < 6u && ++sp < (1u << 22)) __builtin_amdgcn_s_sleep(2);
                __builtin_amdgcn_fence(__ATOMIC_ACQUIRE, "agent"); asm volatile("s_waitcnt vmcnt(0)" ::: "memory"); }
            __syncthreads();
        }
        phase_gla_states(a, lds, bid, wid, lane);
    }
    SEAM(3);
    if (IN(4)) phase_gla_out(a, lds, bid, wid, lane);
    SEAM(4);
    if (IN(5)) phase_mixfin(a, bid, G, wid, lane);
    SEAM(5);
    if (IN(6)) {
        pg8::Gemm g{(const bf16_t*)(ws + WS_ACT), (const bf16_t*)(ws + WS_WOUT), D, 0, nullptr};
        pg8::GroupOrder S; S.init(M / 256, D / 256, 1, G, bid);
        pg8::EpiOut E{a.x, a.out, (const float*)(ws + WS_MODF)};
        pg8::gemm_phase<pg8::EpiOut, false>(lds, g, S, E);
    }
    SEAM(6);
    if (IN(7)) phase_router(a, lds, bid, tid, wid, lane);
    SEAM(7);
    if (IN(8)) phase_topk_cvt(a, lds, bid, G, tid, wid, lane);
    SEAM(8);
    if (IN(9)) {
        pg8::Gemm g{(const bf16_t*)(ws + WS_ACT), (const bf16_t*)(ws + WS_WGU), D, (size_t)4096 * D * 2, (const int*)(ws + WS_SELTOK)};
        pg8::GroupOrder S; S.init(16, 16, NE, G, bid);
        pg8::EpiMoe1 E{(bf16_t*)(ws + WS_HID)};
        pg8::gemm_phase<pg8::EpiMoe1, true>(lds, g, S, E);
    }
    SEAM(9);
    if (IN(10)) {
        pg8::Gemm g{(const bf16_t*)(ws + WS_HID), (const bf16_t*)(ws + WS_WDN), DFF, (size_t)D * DFF * 2, nullptr};
        pg8::GroupOrder S; S.init(16, 4, NE, G, bid);
        pg8::EpiMoe2 E{(bf16_t*)(ws + WS_YS), (const float*)(ws + WS_SELGATE)};
        pg8::gemm_phase<pg8::EpiMoe2, false>(lds, g, S, E);
    }
    SEAM(10);
    if (IN(11)) phase_final(a, bid, G, wid, lane);

#undef IN
#undef SEAM
}

#ifndef N_LAUNCHES
#define N_LAUNCHES 1
#endif
extern "C" void kernel_launch(void* const* d_in, const int* in_sizes, int n_in, void* d_out, int out_size, void* d_ws, size_t ws_size, hipStream_t stream) {
    static int grid = 0;
    if (grid == 0) {
        if (n_in != 18 || out_size != M * D || ws_size < WS_END) { fprintf(stderr, "kernel_launch: unexpected shapes (n_in %d out %d ws %zu)\n", n_in, out_size, ws_size); grid = -1; return; }
        int dev = 0, cus = 0, per_cu = 0;
        (void)hipGetDevice(&dev); (void)hipDeviceGetAttribute(&cus, hipDeviceAttributeMultiprocessorCount, dev);
        (void)hipFuncSetAttribute((const void*)mega_fwd, hipFuncAttributeMaxDynamicSharedMemorySize, LDS_BYTES);
        (void)hipOccupancyMaxActiveBlocksPerMultiprocessor(&per_cu, (const void*)mega_fwd, 512, LDS_BYTES);
        if (per_cu < 1) { fprintf(stderr, "kernel_launch: occupancy query says %d blocks per CU\n", per_cu); grid = -1; return; }
        grid = 256;
        if (cus != 256) fprintf(stderr, "kernel_launch: note: %d CUs (built for 256)\n", cus);
    }
    if (grid < 0) return;
    Args a{};
    a.x = (const float*)d_in[0]; a.c = (const float*)d_in[1]; a.ctx = (const float*)d_in[2]; a.c_ctx = (const float*)d_in[3]; a.w_ada = (const float*)d_in[4]; a.b_ada = (const float*)d_in[5];
    a.norm_mix = (const float*)d_in[6]; a.norm_ffn = (const float*)d_in[7]; a.w_in = (const float*)d_in[8]; a.lb_logits = (const float*)d_in[9]; a.hg_norm = (const float*)d_in[10];
    a.conv_w = (const float*)d_in[11]; a.w_out = (const float*)d_in[12]; a.w_router = (const float*)d_in[13]; a.w_gate = (const float*)d_in[14]; a.w_up = (const float*)d_in[15];
    a.w_down = (const float*)d_in[16]; a.norm_final = (const float*)d_in[17]; a.out = (float*)d_out; a.ws = (uchar*)d_ws;
    if (N_LAUNCHES == 1) {
        (void)hipMemsetAsync((char*)d_ws + WS_BAR, 0, 16384, stream);
        a.ph_lo = 0; a.ph_hi = NPHASE;
        hipLaunchKernelGGL(mega_fwd, dim3(grid), dim3(512), LDS_BYTES, stream, a);
    } else {
        for (int p = 0; p < NPHASE; ++p) { a.ph_lo = p; a.ph_hi = p + 1; void* args[] = {&a};
            hipError_t e = hipLaunchCooperativeKernel((const void*)mega_fwd, dim3(grid), dim3(512), args, LDS_BYTES, stream);
            if (e != hipSuccess) { fprintf(stderr, "launch %d failed: %s\n", p, hipGetErrorString(e)); break; } }
    }
}
```

```cpp
#include <hip/hip_runtime.h>
#include <cstdio>

#define LAS __attribute__((address_space(3)))
#define GAS __attribute__((address_space(1)))
typedef unsigned short bf16_t;
typedef short bf16x8 __attribute__((ext_vector_type(8)));
typedef float f32x4 __attribute__((ext_vector_type(4)));
typedef float f32x2 __attribute__((ext_vector_type(2)));
typedef unsigned u32x4 __attribute__((ext_vector_type(4)));
typedef unsigned u32x2 __attribute__((ext_vector_type(2)));
typedef unsigned char uchar;

constexpr int D = 1024, NB = 8, T = 4096, M = NB * T, CT = 256, MC = NB * CT;
constexpr int NIN = 4096, HK = 512, NH = 4, NE = 16, CAP = 512, DFF = 2048, NMOD = 6 * D;
constexpr float EPS = 1e-6f;
constexpr int NPHASE = 12;

constexpr size_t MiB = 1u << 20;
constexpr size_t WS_ACT = 0;
constexpr size_t WS_WIN = 64 * MiB;
constexpr size_t WS_WOUT = 72 * MiB;
constexpr size_t WS_MODP = 74 * MiB;
constexpr size_t WS_MODF = 76 * MiB;
constexpr size_t WS_LB = 76 * MiB + 512 * 1024;
constexpr size_t WS_HC = 77 * MiB;
constexpr size_t WS_CLF = 81 * MiB;
constexpr size_t WS_CLB = 85 * MiB;
constexpr size_t WS_CI = 89 * MiB;
constexpr size_t WS_S0 = 91 * MiB;
constexpr size_t WS_AFF = 95 * MiB;
constexpr size_t WS_SELTOK = 97 * MiB;
constexpr size_t WS_SELGATE = 97 * MiB + 256 * 1024;
constexpr size_t WS_POS = 98 * MiB;
constexpr size_t WS_BAR = 100 * MiB;
constexpr size_t WS_SL = 488 * MiB;
constexpr size_t WS_DL = 500 * MiB;
constexpr size_t WS_ZQ = 104 * MiB;
constexpr size_t WS_LF = 136 * MiB;
constexpr size_t WS_LBW = 200 * MiB;
constexpr size_t WS_ZI = 264 * MiB;
constexpr size_t WS_ZG = 296 * MiB;
constexpr size_t WS_ZGB = 328 * MiB;
constexpr size_t WS_ZGC = 360 * MiB;
constexpr size_t WS_ZV = 392 * MiB;
constexpr size_t WS_OF = 424 * MiB;
constexpr size_t WS_OB = 456 * MiB;
constexpr size_t WS_WGU = 104 * MiB;
constexpr size_t WS_WDN = 232 * MiB;
constexpr size_t WS_HID = 296 * MiB;
constexpr size_t WS_YS = WS_WGU;
constexpr size_t WS_END = 552 * MiB;
static_assert(WS_ZI == WS_ZQ + 160 * MiB && WS_ZG == WS_ZI + 32 * MiB && WS_ZGB == WS_ZG + 32 * MiB && WS_ZGC == WS_ZGB + 32 * MiB && WS_ZV == WS_ZGC + 32 * MiB, "z segment map");

constexpr int LDS_BYTES = 147456;

typedef __bf16 bf16x2_t __attribute__((ext_vector_type(2)));
__device__ __forceinline__ unsigned cvt_pk_bf16_safe(float lo, float hi) { typedef float f2_t __attribute__((ext_vector_type(2))); const bf16x2_t v = __builtin_convertvector((f2_t){lo, hi}, bf16x2_t); return __builtin_bit_cast(unsigned, v); }
__device__ __forceinline__ unsigned cvt_pk_bf16(float lo, float hi) { unsigned r; asm volatile("v_cvt_pk_bf16_f32 %0, %1, %2" : "=v"(r) : "v"(lo), "v"(hi)); return r; }
__device__ __forceinline__ float bf_lo(unsigned u) { return __uint_as_float(u << 16); }
__device__ __forceinline__ float bf_hi(unsigned u) { return __uint_as_float(u & 0xffff0000u); }
__device__ __forceinline__ float wave_sum(float v) {
#pragma unroll
    for (int o = 1; o < 64; o <<= 1) v += __shfl_xor(v, o);
    return v;
}
__device__ __forceinline__ float silu_f(float x) { return x * __builtin_amdgcn_rcpf(1.f + __builtin_amdgcn_exp2f(x * -1.44269504f)); }
#define LDS_WAIT() asm volatile("s_waitcnt lgkmcnt(0)" ::: "memory")


#define XB_TMO      128
#define XB_XCNT(j)  (256  + 64 * (j))
#define XB_XSUB(j)  (1280 + 64 * (j))
#define XB_XGEN(j)  (2304 + 64 * (j))
#define XB_TOP      3328
#define XB_TOPGEN   3392
#define XCD_BAR_WORDS 3456
#define XB_SPIN_CAP (1u << 20)
__device__ __forceinline__ unsigned xb_ld(unsigned* p)              { return __hip_atomic_load(p, __ATOMIC_RELAXED, __HIP_MEMORY_SCOPE_AGENT); }
__device__ __forceinline__ unsigned xb_add(unsigned* p, unsigned v) { return __hip_atomic_fetch_add(p, v, __ATOMIC_RELAXED, __HIP_MEMORY_SCOPE_AGENT); }
__device__ __forceinline__ unsigned xb_xcc_id() { return (unsigned)__builtin_amdgcn_s_getreg((3 << 11) | 20) & 0xFu; }
#define XB_SPIN(cond, bar) do { unsigned _sp = 0; while (cond) { __builtin_amdgcn_s_sleep(1); \
    if ((++_sp & 255u) == 0u) { if (xb_ld(&(bar)[XB_TMO])) break; if (_sp > XB_SPIN_CAP) { atomicAdd(&(bar)[XB_TMO], 1u); break; } } } } while (0)
struct XcdBarrier { unsigned* bar; unsigned x; volatile LAS unsigned* st; };
__device__ __forceinline__ XcdBarrier xcd_barrier_post(unsigned* bar, volatile LAS unsigned* st) {
    XcdBarrier b; b.bar = bar; b.x = xb_xcc_id(); b.st = st;
    if (threadIdx.x == 0) (void)xb_add(&bar[XB_XCNT(b.x)], 1u);
    return b;
}
__device__ __forceinline__ void xcd_barrier_complete(unsigned* bar, unsigned x, unsigned& nloc, unsigned& nx) {
    const unsigned G = gridDim.x * gridDim.y * gridDim.z;
    unsigned sum, cnt, mine, sp = 0u;
    for (;;) {
        sum = 0u; cnt = 0u; mine = 0u;
#pragma unroll
        for (unsigned j = 0; j < 16; ++j) { const unsigned c = xb_ld(&bar[XB_XCNT(j)]); sum += c; cnt += (c > 0u) ? 1u : 0u; mine = (j == x) ? c : mine; }
        if (sum == G) break;
        __builtin_amdgcn_s_sleep(1);
        if ((++sp & 255u) == 0u) { if (xb_ld(&bar[XB_TMO])) break; if (sp > XB_SPIN_CAP) { atomicAdd(&bar[XB_TMO], 1u); break; } }
    }
    nloc = mine > 0u ? mine : 1u; nx = cnt > 0u ? cnt : 1u;
}
__device__ __forceinline__ void xcd_barrier(const XcdBarrier& b) {
    asm volatile("s_waitcnt vmcnt(0)" ::: "memory");
    __syncthreads();
    if (threadIdx.x == 0) {
        unsigned* bar = b.bar;
        __builtin_amdgcn_s_waitcnt(0);
        unsigned nloc = b.st[0], nx = b.st[1];
        if (nloc == 0u) { xcd_barrier_complete(bar, b.x, nloc, nx); b.st[0] = nloc; b.st[1] = nx; }
        const unsigned old = xb_add(&bar[XB_XSUB(b.x)], 1u);
        const unsigned gen = old / nloc;
        if (old + 1u == (gen + 1u) * nloc) {
            __builtin_amdgcn_fence(__ATOMIC_RELEASE, "agent");
            asm volatile("s_waitcnt vmcnt(0)" ::: "memory");
            const unsigned og = xb_add(&bar[XB_TOP], 1u);
            const unsigned tg = og / nx;
            if (og + 1u == (tg + 1u) * nx) xb_add(&bar[XB_TOPGEN], 1u);
            else XB_SPIN(xb_ld(&bar[XB_TOPGEN]) == tg, bar);
            __builtin_amdgcn_fence(__ATOMIC_ACQUIRE, "agent");
            xb_add(&bar[XB_XGEN(b.x)], 1u);
            asm volatile("s_waitcnt vmcnt(0)" ::: "memory");
        } else {
            XB_SPIN(xb_ld(&bar[XB_XGEN(b.x)]) == gen, bar);
            __builtin_amdgcn_fence(__ATOMIC_ACQUIRE, "agent");
            asm volatile("s_waitcnt vmcnt(0)" ::: "memory");
        }
    }
    __syncthreads();
}

namespace pg8 {
constexpr int BM = 256, BK = 64, HALF = 128, HTB = HALF * BK * 2, STAGE_BYTES = 8 * HTB, NXCD = 8, WGM = 8;
__device__ __forceinline__ int lds_byte(int r, int c) { const int st = (r >> 4) * 2 + (c >> 5), rr = r & 15, cc = c & 31, ob = rr * 64 + cc * 2; return st * 1024 + (ob ^ (((ob >> 9) & 1) << 5)); }
__device__ __forceinline__ void stage_rc(int b, int& R, int& C) { const int st = b / 1024, sb = b % 1024, swz = sb ^ (((sb >> 9) & 1) << 5); R = (st >> 1) * 16 + swz / 64; C = (st & 1) * 32 + (swz % 64) / 2; }
__device__ __forceinline__ int perm32(int rho) { const int n = rho >> 4, i = rho & 15; return 8 * (i >> 2) + 4 * n + (i & 3); }

struct Unit { int pm, pn, e; };
struct GroupOrder {
    int nM, nN, ng, G, c;
    __device__ __forceinline__ void init(int nM_, int nN_, int ng_, int G_, int c_) { nM = nM_; nN = nN_; ng = ng_; G = G_; c = c_; }
    __device__ __forceinline__ bool next(int i, Unit& u) const {
        const int nwg = nM * nN; const long L = (long)i * G + c; if (L >= (long)nwg * ng) return false;
        const int grp = (int)(L / nwg); int wgid = (int)(L % nwg);
        { const int q = nwg / NXCD, r = nwg % NXCD, xcd = wgid % NXCD, off = wgid / NXCD; wgid = (xcd < r ? xcd * (q + 1) : r * (q + 1) + (xcd - r) * q) + off; }
        const int nig = WGM * nN, gid = wgid / nig, fm = gid * WGM, gsz = (nM - fm) < WGM ? (nM - fm) : WGM;
        u.pm = grp * nM + fm + ((wgid % nig) % gsz); u.pn = (wgid % nig) / gsz; u.e = grp; return true;
    }
};
struct Moe2Order {
    int c;
    __device__ __forceinline__ bool next(int i, Unit& u) const { if (i >= 4) return false; const int x = c & 7, j = c >> 3; u.e = 4 * i + (j >> 3); u.pm = u.e * 16 + 2 * x + ((j & 7) >> 2); u.pn = j & 3; return true; }
};
struct Gemm { const bf16_t* A; const bf16_t* Bt; int K; size_t bgs; const int* rowidx; };

template <class Epi, bool GATHER, class Sched = GroupOrder>
__device__ __forceinline__ void gemm_phase(LAS uchar* lds, const Gemm g, const Sched& S, const Epi& E) {
    const int tid = threadIdx.x, wid = __builtin_amdgcn_readfirstlane(tid >> 6), lane = tid & 63, wr = wid >> 2, wc = wid & 3, fr = lane & 15, fq = lane >> 4;
    const int K = g.K, nt = K / BK;
    unsigned voffA[2], voffB[2]; int Rr[2], Cc[2];
#pragma unroll
    for (int i = 0; i < 2; ++i) { int R, C; stage_rc(tid * 16 + i * 8192, R, C); const int Rb = Epi::PERM ? ((R & ~31) + perm32(R & 31)) : R; Rr[i] = R; Cc[i] = C;
        voffA[i] = (unsigned)(R * K + C) * 2u; voffB[i] = (unsigned)(Rb * K + C) * 2u; }
    const size_t kstep = (size_t)(BK * 2);
    const size_t hstep = (size_t)HALF * K * 2;
    const size_t tstep = 2 * hstep;
    const unsigned ldsw = (unsigned)wid * 1024u;
    const int aoff = lds_byte(wr * 64 + fr, fq * 8), boff = lds_byte(wc * 32 + fr, fq * 8);
#define PG8_SA(b, h) (((b) * 2 + (h)) * HTB)
#define PG8_SB(b, h) ((4 + (b) * 2 + (h)) * HTB)
#define PG8_STAGE(bufoff, gbase, voff) do { _Pragma("unroll") for (int _i = 0; _i < 2; ++_i) \
        __builtin_amdgcn_global_load_lds((const unsigned*)((const char*)(gbase) + (voff)[_i]), (LAS unsigned*)(lds + (bufoff) + ldsw + _i * 8192), 16, 0, 0); } while (0)
#define PG8_STAGE_A(bufoff, p, ofs, h) do { if constexpr (GATHER) { PG8_STAGE(bufoff, p, (ofs)[h]); } else { PG8_STAGE(bufoff, (p) + (h) * hstep, voffA); } } while (0)
#define PG8_LDA(dst, b, h) do { _Pragma("unroll") for (int m = 0; m < 4; ++m) _Pragma("unroll") for (int k = 0; k < 2; ++k) dst[m][k] = *(const LAS bf16x8*)(lds + PG8_SA(b, h) + aoff + m * 2048 + k * 1024); } while (0)
#define PG8_LDB(dst, b, h) do { _Pragma("unroll") for (int n = 0; n < 2; ++n) _Pragma("unroll") for (int k = 0; k < 2; ++k) dst[n][k] = *(const LAS bf16x8*)(lds + PG8_SB(b, h) + boff + n * 2048 + k * 1024); } while (0)
#define PG8_MMA(ai, bj, At, Bt) do { __builtin_amdgcn_s_setprio(1); _Pragma("unroll") for (int m = 0; m < 4; ++m) _Pragma("unroll") for (int n = 0; n < 2; ++n) _Pragma("unroll") for (int k = 0; k < 2; ++k) \
        acc[ai][bj][m][n] = __builtin_amdgcn_mfma_f32_16x16x32_bf16(Bt[n][k], At[m][k], acc[ai][bj][m][n], 0, 0, 0); __builtin_amdgcn_s_setprio(0); } while (0)
#define PG8_WAIT_V(n) asm volatile("s_waitcnt vmcnt(" #n ")" ::: "memory")
#define PG8_WAIT_L(n) asm volatile("s_waitcnt lgkmcnt(" #n ")" ::: "memory")
#define PG8_BAR __builtin_amdgcn_s_barrier()
#define PG8_SCHED __builtin_amdgcn_sched_barrier(0)
    Unit cur, nxt; int ui = 0;
    if (!S.next(0, cur)) return;
    f32x4 acc[2][2][4][2];
#pragma unroll
    for (int a = 0; a < 2; ++a)
#pragma unroll
        for (int b = 0; b < 2; ++b)
#pragma unroll
            for (int m = 0; m < 4; ++m)
#pragma unroll
                for (int n = 0; n < 2; ++n) acc[a][b][m][n] = (f32x4){0.f, 0.f, 0.f, 0.f};
    bf16x8 At[4][2], B0[2][2], B1[2][2];
    unsigned cofs[2][2], nofs[2][2];
    LAS unsigned short* ridx = (LAS unsigned short*)(lds + STAGE_BYTES);
    if constexpr (GATHER) {
        { Unit tu; for (int uu = 0; uu < 16 && S.next(uu, tu); ++uu) if (tid < BM) ridx[uu * BM + tid] = (unsigned short)g.rowidx[tu.pm * BM + tid]; }
        asm volatile("s_waitcnt vmcnt(0) lgkmcnt(0)" ::: "memory"); __builtin_amdgcn_s_barrier(); asm volatile("" ::: "memory");
#pragma unroll
        for (int h = 0; h < 2; ++h)
#pragma unroll
            for (int i = 0; i < 2; ++i) { const int row = ridx[h * HALF + Rr[i]]; cofs[h][i] = (unsigned)(row * K + Cc[i]) * 2u; nofs[h][i] = cofs[h][i]; }
    }
    const char* cA = GATHER ? (const char*)g.A : (const char*)g.A + (size_t)cur.pm * tstep;
    const char* cB = (const char*)g.Bt + (size_t)cur.e * g.bgs + (size_t)cur.pn * tstep;
    PG8_STAGE(PG8_SB(0, 0), cB, voffB); PG8_STAGE(PG8_SB(0, 1), cB + hstep, voffB); PG8_STAGE_A(PG8_SA(0, 0), cA, cofs, 0); PG8_STAGE_A(PG8_SA(0, 1), cA, cofs, 1);
    if (wr == 1) PG8_BAR;
    PG8_WAIT_V(2); PG8_BAR;
    PG8_STAGE(PG8_SB(1, 0), cB + kstep, voffB); PG8_STAGE_A(PG8_SA(1, 0), cA + kstep, cofs, 0); PG8_STAGE(PG8_SB(1, 1), cB + hstep + kstep, voffB);
    PG8_WAIT_V(6); PG8_BAR;
    for (;;) {
        const bool has_next = S.next(ui + 1, nxt);
        const char* nA = GATHER ? (const char*)g.A : (has_next ? (const char*)g.A + (size_t)nxt.pm * tstep : cA);
        const char* nB = has_next ? (const char*)g.Bt + (size_t)nxt.e * g.bgs + (size_t)nxt.pn * tstep : cB;
        for (int t = 0; t < nt; t += 2) {
            const bool last = (t == nt - 2);
            const char* a1 = cA + (size_t)(t + 1) * kstep;
            const char* a2 = last ? nA : cA + (size_t)(t + 2) * kstep; const char* b2 = last ? nB : cB + (size_t)(t + 2) * kstep;
            const char* a3 = a2 + kstep; const char* b3 = b2 + kstep;
            if constexpr (GATHER) {
                if (last && has_next) {
#pragma unroll
                    for (int h = 0; h < 2; ++h)
#pragma unroll
                        for (int i = 0; i < 2; ++i) { const int row = ridx[(ui + 1) * BM + h * HALF + Rr[i]]; nofs[h][i] = (unsigned)(row * K + Cc[i]) * 2u; }
                }
            }
            PG8_LDB(B0, 0, 0); PG8_LDB(B1, 0, 1); PG8_SCHED; PG8_LDA(At, 0, 0); PG8_STAGE_A(PG8_SA(1, 1), a1, cofs, 1);
            PG8_WAIT_V(8); PG8_WAIT_L(0); PG8_BAR; PG8_MMA(0, 0, At, B0); PG8_MMA(0, 1, At, B1); PG8_BAR; PG8_SCHED;
            PG8_LDA(At, 0, 1); PG8_STAGE(PG8_SB(0, 0), b2, voffB); PG8_STAGE(PG8_SB(0, 1), b2 + hstep, voffB);
            if (last) { PG8_STAGE_A(PG8_SA(0, 0), a2, nofs, 0); } else { PG8_STAGE_A(PG8_SA(0, 0), a2, cofs, 0); }
            PG8_WAIT_V(8); PG8_WAIT_L(0); PG8_BAR; PG8_MMA(1, 0, At, B0); PG8_MMA(1, 1, At, B1); PG8_BAR; PG8_SCHED;
            PG8_LDB(B0, 1, 0); PG8_LDB(B1, 1, 1); PG8_SCHED; PG8_LDA(At, 1, 0);
            if (last) { PG8_STAGE_A(PG8_SA(0, 1), a2, nofs, 1); } else { PG8_STAGE_A(PG8_SA(0, 1), a2, cofs, 1); }
            PG8_WAIT_V(8); PG8_WAIT_L(0); PG8_BAR; PG8_MMA(0, 0, At, B0); PG8_MMA(0, 1, At, B1); PG8_BAR; PG8_SCHED;
            PG8_LDA(At, 1, 1); PG8_STAGE(PG8_SB(1, 0), b3, voffB); PG8_STAGE(PG8_SB(1, 1), b3 + hstep, voffB);
            if (last) { PG8_STAGE_A(PG8_SA(1, 0), a3, nofs, 0); } else { PG8_STAGE_A(PG8_SA(1, 0), a3, cofs, 0); }
            PG8_WAIT_V(8); PG8_WAIT_L(0); PG8_BAR; PG8_MMA(1, 0, At, B0); PG8_MMA(1, 1, At, B1); PG8_BAR; PG8_SCHED;
        }
        if (wr == 0) PG8_BAR;
        E(acc, cur, wr, wc, fr, fq);
        if (!has_next) break;
#pragma unroll
        for (int a = 0; a < 2; ++a)
#pragma unroll
            for (int b = 0; b < 2; ++b)
#pragma unroll
                for (int m = 0; m < 4; ++m)
#pragma unroll
                    for (int n = 0; n < 2; ++n) acc[a][b][m][n] = (f32x4){0.f, 0.f, 0.f, 0.f};
        cur = nxt; cA = nA; cB = nB; ++ui;
        if constexpr (GATHER) {
#pragma unroll
            for (int h = 0; h < 2; ++h)
#pragma unroll
                for (int i = 0; i < 2; ++i) cofs[h][i] = nofs[h][i];
        }
        if (wr == 1) PG8_BAR;
    }
    PG8_WAIT_V(0);
    PG8_BAR;
#undef PG8_SA
#undef PG8_SB
#undef PG8_STAGE
#undef PG8_STAGE_A
#undef PG8_LDA
#undef PG8_LDB
#undef PG8_MMA
#undef PG8_WAIT_V
#undef PG8_WAIT_L
#undef PG8_BAR
#undef PG8_SCHED
}


struct EpiInproj {
    static constexpr bool PERM = true;
    uchar* zbase; bf16_t* ci; _Float16* olog0; _Float16* olog1; const float* lb; int seg0; int Tn;
    __device__ __forceinline__ void operator()(const f32x4 (&acc)[2][2][4][2], const Unit& u, int wr, int wc, int fr, int fq) const {
        const int seg = seg0 + (u.pn >> 1);
        const int row0 = u.pm * BM + wr * 64 + fr;
        if (seg <= 3) {
            const int b = (u.pm * BM) / Tn, t0 = row0 - b * Tn, dcol = wc * 32 + 8 * fq;
#pragma unroll
            for (int bj = 0; bj < 2; ++bj) { const int hh = (u.pn & 1) * 2 + bj; const size_t plane = (size_t)(b * NH + hh) * Tn;
                if (seg == 1 || seg == 2) {
                    _Float16* O = (seg == 1) ? olog0 : olog1; const float* lbp = lb + (seg - 1) * 512 + hh * 128 + dcol;
                    const f32x4 l0 = *(const f32x4*)lbp, l1 = *(const f32x4*)(lbp + 4);
#pragma unroll
                    for (int ai = 0; ai < 2; ++ai)
#pragma unroll
                        for (int m = 0; m < 4; ++m) { const f32x4 v0 = acc[ai][bj][m][0], v1 = acc[ai][bj][m][1]; _Float16 o[8];
#pragma unroll
                            for (int j = 0; j < 4; ++j) { const float s0 = __builtin_amdgcn_rcpf(1.f + __builtin_amdgcn_exp2f(v0[j] * -1.44269504f)), s1 = __builtin_amdgcn_rcpf(1.f + __builtin_amdgcn_exp2f(v1[j] * -1.44269504f));
                                o[j] = (_Float16)__builtin_amdgcn_logf(l0[j] + (1.f - l0[j]) * s0); o[4 + j] = (_Float16)__builtin_amdgcn_logf(l1[j] + (1.f - l1[j]) * s1); }
                            *(u32x4*)(O + (plane + t0 + ai * HALF + m * 16) * 128 + dcol) = __builtin_bit_cast(u32x4, o); }
                } else {
                    bf16_t* O = zbase ? (bf16_t*)(zbase + (size_t)(seg == 0 ? 0 : 160) * MiB) : ci;
#pragma unroll
                    for (int ai = 0; ai < 2; ++ai)
#pragma unroll
                        for (int m = 0; m < 4; ++m) { const f32x4 v0 = acc[ai][bj][m][0], v1 = acc[ai][bj][m][1];
                            u32x4 w; w.x = cvt_pk_bf16(v0[0], v0[1]); w.y = cvt_pk_bf16(v0[2], v0[3]); w.z = cvt_pk_bf16(v1[0], v1[1]); w.w = cvt_pk_bf16(v1[2], v1[3]);
                            *(u32x4*)(O + (plane + t0 + ai * HALF + m * 16) * 128 + dcol) = w; }
                }
            }
        } else {
            const int col0 = (u.pn & 1) * 256 + wc * 32 + 8 * fq;
            bf16_t* O = (bf16_t*)(zbase + (size_t)(32 * seg + 64) * MiB);
#pragma unroll
            for (int ai = 0; ai < 2; ++ai)
#pragma unroll
                for (int m = 0; m < 4; ++m) { bf16_t* rowp = O + (size_t)(row0 + ai * HALF + m * 16) * 512 + col0;
#pragma unroll
                    for (int bj = 0; bj < 2; ++bj) { const f32x4 v0 = acc[ai][bj][m][0], v1 = acc[ai][bj][m][1];
                        u32x4 w; w.x = cvt_pk_bf16(v0[0], v0[1]); w.y = cvt_pk_bf16(v0[2], v0[3]); w.z = cvt_pk_bf16(v1[0], v1[1]); w.w = cvt_pk_bf16(v1[2], v1[3]);
                        *(u32x4*)(rowp + bj * HALF) = w; } }
        }
    }
};
struct EpiOut {
    static constexpr bool PERM = false;
    const float* x; float* x1; const float* modf;
    __device__ __forceinline__ void operator()(const f32x4 (&acc)[2][2][4][2], const Unit& u, int wr, int wc, int fr, int fq) const {
        const int row0 = u.pm * BM + wr * 64 + fr, col0 = u.pn * BM + wc * 32 + 4 * fq;
        const int b = (u.pm * BM) / T;
        const float* g1 = modf + (size_t)b * NMOD + 2 * D;
        f32x4 gv[2][2];
#pragma unroll
        for (int bj = 0; bj < 2; ++bj)
#pragma unroll
            for (int n = 0; n < 2; ++n) gv[bj][n] = *(const f32x4*)(g1 + col0 + bj * HALF + n * 16);
#pragma unroll
        for (int ai = 0; ai < 2; ++ai)
#pragma unroll
            for (int m = 0; m < 4; ++m) { const size_t off = (size_t)(row0 + ai * HALF + m * 16) * D + col0;
#pragma unroll
                for (int bj = 0; bj < 2; ++bj)
#pragma unroll
                    for (int n = 0; n < 2; ++n) { const f32x4 xs = *(const f32x4*)(x + off + bj * HALF + n * 16); *(f32x4*)(x1 + off + bj * HALF + n * 16) = xs + gv[bj][n] * acc[ai][bj][m][n]; }
                asm volatile("" ::: "memory"); }
    }
};
struct EpiMoe1 {
    static constexpr bool PERM = true;
    bf16_t* hid;
    __device__ __forceinline__ void operator()(const f32x4 (&acc)[2][2][4][2], const Unit& u, int wr, int wc, int fr, int fq) const {
        const int row0 = u.pm * BM + wr * 64 + fr, col0 = u.pn * 128 + wc * 32 + 8 * fq;
#pragma unroll
        for (int ai = 0; ai < 2; ++ai)
#pragma unroll
            for (int m = 0; m < 4; ++m) { bf16_t* rowp = hid + (size_t)(row0 + ai * HALF + m * 16) * DFF + col0;
                float o[8];
#pragma unroll
                for (int n = 0; n < 2; ++n)
#pragma unroll
                    for (int j = 0; j < 4; ++j) { const float gt = acc[ai][0][m][n][j], up = acc[ai][1][m][n][j]; o[n * 4 + j] = gt * up * __builtin_amdgcn_rcpf(1.f + __builtin_amdgcn_exp2f(gt * -1.44269504f)); }
                u32x4 w; w.x = cvt_pk_bf16(o[0], o[1]); w.y = cvt_pk_bf16(o[2], o[3]); w.z = cvt_pk_bf16(o[4], o[5]); w.w = cvt_pk_bf16(o[6], o[7]);
                *(u32x4*)rowp = w; }
    }
};
struct EpiMoe2 {
    static constexpr bool PERM = true;
    bf16_t* ys; const float* gate;
    __device__ __forceinline__ void operator()(const f32x4 (&acc)[2][2][4][2], const Unit& u, int wr, int wc, int fr, int fq) const {
        const int row0 = u.pm * BM + wr * 64 + fr, col0 = u.pn * BM + wc * 32 + 8 * fq;
#pragma unroll
        for (int ai = 0; ai < 2; ++ai)
#pragma unroll
            for (int m = 0; m < 4; ++m) { const int row = row0 + ai * HALF + m * 16; const float gt = gate[row]; bf16_t* rowp = ys + (size_t)row * D + col0;
#pragma unroll
                for (int bj = 0; bj < 2; ++bj) { const f32x4 v0 = acc[ai][bj][m][0] * gt, v1 = acc[ai][bj][m][1] * gt;
                    u32x4 w; w.x = cvt_pk_bf16(v0[0], v0[1]); w.y = cvt_pk_bf16(v0[2], v0[3]); w.z = cvt_pk_bf16(v1[0], v1[1]); w.w = cvt_pk_bf16(v1[2], v1[3]);
                    *(u32x4*)(rowp + bj * HALF) = w; } }
    }
};
}

struct Args {
    const float *x, *c, *ctx, *c_ctx, *w_ada, *b_ada, *norm_mix, *norm_ffn, *w_in, *lb_logits, *hg_norm, *conv_w, *w_out, *w_router, *w_gate, *w_up, *w_down, *norm_final;
    float* out; uchar* ws; int ph_lo, ph_hi;
};

__device__ __forceinline__ void cvt_item(const float* W, int ldw, bf16_t* WT, int ldt, int k0, int n0, int nrow0, LAS float* scr, int lane) {
    const int r = lane >> 3, c4 = lane & 7;
    f32x4 v[8];
#pragma unroll
    for (int i = 0; i < 8; ++i) v[i] = *(const f32x4*)(W + (size_t)(k0 + 8 * i + r) * ldw + n0 + 4 * c4);
#pragma unroll
    for (int i = 0; i < 8; ++i) { LAS float* d = scr + (8 * i + r) * 33 + 4 * c4; d[0] = v[i].x; d[1] = v[i].y; d[2] = v[i].z; d[3] = v[i].w; }
    LDS_WAIT(); asm volatile("" ::: "memory");
    const int c = lane & 7;
#pragma unroll
    for (int j = 0; j < 4; ++j) { const int n = (lane >> 3) + 8 * j; const LAS float* sp = scr + (8 * c) * 33 + n;
        u32x4 o; o.x = cvt_pk_bf16(sp[0 * 33], sp[1 * 33]); o.y = cvt_pk_bf16(sp[2 * 33], sp[3 * 33]); o.z = cvt_pk_bf16(sp[4 * 33], sp[5 * 33]); o.w = cvt_pk_bf16(sp[6 * 33], sp[7 * 33]);
        *(u32x4*)(WT + (size_t)(nrow0 + n) * ldt + k0 + 8 * c) = o; }
    LDS_WAIT(); asm volatile("" ::: "memory");
}

__device__ __forceinline__ void phase_prep(const Args& a, LAS uchar* lds, int bid, int G, int tid, int wid, int lane) {
    float* modp = (float*)(a.ws + WS_MODP);
    if (bid < 192) {
        const int cgp = bid % 24, ks = bid / 24, n0 = cgp * 256 + lane * 4, k0 = ks * 128 + wid * 16;
        f32x4 acc[9];
#pragma unroll
        for (int r = 0; r < 9; ++r) acc[r] = (f32x4){0.f, 0.f, 0.f, 0.f};
#pragma unroll 4
        for (int kk = 0; kk < 16; ++kk) { const int k = k0 + kk; const f32x4 w = *(const f32x4*)(a.w_ada + (size_t)k * NMOD + n0);
#pragma unroll
            for (int r = 0; r < 9; ++r) { const float cv = (r < 8) ? a.c[r * D + k] : a.c_ctx[k]; const float s = silu_f(cv); acc[r] += w * s; } }
        LAS f32x4* red = (LAS f32x4*)lds;
#pragma unroll
        for (int r = 0; r < 9; ++r) red[(wid * 9 + r) * 64 + lane] = acc[r];
        __syncthreads();
        for (int o = tid; o < 9 * 64; o += 512) { const int r = o / 64, l = o % 64; f32x4 s = red[(0 * 9 + r) * 64 + l];
#pragma unroll
            for (int w = 1; w < 8; ++w) s += red[(w * 9 + r) * 64 + l];
            if (ks == 0) s += *(const f32x4*)(a.b_ada + cgp * 256 + l * 4);
            *(f32x4*)(modp + ((size_t)ks * 9 + r) * NMOD + cgp * 256 + l * 4) = s; }
        __syncthreads();
    }
    if (bid == 255) {
        float* lb = (float*)(a.ws + WS_LB);
        for (int i = tid; i < 1024; i += 512) { const float l0 = a.lb_logits[i], l1 = a.lb_logits[1024 + i]; lb[i] = 1.f / (1.f + __expf(l1 - l0)); }
    }
    LAS float* scr = (LAS float*)lds + wid * (64 * 33);
    const int gw = (G - 1 - bid) * 8 + wid, NGW = G * 8;
    constexpr int I_IN = (D / 64) * (NIN / 32), I_OUT = (D / 64) * (D / 32);
    for (int it = gw; it < I_IN + I_OUT; it += NGW) {
        if (it < I_IN) { const int nblk = NIN / 32, kb = it / nblk, nb = it % nblk; cvt_item(a.w_in, NIN, (bf16_t*)(a.ws + WS_WIN), D, kb * 64, nb * 32, nb * 32, scr, lane); }
        else { const int r = it - I_IN, nblk = D / 32, kb = r / nblk, nb = r % nblk; cvt_item(a.w_out, D, (bf16_t*)(a.ws + WS_WOUT), D, kb * 64, nb * 32, nb * 32, scr, lane); }
    }
}

__device__ __forceinline__ float modp_sum(const float* modp, int r, int col) { float s = 0.f;
#pragma unroll
    for (int ks = 0; ks < 8; ++ks) s += modp[((size_t)ks * 9 + r) * NMOD + col];
    return s; }
template <int NR>
__device__ __forceinline__ void norm_rows(const float* xrow0, bf16_t* orow0, const LAS float* gm, const LAS float* sh, int lane) {
    f32x4 v[NR][4]; float ss[NR];
#pragma unroll
    for (int i = 0; i < NR; ++i) { ss[i] = 0.f;
#pragma unroll
        for (int j = 0; j < 4; ++j) v[i][j] = *((const f32x4*)(xrow0 + (size_t)i * D) + lane + 64 * j); }
#pragma unroll
    for (int i = 0; i < NR; ++i) {
#pragma unroll
        for (int j = 0; j < 4; ++j) ss[i] += (v[i][j].x * v[i][j].x + v[i][j].y * v[i][j].y) + (v[i][j].z * v[i][j].z + v[i][j].w * v[i][j].w);
        ss[i] = rsqrtf(wave_sum(ss[i]) * (1.f / D) + EPS); }
#pragma unroll
    for (int j = 0; j < 4; ++j) { const f32x4 g4 = *((const LAS f32x4*)gm + lane + 64 * j), s4 = *((const LAS f32x4*)sh + lane + 64 * j);
#pragma unroll
        for (int i = 0; i < NR; ++i) { const f32x4 o = v[i][j] * ss[i] * g4 + s4;
            u32x2 w; w.x = cvt_pk_bf16(o.x, o.y); w.y = cvt_pk_bf16(o.z, o.w); *((u32x2*)(orow0 + (size_t)i * D) + lane + 64 * j) = w; } }
}
__device__ __forceinline__ void phase_norm(const Args& a, LAS uchar* lds, int bid, int G, int tid, int wid, int lane) {
    const float* modp = (const float*)(a.ws + WS_MODP); float* modf = (float*)(a.ws + WS_MODF);
    { const int gt = bid * 512 + tid; if (gt < 9 * NMOD) modf[gt] = modp_sum(modp, gt / NMOD, gt % NMOD); }
    LAS float* gm = (LAS float*)lds; LAS float* sh = gm + D; LAS float* cgm = sh + D; LAS float* csh = cgm + D;
    const int b = bid / 32;
    for (int cidx = tid; cidx < D; cidx += 512) { const float nm = a.norm_mix[cidx];
        sh[cidx] = modp_sum(modp, b, cidx); gm[cidx] = nm * (1.f + modp_sum(modp, b, D + cidx));
        csh[cidx] = modp_sum(modp, 8, cidx); cgm[cidx] = nm * (1.f + modp_sum(modp, 8, D + cidx)); }
    __syncthreads();
    bf16_t* hx = (bf16_t*)(a.ws + WS_ACT); bf16_t* hc = (bf16_t*)(a.ws + WS_HC);
    { const int row = bid * 8 + wid; norm_rows<1>(a.ctx + (size_t)row * D, hc + (size_t)row * D, cgm, csh, lane); }
    for (int j = 0; j < 16; j += 4) { const int row = bid * 128 + wid * 16 + j; norm_rows<4>(a.x + (size_t)row * D, hx + (size_t)row * D, gm, sh, lane); }
    __syncthreads();
}

constexpr int GL_QDP = 0, GL_KIP = 8704, GL_KETP = 17408, GL_VTP = 27648, GL_DEC = 37888, GL_TOT = 38400, GL_RING = 43008, GL_SLOT = 24576;
#define GLA_BAR() do { asm volatile("s_waitcnt lgkmcnt(0)" ::: "memory"); __builtin_amdgcn_s_barrier(); asm volatile("" ::: "memory"); } while (0)
template <bool FULL>
__device__ __forceinline__ void gla_item(LAS uchar* lds, const bf16_t* qb, const _Float16* lfb, const bf16_t* vb, bf16_t* ob, f32x4 (&S)[8], float* dl_out,
                                         int row_base, int Tn, int tau0, int nch, int h, int dir, int wid, int lane) {
    const int fr = lane & 15, fq = lane >> 4;
#define GLA_ISSUE(c) do { LAS uchar* _sl = lds + GL_RING + ((c) & 3) * GL_SLOT + wid * 3072; \
        const int _tau = tau0 + 32 * (c) + 4 * wid + (lane >> 4); const size_t _o = (size_t)(dir ? (Tn - 1 - _tau) : _tau) * 128 + (lane & 15) * 8; \
        __builtin_amdgcn_global_load_lds((const unsigned*)(lfb + _o), (LAS unsigned*)(_sl), 16, 0, 0); \
        if (FULL) __builtin_amdgcn_global_load_lds((const unsigned*)(qb + _o), (LAS unsigned*)(_sl + 1024), 16, 0, 0); \
        __builtin_amdgcn_global_load_lds((const unsigned*)(vb + _o), (LAS unsigned*)(_sl + 2048), 16, 0, 0); } while (0)
    GLA_ISSUE(0);
    if (nch > 1) GLA_ISSUE(1);
    if (nch > 2) GLA_ISSUE(2);
    const int d0 = 2 * lane, pos0 = (d0 & ~31) + 8 * ((d0 >> 2) & 3) + 4 * ((d0 >> 4) & 1) + (d0 & 3);
    const int spos = 8 * (wid & 3) + 4 * (wid >> 2);
    f32x2 dsum = (f32x2){0.f, 0.f};
    for (int n = 0; n < nch; ++n) {
        if (n + 2 < nch) { if (FULL) asm volatile("s_waitcnt vmcnt(6)" ::: "memory"); else asm volatile("s_waitcnt vmcnt(4)" ::: "memory"); }
        else if (n + 1 < nch) { if (FULL) asm volatile("s_waitcnt vmcnt(3)" ::: "memory"); else asm volatile("s_waitcnt vmcnt(2)" ::: "memory"); }
        else asm volatile("s_waitcnt vmcnt(0)" ::: "memory");
        const LAS uchar* sl = lds + GL_RING + (n & 3) * GL_SLOT + wid * 3072;
        f32x2 lf[4];
#pragma unroll
        for (int rr = 0; rr < 4; ++rr) { typedef _Float16 h2_t __attribute__((ext_vector_type(2))); const h2_t hv = *(const LAS h2_t*)(sl + rr * 256 + lane * 4); lf[rr] = (f32x2){(float)hv.x, (float)hv.y}; }
        f32x2 c[4]; c[0] = lf[0]; c[1] = c[0] + lf[1]; c[2] = c[1] + lf[2]; c[3] = c[2] + lf[3];
        LAS f32x2* tot = (LAS f32x2*)(lds + GL_TOT);
        tot[wid * 64 + lane] = c[3];
        unsigned qv[4], vv[4];
#pragma unroll
        for (int rr = 0; rr < 4; ++rr) { vv[rr] = *(const LAS unsigned*)(sl + 2048 + rr * 256 + lane * 4); qv[rr] = FULL ? *(const LAS unsigned*)(sl + 1024 + rr * 256 + lane * 4) : 0u; }
        GLA_BAR();
        if (n + 3 < nch) GLA_ISSUE(n + 3);
        f32x2 pre = (f32x2){0.f, 0.f}, all = (f32x2){0.f, 0.f};
#pragma unroll
        for (int w = 0; w < 8; ++w) { const f32x2 tw = tot[w * 64 + lane]; all += tw; if (w < wid) pre += tw; }
        dsum += all;
        const f32x2 decall = (f32x2){__builtin_amdgcn_exp2f(all.x), __builtin_amdgcn_exp2f(all.y)};
        f32x2 kE[4];
#pragma unroll
        for (int rr = 0; rr < 4; ++rr) {
            const f32x2 cum = pre + c[rr];
            const f32x2 k = 1.f - (f32x2){__builtin_amdgcn_exp2f(lf[rr].x), __builtin_amdgcn_exp2f(lf[rr].y)};
            const f32x2 ki = k * (f32x2){__builtin_amdgcn_exp2f(-cum.x), __builtin_amdgcn_exp2f(-cum.y)};
            kE[rr] = ki * decall;
            if (FULL) { const int s = 4 * wid + rr; const f32x2 qd = (f32x2){bf_lo(qv[rr]), bf_hi(qv[rr])} * (f32x2){__builtin_amdgcn_exp2f(cum.x), __builtin_amdgcn_exp2f(cum.y)};
                *(LAS unsigned*)(lds + GL_QDP + s * 272 + pos0 * 2) = cvt_pk_bf16(qd.x, qd.y);
                *(LAS unsigned*)(lds + GL_KIP + s * 272 + pos0 * 2) = cvt_pk_bf16(ki.x, ki.y); }
        }
        { u32x2 w0, w1; w0.x = cvt_pk_bf16(kE[0].x, kE[1].x); w0.y = cvt_pk_bf16(kE[2].x, kE[3].x); w1.x = cvt_pk_bf16(kE[0].y, kE[1].y); w1.y = cvt_pk_bf16(kE[2].y, kE[3].y);
          *(LAS u32x2*)(lds + GL_KETP + (d0) * 80 + spos * 2) = w0; *(LAS u32x2*)(lds + GL_KETP + (d0 + 1) * 80 + spos * 2) = w1;
          u32x2 v0, v1; v0.x = (vv[0] & 0xffffu) | (vv[1] << 16); v0.y = (vv[2] & 0xffffu) | (vv[3] << 16);
          v1.x = (vv[0] >> 16) | (vv[1] & 0xffff0000u); v1.y = (vv[2] >> 16) | (vv[3] & 0xffff0000u);
          *(LAS u32x2*)(lds + GL_VTP + (d0) * 80 + spos * 2) = v0; *(LAS u32x2*)(lds + GL_VTP + (d0 + 1) * 80 + spos * 2) = v1; }
        if (wid == 0) *(LAS f32x2*)(lds + GL_DEC + lane * 8) = decall;
        GLA_BAR();
        const bf16x8 vt = *(const LAS bf16x8*)(lds + GL_VTP + (16 * wid + fr) * 80 + fq * 16);
        if (FULL) {
            bf16x8 qf[2][4];
#pragma unroll
            for (int ti = 0; ti < 2; ++ti)
#pragma unroll
                for (int kk = 0; kk < 4; ++kk) qf[ti][kk] = *(const LAS bf16x8*)(lds + GL_QDP + (16 * ti + fr) * 272 + kk * 64 + fq * 16);
            f32x4 oT[2] = {(f32x4){0.f, 0.f, 0.f, 0.f}, (f32x4){0.f, 0.f, 0.f, 0.f}};
            f32x4 p00 = (f32x4){0.f, 0.f, 0.f, 0.f}, p01 = p00, p11 = p00;
#pragma unroll
            for (int kk = 0; kk < 4; ++kk) {
                const bf16x8 kj0 = *(const LAS bf16x8*)(lds + GL_KIP + (fr) * 272 + kk * 64 + fq * 16);
                const bf16x8 kj1 = *(const LAS bf16x8*)(lds + GL_KIP + (16 + fr) * 272 + kk * 64 + fq * 16);
                p00 = __builtin_amdgcn_mfma_f32_16x16x32_bf16(kj0, qf[0][kk], p00, 0, 0, 0);
                p01 = __builtin_amdgcn_mfma_f32_16x16x32_bf16(kj0, qf[1][kk], p01, 0, 0, 0);
                p11 = __builtin_amdgcn_mfma_f32_16x16x32_bf16(kj1, qf[1][kk], p11, 0, 0, 0);
                u32x4 sa; sa.x = cvt_pk_bf16_safe(S[2 * kk][0], S[2 * kk][1]); sa.y = cvt_pk_bf16_safe(S[2 * kk][2], S[2 * kk][3]);
                sa.z = cvt_pk_bf16_safe(S[2 * kk + 1][0], S[2 * kk + 1][1]); sa.w = cvt_pk_bf16_safe(S[2 * kk + 1][2], S[2 * kk + 1][3]);
                const bf16x8 sA = __builtin_bit_cast(bf16x8, sa);
                oT[0] = __builtin_amdgcn_mfma_f32_16x16x32_bf16(sA, qf[0][kk], oT[0], 0, 0, 0);
                oT[1] = __builtin_amdgcn_mfma_f32_16x16x32_bf16(sA, qf[1][kk], oT[1], 0, 0, 0);
            }
            u32x4 pb0, pb1;
            { float m0[4], m1[4];
#pragma unroll
              for (int r = 0; r < 4; ++r) { const bool ok = (4 * fq + r) <= fr; m0[r] = ok ? p00[r] : 0.f; m1[r] = ok ? p11[r] : 0.f; }
              pb0.x = cvt_pk_bf16_safe(m0[0], m0[1]); pb0.y = cvt_pk_bf16_safe(m0[2], m0[3]); pb0.z = 0u; pb0.w = 0u;
              pb1.x = cvt_pk_bf16_safe(p01[0], p01[1]); pb1.y = cvt_pk_bf16_safe(p01[2], p01[3]); pb1.z = cvt_pk_bf16_safe(m1[0], m1[1]); pb1.w = cvt_pk_bf16_safe(m1[2], m1[3]); }
            oT[0] = __builtin_amdgcn_mfma_f32_16x16x32_bf16(vt, __builtin_bit_cast(bf16x8, pb0), oT[0], 0, 0, 0);
            oT[1] = __builtin_amdgcn_mfma_f32_16x16x32_bf16(vt, __builtin_bit_cast(bf16x8, pb1), oT[1], 0, 0, 0);
#pragma unroll
            for (int ti = 0; ti < 2; ++ti) { const int tau = tau0 + 32 * n + 16 * ti + fr; const size_t row = (size_t)(row_base + (dir ? (Tn - 1 - tau) : tau));
                u32x2 w; w.x = cvt_pk_bf16_safe(oT[ti][0], oT[ti][1]); w.y = cvt_pk_bf16_safe(oT[ti][2], oT[ti][3]);
                *(u32x2*)(ob + row * 512 + h * 128 + 16 * wid + 4 * fq) = w; }
        }
#pragma unroll
        for (int t8 = 0; t8 < 8; ++t8) {
            const f32x4 dc = *(const LAS f32x4*)(lds + GL_DEC + (16 * t8 + 4 * fq) * 4);
            const bf16x8 ka = *(const LAS bf16x8*)(lds + GL_KETP + (16 * t8 + fr) * 80 + fq * 16);
            S[t8] = __builtin_amdgcn_mfma_f32_16x16x32_bf16(ka, vt, S[t8] * dc, 0, 0, 0);
        }
    }
#undef GLA_ISSUE
    if (dl_out && wid == 0) *(f32x2*)(dl_out + 2 * lane) = dsum;
    asm volatile("s_waitcnt vmcnt(0)" ::: "memory");
    GLA_BAR();
}
__device__ __forceinline__ void gla_state_store(float* p, const f32x4 (&S)[8], int wid, int fr, int fq) {
#pragma unroll
    for (int t8 = 0; t8 < 8; ++t8)
#pragma unroll
        for (int r = 0; r < 4; ++r) p[(size_t)(16 * t8 + 4 * fq + r) * 128 + 16 * wid + fr] = S[t8][r];
}
__device__ __forceinline__ void phase_gla_states(const Args& a, LAS uchar* lds, int bid, int wid, int lane) {
    uchar* ws = a.ws; const int fr = lane & 15, fq = lane >> 4;
    f32x4 S[8];
#pragma unroll
    for (int t8 = 0; t8 < 8; ++t8) S[t8] = (f32x4){0.f, 0.f, 0.f, 0.f};
    if (bid < 192) { const int bhd = bid / 3, seg = bid % 3, b = bhd >> 3, h = (bhd >> 1) & 3, dir = bhd & 1;
        const size_t pl = (size_t)(b * NH + h) * T * 128;
        gla_item<false>(lds, nullptr, (const _Float16*)(ws + (dir ? WS_LBW : WS_LF)) + pl, (const bf16_t*)(ws + WS_ZI) + pl, nullptr, S, (float*)(ws + WS_DL) + (size_t)bid * 128,
                        b * T, T, seg * 1024, 32, h, dir, wid, lane);
        gla_state_store((float*)(ws + WS_SL) + (size_t)bid * 16384, S, wid, fr, fq);
    } else { const int bhd = bid - 192, b = bhd >> 3, h = (bhd >> 1) & 3, dir = bhd & 1;
        const size_t pl = (size_t)(b * NH + h) * CT * 128;
        gla_item<false>(lds, nullptr, (const _Float16*)(ws + (dir ? WS_CLB : WS_CLF)) + pl, (const bf16_t*)(ws + WS_CI) + pl, nullptr, S, nullptr, b * CT, CT, 0, CT / 32, h, dir, wid, lane);
        gla_state_store((float*)(ws + WS_S0) + (size_t)bhd * 16384, S, wid, fr, fq);
    }
}
__device__ __forceinline__ void phase_gla_out(const Args& a, LAS uchar* lds, int bid, int wid, int lane) {
    uchar* ws = a.ws; const int fr = lane & 15, fq = lane >> 4;
    const int bhd = bid >> 2, seg = bid & 3, b = bhd >> 3, h = (bhd >> 1) & 3, dir = bhd & 1;
    f32x4 S[8];
    { const float* p = (const float*)(ws + WS_S0) + (size_t)bhd * 16384;
#pragma unroll
      for (int t8 = 0; t8 < 8; ++t8)
#pragma unroll
          for (int r = 0; r < 4; ++r) S[t8][r] = p[(size_t)(16 * t8 + 4 * fq + r) * 128 + 16 * wid + fr]; }
    for (int j = 0; j < seg; ++j) { const float* p = (const float*)(ws + WS_SL) + (size_t)(bhd * 3 + j) * 16384; const float* dl = (const float*)(ws + WS_DL) + (size_t)(bhd * 3 + j) * 128;
#pragma unroll
        for (int t8 = 0; t8 < 8; ++t8) { const f32x4 dv = *(const f32x4*)(dl + 16 * t8 + 4 * fq);
#pragma unroll
            for (int r = 0; r < 4; ++r) S[t8][r] = __builtin_amdgcn_exp2f(dv[r]) * S[t8][r] + p[(size_t)(16 * t8 + 4 * fq + r) * 128 + 16 * wid + fr]; } }
    asm volatile("s_waitcnt vmcnt(0)" ::: "memory");
    const size_t pl = (size_t)(b * NH + h) * T * 128;
    gla_item<true>(lds, (const bf16_t*)(ws + WS_ZQ) + pl, (const _Float16*)(ws + (dir ? WS_LBW : WS_LF)) + pl, (const bf16_t*)(ws + WS_ZI) + pl, (bf16_t*)(ws + (dir ? WS_OB : WS_OF)), S, nullptr,
                   b * T, T, seg * 1024, 32, h, dir, wid, lane);
}

__device__ __forceinline__ void unpack8(const u32x4 w, float (&f)[8]) { f[0] = bf_lo(w.x); f[1] = bf_hi(w.x); f[2] = bf_lo(w.y); f[3] = bf_hi(w.y); f[4] = bf_lo(w.z); f[5] = bf_hi(w.z); f[6] = bf_lo(w.w); f[7] = bf_hi(w.w); }
__device__ __forceinline__ void phase_mixfin(const Args& a, int bid, int G, int wid, int lane) {
    const bf16_t* of = (const bf16_t*)(a.ws + WS_OF); const bf16_t* obw = (const bf16_t*)(a.ws + WS_OB); const bf16_t* zg = (const bf16_t*)(a.ws + WS_ZG);
    const bf16_t* zgb = (const bf16_t*)(a.ws + WS_ZGB); const bf16_t* zgc = (const bf16_t*)(a.ws + WS_ZGC); const bf16_t* zv = (const bf16_t*)(a.ws + WS_ZV);
    bf16_t* A2 = (bf16_t*)(a.ws + WS_ACT);
    const int c0 = 8 * lane;
    float gain[8], cw0[8], cw1[8], cw2[8];
#pragma unroll
    for (int j = 0; j < 8; ++j) { gain[j] = a.hg_norm[(c0 + j) & 127]; cw0[j] = a.conv_w[c0 + j]; cw1[j] = a.conv_w[512 + c0 + j]; cw2[j] = a.conv_w[1024 + c0 + j]; }
    for (int row = bid * 8 + wid; row < M; row += G * 8) {
        const size_t ro = (size_t)row * 512 + c0;
        float f0[8], f1[8], gg[8], o[8];
        unpack8(*(const u32x4*)(of + ro), f0); unpack8(*(const u32x4*)(obw + ro), f1); unpack8(*(const u32x4*)(zg + ro), gg);
        float ss = 0.f;
#pragma unroll
        for (int j = 0; j < 8; ++j) { o[j] = f0[j] + f1[j]; ss += o[j] * o[j]; }
        ss += __shfl_xor(ss, 1); ss += __shfl_xor(ss, 2); ss += __shfl_xor(ss, 4); ss += __shfl_xor(ss, 8);
        const float rstd = rsqrtf(ss * (1.f / 128.f) + EPS);
#pragma unroll
        for (int j = 0; j < 8; ++j) o[j] = o[j] * rstd * gain[j] * silu_f(gg[j]);
        u32x4 w; w.x = cvt_pk_bf16(o[0], o[1]); w.y = cvt_pk_bf16(o[2], o[3]); w.z = cvt_pk_bf16(o[4], o[5]); w.w = cvt_pk_bf16(o[6], o[7]);
        *(u32x4*)(A2 + (size_t)row * D + c0) = w;
        const int tw = row & 63;
        float gcm[8], vm[8], gc0[8], v0[8], gcp[8], vp[8], gb[8], y[8];
        unpack8(*(const u32x4*)(zgc + ro), gc0); unpack8(*(const u32x4*)(zv + ro), v0); unpack8(*(const u32x4*)(zgb + ro), gb);
        if (tw > 0) { unpack8(*(const u32x4*)(zgc + ro - 512), gcm); unpack8(*(const u32x4*)(zv + ro - 512), vm); }
        else {
#pragma unroll
            for (int j = 0; j < 8; ++j) { gcm[j] = 0.f; vm[j] = 0.f; } }
        if (tw < 63) { unpack8(*(const u32x4*)(zgc + ro + 512), gcp); unpack8(*(const u32x4*)(zv + ro + 512), vp); }
        else {
#pragma unroll
            for (int j = 0; j < 8; ++j) { gcp[j] = 0.f; vp[j] = 0.f; } }
#pragma unroll
        for (int j = 0; j < 8; ++j) y[j] = gb[j] * (cw0[j] * (gcm[j] * vm[j]) + cw1[j] * (gc0[j] * v0[j]) + cw2[j] * (gcp[j] * vp[j]));
        w.x = cvt_pk_bf16(y[0], y[1]); w.y = cvt_pk_bf16(y[2], y[3]); w.z = cvt_pk_bf16(y[4], y[5]); w.w = cvt_pk_bf16(y[6], y[7]);
        *(u32x4*)(A2 + (size_t)row * D + 512 + c0) = w;
    }
}

__device__ __forceinline__ void phase_router(const Args& a, LAS uchar* lds, int bid, int tid, int wid, int lane) {
    const float* modf = (const float*)(a.ws + WS_MODF);
    LAS float* gm = (LAS float*)lds; LAS float* sh = gm + D;
    LAS uchar* wrl = lds + 8192;
    const int b = bid / 32;
    for (int cidx = tid; cidx < D; cidx += 512) { sh[cidx] = modf[(size_t)b * NMOD + 3 * D + cidx]; gm[cidx] = a.norm_ffn[cidx] * (1.f + modf[(size_t)b * NMOD + 4 * D + cidx]); }
    for (int i = tid; i < D * 4; i += 512) { const int col = i >> 2, q4 = i & 3; *(LAS f32x4*)(wrl + col * 64 + (col >> 2) * 16 + q4 * 16) = *(const f32x4*)(a.w_router + col * 16 + q4 * 4); }
    __syncthreads();
    bf16_t* hx2 = (bf16_t*)(a.ws + WS_ACT); float* aff = (float*)(a.ws + WS_AFF);
    for (int jb = 0; jb < 4; ++jb) {
        const int row0 = bid * 128 + wid * 16 + jb * 4;
        f32x4 v[4][4]; float rstd[4];
#pragma unroll
        for (int i = 0; i < 4; ++i) { const float* xrow = a.out + (size_t)(row0 + i) * D; float ss = 0.f;
#pragma unroll
            for (int jj = 0; jj < 4; ++jj) { v[i][jj] = *((const f32x4*)xrow + lane + 64 * jj); ss += (v[i][jj].x * v[i][jj].x + v[i][jj].y * v[i][jj].y) + (v[i][jj].z * v[i][jj].z + v[i][jj].w * v[i][jj].w); }
            rstd[i] = ss; }
#pragma unroll
        for (int i = 0; i < 4; ++i) rstd[i] = rsqrtf(wave_sum(rstd[i]) * (1.f / D) + EPS);
        float pl[64];
#pragma unroll
        for (int e = 0; e < 64; ++e) pl[e] = 0.f;
#pragma unroll
        for (int jj = 0; jj < 4; ++jj) { const f32x4 g4 = *((const LAS f32x4*)gm + lane + 64 * jj), s4 = *((const LAS f32x4*)sh + lane + 64 * jj);
#pragma unroll
            for (int i = 0; i < 4; ++i) { v[i][jj] = v[i][jj] * rstd[i] * g4 + s4;
                u32x2 w; w.x = cvt_pk_bf16(v[i][jj].x, v[i][jj].y); w.y = cvt_pk_bf16(v[i][jj].z, v[i][jj].w); *((u32x2*)(hx2 + (size_t)(row0 + i) * D) + lane + 64 * jj) = w; }
            const int colb = 4 * lane + 256 * jj;
#pragma unroll
            for (int cc = 0; cc < 4; ++cc) { const int col = colb + cc; const LAS uchar* wp = wrl + col * 64 + (col >> 2) * 16;
#pragma unroll
                for (int q4 = 0; q4 < 4; ++q4) { const f32x4 w4 = *(const LAS f32x4*)(wp + q4 * 16);
#pragma unroll
                    for (int i = 0; i < 4; ++i) { const float hvv = v[i][jj][cc]; pl[i * 16 + q4 * 4 + 0] += hvv * w4.x; pl[i * 16 + q4 * 4 + 1] += hvv * w4.y; pl[i * 16 + q4 * 4 + 2] += hvv * w4.z; pl[i * 16 + q4 * 4 + 3] += hvv * w4.w; } } } }
#pragma unroll
        for (int k = 0; k < 32; ++k) { const bool hi = (lane & 32) != 0; const float keep = hi ? pl[32 + k] : pl[k], send = hi ? pl[k] : pl[32 + k]; pl[k] = keep + __shfl_xor(send, 32); }
#pragma unroll
        for (int k = 0; k < 16; ++k) { const bool hi = (lane & 16) != 0; const float keep = hi ? pl[16 + k] : pl[k], send = hi ? pl[k] : pl[16 + k]; pl[k] = keep + __shfl_xor(send, 16); }
#pragma unroll
        for (int k = 0; k < 8; ++k) { const bool hi = (lane & 8) != 0; const float keep = hi ? pl[8 + k] : pl[k], send = hi ? pl[k] : pl[8 + k]; pl[k] = keep + __shfl_xor(send, 8); }
#pragma unroll
        for (int k = 0; k < 4; ++k) { const bool hi = (lane & 4) != 0; const float keep = hi ? pl[4 + k] : pl[k], send = hi ? pl[k] : pl[4 + k]; pl[k] = keep + __shfl_xor(send, 4); }
#pragma unroll
        for (int k = 0; k < 2; ++k) { const bool hi = (lane & 2) != 0; const float keep = hi ? pl[2 + k] : pl[k], send = hi ? pl[k] : pl[2 + k]; pl[k] = keep + __shfl_xor(send, 2); }
        { const bool hi = (lane & 1) != 0; const float keep = hi ? pl[1] : pl[0], send = hi ? pl[0] : pl[1]; pl[0] = keep + __shfl_xor(send, 1); }
        const float lg = pl[0];
        float mx = lg;
#pragma unroll
        for (int o = 1; o < 16; o <<= 1) mx = fmaxf(mx, __shfl_xor(mx, o));
        const float ex = __expf(lg - mx); float den = ex;
#pragma unroll
        for (int o = 1; o < 16; o <<= 1) den += __shfl_xor(den, o);
        const int t = (row0 + (lane >> 4)) & (T - 1);
        aff[((size_t)b * NE + (lane & 15)) * T + t] = ex / den;
    }
    __syncthreads();
}

__device__ __forceinline__ void topk_item(const Args& a, LAS uchar* lds, int b, int e, int tid, int wid, int lane) {
    LAS unsigned* key = (LAS unsigned*)lds;
    LAS unsigned* hist = key + 4096;
    LAS unsigned* ctl = hist + 256;
    LAS unsigned* wsum = ctl + 8;
    const float* affp = (const float*)(a.ws + WS_AFF) + ((size_t)b * NE + e) * T;
    unsigned kv[8];
    { const u32x4 k0 = *(const u32x4*)(affp + tid * 8), k1 = *(const u32x4*)(affp + tid * 8 + 4); kv[0] = k0.x; kv[1] = k0.y; kv[2] = k0.z; kv[3] = k0.w; kv[4] = k1.x; kv[5] = k1.y; kv[6] = k1.z; kv[7] = k1.w; }
    unsigned prefix = 0u, mask = 0u, need = CAP;
    for (int shift = 24; shift >= 0; shift -= 8) {
        if (tid < 256) hist[tid] = 0u;
        __syncthreads();
#pragma unroll
        for (int j = 0; j < 8; ++j) if ((kv[j] & mask) == prefix) __hip_atomic_fetch_add(&hist[(kv[j] >> shift) & 255u], 1u, __ATOMIC_RELAXED, __HIP_MEMORY_SCOPE_WORKGROUP);
        __syncthreads();
        if (tid < 256) { unsigned above = 0u; for (int bb = tid + 1; bb < 256; ++bb) above += hist[bb]; const unsigned mine = hist[tid];
            if (above < need && need <= above + mine) { ctl[0] = (unsigned)tid; ctl[1] = need - above; } }
        __syncthreads();
        prefix |= ctl[0] << shift; mask |= 255u << shift; need = ctl[1];
        __syncthreads();
    }
    unsigned cg_ = 0u, ce_ = 0u;
#pragma unroll
    for (int j = 0; j < 8; ++j) { cg_ += kv[j] > prefix; ce_ += kv[j] == prefix; }
    unsigned pk = cg_ | (ce_ << 16), incl = pk;
#pragma unroll
    for (int o = 1; o < 64; o <<= 1) { const unsigned t2 = __shfl_up(incl, o); if (lane >= o) incl += t2; }
    if (lane == 63) wsum[wid] = incl;
    __syncthreads();
    unsigned base = 0u;
    for (int w = 0; w < wid; ++w) base += wsum[w];
    unsigned excl = base + incl - pk; unsigned ng = excl & 0xffffu, neq = excl >> 16;
    int* seltok = (int*)(a.ws + WS_SELTOK); float* selgate = (float*)(a.ws + WS_SELGATE); short* pos = (short*)(a.ws + WS_POS);
#pragma unroll
    for (int j = 0; j < 8; ++j) { const int t = tid * 8 + j; const bool gt = kv[j] > prefix, eq = kv[j] == prefix; const bool sel = gt || (eq && neq < need);
        int slot = -1;
        if (sel) slot = (int)(ng + (neq < need ? neq : need));
        if (sel) { seltok[e * 4096 + b * 512 + slot] = b * T + t; selgate[e * 4096 + b * 512 + slot] = __uint_as_float(kv[j]); }
        pos[((size_t)b * T + t) * 16 + e] = (short)slot;
        ng += gt; neq += eq; }
    __syncthreads();
}
__device__ __forceinline__ void phase_topk_cvt(const Args& a, LAS uchar* lds, int bid, int G, int tid, int wid, int lane) {
    if (bid < 128) topk_item(a, lds, bid / 16, bid % 16, tid, wid, lane);
    LAS float* scr = (LAS float*)(lds + 32768) + wid * (64 * 33);
    bf16_t* wgu = (bf16_t*)(a.ws + WS_WGU); bf16_t* wdn = (bf16_t*)(a.ws + WS_WDN);
    constexpr int I_G = (D / 64) * (DFF / 32);
    constexpr int I_D = (DFF / 64) * (D / 32);
    constexpr int PER_E = 2 * I_G + I_D, TOTAL = NE * PER_E;
    const int gw = (G - 1 - bid) * 8 + wid, NGW = G * 8;
    for (int it = gw; it < TOTAL; it += NGW) {
        const int e = it / PER_E; int r = it % PER_E;
        if (r < 2 * I_G) { const int up = r >= I_G; if (up) r -= I_G; const int nblk = DFF / 32, kb = r / nblk, nb = r % nblk, n0 = nb * 32;
            const float* W = (up ? a.w_up : a.w_gate) + (size_t)e * D * DFF;
            cvt_item(W, DFF, wgu + (size_t)e * 4096 * D, D, kb * 64, n0, (n0 >> 7) * 256 + (n0 & 127) + (up ? 128 : 0), scr, lane); }
        else { r -= 2 * I_G; const int nblk = D / 32, kb = r / nblk, nb = r % nblk;
            cvt_item(a.w_down + (size_t)e * DFF * D, D, wdn + (size_t)e * D * DFF, DFF, kb * 64, nb * 32, nb * 32, scr, lane); }
    }
    __syncthreads();
}

__device__ __forceinline__ void phase_final(const Args& a, int bid, int G, int wid, int lane) {
    const float* modf = (const float*)(a.ws + WS_MODF); const short* pos = (const short*)(a.ws + WS_POS); const bf16_t* ys = (const bf16_t*)(a.ws + WS_YS);
    f32x4 nf[4];
#pragma unroll
    for (int q = 0; q < 4; ++q) nf[q] = *(const f32x4*)(a.norm_final + (q >> 1) * 512 + 8 * lane + (q & 1) * 4);
    for (int row = bid * 8 + wid; row < M; row += G * 8) {
        const int b = row / T; float* xrow = a.out + (size_t)row * D;
        f32x4 v[4], acc[4];
#pragma unroll
        for (int q = 0; q < 4; ++q) { v[q] = *(const f32x4*)(xrow + (q >> 1) * 512 + 8 * lane + (q & 1) * 4); acc[q] = (f32x4){0.f, 0.f, 0.f, 0.f}; }
        const int myslot = (lane < 16) ? (int)pos[(size_t)row * 16 + lane] : -1;
        unsigned long long mask = __ballot(myslot >= 0);
        while (mask) {
            int ee[4], sl[4];
#pragma unroll
            for (int k = 0; k < 4; ++k) { if (mask) { ee[k] = __builtin_ctzll(mask); mask &= mask - 1; sl[k] = __shfl(myslot, ee[k]); } else { ee[k] = -1; sl[k] = 0; } }
            u32x4 w[4][2];
#pragma unroll
            for (int k = 0; k < 4; ++k) if (ee[k] >= 0) { const bf16_t* yr = ys + ((size_t)ee[k] * 4096 + b * 512 + sl[k]) * D + 8 * lane; w[k][0] = *(const u32x4*)yr; w[k][1] = *(const u32x4*)(yr + 512); }
#pragma unroll
            for (int k = 0; k < 4; ++k) if (ee[k] >= 0) {
#pragma unroll
                for (int hf = 0; hf < 2; ++hf) { const u32x4 ww = w[k][hf];
                    acc[2 * hf].x += bf_lo(ww.x); acc[2 * hf].y += bf_hi(ww.x); acc[2 * hf].z += bf_lo(ww.y); acc[2 * hf].w += bf_hi(ww.y);
                    acc[2 * hf + 1].x += bf_lo(ww.z); acc[2 * hf + 1].y += bf_hi(ww.z); acc[2 * hf + 1].z += bf_lo(ww.w); acc[2 * hf + 1].w += bf_hi(ww.w); } }
        }
        float ss = 0.f;
#pragma unroll
        for (int q = 0; q < 4; ++q) { const f32x4 g2 = *(const f32x4*)(modf + (size_t)b * NMOD + 5 * D + (q >> 1) * 512 + 8 * lane + (q & 1) * 4); v[q] = v[q] + g2 * acc[q];
            ss += (v[q].x * v[q].x + v[q].y * v[q].y) + (v[q].z * v[q].z + v[q].w * v[q].w); }
        const float rstd = rsqrtf(wave_sum(ss) * (1.f / D) + EPS);
#pragma unroll
        for (int q = 0; q < 4; ++q) *(f32x4*)(xrow + (q >> 1) * 512 + 8 * lane + (q & 1) * 4) = v[q] * rstd * nf[q];
    }
}

__global__ void __launch_bounds__(512, 2) mega_fwd(Args a) {
    extern __shared__ __attribute__((aligned(16))) uchar lds_raw[];
    LAS uchar* lds = (LAS uchar*)lds_raw;
    const int tid = threadIdx.x, lane = tid & 63, wid = __builtin_amdgcn_readfirstlane(tid >> 6), bid = blockIdx.x, G = gridDim.x;
    const int lo = a.ph_lo, hi = a.ph_hi;
    uchar* ws = a.ws;
#define IN(k) (lo <= (k) && (k) < hi)
#define SEAM(k) do { if (IN(k) && IN((k) + 1)) xcd_barrier(xbar); } while (0)
    if (tid < 2) ((volatile LAS unsigned*)(lds + (LDS_BYTES - 16)))[tid] = 0u;
    __syncthreads();
    XcdBarrier xbar = xcd_barrier_post((unsigned*)(ws + WS_BAR), (volatile LAS unsigned*)(lds + (LDS_BYTES - 16)));
    if (IN(0)) phase_prep(a, lds, bid, G, tid, wid, lane);
    SEAM(0);
    if (IN(1)) phase_norm(a, lds, bid, G, tid, wid, lane);
    SEAM(1);
    if (IN(2)) {
        {
            pg8::Gemm g{(const bf16_t*)(ws + WS_ACT), (const bf16_t*)(ws + WS_WIN), D, 0, nullptr};
            pg8::GroupOrder S; S.init(M / 256, NIN / 256, 1, G, bid);
            pg8::EpiInproj E{ws + WS_ZQ, nullptr, (_Float16*)(ws + WS_LF), (_Float16*)(ws + WS_LBW), (const float*)(ws + WS_LB), 0, T};
            pg8::gemm_phase<pg8::EpiInproj, false>(lds, g, S, E);
        }
    }
    SEAM(2);
    if (IN(3)) {
        unsigned* cnt = (unsigned*)(ws + WS_BAR + 14336);
        if (bid >= 192 && bid < 240) {
            pg8::Gemm g{(const bf16_t*)(ws + WS_HC), (const bf16_t*)(ws + WS_WIN) + (size_t)512 * D, D, 0, nullptr};
            pg8::GroupOrder S; S.init(MC / 256, 1536 / 256, 1, 48, bid - 192);
            pg8::EpiInproj E{nullptr, (bf16_t*)(ws + WS_CI), (_Float16*)(ws + WS_CLF), (_Float16*)(ws + WS_CLB), (const float*)(ws + WS_LB), 1, CT};
            pg8::gemm_phase<pg8::EpiInproj, false>(lds, g, S, E);
            pg8::Unit u; S.next(0, u);
            asm volatile("s_waitcnt vmcnt(0)" ::: "memory"); __syncthreads();
            if (tid == 0) { __builtin_amdgcn_fence(__ATOMIC_RELEASE, "agent"); asm volatile("s_waitcnt vmcnt(0)" ::: "memory");
                __hip_atomic_fetch_add(cnt + 64 * u.pm, 1u, __ATOMIC_RELAXED, __HIP_MEMORY_SCOPE_AGENT); }
        }
        if (bid >= 192) {
            const int b = (bid - 192) >> 3;
            if (tid == 0) { unsigned sp = 0; while (__hip_atomic_load(cnt + 64 * b, __ATOMIC_RELAXED, __HIP_MEMORY_SCOPE_AGENT) < 6u && ++sp < (1u << 22)) __builtin_amdgcn_s_sleep(2);
                __builtin_amdgcn_fence(__ATOMIC_ACQUIRE, "agent"); asm volatile("s_waitcnt vmcnt(0)" ::: "memory"); }
            __syncthreads();
        }
        phase_gla_states(a, lds, bid, wid, lane);
    }
    SEAM(3);
    if (IN(4)) phase_gla_out(a, lds, bid, wid, lane);
    SEAM(4);
    if (IN(5)) phase_mixfin(a, bid, G, wid, lane);
    SEAM(5);
    if (IN(6)) {
        pg8::Gemm g{(const bf16_t*)(ws + WS_ACT), (const bf16_t*)(ws + WS_WOUT), D, 0, nullptr};
        pg8::GroupOrder S; S.init(M / 256, D / 256, 1, G, bid);
        pg8::EpiOut E{a.x, a.out, (const float*)(ws + WS_MODF)};
        pg8::gemm_phase<pg8::EpiOut, false>(lds, g, S, E);
    }
    SEAM(6);
    if (IN(7)) phase_router(a, lds, bid, tid, wid, lane);
    SEAM(7);
    if (IN(8)) phase_topk_cvt(a, lds, bid, G, tid, wid, lane);
    SEAM(8);
    if (IN(9)) {
        pg8::Gemm g{(const bf16_t*)(ws + WS_ACT), (const bf16_t*)(ws + WS_WGU), D, (size_t)4096 * D * 2, (const int*)(ws + WS_SELTOK)};
        pg8::GroupOrder S; S.init(16, 16, NE, G, bid);
        pg8::EpiMoe1 E{(bf16_t*)(ws + WS_HID)};
        pg8::gemm_phase<pg8::EpiMoe1, true>(lds, g, S, E);
    }
    SEAM(9);
    if (IN(10)) {
        pg8::Gemm g{(const bf16_t*)(ws + WS_HID), (const bf16_t*)(ws + WS_WDN), DFF, (size_t)D * DFF * 2, nullptr};
        pg8::Moe2Order S{bid};
        pg8::EpiMoe2 E{(bf16_t*)(ws + WS_YS), (const float*)(ws + WS_SELGATE)};
        pg8::gemm_phase<pg8::EpiMoe2, false, pg8::Moe2Order>(lds, g, S, E);
    }
    SEAM(10);
    if (IN(11)) phase_final(a, bid, G, wid, lane);

#undef IN
#undef SEAM
}

#ifndef N_LAUNCHES
#define N_LAUNCHES 1
#endif
extern "C" void kernel_launch(void* const* d_in, const int* in_sizes, int n_in, void* d_out, int out_size, void* d_ws, size_t ws_size, hipStream_t stream) {
    static int grid = 0;
    if (grid == 0) {
        if (n_in != 18 || out_size != M * D || ws_size < WS_END) { fprintf(stderr, "kernel_launch: unexpected shapes (n_in %d out %d ws %zu)\n", n_in, out_size, ws_size); grid = -1; return; }
        int dev = 0, cus = 0, per_cu = 0;
        (void)hipGetDevice(&dev); (void)hipDeviceGetAttribute(&cus, hipDeviceAttributeMultiprocessorCount, dev);
        (void)hipFuncSetAttribute((const void*)mega_fwd, hipFuncAttributeMaxDynamicSharedMemorySize, LDS_BYTES);
        (void)hipOccupancyMaxActiveBlocksPerMultiprocessor(&per_cu, (const void*)mega_fwd, 512, LDS_BYTES);
        if (per_cu < 1) { fprintf(stderr, "kernel_launch: occupancy query says %d blocks per CU\n", per_cu); grid = -1; return; }
        grid = 256;
        if (cus != 256) fprintf(stderr, "kernel_launch: note: %d CUs (built for 256)\n", cus);
    }
    if (grid < 0) return;
    Args a{};
    a.x = (const float*)d_in[0]; a.c = (const float*)d_in[1]; a.ctx = (const float*)d_in[2]; a.c_ctx = (const float*)d_in[3]; a.w_ada = (const float*)d_in[4]; a.b_ada = (const float*)d_in[5];
    a.norm_mix = (const float*)d_in[6]; a.norm_ffn = (const float*)d_in[7]; a.w_in = (const float*)d_in[8]; a.lb_logits = (const float*)d_in[9]; a.hg_norm = (const float*)d_in[10];
    a.conv_w = (const float*)d_in[11]; a.w_out = (const float*)d_in[12]; a.w_router = (const float*)d_in[13]; a.w_gate = (const float*)d_in[14]; a.w_up = (const float*)d_in[15];
    a.w_down = (const float*)d_in[16]; a.norm_final = (const float*)d_in[17]; a.out = (float*)d_out; a.ws = (uchar*)d_ws;
    if (N_LAUNCHES == 1) {
        (void)hipMemsetAsync((char*)d_ws + WS_BAR, 0, 16384, stream);
        a.ph_lo = 0; a.ph_hi = NPHASE;
        hipLaunchKernelGGL(mega_fwd, dim3(grid), dim3(512), LDS_BYTES, stream, a);
    } else {
        for (int p = 0; p < NPHASE; ++p) { a.ph_lo = p; a.ph_hi = p + 1; void* args[] = {&a};
            hipError_t e = hipLaunchCooperativeKernel((const void*)mega_fwd, dim3(grid), dim3(512), args, LDS_BYTES, stream);
            if (e != hipSuccess) { fprintf(stderr, "launch %d failed: %s\n", p, hipGetErrorString(e)); break; } }
    }
}
```

```cpp
#include <hip/hip_runtime.h>
#include <cstdio>

#define LAS __attribute__((address_space(3)))
#define GAS __attribute__((address_space(1)))
typedef unsigned short bf16_t;
typedef short bf16x8 __attribute__((ext_vector_type(8)));
typedef float f32x4 __attribute__((ext_vector_type(4)));
typedef float f32x2 __attribute__((ext_vector_type(2)));
typedef unsigned u32x4 __attribute__((ext_vector_type(4)));
typedef unsigned u32x2 __attribute__((ext_vector_type(2)));
typedef unsigned char uchar;

constexpr int D = 1024, NB = 8, T = 4096, M = NB * T, CT = 256, MC = NB * CT;
constexpr int NIN = 4096, HK = 512, NH = 4, NE = 16, CAP = 512, DFF = 2048, NMOD = 6 * D;
constexpr float EPS = 1e-6f;
constexpr int NPHASE = 12;

constexpr size_t MiB = 1u << 20;
constexpr size_t WS_ACT = 0;
constexpr size_t WS_WIN = 64 * MiB;
constexpr size_t WS_WOUT = 72 * MiB;
constexpr size_t WS_MODP = 74 * MiB;
constexpr size_t WS_MODF = 76 * MiB;
constexpr size_t WS_LB = 76 * MiB + 512 * 1024;
constexpr size_t WS_HC = 77 * MiB;
constexpr size_t WS_CLF = 81 * MiB;
constexpr size_t WS_CLB = 85 * MiB;
constexpr size_t WS_CI = 89 * MiB;
constexpr size_t WS_S0 = 91 * MiB;
constexpr size_t WS_AFF = 95 * MiB;
constexpr size_t WS_SELTOK = 97 * MiB;
constexpr size_t WS_SELGATE = 97 * MiB + 256 * 1024;
constexpr size_t WS_POS = 98 * MiB;
constexpr size_t WS_BAR = 100 * MiB;
constexpr size_t WS_SL = 488 * MiB;
constexpr size_t WS_DL = 500 * MiB;
constexpr size_t WS_ZQ = 104 * MiB;
constexpr size_t WS_LF = 136 * MiB;
constexpr size_t WS_LBW = 200 * MiB;
constexpr size_t WS_ZI = 264 * MiB;
constexpr size_t WS_ZG = 296 * MiB;
constexpr size_t WS_ZGB = 328 * MiB;
constexpr size_t WS_ZGC = 360 * MiB;
constexpr size_t WS_ZV = 392 * MiB;
constexpr size_t WS_OF = 424 * MiB;
constexpr size_t WS_OB = 456 * MiB;
constexpr size_t WS_WGU = 104 * MiB;
constexpr size_t WS_WDN = 232 * MiB;
constexpr size_t WS_HID = 296 * MiB;
constexpr size_t WS_YS = WS_WGU;
constexpr size_t WS_END = 552 * MiB;
static_assert(WS_ZI == WS_ZQ + 160 * MiB && WS_ZG == WS_ZI + 32 * MiB && WS_ZGB == WS_ZG + 32 * MiB && WS_ZGC == WS_ZGB + 32 * MiB && WS_ZV == WS_ZGC + 32 * MiB, "z segment map");

constexpr int LDS_BYTES = 147456;

typedef __bf16 bf16x2_t __attribute__((ext_vector_type(2)));
__device__ __forceinline__ unsigned cvt_pk_bf16_safe(float lo, float hi) { typedef float f2_t __attribute__((ext_vector_type(2))); const bf16x2_t v = __builtin_convertvector((f2_t){lo, hi}, bf16x2_t); return __builtin_bit_cast(unsigned, v); }
__device__ __forceinline__ unsigned cvt_pk_bf16(float lo, float hi) { unsigned r; asm volatile("v_cvt_pk_bf16_f32 %0, %1, %2" : "=v"(r) : "v"(lo), "v"(hi)); return r; }
__device__ __forceinline__ float bf_lo(unsigned u) { return __uint_as_float(u << 16); }
__device__ __forceinline__ float bf_hi(unsigned u) { return __uint_as_float(u & 0xffff0000u); }
__device__ __forceinline__ float wave_sum(float v) {
#pragma unroll
    for (int o = 1; o < 64; o <<= 1) v += __shfl_xor(v, o);
    return v;
}
__device__ __forceinline__ float silu_f(float x) { return x * __builtin_amdgcn_rcpf(1.f + __builtin_amdgcn_exp2f(x * -1.44269504f)); }
#define LDS_WAIT() asm volatile("s_waitcnt lgkmcnt(0)" ::: "memory")


#define XB_TMO      128
#define XB_XCNT(j)  (256  + 64 * (j))
#define XB_XSUB(j)  (1280 + 64 * (j))
#define XB_XGEN(j)  (2304 + 64 * (j))
#define XB_TOP      3328
#define XB_TOPGEN   3392
#define XCD_BAR_WORDS 3456
#define XB_SPIN_CAP (1u << 20)
__device__ __forceinline__ unsigned xb_ld(unsigned* p)              { return __hip_atomic_load(p, __ATOMIC_RELAXED, __HIP_MEMORY_SCOPE_AGENT); }
__device__ __forceinline__ unsigned xb_add(unsigned* p, unsigned v) { return __hip_atomic_fetch_add(p, v, __ATOMIC_RELAXED, __HIP_MEMORY_SCOPE_AGENT); }
__device__ __forceinline__ unsigned xb_xcc_id() { return (unsigned)__builtin_amdgcn_s_getreg((3 << 11) | 20) & 0xFu; }
#define XB_SPIN(cond, bar) do { unsigned _sp = 0; while (cond) { __builtin_amdgcn_s_sleep(1); \
    if ((++_sp & 255u) == 0u) { if (xb_ld(&(bar)[XB_TMO])) break; if (_sp > XB_SPIN_CAP) { atomicAdd(&(bar)[XB_TMO], 1u); break; } } } } while (0)
struct XcdBarrier { unsigned* bar; unsigned x; volatile LAS unsigned* st; };
__device__ __forceinline__ XcdBarrier xcd_barrier_post(unsigned* bar, volatile LAS unsigned* st) {
    XcdBarrier b; b.bar = bar; b.x = xb_xcc_id(); b.st = st;
    if (threadIdx.x == 0) (void)xb_add(&bar[XB_XCNT(b.x)], 1u);
    return b;
}
__device__ __forceinline__ void xcd_barrier_complete(unsigned* bar, unsigned x, unsigned& nloc, unsigned& nx) {
    const unsigned G = gridDim.x * gridDim.y * gridDim.z;
    unsigned sum, cnt, mine, sp = 0u;
    for (;;) {
        sum = 0u; cnt = 0u; mine = 0u;
#pragma unroll
        for (unsigned j = 0; j < 16; ++j) { const unsigned c = xb_ld(&bar[XB_XCNT(j)]); sum += c; cnt += (c > 0u) ? 1u : 0u; mine = (j == x) ? c : mine; }
        if (sum == G) break;
        __builtin_amdgcn_s_sleep(1);
        if ((++sp & 255u) == 0u) { if (xb_ld(&bar[XB_TMO])) break; if (sp > XB_SPIN_CAP) { atomicAdd(&bar[XB_TMO], 1u); break; } }
    }
    nloc = mine > 0u ? mine : 1u; nx = cnt > 0u ? cnt : 1u;
}
__device__ __forceinline__ void xcd_barrier(const XcdBarrier& b) {
    asm volatile("s_waitcnt vmcnt(0)" ::: "memory");
    __syncthreads();
    if (threadIdx.x == 0) {
        unsigned* bar = b.bar;
        __builtin_amdgcn_s_waitcnt(0);
        unsigned nloc = b.st[0], nx = b.st[1];
        if (nloc == 0u) { xcd_barrier_complete(bar, b.x, nloc, nx); b.st[0] = nloc; b.st[1] = nx; }
        const unsigned old = xb_add(&bar[XB_XSUB(b.x)], 1u);
        const unsigned gen = old / nloc;
        if (old + 1u == (gen + 1u) * nloc) {
            __builtin_amdgcn_fence(__ATOMIC_RELEASE, "agent");
            asm volatile("s_waitcnt vmcnt(0)" ::: "memory");
            const unsigned og = xb_add(&bar[XB_TOP], 1u);
            const unsigned tg = og / nx;
            if (og + 1u == (tg + 1u) * nx) xb_add(&bar[XB_TOPGEN], 1u);
            else XB_SPIN(xb_ld(&bar[XB_TOPGEN]) == tg, bar);
            __builtin_amdgcn_fence(__ATOMIC_ACQUIRE, "agent");
            xb_add(&bar[XB_XGEN(b.x)], 1u);
            asm volatile("s_waitcnt vmcnt(0)" ::: "memory");
        } else {
            XB_SPIN(xb_ld(&bar[XB_XGEN(b.x)]) == gen, bar);
            __builtin_amdgcn_fence(__ATOMIC_ACQUIRE, "agent");
            asm volatile("s_waitcnt vmcnt(0)" ::: "memory");
        }
    }
    __syncthreads();
}

namespace pg8 {
constexpr int BM = 256, BK = 64, HALF = 128, HTB = HALF * BK * 2, STAGE_BYTES = 8 * HTB, NXCD = 8, WGM = 8;
__device__ __forceinline__ int lds_byte(int r, int c) { const int st = (r >> 4) * 2 + (c >> 5), rr = r & 15, cc = c & 31, ob = rr * 64 + cc * 2; return st * 1024 + (ob ^ (((ob >> 9) & 1) << 5)); }
__device__ __forceinline__ void stage_rc(int b, int& R, int& C) { const int st = b / 1024, sb = b % 1024, swz = sb ^ (((sb >> 9) & 1) << 5); R = (st >> 1) * 16 + swz / 64; C = (st & 1) * 32 + (swz % 64) / 2; }
__device__ __forceinline__ int perm32(int rho) { const int n = rho >> 4, i = rho & 15; return 8 * (i >> 2) + 4 * n + (i & 3); }

struct Unit { int pm, pn, e; };
struct GroupOrder {
    int nM, nN, ng, G, c;
    __device__ __forceinline__ void init(int nM_, int nN_, int ng_, int G_, int c_) { nM = nM_; nN = nN_; ng = ng_; G = G_; c = c_; }
    __device__ __forceinline__ bool next(int i, Unit& u) const {
        const int nwg = nM * nN; const long L = (long)i * G + c; if (L >= (long)nwg * ng) return false;
        const int grp = (int)(L / nwg); int wgid = (int)(L % nwg);
        { const int q = nwg / NXCD, r = nwg % NXCD, xcd = wgid % NXCD, off = wgid / NXCD; wgid = (xcd < r ? xcd * (q + 1) : r * (q + 1) + (xcd - r) * q) + off; }
        const int nig = WGM * nN, gid = wgid / nig, fm = gid * WGM, gsz = (nM - fm) < WGM ? (nM - fm) : WGM;
        u.pm = grp * nM + fm + ((wgid % nig) % gsz); u.pn = (wgid % nig) / gsz; u.e = grp; return true;
    }
};
struct Moe2Order {
    int c;
    __device__ __forceinline__ bool next(int i, Unit& u) const { if (i >= 4) return false; const int x = c & 7, j = c >> 3; u.e = 4 * i + (j >> 3); u.pm = u.e * 16 + 2 * x + ((j & 7) >> 2); u.pn = j & 3; return true; }
};
struct Gemm { const bf16_t* A; const bf16_t* Bt; int K; size_t bgs; const int* rowidx; };

template <class Epi, bool GATHER, class Sched = GroupOrder>
__device__ __forceinline__ void gemm_phase(LAS uchar* lds, const Gemm g, const Sched& S, const Epi& E) {
    const int tid = threadIdx.x, wid = __builtin_amdgcn_readfirstlane(tid >> 6), lane = tid & 63, wr = wid >> 2, wc = wid & 3, fr = lane & 15, fq = lane >> 4;
    const int K = g.K, nt = K / BK;
    unsigned voffA[2], voffB[2]; int Rr[2], Cc[2];
#pragma unroll
    for (int i = 0; i < 2; ++i) { int R, C; stage_rc(tid * 16 + i * 8192, R, C); const int Rb = Epi::PERM ? ((R & ~31) + perm32(R & 31)) : R; Rr[i] = R; Cc[i] = C;
        voffA[i] = (unsigned)(R * K + C) * 2u; voffB[i] = (unsigned)(Rb * K + C) * 2u; }
    const size_t kstep = (size_t)(BK * 2);
    const size_t hstep = (size_t)HALF * K * 2;
    const size_t tstep = 2 * hstep;
    const unsigned ldsw = (unsigned)wid * 1024u;
    const int aoff = lds_byte(wr * 64 + fr, fq * 8), boff = lds_byte(wc * 32 + fr, fq * 8);
#define PG8_SA(b, h) (((b) * 2 + (h)) * HTB)
#define PG8_SB(b, h) ((4 + (b) * 2 + (h)) * HTB)
#define PG8_STAGE(bufoff, gbase, voff) do { _Pragma("unroll") for (int _i = 0; _i < 2; ++_i) \
        __builtin_amdgcn_global_load_lds((const unsigned*)((const char*)(gbase) + (voff)[_i]), (LAS unsigned*)(lds + (bufoff) + ldsw + _i * 8192), 16, 0, 0); } while (0)
#define PG8_STAGE_A(bufoff, p, ofs, h) do { if constexpr (GATHER) { PG8_STAGE(bufoff, p, (ofs)[h]); } else { PG8_STAGE(bufoff, (p) + (h) * hstep, voffA); } } while (0)
#define PG8_LDA(dst, b, h) do { _Pragma("unroll") for (int m = 0; m < 4; ++m) _Pragma("unroll") for (int k = 0; k < 2; ++k) dst[m][k] = *(const LAS bf16x8*)(lds + PG8_SA(b, h) + aoff + m * 2048 + k * 1024); } while (0)
#define PG8_LDB(dst, b, h) do { _Pragma("unroll") for (int n = 0; n < 2; ++n) _Pragma("unroll") for (int k = 0; k < 2; ++k) dst[n][k] = *(const LAS bf16x8*)(lds + PG8_SB(b, h) + boff + n * 2048 + k * 1024); } while (0)
#define PG8_MMA(ai, bj, At, Bt) do { __builtin_amdgcn_s_setprio(1); _Pragma("unroll") for (int m = 0; m < 4; ++m) _Pragma("unroll") for (int n = 0; n < 2; ++n) _Pragma("unroll") for (int k = 0; k < 2; ++k) \
        acc[ai][bj][m][n] = __builtin_amdgcn_mfma_f32_16x16x32_bf16(Bt[n][k], At[m][k], acc[ai][bj][m][n], 0, 0, 0); __builtin_amdgcn_s_setprio(0); } while (0)
#define PG8_WAIT_V(n) asm volatile("s_waitcnt vmcnt(" #n ")" ::: "memory")
#define PG8_WAIT_L(n) asm volatile("s_waitcnt lgkmcnt(" #n ")" ::: "memory")
#define PG8_BAR __builtin_amdgcn_s_barrier()
#define PG8_SCHED __builtin_amdgcn_sched_barrier(0)
    Unit cur, nxt; int ui = 0;
    if (!S.next(0, cur)) return;
    f32x4 acc[2][2][4][2];
#pragma unroll
    for (int a = 0; a < 2; ++a)
#pragma unroll
        for (int b = 0; b < 2; ++b)
#pragma unroll
            for (int m = 0; m < 4; ++m)
#pragma unroll
                for (int n = 0; n < 2; ++n) acc[a][b][m][n] = (f32x4){0.f, 0.f, 0.f, 0.f};
    bf16x8 At[4][2], B0[2][2], B1[2][2];
    unsigned cofs[2][2], nofs[2][2];
    LAS unsigned short* ridx = (LAS unsigned short*)(lds + STAGE_BYTES);
    if constexpr (GATHER) {
        { Unit tu; for (int uu = 0; uu < 16 && S.next(uu, tu); ++uu) if (tid < BM) ridx[uu * BM + tid] = (unsigned short)g.rowidx[tu.pm * BM + tid]; }
        asm volatile("s_waitcnt vmcnt(0) lgkmcnt(0)" ::: "memory"); __builtin_amdgcn_s_barrier(); asm volatile("" ::: "memory");
#pragma unroll
        for (int h = 0; h < 2; ++h)
#pragma unroll
            for (int i = 0; i < 2; ++i) { const int row = ridx[h * HALF + Rr[i]]; cofs[h][i] = (unsigned)(row * K + Cc[i]) * 2u; nofs[h][i] = cofs[h][i]; }
    }
    const char* cA = GATHER ? (const char*)g.A : (const char*)g.A + (size_t)cur.pm * tstep;
    const char* cB = (const char*)g.Bt + (size_t)cur.e * g.bgs + (size_t)cur.pn * tstep;
    PG8_STAGE(PG8_SB(0, 0), cB, voffB); PG8_STAGE(PG8_SB(0, 1), cB + hstep, voffB); PG8_STAGE_A(PG8_SA(0, 0), cA, cofs, 0); PG8_STAGE_A(PG8_SA(0, 1), cA, cofs, 1);
    if (wr == 1) PG8_BAR;
    PG8_WAIT_V(2); PG8_BAR;
    PG8_STAGE(PG8_SB(1, 0), cB + kstep, voffB); PG8_STAGE_A(PG8_SA(1, 0), cA + kstep, cofs, 0); PG8_STAGE(PG8_SB(1, 1), cB + hstep + kstep, voffB);
    PG8_WAIT_V(6); PG8_BAR;
    for (;;) {
        const bool has_next = S.next(ui + 1, nxt);
        const char* nA = GATHER ? (const char*)g.A : (has_next ? (const char*)g.A + (size_t)nxt.pm * tstep : cA);
        const char* nB = has_next ? (const char*)g.Bt + (size_t)nxt.e * g.bgs + (size_t)nxt.pn * tstep : cB;
        for (int t = 0; t < nt; t += 2) {
            const bool last = (t == nt - 2);
            const char* a1 = cA + (size_t)(t + 1) * kstep;
            const char* a2 = last ? nA : cA + (size_t)(t + 2) * kstep; const char* b2 = last ? nB : cB + (size_t)(t + 2) * kstep;
            const char* a3 = a2 + kstep; const char* b3 = b2 + kstep;
            if constexpr (GATHER) {
                if (last && has_next) {
#pragma unroll
                    for (int h = 0; h < 2; ++h)
#pragma unroll
                        for (int i = 0; i < 2; ++i) { const int row = ridx[(ui + 1) * BM + h * HALF + Rr[i]]; nofs[h][i] = (unsigned)(row * K + Cc[i]) * 2u; }
                }
            }
            PG8_LDB(B0, 0, 0); PG8_LDB(B1, 0, 1); PG8_SCHED; PG8_LDA(At, 0, 0); PG8_STAGE_A(PG8_SA(1, 1), a1, cofs, 1);
            PG8_WAIT_V(8); PG8_WAIT_L(0); PG8_BAR; PG8_MMA(0, 0, At, B0); PG8_MMA(0, 1, At, B1); PG8_BAR; PG8_SCHED;
            PG8_LDA(At, 0, 1); PG8_STAGE(PG8_SB(0, 0), b2, voffB); PG8_STAGE(PG8_SB(0, 1), b2 + hstep, voffB);
            if (last) { PG8_STAGE_A(PG8_SA(0, 0), a2, nofs, 0); } else { PG8_STAGE_A(PG8_SA(0, 0), a2, cofs, 0); }
            PG8_WAIT_V(8); PG8_WAIT_L(0); PG8_BAR; PG8_MMA(1, 0, At, B0); PG8_MMA(1, 1, At, B1); PG8_BAR; PG8_SCHED;
            PG8_LDB(B0, 1, 0); PG8_LDB(B1, 1, 1); PG8_SCHED; PG8_LDA(At, 1, 0);
            if (last) { PG8_STAGE_A(PG8_SA(0, 1), a2, nofs, 1); } else { PG8_STAGE_A(PG8_SA(0, 1), a2, cofs, 1); }
            PG8_WAIT_V(8); PG8_WAIT_L(0); PG8_BAR; PG8_MMA(0, 0, At, B0); PG8_MMA(0, 1, At, B1); PG8_BAR; PG8_SCHED;
            PG8_LDA(At, 1, 1); PG8_STAGE(PG8_SB(1, 0), b3, voffB); PG8_STAGE(PG8_SB(1, 1), b3 + hstep, voffB);
            if (last) { PG8_STAGE_A(PG8_SA(1, 0), a3, nofs, 0); } else { PG8_STAGE_A(PG8_SA(1, 0), a3, cofs, 0); }
            PG8_WAIT_V(8); PG8_WAIT_L(0); PG8_BAR; PG8_MMA(1, 0, At, B0); PG8_MMA(1, 1, At, B1); PG8_BAR; PG8_SCHED;
        }
        if (wr == 0) PG8_BAR;
        E(acc, cur, wr, wc, fr, fq);
        if (!has_next) break;
#pragma unroll
        for (int a = 0; a < 2; ++a)
#pragma unroll
            for (int b = 0; b < 2; ++b)
#pragma unroll
                for (int m = 0; m < 4; ++m)
#pragma unroll
                    for (int n = 0; n < 2; ++n) acc[a][b][m][n] = (f32x4){0.f, 0.f, 0.f, 0.f};
        cur = nxt; cA = nA; cB = nB; ++ui;
        if constexpr (GATHER) {
#pragma unroll
            for (int h = 0; h < 2; ++h)
#pragma unroll
                for (int i = 0; i < 2; ++i) cofs[h][i] = nofs[h][i];
        }
        if (wr == 1) PG8_BAR;
    }
    PG8_WAIT_V(0);
    PG8_BAR;
#undef PG8_SA
#undef PG8_SB
#undef PG8_STAGE
#undef PG8_STAGE_A
#undef PG8_LDA
#undef PG8_LDB
#undef PG8_MMA
#undef PG8_WAIT_V
#undef PG8_WAIT_L
#undef PG8_BAR
#undef PG8_SCHED
}


struct EpiInproj {
    static constexpr bool PERM = true;
    uchar* zbase; bf16_t* ci; _Float16* olog0; _Float16* olog1; const float* lb; int seg0; int Tn;
    __device__ __forceinline__ void operator()(const f32x4 (&acc)[2][2][4][2], const Unit& u, int wr, int wc, int fr, int fq) const {
        const int seg = seg0 + (u.pn >> 1);
        const int row0 = u.pm * BM + wr * 64 + fr;
        if (seg <= 3) {
            const int b = (u.pm * BM) / Tn, t0 = row0 - b * Tn, dcol = wc * 32 + 8 * fq;
#pragma unroll
            for (int bj = 0; bj < 2; ++bj) { const int hh = (u.pn & 1) * 2 + bj; const size_t plane = (size_t)(b * NH + hh) * Tn;
                if (seg == 1 || seg == 2) {
                    _Float16* O = (seg == 1) ? olog0 : olog1; const float* lbp = lb + (seg - 1) * 512 + hh * 128 + dcol;
                    const f32x4 l0 = *(const f32x4*)lbp, l1 = *(const f32x4*)(lbp + 4);
#pragma unroll
                    for (int ai = 0; ai < 2; ++ai)
#pragma unroll
                        for (int m = 0; m < 4; ++m) { const f32x4 v0 = acc[ai][bj][m][0], v1 = acc[ai][bj][m][1]; _Float16 o[8];
#pragma unroll
                            for (int j = 0; j < 4; ++j) { const float s0 = __builtin_amdgcn_rcpf(1.f + __builtin_amdgcn_exp2f(v0[j] * -1.44269504f)), s1 = __builtin_amdgcn_rcpf(1.f + __builtin_amdgcn_exp2f(v1[j] * -1.44269504f));
                                o[j] = (_Float16)__builtin_amdgcn_logf(l0[j] + (1.f - l0[j]) * s0); o[4 + j] = (_Float16)__builtin_amdgcn_logf(l1[j] + (1.f - l1[j]) * s1); }
                            *(u32x4*)(O + (plane + t0 + ai * HALF + m * 16) * 128 + dcol) = __builtin_bit_cast(u32x4, o); }
                } else {
                    bf16_t* O = zbase ? (bf16_t*)(zbase + (size_t)(seg == 0 ? 0 : 160) * MiB) : ci;
#pragma unroll
                    for (int ai = 0; ai < 2; ++ai)
#pragma unroll
                        for (int m = 0; m < 4; ++m) { const f32x4 v0 = acc[ai][bj][m][0], v1 = acc[ai][bj][m][1];
                            u32x4 w; w.x = cvt_pk_bf16(v0[0], v0[1]); w.y = cvt_pk_bf16(v0[2], v0[3]); w.z = cvt_pk_bf16(v1[0], v1[1]); w.w = cvt_pk_bf16(v1[2], v1[3]);
                            *(u32x4*)(O + (plane + t0 + ai * HALF + m * 16) * 128 + dcol) = w; }
                }
            }
        } else if (seg >= 6) {
            const int col0 = (u.pn - 12) * 128 + wc * 32 + 8 * fq;
            bf16_t* O = (bf16_t*)(zbase + (size_t)(32 * 6 + 64) * MiB);
#pragma unroll
            for (int ai = 0; ai < 2; ++ai)
#pragma unroll
                for (int m = 0; m < 4; ++m) { const f32x4 v0 = acc[ai][0][m][0] * acc[ai][1][m][0], v1 = acc[ai][0][m][1] * acc[ai][1][m][1];
                    u32x4 w; w.x = cvt_pk_bf16(v0[0], v0[1]); w.y = cvt_pk_bf16(v0[2], v0[3]); w.z = cvt_pk_bf16(v1[0], v1[1]); w.w = cvt_pk_bf16(v1[2], v1[3]);
                    *(u32x4*)(O + (size_t)(row0 + ai * HALF + m * 16) * 512 + col0) = w; }
        } else {
            const int col0 = (u.pn & 1) * 256 + wc * 32 + 8 * fq;
            bf16_t* O = (bf16_t*)(zbase + (size_t)(32 * seg + 64) * MiB);
#pragma unroll
            for (int ai = 0; ai < 2; ++ai)
#pragma unroll
                for (int m = 0; m < 4; ++m) { bf16_t* rowp = O + (size_t)(row0 + ai * HALF + m * 16) * 512 + col0;
#pragma unroll
                    for (int bj = 0; bj < 2; ++bj) { const f32x4 v0 = acc[ai][bj][m][0], v1 = acc[ai][bj][m][1];
                        u32x4 w; w.x = cvt_pk_bf16(v0[0], v0[1]); w.y = cvt_pk_bf16(v0[2], v0[3]); w.z = cvt_pk_bf16(v1[0], v1[1]); w.w = cvt_pk_bf16(v1[2], v1[3]);
                        *(u32x4*)(rowp + bj * HALF) = w; } }
        }
    }
};
struct EpiOut {
    static constexpr bool PERM = false;
    const float* x; float* x1; const float* modf;
    __device__ __forceinline__ void operator()(const f32x4 (&acc)[2][2][4][2], const Unit& u, int wr, int wc, int fr, int fq) const {
        const int row0 = u.pm * BM + wr * 64 + fr, col0 = u.pn * BM + wc * 32 + 4 * fq;
        const int b = (u.pm * BM) / T;
        const float* g1 = modf + (size_t)b * NMOD + 2 * D;
        f32x4 gv[2][2];
#pragma unroll
        for (int bj = 0; bj < 2; ++bj)
#pragma unroll
            for (int n = 0; n < 2; ++n) gv[bj][n] = *(const f32x4*)(g1 + col0 + bj * HALF + n * 16);
#pragma unroll
        for (int ai = 0; ai < 2; ++ai)
#pragma unroll
            for (int m = 0; m < 4; ++m) { const size_t off = (size_t)(row0 + ai * HALF + m * 16) * D + col0;
#pragma unroll
                for (int bj = 0; bj < 2; ++bj)
#pragma unroll
                    for (int n = 0; n < 2; ++n) { const f32x4 xs = *(const f32x4*)(x + off + bj * HALF + n * 16); *(f32x4*)(x1 + off + bj * HALF + n * 16) = xs + gv[bj][n] * acc[ai][bj][m][n]; }
                asm volatile("" ::: "memory"); }
    }
};
struct EpiMoe1 {
    static constexpr bool PERM = true;
    bf16_t* hid;
    __device__ __forceinline__ void operator()(const f32x4 (&acc)[2][2][4][2], const Unit& u, int wr, int wc, int fr, int fq) const {
        const int row0 = u.pm * BM + wr * 64 + fr, col0 = u.pn * 128 + wc * 32 + 8 * fq;
#pragma unroll
        for (int ai = 0; ai < 2; ++ai)
#pragma unroll
            for (int m = 0; m < 4; ++m) { bf16_t* rowp = hid + (size_t)(row0 + ai * HALF + m * 16) * DFF + col0;
                float o[8];
#pragma unroll
                for (int n = 0; n < 2; ++n)
#pragma unroll
                    for (int j = 0; j < 4; ++j) { const float gt = acc[ai][0][m][n][j], up = acc[ai][1][m][n][j]; o[n * 4 + j] = gt * up * __builtin_amdgcn_rcpf(1.f + __builtin_amdgcn_exp2f(gt * -1.44269504f)); }
                u32x4 w; w.x = cvt_pk_bf16(o[0], o[1]); w.y = cvt_pk_bf16(o[2], o[3]); w.z = cvt_pk_bf16(o[4], o[5]); w.w = cvt_pk_bf16(o[6], o[7]);
                *(u32x4*)rowp = w; }
    }
};
struct EpiMoe2 {
    static constexpr bool PERM = true;
    bf16_t* ys; const LAS float* lgate;
    __device__ __forceinline__ void operator()(const f32x4 (&acc)[2][2][4][2], const Unit& u, int wr, int wc, int fr, int fq) const {
        const int row0 = u.pm * BM + wr * 64 + fr, col0 = u.pn * BM + wc * 32 + 8 * fq;
        const LAS float* gt_ = lgate + (u.e >> 2) * BM + wr * 64 + fr;
#pragma unroll
        for (int ai = 0; ai < 2; ++ai)
#pragma unroll
            for (int m = 0; m < 4; ++m) { const int row = row0 + ai * HALF + m * 16; const float gt = gt_[ai * HALF + m * 16]; bf16_t* rowp = ys + (size_t)row * D + col0;
#pragma unroll
                for (int bj = 0; bj < 2; ++bj) { const f32x4 v0 = acc[ai][bj][m][0] * gt, v1 = acc[ai][bj][m][1] * gt;
                    u32x4 w; w.x = cvt_pk_bf16(v0[0], v0[1]); w.y = cvt_pk_bf16(v0[2], v0[3]); w.z = cvt_pk_bf16(v1[0], v1[1]); w.w = cvt_pk_bf16(v1[2], v1[3]);
                    *(u32x4*)(rowp + bj * HALF) = w; } }
    }
};
}

struct Args {
    const float *x, *c, *ctx, *c_ctx, *w_ada, *b_ada, *norm_mix, *norm_ffn, *w_in, *lb_logits, *hg_norm, *conv_w, *w_out, *w_router, *w_gate, *w_up, *w_down, *norm_final;
    float* out; uchar* ws; int ph_lo, ph_hi;
};

__device__ __forceinline__ void cvt_item(const float* W, int ldw, bf16_t* WT, int ldt, int k0, int n0, int nrow0, LAS float* scr, int lane) {
    const int r = lane >> 3, c4 = lane & 7;
    f32x4 v[8];
#pragma unroll
    for (int i = 0; i < 8; ++i) v[i] = *(const f32x4*)(W + (size_t)(k0 + 8 * i + r) * ldw + n0 + 4 * c4);
#pragma unroll
    for (int i = 0; i < 8; ++i) { LAS float* d = scr + (8 * i + r) * 33 + 4 * c4; d[0] = v[i].x; d[1] = v[i].y; d[2] = v[i].z; d[3] = v[i].w; }
    LDS_WAIT(); asm volatile("" ::: "memory");
    const int c = lane & 7;
#pragma unroll
    for (int j = 0; j < 4; ++j) { const int n = (lane >> 3) + 8 * j; const LAS float* sp = scr + (8 * c) * 33 + n;
        u32x4 o; o.x = cvt_pk_bf16(sp[0 * 33], sp[1 * 33]); o.y = cvt_pk_bf16(sp[2 * 33], sp[3 * 33]); o.z = cvt_pk_bf16(sp[4 * 33], sp[5 * 33]); o.w = cvt_pk_bf16(sp[6 * 33], sp[7 * 33]);
        *(u32x4*)(WT + (size_t)(nrow0 + n) * ldt + k0 + 8 * c) = o; }
    LDS_WAIT(); asm volatile("" ::: "memory");
}

__device__ __forceinline__ void phase_prep(const Args& a, LAS uchar* lds, int bid, int G, int tid, int wid, int lane) {
    float* modp = (float*)(a.ws + WS_MODP);
    if (bid < 192) {
        const int cgp = bid % 24, ks = bid / 24, n0 = cgp * 256 + lane * 4, k0 = ks * 128 + wid * 16;
        LAS float* sc = (LAS float*)(lds + 81920);
        for (int i = tid; i < 9 * 128; i += 512) { const int r = i >> 7, kk = i & 127; sc[i] = silu_f((r < 8) ? a.c[r * D + ks * 128 + kk] : a.c_ctx[ks * 128 + kk]); }
        f32x4 w[16];
#pragma unroll
        for (int kk = 0; kk < 16; ++kk) w[kk] = *(const f32x4*)(a.w_ada + (size_t)(k0 + kk) * NMOD + n0);
        __syncthreads();
        f32x4 acc[9];
#pragma unroll
        for (int r = 0; r < 9; ++r) acc[r] = (f32x4){0.f, 0.f, 0.f, 0.f};
#pragma unroll
        for (int kk = 0; kk < 16; ++kk) {
#pragma unroll
            for (int r = 0; r < 9; ++r) acc[r] += w[kk] * sc[r * 128 + wid * 16 + kk]; }
        LAS f32x4* red = (LAS f32x4*)lds;
#pragma unroll
        for (int r = 0; r < 9; ++r) red[(wid * 9 + r) * 64 + lane] = acc[r];
        __syncthreads();
        for (int o = tid; o < 9 * 64; o += 512) { const int r = o / 64, l = o % 64; f32x4 sm = red[(0 * 9 + r) * 64 + l];
#pragma unroll
            for (int w8 = 1; w8 < 8; ++w8) sm += red[(w8 * 9 + r) * 64 + l];
            if (ks == 0) sm += *(const f32x4*)(a.b_ada + cgp * 256 + l * 4);
            *(f32x4*)(modp + ((size_t)ks * 9 + r) * NMOD + cgp * 256 + l * 4) = sm; }
        __syncthreads();
    }
    if (bid == 255) {
        float* lb = (float*)(a.ws + WS_LB);
        for (int i = tid; i < 1024; i += 512) { const float l0 = a.lb_logits[i], l1 = a.lb_logits[1024 + i]; lb[i] = 1.f / (1.f + __expf(l1 - l0)); }
    }
    LAS float* scr = (LAS float*)lds + wid * (64 * 33);
    const int gw = (G - 1 - bid) * 8 + wid, NGW = G * 8;
    constexpr int I_IN = (D / 64) * (NIN / 32), I_OUT = (D / 64) * (D / 32);
    for (int it = gw; it < I_IN + I_OUT; it += NGW) {
        if (it < I_IN) { const int nblk = NIN / 32, kb = it / nblk, nb = it % nblk; const int n0 = nb * 32;
            const int nrow = (n0 < 3072) ? n0 : 3072 + (((n0 - 3072) & 511) >> 7) * 256 + ((n0 - 3072) & 127) + ((n0 >= 3584) ? 128 : 0);
            cvt_item(a.w_in, NIN, (bf16_t*)(a.ws + WS_WIN), D, kb * 64, n0, nrow, scr, lane); }
        else { const int r = it - I_IN, nblk = D / 32, kb = r / nblk, nb = r % nblk; cvt_item(a.w_out, D, (bf16_t*)(a.ws + WS_WOUT), D, kb * 64, nb * 32, nb * 32, scr, lane); }
    }
}

__device__ __forceinline__ float modp_sum(const float* modp, int r, int col) { float s = 0.f;
#pragma unroll
    for (int ks = 0; ks < 8; ++ks) s += modp[((size_t)ks * 9 + r) * NMOD + col];
    return s; }
template <int NR>
__device__ __forceinline__ void norm_rows(const float* xrow0, bf16_t* orow0, const LAS float* gm, const LAS float* sh, int lane) {
    f32x4 v[NR][4]; float ss[NR];
#pragma unroll
    for (int i = 0; i < NR; ++i) { ss[i] = 0.f;
#pragma unroll
        for (int j = 0; j < 4; ++j) v[i][j] = *((const f32x4*)(xrow0 + (size_t)i * D) + lane + 64 * j); }
#pragma unroll
    for (int i = 0; i < NR; ++i) {
#pragma unroll
        for (int j = 0; j < 4; ++j) ss[i] += (v[i][j].x * v[i][j].x + v[i][j].y * v[i][j].y) + (v[i][j].z * v[i][j].z + v[i][j].w * v[i][j].w);
        ss[i] = rsqrtf(wave_sum(ss[i]) * (1.f / D) + EPS); }
#pragma unroll
    for (int j = 0; j < 4; ++j) { const f32x4 g4 = *((const LAS f32x4*)gm + lane + 64 * j), s4 = *((const LAS f32x4*)sh + lane + 64 * j);
#pragma unroll
        for (int i = 0; i < NR; ++i) { const f32x4 o = v[i][j] * ss[i] * g4 + s4;
            u32x2 w; w.x = cvt_pk_bf16(o.x, o.y); w.y = cvt_pk_bf16(o.z, o.w); *((u32x2*)(orow0 + (size_t)i * D) + lane + 64 * j) = w; } }
}
__device__ __forceinline__ void phase_norm(const Args& a, LAS uchar* lds, int bid, int G, int tid, int wid, int lane) {
    const float* modp = (const float*)(a.ws + WS_MODP); float* modf = (float*)(a.ws + WS_MODF);
    { const int gt = bid * 512 + tid; if (gt < 9 * NMOD) modf[gt] = modp_sum(modp, gt / NMOD, gt % NMOD); }
    LAS float* gm = (LAS float*)lds; LAS float* sh = gm + D; LAS float* cgm = sh + D; LAS float* csh = cgm + D;
    const int b = bid / 32;
    for (int cidx = tid; cidx < D; cidx += 512) { const float nm = a.norm_mix[cidx];
        sh[cidx] = modp_sum(modp, b, cidx); gm[cidx] = nm * (1.f + modp_sum(modp, b, D + cidx));
        csh[cidx] = modp_sum(modp, 8, cidx); cgm[cidx] = nm * (1.f + modp_sum(modp, 8, D + cidx)); }
    __syncthreads();
    bf16_t* hx = (bf16_t*)(a.ws + WS_ACT); bf16_t* hc = (bf16_t*)(a.ws + WS_HC);
    { const int row = bid * 8 + wid; norm_rows<1>(a.ctx + (size_t)row * D, hc + (size_t)row * D, cgm, csh, lane); }
    for (int j = 0; j < 16; j += 4) { const int row = bid * 128 + wid * 16 + j; norm_rows<4>(a.x + (size_t)row * D, hx + (size_t)row * D, gm, sh, lane); }
    __syncthreads();
}

constexpr int GL_QDP = 0, GL_KIP = 8704, GL_KETP = 17408, GL_VTP = 27648, GL_DEC = 37888, GL_TOT = 38400, GL_RING = 43008, GL_SLOT = 24576;
#define GLA_BAR() do { asm volatile("s_waitcnt lgkmcnt(0)" ::: "memory"); __builtin_amdgcn_s_barrier(); asm volatile("" ::: "memory"); } while (0)
template <bool FULL>
__device__ __forceinline__ void gla_item(LAS uchar* lds, const bf16_t* qb, const _Float16* lfb, const bf16_t* vb, bf16_t* ob, f32x4 (&S)[8], float* dl_out,
                                         int row_base, int Tn, int tau0, int nch, int h, int dir, int wid, int lane) {
    const int fr = lane & 15, fq = lane >> 4;
#define GLA_ISSUE(c) do { LAS uchar* _sl = lds + GL_RING + ((c) & 3) * GL_SLOT + wid * 3072; \
        const int _tau = tau0 + 32 * (c) + 4 * wid + (lane >> 4); const size_t _o = (size_t)(dir ? (Tn - 1 - _tau) : _tau) * 128 + (lane & 15) * 8; \
        __builtin_amdgcn_global_load_lds((const unsigned*)(lfb + _o), (LAS unsigned*)(_sl), 16, 0, 0); \
        if (FULL) __builtin_amdgcn_global_load_lds((const unsigned*)(qb + _o), (LAS unsigned*)(_sl + 1024), 16, 0, 0); \
        __builtin_amdgcn_global_load_lds((const unsigned*)(vb + _o), (LAS unsigned*)(_sl + 2048), 16, 0, 0); } while (0)
    GLA_ISSUE(0);
    if (nch > 1) GLA_ISSUE(1);
    if (nch > 2) GLA_ISSUE(2);
    const int d0 = 2 * lane, pos0 = (d0 & ~31) + 8 * ((d0 >> 2) & 3) + 4 * ((d0 >> 4) & 1) + (d0 & 3);
    const int spos = 8 * (wid & 3) + 4 * (wid >> 2);
    f32x2 dsum = (f32x2){0.f, 0.f};
    for (int n = 0; n < nch; ++n) {
        if (n + 2 < nch) { if (FULL) asm volatile("s_waitcnt vmcnt(6)" ::: "memory"); else asm volatile("s_waitcnt vmcnt(4)" ::: "memory"); }
        else if (n + 1 < nch) { if (FULL) asm volatile("s_waitcnt vmcnt(3)" ::: "memory"); else asm volatile("s_waitcnt vmcnt(2)" ::: "memory"); }
        else asm volatile("s_waitcnt vmcnt(0)" ::: "memory");
        const LAS uchar* sl = lds + GL_RING + (n & 3) * GL_SLOT + wid * 3072;
        f32x2 lf[4];
#pragma unroll
        for (int rr = 0; rr < 4; ++rr) { typedef _Float16 h2_t __attribute__((ext_vector_type(2))); const h2_t hv = *(const LAS h2_t*)(sl + rr * 256 + lane * 4); lf[rr] = (f32x2){(float)hv.x, (float)hv.y}; }
        f32x2 c[4]; c[0] = lf[0]; c[1] = c[0] + lf[1]; c[2] = c[1] + lf[2]; c[3] = c[2] + lf[3];
        LAS f32x2* tot = (LAS f32x2*)(lds + GL_TOT);
        tot[wid * 64 + lane] = c[3];
        unsigned qv[4], vv[4];
#pragma unroll
        for (int rr = 0; rr < 4; ++rr) { vv[rr] = *(const LAS unsigned*)(sl + 2048 + rr * 256 + lane * 4); qv[rr] = FULL ? *(const LAS unsigned*)(sl + 1024 + rr * 256 + lane * 4) : 0u; }
        GLA_BAR();
        if (n + 3 < nch) GLA_ISSUE(n + 3);
        f32x2 pre = (f32x2){0.f, 0.f}, all = (f32x2){0.f, 0.f};
#pragma unroll
        for (int w = 0; w < 8; ++w) { const f32x2 tw = tot[w * 64 + lane]; all += tw; if (w < wid) pre += tw; }
        dsum += all;
        const f32x2 decall = (f32x2){__builtin_amdgcn_exp2f(all.x), __builtin_amdgcn_exp2f(all.y)};
        f32x2 kE[4];
#pragma unroll
        for (int rr = 0; rr < 4; ++rr) {
            const f32x2 cum = pre + c[rr];
            const f32x2 k = 1.f - (f32x2){__builtin_amdgcn_exp2f(lf[rr].x), __builtin_amdgcn_exp2f(lf[rr].y)};
            const f32x2 ki = k * (f32x2){__builtin_amdgcn_exp2f(-cum.x), __builtin_amdgcn_exp2f(-cum.y)};
            kE[rr] = ki * decall;
            if (FULL) { const int s = 4 * wid + rr; const f32x2 qd = (f32x2){bf_lo(qv[rr]), bf_hi(qv[rr])} * (f32x2){__builtin_amdgcn_exp2f(cum.x), __builtin_amdgcn_exp2f(cum.y)};
                *(LAS unsigned*)(lds + GL_QDP + s * 272 + pos0 * 2) = cvt_pk_bf16(qd.x, qd.y);
                *(LAS unsigned*)(lds + GL_KIP + s * 272 + pos0 * 2) = cvt_pk_bf16(ki.x, ki.y); }
        }
        { u32x2 w0, w1; w0.x = cvt_pk_bf16(kE[0].x, kE[1].x); w0.y = cvt_pk_bf16(kE[2].x, kE[3].x); w1.x = cvt_pk_bf16(kE[0].y, kE[1].y); w1.y = cvt_pk_bf16(kE[2].y, kE[3].y);
          *(LAS u32x2*)(lds + GL_KETP + (d0) * 80 + spos * 2) = w0; *(LAS u32x2*)(lds + GL_KETP + (d0 + 1) * 80 + spos * 2) = w1;
          u32x2 v0, v1; v0.x = (vv[0] & 0xffffu) | (vv[1] << 16); v0.y = (vv[2] & 0xffffu) | (vv[3] << 16);
          v1.x = (vv[0] >> 16) | (vv[1] & 0xffff0000u); v1.y = (vv[2] >> 16) | (vv[3] & 0xffff0000u);
          *(LAS u32x2*)(lds + GL_VTP + (d0) * 80 + spos * 2) = v0; *(LAS u32x2*)(lds + GL_VTP + (d0 + 1) * 80 + spos * 2) = v1; }
        if (wid == 0) *(LAS f32x2*)(lds + GL_DEC + lane * 8) = decall;
        GLA_BAR();
        const bf16x8 vt = *(const LAS bf16x8*)(lds + GL_VTP + (16 * wid + fr) * 80 + fq * 16);
        if (FULL) {
            bf16x8 qf[2][4];
#pragma unroll
            for (int ti = 0; ti < 2; ++ti)
#pragma unroll
                for (int kk = 0; kk < 4; ++kk) qf[ti][kk] = *(const LAS bf16x8*)(lds + GL_QDP + (16 * ti + fr) * 272 + kk * 64 + fq * 16);
            f32x4 oT[2] = {(f32x4){0.f, 0.f, 0.f, 0.f}, (f32x4){0.f, 0.f, 0.f, 0.f}};
            f32x4 p00 = (f32x4){0.f, 0.f, 0.f, 0.f}, p01 = p00, p11 = p00;
#pragma unroll
            for (int kk = 0; kk < 4; ++kk) {
                const bf16x8 kj0 = *(const LAS bf16x8*)(lds + GL_KIP + (fr) * 272 + kk * 64 + fq * 16);
                const bf16x8 kj1 = *(const LAS bf16x8*)(lds + GL_KIP + (16 + fr) * 272 + kk * 64 + fq * 16);
                p00 = __builtin_amdgcn_mfma_f32_16x16x32_bf16(kj0, qf[0][kk], p00, 0, 0, 0);
                p01 = __builtin_amdgcn_mfma_f32_16x16x32_bf16(kj0, qf[1][kk], p01, 0, 0, 0);
                p11 = __builtin_amdgcn_mfma_f32_16x16x32_bf16(kj1, qf[1][kk], p11, 0, 0, 0);
                u32x4 sa; sa.x = cvt_pk_bf16_safe(S[2 * kk][0], S[2 * kk][1]); sa.y = cvt_pk_bf16_safe(S[2 * kk][2], S[2 * kk][3]);
                sa.z = cvt_pk_bf16_safe(S[2 * kk + 1][0], S[2 * kk + 1][1]); sa.w = cvt_pk_bf16_safe(S[2 * kk + 1][2], S[2 * kk + 1][3]);
                const bf16x8 sA = __builtin_bit_cast(bf16x8, sa);
                oT[0] = __builtin_amdgcn_mfma_f32_16x16x32_bf16(sA, qf[0][kk], oT[0], 0, 0, 0);
                oT[1] = __builtin_amdgcn_mfma_f32_16x16x32_bf16(sA, qf[1][kk], oT[1], 0, 0, 0);
            }
            u32x4 pb0, pb1;
            { float m0[4], m1[4];
#pragma unroll
              for (int r = 0; r < 4; ++r) { const bool ok = (4 * fq + r) <= fr; m0[r] = ok ? p00[r] : 0.f; m1[r] = ok ? p11[r] : 0.f; }
              pb0.x = cvt_pk_bf16_safe(m0[0], m0[1]); pb0.y = cvt_pk_bf16_safe(m0[2], m0[3]); pb0.z = 0u; pb0.w = 0u;
              pb1.x = cvt_pk_bf16_safe(p01[0], p01[1]); pb1.y = cvt_pk_bf16_safe(p01[2], p01[3]); pb1.z = cvt_pk_bf16_safe(m1[0], m1[1]); pb1.w = cvt_pk_bf16_safe(m1[2], m1[3]); }
            oT[0] = __builtin_amdgcn_mfma_f32_16x16x32_bf16(vt, __builtin_bit_cast(bf16x8, pb0), oT[0], 0, 0, 0);
            oT[1] = __builtin_amdgcn_mfma_f32_16x16x32_bf16(vt, __builtin_bit_cast(bf16x8, pb1), oT[1], 0, 0, 0);
#pragma unroll
            for (int ti = 0; ti < 2; ++ti) { const int tau = tau0 + 32 * n + 16 * ti + fr; const size_t row = (size_t)(row_base + (dir ? (Tn - 1 - tau) : tau));
                u32x2 w; w.x = cvt_pk_bf16_safe(oT[ti][0], oT[ti][1]); w.y = cvt_pk_bf16_safe(oT[ti][2], oT[ti][3]);
                *(u32x2*)(ob + row * 512 + h * 128 + 16 * wid + 4 * fq) = w; }
        }
#pragma unroll
        for (int t8 = 0; t8 < 8; ++t8) {
            const f32x4 dc = *(const LAS f32x4*)(lds + GL_DEC + (16 * t8 + 4 * fq) * 4);
            const bf16x8 ka = *(const LAS bf16x8*)(lds + GL_KETP + (16 * t8 + fr) * 80 + fq * 16);
            S[t8] = __builtin_amdgcn_mfma_f32_16x16x32_bf16(ka, vt, S[t8] * dc, 0, 0, 0);
        }
    }
#undef GLA_ISSUE
    if (dl_out && wid == 0) *(f32x2*)(dl_out + 2 * lane) = dsum;
    asm volatile("s_waitcnt vmcnt(0)" ::: "memory");
    GLA_BAR();
}
__device__ __forceinline__ void gla_state_store(float* p, const f32x4 (&S)[8], int wid, int fr, int fq) {
#pragma unroll
    for (int t8 = 0; t8 < 8; ++t8)
#pragma unroll
        for (int r = 0; r < 4; ++r) p[(size_t)(16 * t8 + 4 * fq + r) * 128 + 16 * wid + fr] = S[t8][r];
}
__device__ __forceinline__ void phase_gla_states(const Args& a, LAS uchar* lds, int bid, int wid, int lane) {
    uchar* ws = a.ws; const int fr = lane & 15, fq = lane >> 4;
    f32x4 S[8];
#pragma unroll
    for (int t8 = 0; t8 < 8; ++t8) S[t8] = (f32x4){0.f, 0.f, 0.f, 0.f};
    if (bid < 192) { const int bhd = bid / 3, seg = bid % 3, b = bhd >> 3, h = (bhd >> 1) & 3, dir = bhd & 1;
        const size_t pl = (size_t)(b * NH + h) * T * 128;
        gla_item<false>(lds, nullptr, (const _Float16*)(ws + (dir ? WS_LBW : WS_LF)) + pl, (const bf16_t*)(ws + WS_ZI) + pl, nullptr, S, (float*)(ws + WS_DL) + (size_t)bid * 128,
                        b * T, T, seg * 1024, 32, h, dir, wid, lane);
        gla_state_store((float*)(ws + WS_SL) + (size_t)bid * 16384, S, wid, fr, fq);
    } else { const int bhd = bid - 192, b = bhd >> 3, h = (bhd >> 1) & 3, dir = bhd & 1;
        const size_t pl = (size_t)(b * NH + h) * CT * 128;
        gla_item<false>(lds, nullptr, (const _Float16*)(ws + (dir ? WS_CLB : WS_CLF)) + pl, (const bf16_t*)(ws + WS_CI) + pl, nullptr, S, nullptr, b * CT, CT, 0, CT / 32, h, dir, wid, lane);
        gla_state_store((float*)(ws + WS_S0) + (size_t)bhd * 16384, S, wid, fr, fq);
    }
}
__device__ __forceinline__ void phase_gla_out(const Args& a, LAS uchar* lds, int bid, int wid, int lane) {
    uchar* ws = a.ws; const int fr = lane & 15, fq = lane >> 4;
    const int bhd = bid >> 2, seg = bid & 3, b = bhd >> 3, h = (bhd >> 1) & 3, dir = bhd & 1;
    f32x4 S[8];
    { const float* p = (const float*)(ws + WS_S0) + (size_t)bhd * 16384;
#pragma unroll
      for (int t8 = 0; t8 < 8; ++t8)
#pragma unroll
          for (int r = 0; r < 4; ++r) S[t8][r] = p[(size_t)(16 * t8 + 4 * fq + r) * 128 + 16 * wid + fr]; }
    for (int j = 0; j < seg; ++j) { const float* p = (const float*)(ws + WS_SL) + (size_t)(bhd * 3 + j) * 16384; const float* dl = (const float*)(ws + WS_DL) + (size_t)(bhd * 3 + j) * 128;
#pragma unroll
        for (int t8 = 0; t8 < 8; ++t8) { const f32x4 dv = *(const f32x4*)(dl + 16 * t8 + 4 * fq);
#pragma unroll
            for (int r = 0; r < 4; ++r) S[t8][r] = __builtin_amdgcn_exp2f(dv[r]) * S[t8][r] + p[(size_t)(16 * t8 + 4 * fq + r) * 128 + 16 * wid + fr]; } }
    asm volatile("s_waitcnt vmcnt(0)" ::: "memory");
    const size_t pl = (size_t)(b * NH + h) * T * 128;
    gla_item<true>(lds, (const bf16_t*)(ws + WS_ZQ) + pl, (const _Float16*)(ws + (dir ? WS_LBW : WS_LF)) + pl, (const bf16_t*)(ws + WS_ZI) + pl, (bf16_t*)(ws + (dir ? WS_OB : WS_OF)), S, nullptr,
                   b * T, T, seg * 1024, 32, h, dir, wid, lane);
}

__device__ __forceinline__ void unpack8(const u32x4 w, float (&f)[8]) { f[0] = bf_lo(w.x); f[1] = bf_hi(w.x); f[2] = bf_lo(w.y); f[3] = bf_hi(w.y); f[4] = bf_lo(w.z); f[5] = bf_hi(w.z); f[6] = bf_lo(w.w); f[7] = bf_hi(w.w); }
__device__ __forceinline__ void phase_mixfin(const Args& a, int bid, int G, int wid, int lane) {
    const bf16_t* of = (const bf16_t*)(a.ws + WS_OF); const bf16_t* obw = (const bf16_t*)(a.ws + WS_OB); const bf16_t* zg = (const bf16_t*)(a.ws + WS_ZG);
    const bf16_t* zgb = (const bf16_t*)(a.ws + WS_ZGB); const bf16_t* zgc = (const bf16_t*)(a.ws + WS_ZGC);
    bf16_t* A2 = (bf16_t*)(a.ws + WS_ACT);
    const int c0 = 8 * lane;
    float gain[8], cw0[8], cw1[8], cw2[8];
#pragma unroll
    for (int j = 0; j < 8; ++j) { gain[j] = a.hg_norm[(c0 + j) & 127]; cw0[j] = a.conv_w[c0 + j]; cw1[j] = a.conv_w[512 + c0 + j]; cw2[j] = a.conv_w[1024 + c0 + j]; }
    for (int row = bid * 8 + wid; row < M; row += G * 8) {
        const size_t ro = (size_t)row * 512 + c0;
        float f0[8], f1[8], gg[8], o[8];
        unpack8(*(const u32x4*)(of + ro), f0); unpack8(*(const u32x4*)(obw + ro), f1); unpack8(*(const u32x4*)(zg + ro), gg);
        float ss = 0.f;
#pragma unroll
        for (int j = 0; j < 8; ++j) { o[j] = f0[j] + f1[j]; ss += o[j] * o[j]; }
        ss += __shfl_xor(ss, 1); ss += __shfl_xor(ss, 2); ss += __shfl_xor(ss, 4); ss += __shfl_xor(ss, 8);
        const float rstd = rsqrtf(ss * (1.f / 128.f) + EPS);
#pragma unroll
        for (int j = 0; j < 8; ++j) o[j] = o[j] * rstd * gain[j] * silu_f(gg[j]);
        u32x4 w; w.x = cvt_pk_bf16(o[0], o[1]); w.y = cvt_pk_bf16(o[2], o[3]); w.z = cvt_pk_bf16(o[4], o[5]); w.w = cvt_pk_bf16(o[6], o[7]);
        *(u32x4*)(A2 + (size_t)row * D + c0) = w;
        const int tw = row & 63;
        float um[8], u0[8], up[8], gb[8], y[8];
        unpack8(*(const u32x4*)(zgc + ro), u0); unpack8(*(const u32x4*)(zgb + ro), gb);
        if (tw > 0) unpack8(*(const u32x4*)(zgc + ro - 512), um);
        else {
#pragma unroll
            for (int j = 0; j < 8; ++j) um[j] = 0.f; }
        if (tw < 63) unpack8(*(const u32x4*)(zgc + ro + 512), up);
        else {
#pragma unroll
            for (int j = 0; j < 8; ++j) up[j] = 0.f; }
#pragma unroll
        for (int j = 0; j < 8; ++j) y[j] = gb[j] * (cw0[j] * um[j] + cw1[j] * u0[j] + cw2[j] * up[j]);
        w.x = cvt_pk_bf16(y[0], y[1]); w.y = cvt_pk_bf16(y[2], y[3]); w.z = cvt_pk_bf16(y[4], y[5]); w.w = cvt_pk_bf16(y[6], y[7]);
        *(u32x4*)(A2 + (size_t)row * D + 512 + c0) = w;
    }
}

__device__ __forceinline__ void phase_router(const Args& a, LAS uchar* lds, int bid, int tid, int wid, int lane) {
    const float* modf = (const float*)(a.ws + WS_MODF);
    LAS float* gm = (LAS float*)lds; LAS float* sh = gm + D;
    LAS uchar* wrl = lds + 8192;
    const int b = bid / 32;
    for (int cidx = tid; cidx < D; cidx += 512) { sh[cidx] = modf[(size_t)b * NMOD + 3 * D + cidx]; gm[cidx] = a.norm_ffn[cidx] * (1.f + modf[(size_t)b * NMOD + 4 * D + cidx]); }
    for (int i = tid; i < D * 4; i += 512) { const int col = i >> 2, q4 = i & 3; *(LAS f32x4*)(wrl + col * 64 + (col >> 2) * 16 + q4 * 16) = *(const f32x4*)(a.w_router + col * 16 + q4 * 4); }
    __syncthreads();
    bf16_t* hx2 = (bf16_t*)(a.ws + WS_ACT); float* aff = (float*)(a.ws + WS_AFF);
    for (int jb = 0; jb < 4; ++jb) {
        const int row0 = bid * 128 + wid * 16 + jb * 4;
        f32x4 v[4][4]; float rstd[4];
#pragma unroll
        for (int i = 0; i < 4; ++i) { const float* xrow = a.out + (size_t)(row0 + i) * D; float ss = 0.f;
#pragma unroll
            for (int jj = 0; jj < 4; ++jj) { v[i][jj] = *((const f32x4*)xrow + lane + 64 * jj); ss += (v[i][jj].x * v[i][jj].x + v[i][jj].y * v[i][jj].y) + (v[i][jj].z * v[i][jj].z + v[i][jj].w * v[i][jj].w); }
            rstd[i] = ss; }
#pragma unroll
        for (int i = 0; i < 4; ++i) rstd[i] = rsqrtf(wave_sum(rstd[i]) * (1.f / D) + EPS);
        float pl[64];
#pragma unroll
        for (int e = 0; e < 64; ++e) pl[e] = 0.f;
#pragma unroll
        for (int jj = 0; jj < 4; ++jj) { const f32x4 g4 = *((const LAS f32x4*)gm + lane + 64 * jj), s4 = *((const LAS f32x4*)sh + lane + 64 * jj);
#pragma unroll
            for (int i = 0; i < 4; ++i) { v[i][jj] = v[i][jj] * rstd[i] * g4 + s4;
                u32x2 w; w.x = cvt_pk_bf16(v[i][jj].x, v[i][jj].y); w.y = cvt_pk_bf16(v[i][jj].z, v[i][jj].w); *((u32x2*)(hx2 + (size_t)(row0 + i) * D) + lane + 64 * jj) = w; }
            const int colb = 4 * lane + 256 * jj;
#pragma unroll
            for (int cc = 0; cc < 4; ++cc) { const int col = colb + cc; const LAS uchar* wp = wrl + col * 64 + (col >> 2) * 16;
#pragma unroll
                for (int q4 = 0; q4 < 4; ++q4) { const f32x4 w4 = *(const LAS f32x4*)(wp + q4 * 16);
#pragma unroll
                    for (int i = 0; i < 4; ++i) { const float hvv = v[i][jj][cc]; pl[i * 16 + q4 * 4 + 0] += hvv * w4.x; pl[i * 16 + q4 * 4 + 1] += hvv * w4.y; pl[i * 16 + q4 * 4 + 2] += hvv * w4.z; pl[i * 16 + q4 * 4 + 3] += hvv * w4.w; } } } }
#pragma unroll
        for (int k = 0; k < 32; ++k) { const bool hi = (lane & 32) != 0; const float keep = hi ? pl[32 + k] : pl[k], send = hi ? pl[k] : pl[32 + k]; pl[k] = keep + __shfl_xor(send, 32); }
#pragma unroll
        for (int k = 0; k < 16; ++k) { const bool hi = (lane & 16) != 0; const float keep = hi ? pl[16 + k] : pl[k], send = hi ? pl[k] : pl[16 + k]; pl[k] = keep + __shfl_xor(send, 16); }
#pragma unroll
        for (int k = 0; k < 8; ++k) { const bool hi = (lane & 8) != 0; const float keep = hi ? pl[8 + k] : pl[k], send = hi ? pl[k] : pl[8 + k]; pl[k] = keep + __shfl_xor(send, 8); }
#pragma unroll
        for (int k = 0; k < 4; ++k) { const bool hi = (lane & 4) != 0; const float keep = hi ? pl[4 + k] : pl[k], send = hi ? pl[k] : pl[4 + k]; pl[k] = keep + __shfl_xor(send, 4); }
#pragma unroll
        for (int k = 0; k < 2; ++k) { const bool hi = (lane & 2) != 0; const float keep = hi ? pl[2 + k] : pl[k], send = hi ? pl[k] : pl[2 + k]; pl[k] = keep + __shfl_xor(send, 2); }
        { const bool hi = (lane & 1) != 0; const float keep = hi ? pl[1] : pl[0], send = hi ? pl[0] : pl[1]; pl[0] = keep + __shfl_xor(send, 1); }
        const float lg = pl[0];
        float mx = lg;
#pragma unroll
        for (int o = 1; o < 16; o <<= 1) mx = fmaxf(mx, __shfl_xor(mx, o));
        const float ex = __expf(lg - mx); float den = ex;
#pragma unroll
        for (int o = 1; o < 16; o <<= 1) den += __shfl_xor(den, o);
        const int t = (row0 + (lane >> 4)) & (T - 1);
        aff[((size_t)b * NE + (lane & 15)) * T + t] = ex / den;
    }
    __syncthreads();
}

__device__ __forceinline__ void topk_item(const Args& a, LAS uchar* lds, int b, int e, int tid, int wid, int lane) {
    LAS unsigned* key = (LAS unsigned*)lds;
    LAS unsigned* hist = key + 4096;
    LAS unsigned* ctl = hist + 256;
    LAS unsigned* wsum = ctl + 8;
    const float* affp = (const float*)(a.ws + WS_AFF) + ((size_t)b * NE + e) * T;
    unsigned kv[8];
    { const u32x4 k0 = *(const u32x4*)(affp + tid * 8), k1 = *(const u32x4*)(affp + tid * 8 + 4); kv[0] = k0.x; kv[1] = k0.y; kv[2] = k0.z; kv[3] = k0.w; kv[4] = k1.x; kv[5] = k1.y; kv[6] = k1.z; kv[7] = k1.w; }
    unsigned prefix = 0u, mask = 0u, need = CAP;
    for (int shift = 24; shift >= 0; shift -= 8) {
        if (tid < 256) hist[tid] = 0u;
        __syncthreads();
#pragma unroll
        for (int j = 0; j < 8; ++j) if ((kv[j] & mask) == prefix) __hip_atomic_fetch_add(&hist[(kv[j] >> shift) & 255u], 1u, __ATOMIC_RELAXED, __HIP_MEMORY_SCOPE_WORKGROUP);
        __syncthreads();
        if (tid < 256) { unsigned above = 0u; for (int bb = tid + 1; bb < 256; ++bb) above += hist[bb]; const unsigned mine = hist[tid];
            if (above < need && need <= above + mine) { ctl[0] = (unsigned)tid; ctl[1] = need - above; } }
        __syncthreads();
        prefix |= ctl[0] << shift; mask |= 255u << shift; need = ctl[1];
        __syncthreads();
    }
    unsigned cg_ = 0u, ce_ = 0u;
#pragma unroll
    for (int j = 0; j < 8; ++j) { cg_ += kv[j] > prefix; ce_ += kv[j] == prefix; }
    unsigned pk = cg_ | (ce_ << 16), incl = pk;
#pragma unroll
    for (int o = 1; o < 64; o <<= 1) { const unsigned t2 = __shfl_up(incl, o); if (lane >= o) incl += t2; }
    if (lane == 63) wsum[wid] = incl;
    __syncthreads();
    unsigned base = 0u;
    for (int w = 0; w < wid; ++w) base += wsum[w];
    unsigned excl = base + incl - pk; unsigned ng = excl & 0xffffu, neq = excl >> 16;
    int* seltok = (int*)(a.ws + WS_SELTOK); float* selgate = (float*)(a.ws + WS_SELGATE); short* pos = (short*)(a.ws + WS_POS);
#pragma unroll
    for (int j = 0; j < 8; ++j) { const int t = tid * 8 + j; const bool gt = kv[j] > prefix, eq = kv[j] == prefix; const bool sel = gt || (eq && neq < need);
        int slot = -1;
        if (sel) slot = (int)(ng + (neq < need ? neq : need));
        if (sel) { seltok[e * 4096 + b * 512 + slot] = b * T + t; selgate[e * 4096 + b * 512 + slot] = __uint_as_float(kv[j]); }
        pos[((size_t)b * T + t) * 16 + e] = (short)slot;
        ng += gt; neq += eq; }
    __syncthreads();
}
__device__ __forceinline__ void phase_topk_cvt(const Args& a, LAS uchar* lds, int bid, int G, int tid, int wid, int lane) {
    if (bid < 128) topk_item(a, lds, bid / 16, bid % 16, tid, wid, lane);
    LAS float* scr = (LAS float*)(lds + 32768) + wid * (64 * 33);
    bf16_t* wgu = (bf16_t*)(a.ws + WS_WGU); bf16_t* wdn = (bf16_t*)(a.ws + WS_WDN);
    constexpr int I_G = (D / 64) * (DFF / 32);
    constexpr int I_D = (DFF / 64) * (D / 32);
    constexpr int PER_E = 2 * I_G + I_D, TOTAL = NE * PER_E;
    static_assert(TOTAL == 1024 * 22 + 1024 * 26, "item split");
    const bool tk = bid < 128; const int wi = (tk ? bid : bid - 128) * 8 + wid;
    const int cnt = tk ? 22 : 26, base = tk ? 1024 * 26 : 0;
    for (int k = 0; k < cnt; ++k) { const int it = base + k * 1024 + wi;
        const int e = it / PER_E; int r = it % PER_E;
        if (r < 2 * I_G) { const int up = r >= I_G; if (up) r -= I_G; const int nblk = DFF / 32, kb = r / nblk, nb = r % nblk, n0 = nb * 32;
            const float* W = (up ? a.w_up : a.w_gate) + (size_t)e * D * DFF;
            cvt_item(W, DFF, wgu + (size_t)e * 4096 * D, D, kb * 64, n0, (n0 >> 7) * 256 + (n0 & 127) + (up ? 128 : 0), scr, lane); }
        else { r -= 2 * I_G; const int nblk = D / 32, kb = r / nblk, nb = r % nblk;
            cvt_item(a.w_down + (size_t)e * DFF * D, D, wdn + (size_t)e * D * DFF, DFF, kb * 64, nb * 32, nb * 32, scr, lane); }
    }
    __syncthreads();
}

__device__ __forceinline__ void phase_final(const Args& a, int bid, int G, int wid, int lane) {
    const float* modf = (const float*)(a.ws + WS_MODF); const short* pos = (const short*)(a.ws + WS_POS); const bf16_t* ys = (const bf16_t*)(a.ws + WS_YS);
    f32x4 nf[4];
#pragma unroll
    for (int q = 0; q < 4; ++q) nf[q] = *(const f32x4*)(a.norm_final + (q >> 1) * 512 + 8 * lane + (q & 1) * 4);
    for (int row = bid * 8 + wid; row < M; row += G * 8) {
        const int b = row / T; float* xrow = a.out + (size_t)row * D;
        f32x4 v[4], acc[4];
#pragma unroll
        for (int q = 0; q < 4; ++q) { v[q] = *(const f32x4*)(xrow + (q >> 1) * 512 + 8 * lane + (q & 1) * 4); acc[q] = (f32x4){0.f, 0.f, 0.f, 0.f}; }
        const int myslot = (lane < 16) ? (int)pos[(size_t)row * 16 + lane] : -1;
        unsigned long long mask = __ballot(myslot >= 0);
        while (mask) {
            int ee[4], sl[4];
#pragma unroll
            for (int k = 0; k < 4; ++k) { if (mask) { ee[k] = __builtin_ctzll(mask); mask &= mask - 1; sl[k] = __shfl(myslot, ee[k]); } else { ee[k] = -1; sl[k] = 0; } }
            u32x4 w[4][2];
#pragma unroll
            for (int k = 0; k < 4; ++k) if (ee[k] >= 0) { const bf16_t* yr = ys + ((size_t)ee[k] * 4096 + b * 512 + sl[k]) * D + 8 * lane; w[k][0] = *(const u32x4*)yr; w[k][1] = *(const u32x4*)(yr + 512); }
#pragma unroll
            for (int k = 0; k < 4; ++k) if (ee[k] >= 0) {
#pragma unroll
                for (int hf = 0; hf < 2; ++hf) { const u32x4 ww = w[k][hf];
                    acc[2 * hf].x += bf_lo(ww.x); acc[2 * hf].y += bf_hi(ww.x); acc[2 * hf].z += bf_lo(ww.y); acc[2 * hf].w += bf_hi(ww.y);
                    acc[2 * hf + 1].x += bf_lo(ww.z); acc[2 * hf + 1].y += bf_hi(ww.z); acc[2 * hf + 1].z += bf_lo(ww.w); acc[2 * hf + 1].w += bf_hi(ww.w); } }
        }
        float ss = 0.f;
#pragma unroll
        for (int q = 0; q < 4; ++q) { const f32x4 g2 = *(const f32x4*)(modf + (size_t)b * NMOD + 5 * D + (q >> 1) * 512 + 8 * lane + (q & 1) * 4); v[q] = v[q] + g2 * acc[q];
            ss += (v[q].x * v[q].x + v[q].y * v[q].y) + (v[q].z * v[q].z + v[q].w * v[q].w); }
        const float rstd = rsqrtf(wave_sum(ss) * (1.f / D) + EPS);
#pragma unroll
        for (int q = 0; q < 4; ++q) *(f32x4*)(xrow + (q >> 1) * 512 + 8 * lane + (q & 1) * 4) = v[q] * rstd * nf[q];
    }
}

__global__ void __launch_bounds__(512, 2) mega_fwd(Args a) {
    extern __shared__ __attribute__((aligned(16))) uchar lds_raw[];
    LAS uchar* lds = (LAS uchar*)lds_raw;
    const int tid = threadIdx.x, lane = tid & 63, wid = __builtin_amdgcn_readfirstlane(tid >> 6), bid = blockIdx.x, G = gridDim.x;
    const int lo = a.ph_lo, hi = a.ph_hi;
    uchar* ws = a.ws;
#define IN(k) (lo <= (k) && (k) < hi)
#define SEAM(k) do { if (IN(k) && IN((k) + 1)) xcd_barrier(xbar); } while (0)
    if (tid < 2) ((volatile LAS unsigned*)(lds + (LDS_BYTES - 16)))[tid] = 0u;
    __syncthreads();
    XcdBarrier xbar = xcd_barrier_post((unsigned*)(ws + WS_BAR), (volatile LAS unsigned*)(lds + (LDS_BYTES - 16)));
    if (IN(0)) phase_prep(a, lds, bid, G, tid, wid, lane);
    SEAM(0);
    if (IN(1)) phase_norm(a, lds, bid, G, tid, wid, lane);
    SEAM(1);
    if (IN(2)) {
        {
            pg8::Gemm g{(const bf16_t*)(ws + WS_ACT), (const bf16_t*)(ws + WS_WIN), D, 0, nullptr};
            pg8::GroupOrder S; S.init(M / 256, NIN / 256, 1, G, bid);
            pg8::EpiInproj E{ws + WS_ZQ, nullptr, (_Float16*)(ws + WS_LF), (_Float16*)(ws + WS_LBW), (const float*)(ws + WS_LB), 0, T};
            pg8::gemm_phase<pg8::EpiInproj, false>(lds, g, S, E);
        }
    }
    SEAM(2);
    if (IN(3)) {
        unsigned* cnt = (unsigned*)(ws + WS_BAR + 14336);
        if (bid >= 192 && bid < 240) {
            pg8::Gemm g{(const bf16_t*)(ws + WS_HC), (const bf16_t*)(ws + WS_WIN) + (size_t)512 * D, D, 0, nullptr};
            pg8::GroupOrder S; S.init(MC / 256, 1536 / 256, 1, 48, bid - 192);
            pg8::EpiInproj E{nullptr, (bf16_t*)(ws + WS_CI), (_Float16*)(ws + WS_CLF), (_Float16*)(ws + WS_CLB), (const float*)(ws + WS_LB), 1, CT};
            pg8::gemm_phase<pg8::EpiInproj, false>(lds, g, S, E);
            pg8::Unit u; S.next(0, u);
            asm volatile("s_waitcnt vmcnt(0)" ::: "memory"); __syncthreads();
            if (tid == 0) { __builtin_amdgcn_fence(__ATOMIC_RELEASE, "agent"); asm volatile("s_waitcnt vmcnt(0)" ::: "memory");
                __hip_atomic_fetch_add(cnt + 64 * u.pm, 1u, __ATOMIC_RELAXED, __HIP_MEMORY_SCOPE_AGENT); }
        }
        if (bid >= 192) {
            const int b = (bid - 192) >> 3;
            if (tid == 0) { unsigned sp = 0; while (__hip_atomic_load(cnt + 64 * b, __ATOMIC_RELAXED, __HIP_MEMORY_SCOPE_AGENT) < 6u && ++sp < (1u << 22)) __builtin_amdgcn_s_sleep(2);
                __builtin_amdgcn_fence(__ATOMIC_ACQUIRE, "agent"); asm volatile("s_waitcnt vmcnt(0)" ::: "memory"); }
            __syncthreads();
        }
        phase_gla_states(a, lds, bid, wid, lane);
    }
    SEAM(3);
    if (IN(4)) phase_gla_out(a, lds, bid, wid, lane);
    SEAM(4);
    if (IN(5)) phase_mixfin(a, bid, G, wid, lane);
    SEAM(5);
    if (IN(6)) {
        pg8::Gemm g{(const bf16_t*)(ws + WS_ACT), (const bf16_t*)(ws + WS_WOUT), D, 0, nullptr};
        pg8::GroupOrder S; S.init(M / 256, D / 256, 1, G, bid);
        pg8::EpiOut E{a.x, a.out, (const float*)(ws + WS_MODF)};
        pg8::gemm_phase<pg8::EpiOut, false>(lds, g, S, E);
    }
    SEAM(6);
    if (IN(7)) phase_router(a, lds, bid, tid, wid, lane);
    SEAM(7);
    if (IN(8)) phase_topk_cvt(a, lds, bid, G, tid, wid, lane);
    SEAM(8);
    if (IN(9)) {
        pg8::Gemm g{(const bf16_t*)(ws + WS_ACT), (const bf16_t*)(ws + WS_WGU), D, (size_t)4096 * D * 2, (const int*)(ws + WS_SELTOK)};
        pg8::GroupOrder S; S.init(16, 16, NE, G, bid);
        pg8::EpiMoe1 E{(bf16_t*)(ws + WS_HID)};
        pg8::gemm_phase<pg8::EpiMoe1, true>(lds, g, S, E);
    }
    SEAM(9);
    if (IN(10)) {
        pg8::Gemm g{(const bf16_t*)(ws + WS_HID), (const bf16_t*)(ws + WS_WDN), DFF, (size_t)D * DFF * 2, nullptr};
        pg8::Moe2Order S{bid};
        LAS float* lg = (LAS float*)(lds + pg8::STAGE_BYTES);
        { pg8::Unit tu; for (int uu = 0; uu < 4 && S.next(uu, tu); ++uu) if (tid < 256) lg[uu * 256 + tid] = ((const float*)(ws + WS_SELGATE))[tu.pm * 256 + tid]; }
        __syncthreads();
        pg8::EpiMoe2 E{(bf16_t*)(ws + WS_YS), lg};
        pg8::gemm_phase<pg8::EpiMoe2, false, pg8::Moe2Order>(lds, g, S, E);
    }
    SEAM(10);
    if (IN(11)) phase_final(a, bid, G, wid, lane);

#undef IN
#undef SEAM
}

#ifndef N_LAUNCHES
#define N_LAUNCHES 1
#endif
extern "C" void kernel_launch(void* const* d_in, const int* in_sizes, int n_in, void* d_out, int out_size, void* d_ws, size_t ws_size, hipStream_t stream) {
    static int grid = 0;
    if (grid == 0) {
        if (n_in != 18 || out_size != M * D || ws_size < WS_END) { fprintf(stderr, "kernel_launch: unexpected shapes (n_in %d out %d ws %zu)\n", n_in, out_size, ws_size); grid = -1; return; }
        int dev = 0, cus = 0, per_cu = 0;
        (void)hipGetDevice(&dev); (void)hipDeviceGetAttribute(&cus, hipDeviceAttributeMultiprocessorCount, dev);
        (void)hipFuncSetAttribute((const void*)mega_fwd, hipFuncAttributeMaxDynamicSharedMemorySize, LDS_BYTES);
        (void)hipOccupancyMaxActiveBlocksPerMultiprocessor(&per_cu, (const void*)mega_fwd, 512, LDS_BYTES);
        if (per_cu < 1) { fprintf(stderr, "kernel_launch: occupancy query says %d blocks per CU\n", per_cu); grid = -1; return; }
        grid = 256;
        if (cus != 256) fprintf(stderr, "kernel_launch: note: %d CUs (built for 256)\n", cus);
    }
    if (grid < 0) return;
    Args a{};
    a.x = (const float*)d_in[0]; a.c = (const float*)d_in[1]; a.ctx = (const float*)d_in[2]; a.c_ctx = (const float*)d_in[3]; a.w_ada = (const float*)d_in[4]; a.b_ada = (const float*)d_in[5];
    a.norm_mix = (const float*)d_in[6]; a.norm_ffn = (const float*)d_in[7]; a.w_in = (const float*)d_in[8]; a.lb_logits = (const float*)d_in[9]; a.hg_norm = (const float*)d_in[10];
    a.conv_w = (const float*)d_in[11]; a.w_out = (const float*)d_in[12]; a.w_router = (const float*)d_in[13]; a.w_gate = (const float*)d_in[14]; a.w_up = (const float*)d_in[15];
    a.w_down = (const float*)d_in[16]; a.norm_final = (const float*)d_in[17]; a.out = (float*)d_out; a.ws = (uchar*)d_ws;
    if (N_LAUNCHES == 1) {
        (void)hipMemsetAsync((char*)d_ws + WS_BAR, 0, 16384, stream);
        a.ph_lo = 0; a.ph_hi = NPHASE;
        hipLaunchKernelGGL(mega_fwd, dim3(grid), dim3(512), LDS_BYTES, stream, a);
    } else {
        for (int p = 0; p < NPHASE; ++p) { a.ph_lo = p; a.ph_hi = p + 1; void* args[] = {&a};
            hipError_t e = hipLaunchCooperativeKernel((const void*)mega_fwd, dim3(grid), dim3(512), args, LDS_BYTES, stream);
            if (e != hipSuccess) { fprintf(stderr, "launch %d failed: %s\n", p, hipGetErrorString(e)); break; } }
    }
}
```

```cpp
#include <hip/hip_runtime.h>
#include <cstdio>

#define LAS __attribute__((address_space(3)))
#define GAS __attribute__((address_space(1)))
typedef unsigned short bf16_t;
typedef short bf16x8 __attribute__((ext_vector_type(8)));
typedef float f32x4 __attribute__((ext_vector_type(4)));
typedef float f32x2 __attribute__((ext_vector_type(2)));
typedef unsigned u32x4 __attribute__((ext_vector_type(4)));
typedef unsigned u32x2 __attribute__((ext_vector_type(2)));
typedef unsigned char uchar;

constexpr int D = 1024, NB = 8, T = 4096, M = NB * T, CT = 256, MC = NB * CT;
constexpr int NIN = 4096, HK = 512, NH = 4, NE = 16, CAP = 512, DFF = 2048, NMOD = 6 * D;
constexpr float EPS = 1e-6f;
constexpr int NPHASE = 12;

constexpr size_t MiB = 1u << 20;
constexpr size_t WS_ACT = 0;
constexpr size_t WS_WIN = 64 * MiB;
constexpr size_t WS_WOUT = 72 * MiB;
constexpr size_t WS_MODP = 74 * MiB;
constexpr size_t WS_MODF = 76 * MiB;
constexpr size_t WS_LB = 76 * MiB + 512 * 1024;
constexpr size_t WS_HC = 77 * MiB;
constexpr size_t WS_CLF = 81 * MiB;
constexpr size_t WS_CLB = 85 * MiB;
constexpr size_t WS_CI = 89 * MiB;
constexpr size_t WS_S0 = 91 * MiB;
constexpr size_t WS_AFF = 95 * MiB;
constexpr size_t WS_SELTOK = 97 * MiB;
constexpr size_t WS_SELGATE = 97 * MiB + 256 * 1024;
constexpr size_t WS_POS = 98 * MiB;
constexpr size_t WS_BAR = 100 * MiB;
constexpr size_t WS_SL = 488 * MiB;
constexpr size_t WS_DL = 500 * MiB;
constexpr size_t WS_ZQ = 104 * MiB;
constexpr size_t WS_LF = 136 * MiB;
constexpr size_t WS_LBW = 200 * MiB;
constexpr size_t WS_ZI = 264 * MiB;
constexpr size_t WS_ZG = 296 * MiB;
constexpr size_t WS_ZGB = 328 * MiB;
constexpr size_t WS_ZGC = 360 * MiB;
constexpr size_t WS_ZV = 392 * MiB;
constexpr size_t WS_OF = 424 * MiB;
constexpr size_t WS_OB = 456 * MiB;
constexpr size_t WS_WGU = 104 * MiB;
constexpr size_t WS_WDN = 232 * MiB;
constexpr size_t WS_HID = 296 * MiB;
constexpr size_t WS_YS = WS_WGU;
constexpr size_t WS_END = 552 * MiB;
static_assert(WS_ZI == WS_ZQ + 160 * MiB && WS_ZG == WS_ZI + 32 * MiB && WS_ZGB == WS_ZG + 32 * MiB && WS_ZGC == WS_ZGB + 32 * MiB && WS_ZV == WS_ZGC + 32 * MiB, "z segment map");

constexpr int LDS_BYTES = 147456;

typedef __bf16 bf16x2_t __attribute__((ext_vector_type(2)));
__device__ __forceinline__ unsigned cvt_pk_bf16_safe(float lo, float hi) { typedef float f2_t __attribute__((ext_vector_type(2))); const bf16x2_t v = __builtin_convertvector((f2_t){lo, hi}, bf16x2_t); return __builtin_bit_cast(unsigned, v); }
__device__ __forceinline__ unsigned cvt_pk_bf16(float lo, float hi) { unsigned r; asm volatile("v_cvt_pk_bf16_f32 %0, %1, %2" : "=v"(r) : "v"(lo), "v"(hi)); return r; }
__device__ __forceinline__ float bf_lo(unsigned u) { return __uint_as_float(u << 16); }
__device__ __forceinline__ float bf_hi(unsigned u) { return __uint_as_float(u & 0xffff0000u); }
__device__ __forceinline__ float wave_sum(float v) {
#pragma unroll
    for (int o = 1; o < 64; o <<= 1) v += __shfl_xor(v, o);
    return v;
}
__device__ __forceinline__ float silu_f(float x) { return x * __builtin_amdgcn_rcpf(1.f + __builtin_amdgcn_exp2f(x * -1.44269504f)); }
#define LDS_WAIT() asm volatile("s_waitcnt lgkmcnt(0)" ::: "memory")


#define XB_TMO      128
#define XB_XCNT(j)  (256  + 64 * (j))
#define XB_XSUB(j)  (1280 + 64 * (j))
#define XB_XGEN(j)  (2304 + 64 * (j))
#define XB_TOP      3328
#define XB_TOPGEN   3392
#define XCD_BAR_WORDS 3456
#define XB_SPIN_CAP (1u << 20)
__device__ __forceinline__ unsigned xb_ld(unsigned* p)              { return __hip_atomic_load(p, __ATOMIC_RELAXED, __HIP_MEMORY_SCOPE_AGENT); }
__device__ __forceinline__ unsigned xb_add(unsigned* p, unsigned v) { return __hip_atomic_fetch_add(p, v, __ATOMIC_RELAXED, __HIP_MEMORY_SCOPE_AGENT); }
__device__ __forceinline__ unsigned xb_xcc_id() { return (unsigned)__builtin_amdgcn_s_getreg((3 << 11) | 20) & 0xFu; }
#define XB_SPIN(cond, bar) do { unsigned _sp = 0; while (cond) { __builtin_amdgcn_s_sleep(1); \
    if ((++_sp & 255u) == 0u) { if (xb_ld(&(bar)[XB_TMO])) break; if (_sp > XB_SPIN_CAP) { atomicAdd(&(bar)[XB_TMO], 1u); break; } } } } while (0)
struct XcdBarrier { unsigned* bar; unsigned x; volatile LAS unsigned* st; };
__device__ __forceinline__ XcdBarrier xcd_barrier_post(unsigned* bar, volatile LAS unsigned* st) {
    XcdBarrier b; b.bar = bar; b.x = xb_xcc_id(); b.st = st;
    if (threadIdx.x == 0) (void)xb_add(&bar[XB_XCNT(b.x)], 1u);
    return b;
}
__device__ __forceinline__ void xcd_barrier_complete(unsigned* bar, unsigned x, unsigned& nloc, unsigned& nx) {
    const unsigned G = gridDim.x * gridDim.y * gridDim.z;
    unsigned sum, cnt, mine, sp = 0u;
    for (;;) {
        sum = 0u; cnt = 0u; mine = 0u;
#pragma unroll
        for (unsigned j = 0; j < 16; ++j) { const unsigned c = xb_ld(&bar[XB_XCNT(j)]); sum += c; cnt += (c > 0u) ? 1u : 0u; mine = (j == x) ? c : mine; }
        if (sum == G) break;
        __builtin_amdgcn_s_sleep(1);
        if ((++sp & 255u) == 0u) { if (xb_ld(&bar[XB_TMO])) break; if (sp > XB_SPIN_CAP) { atomicAdd(&bar[XB_TMO], 1u); break; } }
    }
    nloc = mine > 0u ? mine : 1u; nx = cnt > 0u ? cnt : 1u;
}
__device__ __forceinline__ void xcd_barrier(const XcdBarrier& b) {
    asm volatile("s_waitcnt vmcnt(0)" ::: "memory");
    __syncthreads();
    if (threadIdx.x == 0) {
        unsigned* bar = b.bar;
        __builtin_amdgcn_s_waitcnt(0);
        unsigned nloc = b.st[0], nx = b.st[1];
        if (nloc == 0u) { xcd_barrier_complete(bar, b.x, nloc, nx); b.st[0] = nloc; b.st[1] = nx; }
        const unsigned old = xb_add(&bar[XB_XSUB(b.x)], 1u);
        const unsigned gen = old / nloc;
        if (old + 1u == (gen + 1u) * nloc) {
            __builtin_amdgcn_fence(__ATOMIC_RELEASE, "agent");
            asm volatile("s_waitcnt vmcnt(0)" ::: "memory");
            const unsigned og = xb_add(&bar[XB_TOP], 1u);
            const unsigned tg = og / nx;
            if (og + 1u == (tg + 1u) * nx) xb_add(&bar[XB_TOPGEN], 1u);
            else XB_SPIN(xb_ld(&bar[XB_TOPGEN]) == tg, bar);
            __builtin_amdgcn_fence(__ATOMIC_ACQUIRE, "agent");
            xb_add(&bar[XB_XGEN(b.x)], 1u);
            asm volatile("s_waitcnt vmcnt(0)" ::: "memory");
        } else {
            XB_SPIN(xb_ld(&bar[XB_XGEN(b.x)]) == gen, bar);
            __builtin_amdgcn_fence(__ATOMIC_ACQUIRE, "agent");
            asm volatile("s_waitcnt vmcnt(0)" ::: "memory");
        }
    }
    __syncthreads();
}

namespace pg8 {
constexpr int BM = 256, BK = 64, HALF = 128, HTB = HALF * BK * 2, STAGE_BYTES = 8 * HTB, NXCD = 8, WGM = 8;
__device__ __forceinline__ int lds_byte(int r, int c) { const int st = (r >> 4) * 2 + (c >> 5), rr = r & 15, cc = c & 31, ob = rr * 64 + cc * 2; return st * 1024 + (ob ^ (((ob >> 9) & 1) << 5)); }
__device__ __forceinline__ void stage_rc(int b, int& R, int& C) { const int st = b / 1024, sb = b % 1024, swz = sb ^ (((sb >> 9) & 1) << 5); R = (st >> 1) * 16 + swz / 64; C = (st & 1) * 32 + (swz % 64) / 2; }
__device__ __forceinline__ int perm32(int rho) { const int n = rho >> 4, i = rho & 15; return 8 * (i >> 2) + 4 * n + (i & 3); }

struct Unit { int pm, pn, e; };
struct GroupOrder {
    int nM, nN, ng, G, c;
    __device__ __forceinline__ void init(int nM_, int nN_, int ng_, int G_, int c_) { nM = nM_; nN = nN_; ng = ng_; G = G_; c = c_; }
    __device__ __forceinline__ bool next(int i, Unit& u) const {
        const int nwg = nM * nN; const long L = (long)i * G + c; if (L >= (long)nwg * ng) return false;
        const int grp = (int)(L / nwg); int wgid = (int)(L % nwg);
        { const int q = nwg / NXCD, r = nwg % NXCD, xcd = wgid % NXCD, off = wgid / NXCD; wgid = (xcd < r ? xcd * (q + 1) : r * (q + 1) + (xcd - r) * q) + off; }
        const int nig = WGM * nN, gid = wgid / nig, fm = gid * WGM, gsz = (nM - fm) < WGM ? (nM - fm) : WGM;
        u.pm = grp * nM + fm + ((wgid % nig) % gsz); u.pn = (wgid % nig) / gsz; u.e = grp; return true;
    }
};
struct Moe2Order {
    int c;
    __device__ __forceinline__ bool next(int i, Unit& u) const { if (i >= 4) return false; const int x = c & 7, j = c >> 3; u.e = 4 * i + (j >> 3); u.pm = u.e * 16 + 2 * x + ((j & 7) >> 2); u.pn = j & 3; return true; }
};
struct Gemm { const bf16_t* A; const bf16_t* Bt; int K; size_t bgs; const int* rowidx; };

template <class Epi, bool GATHER, class Sched = GroupOrder>
__device__ __forceinline__ void gemm_phase(LAS uchar* lds, const Gemm g, const Sched& S, const Epi& E) {
    const int tid = threadIdx.x, wid = __builtin_amdgcn_readfirstlane(tid >> 6), lane = tid & 63, wr = wid >> 2, wc = wid & 3, fr = lane & 15, fq = lane >> 4;
    const int K = g.K, nt = K / BK;
    unsigned voffA[2], voffB[2]; int Rr[2], Cc[2];
#pragma unroll
    for (int i = 0; i < 2; ++i) { int R, C; stage_rc(tid * 16 + i * 8192, R, C); const int Rb = Epi::PERM ? ((R & ~31) + perm32(R & 31)) : R; Rr[i] = R; Cc[i] = C;
        voffA[i] = (unsigned)(R * K + C) * 2u; voffB[i] = (unsigned)(Rb * K + C) * 2u; }
    const size_t kstep = (size_t)(BK * 2);
    const size_t hstep = (size_t)HALF * K * 2;
    const size_t tstep = 2 * hstep;
    const unsigned ldsw = (unsigned)wid * 1024u;
    const int aoff = lds_byte(wr * 64 + fr, fq * 8), boff = lds_byte(wc * 32 + fr, fq * 8);
#define PG8_SA(b, h) (((b) * 2 + (h)) * HTB)
#define PG8_SB(b, h) ((4 + (b) * 2 + (h)) * HTB)
#define PG8_STAGE(bufoff, gbase, voff) do { _Pragma("unroll") for (int _i = 0; _i < 2; ++_i) \
        __builtin_amdgcn_global_load_lds((const unsigned*)((const char*)(gbase) + (voff)[_i]), (LAS unsigned*)(lds + (bufoff) + ldsw + _i * 8192), 16, 0, 0); } while (0)
#define PG8_STAGE_A(bufoff, p, ofs, h) do { if constexpr (GATHER) { PG8_STAGE(bufoff, p, (ofs)[h]); } else { PG8_STAGE(bufoff, (p) + (h) * hstep, voffA); } } while (0)
#define PG8_LDA(dst, b, h) do { _Pragma("unroll") for (int m = 0; m < 4; ++m) _Pragma("unroll") for (int k = 0; k < 2; ++k) dst[m][k] = *(const LAS bf16x8*)(lds + PG8_SA(b, h) + aoff + m * 2048 + k * 1024); } while (0)
#define PG8_LDB(dst, b, h) do { _Pragma("unroll") for (int n = 0; n < 2; ++n) _Pragma("unroll") for (int k = 0; k < 2; ++k) dst[n][k] = *(const LAS bf16x8*)(lds + PG8_SB(b, h) + boff + n * 2048 + k * 1024); } while (0)
#define PG8_MMA(ai, bj, At, Bt) do { __builtin_amdgcn_s_setprio(1); _Pragma("unroll") for (int m = 0; m < 4; ++m) _Pragma("unroll") for (int n = 0; n < 2; ++n) _Pragma("unroll") for (int k = 0; k < 2; ++k) \
        acc[ai][bj][m][n] = __builtin_amdgcn_mfma_f32_16x16x32_bf16(Bt[n][k], At[m][k], acc[ai][bj][m][n], 0, 0, 0); __builtin_amdgcn_s_setprio(0); } while (0)
#define PG8_WAIT_V(n) asm volatile("s_waitcnt vmcnt(" #n ")" ::: "memory")
#define PG8_WAIT_L(n) asm volatile("s_waitcnt lgkmcnt(" #n ")" ::: "memory")
#define PG8_BAR __builtin_amdgcn_s_barrier()
#define PG8_SCHED __builtin_amdgcn_sched_barrier(0)
    Unit cur, nxt; int ui = 0;
    if (!S.next(0, cur)) return;
    f32x4 acc[2][2][4][2];
#pragma unroll
    for (int a = 0; a < 2; ++a)
#pragma unroll
        for (int b = 0; b < 2; ++b)
#pragma unroll
            for (int m = 0; m < 4; ++m)
#pragma unroll
                for (int n = 0; n < 2; ++n) acc[a][b][m][n] = (f32x4){0.f, 0.f, 0.f, 0.f};
    bf16x8 At[4][2], B0[2][2], B1[2][2];
    unsigned cofs[2][2], nofs[2][2];
    LAS unsigned short* ridx = (LAS unsigned short*)(lds + STAGE_BYTES);
    if constexpr (GATHER) {
        { Unit tu; for (int uu = 0; uu < 16 && S.next(uu, tu); ++uu) if (tid < BM) ridx[uu * BM + tid] = (unsigned short)g.rowidx[tu.pm * BM + tid]; }
        asm volatile("s_waitcnt vmcnt(0) lgkmcnt(0)" ::: "memory"); __builtin_amdgcn_s_barrier(); asm volatile("" ::: "memory");
#pragma unroll
        for (int h = 0; h < 2; ++h)
#pragma unroll
            for (int i = 0; i < 2; ++i) { const int row = ridx[h * HALF + Rr[i]]; cofs[h][i] = (unsigned)(row * K + Cc[i]) * 2u; nofs[h][i] = cofs[h][i]; }
    }
    const char* cA = GATHER ? (const char*)g.A : (const char*)g.A + (size_t)cur.pm * tstep;
    const char* cB = (const char*)g.Bt + (size_t)cur.e * g.bgs + (size_t)cur.pn * tstep;
    PG8_STAGE(PG8_SB(0, 0), cB, voffB); PG8_STAGE(PG8_SB(0, 1), cB + hstep, voffB); PG8_STAGE_A(PG8_SA(0, 0), cA, cofs, 0); PG8_STAGE_A(PG8_SA(0, 1), cA, cofs, 1);
    if (wr == 1) PG8_BAR;
    PG8_WAIT_V(2); PG8_BAR;
    PG8_STAGE(PG8_SB(1, 0), cB + kstep, voffB); PG8_STAGE_A(PG8_SA(1, 0), cA + kstep, cofs, 0); PG8_STAGE(PG8_SB(1, 1), cB + hstep + kstep, voffB);
    PG8_WAIT_V(6); PG8_BAR;
    for (;;) {
        const bool has_next = S.next(ui + 1, nxt);
        const char* nA = GATHER ? (const char*)g.A : (has_next ? (const char*)g.A + (size_t)nxt.pm * tstep : cA);
        const char* nB = has_next ? (const char*)g.Bt + (size_t)nxt.e * g.bgs + (size_t)nxt.pn * tstep : cB;
        for (int t = 0; t < nt; t += 2) {
            const bool last = (t == nt - 2);
            const char* a1 = cA + (size_t)(t + 1) * kstep;
            const char* a2 = last ? nA : cA + (size_t)(t + 2) * kstep; const char* b2 = last ? nB : cB + (size_t)(t + 2) * kstep;
            const char* a3 = a2 + kstep; const char* b3 = b2 + kstep;
            if constexpr (GATHER) {
                if (last && has_next) {
#pragma unroll
                    for (int h = 0; h < 2; ++h)
#pragma unroll
                        for (int i = 0; i < 2; ++i) { const int row = ridx[(ui + 1) * BM + h * HALF + Rr[i]]; nofs[h][i] = (unsigned)(row * K + Cc[i]) * 2u; }
                }
            }
            PG8_LDB(B0, 0, 0); PG8_LDB(B1, 0, 1); PG8_SCHED; PG8_LDA(At, 0, 0); PG8_STAGE_A(PG8_SA(1, 1), a1, cofs, 1);
            PG8_WAIT_V(8); PG8_WAIT_L(0); PG8_BAR; PG8_MMA(0, 0, At, B0); PG8_MMA(0, 1, At, B1); PG8_BAR; PG8_SCHED;
            PG8_LDA(At, 0, 1); PG8_STAGE(PG8_SB(0, 0), b2, voffB); PG8_STAGE(PG8_SB(0, 1), b2 + hstep, voffB);
            if (last) { PG8_STAGE_A(PG8_SA(0, 0), a2, nofs, 0); } else { PG8_STAGE_A(PG8_SA(0, 0), a2, cofs, 0); }
            PG8_WAIT_V(8); PG8_WAIT_L(0); PG8_BAR; PG8_MMA(1, 0, At, B0); PG8_MMA(1, 1, At, B1); PG8_BAR; PG8_SCHED;
            PG8_LDB(B0, 1, 0); PG8_LDB(B1, 1, 1); PG8_SCHED; PG8_LDA(At, 1, 0);
            if (last) { PG8_STAGE_A(PG8_SA(0, 1), a2, nofs, 1); } else { PG8_STAGE_A(PG8_SA(0, 1), a2, cofs, 1); }
            PG8_WAIT_V(8); PG8_WAIT_L(0); PG8_BAR; PG8_MMA(0, 0, At, B0); PG8_MMA(0, 1, At, B1); PG8_BAR; PG8_SCHED;
            PG8_LDA(At, 1, 1); PG8_STAGE(PG8_SB(1, 0), b3, voffB); PG8_STAGE(PG8_SB(1, 1), b3 + hstep, voffB);
            if (last) { PG8_STAGE_A(PG8_SA(1, 0), a3, nofs, 0); } else { PG8_STAGE_A(PG8_SA(1, 0), a3, cofs, 0); }
            PG8_WAIT_V(8); PG8_WAIT_L(0); PG8_BAR; PG8_MMA(1, 0, At, B0); PG8_MMA(1, 1, At, B1); PG8_BAR; PG8_SCHED;
        }
        if (wr == 0) PG8_BAR;
        E(acc, cur, wr, wc, fr, fq);
        if (!has_next) break;
#pragma unroll
        for (int a = 0; a < 2; ++a)
#pragma unroll
            for (int b = 0; b < 2; ++b)
#pragma unroll
                for (int m = 0; m < 4; ++m)
#pragma unroll
                    for (int n = 0; n < 2; ++n) acc[a][b][m][n] = (f32x4){0.f, 0.f, 0.f, 0.f};
        cur = nxt; cA = nA; cB = nB; ++ui;
        if constexpr (GATHER) {
#pragma unroll
            for (int h = 0; h < 2; ++h)
#pragma unroll
                for (int i = 0; i < 2; ++i) cofs[h][i] = nofs[h][i];
        }
        if (wr == 1) PG8_BAR;
    }
    PG8_WAIT_V(0);
    PG8_BAR;
#undef PG8_SA
#undef PG8_SB
#undef PG8_STAGE
#undef PG8_STAGE_A
#undef PG8_LDA
#undef PG8_LDB
#undef PG8_MMA
#undef PG8_WAIT_V
#undef PG8_WAIT_L
#undef PG8_BAR
#undef PG8_SCHED
}


struct EpiInproj {
    static constexpr bool PERM = true;
    uchar* zbase; bf16_t* ci; _Float16* olog0; _Float16* olog1; const float* lb; int seg0; int Tn;
    __device__ __forceinline__ void operator()(const f32x4 (&acc)[2][2][4][2], const Unit& u, int wr, int wc, int fr, int fq) const {
        const int seg = seg0 + (u.pn >> 1);
        const int row0 = u.pm * BM + wr * 64 + fr;
        if (seg <= 3) {
            const int b = (u.pm * BM) / Tn, t0 = row0 - b * Tn, dcol = wc * 32 + 8 * fq;
#pragma unroll
            for (int bj = 0; bj < 2; ++bj) { const int hh = (u.pn & 1) * 2 + bj; const size_t plane = (size_t)(b * NH + hh) * Tn;
                if (seg == 1 || seg == 2) {
                    _Float16* O = (seg == 1) ? olog0 : olog1; const float* lbp = lb + (seg - 1) * 512 + hh * 128 + dcol;
                    const f32x4 l0 = *(const f32x4*)lbp, l1 = *(const f32x4*)(lbp + 4);
#pragma unroll
                    for (int ai = 0; ai < 2; ++ai)
#pragma unroll
                        for (int m = 0; m < 4; ++m) { const f32x4 v0 = acc[ai][bj][m][0], v1 = acc[ai][bj][m][1]; _Float16 o[8];
#pragma unroll
                            for (int j = 0; j < 4; ++j) { const float s0 = __builtin_amdgcn_rcpf(1.f + __builtin_amdgcn_exp2f(v0[j] * -1.44269504f)), s1 = __builtin_amdgcn_rcpf(1.f + __builtin_amdgcn_exp2f(v1[j] * -1.44269504f));
                                o[j] = (_Float16)__builtin_amdgcn_logf(l0[j] + (1.f - l0[j]) * s0); o[4 + j] = (_Float16)__builtin_amdgcn_logf(l1[j] + (1.f - l1[j]) * s1); }
                            __builtin_nontemporal_store(__builtin_bit_cast(u32x4, o), (u32x4*)(O + (plane + t0 + ai * HALF + m * 16) * 128 + dcol)); }
                } else {
                    bf16_t* O = zbase ? (bf16_t*)(zbase + (size_t)(seg == 0 ? 0 : 160) * MiB) : ci;
#pragma unroll
                    for (int ai = 0; ai < 2; ++ai)
#pragma unroll
                        for (int m = 0; m < 4; ++m) { const f32x4 v0 = acc[ai][bj][m][0], v1 = acc[ai][bj][m][1];
                            u32x4 w; w.x = cvt_pk_bf16(v0[0], v0[1]); w.y = cvt_pk_bf16(v0[2], v0[3]); w.z = cvt_pk_bf16(v1[0], v1[1]); w.w = cvt_pk_bf16(v1[2], v1[3]);
                            __builtin_nontemporal_store(w, (u32x4*)(O + (plane + t0 + ai * HALF + m * 16) * 128 + dcol)); }
                }
            }
        } else if (seg >= 6) {
            const int col0 = (u.pn - 12) * 128 + wc * 32 + 8 * fq;
            bf16_t* O = (bf16_t*)(zbase + (size_t)(32 * 6 + 64) * MiB);
#pragma unroll
            for (int ai = 0; ai < 2; ++ai)
#pragma unroll
                for (int m = 0; m < 4; ++m) { const f32x4 v0 = acc[ai][0][m][0] * acc[ai][1][m][0], v1 = acc[ai][0][m][1] * acc[ai][1][m][1];
                    u32x4 w; w.x = cvt_pk_bf16(v0[0], v0[1]); w.y = cvt_pk_bf16(v0[2], v0[3]); w.z = cvt_pk_bf16(v1[0], v1[1]); w.w = cvt_pk_bf16(v1[2], v1[3]);
                    __builtin_nontemporal_store(w, (u32x4*)(O + (size_t)(row0 + ai * HALF + m * 16) * 512 + col0)); }
        } else {
            const int col0 = (u.pn & 1) * 256 + wc * 32 + 8 * fq;
            bf16_t* O = (bf16_t*)(zbase + (size_t)(32 * seg + 64) * MiB);
#pragma unroll
            for (int ai = 0; ai < 2; ++ai)
#pragma unroll
                for (int m = 0; m < 4; ++m) { bf16_t* rowp = O + (size_t)(row0 + ai * HALF + m * 16) * 512 + col0;
#pragma unroll
                    for (int bj = 0; bj < 2; ++bj) { const f32x4 v0 = acc[ai][bj][m][0], v1 = acc[ai][bj][m][1];
                        u32x4 w; w.x = cvt_pk_bf16(v0[0], v0[1]); w.y = cvt_pk_bf16(v0[2], v0[3]); w.z = cvt_pk_bf16(v1[0], v1[1]); w.w = cvt_pk_bf16(v1[2], v1[3]);
                        __builtin_nontemporal_store(w, (u32x4*)(rowp + bj * HALF)); } }
        }
    }
};
struct EpiOut {
    static constexpr bool PERM = false;
    const float* x; float* x1; const float* modf;
    __device__ __forceinline__ void operator()(const f32x4 (&acc)[2][2][4][2], const Unit& u, int wr, int wc, int fr, int fq) const {
        const int row0 = u.pm * BM + wr * 64 + fr, col0 = u.pn * BM + wc * 32 + 4 * fq;
        const int b = (u.pm * BM) / T;
        const float* g1 = modf + (size_t)b * NMOD + 2 * D;
        f32x4 gv[2][2];
#pragma unroll
        for (int bj = 0; bj < 2; ++bj)
#pragma unroll
            for (int n = 0; n < 2; ++n) gv[bj][n] = *(const f32x4*)(g1 + col0 + bj * HALF + n * 16);
#pragma unroll
        for (int ai = 0; ai < 2; ++ai)
#pragma unroll
            for (int m = 0; m < 4; ++m) { const size_t off = (size_t)(row0 + ai * HALF + m * 16) * D + col0;
#pragma unroll
                for (int bj = 0; bj < 2; ++bj)
#pragma unroll
                    for (int n = 0; n < 2; ++n) { const f32x4 xs = __builtin_nontemporal_load((const f32x4*)(x + off + bj * HALF + n * 16)); __builtin_nontemporal_store(xs + gv[bj][n] * acc[ai][bj][m][n], (f32x4*)(x1 + off + bj * HALF + n * 16)); }
                asm volatile("" ::: "memory"); }
    }
};
struct EpiMoe1 {
    static constexpr bool PERM = true;
    bf16_t* hid;
    __device__ __forceinline__ void operator()(const f32x4 (&acc)[2][2][4][2], const Unit& u, int wr, int wc, int fr, int fq) const {
        const int row0 = u.pm * BM + wr * 64 + fr, col0 = u.pn * 128 + wc * 32 + 8 * fq;
#pragma unroll
        for (int ai = 0; ai < 2; ++ai)
#pragma unroll
            for (int m = 0; m < 4; ++m) { bf16_t* rowp = hid + (size_t)(row0 + ai * HALF + m * 16) * DFF + col0;
                float o[8];
#pragma unroll
                for (int n = 0; n < 2; ++n)
#pragma unroll
                    for (int j = 0; j < 4; ++j) { const float gt = acc[ai][0][m][n][j], up = acc[ai][1][m][n][j]; o[n * 4 + j] = gt * up * __builtin_amdgcn_rcpf(1.f + __builtin_amdgcn_exp2f(gt * -1.44269504f)); }
                u32x4 w; w.x = cvt_pk_bf16(o[0], o[1]); w.y = cvt_pk_bf16(o[2], o[3]); w.z = cvt_pk_bf16(o[4], o[5]); w.w = cvt_pk_bf16(o[6], o[7]);
                __builtin_nontemporal_store(w, (u32x4*)rowp); }
    }
};
struct EpiMoe2 {
    static constexpr bool PERM = true;
    bf16_t* ys; const LAS float* lgate;
    __device__ __forceinline__ void operator()(const f32x4 (&acc)[2][2][4][2], const Unit& u, int wr, int wc, int fr, int fq) const {
        const int row0 = u.pm * BM + wr * 64 + fr, col0 = u.pn * BM + wc * 32 + 8 * fq;
        const LAS float* gt_ = lgate + (u.e >> 2) * BM + wr * 64 + fr;
#pragma unroll
        for (int ai = 0; ai < 2; ++ai)
#pragma unroll
            for (int m = 0; m < 4; ++m) { const int row = row0 + ai * HALF + m * 16; const float gt = gt_[ai * HALF + m * 16]; bf16_t* rowp = ys + (size_t)row * D + col0;
#pragma unroll
                for (int bj = 0; bj < 2; ++bj) { const f32x4 v0 = acc[ai][bj][m][0] * gt, v1 = acc[ai][bj][m][1] * gt;
                    u32x4 w; w.x = cvt_pk_bf16(v0[0], v0[1]); w.y = cvt_pk_bf16(v0[2], v0[3]); w.z = cvt_pk_bf16(v1[0], v1[1]); w.w = cvt_pk_bf16(v1[2], v1[3]);
                    __builtin_nontemporal_store(w, (u32x4*)(rowp + bj * HALF)); } }
    }
};
}

struct Args {
    const float *x, *c, *ctx, *c_ctx, *w_ada, *b_ada, *norm_mix, *norm_ffn, *w_in, *lb_logits, *hg_norm, *conv_w, *w_out, *w_router, *w_gate, *w_up, *w_down, *norm_final;
    float* out; uchar* ws; int ph_lo, ph_hi;
};

__device__ __forceinline__ void cvt_item(const float* W, int ldw, bf16_t* WT, int ldt, int k0, int n0, int nrow0, LAS float* scr, int lane) {
    const int r = lane >> 3, c4 = lane & 7;
    f32x4 v[8];
#pragma unroll
    for (int i = 0; i < 8; ++i) v[i] = __builtin_nontemporal_load((const f32x4*)(W + (size_t)(k0 + 8 * i + r) * ldw + n0 + 4 * c4));
#pragma unroll
    for (int i = 0; i < 8; ++i) { LAS float* d = scr + (8 * i + r) * 33 + 4 * c4; d[0] = v[i].x; d[1] = v[i].y; d[2] = v[i].z; d[3] = v[i].w; }
    LDS_WAIT(); asm volatile("" ::: "memory");
    const int c = lane & 7;
#pragma unroll
    for (int j = 0; j < 4; ++j) { const int n = (lane >> 3) + 8 * j; const LAS float* sp = scr + (8 * c) * 33 + n;
        u32x4 o; o.x = cvt_pk_bf16(sp[0 * 33], sp[1 * 33]); o.y = cvt_pk_bf16(sp[2 * 33], sp[3 * 33]); o.z = cvt_pk_bf16(sp[4 * 33], sp[5 * 33]); o.w = cvt_pk_bf16(sp[6 * 33], sp[7 * 33]);
        *(u32x4*)(WT + (size_t)(nrow0 + n) * ldt + k0 + 8 * c) = o; }
    LDS_WAIT(); asm volatile("" ::: "memory");
}

__device__ __forceinline__ void phase_prep(const Args& a, LAS uchar* lds, int bid, int G, int tid, int wid, int lane) {
    float* modp = (float*)(a.ws + WS_MODP);
    if (bid < 192) {
        const int cgp = bid % 24, ks = bid / 24, n0 = cgp * 256 + lane * 4, k0 = ks * 128 + wid * 16;
        LAS float* sc = (LAS float*)(lds + 81920);
        for (int i = tid; i < 9 * 128; i += 512) { const int r = i >> 7, kk = i & 127; sc[i] = silu_f((r < 8) ? a.c[r * D + ks * 128 + kk] : a.c_ctx[ks * 128 + kk]); }
        f32x4 w[16];
#pragma unroll
        for (int kk = 0; kk < 16; ++kk) w[kk] = __builtin_nontemporal_load((const f32x4*)(a.w_ada + (size_t)(k0 + kk) * NMOD + n0));
        __syncthreads();
        f32x4 acc[9];
#pragma unroll
        for (int r = 0; r < 9; ++r) acc[r] = (f32x4){0.f, 0.f, 0.f, 0.f};
#pragma unroll
        for (int kk = 0; kk < 16; ++kk) {
#pragma unroll
            for (int r = 0; r < 9; ++r) acc[r] += w[kk] * sc[r * 128 + wid * 16 + kk]; }
        LAS f32x4* red = (LAS f32x4*)lds;
#pragma unroll
        for (int r = 0; r < 9; ++r) red[(wid * 9 + r) * 64 + lane] = acc[r];
        __syncthreads();
        for (int o = tid; o < 9 * 64; o += 512) { const int r = o / 64, l = o % 64; f32x4 sm = red[(0 * 9 + r) * 64 + l];
#pragma unroll
            for (int w8 = 1; w8 < 8; ++w8) sm += red[(w8 * 9 + r) * 64 + l];
            if (ks == 0) sm += *(const f32x4*)(a.b_ada + cgp * 256 + l * 4);
            *(f32x4*)(modp + ((size_t)ks * 9 + r) * NMOD + cgp * 256 + l * 4) = sm; }
        __syncthreads();
    }
    if (bid == 255) {
        float* lb = (float*)(a.ws + WS_LB);
        for (int i = tid; i < 1024; i += 512) { const float l0 = a.lb_logits[i], l1 = a.lb_logits[1024 + i]; lb[i] = 1.f / (1.f + __expf(l1 - l0)); }
    }
    LAS float* scr = (LAS float*)lds + wid * (64 * 33);
    const int gw = (G - 1 - bid) * 8 + wid, NGW = G * 8;
    constexpr int I_IN = (D / 64) * (NIN / 32), I_OUT = (D / 64) * (D / 32);
    for (int it = gw; it < I_IN + I_OUT; it += NGW) {
        if (it < I_IN) { const int nblk = NIN / 32, kb = it / nblk, nb = it % nblk; const int n0 = nb * 32;
            const int nrow = (n0 < 3072) ? n0 : 3072 + (((n0 - 3072) & 511) >> 7) * 256 + ((n0 - 3072) & 127) + ((n0 >= 3584) ? 128 : 0);
            cvt_item(a.w_in, NIN, (bf16_t*)(a.ws + WS_WIN), D, kb * 64, n0, nrow, scr, lane); }
        else { const int r = it - I_IN, nblk = D / 32, kb = r / nblk, nb = r % nblk; cvt_item(a.w_out, D, (bf16_t*)(a.ws + WS_WOUT), D, kb * 64, nb * 32, nb * 32, scr, lane); }
    }
}

__device__ __forceinline__ float modp_sum(const float* modp, int r, int col) { float s = 0.f;
#pragma unroll
    for (int ks = 0; ks < 8; ++ks) s += modp[((size_t)ks * 9 + r) * NMOD + col];
    return s; }
template <int NR>
__device__ __forceinline__ void norm_rows(const float* xrow0, bf16_t* orow0, const LAS float* gm, const LAS float* sh, int lane) {
    f32x4 v[NR][4]; float ss[NR];
#pragma unroll
    for (int i = 0; i < NR; ++i) { ss[i] = 0.f;
#pragma unroll
        for (int j = 0; j < 4; ++j) v[i][j] = __builtin_nontemporal_load((const f32x4*)(xrow0 + (size_t)i * D) + lane + 64 * j); }
#pragma unroll
    for (int i = 0; i < NR; ++i) {
#pragma unroll
        for (int j = 0; j < 4; ++j) ss[i] += (v[i][j].x * v[i][j].x + v[i][j].y * v[i][j].y) + (v[i][j].z * v[i][j].z + v[i][j].w * v[i][j].w);
        ss[i] = rsqrtf(wave_sum(ss[i]) * (1.f / D) + EPS); }
#pragma unroll
    for (int j = 0; j < 4; ++j) { const f32x4 g4 = *((const LAS f32x4*)gm + lane + 64 * j), s4 = *((const LAS f32x4*)sh + lane + 64 * j);
#pragma unroll
        for (int i = 0; i < NR; ++i) { const f32x4 o = v[i][j] * ss[i] * g4 + s4;
            u32x2 w; w.x = cvt_pk_bf16(o.x, o.y); w.y = cvt_pk_bf16(o.z, o.w); *((u32x2*)(orow0 + (size_t)i * D) + lane + 64 * j) = w; } }
}
__device__ __forceinline__ void phase_norm(const Args& a, LAS uchar* lds, int bid, int G, int tid, int wid, int lane) {
    const float* modp = (const float*)(a.ws + WS_MODP); float* modf = (float*)(a.ws + WS_MODF);
    { const int gt = bid * 512 + tid; if (gt < 9 * NMOD) modf[gt] = modp_sum(modp, gt / NMOD, gt % NMOD); }
    LAS float* gm = (LAS float*)lds; LAS float* sh = gm + D; LAS float* cgm = sh + D; LAS float* csh = cgm + D;
    const int b = bid / 32;
    for (int cidx = tid; cidx < D; cidx += 512) { const float nm = a.norm_mix[cidx];
        sh[cidx] = modp_sum(modp, b, cidx); gm[cidx] = nm * (1.f + modp_sum(modp, b, D + cidx));
        csh[cidx] = modp_sum(modp, 8, cidx); cgm[cidx] = nm * (1.f + modp_sum(modp, 8, D + cidx)); }
    __syncthreads();
    bf16_t* hx = (bf16_t*)(a.ws + WS_ACT); bf16_t* hc = (bf16_t*)(a.ws + WS_HC);
    { const int row = bid * 8 + wid; norm_rows<1>(a.ctx + (size_t)row * D, hc + (size_t)row * D, cgm, csh, lane); }
    for (int j = 0; j < 16; j += 4) { const int row = bid * 128 + wid * 16 + j; norm_rows<4>(a.x + (size_t)row * D, hx + (size_t)row * D, gm, sh, lane); }
    __syncthreads();
}

constexpr int GL_QDP = 0, GL_KIP = 8704, GL_KETP = 17408, GL_VTP = 27648, GL_DEC = 37888, GL_TOT = 38400, GL_RING = 43008, GL_SLOT = 24576;
#define GLA_BAR() do { asm volatile("s_waitcnt lgkmcnt(0)" ::: "memory"); __builtin_amdgcn_s_barrier(); asm volatile("" ::: "memory"); } while (0)
template <bool FULL>
__device__ __forceinline__ void gla_item(LAS uchar* lds, const bf16_t* qb, const _Float16* lfb, const bf16_t* vb, bf16_t* ob, f32x4 (&S)[8], float* dl_out,
                                         int row_base, int Tn, int tau0, int nch, int h, int dir, int wid, int lane) {
    const int fr = lane & 15, fq = lane >> 4;
#define GLA_ISSUE(c) do { LAS uchar* _sl = lds + GL_RING + ((c) & 3) * GL_SLOT + wid * 3072; \
        const int _tau = tau0 + 32 * (c) + 4 * wid + (lane >> 4); const size_t _o = (size_t)(dir ? (Tn - 1 - _tau) : _tau) * 128 + (lane & 15) * 8; \
        __builtin_amdgcn_global_load_lds((const unsigned*)(lfb + _o), (LAS unsigned*)(_sl), 16, 0, 2); \
        if (FULL) __builtin_amdgcn_global_load_lds((const unsigned*)(qb + _o), (LAS unsigned*)(_sl + 1024), 16, 0, 2); \
        __builtin_amdgcn_global_load_lds((const unsigned*)(vb + _o), (LAS unsigned*)(_sl + 2048), 16, 0, 2); } while (0)
    GLA_ISSUE(0);
    if (nch > 1) GLA_ISSUE(1);
    if (nch > 2) GLA_ISSUE(2);
    const int d0 = 2 * lane, pos0 = (d0 & ~31) + 8 * ((d0 >> 2) & 3) + 4 * ((d0 >> 4) & 1) + (d0 & 3);
    const int spos = 8 * (wid & 3) + 4 * (wid >> 2);
    f32x2 dsum = (f32x2){0.f, 0.f};
    for (int n = 0; n < nch; ++n) {
        if (n + 2 < nch) { if (FULL) asm volatile("s_waitcnt vmcnt(6)" ::: "memory"); else asm volatile("s_waitcnt vmcnt(4)" ::: "memory"); }
        else if (n + 1 < nch) { if (FULL) asm volatile("s_waitcnt vmcnt(3)" ::: "memory"); else asm volatile("s_waitcnt vmcnt(2)" ::: "memory"); }
        else asm volatile("s_waitcnt vmcnt(0)" ::: "memory");
        const LAS uchar* sl = lds + GL_RING + (n & 3) * GL_SLOT + wid * 3072;
        f32x2 lf[4];
#pragma unroll
        for (int rr = 0; rr < 4; ++rr) { typedef _Float16 h2_t __attribute__((ext_vector_type(2))); const h2_t hv = *(const LAS h2_t*)(sl + rr * 256 + lane * 4); lf[rr] = (f32x2){(float)hv.x, (float)hv.y}; }
        f32x2 c[4]; c[0] = lf[0]; c[1] = c[0] + lf[1]; c[2] = c[1] + lf[2]; c[3] = c[2] + lf[3];
        LAS f32x2* tot = (LAS f32x2*)(lds + GL_TOT);
        tot[wid * 64 + lane] = c[3];
        unsigned qv[4], vv[4];
#pragma unroll
        for (int rr = 0; rr < 4; ++rr) { vv[rr] = *(const LAS unsigned*)(sl + 2048 + rr * 256 + lane * 4); qv[rr] = FULL ? *(const LAS unsigned*)(sl + 1024 + rr * 256 + lane * 4) : 0u; }
        GLA_BAR();
        if (n + 3 < nch) GLA_ISSUE(n + 3);
        f32x2 pre = (f32x2){0.f, 0.f}, all = (f32x2){0.f, 0.f};
#pragma unroll
        for (int w = 0; w < 8; ++w) { const f32x2 tw = tot[w * 64 + lane]; all += tw; if (w < wid) pre += tw; }
        dsum += all;
        const f32x2 decall = (f32x2){__builtin_amdgcn_exp2f(all.x), __builtin_amdgcn_exp2f(all.y)};
        f32x2 kE[4];
#pragma unroll
        for (int rr = 0; rr < 4; ++rr) {
            const f32x2 cum = pre + c[rr];
            const f32x2 k = 1.f - (f32x2){__builtin_amdgcn_exp2f(lf[rr].x), __builtin_amdgcn_exp2f(lf[rr].y)};
            const f32x2 ki = k * (f32x2){__builtin_amdgcn_exp2f(-cum.x), __builtin_amdgcn_exp2f(-cum.y)};
            kE[rr] = ki * decall;
            if (FULL) { const int s = 4 * wid + rr; const f32x2 qd = (f32x2){bf_lo(qv[rr]), bf_hi(qv[rr])} * (f32x2){__builtin_amdgcn_exp2f(cum.x), __builtin_amdgcn_exp2f(cum.y)};
                *(LAS unsigned*)(lds + GL_QDP + s * 272 + pos0 * 2) = cvt_pk_bf16(qd.x, qd.y);
                *(LAS unsigned*)(lds + GL_KIP + s * 272 + pos0 * 2) = cvt_pk_bf16(ki.x, ki.y); }
        }
        { u32x2 w0, w1; w0.x = cvt_pk_bf16(kE[0].x, kE[1].x); w0.y = cvt_pk_bf16(kE[2].x, kE[3].x); w1.x = cvt_pk_bf16(kE[0].y, kE[1].y); w1.y = cvt_pk_bf16(kE[2].y, kE[3].y);
          *(LAS u32x2*)(lds + GL_KETP + (d0) * 80 + spos * 2) = w0; *(LAS u32x2*)(lds + GL_KETP + (d0 + 1) * 80 + spos * 2) = w1;
          u32x2 v0, v1; v0.x = (vv[0] & 0xffffu) | (vv[1] << 16); v0.y = (vv[2] & 0xffffu) | (vv[3] << 16);
          v1.x = (vv[0] >> 16) | (vv[1] & 0xffff0000u); v1.y = (vv[2] >> 16) | (vv[3] & 0xffff0000u);
          *(LAS u32x2*)(lds + GL_VTP + (d0) * 80 + spos * 2) = v0; *(LAS u32x2*)(lds + GL_VTP + (d0 + 1) * 80 + spos * 2) = v1; }
        if (wid == 0) *(LAS f32x2*)(lds + GL_DEC + lane * 8) = decall;
        GLA_BAR();
        const bf16x8 vt = *(const LAS bf16x8*)(lds + GL_VTP + (16 * wid + fr) * 80 + fq * 16);
        if (FULL) {
            bf16x8 qf[2][4];
#pragma unroll
            for (int ti = 0; ti < 2; ++ti)
#pragma unroll
                for (int kk = 0; kk < 4; ++kk) qf[ti][kk] = *(const LAS bf16x8*)(lds + GL_QDP + (16 * ti + fr) * 272 + kk * 64 + fq * 16);
            f32x4 oT[2] = {(f32x4){0.f, 0.f, 0.f, 0.f}, (f32x4){0.f, 0.f, 0.f, 0.f}};
            f32x4 p00 = (f32x4){0.f, 0.f, 0.f, 0.f}, p01 = p00, p11 = p00;
#pragma unroll
            for (int kk = 0; kk < 4; ++kk) {
                const bf16x8 kj0 = *(const LAS bf16x8*)(lds + GL_KIP + (fr) * 272 + kk * 64 + fq * 16);
                const bf16x8 kj1 = *(const LAS bf16x8*)(lds + GL_KIP + (16 + fr) * 272 + kk * 64 + fq * 16);
                p00 = __builtin_amdgcn_mfma_f32_16x16x32_bf16(kj0, qf[0][kk], p00, 0, 0, 0);
                p01 = __builtin_amdgcn_mfma_f32_16x16x32_bf16(kj0, qf[1][kk], p01, 0, 0, 0);
                p11 = __builtin_amdgcn_mfma_f32_16x16x32_bf16(kj1, qf[1][kk], p11, 0, 0, 0);
                u32x4 sa; sa.x = cvt_pk_bf16_safe(S[2 * kk][0], S[2 * kk][1]); sa.y = cvt_pk_bf16_safe(S[2 * kk][2], S[2 * kk][3]);
                sa.z = cvt_pk_bf16_safe(S[2 * kk + 1][0], S[2 * kk + 1][1]); sa.w = cvt_pk_bf16_safe(S[2 * kk + 1][2], S[2 * kk + 1][3]);
                const bf16x8 sA = __builtin_bit_cast(bf16x8, sa);
                oT[0] = __builtin_amdgcn_mfma_f32_16x16x32_bf16(sA, qf[0][kk], oT[0], 0, 0, 0);
                oT[1] = __builtin_amdgcn_mfma_f32_16x16x32_bf16(sA, qf[1][kk], oT[1], 0, 0, 0);
            }
            u32x4 pb0, pb1;
            { float m0[4], m1[4];
#pragma unroll
              for (int r = 0; r < 4; ++r) { const bool ok = (4 * fq + r) <= fr; m0[r] = ok ? p00[r] : 0.f; m1[r] = ok ? p11[r] : 0.f; }
              pb0.x = cvt_pk_bf16_safe(m0[0], m0[1]); pb0.y = cvt_pk_bf16_safe(m0[2], m0[3]); pb0.z = 0u; pb0.w = 0u;
              pb1.x = cvt_pk_bf16_safe(p01[0], p01[1]); pb1.y = cvt_pk_bf16_safe(p01[2], p01[3]); pb1.z = cvt_pk_bf16_safe(m1[0], m1[1]); pb1.w = cvt_pk_bf16_safe(m1[2], m1[3]); }
            oT[0] = __builtin_amdgcn_mfma_f32_16x16x32_bf16(vt, __builtin_bit_cast(bf16x8, pb0), oT[0], 0, 0, 0);
            oT[1] = __builtin_amdgcn_mfma_f32_16x16x32_bf16(vt, __builtin_bit_cast(bf16x8, pb1), oT[1], 0, 0, 0);
#pragma unroll
            for (int ti = 0; ti < 2; ++ti) { const int tau = tau0 + 32 * n + 16 * ti + fr; const size_t row = (size_t)(row_base + (dir ? (Tn - 1 - tau) : tau));
                u32x2 w; w.x = cvt_pk_bf16_safe(oT[ti][0], oT[ti][1]); w.y = cvt_pk_bf16_safe(oT[ti][2], oT[ti][3]);
                *(u32x2*)(ob + row * 512 + h * 128 + 16 * wid + 4 * fq) = w; }
        }
#pragma unroll
        for (int t8 = 0; t8 < 8; ++t8) {
            const f32x4 dc = *(const LAS f32x4*)(lds + GL_DEC + (16 * t8 + 4 * fq) * 4);
            const bf16x8 ka = *(const LAS bf16x8*)(lds + GL_KETP + (16 * t8 + fr) * 80 + fq * 16);
            S[t8] = __builtin_amdgcn_mfma_f32_16x16x32_bf16(ka, vt, S[t8] * dc, 0, 0, 0);
        }
    }
#undef GLA_ISSUE
    if (dl_out && wid == 0) *(f32x2*)(dl_out + 2 * lane) = dsum;
    asm volatile("s_waitcnt vmcnt(0)" ::: "memory");
    GLA_BAR();
}
__device__ __forceinline__ void gla_state_store(float* p, const f32x4 (&S)[8], int wid, int fr, int fq) {
#pragma unroll
    for (int t8 = 0; t8 < 8; ++t8)
#pragma unroll
        for (int r = 0; r < 4; ++r) p[(size_t)(16 * t8 + 4 * fq + r) * 128 + 16 * wid + fr] = S[t8][r];
}
__device__ __forceinline__ void phase_gla_states(const Args& a, LAS uchar* lds, int bid, int wid, int lane) {
    uchar* ws = a.ws; const int fr = lane & 15, fq = lane >> 4;
    f32x4 S[8];
#pragma unroll
    for (int t8 = 0; t8 < 8; ++t8) S[t8] = (f32x4){0.f, 0.f, 0.f, 0.f};
    if (bid < 192) { const int bhd = bid / 3, seg = bid % 3, b = bhd >> 3, h = (bhd >> 1) & 3, dir = bhd & 1;
        const size_t pl = (size_t)(b * NH + h) * T * 128;
        gla_item<false>(lds, nullptr, (const _Float16*)(ws + (dir ? WS_LBW : WS_LF)) + pl, (const bf16_t*)(ws + WS_ZI) + pl, nullptr, S, (float*)(ws + WS_DL) + (size_t)bid * 128,
                        b * T, T, seg * 1024, 32, h, dir, wid, lane);
        gla_state_store((float*)(ws + WS_SL) + (size_t)bid * 16384, S, wid, fr, fq);
    } else { const int bhd = bid - 192, b = bhd >> 3, h = (bhd >> 1) & 3, dir = bhd & 1;
        const size_t pl = (size_t)(b * NH + h) * CT * 128;
        gla_item<false>(lds, nullptr, (const _Float16*)(ws + (dir ? WS_CLB : WS_CLF)) + pl, (const bf16_t*)(ws + WS_CI) + pl, nullptr, S, nullptr, b * CT, CT, 0, CT / 32, h, dir, wid, lane);
        gla_state_store((float*)(ws + WS_S0) + (size_t)bhd * 16384, S, wid, fr, fq);
    }
}
__device__ __forceinline__ void phase_gla_out(const Args& a, LAS uchar* lds, int bid, int wid, int lane) {
    uchar* ws = a.ws; const int fr = lane & 15, fq = lane >> 4;
    const int bhd = bid >> 2, seg = bid & 3, b = bhd >> 3, h = (bhd >> 1) & 3, dir = bhd & 1;
    f32x4 S[8];
    { const float* p = (const float*)(ws + WS_S0) + (size_t)bhd * 16384;
#pragma unroll
      for (int t8 = 0; t8 < 8; ++t8)
#pragma unroll
          for (int r = 0; r < 4; ++r) S[t8][r] = p[(size_t)(16 * t8 + 4 * fq + r) * 128 + 16 * wid + fr]; }
    for (int j = 0; j < seg; ++j) { const float* p = (const float*)(ws + WS_SL) + (size_t)(bhd * 3 + j) * 16384; const float* dl = (const float*)(ws + WS_DL) + (size_t)(bhd * 3 + j) * 128;
#pragma unroll
        for (int t8 = 0; t8 < 8; ++t8) { const f32x4 dv = *(const f32x4*)(dl + 16 * t8 + 4 * fq);
#pragma unroll
            for (int r = 0; r < 4; ++r) S[t8][r] = __builtin_amdgcn_exp2f(dv[r]) * S[t8][r] + p[(size_t)(16 * t8 + 4 * fq + r) * 128 + 16 * wid + fr]; } }
    asm volatile("s_waitcnt vmcnt(0)" ::: "memory");
    const size_t pl = (size_t)(b * NH + h) * T * 128;
    gla_item<true>(lds, (const bf16_t*)(ws + WS_ZQ) + pl, (const _Float16*)(ws + (dir ? WS_LBW : WS_LF)) + pl, (const bf16_t*)(ws + WS_ZI) + pl, (bf16_t*)(ws + (dir ? WS_OB : WS_OF)), S, nullptr,
                   b * T, T, seg * 1024, 32, h, dir, wid, lane);
}

__device__ __forceinline__ void unpack8(const u32x4 w, float (&f)[8]) { f[0] = bf_lo(w.x); f[1] = bf_hi(w.x); f[2] = bf_lo(w.y); f[3] = bf_hi(w.y); f[4] = bf_lo(w.z); f[5] = bf_hi(w.z); f[6] = bf_lo(w.w); f[7] = bf_hi(w.w); }
__device__ __forceinline__ void phase_mixfin(const Args& a, int bid, int G, int wid, int lane) {
    const bf16_t* of = (const bf16_t*)(a.ws + WS_OF); const bf16_t* obw = (const bf16_t*)(a.ws + WS_OB); const bf16_t* zg = (const bf16_t*)(a.ws + WS_ZG);
    const bf16_t* zgb = (const bf16_t*)(a.ws + WS_ZGB); const bf16_t* zgc = (const bf16_t*)(a.ws + WS_ZGC);
    bf16_t* A2 = (bf16_t*)(a.ws + WS_ACT);
    const int c0 = 8 * lane;
    float gain[8], cw0[8], cw1[8], cw2[8];
#pragma unroll
    for (int j = 0; j < 8; ++j) { gain[j] = a.hg_norm[(c0 + j) & 127]; cw0[j] = a.conv_w[c0 + j]; cw1[j] = a.conv_w[512 + c0 + j]; cw2[j] = a.conv_w[1024 + c0 + j]; }
    for (int row = bid * 8 + wid; row < M; row += G * 8) {
        const size_t ro = (size_t)row * 512 + c0;
        float f0[8], f1[8], gg[8], o[8];
        unpack8(__builtin_nontemporal_load((const u32x4*)(of + ro)), f0); unpack8(__builtin_nontemporal_load((const u32x4*)(obw + ro)), f1); unpack8(__builtin_nontemporal_load((const u32x4*)(zg + ro)), gg);
        float ss = 0.f;
#pragma unroll
        for (int j = 0; j < 8; ++j) { o[j] = f0[j] + f1[j]; ss += o[j] * o[j]; }
        ss += __shfl_xor(ss, 1); ss += __shfl_xor(ss, 2); ss += __shfl_xor(ss, 4); ss += __shfl_xor(ss, 8);
        const float rstd = rsqrtf(ss * (1.f / 128.f) + EPS);
#pragma unroll
        for (int j = 0; j < 8; ++j) o[j] = o[j] * rstd * gain[j] * silu_f(gg[j]);
        u32x4 w; w.x = cvt_pk_bf16(o[0], o[1]); w.y = cvt_pk_bf16(o[2], o[3]); w.z = cvt_pk_bf16(o[4], o[5]); w.w = cvt_pk_bf16(o[6], o[7]);
        *(u32x4*)(A2 + (size_t)row * D + c0) = w;
        const int tw = row & 63;
        float um[8], u0[8], up[8], gb[8], y[8];
        unpack8(*(const u32x4*)(zgc + ro), u0); unpack8(__builtin_nontemporal_load((const u32x4*)(zgb + ro)), gb);
        if (tw > 0) unpack8(*(const u32x4*)(zgc + ro - 512), um);
        else {
#pragma unroll
            for (int j = 0; j < 8; ++j) um[j] = 0.f; }
        if (tw < 63) unpack8(*(const u32x4*)(zgc + ro + 512), up);
        else {
#pragma unroll
            for (int j = 0; j < 8; ++j) up[j] = 0.f; }
#pragma unroll
        for (int j = 0; j < 8; ++j) y[j] = gb[j] * (cw0[j] * um[j] + cw1[j] * u0[j] + cw2[j] * up[j]);
        w.x = cvt_pk_bf16(y[0], y[1]); w.y = cvt_pk_bf16(y[2], y[3]); w.z = cvt_pk_bf16(y[4], y[5]); w.w = cvt_pk_bf16(y[6], y[7]);
        *(u32x4*)(A2 + (size_t)row * D + 512 + c0) = w;
    }
}

__device__ __forceinline__ void phase_router(const Args& a, LAS uchar* lds, int bid, int tid, int wid, int lane) {
    const float* modf = (const float*)(a.ws + WS_MODF);
    LAS float* gm = (LAS float*)lds; LAS float* sh = gm + D;
    LAS uchar* wrl = lds + 8192;
    const int b = bid / 32;
    for (int cidx = tid; cidx < D; cidx += 512) { sh[cidx] = modf[(size_t)b * NMOD + 3 * D + cidx]; gm[cidx] = a.norm_ffn[cidx] * (1.f + modf[(size_t)b * NMOD + 4 * D + cidx]); }
    for (int i = tid; i < D * 4; i += 512) { const int col = i >> 2, q4 = i & 3; *(LAS f32x4*)(wrl + col * 64 + (col >> 2) * 16 + q4 * 16) = *(const f32x4*)(a.w_router + col * 16 + q4 * 4); }
    __syncthreads();
    bf16_t* hx2 = (bf16_t*)(a.ws + WS_ACT); float* aff = (float*)(a.ws + WS_AFF);
    for (int jb = 0; jb < 4; ++jb) {
        const int row0 = bid * 128 + wid * 16 + jb * 4;
        f32x4 v[4][4]; float rstd[4];
#pragma unroll
        for (int i = 0; i < 4; ++i) { const float* xrow = a.out + (size_t)(row0 + i) * D; float ss = 0.f;
#pragma unroll
            for (int jj = 0; jj < 4; ++jj) { v[i][jj] = __builtin_nontemporal_load((const f32x4*)xrow + lane + 64 * jj); ss += (v[i][jj].x * v[i][jj].x + v[i][jj].y * v[i][jj].y) + (v[i][jj].z * v[i][jj].z + v[i][jj].w * v[i][jj].w); }
            rstd[i] = ss; }
#pragma unroll
        for (int i = 0; i < 4; ++i) rstd[i] = rsqrtf(wave_sum(rstd[i]) * (1.f / D) + EPS);
        float pl[64];
#pragma unroll
        for (int e = 0; e < 64; ++e) pl[e] = 0.f;
#pragma unroll
        for (int jj = 0; jj < 4; ++jj) { const f32x4 g4 = *((const LAS f32x4*)gm + lane + 64 * jj), s4 = *((const LAS f32x4*)sh + lane + 64 * jj);
#pragma unroll
            for (int i = 0; i < 4; ++i) { v[i][jj] = v[i][jj] * rstd[i] * g4 + s4;
                u32x2 w; w.x = cvt_pk_bf16(v[i][jj].x, v[i][jj].y); w.y = cvt_pk_bf16(v[i][jj].z, v[i][jj].w); *((u32x2*)(hx2 + (size_t)(row0 + i) * D) + lane + 64 * jj) = w; }
            const int colb = 4 * lane + 256 * jj;
#pragma unroll
            for (int cc = 0; cc < 4; ++cc) { const int col = colb + cc; const LAS uchar* wp = wrl + col * 64 + (col >> 2) * 16;
#pragma unroll
                for (int q4 = 0; q4 < 4; ++q4) { const f32x4 w4 = *(const LAS f32x4*)(wp + q4 * 16);
#pragma unroll
                    for (int i = 0; i < 4; ++i) { const float hvv = v[i][jj][cc]; pl[i * 16 + q4 * 4 + 0] += hvv * w4.x; pl[i * 16 + q4 * 4 + 1] += hvv * w4.y; pl[i * 16 + q4 * 4 + 2] += hvv * w4.z; pl[i * 16 + q4 * 4 + 3] += hvv * w4.w; } } } }
#pragma unroll
        for (int k = 0; k < 32; ++k) { const bool hi = (lane & 32) != 0; const float keep = hi ? pl[32 + k] : pl[k], send = hi ? pl[k] : pl[32 + k]; pl[k] = keep + __shfl_xor(send, 32); }
#pragma unroll
        for (int k = 0; k < 16; ++k) { const bool hi = (lane & 16) != 0; const float keep = hi ? pl[16 + k] : pl[k], send = hi ? pl[k] : pl[16 + k]; pl[k] = keep + __shfl_xor(send, 16); }
#pragma unroll
        for (int k = 0; k < 8; ++k) { const bool hi = (lane & 8) != 0; const float keep = hi ? pl[8 + k] : pl[k], send = hi ? pl[k] : pl[8 + k]; pl[k] = keep + __shfl_xor(send, 8); }
#pragma unroll
        for (int k = 0; k < 4; ++k) { const bool hi = (lane & 4) != 0; const float keep = hi ? pl[4 + k] : pl[k], send = hi ? pl[k] : pl[4 + k]; pl[k] = keep + __shfl_xor(send, 4); }
#pragma unroll
        for (int k = 0; k < 2; ++k) { const bool hi = (lane & 2) != 0; const float keep = hi ? pl[2 + k] : pl[k], send = hi ? pl[k] : pl[2 + k]; pl[k] = keep + __shfl_xor(send, 2); }
        { const bool hi = (lane & 1) != 0; const float keep = hi ? pl[1] : pl[0], send = hi ? pl[0] : pl[1]; pl[0] = keep + __shfl_xor(send, 1); }
        const float lg = pl[0];
        float mx = lg;
#pragma unroll
        for (int o = 1; o < 16; o <<= 1) mx = fmaxf(mx, __shfl_xor(mx, o));
        const float ex = __expf(lg - mx); float den = ex;
#pragma unroll
        for (int o = 1; o < 16; o <<= 1) den += __shfl_xor(den, o);
        const int t = (row0 + (lane >> 4)) & (T - 1);
        aff[((size_t)b * NE + (lane & 15)) * T + t] = ex / den;
    }
    __syncthreads();
}

__device__ __forceinline__ void topk_item(const Args& a, LAS uchar* lds, int b, int e, int tid, int wid, int lane) {
    LAS unsigned* key = (LAS unsigned*)lds;
    LAS unsigned* hist = key + 4096;
    LAS unsigned* ctl = hist + 256;
    LAS unsigned* wsum = ctl + 8;
    const float* affp = (const float*)(a.ws + WS_AFF) + ((size_t)b * NE + e) * T;
    unsigned kv[8];
    { const u32x4 k0 = *(const u32x4*)(affp + tid * 8), k1 = *(const u32x4*)(affp + tid * 8 + 4); kv[0] = k0.x; kv[1] = k0.y; kv[2] = k0.z; kv[3] = k0.w; kv[4] = k1.x; kv[5] = k1.y; kv[6] = k1.z; kv[7] = k1.w; }
    unsigned prefix = 0u, mask = 0u, need = CAP;
    for (int shift = 24; shift >= 0; shift -= 8) {
        if (tid < 256) hist[tid] = 0u;
        __syncthreads();
#pragma unroll
        for (int j = 0; j < 8; ++j) if ((kv[j] & mask) == prefix) __hip_atomic_fetch_add(&hist[(kv[j] >> shift) & 255u], 1u, __ATOMIC_RELAXED, __HIP_MEMORY_SCOPE_WORKGROUP);
        __syncthreads();
        if (tid < 256) { unsigned above = 0u; for (int bb = tid + 1; bb < 256; ++bb) above += hist[bb]; const unsigned mine = hist[tid];
            if (above < need && need <= above + mine) { ctl[0] = (unsigned)tid; ctl[1] = need - above; } }
        __syncthreads();
        prefix |= ctl[0] << shift; mask |= 255u << shift; need = ctl[1];
        __syncthreads();
    }
    unsigned cg_ = 0u, ce_ = 0u;
#pragma unroll
    for (int j = 0; j < 8; ++j) { cg_ += kv[j] > prefix; ce_ += kv[j] == prefix; }
    unsigned pk = cg_ | (ce_ << 16), incl = pk;
#pragma unroll
    for (int o = 1; o < 64; o <<= 1) { const unsigned t2 = __shfl_up(incl, o); if (lane >= o) incl += t2; }
    if (lane == 63) wsum[wid] = incl;
    __syncthreads();
    unsigned base = 0u;
    for (int w = 0; w < wid; ++w) base += wsum[w];
    unsigned excl = base + incl - pk; unsigned ng = excl & 0xffffu, neq = excl >> 16;
    int* seltok = (int*)(a.ws + WS_SELTOK); float* selgate = (float*)(a.ws + WS_SELGATE); short* pos = (short*)(a.ws + WS_POS);
#pragma unroll
    for (int j = 0; j < 8; ++j) { const int t = tid * 8 + j; const bool gt = kv[j] > prefix, eq = kv[j] == prefix; const bool sel = gt || (eq && neq < need);
        int slot = -1;
        if (sel) slot = (int)(ng + (neq < need ? neq : need));
        if (sel) { seltok[e * 4096 + b * 512 + slot] = b * T + t; selgate[e * 4096 + b * 512 + slot] = __uint_as_float(kv[j]); }
        pos[((size_t)b * T + t) * 16 + e] = (short)slot;
        ng += gt; neq += eq; }
    __syncthreads();
}
__device__ __forceinline__ void phase_topk_cvt(const Args& a, LAS uchar* lds, int bid, int G, int tid, int wid, int lane) {
    if (bid < 128) topk_item(a, lds, bid / 16, bid % 16, tid, wid, lane);
    LAS float* scr = (LAS float*)(lds + 32768) + wid * (64 * 33);
    bf16_t* wgu = (bf16_t*)(a.ws + WS_WGU); bf16_t* wdn = (bf16_t*)(a.ws + WS_WDN);
    constexpr int I_G = (D / 64) * (DFF / 32);
    constexpr int I_D = (DFF / 64) * (D / 32);
    constexpr int PER_E = 2 * I_G + I_D, TOTAL = NE * PER_E;
    static_assert(TOTAL == 1024 * 22 + 1024 * 26, "item split");
    const bool tk = bid < 128; const int wi = (tk ? bid : bid - 128) * 8 + wid;
    const int cnt = tk ? 22 : 26, base = tk ? 1024 * 26 : 0;
    for (int k = 0; k < cnt; ++k) { const int it = base + k * 1024 + wi;
        const int e = it / PER_E; int r = it % PER_E;
        if (r < 2 * I_G) { const int up = r >= I_G; if (up) r -= I_G; const int nblk = DFF / 32, kb = r / nblk, nb = r % nblk, n0 = nb * 32;
            const float* W = (up ? a.w_up : a.w_gate) + (size_t)e * D * DFF;
            cvt_item(W, DFF, wgu + (size_t)e * 4096 * D, D, kb * 64, n0, (n0 >> 7) * 256 + (n0 & 127) + (up ? 128 : 0), scr, lane); }
        else { r -= 2 * I_G; const int nblk = D / 32, kb = r / nblk, nb = r % nblk;
            cvt_item(a.w_down + (size_t)e * DFF * D, D, wdn + (size_t)e * D * DFF, DFF, kb * 64, nb * 32, nb * 32, scr, lane); }
    }
    __syncthreads();
}

__device__ __forceinline__ void phase_final(const Args& a, int bid, int G, int wid, int lane) {
    const float* modf = (const float*)(a.ws + WS_MODF); const short* pos = (const short*)(a.ws + WS_POS); const bf16_t* ys = (const bf16_t*)(a.ws + WS_YS);
    f32x4 nf[4];
#pragma unroll
    for (int q = 0; q < 4; ++q) nf[q] = *(const f32x4*)(a.norm_final + (q >> 1) * 512 + 8 * lane + (q & 1) * 4);
    for (int row = bid * 8 + wid; row < M; row += G * 8) {
        const int b = row / T; float* xrow = a.out + (size_t)row * D;
        f32x4 v[4], acc[4];
#pragma unroll
        for (int q = 0; q < 4; ++q) { v[q] = __builtin_nontemporal_load((const f32x4*)(xrow + (q >> 1) * 512 + 8 * lane + (q & 1) * 4)); acc[q] = (f32x4){0.f, 0.f, 0.f, 0.f}; }
        const int myslot = (lane < 16) ? (int)pos[(size_t)row * 16 + lane] : -1;
        unsigned long long mask = __ballot(myslot >= 0);
        while (mask) {
            int ee[4], sl[4];
#pragma unroll
            for (int k = 0; k < 4; ++k) { if (mask) { ee[k] = __builtin_ctzll(mask); mask &= mask - 1; sl[k] = __shfl(myslot, ee[k]); } else { ee[k] = -1; sl[k] = 0; } }
            u32x4 w[4][2];
#pragma unroll
            for (int k = 0; k < 4; ++k) if (ee[k] >= 0) { const bf16_t* yr = ys + ((size_t)ee[k] * 4096 + b * 512 + sl[k]) * D + 8 * lane; w[k][0] = __builtin_nontemporal_load((const u32x4*)yr); w[k][1] = __builtin_nontemporal_load((const u32x4*)(yr + 512)); }
#pragma unroll
            for (int k = 0; k < 4; ++k) if (ee[k] >= 0) {
#pragma unroll
                for (int hf = 0; hf < 2; ++hf) { const u32x4 ww = w[k][hf];
                    acc[2 * hf].x += bf_lo(ww.x); acc[2 * hf].y += bf_hi(ww.x); acc[2 * hf].z += bf_lo(ww.y); acc[2 * hf].w += bf_hi(ww.y);
                    acc[2 * hf + 1].x += bf_lo(ww.z); acc[2 * hf + 1].y += bf_hi(ww.z); acc[2 * hf + 1].z += bf_lo(ww.w); acc[2 * hf + 1].w += bf_hi(ww.w); } }
        }
        float ss = 0.f;
#pragma unroll
        for (int q = 0; q < 4; ++q) { const f32x4 g2 = *(const f32x4*)(modf + (size_t)b * NMOD + 5 * D + (q >> 1) * 512 + 8 * lane + (q & 1) * 4); v[q] = v[q] + g2 * acc[q];
            ss += (v[q].x * v[q].x + v[q].y * v[q].y) + (v[q].z * v[q].z + v[q].w * v[q].w); }
        const float rstd = rsqrtf(wave_sum(ss) * (1.f / D) + EPS);
#pragma unroll
        for (int q = 0; q < 4; ++q) __builtin_nontemporal_store(v[q] * rstd * nf[q], (f32x4*)(xrow + (q >> 1) * 512 + 8 * lane + (q & 1) * 4));
    }
}

__global__ void __launch_bounds__(512, 2) mega_fwd(Args a) {
    extern __shared__ __attribute__((aligned(16))) uchar lds_raw[];
    LAS uchar* lds = (LAS uchar*)lds_raw;
    const int tid = threadIdx.x, lane = tid & 63, wid = __builtin_amdgcn_readfirstlane(tid >> 6), bid = blockIdx.x, G = gridDim.x;
    const int lo = a.ph_lo, hi = a.ph_hi;
    uchar* ws = a.ws;
#define IN(k) (lo <= (k) && (k) < hi)
#define SEAM(k) do { if (IN(k) && IN((k) + 1)) xcd_barrier(xbar); } while (0)
    if (tid < 2) ((volatile LAS unsigned*)(lds + (LDS_BYTES - 16)))[tid] = 0u;
    __syncthreads();
    XcdBarrier xbar = xcd_barrier_post((unsigned*)(ws + WS_BAR), (volatile LAS unsigned*)(lds + (LDS_BYTES - 16)));
    if (IN(0)) phase_prep(a, lds, bid, G, tid, wid, lane);
    SEAM(0);
    if (IN(1)) phase_norm(a, lds, bid, G, tid, wid, lane);
    SEAM(1);
    if (IN(2)) {
        {
            pg8::Gemm g{(const bf16_t*)(ws + WS_ACT), (const bf16_t*)(ws + WS_WIN), D, 0, nullptr};
            pg8::GroupOrder S; S.init(M / 256, NIN / 256, 1, G, bid);
            pg8::EpiInproj E{ws + WS_ZQ, nullptr, (_Float16*)(ws + WS_LF), (_Float16*)(ws + WS_LBW), (const float*)(ws + WS_LB), 0, T};
            pg8::gemm_phase<pg8::EpiInproj, false>(lds, g, S, E);
        }
    }
    SEAM(2);
    if (IN(3)) {
        unsigned* cnt = (unsigned*)(ws + WS_BAR + 14336);
        if (bid >= 192 && bid < 240) {
            pg8::Gemm g{(const bf16_t*)(ws + WS_HC), (const bf16_t*)(ws + WS_WIN) + (size_t)512 * D, D, 0, nullptr};
            pg8::GroupOrder S; S.init(MC / 256, 1536 / 256, 1, 48, bid - 192);
            pg8::EpiInproj E{nullptr, (bf16_t*)(ws + WS_CI), (_Float16*)(ws + WS_CLF), (_Float16*)(ws + WS_CLB), (const float*)(ws + WS_LB), 1, CT};
            pg8::gemm_phase<pg8::EpiInproj, false>(lds, g, S, E);
            pg8::Unit u; S.next(0, u);
            asm volatile("s_waitcnt vmcnt(0)" ::: "memory"); __syncthreads();
            if (tid == 0) { __builtin_amdgcn_fence(__ATOMIC_RELEASE, "agent"); asm volatile("s_waitcnt vmcnt(0)" ::: "memory");
                __hip_atomic_fetch_add(cnt + 64 * u.pm, 1u, __ATOMIC_RELAXED, __HIP_MEMORY_SCOPE_AGENT); }
        }
        if (bid >= 192) {
            const int b = (bid - 192) >> 3;
            if (tid == 0) { unsigned sp = 0; while (__hip_atomic_load(cnt + 64 * b, __ATOMIC_RELAXED, __HIP_MEMORY_SCOPE_AGENT) < 6u && ++sp < (1u << 22)) __builtin_amdgcn_s_sleep(2);
                __builtin_amdgcn_fence(__ATOMIC_ACQUIRE, "agent"); asm volatile("s_waitcnt vmcnt(0)" ::: "memory"); }
            __syncthreads();
        }
        phase_gla_states(a, lds, bid, wid, lane);
    }
    SEAM(3);
    if (IN(4)) phase_gla_out(a, lds, bid, wid, lane);
    SEAM(4);
    if (IN(5)) phase_mixfin(a, bid, G, wid, lane);
    SEAM(5);
    if (IN(6)) {
        pg8::Gemm g{(const bf16_t*)(ws + WS_ACT), (const bf16_t*)(ws + WS_WOUT), D, 0, nullptr};
        pg8::GroupOrder S; S.init(M / 256, D / 256, 1, G, bid);
        pg8::EpiOut E{a.x, a.out, (const float*)(ws + WS_MODF)};
        pg8::gemm_phase<pg8::EpiOut, false>(lds, g, S, E);
    }
    SEAM(6);
    if (IN(7)) phase_router(a, lds, bid, tid, wid, lane);
    SEAM(7);
    if (IN(8)) phase_topk_cvt(a, lds, bid, G, tid, wid, lane);
    SEAM(8);
    if (IN(9)) {
        pg8::Gemm g{(const bf16_t*)(ws + WS_ACT), (const bf16_t*)(ws + WS_WGU), D, (size_t)4096 * D * 2, (const int*)(ws + WS_SELTOK)};
        pg8::GroupOrder S; S.init(16, 16, NE, G, bid);
        pg8::EpiMoe1 E{(bf16_t*)(ws + WS_HID)};
        pg8::gemm_phase<pg8::EpiMoe1, true>(lds, g, S, E);
    }
    SEAM(9);
    if (IN(10)) {
        pg8::Gemm g{(const bf16_t*)(ws + WS_HID), (const bf16_t*)(ws + WS_WDN), DFF, (size_t)D * DFF * 2, nullptr};
        pg8::Moe2Order S{bid};
        LAS float* lg = (LAS float*)(lds + pg8::STAGE_BYTES);
        { pg8::Unit tu; for (int uu = 0; uu < 4 && S.next(uu, tu); ++uu) if (tid < 256) lg[uu * 256 + tid] = ((const float*)(ws + WS_SELGATE))[tu.pm * 256 + tid]; }
        __syncthreads();
        pg8::EpiMoe2 E{(bf16_t*)(ws + WS_YS), lg};
        pg8::gemm_phase<pg8::EpiMoe2, false, pg8::Moe2Order>(lds, g, S, E);
    }
    SEAM(10);
    if (IN(11)) phase_final(a, bid, G, wid, lane);

#undef IN
#undef SEAM
}

#ifndef N_LAUNCHES
#define N_LAUNCHES 1
#endif
extern "C" void kernel_launch(void* const* d_in, const int* in_sizes, int n_in, void* d_out, int out_size, void* d_ws, size_t ws_size, hipStream_t stream) {
    static int grid = 0;
    if (grid == 0) {
        if (n_in != 18 || out_size != M * D || ws_size < WS_END) { fprintf(stderr, "kernel_launch: unexpected shapes (n_in %d out %d ws %zu)\n", n_in, out_size, ws_size); grid = -1; return; }
        int dev = 0, cus = 0, per_cu = 0;
        (void)hipGetDevice(&dev); (void)hipDeviceGetAttribute(&cus, hipDeviceAttributeMultiprocessorCount, dev);
        (void)hipFuncSetAttribute((const void*)mega_fwd, hipFuncAttributeMaxDynamicSharedMemorySize, LDS_BYTES);
        (void)hipOccupancyMaxActiveBlocksPerMultiprocessor(&per_cu, (const void*)mega_fwd, 512, LDS_BYTES);
        if (per_cu < 1) { fprintf(stderr, "kernel_launch: occupancy query says %d blocks per CU\n", per_cu); grid = -1; return; }
        grid = 256;
        if (cus != 256) fprintf(stderr, "kernel_launch: note: %d CUs (built for 256)\n", cus);
    }
    if (grid < 0) return;
    Args a{};
    a.x = (const float*)d_in[0]; a.c = (const float*)d_in[1]; a.ctx = (const float*)d_in[2]; a.c_ctx = (const float*)d_in[3]; a.w_ada = (const float*)d_in[4]; a.b_ada = (const float*)d_in[5];
    a.norm_mix = (const float*)d_in[6]; a.norm_ffn = (const float*)d_in[7]; a.w_in = (const float*)d_in[8]; a.lb_logits = (const float*)d_in[9]; a.hg_norm = (const float*)d_in[10];
    a.conv_w = (const float*)d_in[11]; a.w_out = (const float*)d_in[12]; a.w_router = (const float*)d_in[13]; a.w_gate = (const float*)d_in[14]; a.w_up = (const float*)d_in[15];
    a.w_down = (const float*)d_in[16]; a.norm_final = (const float*)d_in[17]; a.out = (float*)d_out; a.ws = (uchar*)d_ws;
    if (N_LAUNCHES == 1) {
        (void)hipMemsetAsync((char*)d_ws + WS_BAR, 0, 16384, stream);
        a.ph_lo = 0; a.ph_hi = NPHASE;
        hipLaunchKernelGGL(mega_fwd, dim3(grid), dim3(512), LDS_BYTES, stream, a);
    } else {
        for (int p = 0; p < NPHASE; ++p) { a.ph_lo = p; a.ph_hi = p + 1; void* args[] = {&a};
            hipError_t e = hipLaunchCooperativeKernel((const void*)mega_fwd, dim3(grid), dim3(512), args, LDS_BYTES, stream);
            if (e != hipSuccess) { fprintf(stderr, "launch %d failed: %s\n", p, hipGetErrorString(e)); break; } }
    }
}
```

```cpp
#include <hip/hip_runtime.h>
#include <cstdio>

#define LAS __attribute__((address_space(3)))
#define GAS __attribute__((address_space(1)))
typedef unsigned short bf16_t;
typedef short bf16x8 __attribute__((ext_vector_type(8)));
typedef float f32x4 __attribute__((ext_vector_type(4)));
typedef float f32x2 __attribute__((ext_vector_type(2)));
typedef unsigned u32x4 __attribute__((ext_vector_type(4)));
typedef unsigned u32x2 __attribute__((ext_vector_type(2)));
typedef unsigned char uchar;
typedef int i32x8 __attribute__((ext_vector_type(8)));
typedef int i32x4 __attribute__((ext_vector_type(4)));

constexpr int D = 1024, NB = 8, T = 4096, M = NB * T, CT = 256, MC = NB * CT;
constexpr int NIN = 4096, HK = 512, NH = 4, NE = 16, CAP = 512, DFF = 2048, NMOD = 6 * D;
constexpr float EPS = 1e-6f;
constexpr int NPHASE = 12;

constexpr size_t MiB = 1u << 20;
constexpr size_t WS_ACT = 0;
constexpr size_t WS_WIN = 64 * MiB;
constexpr size_t WS_WOUT = 72 * MiB;
constexpr size_t WS_MODP = 74 * MiB;
constexpr size_t WS_MODF = 76 * MiB;
constexpr size_t WS_LB = 76 * MiB + 512 * 1024;
constexpr size_t WS_HC = 77 * MiB;
constexpr size_t WS_CLF = 81 * MiB;
constexpr size_t WS_CLB = 85 * MiB;
constexpr size_t WS_CI = 89 * MiB;
constexpr size_t WS_S0 = 91 * MiB;
constexpr size_t WS_AFF = 95 * MiB;
constexpr size_t WS_SELTOK = 97 * MiB;
constexpr size_t WS_SELGATE = 97 * MiB + 256 * 1024;
constexpr size_t WS_POS = 98 * MiB;
constexpr size_t WS_BAR = 100 * MiB;
constexpr size_t WS_SL = 488 * MiB;
constexpr size_t WS_DL = 500 * MiB;
constexpr size_t WS_ZQ = 104 * MiB;
constexpr size_t WS_LF = 136 * MiB;
constexpr size_t WS_LBW = 200 * MiB;
constexpr size_t WS_ZI = 264 * MiB;
constexpr size_t WS_ZG = 296 * MiB;
constexpr size_t WS_ZGB = 328 * MiB;
constexpr size_t WS_ZGC = 360 * MiB;
constexpr size_t WS_ZV = 392 * MiB;
constexpr size_t WS_OF = 424 * MiB;
constexpr size_t WS_OB = 456 * MiB;
constexpr size_t WS_WGU = 104 * MiB;
constexpr size_t WS_WDN = 232 * MiB;
constexpr size_t WS_HID = 296 * MiB;
constexpr size_t WS_YS = WS_WGU;
constexpr size_t WS_END = 552 * MiB;
static_assert(WS_ZI == WS_ZQ + 160 * MiB && WS_ZG == WS_ZI + 32 * MiB && WS_ZGB == WS_ZG + 32 * MiB && WS_ZGC == WS_ZGB + 32 * MiB && WS_ZV == WS_ZGC + 32 * MiB, "z segment map");

constexpr int LDS_BYTES = 147456;

typedef __bf16 bf16x2_t __attribute__((ext_vector_type(2)));
__device__ __forceinline__ unsigned cvt_pk_bf16_safe(float lo, float hi) { typedef float f2_t __attribute__((ext_vector_type(2))); const bf16x2_t v = __builtin_convertvector((f2_t){lo, hi}, bf16x2_t); return __builtin_bit_cast(unsigned, v); }
__device__ __forceinline__ unsigned cvt_pk_bf16(float lo, float hi) { unsigned r; asm volatile("v_cvt_pk_bf16_f32 %0, %1, %2" : "=v"(r) : "v"(lo), "v"(hi)); return r; }
__device__ __forceinline__ unsigned cvt_pk4_fp8(float a, float b, float c, float d) { unsigned r = 0u; asm volatile("v_cvt_pk_fp8_f32 %0, %1, %2\n\tv_cvt_pk_fp8_f32 %0, %3, %4 op_sel:[0,0,1]" : "+v"(r) : "v"(a), "v"(b), "v"(c), "v"(d)); return r; }
__device__ __forceinline__ float bf_lo(unsigned u) { return __uint_as_float(u << 16); }
__device__ __forceinline__ float bf_hi(unsigned u) { return __uint_as_float(u & 0xffff0000u); }
__device__ __forceinline__ float wave_sum(float v) {
#pragma unroll
    for (int o = 1; o < 64; o <<= 1) v += __shfl_xor(v, o);
    return v;
}
__device__ __forceinline__ float silu_f(float x) { return x * __builtin_amdgcn_rcpf(1.f + __builtin_amdgcn_exp2f(x * -1.44269504f)); }
#define LDS_WAIT() asm volatile("s_waitcnt lgkmcnt(0)" ::: "memory")


#define XB_TMO      128
#define XB_XCNT(j)  (256  + 64 * (j))
#define XB_XSUB(j)  (1280 + 64 * (j))
#define XB_XGEN(j)  (2304 + 64 * (j))
#define XB_TOP      3328
#define XB_TOPGEN   3392
#define XCD_BAR_WORDS 3456
#define XB_SPIN_CAP (1u << 20)
__device__ __forceinline__ unsigned xb_ld(unsigned* p)              { return __hip_atomic_load(p, __ATOMIC_RELAXED, __HIP_MEMORY_SCOPE_AGENT); }
__device__ __forceinline__ unsigned xb_add(unsigned* p, unsigned v) { return __hip_atomic_fetch_add(p, v, __ATOMIC_RELAXED, __HIP_MEMORY_SCOPE_AGENT); }
__device__ __forceinline__ unsigned xb_xcc_id() { return (unsigned)__builtin_amdgcn_s_getreg((3 << 11) | 20) & 0xFu; }
#define XB_SPIN(cond, bar) do { unsigned _sp = 0; while (cond) { __builtin_amdgcn_s_sleep(1); \
    if ((++_sp & 255u) == 0u) { if (xb_ld(&(bar)[XB_TMO])) break; if (_sp > XB_SPIN_CAP) { atomicAdd(&(bar)[XB_TMO], 1u); break; } } } } while (0)
struct XcdBarrier { unsigned* bar; unsigned x; volatile LAS unsigned* st; };
__device__ __forceinline__ XcdBarrier xcd_barrier_post(unsigned* bar, volatile LAS unsigned* st) {
    XcdBarrier b; b.bar = bar; b.x = xb_xcc_id(); b.st = st;
    if (threadIdx.x == 0) (void)xb_add(&bar[XB_XCNT(b.x)], 1u);
    return b;
}
__device__ __forceinline__ void xcd_barrier_complete(unsigned* bar, unsigned x, unsigned& nloc, unsigned& nx) {
    const unsigned G = gridDim.x * gridDim.y * gridDim.z;
    unsigned sum, cnt, mine, sp = 0u;
    for (;;) {
        sum = 0u; cnt = 0u; mine = 0u;
#pragma unroll
        for (unsigned j = 0; j < 16; ++j) { const unsigned c = xb_ld(&bar[XB_XCNT(j)]); sum += c; cnt += (c > 0u) ? 1u : 0u; mine = (j == x) ? c : mine; }
        if (sum == G) break;
        __builtin_amdgcn_s_sleep(1);
        if ((++sp & 255u) == 0u) { if (xb_ld(&bar[XB_TMO])) break; if (sp > XB_SPIN_CAP) { atomicAdd(&bar[XB_TMO], 1u); break; } }
    }
    nloc = mine > 0u ? mine : 1u; nx = cnt > 0u ? cnt : 1u;
}
__device__ __forceinline__ void xcd_barrier(const XcdBarrier& b) {
    asm volatile("s_waitcnt vmcnt(0)" ::: "memory");
    __syncthreads();
    if (threadIdx.x == 0) {
        unsigned* bar = b.bar;
        __builtin_amdgcn_s_waitcnt(0);
        unsigned nloc = b.st[0], nx = b.st[1];
        if (nloc == 0u) { xcd_barrier_complete(bar, b.x, nloc, nx); b.st[0] = nloc; b.st[1] = nx; }
        const unsigned old = xb_add(&bar[XB_XSUB(b.x)], 1u);
        const unsigned gen = old / nloc;
        if (old + 1u == (gen + 1u) * nloc) {
            __builtin_amdgcn_fence(__ATOMIC_RELEASE, "agent");
            asm volatile("s_waitcnt vmcnt(0)" ::: "memory");
            const unsigned og = xb_add(&bar[XB_TOP], 1u);
            const unsigned tg = og / nx;
            if (og + 1u == (tg + 1u) * nx) xb_add(&bar[XB_TOPGEN], 1u);
            else XB_SPIN(xb_ld(&bar[XB_TOPGEN]) == tg, bar);
            __builtin_amdgcn_fence(__ATOMIC_ACQUIRE, "agent");
            xb_add(&bar[XB_XGEN(b.x)], 1u);
            asm volatile("s_waitcnt vmcnt(0)" ::: "memory");
        } else {
            XB_SPIN(xb_ld(&bar[XB_XGEN(b.x)]) == gen, bar);
            __builtin_amdgcn_fence(__ATOMIC_ACQUIRE, "agent");
            asm volatile("s_waitcnt vmcnt(0)" ::: "memory");
        }
    }
    __syncthreads();
}

namespace pg8 {
constexpr int BM = 256, BK = 64, HALF = 128, HTB = HALF * BK * 2, STAGE_BYTES = 8 * HTB, NXCD = 8, WGM = 8;
__device__ __forceinline__ int lds_byte(int r, int c) { const int st = (r >> 4) * 2 + (c >> 5), rr = r & 15, cc = c & 31, ob = rr * 64 + cc * 2; return st * 1024 + (ob ^ (((ob >> 9) & 1) << 5)); }
__device__ __forceinline__ void stage_rc(int b, int& R, int& C) { const int st = b / 1024, sb = b % 1024, swz = sb ^ (((sb >> 9) & 1) << 5); R = (st >> 1) * 16 + swz / 64; C = (st & 1) * 32 + (swz % 64) / 2; }
__device__ __forceinline__ int perm32(int rho) { const int n = rho >> 4, i = rho & 15; return 8 * (i >> 2) + 4 * n + (i & 3); }

struct Unit { int pm, pn, e; };
struct GroupOrder {
    int nM, nN, ng, G, c;
    __device__ __forceinline__ void init(int nM_, int nN_, int ng_, int G_, int c_) { nM = nM_; nN = nN_; ng = ng_; G = G_; c = c_; }
    __device__ __forceinline__ bool next(int i, Unit& u) const {
        const int nwg = nM * nN; const long L = (long)i * G + c; if (L >= (long)nwg * ng) return false;
        const int grp = (int)(L / nwg); int wgid = (int)(L % nwg);
        { const int q = nwg / NXCD, r = nwg % NXCD, xcd = wgid % NXCD, off = wgid / NXCD; wgid = (xcd < r ? xcd * (q + 1) : r * (q + 1) + (xcd - r) * q) + off; }
        const int nig = WGM * nN, gid = wgid / nig, fm = gid * WGM, gsz = (nM - fm) < WGM ? (nM - fm) : WGM;
        u.pm = grp * nM + fm + ((wgid % nig) % gsz); u.pn = (wgid % nig) / gsz; u.e = grp; return true;
    }
};
struct Moe2Order {
    int c;
    __device__ __forceinline__ bool next(int i, Unit& u) const { if (i >= 4) return false; const int x = c & 7, j = c >> 3; u.e = 4 * i + (j >> 3); u.pm = u.e * 16 + 2 * x + ((j & 7) >> 2); u.pn = j & 3; return true; }
};
struct Gemm { const bf16_t* A; const bf16_t* Bt; int K; size_t bgs; const int* rowidx; };

template <class Epi, bool GATHER, class Sched = GroupOrder, bool FP8 = false>
__device__ __forceinline__ void gemm_phase(LAS uchar* lds, const Gemm g, const Sched& S, const Epi& E) {
    const int tid = threadIdx.x, wid = __builtin_amdgcn_readfirstlane(tid >> 6), lane = tid & 63, wr = wid >> 2, wc = wid & 3, fr = lane & 15, fq = lane >> 4;
    const int K = g.K, nt = K / BK;
    unsigned voffA[2], voffB[2]; int Rr[2], Cc[2];
#pragma unroll
    for (int i = 0; i < 2; ++i) { int R, C; stage_rc(tid * 16 + i * 8192, R, C); const int Rb = Epi::PERM ? ((R & ~31) + perm32(R & 31)) : R; Rr[i] = R; Cc[i] = C;
        voffA[i] = (unsigned)(R * K + C) * 2u; voffB[i] = (unsigned)(Rb * K + C) * 2u; }
    const size_t kstep = (size_t)(BK * 2);
    const size_t hstep = (size_t)HALF * K * 2;
    const size_t tstep = 2 * hstep;
    const unsigned ldsw = (unsigned)wid * 1024u;
    const int aoff = lds_byte(wr * 64 + fr, fq * 8), boff = lds_byte(wc * 32 + fr, fq * 8);
#define PG8_SA(b, h) (((b) * 2 + (h)) * HTB)
#define PG8_SB(b, h) ((4 + (b) * 2 + (h)) * HTB)
#define PG8_STAGE(bufoff, gbase, voff) do { _Pragma("unroll") for (int _i = 0; _i < 2; ++_i) \
        __builtin_amdgcn_global_load_lds((const unsigned*)((const char*)(gbase) + (voff)[_i]), (LAS unsigned*)(lds + (bufoff) + ldsw + _i * 8192), 16, 0, 0); } while (0)
#define PG8_STAGE_A(bufoff, p, ofs, h) do { if constexpr (GATHER) { PG8_STAGE(bufoff, p, (ofs)[h]); } else { PG8_STAGE(bufoff, (p) + (h) * hstep, voffA); } } while (0)
#define PG8_LD8(p) __builtin_shufflevector(*(const LAS i32x4*)(p), *(const LAS i32x4*)((p) + 1024), 0, 1, 2, 3, 4, 5, 6, 7)
#define PG8_LDA(dst, b, h) do { _Pragma("unroll") for (int m = 0; m < 4; ++m) dst[m] = PG8_LD8(lds + PG8_SA(b, h) + aoff + m * 2048); } while (0)
#define PG8_LDB(dst, b, h) do { _Pragma("unroll") for (int n = 0; n < 2; ++n) dst[n] = PG8_LD8(lds + PG8_SB(b, h) + boff + n * 2048); } while (0)
#define PG8_HALF(x, k) __builtin_bit_cast(bf16x8, (k) ? __builtin_shufflevector(x, x, 4, 5, 6, 7) : __builtin_shufflevector(x, x, 0, 1, 2, 3))
#define PG8_MMA(ai, bj, At, Bt) do { __builtin_amdgcn_s_setprio(1); _Pragma("unroll") for (int m = 0; m < 4; ++m) _Pragma("unroll") for (int n = 0; n < 2; ++n) { \
        if constexpr (FP8) acc[ai][bj][m][n] = __builtin_amdgcn_mfma_scale_f32_16x16x128_f8f6f4(Bt[n], At[m], acc[ai][bj][m][n], 0, 0, 0, 0x7f7f7f7f, 0, 0x7f7f7f7f); \
        else { acc[ai][bj][m][n] = __builtin_amdgcn_mfma_f32_16x16x32_bf16(PG8_HALF(Bt[n], 0), PG8_HALF(At[m], 0), acc[ai][bj][m][n], 0, 0, 0); \
               acc[ai][bj][m][n] = __builtin_amdgcn_mfma_f32_16x16x32_bf16(PG8_HALF(Bt[n], 1), PG8_HALF(At[m], 1), acc[ai][bj][m][n], 0, 0, 0); } } \
        if constexpr (FP8) { _Pragma("unroll") for (int m = 0; m < 4; ++m) _Pragma("unroll") for (int n = 0; n < 2; ++n) asm volatile("" : "+v"(acc[ai][bj][m][n])); }     \
        __builtin_amdgcn_s_setprio(0); } while (0)
#define PG8_WAIT_V(n) asm volatile("s_waitcnt vmcnt(" #n ")" ::: "memory")
#define PG8_WAIT_L(n) asm volatile("s_waitcnt lgkmcnt(" #n ")" ::: "memory")
#define PG8_BAR __builtin_amdgcn_s_barrier()
#define PG8_SCHED __builtin_amdgcn_sched_barrier(0)
    Unit cur, nxt; int ui = 0;
    if (!S.next(0, cur)) return;
    f32x4 acc[2][2][4][2];
#pragma unroll
    for (int a = 0; a < 2; ++a)
#pragma unroll
        for (int b = 0; b < 2; ++b)
#pragma unroll
            for (int m = 0; m < 4; ++m)
#pragma unroll
                for (int n = 0; n < 2; ++n) acc[a][b][m][n] = (f32x4){0.f, 0.f, 0.f, 0.f};
    i32x8 At[4], B0[2], B1[2];
    unsigned cofs[2][2], nofs[2][2];
    LAS unsigned short* ridx = (LAS unsigned short*)(lds + STAGE_BYTES);
    if constexpr (GATHER) {
        { Unit tu; for (int uu = 0; uu < 16 && S.next(uu, tu); ++uu) if (tid < BM) ridx[uu * BM + tid] = (unsigned short)g.rowidx[tu.pm * BM + tid]; }
        asm volatile("s_waitcnt vmcnt(0) lgkmcnt(0)" ::: "memory"); __builtin_amdgcn_s_barrier(); asm volatile("" ::: "memory");
#pragma unroll
        for (int h = 0; h < 2; ++h)
#pragma unroll
            for (int i = 0; i < 2; ++i) { const int row = ridx[h * HALF + Rr[i]]; cofs[h][i] = (unsigned)(row * K + Cc[i]) * 2u; nofs[h][i] = cofs[h][i]; }
    }
    const char* cA = GATHER ? (const char*)g.A : (const char*)g.A + (size_t)cur.pm * tstep;
    const char* cB = (const char*)g.Bt + (size_t)cur.e * g.bgs + (size_t)cur.pn * tstep;
    PG8_STAGE(PG8_SB(0, 0), cB, voffB); PG8_STAGE(PG8_SB(0, 1), cB + hstep, voffB); PG8_STAGE_A(PG8_SA(0, 0), cA, cofs, 0); PG8_STAGE_A(PG8_SA(0, 1), cA, cofs, 1);
    if (wr == 1) PG8_BAR;
    PG8_WAIT_V(2); PG8_BAR;
    PG8_STAGE(PG8_SB(1, 0), cB + kstep, voffB); PG8_STAGE_A(PG8_SA(1, 0), cA + kstep, cofs, 0); PG8_STAGE(PG8_SB(1, 1), cB + hstep + kstep, voffB);
    PG8_WAIT_V(6); PG8_BAR;
    for (;;) {
        const bool has_next = S.next(ui + 1, nxt);
        const char* nA = GATHER ? (const char*)g.A : (has_next ? (const char*)g.A + (size_t)nxt.pm * tstep : cA);
        const char* nB = has_next ? (const char*)g.Bt + (size_t)nxt.e * g.bgs + (size_t)nxt.pn * tstep : cB;
#pragma unroll 1
        for (int t = 0; t < nt; t += 2) {
            const bool last = (t == nt - 2);
            const char* a1 = cA + (size_t)(t + 1) * kstep;
            const char* a2 = last ? nA : cA + (size_t)(t + 2) * kstep; const char* b2 = last ? nB : cB + (size_t)(t + 2) * kstep;
            const char* a3 = a2 + kstep; const char* b3 = b2 + kstep;
            if constexpr (GATHER) {
                if (last && has_next) {
#pragma unroll
                    for (int h = 0; h < 2; ++h)
#pragma unroll
                        for (int i = 0; i < 2; ++i) { const int row = ridx[(ui + 1) * BM + h * HALF + Rr[i]]; nofs[h][i] = (unsigned)(row * K + Cc[i]) * 2u; }
                }
            }
            PG8_LDB(B0, 0, 0); PG8_LDB(B1, 0, 1); PG8_SCHED; PG8_LDA(At, 0, 0); PG8_STAGE_A(PG8_SA(1, 1), a1, cofs, 1);
            PG8_WAIT_V(8); PG8_WAIT_L(0); PG8_BAR; PG8_MMA(0, 0, At, B0); PG8_MMA(0, 1, At, B1); PG8_BAR; PG8_SCHED;
            PG8_LDA(At, 0, 1); PG8_STAGE(PG8_SB(0, 0), b2, voffB); PG8_STAGE(PG8_SB(0, 1), b2 + hstep, voffB);
            if (last) { PG8_STAGE_A(PG8_SA(0, 0), a2, nofs, 0); } else { PG8_STAGE_A(PG8_SA(0, 0), a2, cofs, 0); }
            PG8_WAIT_V(8); PG8_WAIT_L(0); PG8_BAR; PG8_MMA(1, 0, At, B0); PG8_MMA(1, 1, At, B1); PG8_BAR; PG8_SCHED;
            PG8_LDB(B0, 1, 0); PG8_LDB(B1, 1, 1); PG8_SCHED; PG8_LDA(At, 1, 0);
            if (last) { PG8_STAGE_A(PG8_SA(0, 1), a2, nofs, 1); } else { PG8_STAGE_A(PG8_SA(0, 1), a2, cofs, 1); }
            PG8_WAIT_V(8); PG8_WAIT_L(0); PG8_BAR; PG8_MMA(0, 0, At, B0); PG8_MMA(0, 1, At, B1); PG8_BAR; PG8_SCHED;
            PG8_LDA(At, 1, 1); PG8_STAGE(PG8_SB(1, 0), b3, voffB); PG8_STAGE(PG8_SB(1, 1), b3 + hstep, voffB);
            if (last) { PG8_STAGE_A(PG8_SA(1, 0), a3, nofs, 0); } else { PG8_STAGE_A(PG8_SA(1, 0), a3, cofs, 0); }
            PG8_WAIT_V(8); PG8_WAIT_L(0); PG8_BAR; PG8_MMA(1, 0, At, B0); PG8_MMA(1, 1, At, B1); PG8_BAR; PG8_SCHED;
        }
        if (wr == 0) PG8_BAR;
        E(acc, cur, wr, wc, fr, fq);
        if (!has_next) break;
#pragma unroll
        for (int a = 0; a < 2; ++a)
#pragma unroll
            for (int b = 0; b < 2; ++b)
#pragma unroll
                for (int m = 0; m < 4; ++m)
#pragma unroll
                    for (int n = 0; n < 2; ++n) acc[a][b][m][n] = (f32x4){0.f, 0.f, 0.f, 0.f};
        cur = nxt; cA = nA; cB = nB; ++ui;
        if constexpr (GATHER) {
#pragma unroll
            for (int h = 0; h < 2; ++h)
#pragma unroll
                for (int i = 0; i < 2; ++i) cofs[h][i] = nofs[h][i];
        }
        if (wr == 1) PG8_BAR;
    }
    PG8_WAIT_V(0);
    PG8_BAR;
#undef PG8_SA
#undef PG8_SB
#undef PG8_STAGE
#undef PG8_STAGE_A
#undef PG8_LD8
#undef PG8_HALF
#undef PG8_LDA
#undef PG8_LDB
#undef PG8_MMA
#undef PG8_WAIT_V
#undef PG8_WAIT_L
#undef PG8_BAR
#undef PG8_SCHED
}


struct EpiInproj {
    static constexpr bool PERM = true;
    uchar* zbase; bf16_t* ci; _Float16* olog0; _Float16* olog1; const float* lb; int seg0; int Tn;
    __device__ __forceinline__ void operator()(const f32x4 (&acc)[2][2][4][2], const Unit& u, int wr, int wc, int fr, int fq) const {
        const int seg = seg0 + (u.pn >> 1);
        const int row0 = u.pm * BM + wr * 64 + fr;
        if (seg <= 3) {
            const int b = (u.pm * BM) / Tn, t0 = row0 - b * Tn, dcol = wc * 32 + 8 * fq;
#pragma unroll
            for (int bj = 0; bj < 2; ++bj) { const int hh = (u.pn & 1) * 2 + bj; const size_t plane = (size_t)(b * NH + hh) * Tn;
                if (seg == 1 || seg == 2) {
                    _Float16* O = (seg == 1) ? olog0 : olog1; const float* lbp = lb + (seg - 1) * 512 + hh * 128 + dcol;
                    const f32x4 l0 = *(const f32x4*)lbp, l1 = *(const f32x4*)(lbp + 4);
#pragma unroll
                    for (int ai = 0; ai < 2; ++ai)
#pragma unroll
                        for (int m = 0; m < 4; ++m) { const f32x4 v0 = acc[ai][bj][m][0], v1 = acc[ai][bj][m][1]; _Float16 o[8];
#pragma unroll
                            for (int j = 0; j < 4; ++j) { const float s0 = __builtin_amdgcn_rcpf(1.f + __builtin_amdgcn_exp2f(v0[j] * -1.44269504f)), s1 = __builtin_amdgcn_rcpf(1.f + __builtin_amdgcn_exp2f(v1[j] * -1.44269504f));
                                o[j] = (_Float16)__builtin_amdgcn_logf(l0[j] + (1.f - l0[j]) * s0); o[4 + j] = (_Float16)__builtin_amdgcn_logf(l1[j] + (1.f - l1[j]) * s1); }
                            __builtin_nontemporal_store(__builtin_bit_cast(u32x4, o), (u32x4*)(O + (plane + t0 + ai * HALF + m * 16) * 128 + dcol)); }
                } else {
                    bf16_t* O = zbase ? (bf16_t*)(zbase + (size_t)(seg == 0 ? 0 : 160) * MiB) : ci;
#pragma unroll
                    for (int ai = 0; ai < 2; ++ai)
#pragma unroll
                        for (int m = 0; m < 4; ++m) { const f32x4 v0 = acc[ai][bj][m][0], v1 = acc[ai][bj][m][1];
                            u32x4 w; w.x = cvt_pk_bf16(v0[0], v0[1]); w.y = cvt_pk_bf16(v0[2], v0[3]); w.z = cvt_pk_bf16(v1[0], v1[1]); w.w = cvt_pk_bf16(v1[2], v1[3]);
                            __builtin_nontemporal_store(w, (u32x4*)(O + (plane + t0 + ai * HALF + m * 16) * 128 + dcol)); }
                }
            }
        } else if (seg >= 6) {
            const int col0 = (u.pn - 12) * 128 + wc * 32 + 8 * fq;
            bf16_t* O = (bf16_t*)(zbase + (size_t)(32 * 6 + 64) * MiB);
#pragma unroll
            for (int ai = 0; ai < 2; ++ai)
#pragma unroll
                for (int m = 0; m < 4; ++m) { const f32x4 v0 = acc[ai][0][m][0] * acc[ai][1][m][0], v1 = acc[ai][0][m][1] * acc[ai][1][m][1];
                    u32x4 w; w.x = cvt_pk_bf16(v0[0], v0[1]); w.y = cvt_pk_bf16(v0[2], v0[3]); w.z = cvt_pk_bf16(v1[0], v1[1]); w.w = cvt_pk_bf16(v1[2], v1[3]);
                    __builtin_nontemporal_store(w, (u32x4*)(O + (size_t)(row0 + ai * HALF + m * 16) * 512 + col0)); }
        } else {
            const int col0 = (u.pn & 1) * 256 + wc * 32 + 8 * fq;
            bf16_t* O = (bf16_t*)(zbase + (size_t)(32 * seg + 64) * MiB);
#pragma unroll
            for (int ai = 0; ai < 2; ++ai)
#pragma unroll
                for (int m = 0; m < 4; ++m) { bf16_t* rowp = O + (size_t)(row0 + ai * HALF + m * 16) * 512 + col0;
#pragma unroll
                    for (int bj = 0; bj < 2; ++bj) { const f32x4 v0 = acc[ai][bj][m][0], v1 = acc[ai][bj][m][1];
                        u32x4 w; w.x = cvt_pk_bf16(v0[0], v0[1]); w.y = cvt_pk_bf16(v0[2], v0[3]); w.z = cvt_pk_bf16(v1[0], v1[1]); w.w = cvt_pk_bf16(v1[2], v1[3]);
                        __builtin_nontemporal_store(w, (u32x4*)(rowp + bj * HALF)); } }
        }
    }
};
struct EpiOut {
    static constexpr bool PERM = false;
    const float* x; float* x1; const float* modf;
    __device__ __forceinline__ void operator()(const f32x4 (&acc)[2][2][4][2], const Unit& u, int wr, int wc, int fr, int fq) const {
        const int row0 = u.pm * BM + wr * 64 + fr, col0 = u.pn * BM + wc * 32 + 4 * fq;
        const int b = (u.pm * BM) / T;
        const float* g1 = modf + (size_t)b * NMOD + 2 * D;
        f32x4 gv[2][2];
#pragma unroll
        for (int bj = 0; bj < 2; ++bj)
#pragma unroll
            for (int n = 0; n < 2; ++n) gv[bj][n] = *(const f32x4*)(g1 + col0 + bj * HALF + n * 16);
#pragma unroll
        for (int ai = 0; ai < 2; ++ai)
#pragma unroll
            for (int m = 0; m < 4; ++m) { const size_t off = (size_t)(row0 + ai * HALF + m * 16) * D + col0;
#pragma unroll
                for (int bj = 0; bj < 2; ++bj)
#pragma unroll
                    for (int n = 0; n < 2; ++n) { const f32x4 xs = __builtin_nontemporal_load((const f32x4*)(x + off + bj * HALF + n * 16)); __builtin_nontemporal_store(xs + gv[bj][n] * acc[ai][bj][m][n], (f32x4*)(x1 + off + bj * HALF + n * 16)); }
                asm volatile("" ::: "memory"); }
    }
};
struct EpiMoe1 {
    static constexpr bool PERM = true;
    uchar* hid;
    __device__ __forceinline__ void operator()(const f32x4 (&acc)[2][2][4][2], const Unit& u, int wr, int wc, int fr, int fq) const {
        const int row0 = u.pm * BM + wr * 64 + fr, col0 = u.pn * 128 + wc * 32 + 8 * fq;
#pragma unroll
        for (int ai = 0; ai < 2; ++ai)
#pragma unroll
            for (int m = 0; m < 4; ++m) { uchar* rowp = hid + (size_t)(row0 + ai * HALF + m * 16) * DFF + col0;
                float o[8];
#pragma unroll
                for (int n = 0; n < 2; ++n)
#pragma unroll
                    for (int j = 0; j < 4; ++j) { const float gt = acc[ai][0][m][n][j] * 0.03125f, up = acc[ai][1][m][n][j] * 0.03125f; o[n * 4 + j] = gt * up * __builtin_amdgcn_rcpf(1.f + __builtin_amdgcn_exp2f(gt * -1.44269504f)); }
                u32x2 w; w.x = cvt_pk4_fp8(o[0], o[1], o[2], o[3]); w.y = cvt_pk4_fp8(o[4], o[5], o[6], o[7]);
                __builtin_nontemporal_store(w, (u32x2*)rowp); }
    }
};
struct EpiMoe2 {
    static constexpr bool PERM = true;
    bf16_t* ys; const LAS float* lgate;
    __device__ __forceinline__ void operator()(const f32x4 (&acc)[2][2][4][2], const Unit& u, int wr, int wc, int fr, int fq) const {
        const int row0 = u.pm * BM + wr * 64 + fr, col0 = u.pn * BM + wc * 32 + 8 * fq;
        const LAS float* gt_ = lgate + (u.e >> 2) * BM + wr * 64 + fr;
#pragma unroll
        for (int ai = 0; ai < 2; ++ai)
#pragma unroll
            for (int m = 0; m < 4; ++m) { const int row = row0 + ai * HALF + m * 16; const float gt = gt_[ai * HALF + m * 16] * 0.03125f; bf16_t* rowp = ys + (size_t)row * D + col0;
#pragma unroll
                for (int bj = 0; bj < 2; ++bj) { const f32x4 v0 = acc[ai][bj][m][0] * gt, v1 = acc[ai][bj][m][1] * gt;
                    u32x4 w; w.x = cvt_pk_bf16(v0[0], v0[1]); w.y = cvt_pk_bf16(v0[2], v0[3]); w.z = cvt_pk_bf16(v1[0], v1[1]); w.w = cvt_pk_bf16(v1[2], v1[3]);
                    __builtin_nontemporal_store(w, (u32x4*)(rowp + bj * HALF)); } }
    }
};
}

struct Args {
    const float *x, *c, *ctx, *c_ctx, *w_ada, *b_ada, *norm_mix, *norm_ffn, *w_in, *lb_logits, *hg_norm, *conv_w, *w_out, *w_router, *w_gate, *w_up, *w_down, *norm_final;
    float* out; uchar* ws; int ph_lo, ph_hi;
};

__device__ __forceinline__ void cvt_item(const float* W, int ldw, bf16_t* WT, int ldt, int k0, int n0, int nrow0, LAS float* scr, int lane) {
    const int r = lane >> 3, c4 = lane & 7;
    f32x4 v[8];
#pragma unroll
    for (int i = 0; i < 8; ++i) v[i] = __builtin_nontemporal_load((const f32x4*)(W + (size_t)(k0 + 8 * i + r) * ldw + n0 + 4 * c4));
#pragma unroll
    for (int i = 0; i < 8; ++i) { LAS float* d = scr + (8 * i + r) * 33 + 4 * c4; d[0] = v[i].x; d[1] = v[i].y; d[2] = v[i].z; d[3] = v[i].w; }
    LDS_WAIT(); asm volatile("" ::: "memory");
    const int c = lane & 7;
#pragma unroll
    for (int j = 0; j < 4; ++j) { const int n = (lane >> 3) + 8 * j; const LAS float* sp = scr + (8 * c) * 33 + n;
        u32x4 o; o.x = cvt_pk_bf16(sp[0 * 33], sp[1 * 33]); o.y = cvt_pk_bf16(sp[2 * 33], sp[3 * 33]); o.z = cvt_pk_bf16(sp[4 * 33], sp[5 * 33]); o.w = cvt_pk_bf16(sp[6 * 33], sp[7 * 33]);
        *(u32x4*)(WT + (size_t)(nrow0 + n) * ldt + k0 + 8 * c) = o; }
    LDS_WAIT(); asm volatile("" ::: "memory");
}

__device__ __forceinline__ void cvt_item_fp8(const float* W, int ldw, uchar* WT, int ldt, int k0, int n0, int nrow0, LAS float* scr, int lane) {
    const int r = lane >> 3, c4 = lane & 7;
    f32x4 v[8];
#pragma unroll
    for (int i = 0; i < 8; ++i) v[i] = __builtin_nontemporal_load((const f32x4*)(W + (size_t)(k0 + 8 * i + r) * ldw + n0 + 4 * c4));
#pragma unroll
    for (int i = 0; i < 8; ++i) { LAS float* d = scr + (8 * i + r) * 33 + 4 * c4; d[0] = v[i].x; d[1] = v[i].y; d[2] = v[i].z; d[3] = v[i].w; }
    LDS_WAIT(); asm volatile("" ::: "memory");
    const int c = lane & 7;
#pragma unroll
    for (int j = 0; j < 4; ++j) { const int n = (lane >> 3) + 8 * j; const LAS float* sp = scr + (8 * c) * 33 + n;
        u32x2 o; o.x = cvt_pk4_fp8(sp[0 * 33] * 32.f, sp[1 * 33] * 32.f, sp[2 * 33] * 32.f, sp[3 * 33] * 32.f); o.y = cvt_pk4_fp8(sp[4 * 33] * 32.f, sp[5 * 33] * 32.f, sp[6 * 33] * 32.f, sp[7 * 33] * 32.f);
        *(u32x2*)(WT + (size_t)(nrow0 + n) * ldt + k0 + 8 * c) = o; }
    LDS_WAIT(); asm volatile("" ::: "memory");
}

__device__ __forceinline__ void phase_prep(const Args& a, LAS uchar* lds, int bid, int G, int tid, int wid, int lane) {
    float* modp = (float*)(a.ws + WS_MODP);
    if (bid < 192) {
        const int cgp = bid % 24, ks = bid / 24, n0 = cgp * 256 + lane * 4, k0 = ks * 128 + wid * 16;
        LAS float* sc = (LAS float*)(lds + 81920);
        for (int i = tid; i < 9 * 128; i += 512) { const int r = i >> 7, kk = i & 127; sc[i] = silu_f((r < 8) ? a.c[r * D + ks * 128 + kk] : a.c_ctx[ks * 128 + kk]); }
        f32x4 w[16];
#pragma unroll
        for (int kk = 0; kk < 16; ++kk) w[kk] = __builtin_nontemporal_load((const f32x4*)(a.w_ada + (size_t)(k0 + kk) * NMOD + n0));
        __syncthreads();
        f32x4 acc[9];
#pragma unroll
        for (int r = 0; r < 9; ++r) acc[r] = (f32x4){0.f, 0.f, 0.f, 0.f};
#pragma unroll
        for (int kk = 0; kk < 16; ++kk) {
#pragma unroll
            for (int r = 0; r < 9; ++r) acc[r] += w[kk] * sc[r * 128 + wid * 16 + kk]; }
        LAS f32x4* red = (LAS f32x4*)lds;
#pragma unroll
        for (int r = 0; r < 9; ++r) red[(wid * 9 + r) * 64 + lane] = acc[r];
        __syncthreads();
        for (int o = tid; o < 9 * 64; o += 512) { const int r = o / 64, l = o % 64; f32x4 sm = red[(0 * 9 + r) * 64 + l];
#pragma unroll
            for (int w8 = 1; w8 < 8; ++w8) sm += red[(w8 * 9 + r) * 64 + l];
            if (ks == 0) sm += *(const f32x4*)(a.b_ada + cgp * 256 + l * 4);
            *(f32x4*)(modp + ((size_t)ks * 9 + r) * NMOD + cgp * 256 + l * 4) = sm; }
        __syncthreads();
    }
    if (bid == 255) {
        float* lb = (float*)(a.ws + WS_LB);
        for (int i = tid; i < 1024; i += 512) { const float l0 = a.lb_logits[i], l1 = a.lb_logits[1024 + i]; lb[i] = 1.f / (1.f + __expf(l1 - l0)); }
    }
    LAS float* scr = (LAS float*)lds + wid * (64 * 33);
    const int gw = (G - 1 - bid) * 8 + wid, NGW = G * 8;
    constexpr int I_IN = (D / 64) * (NIN / 32), I_OUT = (D / 64) * (D / 32);
    for (int it = gw; it < I_IN + I_OUT; it += NGW) {
        if (it < I_IN) { const int nblk = NIN / 32, kb = it / nblk, nb = it % nblk; const int n0 = nb * 32;
            const int nrow = (n0 < 3072) ? n0 : 3072 + (((n0 - 3072) & 511) >> 7) * 256 + ((n0 - 3072) & 127) + ((n0 >= 3584) ? 128 : 0);
            cvt_item(a.w_in, NIN, (bf16_t*)(a.ws + WS_WIN), D, kb * 64, n0, nrow, scr, lane); }
        else { const int r = it - I_IN, nblk = D / 32, kb = r / nblk, nb = r % nblk; cvt_item(a.w_out, D, (bf16_t*)(a.ws + WS_WOUT), D, kb * 64, nb * 32, nb * 32, scr, lane); }
    }
}

__device__ __forceinline__ float modp_sum(const float* modp, int r, int col) { float s = 0.f;
#pragma unroll
    for (int ks = 0; ks < 8; ++ks) s += modp[((size_t)ks * 9 + r) * NMOD + col];
    return s; }
template <int NR>
__device__ __forceinline__ void norm_rows(const float* xrow0, bf16_t* orow0, const LAS float* gm, const LAS float* sh, int lane) {
    f32x4 v[NR][4]; float ss[NR];
#pragma unroll
    for (int i = 0; i < NR; ++i) { ss[i] = 0.f;
#pragma unroll
        for (int j = 0; j < 4; ++j) v[i][j] = __builtin_nontemporal_load((const f32x4*)(xrow0 + (size_t)i * D) + lane + 64 * j); }
#pragma unroll
    for (int i = 0; i < NR; ++i) {
#pragma unroll
        for (int j = 0; j < 4; ++j) ss[i] += (v[i][j].x * v[i][j].x + v[i][j].y * v[i][j].y) + (v[i][j].z * v[i][j].z + v[i][j].w * v[i][j].w);
        ss[i] = rsqrtf(wave_sum(ss[i]) * (1.f / D) + EPS); }
#pragma unroll
    for (int j = 0; j < 4; ++j) { const f32x4 g4 = *((const LAS f32x4*)gm + lane + 64 * j), s4 = *((const LAS f32x4*)sh + lane + 64 * j);
#pragma unroll
        for (int i = 0; i < NR; ++i) { const f32x4 o = v[i][j] * ss[i] * g4 + s4;
            u32x2 w; w.x = cvt_pk_bf16(o.x, o.y); w.y = cvt_pk_bf16(o.z, o.w); *((u32x2*)(orow0 + (size_t)i * D) + lane + 64 * j) = w; } }
}
__device__ __forceinline__ void phase_norm(const Args& a, LAS uchar* lds, int bid, int G, int tid, int wid, int lane) {
    const float* modp = (const float*)(a.ws + WS_MODP); float* modf = (float*)(a.ws + WS_MODF);
    { const int gt = bid * 512 + tid; if (gt < 9 * NMOD) modf[gt] = modp_sum(modp, gt / NMOD, gt % NMOD); }
    LAS float* gm = (LAS float*)lds; LAS float* sh = gm + D; LAS float* cgm = sh + D; LAS float* csh = cgm + D;
    const int b = bid / 32;
    for (int cidx = tid; cidx < D; cidx += 512) { const float nm = a.norm_mix[cidx];
        sh[cidx] = modp_sum(modp, b, cidx); gm[cidx] = nm * (1.f + modp_sum(modp, b, D + cidx));
        csh[cidx] = modp_sum(modp, 8, cidx); cgm[cidx] = nm * (1.f + modp_sum(modp, 8, D + cidx)); }
    __syncthreads();
    bf16_t* hx = (bf16_t*)(a.ws + WS_ACT); bf16_t* hc = (bf16_t*)(a.ws + WS_HC);
    { const int row = bid * 8 + wid; norm_rows<1>(a.ctx + (size_t)row * D, hc + (size_t)row * D, cgm, csh, lane); }
    for (int j = 0; j < 16; j += 4) { const int row = bid * 128 + wid * 16 + j; norm_rows<4>(a.x + (size_t)row * D, hx + (size_t)row * D, gm, sh, lane); }
    __syncthreads();
}

constexpr int GL_QDP = 0, GL_KIP = 8704, GL_KETP = 17408, GL_VTP = 27648, GL_DEC = 37888, GL_TOT = 38400, GL_RING = 43008, GL_SLOT = 24576;
#define GLA_BAR() do { asm volatile("s_waitcnt lgkmcnt(0)" ::: "memory"); __builtin_amdgcn_s_barrier(); asm volatile("" ::: "memory"); } while (0)
template <bool FULL>
__device__ __forceinline__ void gla_item(LAS uchar* lds, const bf16_t* qb, const _Float16* lfb, const bf16_t* vb, bf16_t* ob, f32x4 (&S)[8], float* dl_out,
                                         int row_base, int Tn, int tau0, int nch, int h, int dir, int wid, int lane) {
    const int fr = lane & 15, fq = lane >> 4;
#define GLA_ISSUE(c) do { LAS uchar* _sl = lds + GL_RING + ((c) & 3) * GL_SLOT + wid * 3072; \
        const int _tau = tau0 + 32 * (c) + 4 * wid + (lane >> 4); const size_t _o = (size_t)(dir ? (Tn - 1 - _tau) : _tau) * 128 + (lane & 15) * 8; \
        __builtin_amdgcn_global_load_lds((const unsigned*)(lfb + _o), (LAS unsigned*)(_sl), 16, 0, 2); \
        if (FULL) __builtin_amdgcn_global_load_lds((const unsigned*)(qb + _o), (LAS unsigned*)(_sl + 1024), 16, 0, 2); \
        __builtin_amdgcn_global_load_lds((const unsigned*)(vb + _o), (LAS unsigned*)(_sl + 2048), 16, 0, 2); } while (0)
    GLA_ISSUE(0);
    if (nch > 1) GLA_ISSUE(1);
    if (nch > 2) GLA_ISSUE(2);
    const int d0 = 2 * lane, pos0 = (d0 & ~31) + 8 * ((d0 >> 2) & 3) + 4 * ((d0 >> 4) & 1) + (d0 & 3);
    const int spos = 8 * (wid & 3) + 4 * (wid >> 2);
    f32x2 dsum = (f32x2){0.f, 0.f};
    for (int n = 0; n < nch; ++n) {
        if (n + 2 < nch) { if (FULL) asm volatile("s_waitcnt vmcnt(6)" ::: "memory"); else asm volatile("s_waitcnt vmcnt(4)" ::: "memory"); }
        else if (n + 1 < nch) { if (FULL) asm volatile("s_waitcnt vmcnt(3)" ::: "memory"); else asm volatile("s_waitcnt vmcnt(2)" ::: "memory"); }
        else asm volatile("s_waitcnt vmcnt(0)" ::: "memory");
        const LAS uchar* sl = lds + GL_RING + (n & 3) * GL_SLOT + wid * 3072;
        f32x2 lf[4];
#pragma unroll
        for (int rr = 0; rr < 4; ++rr) { typedef _Float16 h2_t __attribute__((ext_vector_type(2))); const h2_t hv = *(const LAS h2_t*)(sl + rr * 256 + lane * 4); lf[rr] = (f32x2){(float)hv.x, (float)hv.y}; }
        f32x2 c[4]; c[0] = lf[0]; c[1] = c[0] + lf[1]; c[2] = c[1] + lf[2]; c[3] = c[2] + lf[3];
        LAS f32x2* tot = (LAS f32x2*)(lds + GL_TOT);
        tot[wid * 64 + lane] = c[3];
        unsigned qv[4], vv[4];
#pragma unroll
        for (int rr = 0; rr < 4; ++rr) { vv[rr] = *(const LAS unsigned*)(sl + 2048 + rr * 256 + lane * 4); qv[rr] = FULL ? *(const LAS unsigned*)(sl + 1024 + rr * 256 + lane * 4) : 0u; }
        GLA_BAR();
        if (n + 3 < nch) GLA_ISSUE(n + 3);
        f32x2 pre = (f32x2){0.f, 0.f}, all = (f32x2){0.f, 0.f};
#pragma unroll
        for (int w = 0; w < 8; ++w) { const f32x2 tw = tot[w * 64 + lane]; all += tw; if (w < wid) pre += tw; }
        dsum += all;
        const f32x2 decall = (f32x2){__builtin_amdgcn_exp2f(all.x), __builtin_amdgcn_exp2f(all.y)};
        f32x2 kE[4];
#pragma unroll
        for (int rr = 0; rr < 4; ++rr) {
            const f32x2 cum = pre + c[rr];
            const f32x2 k = 1.f - (f32x2){__builtin_amdgcn_exp2f(lf[rr].x), __builtin_amdgcn_exp2f(lf[rr].y)};
            const f32x2 ki = k * (f32x2){__builtin_amdgcn_exp2f(-cum.x), __builtin_amdgcn_exp2f(-cum.y)};
            kE[rr] = ki * decall;
            if (FULL) { const int s = 4 * wid + rr; const f32x2 qd = (f32x2){bf_lo(qv[rr]), bf_hi(qv[rr])} * (f32x2){__builtin_amdgcn_exp2f(cum.x), __builtin_amdgcn_exp2f(cum.y)};
                *(LAS unsigned*)(lds + GL_QDP + s * 272 + pos0 * 2) = cvt_pk_bf16(qd.x, qd.y);
                *(LAS unsigned*)(lds + GL_KIP + s * 272 + pos0 * 2) = cvt_pk_bf16(ki.x, ki.y); }
        }
        { u32x2 w0, w1; w0.x = cvt_pk_bf16(kE[0].x, kE[1].x); w0.y = cvt_pk_bf16(kE[2].x, kE[3].x); w1.x = cvt_pk_bf16(kE[0].y, kE[1].y); w1.y = cvt_pk_bf16(kE[2].y, kE[3].y);
          *(LAS u32x2*)(lds + GL_KETP + (d0) * 80 + spos * 2) = w0; *(LAS u32x2*)(lds + GL_KETP + (d0 + 1) * 80 + spos * 2) = w1;
          u32x2 v0, v1; v0.x = (vv[0] & 0xffffu) | (vv[1] << 16); v0.y = (vv[2] & 0xffffu) | (vv[3] << 16);
          v1.x = (vv[0] >> 16) | (vv[1] & 0xffff0000u); v1.y = (vv[2] >> 16) | (vv[3] & 0xffff0000u);
          *(LAS u32x2*)(lds + GL_VTP + (d0) * 80 + spos * 2) = v0; *(LAS u32x2*)(lds + GL_VTP + (d0 + 1) * 80 + spos * 2) = v1; }
        if (wid == 0) *(LAS f32x2*)(lds + GL_DEC + lane * 8) = decall;
        GLA_BAR();
        const bf16x8 vt = *(const LAS bf16x8*)(lds + GL_VTP + (16 * wid + fr) * 80 + fq * 16);
        if (FULL) {
            bf16x8 qf[2][4];
#pragma unroll
            for (int ti = 0; ti < 2; ++ti)
#pragma unroll
                for (int kk = 0; kk < 4; ++kk) qf[ti][kk] = *(const LAS bf16x8*)(lds + GL_QDP + (16 * ti + fr) * 272 + kk * 64 + fq * 16);
            f32x4 oT[2] = {(f32x4){0.f, 0.f, 0.f, 0.f}, (f32x4){0.f, 0.f, 0.f, 0.f}};
            f32x4 p00 = (f32x4){0.f, 0.f, 0.f, 0.f}, p01 = p00, p11 = p00;
#pragma unroll
            for (int kk = 0; kk < 4; ++kk) {
                const bf16x8 kj0 = *(const LAS bf16x8*)(lds + GL_KIP + (fr) * 272 + kk * 64 + fq * 16);
                const bf16x8 kj1 = *(const LAS bf16x8*)(lds + GL_KIP + (16 + fr) * 272 + kk * 64 + fq * 16);
                p00 = __builtin_amdgcn_mfma_f32_16x16x32_bf16(kj0, qf[0][kk], p00, 0, 0, 0);
                p01 = __builtin_amdgcn_mfma_f32_16x16x32_bf16(kj0, qf[1][kk], p01, 0, 0, 0);
                p11 = __builtin_amdgcn_mfma_f32_16x16x32_bf16(kj1, qf[1][kk], p11, 0, 0, 0);
                u32x4 sa; sa.x = cvt_pk_bf16_safe(S[2 * kk][0], S[2 * kk][1]); sa.y = cvt_pk_bf16_safe(S[2 * kk][2], S[2 * kk][3]);
                sa.z = cvt_pk_bf16_safe(S[2 * kk + 1][0], S[2 * kk + 1][1]); sa.w = cvt_pk_bf16_safe(S[2 * kk + 1][2], S[2 * kk + 1][3]);
                const bf16x8 sA = __builtin_bit_cast(bf16x8, sa);
                oT[0] = __builtin_amdgcn_mfma_f32_16x16x32_bf16(sA, qf[0][kk], oT[0], 0, 0, 0);
                oT[1] = __builtin_amdgcn_mfma_f32_16x16x32_bf16(sA, qf[1][kk], oT[1], 0, 0, 0);
            }
            u32x4 pb0, pb1;
            { float m0[4], m1[4];
#pragma unroll
              for (int r = 0; r < 4; ++r) { const bool ok = (4 * fq + r) <= fr; m0[r] = ok ? p00[r] : 0.f; m1[r] = ok ? p11[r] : 0.f; }
              pb0.x = cvt_pk_bf16_safe(m0[0], m0[1]); pb0.y = cvt_pk_bf16_safe(m0[2], m0[3]); pb0.z = 0u; pb0.w = 0u;
              pb1.x = cvt_pk_bf16_safe(p01[0], p01[1]); pb1.y = cvt_pk_bf16_safe(p01[2], p01[3]); pb1.z = cvt_pk_bf16_safe(m1[0], m1[1]); pb1.w = cvt_pk_bf16_safe(m1[2], m1[3]); }
            oT[0] = __builtin_amdgcn_mfma_f32_16x16x32_bf16(vt, __builtin_bit_cast(bf16x8, pb0), oT[0], 0, 0, 0);
            oT[1] = __builtin_amdgcn_mfma_f32_16x16x32_bf16(vt, __builtin_bit_cast(bf16x8, pb1), oT[1], 0, 0, 0);
#pragma unroll
            for (int ti = 0; ti < 2; ++ti) { const int tau = tau0 + 32 * n + 16 * ti + fr; const size_t row = (size_t)(row_base + (dir ? (Tn - 1 - tau) : tau));
                u32x2 w; w.x = cvt_pk_bf16_safe(oT[ti][0], oT[ti][1]); w.y = cvt_pk_bf16_safe(oT[ti][2], oT[ti][3]);
                *(u32x2*)(ob + row * 512 + h * 128 + 16 * wid + 4 * fq) = w; }
        }
#pragma unroll
        for (int t8 = 0; t8 < 8; ++t8) {
            const f32x4 dc = *(const LAS f32x4*)(lds + GL_DEC + (16 * t8 + 4 * fq) * 4);
            const bf16x8 ka = *(const LAS bf16x8*)(lds + GL_KETP + (16 * t8 + fr) * 80 + fq * 16);
            S[t8] = __builtin_amdgcn_mfma_f32_16x16x32_bf16(ka, vt, S[t8] * dc, 0, 0, 0);
        }
    }
#undef GLA_ISSUE
    if (dl_out && wid == 0) *(f32x2*)(dl_out + 2 * lane) = dsum;
    asm volatile("s_waitcnt vmcnt(0)" ::: "memory");
    GLA_BAR();
}
__device__ __forceinline__ void gla_state_store(float* p, const f32x4 (&S)[8], int wid, int fr, int fq) {
#pragma unroll
    for (int t8 = 0; t8 < 8; ++t8)
#pragma unroll
        for (int r = 0; r < 4; ++r) p[(size_t)(16 * t8 + 4 * fq + r) * 128 + 16 * wid + fr] = S[t8][r];
}
__device__ __forceinline__ void phase_gla_states(const Args& a, LAS uchar* lds, int bid, int wid, int lane) {
    uchar* ws = a.ws; const int fr = lane & 15, fq = lane >> 4;
    f32x4 S[8];
#pragma unroll
    for (int t8 = 0; t8 < 8; ++t8) S[t8] = (f32x4){0.f, 0.f, 0.f, 0.f};
    if (bid < 192) { const int bhd = bid / 3, seg = bid % 3, b = bhd >> 3, h = (bhd >> 1) & 3, dir = bhd & 1;
        const size_t pl = (size_t)(b * NH + h) * T * 128;
        gla_item<false>(lds, nullptr, (const _Float16*)(ws + (dir ? WS_LBW : WS_LF)) + pl, (const bf16_t*)(ws + WS_ZI) + pl, nullptr, S, (float*)(ws + WS_DL) + (size_t)bid * 128,
                        b * T, T, seg * 1024, 32, h, dir, wid, lane);
        gla_state_store((float*)(ws + WS_SL) + (size_t)bid * 16384, S, wid, fr, fq);
    } else { const int bhd = bid - 192, b = bhd >> 3, h = (bhd >> 1) & 3, dir = bhd & 1;
        const size_t pl = (size_t)(b * NH + h) * CT * 128;
        gla_item<false>(lds, nullptr, (const _Float16*)(ws + (dir ? WS_CLB : WS_CLF)) + pl, (const bf16_t*)(ws + WS_CI) + pl, nullptr, S, nullptr, b * CT, CT, 0, CT / 32, h, dir, wid, lane);
        gla_state_store((float*)(ws + WS_S0) + (size_t)bhd * 16384, S, wid, fr, fq);
    }
}
__device__ __forceinline__ void phase_gla_out(const Args& a, LAS uchar* lds, int bid, int wid, int lane) {
    uchar* ws = a.ws; const int fr = lane & 15, fq = lane >> 4;
    const int bhd = bid >> 2, seg = bid & 3, b = bhd >> 3, h = (bhd >> 1) & 3, dir = bhd & 1;
    f32x4 S[8];
    { const float* p = (const float*)(ws + WS_S0) + (size_t)bhd * 16384;
#pragma unroll
      for (int t8 = 0; t8 < 8; ++t8)
#pragma unroll
          for (int r = 0; r < 4; ++r) S[t8][r] = p[(size_t)(16 * t8 + 4 * fq + r) * 128 + 16 * wid + fr]; }
    for (int j = 0; j < seg; ++j) { const float* p = (const float*)(ws + WS_SL) + (size_t)(bhd * 3 + j) * 16384; const float* dl = (const float*)(ws + WS_DL) + (size_t)(bhd * 3 + j) * 128;
#pragma unroll
        for (int t8 = 0; t8 < 8; ++t8) { const f32x4 dv = *(const f32x4*)(dl + 16 * t8 + 4 * fq);
#pragma unroll
            for (int r = 0; r < 4; ++r) S[t8][r] = __builtin_amdgcn_exp2f(dv[r]) * S[t8][r] + p[(size_t)(16 * t8 + 4 * fq + r) * 128 + 16 * wid + fr]; } }
    asm volatile("s_waitcnt vmcnt(0)" ::: "memory");
    const size_t pl = (size_t)(b * NH + h) * T * 128;
    gla_item<true>(lds, (const bf16_t*)(ws + WS_ZQ) + pl, (const _Float16*)(ws + (dir ? WS_LBW : WS_LF)) + pl, (const bf16_t*)(ws + WS_ZI) + pl, (bf16_t*)(ws + (dir ? WS_OB : WS_OF)), S, nullptr,
                   b * T, T, seg * 1024, 32, h, dir, wid, lane);
}

__device__ __forceinline__ void unpack8(const u32x4 w, float (&f)[8]) { f[0] = bf_lo(w.x); f[1] = bf_hi(w.x); f[2] = bf_lo(w.y); f[3] = bf_hi(w.y); f[4] = bf_lo(w.z); f[5] = bf_hi(w.z); f[6] = bf_lo(w.w); f[7] = bf_hi(w.w); }
__device__ __forceinline__ void phase_mixfin(const Args& a, int bid, int G, int wid, int lane) {
    const bf16_t* of = (const bf16_t*)(a.ws + WS_OF); const bf16_t* obw = (const bf16_t*)(a.ws + WS_OB); const bf16_t* zg = (const bf16_t*)(a.ws + WS_ZG);
    const bf16_t* zgb = (const bf16_t*)(a.ws + WS_ZGB); const bf16_t* zgc = (const bf16_t*)(a.ws + WS_ZGC);
    bf16_t* A2 = (bf16_t*)(a.ws + WS_ACT);
    const int c0 = 8 * lane;
    float gain[8], cw0[8], cw1[8], cw2[8];
#pragma unroll
    for (int j = 0; j < 8; ++j) { gain[j] = a.hg_norm[(c0 + j) & 127]; cw0[j] = a.conv_w[c0 + j]; cw1[j] = a.conv_w[512 + c0 + j]; cw2[j] = a.conv_w[1024 + c0 + j]; }
    for (int row = bid * 8 + wid; row < M; row += G * 8) {
        const size_t ro = (size_t)row * 512 + c0;
        float f0[8], f1[8], gg[8], o[8];
        unpack8(__builtin_nontemporal_load((const u32x4*)(of + ro)), f0); unpack8(__builtin_nontemporal_load((const u32x4*)(obw + ro)), f1); unpack8(__builtin_nontemporal_load((const u32x4*)(zg + ro)), gg);
        float ss = 0.f;
#pragma unroll
        for (int j = 0; j < 8; ++j) { o[j] = f0[j] + f1[j]; ss += o[j] * o[j]; }
        ss += __shfl_xor(ss, 1); ss += __shfl_xor(ss, 2); ss += __shfl_xor(ss, 4); ss += __shfl_xor(ss, 8);
        const float rstd = rsqrtf(ss * (1.f / 128.f) + EPS);
#pragma unroll
        for (int j = 0; j < 8; ++j) o[j] = o[j] * rstd * gain[j] * silu_f(gg[j]);
        u32x4 w; w.x = cvt_pk_bf16(o[0], o[1]); w.y = cvt_pk_bf16(o[2], o[3]); w.z = cvt_pk_bf16(o[4], o[5]); w.w = cvt_pk_bf16(o[6], o[7]);
        *(u32x4*)(A2 + (size_t)row * D + c0) = w;
        const int tw = row & 63;
        float um[8], u0[8], up[8], gb[8], y[8];
        unpack8(*(const u32x4*)(zgc + ro), u0); unpack8(__builtin_nontemporal_load((const u32x4*)(zgb + ro)), gb);
        if (tw > 0) unpack8(*(const u32x4*)(zgc + ro - 512), um);
        else {
#pragma unroll
            for (int j = 0; j < 8; ++j) um[j] = 0.f; }
        if (tw < 63) unpack8(*(const u32x4*)(zgc + ro + 512), up);
        else {
#pragma unroll
            for (int j = 0; j < 8; ++j) up[j] = 0.f; }
#pragma unroll
        for (int j = 0; j < 8; ++j) y[j] = gb[j] * (cw0[j] * um[j] + cw1[j] * u0[j] + cw2[j] * up[j]);
        w.x = cvt_pk_bf16(y[0], y[1]); w.y = cvt_pk_bf16(y[2], y[3]); w.z = cvt_pk_bf16(y[4], y[5]); w.w = cvt_pk_bf16(y[6], y[7]);
        *(u32x4*)(A2 + (size_t)row * D + 512 + c0) = w;
    }
}

__device__ __forceinline__ void phase_router(const Args& a, LAS uchar* lds, int bid, int tid, int wid, int lane) {
    const float* modf = (const float*)(a.ws + WS_MODF);
    LAS float* gm = (LAS float*)lds; LAS float* sh = gm + D;
    LAS uchar* wrl = lds + 8192;
    const int b = bid / 32;
    for (int cidx = tid; cidx < D; cidx += 512) { sh[cidx] = modf[(size_t)b * NMOD + 3 * D + cidx]; gm[cidx] = a.norm_ffn[cidx] * (1.f + modf[(size_t)b * NMOD + 4 * D + cidx]); }
    for (int i = tid; i < D * 4; i += 512) { const int col = i >> 2, q4 = i & 3; *(LAS f32x4*)(wrl + col * 64 + (col >> 2) * 16 + q4 * 16) = *(const f32x4*)(a.w_router + col * 16 + q4 * 4); }
    __syncthreads();
    uchar* hx2 = a.ws + WS_ACT; float* aff = (float*)(a.ws + WS_AFF);
    for (int jb = 0; jb < 4; ++jb) {
        const int row0 = bid * 128 + wid * 16 + jb * 4;
        f32x4 v[4][4]; float rstd[4];
#pragma unroll
        for (int i = 0; i < 4; ++i) { const float* xrow = a.out + (size_t)(row0 + i) * D; float ss = 0.f;
#pragma unroll
            for (int jj = 0; jj < 4; ++jj) { v[i][jj] = __builtin_nontemporal_load((const f32x4*)xrow + lane + 64 * jj); ss += (v[i][jj].x * v[i][jj].x + v[i][jj].y * v[i][jj].y) + (v[i][jj].z * v[i][jj].z + v[i][jj].w * v[i][jj].w); }
            rstd[i] = ss; }
#pragma unroll
        for (int i = 0; i < 4; ++i) rstd[i] = rsqrtf(wave_sum(rstd[i]) * (1.f / D) + EPS);
        float pl[64];
#pragma unroll
        for (int e = 0; e < 64; ++e) pl[e] = 0.f;
#pragma unroll
        for (int jj = 0; jj < 4; ++jj) { const f32x4 g4 = *((const LAS f32x4*)gm + lane + 64 * jj), s4 = *((const LAS f32x4*)sh + lane + 64 * jj);
#pragma unroll
            for (int i = 0; i < 4; ++i) { v[i][jj] = v[i][jj] * rstd[i] * g4 + s4;
                *((unsigned*)(hx2 + (size_t)(row0 + i) * D) + lane + 64 * jj) = cvt_pk4_fp8(v[i][jj].x, v[i][jj].y, v[i][jj].z, v[i][jj].w); }
            const int colb = 4 * lane + 256 * jj;
#pragma unroll
            for (int cc = 0; cc < 4; ++cc) { const int col = colb + cc; const LAS uchar* wp = wrl + col * 64 + (col >> 2) * 16;
#pragma unroll
                for (int q4 = 0; q4 < 4; ++q4) { const f32x4 w4 = *(const LAS f32x4*)(wp + q4 * 16);
#pragma unroll
                    for (int i = 0; i < 4; ++i) { const float hvv = v[i][jj][cc]; pl[i * 16 + q4 * 4 + 0] += hvv * w4.x; pl[i * 16 + q4 * 4 + 1] += hvv * w4.y; pl[i * 16 + q4 * 4 + 2] += hvv * w4.z; pl[i * 16 + q4 * 4 + 3] += hvv * w4.w; } } } }
#pragma unroll
        for (int k = 0; k < 32; ++k) { const bool hi = (lane & 32) != 0; const float keep = hi ? pl[32 + k] : pl[k], send = hi ? pl[k] : pl[32 + k]; pl[k] = keep + __shfl_xor(send, 32); }
#pragma unroll
        for (int k = 0; k < 16; ++k) { const bool hi = (lane & 16) != 0; const float keep = hi ? pl[16 + k] : pl[k], send = hi ? pl[k] : pl[16 + k]; pl[k] = keep + __shfl_xor(send, 16); }
#pragma unroll
        for (int k = 0; k < 8; ++k) { const bool hi = (lane & 8) != 0; const float keep = hi ? pl[8 + k] : pl[k], send = hi ? pl[k] : pl[8 + k]; pl[k] = keep + __shfl_xor(send, 8); }
#pragma unroll
        for (int k = 0; k < 4; ++k) { const bool hi = (lane & 4) != 0; const float keep = hi ? pl[4 + k] : pl[k], send = hi ? pl[k] : pl[4 + k]; pl[k] = keep + __shfl_xor(send, 4); }
#pragma unroll
        for (int k = 0; k < 2; ++k) { const bool hi = (lane & 2) != 0; const float keep = hi ? pl[2 + k] : pl[k], send = hi ? pl[k] : pl[2 + k]; pl[k] = keep + __shfl_xor(send, 2); }
        { const bool hi = (lane & 1) != 0; const float keep = hi ? pl[1] : pl[0], send = hi ? pl[0] : pl[1]; pl[0] = keep + __shfl_xor(send, 1); }
        const float lg = pl[0];
        float mx = lg;
#pragma unroll
        for (int o = 1; o < 16; o <<= 1) mx = fmaxf(mx, __shfl_xor(mx, o));
        const float ex = __expf(lg - mx); float den = ex;
#pragma unroll
        for (int o = 1; o < 16; o <<= 1) den += __shfl_xor(den, o);
        const int t = (row0 + (lane >> 4)) & (T - 1);
        aff[((size_t)b * NE + (lane & 15)) * T + t] = ex / den;
    }
    __syncthreads();
}

__device__ __forceinline__ void topk_item(const Args& a, LAS uchar* lds, int b, int e, int tid, int wid, int lane) {
    LAS unsigned* key = (LAS unsigned*)lds;
    LAS unsigned* hist = key + 4096;
    LAS unsigned* ctl = hist + 256;
    LAS unsigned* wsum = ctl + 8;
    const float* affp = (const float*)(a.ws + WS_AFF) + ((size_t)b * NE + e) * T;
    unsigned kv[8];
    { const u32x4 k0 = *(const u32x4*)(affp + tid * 8), k1 = *(const u32x4*)(affp + tid * 8 + 4); kv[0] = k0.x; kv[1] = k0.y; kv[2] = k0.z; kv[3] = k0.w; kv[4] = k1.x; kv[5] = k1.y; kv[6] = k1.z; kv[7] = k1.w; }
    unsigned prefix = 0u, mask = 0u, need = CAP;
    for (int shift = 24; shift >= 0; shift -= 8) {
        if (tid < 256) hist[tid] = 0u;
        __syncthreads();
#pragma unroll
        for (int j = 0; j < 8; ++j) if ((kv[j] & mask) == prefix) __hip_atomic_fetch_add(&hist[(kv[j] >> shift) & 255u], 1u, __ATOMIC_RELAXED, __HIP_MEMORY_SCOPE_WORKGROUP);
        __syncthreads();
        if (tid < 256) { unsigned above = 0u; for (int bb = tid + 1; bb < 256; ++bb) above += hist[bb]; const unsigned mine = hist[tid];
            if (above < need && need <= above + mine) { ctl[0] = (unsigned)tid; ctl[1] = need - above; } }
        __syncthreads();
        prefix |= ctl[0] << shift; mask |= 255u << shift; need = ctl[1];
        __syncthreads();
    }
    unsigned cg_ = 0u, ce_ = 0u;
#pragma unroll
    for (int j = 0; j < 8; ++j) { cg_ += kv[j] > prefix; ce_ += kv[j] == prefix; }
    unsigned pk = cg_ | (ce_ << 16), incl = pk;
#pragma unroll
    for (int o = 1; o < 64; o <<= 1) { const unsigned t2 = __shfl_up(incl, o); if (lane >= o) incl += t2; }
    if (lane == 63) wsum[wid] = incl;
    __syncthreads();
    unsigned base = 0u;
    for (int w = 0; w < wid; ++w) base += wsum[w];
    unsigned excl = base + incl - pk; unsigned ng = excl & 0xffffu, neq = excl >> 16;
    int* seltok = (int*)(a.ws + WS_SELTOK); float* selgate = (float*)(a.ws + WS_SELGATE); short* pos = (short*)(a.ws + WS_POS);
#pragma unroll
    for (int j = 0; j < 8; ++j) { const int t = tid * 8 + j; const bool gt = kv[j] > prefix, eq = kv[j] == prefix; const bool sel = gt || (eq && neq < need);
        int slot = -1;
        if (sel) slot = (int)(ng + (neq < need ? neq : need));
        if (sel) { seltok[e * 4096 + b * 512 + slot] = b * T + t; selgate[e * 4096 + b * 512 + slot] = __uint_as_float(kv[j]); }
        pos[((size_t)b * T + t) * 16 + e] = (short)slot;
        ng += gt; neq += eq; }
    __syncthreads();
}
__device__ __forceinline__ void phase_topk_cvt(const Args& a, LAS uchar* lds, int bid, int G, int tid, int wid, int lane) {
    if (bid < 128) topk_item(a, lds, bid / 16, bid % 16, tid, wid, lane);
    LAS float* scr = (LAS float*)(lds + 32768) + wid * (64 * 33);
    uchar* wgu = a.ws + WS_WGU; uchar* wdn = a.ws + WS_WDN;
    constexpr int I_G = (D / 64) * (DFF / 32);
    constexpr int I_D = (DFF / 64) * (D / 32);
    constexpr int PER_E = 2 * I_G + I_D, TOTAL = NE * PER_E;
    static_assert(TOTAL == 1024 * 22 + 1024 * 26, "item split");
    const bool tk = bid < 128; const int wi = (tk ? bid : bid - 128) * 8 + wid;
    const int cnt = tk ? 22 : 26, base = tk ? 1024 * 26 : 0;
    for (int k = 0; k < cnt; ++k) { const int it = base + k * 1024 + wi;
        const int e = it / PER_E; int r = it % PER_E;
        if (r < 2 * I_G) { const int up = r >= I_G; if (up) r -= I_G; const int nblk = DFF / 32, kb = r / nblk, nb = r % nblk, n0 = nb * 32;
            const float* W = (up ? a.w_up : a.w_gate) + (size_t)e * D * DFF;
            cvt_item_fp8(W, DFF, wgu + (size_t)e * 4096 * D, D, kb * 64, n0, (n0 >> 7) * 256 + (n0 & 127) + (up ? 128 : 0), scr, lane); }
        else { r -= 2 * I_G; const int nblk = D / 32, kb = r / nblk, nb = r % nblk;
            cvt_item_fp8(a.w_down + (size_t)e * DFF * D, D, wdn + (size_t)e * D * DFF, DFF, kb * 64, nb * 32, nb * 32, scr, lane); }
    }
    __syncthreads();
}

__device__ __forceinline__ void phase_final(const Args& a, int bid, int G, int wid, int lane) {
    const float* modf = (const float*)(a.ws + WS_MODF); const short* pos = (const short*)(a.ws + WS_POS); const bf16_t* ys = (const bf16_t*)(a.ws + WS_YS);
    f32x4 nf[4];
#pragma unroll
    for (int q = 0; q < 4; ++q) nf[q] = *(const f32x4*)(a.norm_final + (q >> 1) * 512 + 8 * lane + (q & 1) * 4);
    for (int row = bid * 8 + wid; row < M; row += G * 8) {
        const int b = row / T; float* xrow = a.out + (size_t)row * D;
        f32x4 v[4], acc[4];
#pragma unroll
        for (int q = 0; q < 4; ++q) { v[q] = __builtin_nontemporal_load((const f32x4*)(xrow + (q >> 1) * 512 + 8 * lane + (q & 1) * 4)); acc[q] = (f32x4){0.f, 0.f, 0.f, 0.f}; }
        const int myslot = (lane < 16) ? (int)pos[(size_t)row * 16 + lane] : -1;
        unsigned long long mask = __ballot(myslot >= 0);
        while (mask) {
            int ee[4], sl[4];
#pragma unroll
            for (int k = 0; k < 4; ++k) { if (mask) { ee[k] = __builtin_ctzll(mask); mask &= mask - 1; sl[k] = __shfl(myslot, ee[k]); } else { ee[k] = -1; sl[k] = 0; } }
            u32x4 w[4][2];
#pragma unroll
            for (int k = 0; k < 4; ++k) if (ee[k] >= 0) { const bf16_t* yr = ys + ((size_t)ee[k] * 4096 + b * 512 + sl[k]) * D + 8 * lane; w[k][0] = __builtin_nontemporal_load((const u32x4*)yr); w[k][1] = __builtin_nontemporal_load((const u32x4*)(yr + 512)); }
#pragma unroll
            for (int k = 0; k < 4; ++k) if (ee[k] >= 0) {
#pragma unroll
                for (int hf = 0; hf < 2; ++hf) { const u32x4 ww = w[k][hf];
                    acc[2 * hf].x += bf_lo(ww.x); acc[2 * hf].y += bf_hi(ww.x); acc[2 * hf].z += bf_lo(ww.y); acc[2 * hf].w += bf_hi(ww.y);
                    acc[2 * hf + 1].x += bf_lo(ww.z); acc[2 * hf + 1].y += bf_hi(ww.z); acc[2 * hf + 1].z += bf_lo(ww.w); acc[2 * hf + 1].w += bf_hi(ww.w); } }
        }
        float ss = 0.f;
#pragma unroll
        for (int q = 0; q < 4; ++q) { const f32x4 g2 = *(const f32x4*)(modf + (size_t)b * NMOD + 5 * D + (q >> 1) * 512 + 8 * lane + (q & 1) * 4); v[q] = v[q] + g2 * acc[q];
            ss += (v[q].x * v[q].x + v[q].y * v[q].y) + (v[q].z * v[q].z + v[q].w * v[q].w); }
        const float rstd = rsqrtf(wave_sum(ss) * (1.f / D) + EPS);
#pragma unroll
        for (int q = 0; q < 4; ++q) __builtin_nontemporal_store(v[q] * rstd * nf[q], (f32x4*)(xrow + (q >> 1) * 512 + 8 * lane + (q & 1) * 4));
    }
}

__global__ void __launch_bounds__(512, 2) mega_fwd(Args a) {
    extern __shared__ __attribute__((aligned(16))) uchar lds_raw[];
    LAS uchar* lds = (LAS uchar*)lds_raw;
    const int tid = threadIdx.x, lane = tid & 63, wid = __builtin_amdgcn_readfirstlane(tid >> 6), bid = blockIdx.x, G = gridDim.x;
    const int lo = a.ph_lo, hi = a.ph_hi;
    uchar* ws = a.ws;
#define IN(k) (lo <= (k) && (k) < hi)
#define SEAM(k) do { if (IN(k) && IN((k) + 1)) xcd_barrier(xbar); } while (0)
    if (tid < 2) ((volatile LAS unsigned*)(lds + (LDS_BYTES - 16)))[tid] = 0u;
    __syncthreads();
    XcdBarrier xbar = xcd_barrier_post((unsigned*)(ws + WS_BAR), (volatile LAS unsigned*)(lds + (LDS_BYTES - 16)));
    if (IN(0)) phase_prep(a, lds, bid, G, tid, wid, lane);
    SEAM(0);
    if (IN(1)) phase_norm(a, lds, bid, G, tid, wid, lane);
    SEAM(1);
    if (IN(2)) {
        {
            pg8::Gemm g{(const bf16_t*)(ws + WS_ACT), (const bf16_t*)(ws + WS_WIN), D, 0, nullptr};
            pg8::GroupOrder S; S.init(M / 256, NIN / 256, 1, G, bid);
            pg8::EpiInproj E{ws + WS_ZQ, nullptr, (_Float16*)(ws + WS_LF), (_Float16*)(ws + WS_LBW), (const float*)(ws + WS_LB), 0, T};
            pg8::gemm_phase<pg8::EpiInproj, false>(lds, g, S, E);
        }
    }
    SEAM(2);
    if (IN(3)) {
        unsigned* cnt = (unsigned*)(ws + WS_BAR + 14336);
        if (bid >= 192 && bid < 240) {
            pg8::Gemm g{(const bf16_t*)(ws + WS_HC), (const bf16_t*)(ws + WS_WIN) + (size_t)512 * D, D, 0, nullptr};
            pg8::GroupOrder S; S.init(MC / 256, 1536 / 256, 1, 48, bid - 192);
            pg8::EpiInproj E{nullptr, (bf16_t*)(ws + WS_CI), (_Float16*)(ws + WS_CLF), (_Float16*)(ws + WS_CLB), (const float*)(ws + WS_LB), 1, CT};
            pg8::gemm_phase<pg8::EpiInproj, false>(lds, g, S, E);
            pg8::Unit u; S.next(0, u);
            asm volatile("s_waitcnt vmcnt(0)" ::: "memory"); __syncthreads();
            if (tid == 0) { __builtin_amdgcn_fence(__ATOMIC_RELEASE, "agent"); asm volatile("s_waitcnt vmcnt(0)" ::: "memory");
                __hip_atomic_fetch_add(cnt + 64 * u.pm, 1u, __ATOMIC_RELAXED, __HIP_MEMORY_SCOPE_AGENT); }
        }
        if (bid >= 192) {
            const int b = (bid - 192) >> 3;
            if (tid == 0) { unsigned sp = 0; while (__hip_atomic_load(cnt + 64 * b, __ATOMIC_RELAXED, __HIP_MEMORY_SCOPE_AGENT) < 6u && ++sp < (1u << 22)) __builtin_amdgcn_s_sleep(2);
                __builtin_amdgcn_fence(__ATOMIC_ACQUIRE, "agent"); asm volatile("s_waitcnt vmcnt(0)" ::: "memory"); }
            __syncthreads();
        }
        phase_gla_states(a, lds, bid, wid, lane);
    }
    SEAM(3);
    if (IN(4)) phase_gla_out(a, lds, bid, wid, lane);
    SEAM(4);
    if (IN(5)) phase_mixfin(a, bid, G, wid, lane);
    SEAM(5);
    if (IN(6)) {
        pg8::Gemm g{(const bf16_t*)(ws + WS_ACT), (const bf16_t*)(ws + WS_WOUT), D, 0, nullptr};
        pg8::GroupOrder S; S.init(M / 256, D / 256, 1, G, bid);
        pg8::EpiOut E{a.x, a.out, (const float*)(ws + WS_MODF)};
        pg8::gemm_phase<pg8::EpiOut, false>(lds, g, S, E);
    }
    SEAM(6);
    if (IN(7)) phase_router(a, lds, bid, tid, wid, lane);
    SEAM(7);
    if (IN(8)) phase_topk_cvt(a, lds, bid, G, tid, wid, lane);
    SEAM(8);
    if (IN(9)) {
        pg8::Gemm g{(const bf16_t*)(ws + WS_ACT), (const bf16_t*)(ws + WS_WGU), D / 2, (size_t)4096 * D, (const int*)(ws + WS_SELTOK)};
        pg8::GroupOrder S; S.init(16, 16, NE, G, bid);
        pg8::EpiMoe1 E{ws + WS_HID};
        pg8::gemm_phase<pg8::EpiMoe1, true, pg8::GroupOrder, true>(lds, g, S, E);
    }
    SEAM(9);
    if (IN(10)) {
        pg8::Gemm g{(const bf16_t*)(ws + WS_HID), (const bf16_t*)(ws + WS_WDN), DFF / 2, (size_t)D * DFF, nullptr};
        pg8::Moe2Order S{bid};
        LAS float* lg = (LAS float*)(lds + pg8::STAGE_BYTES);
        { pg8::Unit tu; for (int uu = 0; uu < 4 && S.next(uu, tu); ++uu) if (tid < 256) lg[uu * 256 + tid] = ((const float*)(ws + WS_SELGATE))[tu.pm * 256 + tid]; }
        __syncthreads();
        pg8::EpiMoe2 E{(bf16_t*)(ws + WS_YS), lg};
        pg8::gemm_phase<pg8::EpiMoe2, false, pg8::Moe2Order, true>(lds, g, S, E);
    }
    SEAM(10);
    if (IN(11)) phase_final(a, bid, G, wid, lane);

#undef IN
#undef SEAM
}

#ifndef N_LAUNCHES
#define N_LAUNCHES 1
#endif
extern "C" void kernel_launch(void* const* d_in, const int* in_sizes, int n_in, void* d_out, int out_size, void* d_ws, size_t ws_size, hipStream_t stream) {
    static int grid = 0;
    if (grid == 0) {
        if (n_in != 18 || out_size != M * D || ws_size < WS_END) { fprintf(stderr, "kernel_launch: unexpected shapes (n_in %d out %d ws %zu)\n", n_in, out_size, ws_size); grid = -1; return; }
        int dev = 0, cus = 0, per_cu = 0;
        (void)hipGetDevice(&dev); (void)hipDeviceGetAttribute(&cus, hipDeviceAttributeMultiprocessorCount, dev);
        (void)hipFuncSetAttribute((const void*)mega_fwd, hipFuncAttributeMaxDynamicSharedMemorySize, LDS_BYTES);
        (void)hipOccupancyMaxActiveBlocksPerMultiprocessor(&per_cu, (const void*)mega_fwd, 512, LDS_BYTES);
        if (per_cu < 1) { fprintf(stderr, "kernel_launch: occupancy query says %d blocks per CU\n", per_cu); grid = -1; return; }
        grid = 256;
        if (cus != 256) fprintf(stderr, "kernel_launch: note: %d CUs (built for 256)\n", cus);
    }
    if (grid < 0) return;
    Args a{};
    a.x = (const float*)d_in[0]; a.c = (const float*)d_in[1]; a.ctx = (const float*)d_in[2]; a.c_ctx = (const float*)d_in[3]; a.w_ada = (const float*)d_in[4]; a.b_ada = (const float*)d_in[5];
    a.norm_mix = (const float*)d_in[6]; a.norm_ffn = (const float*)d_in[7]; a.w_in = (const float*)d_in[8]; a.lb_logits = (const float*)d_in[9]; a.hg_norm = (const float*)d_in[10];
    a.conv_w = (const float*)d_in[11]; a.w_out = (const float*)d_in[12]; a.w_router = (const float*)d_in[13]; a.w_gate = (const float*)d_in[14]; a.w_up = (const float*)d_in[15];
    a.w_down = (const float*)d_in[16]; a.norm_final = (const float*)d_in[17]; a.out = (float*)d_out; a.ws = (uchar*)d_ws;
    if (N_LAUNCHES == 1) {
        (void)hipMemsetAsync((char*)d_ws + WS_BAR, 0, 16384, stream);
        a.ph_lo = 0; a.ph_hi = NPHASE;
        hipLaunchKernelGGL(mega_fwd, dim3(grid), dim3(512), LDS_BYTES, stream, a);
    } else {
        for (int p = 0; p < NPHASE; ++p) { a.ph_lo = p; a.ph_hi = p + 1; void* args[] = {&a};
            hipError_t e = hipLaunchCooperativeKernel((const void*)mega_fwd, dim3(grid), dim3(512), args, LDS_BYTES, stream);
            if (e != hipSuccess) { fprintf(stderr, "launch %d failed: %s\n", p, hipGetErrorString(e)); break; } }
    }
}
```

```cpp
#include <hip/hip_runtime.h>
#include <cstdio>

#define LAS __attribute__((address_space(3)))
#define GAS __attribute__((address_space(1)))
typedef unsigned short bf16_t;
typedef short bf16x8 __attribute__((ext_vector_type(8)));
typedef float f32x4 __attribute__((ext_vector_type(4)));
typedef float f32x2 __attribute__((ext_vector_type(2)));
typedef unsigned u32x4 __attribute__((ext_vector_type(4)));
typedef unsigned u32x2 __attribute__((ext_vector_type(2)));
typedef unsigned char uchar;
typedef int i32x8 __attribute__((ext_vector_type(8)));
typedef int i32x4 __attribute__((ext_vector_type(4)));

constexpr int D = 1024, NB = 8, T = 4096, M = NB * T, CT = 256, MC = NB * CT;
constexpr int NIN = 4096, HK = 512, NH = 4, NE = 16, CAP = 512, DFF = 2048, NMOD = 6 * D;
constexpr float EPS = 1e-6f;
constexpr int NPHASE = 12;

constexpr size_t MiB = 1u << 20;
constexpr size_t WS_ACT = 0;
constexpr size_t WS_WIN = 64 * MiB;
constexpr size_t WS_WOUT = 72 * MiB;
constexpr size_t WS_MODP = 74 * MiB;
constexpr size_t WS_MODF = 76 * MiB;
constexpr size_t WS_LB = 76 * MiB + 512 * 1024;
constexpr size_t WS_HC = 77 * MiB;
constexpr size_t WS_CLF = 81 * MiB;
constexpr size_t WS_CLB = 85 * MiB;
constexpr size_t WS_CI = 89 * MiB;
constexpr size_t WS_S0 = 91 * MiB;
constexpr size_t WS_AFF = 95 * MiB;
constexpr size_t WS_SELTOK = 97 * MiB;
constexpr size_t WS_SELGATE = 97 * MiB + 256 * 1024;
constexpr size_t WS_POS = 98 * MiB;
constexpr size_t WS_BAR = 100 * MiB;
constexpr size_t WS_SL = 488 * MiB;
constexpr size_t WS_DL = 500 * MiB;
constexpr size_t WS_ZQ = 104 * MiB;
constexpr size_t WS_LF = 136 * MiB;
constexpr size_t WS_LBW = 200 * MiB;
constexpr size_t WS_ZI = 264 * MiB;
constexpr size_t WS_ZG = 296 * MiB;
constexpr size_t WS_ZGB = 328 * MiB;
constexpr size_t WS_ZGC = 360 * MiB;
constexpr size_t WS_ZV = 392 * MiB;
constexpr size_t WS_OF = 424 * MiB;
constexpr size_t WS_OB = 456 * MiB;
constexpr size_t WS_WGU = 104 * MiB;
constexpr size_t WS_WDN = 232 * MiB;
constexpr size_t WS_HID = 296 * MiB;
constexpr size_t WS_YS = WS_WGU;
constexpr size_t WS_X1B = 424 * MiB;
constexpr size_t WS_END = 552 * MiB;
static_assert(WS_ZI == WS_ZQ + 160 * MiB && WS_ZG == WS_ZI + 32 * MiB && WS_ZGB == WS_ZG + 32 * MiB && WS_ZGC == WS_ZGB + 32 * MiB && WS_ZV == WS_ZGC + 32 * MiB, "z segment map");

constexpr int LDS_BYTES = 147456;

typedef __bf16 bf16x2_t __attribute__((ext_vector_type(2)));
__device__ __forceinline__ unsigned cvt_pk_bf16_safe(float lo, float hi) { typedef float f2_t __attribute__((ext_vector_type(2))); const bf16x2_t v = __builtin_convertvector((f2_t){lo, hi}, bf16x2_t); return __builtin_bit_cast(unsigned, v); }
__device__ __forceinline__ unsigned cvt_pk_bf16(float lo, float hi) { unsigned r; asm volatile("v_cvt_pk_bf16_f32 %0, %1, %2" : "=v"(r) : "v"(lo), "v"(hi)); return r; }
__device__ __forceinline__ unsigned cvt_pk4_fp8(float a, float b, float c, float d) { unsigned r = 0u; asm volatile("v_cvt_pk_fp8_f32 %0, %1, %2\n\tv_cvt_pk_fp8_f32 %0, %3, %4 op_sel:[0,0,1]" : "+v"(r) : "v"(a), "v"(b), "v"(c), "v"(d)); return r; }
__device__ __forceinline__ float bf_lo(unsigned u) { return __uint_as_float(u << 16); }
__device__ __forceinline__ float bf_hi(unsigned u) { return __uint_as_float(u & 0xffff0000u); }
__device__ __forceinline__ float wave_sum(float v) {
#pragma unroll
    for (int o = 1; o < 64; o <<= 1) v += __shfl_xor(v, o);
    return v;
}
__device__ __forceinline__ float silu_f(float x) { return x * __builtin_amdgcn_rcpf(1.f + __builtin_amdgcn_exp2f(x * -1.44269504f)); }
#define LDS_WAIT() asm volatile("s_waitcnt lgkmcnt(0)" ::: "memory")


#define XB_TMO      128
#define XB_XCNT(j)  (256  + 64 * (j))
#define XB_XSUB(j)  (1280 + 64 * (j))
#define XB_XGEN(j)  (2304 + 64 * (j))
#define XB_TOP      3328
#define XB_TOPGEN   3392
#define XCD_BAR_WORDS 3456
#define XB_SPIN_CAP (1u << 20)
__device__ __forceinline__ unsigned xb_ld(unsigned* p)              { return __hip_atomic_load(p, __ATOMIC_RELAXED, __HIP_MEMORY_SCOPE_AGENT); }
__device__ __forceinline__ unsigned xb_add(unsigned* p, unsigned v) { return __hip_atomic_fetch_add(p, v, __ATOMIC_RELAXED, __HIP_MEMORY_SCOPE_AGENT); }
__device__ __forceinline__ unsigned xb_xcc_id() { return (unsigned)__builtin_amdgcn_s_getreg((3 << 11) | 20) & 0xFu; }
#define XB_SPIN(cond, bar) do { unsigned _sp = 0; while (cond) { __builtin_amdgcn_s_sleep(1); \
    if ((++_sp & 255u) == 0u) { if (xb_ld(&(bar)[XB_TMO])) break; if (_sp > XB_SPIN_CAP) { atomicAdd(&(bar)[XB_TMO], 1u); break; } } } } while (0)
struct XcdBarrier { unsigned* bar; unsigned x; volatile LAS unsigned* st; };
__device__ __forceinline__ XcdBarrier xcd_barrier_post(unsigned* bar, volatile LAS unsigned* st) {
    XcdBarrier b; b.bar = bar; b.x = xb_xcc_id(); b.st = st;
    if (threadIdx.x == 0) (void)xb_add(&bar[XB_XCNT(b.x)], 1u);
    return b;
}
__device__ __forceinline__ void xcd_barrier_complete(unsigned* bar, unsigned x, unsigned& nloc, unsigned& nx) {
    const unsigned G = gridDim.x * gridDim.y * gridDim.z;
    unsigned sum, cnt, mine, sp = 0u;
    for (;;) {
        sum = 0u; cnt = 0u; mine = 0u;
#pragma unroll
        for (unsigned j = 0; j < 16; ++j) { const unsigned c = xb_ld(&bar[XB_XCNT(j)]); sum += c; cnt += (c > 0u) ? 1u : 0u; mine = (j == x) ? c : mine; }
        if (sum == G) break;
        __builtin_amdgcn_s_sleep(1);
        if ((++sp & 255u) == 0u) { if (xb_ld(&bar[XB_TMO])) break; if (sp > XB_SPIN_CAP) { atomicAdd(&bar[XB_TMO], 1u); break; } }
    }
    nloc = mine > 0u ? mine : 1u; nx = cnt > 0u ? cnt : 1u;
}
__device__ __forceinline__ void xcd_barrier(const XcdBarrier& b) {
    asm volatile("s_waitcnt vmcnt(0)" ::: "memory");
    __syncthreads();
    if (threadIdx.x == 0) {
        unsigned* bar = b.bar;
        __builtin_amdgcn_s_waitcnt(0);
        unsigned nloc = b.st[0], nx = b.st[1];
        if (nloc == 0u) { xcd_barrier_complete(bar, b.x, nloc, nx); b.st[0] = nloc; b.st[1] = nx; }
        const unsigned old = xb_add(&bar[XB_XSUB(b.x)], 1u);
        const unsigned gen = old / nloc;
        if (old + 1u == (gen + 1u) * nloc) {
            __builtin_amdgcn_fence(__ATOMIC_RELEASE, "agent");
            asm volatile("s_waitcnt vmcnt(0)" ::: "memory");
            const unsigned og = xb_add(&bar[XB_TOP], 1u);
            const unsigned tg = og / nx;
            if (og + 1u == (tg + 1u) * nx) xb_add(&bar[XB_TOPGEN], 1u);
            else XB_SPIN(xb_ld(&bar[XB_TOPGEN]) == tg, bar);
            __builtin_amdgcn_fence(__ATOMIC_ACQUIRE, "agent");
            xb_add(&bar[XB_XGEN(b.x)], 1u);
            asm volatile("s_waitcnt vmcnt(0)" ::: "memory");
        } else {
            XB_SPIN(xb_ld(&bar[XB_XGEN(b.x)]) == gen, bar);
            __builtin_amdgcn_fence(__ATOMIC_ACQUIRE, "agent");
            asm volatile("s_waitcnt vmcnt(0)" ::: "memory");
        }
    }
    __syncthreads();
}

namespace pg8 {
constexpr int BM = 256, BK = 64, HALF = 128, HTB = HALF * BK * 2, STAGE_BYTES = 8 * HTB, NXCD = 8, WGM = 8;
__device__ __forceinline__ int lds_byte(int r, int c) { const int st = (r >> 4) * 2 + (c >> 5), rr = r & 15, cc = c & 31, ob = rr * 64 + cc * 2; return st * 1024 + (ob ^ (((ob >> 9) & 1) << 5)); }
__device__ __forceinline__ void stage_rc(int b, int& R, int& C) { const int st = b / 1024, sb = b % 1024, swz = sb ^ (((sb >> 9) & 1) << 5); R = (st >> 1) * 16 + swz / 64; C = (st & 1) * 32 + (swz % 64) / 2; }
__device__ __forceinline__ int perm32(int rho) { const int n = rho >> 4, i = rho & 15; return 8 * (i >> 2) + 4 * n + (i & 3); }

struct Unit { int pm, pn, e; };
struct GroupOrder {
    int nM, nN, ng, G, c;
    __device__ __forceinline__ void init(int nM_, int nN_, int ng_, int G_, int c_) { nM = nM_; nN = nN_; ng = ng_; G = G_; c = c_; }
    __device__ __forceinline__ bool next(int i, Unit& u) const {
        const int nwg = nM * nN; const long L = (long)i * G + c; if (L >= (long)nwg * ng) return false;
        const int grp = (int)(L / nwg); int wgid = (int)(L % nwg);
        { const int q = nwg / NXCD, r = nwg % NXCD, xcd = wgid % NXCD, off = wgid / NXCD; wgid = (xcd < r ? xcd * (q + 1) : r * (q + 1) + (xcd - r) * q) + off; }
        const int nig = WGM * nN, gid = wgid / nig, fm = gid * WGM, gsz = (nM - fm) < WGM ? (nM - fm) : WGM;
        u.pm = grp * nM + fm + ((wgid % nig) % gsz); u.pn = (wgid % nig) / gsz; u.e = grp; return true;
    }
};
struct Moe2Order {
    int c;
    __device__ __forceinline__ bool next(int i, Unit& u) const { if (i >= 4) return false; const int x = c & 7, j = c >> 3; u.e = 4 * i + (j >> 3); u.pm = u.e * 16 + 2 * x + ((j & 7) >> 2); u.pn = j & 3; return true; }
};
struct Gemm { const bf16_t* A; const bf16_t* Bt; int K; size_t bgs; const int* rowidx; };

template <class Epi, bool GATHER, class Sched = GroupOrder, bool FP8 = false>
__device__ __forceinline__ void gemm_phase(LAS uchar* lds, const Gemm g, const Sched& S, const Epi& E) {
    const int tid = threadIdx.x, wid = __builtin_amdgcn_readfirstlane(tid >> 6), lane = tid & 63, wr = wid >> 2, wc = wid & 3, fr = lane & 15, fq = lane >> 4;
    const int K = g.K, nt = K / BK;
    unsigned voffA[2], voffB[2]; int Rr[2], Cc[2];
#pragma unroll
    for (int i = 0; i < 2; ++i) { int R, C; stage_rc(tid * 16 + i * 8192, R, C); const int Rb = Epi::PERM ? ((R & ~31) + perm32(R & 31)) : R; Rr[i] = R; Cc[i] = C;
        voffA[i] = (unsigned)(R * K + C) * 2u; voffB[i] = (unsigned)(Rb * K + C) * 2u; }
    const size_t kstep = (size_t)(BK * 2);
    const size_t hstep = (size_t)HALF * K * 2;
    const size_t tstep = 2 * hstep;
    const unsigned ldsw = (unsigned)wid * 1024u;
    const int aoff = lds_byte(wr * 64 + fr, fq * 8), boff = lds_byte(wc * 32 + fr, fq * 8);
#define PG8_SA(b, h) (((b) * 2 + (h)) * HTB)
#define PG8_SB(b, h) ((4 + (b) * 2 + (h)) * HTB)
#define PG8_STAGE(bufoff, gbase, voff) do { _Pragma("unroll") for (int _i = 0; _i < 2; ++_i) \
        __builtin_amdgcn_global_load_lds((const unsigned*)((const char*)(gbase) + (voff)[_i]), (LAS unsigned*)(lds + (bufoff) + ldsw + _i * 8192), 16, 0, 0); } while (0)
#define PG8_STAGE_A(bufoff, p, ofs, h) do { if constexpr (GATHER) { PG8_STAGE(bufoff, p, (ofs)[h]); } else { PG8_STAGE(bufoff, (p) + (h) * hstep, voffA); } } while (0)
#define PG8_LD8(p) __builtin_shufflevector(*(const LAS i32x4*)(p), *(const LAS i32x4*)((p) + 1024), 0, 1, 2, 3, 4, 5, 6, 7)
#define PG8_LDA(dst, b, h) do { _Pragma("unroll") for (int m = 0; m < 4; ++m) dst[m] = PG8_LD8(lds + PG8_SA(b, h) + aoff + m * 2048); } while (0)
#define PG8_LDB(dst, b, h) do { _Pragma("unroll") for (int n = 0; n < 2; ++n) dst[n] = PG8_LD8(lds + PG8_SB(b, h) + boff + n * 2048); } while (0)
#define PG8_HALF(x, k) __builtin_bit_cast(bf16x8, (k) ? __builtin_shufflevector(x, x, 4, 5, 6, 7) : __builtin_shufflevector(x, x, 0, 1, 2, 3))
#define PG8_MMA(ai, bj, At, Bt) do { __builtin_amdgcn_s_setprio(1); _Pragma("unroll") for (int m = 0; m < 4; ++m) _Pragma("unroll") for (int n = 0; n < 2; ++n) { \
        if constexpr (FP8) acc[ai][bj][m][n] = __builtin_amdgcn_mfma_scale_f32_16x16x128_f8f6f4(Bt[n], At[m], acc[ai][bj][m][n], 0, 0, 0, 0x7f7f7f7f, 0, 0x7f7f7f7f); \
        else { acc[ai][bj][m][n] = __builtin_amdgcn_mfma_f32_16x16x32_bf16(PG8_HALF(Bt[n], 0), PG8_HALF(At[m], 0), acc[ai][bj][m][n], 0, 0, 0); \
               acc[ai][bj][m][n] = __builtin_amdgcn_mfma_f32_16x16x32_bf16(PG8_HALF(Bt[n], 1), PG8_HALF(At[m], 1), acc[ai][bj][m][n], 0, 0, 0); } } \
        if constexpr (FP8) { _Pragma("unroll") for (int m = 0; m < 4; ++m) _Pragma("unroll") for (int n = 0; n < 2; ++n) asm volatile("" : "+v"(acc[ai][bj][m][n])); }     \
        __builtin_amdgcn_s_setprio(0); } while (0)
#define PG8_WAIT_V(n) asm volatile("s_waitcnt vmcnt(" #n ")" ::: "memory")
#define PG8_WAIT_L(n) asm volatile("s_waitcnt lgkmcnt(" #n ")" ::: "memory")
#define PG8_BAR __builtin_amdgcn_s_barrier()
#define PG8_SCHED __builtin_amdgcn_sched_barrier(0)
    Unit cur, nxt; int ui = 0;
    if (!S.next(0, cur)) return;
    f32x4 acc[2][2][4][2];
#pragma unroll
    for (int a = 0; a < 2; ++a)
#pragma unroll
        for (int b = 0; b < 2; ++b)
#pragma unroll
            for (int m = 0; m < 4; ++m)
#pragma unroll
                for (int n = 0; n < 2; ++n) acc[a][b][m][n] = (f32x4){0.f, 0.f, 0.f, 0.f};
    i32x8 At[4], B0[2], B1[2];
    unsigned cofs[2][2], nofs[2][2];
    LAS unsigned short* ridx = (LAS unsigned short*)(lds + STAGE_BYTES);
    if constexpr (GATHER) {
        { Unit tu; for (int uu = 0; uu < 16 && S.next(uu, tu); ++uu) if (tid < BM) ridx[uu * BM + tid] = (unsigned short)g.rowidx[tu.pm * BM + tid]; }
        asm volatile("s_waitcnt vmcnt(0) lgkmcnt(0)" ::: "memory"); __builtin_amdgcn_s_barrier(); asm volatile("" ::: "memory");
#pragma unroll
        for (int h = 0; h < 2; ++h)
#pragma unroll
            for (int i = 0; i < 2; ++i) { const int row = ridx[h * HALF + Rr[i]]; cofs[h][i] = (unsigned)(row * K + Cc[i]) * 2u; nofs[h][i] = cofs[h][i]; }
    }
    const char* cA = GATHER ? (const char*)g.A : (const char*)g.A + (size_t)cur.pm * tstep;
    const char* cB = (const char*)g.Bt + (size_t)cur.e * g.bgs + (size_t)cur.pn * tstep;
    PG8_STAGE(PG8_SB(0, 0), cB, voffB); PG8_STAGE(PG8_SB(0, 1), cB + hstep, voffB); PG8_STAGE_A(PG8_SA(0, 0), cA, cofs, 0); PG8_STAGE_A(PG8_SA(0, 1), cA, cofs, 1);
    if (wr == 1) PG8_BAR;
    PG8_WAIT_V(2); PG8_BAR;
    PG8_STAGE(PG8_SB(1, 0), cB + kstep, voffB); PG8_STAGE_A(PG8_SA(1, 0), cA + kstep, cofs, 0); PG8_STAGE(PG8_SB(1, 1), cB + hstep + kstep, voffB);
    PG8_WAIT_V(6); PG8_BAR;
    for (;;) {
        const bool has_next = S.next(ui + 1, nxt);
        const char* nA = GATHER ? (const char*)g.A : (has_next ? (const char*)g.A + (size_t)nxt.pm * tstep : cA);
        const char* nB = has_next ? (const char*)g.Bt + (size_t)nxt.e * g.bgs + (size_t)nxt.pn * tstep : cB;
#pragma unroll 1
        for (int t = 0; t < nt; t += 2) {
            const bool last = (t == nt - 2);
            const char* a1 = cA + (size_t)(t + 1) * kstep;
            const char* a2 = last ? nA : cA + (size_t)(t + 2) * kstep; const char* b2 = last ? nB : cB + (size_t)(t + 2) * kstep;
            const char* a3 = a2 + kstep; const char* b3 = b2 + kstep;
            if constexpr (GATHER) {
                if (last && has_next) {
#pragma unroll
                    for (int h = 0; h < 2; ++h)
#pragma unroll
                        for (int i = 0; i < 2; ++i) { const int row = ridx[(ui + 1) * BM + h * HALF + Rr[i]]; nofs[h][i] = (unsigned)(row * K + Cc[i]) * 2u; }
                }
            }
            PG8_LDB(B0, 0, 0); PG8_LDB(B1, 0, 1); PG8_SCHED; PG8_LDA(At, 0, 0); PG8_STAGE_A(PG8_SA(1, 1), a1, cofs, 1);
            PG8_WAIT_V(8); PG8_WAIT_L(0); PG8_BAR; PG8_MMA(0, 0, At, B0); PG8_MMA(0, 1, At, B1); PG8_BAR; PG8_SCHED;
            PG8_LDA(At, 0, 1); PG8_STAGE(PG8_SB(0, 0), b2, voffB); PG8_STAGE(PG8_SB(0, 1), b2 + hstep, voffB);
            if (last) { PG8_STAGE_A(PG8_SA(0, 0), a2, nofs, 0); } else { PG8_STAGE_A(PG8_SA(0, 0), a2, cofs, 0); }
            PG8_WAIT_V(8); PG8_WAIT_L(0); PG8_BAR; PG8_MMA(1, 0, At, B0); PG8_MMA(1, 1, At, B1); PG8_BAR; PG8_SCHED;
            PG8_LDB(B0, 1, 0); PG8_LDB(B1, 1, 1); PG8_SCHED; PG8_LDA(At, 1, 0);
            if (last) { PG8_STAGE_A(PG8_SA(0, 1), a2, nofs, 1); } else { PG8_STAGE_A(PG8_SA(0, 1), a2, cofs, 1); }
            PG8_WAIT_V(8); PG8_WAIT_L(0); PG8_BAR; PG8_MMA(0, 0, At, B0); PG8_MMA(0, 1, At, B1); PG8_BAR; PG8_SCHED;
            PG8_LDA(At, 1, 1); PG8_STAGE(PG8_SB(1, 0), b3, voffB); PG8_STAGE(PG8_SB(1, 1), b3 + hstep, voffB);
            if (last) { PG8_STAGE_A(PG8_SA(1, 0), a3, nofs, 0); } else { PG8_STAGE_A(PG8_SA(1, 0), a3, cofs, 0); }
            PG8_WAIT_V(8); PG8_WAIT_L(0); PG8_BAR; PG8_MMA(1, 0, At, B0); PG8_MMA(1, 1, At, B1); PG8_BAR; PG8_SCHED;
        }
        if (wr == 0) PG8_BAR;
        E(acc, cur, wr, wc, fr, fq);
        if (!has_next) break;
#pragma unroll
        for (int a = 0; a < 2; ++a)
#pragma unroll
            for (int b = 0; b < 2; ++b)
#pragma unroll
                for (int m = 0; m < 4; ++m)
#pragma unroll
                    for (int n = 0; n < 2; ++n) acc[a][b][m][n] = (f32x4){0.f, 0.f, 0.f, 0.f};
        cur = nxt; cA = nA; cB = nB; ++ui;
        if constexpr (GATHER) {
#pragma unroll
            for (int h = 0; h < 2; ++h)
#pragma unroll
                for (int i = 0; i < 2; ++i) cofs[h][i] = nofs[h][i];
        }
        if (wr == 1) PG8_BAR;
    }
    PG8_WAIT_V(0);
    PG8_BAR;
#undef PG8_SA
#undef PG8_SB
#undef PG8_STAGE
#undef PG8_STAGE_A
#undef PG8_LD8
#undef PG8_HALF
#undef PG8_LDA
#undef PG8_LDB
#undef PG8_MMA
#undef PG8_WAIT_V
#undef PG8_WAIT_L
#undef PG8_BAR
#undef PG8_SCHED
}


struct EpiInproj {
    static constexpr bool PERM = true;
    uchar* zbase; bf16_t* ci; _Float16* olog0; _Float16* olog1; const float* lb; int seg0; int Tn;
    __device__ __forceinline__ void operator()(const f32x4 (&acc)[2][2][4][2], const Unit& u, int wr, int wc, int fr, int fq) const {
        const int seg = seg0 + (u.pn >> 1);
        const int row0 = u.pm * BM + wr * 64 + fr;
        if (seg <= 3) {
            const int b = (u.pm * BM) / Tn, t0 = row0 - b * Tn, dcol = wc * 32 + 8 * fq;
#pragma unroll
            for (int bj = 0; bj < 2; ++bj) { const int hh = (u.pn & 1) * 2 + bj; const size_t plane = (size_t)(b * NH + hh) * Tn;
                if (seg == 1 || seg == 2) {
                    _Float16* O = (seg == 1) ? olog0 : olog1; const float* lbp = lb + (seg - 1) * 512 + hh * 128 + dcol;
                    const f32x4 l0 = *(const f32x4*)lbp, l1 = *(const f32x4*)(lbp + 4);
#pragma unroll
                    for (int ai = 0; ai < 2; ++ai)
#pragma unroll
                        for (int m = 0; m < 4; ++m) { const f32x4 v0 = acc[ai][bj][m][0], v1 = acc[ai][bj][m][1]; _Float16 o[8];
#pragma unroll
                            for (int j = 0; j < 4; ++j) { const float s0 = __builtin_amdgcn_rcpf(1.f + __builtin_amdgcn_exp2f(v0[j] * -1.44269504f)), s1 = __builtin_amdgcn_rcpf(1.f + __builtin_amdgcn_exp2f(v1[j] * -1.44269504f));
                                o[j] = (_Float16)__builtin_amdgcn_logf(l0[j] + (1.f - l0[j]) * s0); o[4 + j] = (_Float16)__builtin_amdgcn_logf(l1[j] + (1.f - l1[j]) * s1); }
                            __builtin_nontemporal_store(__builtin_bit_cast(u32x4, o), (u32x4*)(O + (plane + t0 + ai * HALF + m * 16) * 128 + dcol)); }
                } else {
                    bf16_t* O = zbase ? (bf16_t*)(zbase + (size_t)(seg == 0 ? 0 : 160) * MiB) : ci;
#pragma unroll
                    for (int ai = 0; ai < 2; ++ai)
#pragma unroll
                        for (int m = 0; m < 4; ++m) { const f32x4 v0 = acc[ai][bj][m][0], v1 = acc[ai][bj][m][1];
                            u32x4 w; w.x = cvt_pk_bf16(v0[0], v0[1]); w.y = cvt_pk_bf16(v0[2], v0[3]); w.z = cvt_pk_bf16(v1[0], v1[1]); w.w = cvt_pk_bf16(v1[2], v1[3]);
                            __builtin_nontemporal_store(w, (u32x4*)(O + (plane + t0 + ai * HALF + m * 16) * 128 + dcol)); }
                }
            }
        } else if (seg >= 6) {
            const int col0 = (u.pn - 12) * 128 + wc * 32 + 8 * fq;
            bf16_t* O = (bf16_t*)(zbase + (size_t)(32 * 6 + 64) * MiB);
#pragma unroll
            for (int ai = 0; ai < 2; ++ai)
#pragma unroll
                for (int m = 0; m < 4; ++m) { const f32x4 v0 = acc[ai][0][m][0] * acc[ai][1][m][0], v1 = acc[ai][0][m][1] * acc[ai][1][m][1];
                    u32x4 w; w.x = cvt_pk_bf16(v0[0], v0[1]); w.y = cvt_pk_bf16(v0[2], v0[3]); w.z = cvt_pk_bf16(v1[0], v1[1]); w.w = cvt_pk_bf16(v1[2], v1[3]);
                    __builtin_nontemporal_store(w, (u32x4*)(O + (size_t)(row0 + ai * HALF + m * 16) * 512 + col0)); }
        } else {
            const int col0 = (u.pn & 1) * 256 + wc * 32 + 8 * fq;
            bf16_t* O = (bf16_t*)(zbase + (size_t)(32 * seg + 64) * MiB);
#pragma unroll
            for (int ai = 0; ai < 2; ++ai)
#pragma unroll
                for (int m = 0; m < 4; ++m) { bf16_t* rowp = O + (size_t)(row0 + ai * HALF + m * 16) * 512 + col0;
#pragma unroll
                    for (int bj = 0; bj < 2; ++bj) { const f32x4 v0 = acc[ai][bj][m][0], v1 = acc[ai][bj][m][1];
                        u32x4 w; w.x = cvt_pk_bf16(v0[0], v0[1]); w.y = cvt_pk_bf16(v0[2], v0[3]); w.z = cvt_pk_bf16(v1[0], v1[1]); w.w = cvt_pk_bf16(v1[2], v1[3]);
                        __builtin_nontemporal_store(w, (u32x4*)(rowp + bj * HALF)); } }
        }
    }
};
struct EpiOut {
    static constexpr bool PERM = true;
    const float* x; bf16_t* x1; const float* modf;
    __device__ __forceinline__ void operator()(const f32x4 (&acc)[2][2][4][2], const Unit& u, int wr, int wc, int fr, int fq) const {
        const int row0 = u.pm * BM + wr * 64 + fr, col0 = u.pn * BM + wc * 32 + 8 * fq;
        const int b = (u.pm * BM) / T;
        const float* g1 = modf + (size_t)b * NMOD + 2 * D;
        f32x4 gv[2][2];
#pragma unroll
        for (int bj = 0; bj < 2; ++bj)
#pragma unroll
            for (int n = 0; n < 2; ++n) gv[bj][n] = *(const f32x4*)(g1 + col0 + bj * HALF + 4 * n);
#pragma unroll
        for (int ai = 0; ai < 2; ++ai)
#pragma unroll
            for (int m = 0; m < 4; ++m) { const size_t off = (size_t)(row0 + ai * HALF + m * 16) * D + col0;
#pragma unroll
                for (int bj = 0; bj < 2; ++bj) {
                    const f32x4 x0 = __builtin_nontemporal_load((const f32x4*)(x + off + bj * HALF)), x1v = __builtin_nontemporal_load((const f32x4*)(x + off + bj * HALF + 4));
                    const f32x4 v0 = x0 + gv[bj][0] * acc[ai][bj][m][0], v1 = x1v + gv[bj][1] * acc[ai][bj][m][1];
                    u32x4 w; w.x = cvt_pk_bf16(v0[0], v0[1]); w.y = cvt_pk_bf16(v0[2], v0[3]); w.z = cvt_pk_bf16(v1[0], v1[1]); w.w = cvt_pk_bf16(v1[2], v1[3]);
                    __builtin_nontemporal_store(w, (u32x4*)(x1 + off + bj * HALF)); }
                asm volatile("" ::: "memory"); }
    }
};
struct EpiMoe1 {
    static constexpr bool PERM = true;
    uchar* hid;
    __device__ __forceinline__ void operator()(const f32x4 (&acc)[2][2][4][2], const Unit& u, int wr, int wc, int fr, int fq) const {
        const int row0 = u.pm * BM + wr * 64 + fr, col0 = u.pn * 128 + wc * 32 + 8 * fq;
#pragma unroll
        for (int ai = 0; ai < 2; ++ai)
#pragma unroll
            for (int m = 0; m < 4; ++m) { uchar* rowp = hid + (size_t)(row0 + ai * HALF + m * 16) * DFF + col0;
                float o[8];
#pragma unroll
                for (int n = 0; n < 2; ++n)
#pragma unroll
                    for (int j = 0; j < 4; ++j) { const float gt = acc[ai][0][m][n][j] * 0.03125f, up = acc[ai][1][m][n][j] * 0.03125f; o[n * 4 + j] = gt * up * __builtin_amdgcn_rcpf(1.f + __builtin_amdgcn_exp2f(gt * -1.44269504f)); }
                u32x2 w; w.x = cvt_pk4_fp8(o[0], o[1], o[2], o[3]); w.y = cvt_pk4_fp8(o[4], o[5], o[6], o[7]);
                __builtin_nontemporal_store(w, (u32x2*)rowp); }
    }
};
struct EpiMoe2 {
    static constexpr bool PERM = true;
    uchar* ys; const LAS float* lgate;
    __device__ __forceinline__ void operator()(const f32x4 (&acc)[2][2][4][2], const Unit& u, int wr, int wc, int fr, int fq) const {
        const int row0 = u.pm * BM + wr * 64 + fr, col0 = u.pn * BM + wc * 32 + 8 * fq;
        const LAS float* gt_ = lgate + (u.e >> 2) * BM + wr * 64 + fr;
#pragma unroll
        for (int ai = 0; ai < 2; ++ai)
#pragma unroll
            for (int m = 0; m < 4; ++m) { const int row = row0 + ai * HALF + m * 16; const float gt = gt_[ai * HALF + m * 16] * 0.5f; uchar* rowp = ys + (size_t)row * D + col0;
#pragma unroll
                for (int bj = 0; bj < 2; ++bj) { const f32x4 v0 = acc[ai][bj][m][0] * gt, v1 = acc[ai][bj][m][1] * gt;
                    u32x2 w; w.x = cvt_pk4_fp8(v0[0], v0[1], v0[2], v0[3]); w.y = cvt_pk4_fp8(v1[0], v1[1], v1[2], v1[3]);
                    __builtin_nontemporal_store(w, (u32x2*)(rowp + bj * HALF)); } }
    }
};
}

struct Args {
    const float *x, *c, *ctx, *c_ctx, *w_ada, *b_ada, *norm_mix, *norm_ffn, *w_in, *lb_logits, *hg_norm, *conv_w, *w_out, *w_router, *w_gate, *w_up, *w_down, *norm_final;
    float* out; uchar* ws; int ph_lo, ph_hi;
};

__device__ __forceinline__ void cvt_item(const float* W, int ldw, bf16_t* WT, int ldt, int k0, int n0, int nrow0, LAS float* scr, int lane) {
    const int r = lane >> 3, c4 = lane & 7;
    f32x4 v[8];
#pragma unroll
    for (int i = 0; i < 8; ++i) v[i] = __builtin_nontemporal_load((const f32x4*)(W + (size_t)(k0 + 8 * i + r) * ldw + n0 + 4 * c4));
#pragma unroll
    for (int i = 0; i < 8; ++i) { LAS float* d = scr + (8 * i + r) * 33 + 4 * c4; d[0] = v[i].x; d[1] = v[i].y; d[2] = v[i].z; d[3] = v[i].w; }
    LDS_WAIT(); asm volatile("" ::: "memory");
    const int c = lane & 7;
#pragma unroll
    for (int j = 0; j < 4; ++j) { const int n = (lane >> 3) + 8 * j; const LAS float* sp = scr + (8 * c) * 33 + n;
        u32x4 o; o.x = cvt_pk_bf16(sp[0 * 33], sp[1 * 33]); o.y = cvt_pk_bf16(sp[2 * 33], sp[3 * 33]); o.z = cvt_pk_bf16(sp[4 * 33], sp[5 * 33]); o.w = cvt_pk_bf16(sp[6 * 33], sp[7 * 33]);
        *(u32x4*)(WT + (size_t)(nrow0 + n) * ldt + k0 + 8 * c) = o; }
    LDS_WAIT(); asm volatile("" ::: "memory");
}

__device__ __forceinline__ void cvt_item_fp8(const float* W, int ldw, uchar* WT, int ldt, int k0, int n0, int nrow0, LAS float* scr, int lane) {
    const int r = lane >> 3, c4 = lane & 7;
    f32x4 v[8];
#pragma unroll
    for (int i = 0; i < 8; ++i) v[i] = __builtin_nontemporal_load((const f32x4*)(W + (size_t)(k0 + 8 * i + r) * ldw + n0 + 4 * c4));
#pragma unroll
    for (int i = 0; i < 8; ++i) { LAS float* d = scr + (8 * i + r) * 33 + 4 * c4; d[0] = v[i].x; d[1] = v[i].y; d[2] = v[i].z; d[3] = v[i].w; }
    LDS_WAIT(); asm volatile("" ::: "memory");
    const int c = lane & 7;
#pragma unroll
    for (int j = 0; j < 4; ++j) { const int n = (lane >> 3) + 8 * j; const LAS float* sp = scr + (8 * c) * 33 + n;
        u32x2 o; o.x = cvt_pk4_fp8(sp[0 * 33] * 32.f, sp[1 * 33] * 32.f, sp[2 * 33] * 32.f, sp[3 * 33] * 32.f); o.y = cvt_pk4_fp8(sp[4 * 33] * 32.f, sp[5 * 33] * 32.f, sp[6 * 33] * 32.f, sp[7 * 33] * 32.f);
        *(u32x2*)(WT + (size_t)(nrow0 + n) * ldt + k0 + 8 * c) = o; }
    LDS_WAIT(); asm volatile("" ::: "memory");
}

__device__ __forceinline__ void phase_prep(const Args& a, LAS uchar* lds, int bid, int G, int tid, int wid, int lane) {
    float* modp = (float*)(a.ws + WS_MODP);
    if (bid < 192) {
        const int cgp = bid % 24, ks = bid / 24, n0 = cgp * 256 + lane * 4, k0 = ks * 128 + wid * 16;
        LAS float* sc = (LAS float*)(lds + 81920);
        for (int i = tid; i < 9 * 128; i += 512) { const int r = i >> 7, kk = i & 127; sc[i] = silu_f((r < 8) ? a.c[r * D + ks * 128 + kk] : a.c_ctx[ks * 128 + kk]); }
        f32x4 w[16];
#pragma unroll
        for (int kk = 0; kk < 16; ++kk) w[kk] = __builtin_nontemporal_load((const f32x4*)(a.w_ada + (size_t)(k0 + kk) * NMOD + n0));
        __syncthreads();
        f32x4 acc[9];
#pragma unroll
        for (int r = 0; r < 9; ++r) acc[r] = (f32x4){0.f, 0.f, 0.f, 0.f};
#pragma unroll
        for (int kk = 0; kk < 16; ++kk) {
#pragma unroll
            for (int r = 0; r < 9; ++r) acc[r] += w[kk] * sc[r * 128 + wid * 16 + kk]; }
        LAS f32x4* red = (LAS f32x4*)lds;
#pragma unroll
        for (int r = 0; r < 9; ++r) red[(wid * 9 + r) * 64 + lane] = acc[r];
        __syncthreads();
        for (int o = tid; o < 9 * 64; o += 512) { const int r = o / 64, l = o % 64; f32x4 sm = red[(0 * 9 + r) * 64 + l];
#pragma unroll
            for (int w8 = 1; w8 < 8; ++w8) sm += red[(w8 * 9 + r) * 64 + l];
            if (ks == 0) sm += *(const f32x4*)(a.b_ada + cgp * 256 + l * 4);
            *(f32x4*)(modp + ((size_t)ks * 9 + r) * NMOD + cgp * 256 + l * 4) = sm; }
        __syncthreads();
    }
    if (bid == 255) {
        float* lb = (float*)(a.ws + WS_LB);
        for (int i = tid; i < 1024; i += 512) { const float l0 = a.lb_logits[i], l1 = a.lb_logits[1024 + i]; lb[i] = 1.f / (1.f + __expf(l1 - l0)); }
    }
    LAS float* scr = (LAS float*)lds + wid * (64 * 33);
    const int gw = (G - 1 - bid) * 8 + wid, NGW = G * 8;
    constexpr int I_IN = (D / 64) * (NIN / 32), I_OUT = (D / 64) * (D / 32);
    for (int it = gw; it < I_IN + I_OUT; it += NGW) {
        if (it < I_IN) { const int nblk = NIN / 32, kb = it / nblk, nb = it % nblk; const int n0 = nb * 32;
            const int nrow = (n0 < 3072) ? n0 : 3072 + (((n0 - 3072) & 511) >> 7) * 256 + ((n0 - 3072) & 127) + ((n0 >= 3584) ? 128 : 0);
            cvt_item(a.w_in, NIN, (bf16_t*)(a.ws + WS_WIN), D, kb * 64, n0, nrow, scr, lane); }
        else { const int r = it - I_IN, nblk = D / 32, kb = r / nblk, nb = r % nblk; cvt_item(a.w_out, D, (bf16_t*)(a.ws + WS_WOUT), D, kb * 64, nb * 32, nb * 32, scr, lane); }
    }
}

__device__ __forceinline__ float modp_sum(const float* modp, int r, int col) { float s = 0.f;
#pragma unroll
    for (int ks = 0; ks < 8; ++ks) s += modp[((size_t)ks * 9 + r) * NMOD + col];
    return s; }
template <int NR>
__device__ __forceinline__ void norm_rows(const float* xrow0, bf16_t* orow0, const LAS float* gm, const LAS float* sh, int lane) {
    f32x4 v[NR][4]; float ss[NR];
#pragma unroll
    for (int i = 0; i < NR; ++i) { ss[i] = 0.f;
#pragma unroll
        for (int j = 0; j < 4; ++j) v[i][j] = __builtin_nontemporal_load((const f32x4*)(xrow0 + (size_t)i * D) + lane + 64 * j); }
#pragma unroll
    for (int i = 0; i < NR; ++i) {
#pragma unroll
        for (int j = 0; j < 4; ++j) ss[i] += (v[i][j].x * v[i][j].x + v[i][j].y * v[i][j].y) + (v[i][j].z * v[i][j].z + v[i][j].w * v[i][j].w);
        ss[i] = rsqrtf(wave_sum(ss[i]) * (1.f / D) + EPS); }
#pragma unroll
    for (int j = 0; j < 4; ++j) { const f32x4 g4 = *((const LAS f32x4*)gm + lane + 64 * j), s4 = *((const LAS f32x4*)sh + lane + 64 * j);
#pragma unroll
        for (int i = 0; i < NR; ++i) { const f32x4 o = v[i][j] * ss[i] * g4 + s4;
            u32x2 w; w.x = cvt_pk_bf16(o.x, o.y); w.y = cvt_pk_bf16(o.z, o.w); *((u32x2*)(orow0 + (size_t)i * D) + lane + 64 * j) = w; } }
}
__device__ __forceinline__ void phase_norm(const Args& a, LAS uchar* lds, int bid, int G, int tid, int wid, int lane) {
    const float* modp = (const float*)(a.ws + WS_MODP); float* modf = (float*)(a.ws + WS_MODF);
    { const int gt = bid * 512 + tid; if (gt < 9 * NMOD) modf[gt] = modp_sum(modp, gt / NMOD, gt % NMOD); }
    LAS float* gm = (LAS float*)lds; LAS float* sh = gm + D; LAS float* cgm = sh + D; LAS float* csh = cgm + D;
    const int b = bid / 32;
    for (int cidx = tid; cidx < D; cidx += 512) { const float nm = a.norm_mix[cidx];
        sh[cidx] = modp_sum(modp, b, cidx); gm[cidx] = nm * (1.f + modp_sum(modp, b, D + cidx));
        csh[cidx] = modp_sum(modp, 8, cidx); cgm[cidx] = nm * (1.f + modp_sum(modp, 8, D + cidx)); }
    __syncthreads();
    bf16_t* hx = (bf16_t*)(a.ws + WS_ACT); bf16_t* hc = (bf16_t*)(a.ws + WS_HC);
    { const int row = bid * 8 + wid; norm_rows<1>(a.ctx + (size_t)row * D, hc + (size_t)row * D, cgm, csh, lane); }
    for (int j = 0; j < 16; j += 4) { const int row = bid * 128 + wid * 16 + j; norm_rows<4>(a.x + (size_t)row * D, hx + (size_t)row * D, gm, sh, lane); }
    __syncthreads();
}

constexpr int GL_QDP = 0, GL_KIP = 8704, GL_KETP = 17408, GL_VTP = 27648, GL_DEC = 37888, GL_TOT = 38400, GL_RING = 43008, GL_SLOT = 24576;
#define GLA_BAR() do { asm volatile("s_waitcnt lgkmcnt(0)" ::: "memory"); __builtin_amdgcn_s_barrier(); asm volatile("" ::: "memory"); } while (0)
template <bool FULL>
__device__ __forceinline__ void gla_item(LAS uchar* lds, const bf16_t* qb, const _Float16* lfb, const bf16_t* vb, bf16_t* ob, f32x4 (&S)[8], float* dl_out,
                                         int row_base, int Tn, int tau0, int nch, int h, int dir, int wid, int lane) {
    const int fr = lane & 15, fq = lane >> 4;
#define GLA_ISSUE(c) do { LAS uchar* _sl = lds + GL_RING + ((c) & 3) * GL_SLOT + wid * 3072; \
        const int _tau = tau0 + 32 * (c) + 4 * wid + (lane >> 4); const size_t _o = (size_t)(dir ? (Tn - 1 - _tau) : _tau) * 128 + (lane & 15) * 8; \
        __builtin_amdgcn_global_load_lds((const unsigned*)(lfb + _o), (LAS unsigned*)(_sl), 16, 0, 2); \
        if (FULL) __builtin_amdgcn_global_load_lds((const unsigned*)(qb + _o), (LAS unsigned*)(_sl + 1024), 16, 0, 2); \
        __builtin_amdgcn_global_load_lds((const unsigned*)(vb + _o), (LAS unsigned*)(_sl + 2048), 16, 0, 2); } while (0)
    GLA_ISSUE(0);
    if (nch > 1) GLA_ISSUE(1);
    if (nch > 2) GLA_ISSUE(2);
    const int d0 = 2 * lane, pos0 = (d0 & ~31) + 8 * ((d0 >> 2) & 3) + 4 * ((d0 >> 4) & 1) + (d0 & 3);
    const int spos = 8 * (wid & 3) + 4 * (wid >> 2);
    f32x2 dsum = (f32x2){0.f, 0.f};
    for (int n = 0; n < nch; ++n) {
        if (n + 2 < nch) { if (FULL) asm volatile("s_waitcnt vmcnt(6)" ::: "memory"); else asm volatile("s_waitcnt vmcnt(4)" ::: "memory"); }
        else if (n + 1 < nch) { if (FULL) asm volatile("s_waitcnt vmcnt(3)" ::: "memory"); else asm volatile("s_waitcnt vmcnt(2)" ::: "memory"); }
        else asm volatile("s_waitcnt vmcnt(0)" ::: "memory");
        const LAS uchar* sl = lds + GL_RING + (n & 3) * GL_SLOT + wid * 3072;
        f32x2 lf[4];
#pragma unroll
        for (int rr = 0; rr < 4; ++rr) { typedef _Float16 h2_t __attribute__((ext_vector_type(2))); const h2_t hv = *(const LAS h2_t*)(sl + rr * 256 + lane * 4); lf[rr] = (f32x2){(float)hv.x, (float)hv.y}; }
        f32x2 c[4]; c[0] = lf[0]; c[1] = c[0] + lf[1]; c[2] = c[1] + lf[2]; c[3] = c[2] + lf[3];
        LAS f32x2* tot = (LAS f32x2*)(lds + GL_TOT);
        tot[wid * 64 + lane] = c[3];
        unsigned qv[4], vv[4];
#pragma unroll
        for (int rr = 0; rr < 4; ++rr) { vv[rr] = *(const LAS unsigned*)(sl + 2048 + rr * 256 + lane * 4); qv[rr] = FULL ? *(const LAS unsigned*)(sl + 1024 + rr * 256 + lane * 4) : 0u; }
        GLA_BAR();
        if (n + 3 < nch) GLA_ISSUE(n + 3);
        f32x2 pre = (f32x2){0.f, 0.f}, all = (f32x2){0.f, 0.f};
#pragma unroll
        for (int w = 0; w < 8; ++w) { const f32x2 tw = tot[w * 64 + lane]; all += tw; if (w < wid) pre += tw; }
        dsum += all;
        const f32x2 decall = (f32x2){__builtin_amdgcn_exp2f(all.x), __builtin_amdgcn_exp2f(all.y)};
        f32x2 kE[4];
#pragma unroll
        for (int rr = 0; rr < 4; ++rr) {
            const f32x2 cum = pre + c[rr];
            const f32x2 k = 1.f - (f32x2){__builtin_amdgcn_exp2f(lf[rr].x), __builtin_amdgcn_exp2f(lf[rr].y)};
            const f32x2 ki = k * (f32x2){__builtin_amdgcn_exp2f(-cum.x), __builtin_amdgcn_exp2f(-cum.y)};
            kE[rr] = ki * decall;
            if (FULL) { const int s = 4 * wid + rr; const f32x2 qd = (f32x2){bf_lo(qv[rr]), bf_hi(qv[rr])} * (f32x2){__builtin_amdgcn_exp2f(cum.x), __builtin_amdgcn_exp2f(cum.y)};
                *(LAS unsigned*)(lds + GL_QDP + s * 272 + pos0 * 2) = cvt_pk_bf16(qd.x, qd.y);
                *(LAS unsigned*)(lds + GL_KIP + s * 272 + pos0 * 2) = cvt_pk_bf16(ki.x, ki.y); }
        }
        { u32x2 w0, w1; w0.x = cvt_pk_bf16(kE[0].x, kE[1].x); w0.y = cvt_pk_bf16(kE[2].x, kE[3].x); w1.x = cvt_pk_bf16(kE[0].y, kE[1].y); w1.y = cvt_pk_bf16(kE[2].y, kE[3].y);
          *(LAS u32x2*)(lds + GL_KETP + (d0) * 80 + spos * 2) = w0; *(LAS u32x2*)(lds + GL_KETP + (d0 + 1) * 80 + spos * 2) = w1;
          u32x2 v0, v1; v0.x = (vv[0] & 0xffffu) | (vv[1] << 16); v0.y = (vv[2] & 0xffffu) | (vv[3] << 16);
          v1.x = (vv[0] >> 16) | (vv[1] & 0xffff0000u); v1.y = (vv[2] >> 16) | (vv[3] & 0xffff0000u);
          *(LAS u32x2*)(lds + GL_VTP + (d0) * 80 + spos * 2) = v0; *(LAS u32x2*)(lds + GL_VTP + (d0 + 1) * 80 + spos * 2) = v1; }
        if (wid == 0) *(LAS f32x2*)(lds + GL_DEC + lane * 8) = decall;
        GLA_BAR();
        const bf16x8 vt = *(const LAS bf16x8*)(lds + GL_VTP + (16 * wid + fr) * 80 + fq * 16);
        if (FULL) {
            bf16x8 qf[2][4];
#pragma unroll
            for (int ti = 0; ti < 2; ++ti)
#pragma unroll
                for (int kk = 0; kk < 4; ++kk) qf[ti][kk] = *(const LAS bf16x8*)(lds + GL_QDP + (16 * ti + fr) * 272 + kk * 64 + fq * 16);
            f32x4 oT[2] = {(f32x4){0.f, 0.f, 0.f, 0.f}, (f32x4){0.f, 0.f, 0.f, 0.f}};
            f32x4 p00 = (f32x4){0.f, 0.f, 0.f, 0.f}, p01 = p00, p11 = p00;
#pragma unroll
            for (int kk = 0; kk < 4; ++kk) {
                const bf16x8 kj0 = *(const LAS bf16x8*)(lds + GL_KIP + (fr) * 272 + kk * 64 + fq * 16);
                const bf16x8 kj1 = *(const LAS bf16x8*)(lds + GL_KIP + (16 + fr) * 272 + kk * 64 + fq * 16);
                p00 = __builtin_amdgcn_mfma_f32_16x16x32_bf16(kj0, qf[0][kk], p00, 0, 0, 0);
                p01 = __builtin_amdgcn_mfma_f32_16x16x32_bf16(kj0, qf[1][kk], p01, 0, 0, 0);
                p11 = __builtin_amdgcn_mfma_f32_16x16x32_bf16(kj1, qf[1][kk], p11, 0, 0, 0);
                u32x4 sa; sa.x = cvt_pk_bf16_safe(S[2 * kk][0], S[2 * kk][1]); sa.y = cvt_pk_bf16_safe(S[2 * kk][2], S[2 * kk][3]);
                sa.z = cvt_pk_bf16_safe(S[2 * kk + 1][0], S[2 * kk + 1][1]); sa.w = cvt_pk_bf16_safe(S[2 * kk + 1][2], S[2 * kk + 1][3]);
                const bf16x8 sA = __builtin_bit_cast(bf16x8, sa);
                oT[0] = __builtin_amdgcn_mfma_f32_16x16x32_bf16(sA, qf[0][kk], oT[0], 0, 0, 0);
                oT[1] = __builtin_amdgcn_mfma_f32_16x16x32_bf16(sA, qf[1][kk], oT[1], 0, 0, 0);
            }
            u32x4 pb0, pb1;
            { float m0[4], m1[4];
#pragma unroll
              for (int r = 0; r < 4; ++r) { const bool ok = (4 * fq + r) <= fr; m0[r] = ok ? p00[r] : 0.f; m1[r] = ok ? p11[r] : 0.f; }
              pb0.x = cvt_pk_bf16_safe(m0[0], m0[1]); pb0.y = cvt_pk_bf16_safe(m0[2], m0[3]); pb0.z = 0u; pb0.w = 0u;
              pb1.x = cvt_pk_bf16_safe(p01[0], p01[1]); pb1.y = cvt_pk_bf16_safe(p01[2], p01[3]); pb1.z = cvt_pk_bf16_safe(m1[0], m1[1]); pb1.w = cvt_pk_bf16_safe(m1[2], m1[3]); }
            oT[0] = __builtin_amdgcn_mfma_f32_16x16x32_bf16(vt, __builtin_bit_cast(bf16x8, pb0), oT[0], 0, 0, 0);
            oT[1] = __builtin_amdgcn_mfma_f32_16x16x32_bf16(vt, __builtin_bit_cast(bf16x8, pb1), oT[1], 0, 0, 0);
#pragma unroll
            for (int ti = 0; ti < 2; ++ti) { const int tau = tau0 + 32 * n + 16 * ti + fr; const size_t row = (size_t)(row_base + (dir ? (Tn - 1 - tau) : tau));
                u32x2 w; w.x = cvt_pk_bf16_safe(oT[ti][0], oT[ti][1]); w.y = cvt_pk_bf16_safe(oT[ti][2], oT[ti][3]);
                *(u32x2*)(ob + row * 512 + h * 128 + 16 * wid + 4 * fq) = w; }
        }
#pragma unroll
        for (int t8 = 0; t8 < 8; ++t8) {
            const f32x4 dc = *(const LAS f32x4*)(lds + GL_DEC + (16 * t8 + 4 * fq) * 4);
            const bf16x8 ka = *(const LAS bf16x8*)(lds + GL_KETP + (16 * t8 + fr) * 80 + fq * 16);
            S[t8] = __builtin_amdgcn_mfma_f32_16x16x32_bf16(ka, vt, S[t8] * dc, 0, 0, 0);
        }
    }
#undef GLA_ISSUE
    if (dl_out && wid == 0) *(f32x2*)(dl_out + 2 * lane) = dsum;
    asm volatile("s_waitcnt vmcnt(0)" ::: "memory");
    GLA_BAR();
}
__device__ __forceinline__ void gla_state_store(float* p, const f32x4 (&S)[8], int wid, int fr, int fq) {
#pragma unroll
    for (int t8 = 0; t8 < 8; ++t8)
#pragma unroll
        for (int r = 0; r < 4; ++r) p[(size_t)(16 * t8 + 4 * fq + r) * 128 + 16 * wid + fr] = S[t8][r];
}
__device__ __forceinline__ void phase_gla_states(const Args& a, LAS uchar* lds, int bid, int wid, int lane) {
    uchar* ws = a.ws; const int fr = lane & 15, fq = lane >> 4;
    f32x4 S[8];
#pragma unroll
    for (int t8 = 0; t8 < 8; ++t8) S[t8] = (f32x4){0.f, 0.f, 0.f, 0.f};
    if (bid < 192) { const int bhd = bid / 3, seg = bid % 3, b = bhd >> 3, h = (bhd >> 1) & 3, dir = bhd & 1;
        const size_t pl = (size_t)(b * NH + h) * T * 128;
        gla_item<false>(lds, nullptr, (const _Float16*)(ws + (dir ? WS_LBW : WS_LF)) + pl, (const bf16_t*)(ws + WS_ZI) + pl, nullptr, S, (float*)(ws + WS_DL) + (size_t)bid * 128,
                        b * T, T, seg * 1024, 32, h, dir, wid, lane);
        gla_state_store((float*)(ws + WS_SL) + (size_t)bid * 16384, S, wid, fr, fq);
    } else { const int bhd = bid - 192, b = bhd >> 3, h = (bhd >> 1) & 3, dir = bhd & 1;
        const size_t pl = (size_t)(b * NH + h) * CT * 128;
        gla_item<false>(lds, nullptr, (const _Float16*)(ws + (dir ? WS_CLB : WS_CLF)) + pl, (const bf16_t*)(ws + WS_CI) + pl, nullptr, S, nullptr, b * CT, CT, 0, CT / 32, h, dir, wid, lane);
        gla_state_store((float*)(ws + WS_S0) + (size_t)bhd * 16384, S, wid, fr, fq);
    }
}
__device__ __forceinline__ void phase_gla_out(const Args& a, LAS uchar* lds, int bid, int wid, int lane) {
    uchar* ws = a.ws; const int fr = lane & 15, fq = lane >> 4;
    const int bhd = bid >> 2, seg = bid & 3, b = bhd >> 3, h = (bhd >> 1) & 3, dir = bhd & 1;
    f32x4 S[8];
    { const float* p = (const float*)(ws + WS_S0) + (size_t)bhd * 16384;
#pragma unroll
      for (int t8 = 0; t8 < 8; ++t8)
#pragma unroll
          for (int r = 0; r < 4; ++r) S[t8][r] = p[(size_t)(16 * t8 + 4 * fq + r) * 128 + 16 * wid + fr]; }
    for (int j = 0; j < seg; ++j) { const float* p = (const float*)(ws + WS_SL) + (size_t)(bhd * 3 + j) * 16384; const float* dl = (const float*)(ws + WS_DL) + (size_t)(bhd * 3 + j) * 128;
#pragma unroll
        for (int t8 = 0; t8 < 8; ++t8) { const f32x4 dv = *(const f32x4*)(dl + 16 * t8 + 4 * fq);
#pragma unroll
            for (int r = 0; r < 4; ++r) S[t8][r] = __builtin_amdgcn_exp2f(dv[r]) * S[t8][r] + p[(size_t)(16 * t8 + 4 * fq + r) * 128 + 16 * wid + fr]; } }
    asm volatile("s_waitcnt vmcnt(0)" ::: "memory");
    const size_t pl = (size_t)(b * NH + h) * T * 128;
    gla_item<true>(lds, (const bf16_t*)(ws + WS_ZQ) + pl, (const _Float16*)(ws + (dir ? WS_LBW : WS_LF)) + pl, (const bf16_t*)(ws + WS_ZI) + pl, (bf16_t*)(ws + (dir ? WS_OB : WS_OF)), S, nullptr,
                   b * T, T, seg * 1024, 32, h, dir, wid, lane);
}

__device__ __forceinline__ void unpack8(const u32x4 w, float (&f)[8]) { f[0] = bf_lo(w.x); f[1] = bf_hi(w.x); f[2] = bf_lo(w.y); f[3] = bf_hi(w.y); f[4] = bf_lo(w.z); f[5] = bf_hi(w.z); f[6] = bf_lo(w.w); f[7] = bf_hi(w.w); }
__device__ __forceinline__ void phase_mixfin(const Args& a, int bid, int G, int wid, int lane) {
    const bf16_t* of = (const bf16_t*)(a.ws + WS_OF); const bf16_t* obw = (const bf16_t*)(a.ws + WS_OB); const bf16_t* zg = (const bf16_t*)(a.ws + WS_ZG);
    const bf16_t* zgb = (const bf16_t*)(a.ws + WS_ZGB); const bf16_t* zgc = (const bf16_t*)(a.ws + WS_ZGC);
    bf16_t* A2 = (bf16_t*)(a.ws + WS_ACT);
    const int c0 = 8 * lane;
    float gain[8], cw0[8], cw1[8], cw2[8];
#pragma unroll
    for (int j = 0; j < 8; ++j) { gain[j] = a.hg_norm[(c0 + j) & 127]; cw0[j] = a.conv_w[c0 + j]; cw1[j] = a.conv_w[512 + c0 + j]; cw2[j] = a.conv_w[1024 + c0 + j]; }
    for (int row = bid * 8 + wid; row < M; row += G * 8) {
        const size_t ro = (size_t)row * 512 + c0;
        float f0[8], f1[8], gg[8], o[8];
        unpack8(__builtin_nontemporal_load((const u32x4*)(of + ro)), f0); unpack8(__builtin_nontemporal_load((const u32x4*)(obw + ro)), f1); unpack8(__builtin_nontemporal_load((const u32x4*)(zg + ro)), gg);
        float ss = 0.f;
#pragma unroll
        for (int j = 0; j < 8; ++j) { o[j] = f0[j] + f1[j]; ss += o[j] * o[j]; }
        ss += __shfl_xor(ss, 1); ss += __shfl_xor(ss, 2); ss += __shfl_xor(ss, 4); ss += __shfl_xor(ss, 8);
        const float rstd = rsqrtf(ss * (1.f / 128.f) + EPS);
#pragma unroll
        for (int j = 0; j < 8; ++j) o[j] = o[j] * rstd * gain[j] * silu_f(gg[j]);
        u32x4 w; w.x = cvt_pk_bf16(o[0], o[1]); w.y = cvt_pk_bf16(o[2], o[3]); w.z = cvt_pk_bf16(o[4], o[5]); w.w = cvt_pk_bf16(o[6], o[7]);
        *(u32x4*)(A2 + (size_t)row * D + c0) = w;
        const int tw = row & 63;
        float um[8], u0[8], up[8], gb[8], y[8];
        unpack8(*(const u32x4*)(zgc + ro), u0); unpack8(__builtin_nontemporal_load((const u32x4*)(zgb + ro)), gb);
        if (tw > 0) unpack8(*(const u32x4*)(zgc + ro - 512), um);
        else {
#pragma unroll
            for (int j = 0; j < 8; ++j) um[j] = 0.f; }
        if (tw < 63) unpack8(*(const u32x4*)(zgc + ro + 512), up);
        else {
#pragma unroll
            for (int j = 0; j < 8; ++j) up[j] = 0.f; }
#pragma unroll
        for (int j = 0; j < 8; ++j) y[j] = gb[j] * (cw0[j] * um[j] + cw1[j] * u0[j] + cw2[j] * up[j]);
        w.x = cvt_pk_bf16(y[0], y[1]); w.y = cvt_pk_bf16(y[2], y[3]); w.z = cvt_pk_bf16(y[4], y[5]); w.w = cvt_pk_bf16(y[6], y[7]);
        *(u32x4*)(A2 + (size_t)row * D + 512 + c0) = w;
    }
}

__device__ __forceinline__ void phase_router(const Args& a, LAS uchar* lds, int bid, int tid, int wid, int lane) {
    const float* modf = (const float*)(a.ws + WS_MODF);
    LAS float* gm = (LAS float*)lds; LAS float* sh = gm + D;
    LAS uchar* wrl = lds + 8192;
    const int b = bid / 32;
    for (int cidx = tid; cidx < D; cidx += 512) { sh[cidx] = modf[(size_t)b * NMOD + 3 * D + cidx]; gm[cidx] = a.norm_ffn[cidx] * (1.f + modf[(size_t)b * NMOD + 4 * D + cidx]); }
    for (int i = tid; i < D * 4; i += 512) { const int col = i >> 2, q4 = i & 3; *(LAS f32x4*)(wrl + col * 64 + (col >> 2) * 16 + q4 * 16) = *(const f32x4*)(a.w_router + col * 16 + q4 * 4); }
    __syncthreads();
    uchar* hx2 = a.ws + WS_ACT; float* aff = (float*)(a.ws + WS_AFF);
    for (int jb = 0; jb < 4; ++jb) {
        const int row0 = bid * 128 + wid * 16 + jb * 4;
        f32x4 v[4][4]; float rstd[4];
#pragma unroll
        for (int i = 0; i < 4; ++i) { const bf16_t* xrow = (const bf16_t*)(a.ws + WS_X1B) + (size_t)(row0 + i) * D; float ss = 0.f;
#pragma unroll
            for (int jj = 0; jj < 4; ++jj) { const u32x2 xw = __builtin_nontemporal_load((const u32x2*)xrow + lane + 64 * jj); v[i][jj] = (f32x4){bf_lo(xw.x), bf_hi(xw.x), bf_lo(xw.y), bf_hi(xw.y)}; ss += (v[i][jj].x * v[i][jj].x + v[i][jj].y * v[i][jj].y) + (v[i][jj].z * v[i][jj].z + v[i][jj].w * v[i][jj].w); }
            rstd[i] = ss; }
#pragma unroll
        for (int i = 0; i < 4; ++i) rstd[i] = rsqrtf(wave_sum(rstd[i]) * (1.f / D) + EPS);
        float pl[64];
#pragma unroll
        for (int e = 0; e < 64; ++e) pl[e] = 0.f;
#pragma unroll
        for (int jj = 0; jj < 4; ++jj) { const f32x4 g4 = *((const LAS f32x4*)gm + lane + 64 * jj), s4 = *((const LAS f32x4*)sh + lane + 64 * jj);
#pragma unroll
            for (int i = 0; i < 4; ++i) { v[i][jj] = v[i][jj] * rstd[i] * g4 + s4;
                *((unsigned*)(hx2 + (size_t)(row0 + i) * D) + lane + 64 * jj) = cvt_pk4_fp8(v[i][jj].x, v[i][jj].y, v[i][jj].z, v[i][jj].w); }
            const int colb = 4 * lane + 256 * jj;
#pragma unroll
            for (int cc = 0; cc < 4; ++cc) { const int col = colb + cc; const LAS uchar* wp = wrl + col * 64 + (col >> 2) * 16;
#pragma unroll
                for (int q4 = 0; q4 < 4; ++q4) { const f32x4 w4 = *(const LAS f32x4*)(wp + q4 * 16);
#pragma unroll
                    for (int i = 0; i < 4; ++i) { const float hvv = v[i][jj][cc]; pl[i * 16 + q4 * 4 + 0] += hvv * w4.x; pl[i * 16 + q4 * 4 + 1] += hvv * w4.y; pl[i * 16 + q4 * 4 + 2] += hvv * w4.z; pl[i * 16 + q4 * 4 + 3] += hvv * w4.w; } } } }
#pragma unroll
        for (int k = 0; k < 32; ++k) { const bool hi = (lane & 32) != 0; const float keep = hi ? pl[32 + k] : pl[k], send = hi ? pl[k] : pl[32 + k]; pl[k] = keep + __shfl_xor(send, 32); }
#pragma unroll
        for (int k = 0; k < 16; ++k) { const bool hi = (lane & 16) != 0; const float keep = hi ? pl[16 + k] : pl[k], send = hi ? pl[k] : pl[16 + k]; pl[k] = keep + __shfl_xor(send, 16); }
#pragma unroll
        for (int k = 0; k < 8; ++k) { const bool hi = (lane & 8) != 0; const float keep = hi ? pl[8 + k] : pl[k], send = hi ? pl[k] : pl[8 + k]; pl[k] = keep + __shfl_xor(send, 8); }
#pragma unroll
        for (int k = 0; k < 4; ++k) { const bool hi = (lane & 4) != 0; const float keep = hi ? pl[4 + k] : pl[k], send = hi ? pl[k] : pl[4 + k]; pl[k] = keep + __shfl_xor(send, 4); }
#pragma unroll
        for (int k = 0; k < 2; ++k) { const bool hi = (lane & 2) != 0; const float keep = hi ? pl[2 + k] : pl[k], send = hi ? pl[k] : pl[2 + k]; pl[k] = keep + __shfl_xor(send, 2); }
        { const bool hi = (lane & 1) != 0; const float keep = hi ? pl[1] : pl[0], send = hi ? pl[0] : pl[1]; pl[0] = keep + __shfl_xor(send, 1); }
        const float lg = pl[0];
        float mx = lg;
#pragma unroll
        for (int o = 1; o < 16; o <<= 1) mx = fmaxf(mx, __shfl_xor(mx, o));
        const float ex = __expf(lg - mx); float den = ex;
#pragma unroll
        for (int o = 1; o < 16; o <<= 1) den += __shfl_xor(den, o);
        const int t = (row0 + (lane >> 4)) & (T - 1);
        aff[((size_t)b * NE + (lane & 15)) * T + t] = ex / den;
    }
    __syncthreads();
}

__device__ __forceinline__ void topk_item(const Args& a, LAS uchar* lds, int b, int e, int tid, int wid, int lane) {
    LAS unsigned* key = (LAS unsigned*)lds;
    LAS unsigned* hist = key + 4096;
    LAS unsigned* ctl = hist + 256;
    LAS unsigned* wsum = ctl + 8;
    const float* affp = (const float*)(a.ws + WS_AFF) + ((size_t)b * NE + e) * T;
    unsigned kv[8];
    { const u32x4 k0 = *(const u32x4*)(affp + tid * 8), k1 = *(const u32x4*)(affp + tid * 8 + 4); kv[0] = k0.x; kv[1] = k0.y; kv[2] = k0.z; kv[3] = k0.w; kv[4] = k1.x; kv[5] = k1.y; kv[6] = k1.z; kv[7] = k1.w; }
    unsigned prefix = 0u, mask = 0u, need = CAP;
    for (int shift = 24; shift >= 0; shift -= 8) {
        if (tid < 256) hist[tid] = 0u;
        __syncthreads();
#pragma unroll
        for (int j = 0; j < 8; ++j) if ((kv[j] & mask) == prefix) __hip_atomic_fetch_add(&hist[(kv[j] >> shift) & 255u], 1u, __ATOMIC_RELAXED, __HIP_MEMORY_SCOPE_WORKGROUP);
        __syncthreads();
        if (tid < 256) { unsigned above = 0u; for (int bb = tid + 1; bb < 256; ++bb) above += hist[bb]; const unsigned mine = hist[tid];
            if (above < need && need <= above + mine) { ctl[0] = (unsigned)tid; ctl[1] = need - above; } }
        __syncthreads();
        prefix |= ctl[0] << shift; mask |= 255u << shift; need = ctl[1];
        __syncthreads();
    }
    unsigned cg_ = 0u, ce_ = 0u;
#pragma unroll
    for (int j = 0; j < 8; ++j) { cg_ += kv[j] > prefix; ce_ += kv[j] == prefix; }
    unsigned pk = cg_ | (ce_ << 16), incl = pk;
#pragma unroll
    for (int o = 1; o < 64; o <<= 1) { const unsigned t2 = __shfl_up(incl, o); if (lane >= o) incl += t2; }
    if (lane == 63) wsum[wid] = incl;
    __syncthreads();
    unsigned base = 0u;
    for (int w = 0; w < wid; ++w) base += wsum[w];
    unsigned excl = base + incl - pk; unsigned ng = excl & 0xffffu, neq = excl >> 16;
    int* seltok = (int*)(a.ws + WS_SELTOK); float* selgate = (float*)(a.ws + WS_SELGATE); short* pos = (short*)(a.ws + WS_POS);
#pragma unroll
    for (int j = 0; j < 8; ++j) { const int t = tid * 8 + j; const bool gt = kv[j] > prefix, eq = kv[j] == prefix; const bool sel = gt || (eq && neq < need);
        int slot = -1;
        if (sel) slot = (int)(ng + (neq < need ? neq : need));
        if (sel) { seltok[e * 4096 + b * 512 + slot] = b * T + t; selgate[e * 4096 + b * 512 + slot] = __uint_as_float(kv[j]); }
        pos[((size_t)b * T + t) * 16 + e] = (short)slot;
        ng += gt; neq += eq; }
    __syncthreads();
}
__device__ __forceinline__ void phase_topk_cvt(const Args& a, LAS uchar* lds, int bid, int G, int tid, int wid, int lane) {
    if (bid < 128) topk_item(a, lds, bid / 16, bid % 16, tid, wid, lane);
    LAS float* scr = (LAS float*)(lds + 32768) + wid * (64 * 33);
    uchar* wgu = a.ws + WS_WGU; uchar* wdn = a.ws + WS_WDN;
    constexpr int I_G = (D / 64) * (DFF / 32);
    constexpr int I_D = (DFF / 64) * (D / 32);
    constexpr int PER_E = 2 * I_G + I_D, TOTAL = NE * PER_E;
    static_assert(TOTAL == 1024 * 22 + 1024 * 26, "item split");
    const bool tk = bid < 128; const int wi = (tk ? bid : bid - 128) * 8 + wid;
    const int cnt = tk ? 22 : 26, base = tk ? 1024 * 26 : 0;
    for (int k = 0; k < cnt; ++k) { const int it = base + k * 1024 + wi;
        const int e = it / PER_E; int r = it % PER_E;
        if (r < 2 * I_G) { const int up = r >= I_G; if (up) r -= I_G; const int nblk = DFF / 32, kb = r / nblk, nb = r % nblk, n0 = nb * 32;
            const float* W = (up ? a.w_up : a.w_gate) + (size_t)e * D * DFF;
            cvt_item_fp8(W, DFF, wgu + (size_t)e * 4096 * D, D, kb * 64, n0, (n0 >> 7) * 256 + (n0 & 127) + (up ? 128 : 0), scr, lane); }
        else { r -= 2 * I_G; const int nblk = D / 32, kb = r / nblk, nb = r % nblk;
            cvt_item_fp8(a.w_down + (size_t)e * DFF * D, D, wdn + (size_t)e * D * DFF, DFF, kb * 64, nb * 32, nb * 32, scr, lane); }
    }
    __syncthreads();
}

__device__ __forceinline__ void phase_final(const Args& a, int bid, int G, int wid, int lane) {
    const float* modf = (const float*)(a.ws + WS_MODF); const short* pos = (const short*)(a.ws + WS_POS); const uchar* ys = a.ws + WS_YS;
    f32x4 nf[4];
#pragma unroll
    for (int q = 0; q < 4; ++q) nf[q] = *(const f32x4*)(a.norm_final + (q >> 1) * 512 + 8 * lane + (q & 1) * 4);
    for (int row = bid * 8 + wid; row < M; row += G * 8) {
        const int b = row / T; float* xrow = a.out + (size_t)row * D; const bf16_t* x1r = (const bf16_t*)(a.ws + WS_X1B) + (size_t)row * D;
        f32x4 v[4], acc[4];
#pragma unroll
        for (int hf = 0; hf < 2; ++hf) { const u32x4 xw = __builtin_nontemporal_load((const u32x4*)(x1r + hf * 512 + 8 * lane));
            v[2 * hf] = (f32x4){bf_lo(xw.x), bf_hi(xw.x), bf_lo(xw.y), bf_hi(xw.y)}; v[2 * hf + 1] = (f32x4){bf_lo(xw.z), bf_hi(xw.z), bf_lo(xw.w), bf_hi(xw.w)}; acc[2 * hf] = (f32x4){0.f, 0.f, 0.f, 0.f}; acc[2 * hf + 1] = (f32x4){0.f, 0.f, 0.f, 0.f}; }
        const int myslot = (lane < 16) ? (int)pos[(size_t)row * 16 + lane] : -1;
        unsigned long long mask = __ballot(myslot >= 0);
        while (mask) {
            int ee[4], sl[4];
#pragma unroll
            for (int k = 0; k < 4; ++k) { if (mask) { ee[k] = __builtin_ctzll(mask); mask &= mask - 1; sl[k] = __shfl(myslot, ee[k]); } else { ee[k] = -1; sl[k] = 0; } }
            u32x2 w[4][2];
#pragma unroll
            for (int k = 0; k < 4; ++k) if (ee[k] >= 0) { const uchar* yr = ys + ((size_t)ee[k] * 4096 + b * 512 + sl[k]) * D + 8 * lane; w[k][0] = __builtin_nontemporal_load((const u32x2*)yr); w[k][1] = __builtin_nontemporal_load((const u32x2*)(yr + 512)); }
#pragma unroll
            for (int k = 0; k < 4; ++k) if (ee[k] >= 0) {
#pragma unroll
                for (int hf = 0; hf < 2; ++hf) { const u32x2 ww = w[k][hf];
                    const f32x2 p0 = __builtin_amdgcn_cvt_pk_f32_fp8(ww.x, false), p1 = __builtin_amdgcn_cvt_pk_f32_fp8(ww.x, true), p2 = __builtin_amdgcn_cvt_pk_f32_fp8(ww.y, false), p3 = __builtin_amdgcn_cvt_pk_f32_fp8(ww.y, true);
                    acc[2 * hf].x += p0.x; acc[2 * hf].y += p0.y; acc[2 * hf].z += p1.x; acc[2 * hf].w += p1.y;
                    acc[2 * hf + 1].x += p2.x; acc[2 * hf + 1].y += p2.y; acc[2 * hf + 1].z += p3.x; acc[2 * hf + 1].w += p3.y; } }
        }
        float ss = 0.f;
#pragma unroll
        for (int q = 0; q < 4; ++q) { const f32x4 g2 = *(const f32x4*)(modf + (size_t)b * NMOD + 5 * D + (q >> 1) * 512 + 8 * lane + (q & 1) * 4); v[q] = v[q] + g2 * acc[q] * 0.0625f;
            ss += (v[q].x * v[q].x + v[q].y * v[q].y) + (v[q].z * v[q].z + v[q].w * v[q].w); }
        const float rstd = rsqrtf(wave_sum(ss) * (1.f / D) + EPS);
#pragma unroll
        for (int q = 0; q < 4; ++q) __builtin_nontemporal_store(v[q] * rstd * nf[q], (f32x4*)(xrow + (q >> 1) * 512 + 8 * lane + (q & 1) * 4));
    }
}

__global__ void __launch_bounds__(512, 2) mega_fwd(Args a) {
    extern __shared__ __attribute__((aligned(16))) uchar lds_raw[];
    LAS uchar* lds = (LAS uchar*)lds_raw;
    const int tid = threadIdx.x, lane = tid & 63, wid = __builtin_amdgcn_readfirstlane(tid >> 6), bid = blockIdx.x, G = gridDim.x;
    const int lo = a.ph_lo, hi = a.ph_hi;
    uchar* ws = a.ws;
#define IN(k) (lo <= (k) && (k) < hi)
#define SEAM(k) do { if (IN(k) && IN((k) + 1)) xcd_barrier(xbar); } while (0)
    if (tid < 2) ((volatile LAS unsigned*)(lds + (LDS_BYTES - 16)))[tid] = 0u;
    __syncthreads();
    XcdBarrier xbar = xcd_barrier_post((unsigned*)(ws + WS_BAR), (volatile LAS unsigned*)(lds + (LDS_BYTES - 16)));
    if (IN(0)) phase_prep(a, lds, bid, G, tid, wid, lane);
    SEAM(0);
    if (IN(1)) phase_norm(a, lds, bid, G, tid, wid, lane);
    SEAM(1);
    if (IN(2)) {
        {
            pg8::Gemm g{(const bf16_t*)(ws + WS_ACT), (const bf16_t*)(ws + WS_WIN), D, 0, nullptr};
            pg8::GroupOrder S; S.init(M / 256, NIN / 256, 1, G, bid);
            pg8::EpiInproj E{ws + WS_ZQ, nullptr, (_Float16*)(ws + WS_LF), (_Float16*)(ws + WS_LBW), (const float*)(ws + WS_LB), 0, T};
            pg8::gemm_phase<pg8::EpiInproj, false>(lds, g, S, E);
        }
    }
    SEAM(2);
    if (IN(3)) {
        unsigned* cnt = (unsigned*)(ws + WS_BAR + 14336);
        if (bid >= 192 && bid < 240) {
            pg8::Gemm g{(const bf16_t*)(ws + WS_HC), (const bf16_t*)(ws + WS_WIN) + (size_t)512 * D, D, 0, nullptr};
            pg8::GroupOrder S; S.init(MC / 256, 1536 / 256, 1, 48, bid - 192);
            pg8::EpiInproj E{nullptr, (bf16_t*)(ws + WS_CI), (_Float16*)(ws + WS_CLF), (_Float16*)(ws + WS_CLB), (const float*)(ws + WS_LB), 1, CT};
            pg8::gemm_phase<pg8::EpiInproj, false>(lds, g, S, E);
            pg8::Unit u; S.next(0, u);
            asm volatile("s_waitcnt vmcnt(0)" ::: "memory"); __syncthreads();
            if (tid == 0) { __builtin_amdgcn_fence(__ATOMIC_RELEASE, "agent"); asm volatile("s_waitcnt vmcnt(0)" ::: "memory");
                __hip_atomic_fetch_add(cnt + 64 * u.pm, 1u, __ATOMIC_RELAXED, __HIP_MEMORY_SCOPE_AGENT); }
        }
        if (bid >= 192) {
            const int b = (bid - 192) >> 3;
            if (tid == 0) { unsigned sp = 0; while (__hip_atomic_load(cnt + 64 * b, __ATOMIC_RELAXED, __HIP_MEMORY_SCOPE_AGENT) < 6u && ++sp < (1u << 22)) __builtin_amdgcn_s_sleep(2);
                __builtin_amdgcn_fence(__ATOMIC_ACQUIRE, "agent"); asm volatile("s_waitcnt vmcnt(0)" ::: "memory"); }
            __syncthreads();
        }
        phase_gla_states(a, lds, bid, wid, lane);
    }
    SEAM(3);
    if (IN(4)) phase_gla_out(a, lds, bid, wid, lane);
    SEAM(4);
    if (IN(5)) phase_mixfin(a, bid, G, wid, lane);
    SEAM(5);
    if (IN(6)) {
        pg8::Gemm g{(const bf16_t*)(ws + WS_ACT), (const bf16_t*)(ws + WS_WOUT), D, 0, nullptr};
        pg8::GroupOrder S; S.init(M / 256, D / 256, 1, G, bid);
        pg8::EpiOut E{a.x, (bf16_t*)(ws + WS_X1B), (const float*)(ws + WS_MODF)};
        pg8::gemm_phase<pg8::EpiOut, false>(lds, g, S, E);
    }
    SEAM(6);
    if (IN(7)) phase_router(a, lds, bid, tid, wid, lane);
    SEAM(7);
    if (IN(8)) phase_topk_cvt(a, lds, bid, G, tid, wid, lane);
    SEAM(8);
    if (IN(9)) {
        pg8::Gemm g{(const bf16_t*)(ws + WS_ACT), (const bf16_t*)(ws + WS_WGU), D / 2, (size_t)4096 * D, (const int*)(ws + WS_SELTOK)};
        pg8::GroupOrder S; S.init(16, 16, NE, G, bid);
        pg8::EpiMoe1 E{ws + WS_HID};
        pg8::gemm_phase<pg8::EpiMoe1, true, pg8::GroupOrder, true>(lds, g, S, E);
    }
    SEAM(9);
    if (IN(10)) {
        pg8::Gemm g{(const bf16_t*)(ws + WS_HID), (const bf16_t*)(ws + WS_WDN), DFF / 2, (size_t)D * DFF, nullptr};
        pg8::Moe2Order S{bid};
        LAS float* lg = (LAS float*)(lds + pg8::STAGE_BYTES);
        { pg8::Unit tu; for (int uu = 0; uu < 4 && S.next(uu, tu); ++uu) if (tid < 256) lg[uu * 256 + tid] = ((const float*)(ws + WS_SELGATE))[tu.pm * 256 + tid]; }
        __syncthreads();
        pg8::EpiMoe2 E{ws + WS_YS, lg};
        pg8::gemm_phase<pg8::EpiMoe2, false, pg8::Moe2Order, true>(lds, g, S, E);
    }
    SEAM(10);
    if (IN(11)) phase_final(a, bid, G, wid, lane);

#undef IN
#undef SEAM
}

#ifndef N_LAUNCHES
#define N_LAUNCHES 1
#endif
extern "C" void kernel_launch(void* const* d_in, const int* in_sizes, int n_in, void* d_out, int out_size, void* d_ws, size_t ws_size, hipStream_t stream) {
    static int grid = 0;
    if (grid == 0) {
        if (n_in != 18 || out_size != M * D || ws_size < WS_END) { fprintf(stderr, "kernel_launch: unexpected shapes (n_in %d out %d ws %zu)\n", n_in, out_size, ws_size); grid = -1; return; }
        int dev = 0, cus = 0, per_cu = 0;
        (void)hipGetDevice(&dev); (void)hipDeviceGetAttribute(&cus, hipDeviceAttributeMultiprocessorCount, dev);
        (void)hipFuncSetAttribute((const void*)mega_fwd, hipFuncAttributeMaxDynamicSharedMemorySize, LDS_BYTES);
        (void)hipOccupancyMaxActiveBlocksPerMultiprocessor(&per_cu, (const void*)mega_fwd, 512, LDS_BYTES);
        if (per_cu < 1) { fprintf(stderr, "kernel_launch: occupancy query says %d blocks per CU\n", per_cu); grid = -1; return; }
        grid = 256;
        if (cus != 256) fprintf(stderr, "kernel_launch: note: %d CUs (built for 256)\n", cus);
    }
    if (grid < 0) return;
    Args a{};
    a.x = (const float*)d_in[0]; a.c = (const float*)d_in[1]; a.ctx = (const float*)d_in[2]; a.c_ctx = (const float*)d_in[3]; a.w_ada = (const float*)d_in[4]; a.b_ada = (const float*)d_in[5];
    a.norm_mix = (const float*)d_in[6]; a.norm_ffn = (const float*)d_in[7]; a.w_in = (const float*)d_in[8]; a.lb_logits = (const float*)d_in[9]; a.hg_norm = (const float*)d_in[10];
    a.conv_w = (const float*)d_in[11]; a.w_out = (const float*)d_in[12]; a.w_router = (const float*)d_in[13]; a.w_gate = (const float*)d_in[14]; a.w_up = (const float*)d_in[15];
    a.w_down = (const float*)d_in[16]; a.norm_final = (const float*)d_in[17]; a.out = (float*)d_out; a.ws = (uchar*)d_ws;
    if (N_LAUNCHES == 1) {
        (void)hipMemsetAsync((char*)d_ws + WS_BAR, 0, 16384, stream);
        a.ph_lo = 0; a.ph_hi = NPHASE;
        hipLaunchKernelGGL(mega_fwd, dim3(grid), dim3(512), LDS_BYTES, stream, a);
    } else {
        for (int p = 0; p < NPHASE; ++p) { a.ph_lo = p; a.ph_hi = p + 1; void* args[] = {&a};
            hipError_t e = hipLaunchCooperativeKernel((const void*)mega_fwd, dim3(grid), dim3(512), args, LDS_BYTES, stream);
            if (e != hipSuccess) { fprintf(stderr, "launch %d failed: %s\n", p, hipGetErrorString(e)); break; } }
    }
}
```

```cpp
#include <hip/hip_runtime.h>
#include <cstdio>

#define LAS __attribute__((address_space(3)))
#define GAS __attribute__((address_space(1)))
typedef unsigned short bf16_t;
typedef short bf16x8 __attribute__((ext_vector_type(8)));
typedef float f32x4 __attribute__((ext_vector_type(4)));
typedef float f32x2 __attribute__((ext_vector_type(2)));
typedef unsigned u32x4 __attribute__((ext_vector_type(4)));
typedef unsigned u32x2 __attribute__((ext_vector_type(2)));
typedef unsigned char uchar;
typedef int i32x8 __attribute__((ext_vector_type(8)));
typedef int i32x4 __attribute__((ext_vector_type(4)));

constexpr int D = 1024, NB = 8, T = 4096, M = NB * T, CT = 256, MC = NB * CT;
constexpr int NIN = 4096, HK = 512, NH = 4, NE = 16, CAP = 512, DFF = 2048, NMOD = 6 * D;
constexpr float EPS = 1e-6f;
constexpr int NPHASE = 12;

constexpr size_t MiB = 1u << 20;
constexpr size_t WS_ACT = 0;
constexpr size_t WS_WIN = 64 * MiB;
constexpr size_t WS_WOUT = 72 * MiB;
constexpr size_t WS_MODP = 74 * MiB;
constexpr size_t WS_MODF = 76 * MiB;
constexpr size_t WS_LB = 76 * MiB + 512 * 1024;
constexpr size_t WS_HC = 77 * MiB;
constexpr size_t WS_CLF = 81 * MiB;
constexpr size_t WS_CLB = 85 * MiB;
constexpr size_t WS_CI = 89 * MiB;
constexpr size_t WS_S0 = 91 * MiB;
constexpr size_t WS_AFF = 95 * MiB;
constexpr size_t WS_SELTOK = 97 * MiB;
constexpr size_t WS_SELGATE = 97 * MiB + 256 * 1024;
constexpr size_t WS_POS = 98 * MiB;
constexpr size_t WS_BAR = 100 * MiB;
constexpr size_t WS_SL = 488 * MiB;
constexpr size_t WS_DL = 500 * MiB;
constexpr size_t WS_ZQ = 104 * MiB;
constexpr size_t WS_LF = 136 * MiB;
constexpr size_t WS_LBW = 200 * MiB;
constexpr size_t WS_ZI = 264 * MiB;
constexpr size_t WS_ZG = 296 * MiB;
constexpr size_t WS_ZGB = 328 * MiB;
constexpr size_t WS_ZGC = 360 * MiB;
constexpr size_t WS_ZV = 392 * MiB;
constexpr size_t WS_OF = 424 * MiB;
constexpr size_t WS_OB = 456 * MiB;
constexpr size_t WS_WGU = 104 * MiB;
constexpr size_t WS_WDN = 232 * MiB;
constexpr size_t WS_HID = 296 * MiB;
constexpr size_t WS_YS = WS_WGU;
constexpr size_t WS_X1B = 424 * MiB;
constexpr size_t WS_END = 552 * MiB;
static_assert(WS_ZI == WS_ZQ + 160 * MiB && WS_ZG == WS_ZI + 32 * MiB && WS_ZGB == WS_ZG + 32 * MiB && WS_ZGC == WS_ZGB + 32 * MiB && WS_ZV == WS_ZGC + 32 * MiB, "z segment map");

constexpr int LDS_BYTES = 147456;

typedef __bf16 bf16x2_t __attribute__((ext_vector_type(2)));
__device__ __forceinline__ unsigned cvt_pk_bf16_safe(float lo, float hi) { typedef float f2_t __attribute__((ext_vector_type(2))); const bf16x2_t v = __builtin_convertvector((f2_t){lo, hi}, bf16x2_t); return __builtin_bit_cast(unsigned, v); }
__device__ __forceinline__ unsigned cvt_pk_bf16(float lo, float hi) { unsigned r; asm volatile("v_cvt_pk_bf16_f32 %0, %1, %2" : "=v"(r) : "v"(lo), "v"(hi)); return r; }
__device__ __forceinline__ unsigned cvt_pk4_fp8(float a, float b, float c, float d) { unsigned r = 0u; asm volatile("v_cvt_pk_fp8_f32 %0, %1, %2\n\tv_cvt_pk_fp8_f32 %0, %3, %4 op_sel:[0,0,1]" : "+v"(r) : "v"(a), "v"(b), "v"(c), "v"(d)); return r; }
__device__ __forceinline__ float bf_lo(unsigned u) { return __uint_as_float(u << 16); }
__device__ __forceinline__ float bf_hi(unsigned u) { return __uint_as_float(u & 0xffff0000u); }
__device__ __forceinline__ float wave_sum(float v) {
#pragma unroll
    for (int o = 1; o < 64; o <<= 1) v += __shfl_xor(v, o);
    return v;
}
__device__ __forceinline__ float silu_f(float x) { return x * __builtin_amdgcn_rcpf(1.f + __builtin_amdgcn_exp2f(x * -1.44269504f)); }
#define LDS_WAIT() asm volatile("s_waitcnt lgkmcnt(0)" ::: "memory")


#define XB_TMO      128
#define XB_XCNT(j)  (256  + 64 * (j))
#define XB_XSUB(j)  (1280 + 64 * (j))
#define XB_XGEN(j)  (2304 + 64 * (j))
#define XB_TOP      3328
#define XB_TOPGEN   3392
#define XCD_BAR_WORDS 3456
#define XB_SPIN_CAP (1u << 20)
__device__ __forceinline__ unsigned xb_ld(unsigned* p)              { return __hip_atomic_load(p, __ATOMIC_RELAXED, __HIP_MEMORY_SCOPE_AGENT); }
__device__ __forceinline__ unsigned xb_add(unsigned* p, unsigned v) { return __hip_atomic_fetch_add(p, v, __ATOMIC_RELAXED, __HIP_MEMORY_SCOPE_AGENT); }
__device__ __forceinline__ unsigned xb_xcc_id() { return (unsigned)__builtin_amdgcn_s_getreg((3 << 11) | 20) & 0xFu; }
#define XB_SPIN(cond, bar) do { unsigned _sp = 0; while (cond) { __builtin_amdgcn_s_sleep(1); \
    if ((++_sp & 255u) == 0u) { if (xb_ld(&(bar)[XB_TMO])) break; if (_sp > XB_SPIN_CAP) { atomicAdd(&(bar)[XB_TMO], 1u); break; } } } } while (0)
struct XcdBarrier { unsigned* bar; unsigned x; volatile LAS unsigned* st; };
__device__ __forceinline__ XcdBarrier xcd_barrier_post(unsigned* bar, volatile LAS unsigned* st) {
    XcdBarrier b; b.bar = bar; b.x = xb_xcc_id(); b.st = st;
    if (threadIdx.x == 0) (void)xb_add(&bar[XB_XCNT(b.x)], 1u);
    return b;
}
__device__ __forceinline__ void xcd_barrier_complete(unsigned* bar, unsigned x, unsigned& nloc, unsigned& nx) {
    const unsigned G = gridDim.x * gridDim.y * gridDim.z;
    unsigned sum, cnt, mine, sp = 0u;
    for (;;) {
        sum = 0u; cnt = 0u; mine = 0u;
#pragma unroll
        for (unsigned j = 0; j < 16; ++j) { const unsigned c = xb_ld(&bar[XB_XCNT(j)]); sum += c; cnt += (c > 0u) ? 1u : 0u; mine = (j == x) ? c : mine; }
        if (sum == G) break;
        __builtin_amdgcn_s_sleep(1);
        if ((++sp & 255u) == 0u) { if (xb_ld(&bar[XB_TMO])) break; if (sp > XB_SPIN_CAP) { atomicAdd(&bar[XB_TMO], 1u); break; } }
    }
    nloc = mine > 0u ? mine : 1u; nx = cnt > 0u ? cnt : 1u;
}
__device__ __forceinline__ void xcd_barrier(const XcdBarrier& b) {
    asm volatile("s_waitcnt vmcnt(0)" ::: "memory");
    __syncthreads();
    if (threadIdx.x == 0) {
        unsigned* bar = b.bar;
        __builtin_amdgcn_s_waitcnt(0);
        unsigned nloc = b.st[0], nx = b.st[1];
        if (nloc == 0u) { xcd_barrier_complete(bar, b.x, nloc, nx); b.st[0] = nloc; b.st[1] = nx; }
        const unsigned old = xb_add(&bar[XB_XSUB(b.x)], 1u);
        const unsigned gen = old / nloc;
        if (old + 1u == (gen + 1u) * nloc) {
            __builtin_amdgcn_fence(__ATOMIC_RELEASE, "agent");
            asm volatile("s_waitcnt vmcnt(0)" ::: "memory");
            const unsigned og = xb_add(&bar[XB_TOP], 1u);
            const unsigned tg = og / nx;
            if (og + 1u == (tg + 1u) * nx) xb_add(&bar[XB_TOPGEN], 1u);
            else XB_SPIN(xb_ld(&bar[XB_TOPGEN]) == tg, bar);
            __builtin_amdgcn_fence(__ATOMIC_ACQUIRE, "agent");
            xb_add(&bar[XB_XGEN(b.x)], 1u);
            asm volatile("s_waitcnt vmcnt(0)" ::: "memory");
        } else {
            XB_SPIN(xb_ld(&bar[XB_XGEN(b.x)]) == gen, bar);
            __builtin_amdgcn_fence(__ATOMIC_ACQUIRE, "agent");
            asm volatile("s_waitcnt vmcnt(0)" ::: "memory");
        }
    }
    __syncthreads();
}

namespace pg8 {
constexpr int BM = 256, BK = 64, HALF = 128, HTB = HALF * BK * 2, STAGE_BYTES = 8 * HTB, NXCD = 8, WGM = 8;
__device__ __forceinline__ int lds_byte(int r, int c) { const int st = (r >> 4) * 2 + (c >> 5), rr = r & 15, cc = c & 31, ob = rr * 64 + cc * 2; return st * 1024 + (ob ^ (((ob >> 9) & 1) << 5)); }
__device__ __forceinline__ void stage_rc(int b, int& R, int& C) { const int st = b / 1024, sb = b % 1024, swz = sb ^ (((sb >> 9) & 1) << 5); R = (st >> 1) * 16 + swz / 64; C = (st & 1) * 32 + (swz % 64) / 2; }
__device__ __forceinline__ int perm32(int rho) { const int n = rho >> 4, i = rho & 15; return 8 * (i >> 2) + 4 * n + (i & 3); }

struct Unit { int pm, pn, e; };
struct GroupOrder {
    int nM, nN, ng, G, c;
    __device__ __forceinline__ void init(int nM_, int nN_, int ng_, int G_, int c_) { nM = nM_; nN = nN_; ng = ng_; G = G_; c = c_; }
    __device__ __forceinline__ bool next(int i, Unit& u) const {
        const int nwg = nM * nN; const long L = (long)i * G + c; if (L >= (long)nwg * ng) return false;
        const int grp = (int)(L / nwg); int wgid = (int)(L % nwg);
        { const int q = nwg / NXCD, r = nwg % NXCD, xcd = wgid % NXCD, off = wgid / NXCD; wgid = (xcd < r ? xcd * (q + 1) : r * (q + 1) + (xcd - r) * q) + off; }
        const int nig = WGM * nN, gid = wgid / nig, fm = gid * WGM, gsz = (nM - fm) < WGM ? (nM - fm) : WGM;
        u.pm = grp * nM + fm + ((wgid % nig) % gsz); u.pn = (wgid % nig) / gsz; u.e = grp; return true;
    }
};
struct Moe2Order {
    int c;
    __device__ __forceinline__ bool next(int i, Unit& u) const { if (i >= 4) return false; const int x = c & 7, j = c >> 3; u.e = 4 * i + (j >> 3); u.pm = u.e * 16 + 2 * x + ((j & 7) >> 2); u.pn = j & 3; return true; }
};
struct Gemm { const bf16_t* A; const bf16_t* Bt; int K; size_t bgs; const int* rowidx; };

template <class Epi, bool GATHER, class Sched = GroupOrder, bool FP8 = false>
__device__ __forceinline__ void gemm_phase(LAS uchar* lds, const Gemm g, const Sched& S, const Epi& E) {
    const int tid = threadIdx.x, wid = __builtin_amdgcn_readfirstlane(tid >> 6), lane = tid & 63, wr = wid >> 2, wc = wid & 3, fr = lane & 15, fq = lane >> 4;
    const int K = g.K, nt = K / BK;
    unsigned voffA[2], voffB[2]; int Rr[2], Cc[2];
#pragma unroll
    for (int i = 0; i < 2; ++i) { int R, C; stage_rc(tid * 16 + i * 8192, R, C); const int Rb = Epi::PERM ? ((R & ~31) + perm32(R & 31)) : R; Rr[i] = R; Cc[i] = C;
        voffA[i] = (unsigned)(R * K + C) * 2u; voffB[i] = (unsigned)(Rb * K + C) * 2u; }
    const size_t kstep = (size_t)(BK * 2);
    const size_t hstep = (size_t)HALF * K * 2;
    const size_t tstep = 2 * hstep;
    const unsigned ldsw = (unsigned)wid * 1024u;
    const int aoff = lds_byte(wr * 64 + fr, fq * 8), boff = lds_byte(wc * 32 + fr, fq * 8);
#define PG8_SA(b, h) (((b) * 2 + (h)) * HTB)
#define PG8_SB(b, h) ((4 + (b) * 2 + (h)) * HTB)
#define PG8_STAGE(bufoff, gbase, voff) do { _Pragma("unroll") for (int _i = 0; _i < 2; ++_i) \
        __builtin_amdgcn_global_load_lds((const unsigned*)((const char*)(gbase) + (voff)[_i]), (LAS unsigned*)(lds + (bufoff) + ldsw + _i * 8192), 16, 0, 0); } while (0)
#define PG8_STAGE_A(bufoff, p, ofs, h) do { if constexpr (GATHER) { PG8_STAGE(bufoff, p, (ofs)[h]); } else { PG8_STAGE(bufoff, (p) + (h) * hstep, voffA); } } while (0)
#define PG8_LD8(p) __builtin_shufflevector(*(const LAS i32x4*)(p), *(const LAS i32x4*)((p) + 1024), 0, 1, 2, 3, 4, 5, 6, 7)
#define PG8_LDA(dst, b, h) do { _Pragma("unroll") for (int m = 0; m < 4; ++m) dst[m] = PG8_LD8(lds + PG8_SA(b, h) + aoff + m * 2048); } while (0)
#define PG8_LDB(dst, b, h) do { _Pragma("unroll") for (int n = 0; n < 2; ++n) dst[n] = PG8_LD8(lds + PG8_SB(b, h) + boff + n * 2048); } while (0)
#define PG8_HALF(x, k) __builtin_bit_cast(bf16x8, (k) ? __builtin_shufflevector(x, x, 4, 5, 6, 7) : __builtin_shufflevector(x, x, 0, 1, 2, 3))
#define PG8_MMA(ai, bj, At, Bt) do { __builtin_amdgcn_s_setprio(1); _Pragma("unroll") for (int m = 0; m < 4; ++m) _Pragma("unroll") for (int n = 0; n < 2; ++n) { \
        if constexpr (FP8) acc[ai][bj][m][n] = __builtin_amdgcn_mfma_scale_f32_16x16x128_f8f6f4(Bt[n], At[m], acc[ai][bj][m][n], 0, 0, 0, 0x7f7f7f7f, 0, 0x7f7f7f7f); \
        else { acc[ai][bj][m][n] = __builtin_amdgcn_mfma_f32_16x16x32_bf16(PG8_HALF(Bt[n], 0), PG8_HALF(At[m], 0), acc[ai][bj][m][n], 0, 0, 0); \
               acc[ai][bj][m][n] = __builtin_amdgcn_mfma_f32_16x16x32_bf16(PG8_HALF(Bt[n], 1), PG8_HALF(At[m], 1), acc[ai][bj][m][n], 0, 0, 0); } } \
        if constexpr (FP8) { _Pragma("unroll") for (int m = 0; m < 4; ++m) _Pragma("unroll") for (int n = 0; n < 2; ++n) asm volatile("" : "+v"(acc[ai][bj][m][n])); }     \
        __builtin_amdgcn_s_setprio(0); } while (0)
#define PG8_WAIT_V(n) asm volatile("s_waitcnt vmcnt(" #n ")" ::: "memory")
#define PG8_WAIT_L(n) asm volatile("s_waitcnt lgkmcnt(" #n ")" ::: "memory")
#define PG8_BAR __builtin_amdgcn_s_barrier()
#define PG8_SCHED __builtin_amdgcn_sched_barrier(0)
    Unit cur, nxt; int ui = 0;
    if (!S.next(0, cur)) return;
    f32x4 acc[2][2][4][2];
#pragma unroll
    for (int a = 0; a < 2; ++a)
#pragma unroll
        for (int b = 0; b < 2; ++b)
#pragma unroll
            for (int m = 0; m < 4; ++m)
#pragma unroll
                for (int n = 0; n < 2; ++n) acc[a][b][m][n] = (f32x4){0.f, 0.f, 0.f, 0.f};
    i32x8 At[4], B0[2], B1[2];
    unsigned cofs[2][2], nofs[2][2];
    LAS unsigned short* ridx = (LAS unsigned short*)(lds + STAGE_BYTES);
    if constexpr (GATHER) {
        { Unit tu; for (int uu = 0; uu < 16 && S.next(uu, tu); ++uu) if (tid < BM) ridx[uu * BM + tid] = (unsigned short)g.rowidx[tu.pm * BM + tid]; }
        asm volatile("s_waitcnt vmcnt(0) lgkmcnt(0)" ::: "memory"); __builtin_amdgcn_s_barrier(); asm volatile("" ::: "memory");
#pragma unroll
        for (int h = 0; h < 2; ++h)
#pragma unroll
            for (int i = 0; i < 2; ++i) { const int row = ridx[h * HALF + Rr[i]]; cofs[h][i] = (unsigned)(row * K + Cc[i]) * 2u; nofs[h][i] = cofs[h][i]; }
    }
    const char* cA = GATHER ? (const char*)g.A : (const char*)g.A + (size_t)cur.pm * tstep;
    const char* cB = (const char*)g.Bt + (size_t)cur.e * g.bgs + (size_t)cur.pn * tstep;
    PG8_STAGE(PG8_SB(0, 0), cB, voffB); PG8_STAGE(PG8_SB(0, 1), cB + hstep, voffB); PG8_STAGE_A(PG8_SA(0, 0), cA, cofs, 0); PG8_STAGE_A(PG8_SA(0, 1), cA, cofs, 1);
    if (wr == 1) PG8_BAR;
    PG8_WAIT_V(2); PG8_BAR;
    PG8_STAGE(PG8_SB(1, 0), cB + kstep, voffB); PG8_STAGE_A(PG8_SA(1, 0), cA + kstep, cofs, 0); PG8_STAGE(PG8_SB(1, 1), cB + hstep + kstep, voffB);
    PG8_WAIT_V(6); PG8_BAR;
    for (;;) {
        const bool has_next = S.next(ui + 1, nxt);
        const char* nA = GATHER ? (const char*)g.A : (has_next ? (const char*)g.A + (size_t)nxt.pm * tstep : cA);
        const char* nB = has_next ? (const char*)g.Bt + (size_t)nxt.e * g.bgs + (size_t)nxt.pn * tstep : cB;
#pragma unroll 1
        for (int t = 0; t < nt; t += 2) {
            const bool last = (t == nt - 2);
            const char* a1 = cA + (size_t)(t + 1) * kstep;
            const char* a2 = last ? nA : cA + (size_t)(t + 2) * kstep; const char* b2 = last ? nB : cB + (size_t)(t + 2) * kstep;
            const char* a3 = a2 + kstep; const char* b3 = b2 + kstep;
            if constexpr (GATHER) {
                if (last && has_next) {
#pragma unroll
                    for (int h = 0; h < 2; ++h)
#pragma unroll
                        for (int i = 0; i < 2; ++i) { const int row = ridx[(ui + 1) * BM + h * HALF + Rr[i]]; nofs[h][i] = (unsigned)(row * K + Cc[i]) * 2u; }
                }
            }
            PG8_LDB(B0, 0, 0); PG8_LDB(B1, 0, 1); PG8_SCHED; PG8_LDA(At, 0, 0); PG8_STAGE_A(PG8_SA(1, 1), a1, cofs, 1);
            PG8_WAIT_V(8); PG8_WAIT_L(0); PG8_BAR; PG8_MMA(0, 0, At, B0); PG8_MMA(0, 1, At, B1); PG8_BAR; PG8_SCHED;
            PG8_LDA(At, 0, 1); PG8_STAGE(PG8_SB(0, 0), b2, voffB); PG8_STAGE(PG8_SB(0, 1), b2 + hstep, voffB);
            if (last) { PG8_STAGE_A(PG8_SA(0, 0), a2, nofs, 0); } else { PG8_STAGE_A(PG8_SA(0, 0), a2, cofs, 0); }
            PG8_WAIT_V(8); PG8_WAIT_L(0); PG8_BAR; PG8_MMA(1, 0, At, B0); PG8_MMA(1, 1, At, B1); PG8_BAR; PG8_SCHED;
            PG8_LDB(B0, 1, 0); PG8_LDB(B1, 1, 1); PG8_SCHED; PG8_LDA(At, 1, 0);
            if (last) { PG8_STAGE_A(PG8_SA(0, 1), a2, nofs, 1); } else { PG8_STAGE_A(PG8_SA(0, 1), a2, cofs, 1); }
            PG8_WAIT_V(8); PG8_WAIT_L(0); PG8_BAR; PG8_MMA(0, 0, At, B0); PG8_MMA(0, 1, At, B1); PG8_BAR; PG8_SCHED;
            PG8_LDA(At, 1, 1); PG8_STAGE(PG8_SB(1, 0), b3, voffB); PG8_STAGE(PG8_SB(1, 1), b3 + hstep, voffB);
            if (last) { PG8_STAGE_A(PG8_SA(1, 0), a3, nofs, 0); } else { PG8_STAGE_A(PG8_SA(1, 0), a3, cofs, 0); }
            PG8_WAIT_V(8); PG8_WAIT_L(0); PG8_BAR; PG8_MMA(1, 0, At, B0); PG8_MMA(1, 1, At, B1); PG8_BAR; PG8_SCHED;
        }
        if (wr == 0) PG8_BAR;
        E(acc, cur, wr, wc, fr, fq);
        if (!has_next) break;
#pragma unroll
        for (int a = 0; a < 2; ++a)
#pragma unroll
            for (int b = 0; b < 2; ++b)
#pragma unroll
                for (int m = 0; m < 4; ++m)
#pragma unroll
                    for (int n = 0; n < 2; ++n) acc[a][b][m][n] = (f32x4){0.f, 0.f, 0.f, 0.f};
        cur = nxt; cA = nA; cB = nB; ++ui;
        if constexpr (GATHER) {
#pragma unroll
            for (int h = 0; h < 2; ++h)
#pragma unroll
                for (int i = 0; i < 2; ++i) cofs[h][i] = nofs[h][i];
        }
        if (wr == 1) PG8_BAR;
    }
    PG8_WAIT_V(0);
    PG8_BAR;
#undef PG8_SA
#undef PG8_SB
#undef PG8_STAGE
#undef PG8_STAGE_A
#undef PG8_LD8
#undef PG8_HALF
#undef PG8_LDA
#undef PG8_LDB
#undef PG8_MMA
#undef PG8_WAIT_V
#undef PG8_WAIT_L
#undef PG8_BAR
#undef PG8_SCHED
}


struct EpiInproj {
    static constexpr bool PERM = true;
    uchar* zbase; bf16_t* ci; _Float16* olog0; _Float16* olog1; const float* lb; int seg0; int Tn;
    __device__ __forceinline__ void operator()(const f32x4 (&acc)[2][2][4][2], const Unit& u, int wr, int wc, int fr, int fq) const {
        const int seg = seg0 + (u.pn >> 1);
        const int row0 = u.pm * BM + wr * 64 + fr;
        if (seg <= 3) {
            const int b = (u.pm * BM) / Tn, t0 = row0 - b * Tn, dcol = wc * 32 + 8 * fq;
#pragma unroll
            for (int bj = 0; bj < 2; ++bj) { const int hh = (u.pn & 1) * 2 + bj; const size_t plane = (size_t)(b * NH + hh) * Tn;
                if (seg == 1 || seg == 2) {
                    _Float16* O = (seg == 1) ? olog0 : olog1; const float* lbp = lb + (seg - 1) * 512 + hh * 128 + dcol;
                    const f32x4 l0 = *(const f32x4*)lbp, l1 = *(const f32x4*)(lbp + 4);
#pragma unroll
                    for (int ai = 0; ai < 2; ++ai)
#pragma unroll
                        for (int m = 0; m < 4; ++m) { const f32x4 v0 = acc[ai][bj][m][0], v1 = acc[ai][bj][m][1]; _Float16 o[8];
#pragma unroll
                            for (int j = 0; j < 4; ++j) { const float s0 = __builtin_amdgcn_rcpf(1.f + __builtin_amdgcn_exp2f(v0[j] * -1.44269504f)), s1 = __builtin_amdgcn_rcpf(1.f + __builtin_amdgcn_exp2f(v1[j] * -1.44269504f));
                                o[j] = (_Float16)__builtin_amdgcn_logf(l0[j] + (1.f - l0[j]) * s0); o[4 + j] = (_Float16)__builtin_amdgcn_logf(l1[j] + (1.f - l1[j]) * s1); }
                            __builtin_nontemporal_store(__builtin_bit_cast(u32x4, o), (u32x4*)(O + (plane + t0 + ai * HALF + m * 16) * 128 + dcol)); }
                } else {
                    bf16_t* O = zbase ? (bf16_t*)(zbase + (size_t)(seg == 0 ? 0 : 160) * MiB) : ci;
#pragma unroll
                    for (int ai = 0; ai < 2; ++ai)
#pragma unroll
                        for (int m = 0; m < 4; ++m) { const f32x4 v0 = acc[ai][bj][m][0], v1 = acc[ai][bj][m][1];
                            u32x4 w; w.x = cvt_pk_bf16(v0[0], v0[1]); w.y = cvt_pk_bf16(v0[2], v0[3]); w.z = cvt_pk_bf16(v1[0], v1[1]); w.w = cvt_pk_bf16(v1[2], v1[3]);
                            __builtin_nontemporal_store(w, (u32x4*)(O + (plane + t0 + ai * HALF + m * 16) * 128 + dcol)); }
                }
            }
        } else if (seg >= 6) {
            const int col0 = (u.pn - 12) * 128 + wc * 32 + 8 * fq;
            bf16_t* O = (bf16_t*)(zbase + (size_t)(32 * 6 + 64) * MiB);
#pragma unroll
            for (int ai = 0; ai < 2; ++ai)
#pragma unroll
                for (int m = 0; m < 4; ++m) { const f32x4 v0 = acc[ai][0][m][0] * acc[ai][1][m][0], v1 = acc[ai][0][m][1] * acc[ai][1][m][1];
                    u32x4 w; w.x = cvt_pk_bf16(v0[0], v0[1]); w.y = cvt_pk_bf16(v0[2], v0[3]); w.z = cvt_pk_bf16(v1[0], v1[1]); w.w = cvt_pk_bf16(v1[2], v1[3]);
                    __builtin_nontemporal_store(w, (u32x4*)(O + (size_t)(row0 + ai * HALF + m * 16) * 512 + col0)); }
        } else {
            const int col0 = (u.pn & 1) * 256 + wc * 32 + 8 * fq;
            bf16_t* O = (bf16_t*)(zbase + (size_t)(32 * seg + 64) * MiB);
#pragma unroll
            for (int ai = 0; ai < 2; ++ai)
#pragma unroll
                for (int m = 0; m < 4; ++m) { bf16_t* rowp = O + (size_t)(row0 + ai * HALF + m * 16) * 512 + col0;
#pragma unroll
                    for (int bj = 0; bj < 2; ++bj) { const f32x4 v0 = acc[ai][bj][m][0], v1 = acc[ai][bj][m][1];
                        u32x4 w; w.x = cvt_pk_bf16(v0[0], v0[1]); w.y = cvt_pk_bf16(v0[2], v0[3]); w.z = cvt_pk_bf16(v1[0], v1[1]); w.w = cvt_pk_bf16(v1[2], v1[3]);
                        __builtin_nontemporal_store(w, (u32x4*)(rowp + bj * HALF)); } }
        }
    }
};
struct EpiOut {
    static constexpr bool PERM = true;
    const float* x; bf16_t* x1; const float* modf;
    __device__ __forceinline__ void operator()(const f32x4 (&acc)[2][2][4][2], const Unit& u, int wr, int wc, int fr, int fq) const {
        const int row0 = u.pm * BM + wr * 64 + fr, col0 = u.pn * BM + wc * 32 + 8 * fq;
        const int b = (u.pm * BM) / T;
        const float* g1 = modf + (size_t)b * NMOD + 2 * D;
        f32x4 gv[2][2];
#pragma unroll
        for (int bj = 0; bj < 2; ++bj)
#pragma unroll
            for (int n = 0; n < 2; ++n) gv[bj][n] = *(const f32x4*)(g1 + col0 + bj * HALF + 4 * n);
#pragma unroll
        for (int ai = 0; ai < 2; ++ai)
#pragma unroll
            for (int m = 0; m < 4; ++m) { const size_t off = (size_t)(row0 + ai * HALF + m * 16) * D + col0;
#pragma unroll
                for (int bj = 0; bj < 2; ++bj) {
                    const f32x4 x0 = __builtin_nontemporal_load((const f32x4*)(x + off + bj * HALF)), x1v = __builtin_nontemporal_load((const f32x4*)(x + off + bj * HALF + 4));
                    const f32x4 v0 = x0 + gv[bj][0] * acc[ai][bj][m][0], v1 = x1v + gv[bj][1] * acc[ai][bj][m][1];
                    u32x4 w; w.x = cvt_pk_bf16(v0[0], v0[1]); w.y = cvt_pk_bf16(v0[2], v0[3]); w.z = cvt_pk_bf16(v1[0], v1[1]); w.w = cvt_pk_bf16(v1[2], v1[3]);
                    __builtin_nontemporal_store(w, (u32x4*)(x1 + off + bj * HALF)); }
                asm volatile("" ::: "memory"); }
    }
};
struct EpiMoe1 {
    static constexpr bool PERM = true;
    uchar* hid;
    __device__ __forceinline__ void operator()(const f32x4 (&acc)[2][2][4][2], const Unit& u, int wr, int wc, int fr, int fq) const {
        const int row0 = u.pm * BM + wr * 64 + fr, col0 = u.pn * 128 + wc * 32 + 8 * fq;
#pragma unroll
        for (int ai = 0; ai < 2; ++ai)
#pragma unroll
            for (int m = 0; m < 4; ++m) { uchar* rowp = hid + (size_t)(row0 + ai * HALF + m * 16) * DFF + col0;
                float o[8];
#pragma unroll
                for (int n = 0; n < 2; ++n)
#pragma unroll
                    for (int j = 0; j < 4; ++j) { const float gt = acc[ai][0][m][n][j] * 0.03125f, up = acc[ai][1][m][n][j] * 0.03125f; o[n * 4 + j] = gt * up * __builtin_amdgcn_rcpf(1.f + __builtin_amdgcn_exp2f(gt * -1.44269504f)); }
                u32x2 w; w.x = cvt_pk4_fp8(o[0], o[1], o[2], o[3]); w.y = cvt_pk4_fp8(o[4], o[5], o[6], o[7]);
                __builtin_nontemporal_store(w, (u32x2*)rowp); }
    }
};
struct EpiMoe2 {
    static constexpr bool PERM = true;
    uchar* ys; const LAS float* lgate;
    __device__ __forceinline__ void operator()(const f32x4 (&acc)[2][2][4][2], const Unit& u, int wr, int wc, int fr, int fq) const {
        const int row0 = u.pm * BM + wr * 64 + fr, col0 = u.pn * BM + wc * 32 + 8 * fq;
        const LAS float* gt_ = lgate + (u.e >> 2) * BM + wr * 64 + fr;
#pragma unroll
        for (int ai = 0; ai < 2; ++ai)
#pragma unroll
            for (int m = 0; m < 4; ++m) { const int row = row0 + ai * HALF + m * 16; const float gt = gt_[ai * HALF + m * 16] * 0.5f; uchar* rowp = ys + (size_t)row * D + col0;
#pragma unroll
                for (int bj = 0; bj < 2; ++bj) { const f32x4 v0 = acc[ai][bj][m][0] * gt, v1 = acc[ai][bj][m][1] * gt;
                    u32x2 w; w.x = cvt_pk4_fp8(v0[0], v0[1], v0[2], v0[3]); w.y = cvt_pk4_fp8(v1[0], v1[1], v1[2], v1[3]);
                    __builtin_nontemporal_store(w, (u32x2*)(rowp + bj * HALF)); } }
    }
};
}

struct Args {
    const float *x, *c, *ctx, *c_ctx, *w_ada, *b_ada, *norm_mix, *norm_ffn, *w_in, *lb_logits, *hg_norm, *conv_w, *w_out, *w_router, *w_gate, *w_up, *w_down, *norm_final;
    float* out; uchar* ws; int ph_lo, ph_hi;
};

__device__ __forceinline__ void cvt_item(const float* W, int ldw, bf16_t* WT, int ldt, int k0, int n0, int nrow0, LAS float* scr, int lane) {
    const int r = lane >> 3, c4 = lane & 7;
    f32x4 v[8];
#pragma unroll
    for (int i = 0; i < 8; ++i) v[i] = __builtin_nontemporal_load((const f32x4*)(W + (size_t)(k0 + 8 * i + r) * ldw + n0 + 4 * c4));
#pragma unroll
    for (int i = 0; i < 8; ++i) { LAS float* d = scr + (8 * i + r) * 33 + 4 * c4; d[0] = v[i].x; d[1] = v[i].y; d[2] = v[i].z; d[3] = v[i].w; }
    LDS_WAIT(); asm volatile("" ::: "memory");
    const int c = lane & 7;
#pragma unroll
    for (int j = 0; j < 4; ++j) { const int n = (lane >> 3) + 8 * j; const LAS float* sp = scr + (8 * c) * 33 + n;
        u32x4 o; o.x = cvt_pk_bf16(sp[0 * 33], sp[1 * 33]); o.y = cvt_pk_bf16(sp[2 * 33], sp[3 * 33]); o.z = cvt_pk_bf16(sp[4 * 33], sp[5 * 33]); o.w = cvt_pk_bf16(sp[6 * 33], sp[7 * 33]);
        *(u32x4*)(WT + (size_t)(nrow0 + n) * ldt + k0 + 8 * c) = o; }
    LDS_WAIT(); asm volatile("" ::: "memory");
}

__device__ __forceinline__ void cvt_item_fp8(const float* W, int ldw, uchar* WT, int ldt, int k0, int n0, int nrow0, LAS float* scr, int lane) {
    const int r = lane >> 3, c4 = lane & 7;
    f32x4 v[8];
#pragma unroll
    for (int i = 0; i < 8; ++i) v[i] = __builtin_nontemporal_load((const f32x4*)(W + (size_t)(k0 + 8 * i + r) * ldw + n0 + 4 * c4));
#pragma unroll
    for (int i = 0; i < 8; ++i) { LAS float* d = scr + (8 * i + r) * 33 + 4 * c4; d[0] = v[i].x; d[1] = v[i].y; d[2] = v[i].z; d[3] = v[i].w; }
    LDS_WAIT(); asm volatile("" ::: "memory");
    const int c = lane & 7;
#pragma unroll
    for (int j = 0; j < 4; ++j) { const int n = (lane >> 3) + 8 * j; const LAS float* sp = scr + (8 * c) * 33 + n;
        u32x2 o; o.x = cvt_pk4_fp8(sp[0 * 33] * 32.f, sp[1 * 33] * 32.f, sp[2 * 33] * 32.f, sp[3 * 33] * 32.f); o.y = cvt_pk4_fp8(sp[4 * 33] * 32.f, sp[5 * 33] * 32.f, sp[6 * 33] * 32.f, sp[7 * 33] * 32.f);
        *(u32x2*)(WT + (size_t)(nrow0 + n) * ldt + k0 + 8 * c) = o; }
    LDS_WAIT(); asm volatile("" ::: "memory");
}

__device__ __forceinline__ void phase_prep(const Args& a, LAS uchar* lds, int bid, int G, int tid, int wid, int lane) {
    float* modp = (float*)(a.ws + WS_MODP);
    if (bid < 192) {
        const int cgp = bid % 24, ks = bid / 24, n0 = cgp * 256 + lane * 4, k0 = ks * 128 + wid * 16;
        LAS float* sc = (LAS float*)(lds + 81920);
        for (int i = tid; i < 9 * 128; i += 512) { const int r = i >> 7, kk = i & 127; sc[i] = silu_f((r < 8) ? a.c[r * D + ks * 128 + kk] : a.c_ctx[ks * 128 + kk]); }
        f32x4 w[16];
#pragma unroll
        for (int kk = 0; kk < 16; ++kk) w[kk] = __builtin_nontemporal_load((const f32x4*)(a.w_ada + (size_t)(k0 + kk) * NMOD + n0));
        __syncthreads();
        f32x4 acc[9];
#pragma unroll
        for (int r = 0; r < 9; ++r) acc[r] = (f32x4){0.f, 0.f, 0.f, 0.f};
#pragma unroll
        for (int kk = 0; kk < 16; ++kk) {
#pragma unroll
            for (int r = 0; r < 9; ++r) acc[r] += w[kk] * sc[r * 128 + wid * 16 + kk]; }
        LAS f32x4* red = (LAS f32x4*)lds;
#pragma unroll
        for (int r = 0; r < 9; ++r) red[(wid * 9 + r) * 64 + lane] = acc[r];
        __syncthreads();
        for (int o = tid; o < 9 * 64; o += 512) { const int r = o / 64, l = o % 64; f32x4 sm = red[(0 * 9 + r) * 64 + l];
#pragma unroll
            for (int w8 = 1; w8 < 8; ++w8) sm += red[(w8 * 9 + r) * 64 + l];
            if (ks == 0) sm += *(const f32x4*)(a.b_ada + cgp * 256 + l * 4);
            *(f32x4*)(modp + ((size_t)ks * 9 + r) * NMOD + cgp * 256 + l * 4) = sm; }
        __syncthreads();
    }
    if (bid == 255) {
        float* lb = (float*)(a.ws + WS_LB);
        for (int i = tid; i < 1024; i += 512) { const float l0 = a.lb_logits[i], l1 = a.lb_logits[1024 + i]; lb[i] = 1.f / (1.f + __expf(l1 - l0)); }
    }
    LAS float* scr = (LAS float*)lds + wid * (64 * 33);
    const int gw = (G - 1 - bid) * 8 + wid, NGW = G * 8;
    constexpr int I_IN = (D / 64) * (NIN / 32), I_OUT = (D / 64) * (D / 32);
    for (int it = gw; it < I_IN + I_OUT; it += NGW) {
        if (it < I_IN) { const int nblk = NIN / 32, kb = it / nblk, nb = it % nblk; const int n0 = nb * 32;
            const int nrow = (n0 < 3072) ? n0 : 3072 + (((n0 - 3072) & 511) >> 7) * 256 + ((n0 - 3072) & 127) + ((n0 >= 3584) ? 128 : 0);
            cvt_item(a.w_in, NIN, (bf16_t*)(a.ws + WS_WIN), D, kb * 64, n0, nrow, scr, lane); }
        else { const int r = it - I_IN, nblk = D / 32, kb = r / nblk, nb = r % nblk; cvt_item(a.w_out, D, (bf16_t*)(a.ws + WS_WOUT), D, kb * 64, nb * 32, nb * 32, scr, lane); }
    }
}

__device__ __forceinline__ float modp_sum(const float* modp, int r, int col) { float s = 0.f;
#pragma unroll
    for (int ks = 0; ks < 8; ++ks) s += modp[((size_t)ks * 9 + r) * NMOD + col];
    return s; }
template <int NR>
__device__ __forceinline__ void norm_rows(const float* xrow0, bf16_t* orow0, const LAS float* gm, const LAS float* sh, int lane) {
    f32x4 v[NR][4]; float ss[NR];
#pragma unroll
    for (int i = 0; i < NR; ++i) { ss[i] = 0.f;
#pragma unroll
        for (int j = 0; j < 4; ++j) v[i][j] = __builtin_nontemporal_load((const f32x4*)(xrow0 + (size_t)i * D) + lane + 64 * j); }
#pragma unroll
    for (int i = 0; i < NR; ++i) {
#pragma unroll
        for (int j = 0; j < 4; ++j) ss[i] += (v[i][j].x * v[i][j].x + v[i][j].y * v[i][j].y) + (v[i][j].z * v[i][j].z + v[i][j].w * v[i][j].w);
        ss[i] = rsqrtf(wave_sum(ss[i]) * (1.f / D) + EPS); }
#pragma unroll
    for (int j = 0; j < 4; ++j) { const f32x4 g4 = *((const LAS f32x4*)gm + lane + 64 * j), s4 = *((const LAS f32x4*)sh + lane + 64 * j);
#pragma unroll
        for (int i = 0; i < NR; ++i) { const f32x4 o = v[i][j] * ss[i] * g4 + s4;
            u32x2 w; w.x = cvt_pk_bf16(o.x, o.y); w.y = cvt_pk_bf16(o.z, o.w); *((u32x2*)(orow0 + (size_t)i * D) + lane + 64 * j) = w; } }
}
__device__ __forceinline__ void phase_norm(const Args& a, LAS uchar* lds, int bid, int G, int tid, int wid, int lane) {
    const float* modp = (const float*)(a.ws + WS_MODP); float* modf = (float*)(a.ws + WS_MODF);
    { const int gt = bid * 512 + tid; if (gt < 9 * NMOD) modf[gt] = modp_sum(modp, gt / NMOD, gt % NMOD); }
    LAS float* gm = (LAS float*)lds; LAS float* sh = gm + D; LAS float* cgm = sh + D; LAS float* csh = cgm + D;
    const int b = bid / 32;
    for (int cidx = tid; cidx < D; cidx += 512) { const float nm = a.norm_mix[cidx];
        sh[cidx] = modp_sum(modp, b, cidx); gm[cidx] = nm * (1.f + modp_sum(modp, b, D + cidx));
        csh[cidx] = modp_sum(modp, 8, cidx); cgm[cidx] = nm * (1.f + modp_sum(modp, 8, D + cidx)); }
    __syncthreads();
    bf16_t* hx = (bf16_t*)(a.ws + WS_ACT); bf16_t* hc = (bf16_t*)(a.ws + WS_HC);
    { const int row = bid * 8 + wid; norm_rows<1>(a.ctx + (size_t)row * D, hc + (size_t)row * D, cgm, csh, lane); }
    for (int j = 0; j < 16; j += 4) { const int row = bid * 128 + wid * 16 + j; norm_rows<4>(a.x + (size_t)row * D, hx + (size_t)row * D, gm, sh, lane); }
    __syncthreads();
}

constexpr int GL_QDP = 0, GL_KIP = 8704, GL_SET0 = 17408, GL_SETSZ = 20992, GL_VTPO = 10240, GL_DECO = 20480, GL_TOT = 59392, GL_RING = 61440, GL_SLOT = 24576;
static_assert(GL_RING + 3 * GL_SLOT <= LDS_BYTES - 16, "GLA LDS map");
#define GLA_BAR() do { asm volatile("s_waitcnt lgkmcnt(0)" ::: "memory"); __builtin_amdgcn_s_barrier(); asm volatile("" ::: "memory"); } while (0)
template <bool FULL>
__device__ __forceinline__ void gla_item(LAS uchar* lds, const bf16_t* qb, const _Float16* lfb, const bf16_t* vb, bf16_t* ob, f32x4 (&S)[8][2], float* dl_out,
                                         int row_base, int Tn, int tau0, int nch, int h, int dir, int wid, int lane) {
    const int fr = lane & 15, fq = lane >> 4;
    const bool prod = wid < 4; const int pw = wid & 3;
    constexpr int NT = FULL ? 6 : 4;
    f32x2 kk_[8], cs[8]; unsigned qv[8]; f32x2 dsum = (f32x2){0.f, 0.f};
    const int d0 = 2 * lane, pos0 = (d0 & ~31) + 8 * ((d0 >> 2) & 3) + 4 * ((d0 >> 4) & 1) + (d0 & 3);
#define GLA_ISSUE(c) do { LAS uchar* _sl = lds + GL_RING + ((c) % 3) * GL_SLOT + pw * 6144; \
        _Pragma("unroll") for (int _g = 0; _g < 2; ++_g) { const int _tau = tau0 + 32 * (c) + 8 * pw + 4 * _g + (lane >> 4); const size_t _o = (size_t)(dir ? (Tn - 1 - _tau) : _tau) * 128 + (lane & 15) * 8; \
            __builtin_amdgcn_global_load_lds((const unsigned*)(lfb + _o), (LAS unsigned*)(_sl + _g * 1024), 16, 0, 2); \
            if (FULL) __builtin_amdgcn_global_load_lds((const unsigned*)(qb + _o), (LAS unsigned*)(_sl + 2048 + _g * 1024), 16, 0, 2); \
            __builtin_amdgcn_global_load_lds((const unsigned*)(vb + _o), (LAS unsigned*)(_sl + 4096 + _g * 1024), 16, 0, 2); } } while (0)
#define GLA_P1(c) do { \
        if ((c) + 2 < nch) { if (FULL) asm volatile("s_waitcnt vmcnt(12)" ::: "memory"); else asm volatile("s_waitcnt vmcnt(8)" ::: "memory"); } \
        else if ((c) + 1 < nch) { if (FULL) asm volatile("s_waitcnt vmcnt(6)" ::: "memory"); else asm volatile("s_waitcnt vmcnt(4)" ::: "memory"); } \
        else asm volatile("s_waitcnt vmcnt(0)" ::: "memory"); \
        const LAS uchar* _sl = lds + GL_RING + ((c) % 3) * GL_SLOT + pw * 6144; \
        LAS uchar* _set1 = lds + GL_SET0 + ((c) & 1) * GL_SETSZ; \
        unsigned _vv[8]; f32x2 _lf[8]; \
        _Pragma("unroll") for (int _r = 0; _r < 8; ++_r) { typedef _Float16 h2_t __attribute__((ext_vector_type(2))); const h2_t _hv = *(const LAS h2_t*)(_sl + _r * 256 + lane * 4); _lf[_r] = (f32x2){(float)_hv.x, (float)_hv.y}; \
            _vv[_r] = *(const LAS unsigned*)(_sl + 4096 + _r * 256 + lane * 4); qv[_r] = FULL ? *(const LAS unsigned*)(_sl + 2048 + _r * 256 + lane * 4) : 0u; } \
        cs[0] = _lf[0]; _Pragma("unroll") for (int _r = 1; _r < 8; ++_r) cs[_r] = cs[_r - 1] + _lf[_r]; \
        ((LAS f32x2*)(lds + GL_TOT))[pw * 64 + lane] = cs[7]; \
        _Pragma("unroll") for (int _r = 0; _r < 8; ++_r) kk_[_r] = 1.f - (f32x2){__builtin_amdgcn_exp2f(_lf[_r].x), __builtin_amdgcn_exp2f(_lf[_r].y)}; \
        _Pragma("unroll") for (int _g = 0; _g < 2; ++_g) { const int _sp = 8 * ((2 * pw + _g) & 3) + 4 * (pw >> 1);     \
            u32x2 _v0, _v1; _v0.x = (_vv[4 * _g] & 0xffffu) | (_vv[4 * _g + 1] << 16); _v0.y = (_vv[4 * _g + 2] & 0xffffu) | (_vv[4 * _g + 3] << 16); \
            _v1.x = (_vv[4 * _g] >> 16) | (_vv[4 * _g + 1] & 0xffff0000u); _v1.y = (_vv[4 * _g + 2] >> 16) | (_vv[4 * _g + 3] & 0xffff0000u); \
            *(LAS u32x2*)(_set1 + GL_VTPO + (d0) * 80 + _sp * 2) = _v0; *(LAS u32x2*)(_set1 + GL_VTPO + (d0 + 1) * 80 + _sp * 2) = _v1; } } while (0)
#define GLA_P2(c) do { \
        if ((c) + 3 < nch) GLA_ISSUE((c) + 3);     \
        f32x2 _pre = (f32x2){0.f, 0.f}, _all = (f32x2){0.f, 0.f}; \
        _Pragma("unroll") for (int _w = 0; _w < 4; ++_w) { const f32x2 _tw = ((const LAS f32x2*)(lds + GL_TOT))[_w * 64 + lane]; _all += _tw; if (_w < pw) _pre += _tw; } \
        dsum += _all; \
        const f32x2 _dec = (f32x2){__builtin_amdgcn_exp2f(_all.x), __builtin_amdgcn_exp2f(_all.y)}; \
        LAS uchar* _set = lds + GL_SET0 + ((c) & 1) * GL_SETSZ; \
        f32x2 _kE[8]; \
        _Pragma("unroll") for (int _r = 0; _r < 8; ++_r) { \
            const f32x2 _cum = _pre + cs[_r]; \
            const f32x2 _ki = kk_[_r] * (f32x2){__builtin_amdgcn_exp2f(-_cum.x), __builtin_amdgcn_exp2f(-_cum.y)}; \
            _kE[_r] = _ki * _dec; \
            if (FULL) { const int _s = 8 * pw + _r; const f32x2 _qd = (f32x2){bf_lo(qv[_r]), bf_hi(qv[_r])} * (f32x2){__builtin_amdgcn_exp2f(_cum.x), __builtin_amdgcn_exp2f(_cum.y)}; \
                *(LAS unsigned*)(lds + GL_QDP + _s * 272 + pos0 * 2) = cvt_pk_bf16(_qd.x, _qd.y); \
                *(LAS unsigned*)(lds + GL_KIP + _s * 272 + pos0 * 2) = cvt_pk_bf16(_ki.x, _ki.y); } } \
        _Pragma("unroll") for (int _g = 0; _g < 2; ++_g) { const int _sp = 8 * ((2 * pw + _g) & 3) + 4 * (pw >> 1);     \
            u32x2 _w0, _w1; _w0.x = cvt_pk_bf16(_kE[4 * _g].x, _kE[4 * _g + 1].x); _w0.y = cvt_pk_bf16(_kE[4 * _g + 2].x, _kE[4 * _g + 3].x); \
            _w1.x = cvt_pk_bf16(_kE[4 * _g].y, _kE[4 * _g + 1].y); _w1.y = cvt_pk_bf16(_kE[4 * _g + 2].y, _kE[4 * _g + 3].y); \
            *(LAS u32x2*)(_set + (d0) * 80 + _sp * 2) = _w0; *(LAS u32x2*)(_set + (d0 + 1) * 80 + _sp * 2) = _w1; \
} \
        if (pw == 0) *(LAS f32x2*)(_set + GL_DECO + lane * 8) = _dec; } while (0)

    if (prod) {
        GLA_ISSUE(0); if (nch > 1) GLA_ISSUE(1); if (nch > 2) GLA_ISSUE(2);
        GLA_P1(0);
        GLA_BAR();
        GLA_P2(0);
        GLA_BAR();
        for (int n = 0; n < nch; ++n) {
            if (n + 1 < nch) GLA_P1(n + 1);
            GLA_BAR();
            if (n + 1 < nch) GLA_P2(n + 1);
            GLA_BAR();
        }
    } else {
        u32x4 sAp[4][2];
#define GLA_SCVT() do { _Pragma("unroll") for (int _kk = 0; _kk < 4; ++_kk) _Pragma("unroll") for (int _vt = 0; _vt < 2; ++_vt) { \
            sAp[_kk][_vt].x = cvt_pk_bf16_safe(S[2 * _kk][_vt][0], S[2 * _kk][_vt][1]); sAp[_kk][_vt].y = cvt_pk_bf16_safe(S[2 * _kk][_vt][2], S[2 * _kk][_vt][3]); \
            sAp[_kk][_vt].z = cvt_pk_bf16_safe(S[2 * _kk + 1][_vt][0], S[2 * _kk + 1][_vt][1]); sAp[_kk][_vt].w = cvt_pk_bf16_safe(S[2 * _kk + 1][_vt][2], S[2 * _kk + 1][_vt][3]); } } while (0)
        if (FULL) GLA_SCVT();
        GLA_BAR();
        GLA_BAR();
        for (int n = 0; n < nch; ++n) {
            const LAS uchar* set = lds + GL_SET0 + (n & 1) * GL_SETSZ;
            bf16x8 vtf[2];
#pragma unroll
            for (int vt = 0; vt < 2; ++vt) vtf[vt] = *(const LAS bf16x8*)(set + GL_VTPO + (32 * pw + 16 * vt + fr) * 80 + fq * 16);
            if (FULL) {
                bf16x8 qf[2][4];
#pragma unroll
                for (int ti = 0; ti < 2; ++ti)
#pragma unroll
                    for (int kk = 0; kk < 4; ++kk) qf[ti][kk] = *(const LAS bf16x8*)(lds + GL_QDP + (16 * ti + fr) * 272 + kk * 64 + fq * 16);
                f32x4 oT[2][2];
#pragma unroll
                for (int vt = 0; vt < 2; ++vt)
#pragma unroll
                    for (int ti = 0; ti < 2; ++ti) oT[vt][ti] = (f32x4){0.f, 0.f, 0.f, 0.f};
                f32x4 p00 = (f32x4){0.f, 0.f, 0.f, 0.f}, p01 = p00, p11 = p00;
#pragma unroll
                for (int kk = 0; kk < 4; ++kk) {
                    const bf16x8 kj0 = *(const LAS bf16x8*)(lds + GL_KIP + (fr) * 272 + kk * 64 + fq * 16);
                    const bf16x8 kj1 = *(const LAS bf16x8*)(lds + GL_KIP + (16 + fr) * 272 + kk * 64 + fq * 16);
                    p00 = __builtin_amdgcn_mfma_f32_16x16x32_bf16(kj0, qf[0][kk], p00, 0, 0, 0);
                    p01 = __builtin_amdgcn_mfma_f32_16x16x32_bf16(kj0, qf[1][kk], p01, 0, 0, 0);
                    p11 = __builtin_amdgcn_mfma_f32_16x16x32_bf16(kj1, qf[1][kk], p11, 0, 0, 0);
#pragma unroll
                    for (int vt = 0; vt < 2; ++vt) {
                        const bf16x8 sA = __builtin_bit_cast(bf16x8, sAp[kk][vt]);
                        oT[vt][0] = __builtin_amdgcn_mfma_f32_16x16x32_bf16(sA, qf[0][kk], oT[vt][0], 0, 0, 0);
                        oT[vt][1] = __builtin_amdgcn_mfma_f32_16x16x32_bf16(sA, qf[1][kk], oT[vt][1], 0, 0, 0); }
                }
                u32x4 pb0, pb1;
                { float m0[4], m1[4];
#pragma unroll
                  for (int r = 0; r < 4; ++r) { const bool ok = (4 * fq + r) <= fr; m0[r] = ok ? p00[r] : 0.f; m1[r] = ok ? p11[r] : 0.f; }
                  pb0.x = cvt_pk_bf16_safe(m0[0], m0[1]); pb0.y = cvt_pk_bf16_safe(m0[2], m0[3]); pb0.z = 0u; pb0.w = 0u;
                  pb1.x = cvt_pk_bf16_safe(p01[0], p01[1]); pb1.y = cvt_pk_bf16_safe(p01[2], p01[3]); pb1.z = cvt_pk_bf16_safe(m1[0], m1[1]); pb1.w = cvt_pk_bf16_safe(m1[2], m1[3]); }
#pragma unroll
                for (int vt = 0; vt < 2; ++vt) {
                    oT[vt][0] = __builtin_amdgcn_mfma_f32_16x16x32_bf16(vtf[vt], __builtin_bit_cast(bf16x8, pb0), oT[vt][0], 0, 0, 0);
                    oT[vt][1] = __builtin_amdgcn_mfma_f32_16x16x32_bf16(vtf[vt], __builtin_bit_cast(bf16x8, pb1), oT[vt][1], 0, 0, 0); }
#pragma unroll
                for (int ti = 0; ti < 2; ++ti) { const int tau = tau0 + 32 * n + 16 * ti + fr; const size_t row = (size_t)(row_base + (dir ? (Tn - 1 - tau) : tau));
#pragma unroll
                    for (int vt = 0; vt < 2; ++vt) { u32x2 w; w.x = cvt_pk_bf16_safe(oT[vt][ti][0], oT[vt][ti][1]); w.y = cvt_pk_bf16_safe(oT[vt][ti][2], oT[vt][ti][3]);
                        *(u32x2*)(ob + row * 512 + h * 128 + 32 * pw + 16 * vt + 4 * fq) = w; } }
            }
            GLA_BAR();
#pragma unroll
            for (int t8 = 0; t8 < 8; ++t8) {
                const f32x4 dc = *(const LAS f32x4*)(set + GL_DECO + (16 * t8 + 4 * fq) * 4);
                const bf16x8 ka = *(const LAS bf16x8*)(set + (16 * t8 + fr) * 80 + fq * 16);
#pragma unroll
                for (int vt = 0; vt < 2; ++vt) S[t8][vt] = __builtin_amdgcn_mfma_f32_16x16x32_bf16(ka, vtf[vt], S[t8][vt] * dc, 0, 0, 0);
            }
            if (FULL && n + 1 < nch) GLA_SCVT();
            GLA_BAR();
        }
#undef GLA_SCVT
    }
#undef GLA_ISSUE
#undef GLA_P1
#undef GLA_P2
    if (dl_out && wid == 0) *(f32x2*)(dl_out + 2 * lane) = dsum;
    asm volatile("s_waitcnt vmcnt(0)" ::: "memory");
    GLA_BAR();
}
__device__ __forceinline__ void gla_state_store(float* p, const f32x4 (&S)[8][2], int cw, int fr, int fq) {
#pragma unroll
    for (int t8 = 0; t8 < 8; ++t8)
#pragma unroll
        for (int vt = 0; vt < 2; ++vt)
#pragma unroll
            for (int r = 0; r < 4; ++r) p[(size_t)(16 * t8 + 4 * fq + r) * 128 + 32 * cw + 16 * vt + fr] = S[t8][vt][r];
}
__device__ __forceinline__ void phase_gla_states(const Args& a, LAS uchar* lds, int bid, int wid, int lane) {
    uchar* ws = a.ws; const int fr = lane & 15, fq = lane >> 4;
    f32x4 S[8][2];
#pragma unroll
    for (int t8 = 0; t8 < 8; ++t8) { S[t8][0] = (f32x4){0.f, 0.f, 0.f, 0.f}; S[t8][1] = (f32x4){0.f, 0.f, 0.f, 0.f}; }
    if (bid < 192) { const int bhd = bid / 3, seg = bid % 3, b = bhd >> 3, h = (bhd >> 1) & 3, dir = bhd & 1;
        const size_t pl = (size_t)(b * NH + h) * T * 128;
        gla_item<false>(lds, nullptr, (const _Float16*)(ws + (dir ? WS_LBW : WS_LF)) + pl, (const bf16_t*)(ws + WS_ZI) + pl, nullptr, S, (float*)(ws + WS_DL) + (size_t)bid * 128,
                        b * T, T, seg * 1024, 32, h, dir, wid, lane);
        if (wid >= 4) gla_state_store((float*)(ws + WS_SL) + (size_t)bid * 16384, S, wid - 4, fr, fq);
    } else { const int bhd = bid - 192, b = bhd >> 3, h = (bhd >> 1) & 3, dir = bhd & 1;
        const size_t pl = (size_t)(b * NH + h) * CT * 128;
        gla_item<false>(lds, nullptr, (const _Float16*)(ws + (dir ? WS_CLB : WS_CLF)) + pl, (const bf16_t*)(ws + WS_CI) + pl, nullptr, S, nullptr, b * CT, CT, 0, CT / 32, h, dir, wid, lane);
        if (wid >= 4) gla_state_store((float*)(ws + WS_S0) + (size_t)bhd * 16384, S, wid - 4, fr, fq);
    }
}
__device__ __forceinline__ void phase_gla_out(const Args& a, LAS uchar* lds, int bid, int wid, int lane) {
    uchar* ws = a.ws; const int fr = lane & 15, fq = lane >> 4;
    const int bhd = bid >> 2, seg = bid & 3, b = bhd >> 3, h = (bhd >> 1) & 3, dir = bhd & 1;
    f32x4 S[8][2];
    if (wid >= 4) { const int cw = wid - 4;
        { const float* p = (const float*)(ws + WS_S0) + (size_t)bhd * 16384;
#pragma unroll
          for (int t8 = 0; t8 < 8; ++t8)
#pragma unroll
              for (int vt = 0; vt < 2; ++vt)
#pragma unroll
                  for (int r = 0; r < 4; ++r) S[t8][vt][r] = p[(size_t)(16 * t8 + 4 * fq + r) * 128 + 32 * cw + 16 * vt + fr]; }
        for (int j = 0; j < seg; ++j) { const float* p = (const float*)(ws + WS_SL) + (size_t)(bhd * 3 + j) * 16384; const float* dl = (const float*)(ws + WS_DL) + (size_t)(bhd * 3 + j) * 128;
#pragma unroll
            for (int t8 = 0; t8 < 8; ++t8) { const f32x4 dv = *(const f32x4*)(dl + 16 * t8 + 4 * fq);
#pragma unroll
                for (int vt = 0; vt < 2; ++vt)
#pragma unroll
                    for (int r = 0; r < 4; ++r) S[t8][vt][r] = __builtin_amdgcn_exp2f(dv[r]) * S[t8][vt][r] + p[(size_t)(16 * t8 + 4 * fq + r) * 128 + 32 * cw + 16 * vt + fr]; } }
    } else {
#pragma unroll
        for (int t8 = 0; t8 < 8; ++t8) { S[t8][0] = (f32x4){0.f, 0.f, 0.f, 0.f}; S[t8][1] = (f32x4){0.f, 0.f, 0.f, 0.f}; }
    }
    asm volatile("s_waitcnt vmcnt(0)" ::: "memory");
    const size_t pl = (size_t)(b * NH + h) * T * 128;
    gla_item<true>(lds, (const bf16_t*)(ws + WS_ZQ) + pl, (const _Float16*)(ws + (dir ? WS_LBW : WS_LF)) + pl, (const bf16_t*)(ws + WS_ZI) + pl, (bf16_t*)(ws + (dir ? WS_OB : WS_OF)), S, nullptr,
                   b * T, T, seg * 1024, 32, h, dir, wid, lane);
}

__device__ __forceinline__ void unpack8(const u32x4 w, float (&f)[8]) { f[0] = bf_lo(w.x); f[1] = bf_hi(w.x); f[2] = bf_lo(w.y); f[3] = bf_hi(w.y); f[4] = bf_lo(w.z); f[5] = bf_hi(w.z); f[6] = bf_lo(w.w); f[7] = bf_hi(w.w); }
__device__ __forceinline__ void phase_mixfin(const Args& a, int bid, int G, int wid, int lane) {
    const bf16_t* of = (const bf16_t*)(a.ws + WS_OF); const bf16_t* obw = (const bf16_t*)(a.ws + WS_OB); const bf16_t* zg = (const bf16_t*)(a.ws + WS_ZG);
    const bf16_t* zgb = (const bf16_t*)(a.ws + WS_ZGB); const bf16_t* zgc = (const bf16_t*)(a.ws + WS_ZGC);
    bf16_t* A2 = (bf16_t*)(a.ws + WS_ACT);
    const int c0 = 8 * lane;
    float gain[8], cw0[8], cw1[8], cw2[8];
#pragma unroll
    for (int j = 0; j < 8; ++j) { gain[j] = a.hg_norm[(c0 + j) & 127]; cw0[j] = a.conv_w[c0 + j]; cw1[j] = a.conv_w[512 + c0 + j]; cw2[j] = a.conv_w[1024 + c0 + j]; }
    for (int row = bid * 8 + wid; row < M; row += G * 8) {
        const size_t ro = (size_t)row * 512 + c0;
        float f0[8], f1[8], gg[8], o[8];
        unpack8(__builtin_nontemporal_load((const u32x4*)(of + ro)), f0); unpack8(__builtin_nontemporal_load((const u32x4*)(obw + ro)), f1); unpack8(__builtin_nontemporal_load((const u32x4*)(zg + ro)), gg);
        float ss = 0.f;
#pragma unroll
        for (int j = 0; j < 8; ++j) { o[j] = f0[j] + f1[j]; ss += o[j] * o[j]; }
        ss += __shfl_xor(ss, 1); ss += __shfl_xor(ss, 2); ss += __shfl_xor(ss, 4); ss += __shfl_xor(ss, 8);
        const float rstd = rsqrtf(ss * (1.f / 128.f) + EPS);
#pragma unroll
        for (int j = 0; j < 8; ++j) o[j] = o[j] * rstd * gain[j] * silu_f(gg[j]);
        u32x4 w; w.x = cvt_pk_bf16(o[0], o[1]); w.y = cvt_pk_bf16(o[2], o[3]); w.z = cvt_pk_bf16(o[4], o[5]); w.w = cvt_pk_bf16(o[6], o[7]);
        *(u32x4*)(A2 + (size_t)row * D + c0) = w;
        const int tw = row & 63;
        float um[8], u0[8], up[8], gb[8], y[8];
        unpack8(*(const u32x4*)(zgc + ro), u0); unpack8(__builtin_nontemporal_load((const u32x4*)(zgb + ro)), gb);
        if (tw > 0) unpack8(*(const u32x4*)(zgc + ro - 512), um);
        else {
#pragma unroll
            for (int j = 0; j < 8; ++j) um[j] = 0.f; }
        if (tw < 63) unpack8(*(const u32x4*)(zgc + ro + 512), up);
        else {
#pragma unroll
            for (int j = 0; j < 8; ++j) up[j] = 0.f; }
#pragma unroll
        for (int j = 0; j < 8; ++j) y[j] = gb[j] * (cw0[j] * um[j] + cw1[j] * u0[j] + cw2[j] * up[j]);
        w.x = cvt_pk_bf16(y[0], y[1]); w.y = cvt_pk_bf16(y[2], y[3]); w.z = cvt_pk_bf16(y[4], y[5]); w.w = cvt_pk_bf16(y[6], y[7]);
        *(u32x4*)(A2 + (size_t)row * D + 512 + c0) = w;
    }
}

__device__ __forceinline__ void phase_router(const Args& a, LAS uchar* lds, int bid, int tid, int wid, int lane) {
    const float* modf = (const float*)(a.ws + WS_MODF);
    LAS float* gm = (LAS float*)lds; LAS float* sh = gm + D;
    LAS uchar* wrl = lds + 8192;
    const int b = bid / 32;
    for (int cidx = tid; cidx < D; cidx += 512) { sh[cidx] = modf[(size_t)b * NMOD + 3 * D + cidx]; gm[cidx] = a.norm_ffn[cidx] * (1.f + modf[(size_t)b * NMOD + 4 * D + cidx]); }
    for (int i = tid; i < D * 4; i += 512) { const int col = i >> 2, q4 = i & 3; *(LAS f32x4*)(wrl + col * 64 + (col >> 2) * 16 + q4 * 16) = *(const f32x4*)(a.w_router + col * 16 + q4 * 4); }
    __syncthreads();
    uchar* hx2 = a.ws + WS_ACT; float* aff = (float*)(a.ws + WS_AFF);
    for (int jb = 0; jb < 4; ++jb) {
        const int row0 = bid * 128 + wid * 16 + jb * 4;
        f32x4 v[4][4]; float rstd[4];
#pragma unroll
        for (int i = 0; i < 4; ++i) { const bf16_t* xrow = (const bf16_t*)(a.ws + WS_X1B) + (size_t)(row0 + i) * D; float ss = 0.f;
#pragma unroll
            for (int jj = 0; jj < 4; ++jj) { const u32x2 xw = __builtin_nontemporal_load((const u32x2*)xrow + lane + 64 * jj); v[i][jj] = (f32x4){bf_lo(xw.x), bf_hi(xw.x), bf_lo(xw.y), bf_hi(xw.y)}; ss += (v[i][jj].x * v[i][jj].x + v[i][jj].y * v[i][jj].y) + (v[i][jj].z * v[i][jj].z + v[i][jj].w * v[i][jj].w); }
            rstd[i] = ss; }
#pragma unroll
        for (int i = 0; i < 4; ++i) rstd[i] = rsqrtf(wave_sum(rstd[i]) * (1.f / D) + EPS);
        float pl[64];
#pragma unroll
        for (int e = 0; e < 64; ++e) pl[e] = 0.f;
#pragma unroll
        for (int jj = 0; jj < 4; ++jj) { const f32x4 g4 = *((const LAS f32x4*)gm + lane + 64 * jj), s4 = *((const LAS f32x4*)sh + lane + 64 * jj);
#pragma unroll
            for (int i = 0; i < 4; ++i) { v[i][jj] = v[i][jj] * rstd[i] * g4 + s4;
                *((unsigned*)(hx2 + (size_t)(row0 + i) * D) + lane + 64 * jj) = cvt_pk4_fp8(v[i][jj].x, v[i][jj].y, v[i][jj].z, v[i][jj].w); }
            const int colb = 4 * lane + 256 * jj;
#pragma unroll
            for (int cc = 0; cc < 4; ++cc) { const int col = colb + cc; const LAS uchar* wp = wrl + col * 64 + (col >> 2) * 16;
#pragma unroll
                for (int q4 = 0; q4 < 4; ++q4) { const f32x4 w4 = *(const LAS f32x4*)(wp + q4 * 16);
#pragma unroll
                    for (int i = 0; i < 4; ++i) { const float hvv = v[i][jj][cc]; pl[i * 16 + q4 * 4 + 0] += hvv * w4.x; pl[i * 16 + q4 * 4 + 1] += hvv * w4.y; pl[i * 16 + q4 * 4 + 2] += hvv * w4.z; pl[i * 16 + q4 * 4 + 3] += hvv * w4.w; } } } }
#pragma unroll
        for (int k = 0; k < 32; ++k) { const bool hi = (lane & 32) != 0; const float keep = hi ? pl[32 + k] : pl[k], send = hi ? pl[k] : pl[32 + k]; pl[k] = keep + __shfl_xor(send, 32); }
#pragma unroll
        for (int k = 0; k < 16; ++k) { const bool hi = (lane & 16) != 0; const float keep = hi ? pl[16 + k] : pl[k], send = hi ? pl[k] : pl[16 + k]; pl[k] = keep + __shfl_xor(send, 16); }
#pragma unroll
        for (int k = 0; k < 8; ++k) { const bool hi = (lane & 8) != 0; const float keep = hi ? pl[8 + k] : pl[k], send = hi ? pl[k] : pl[8 + k]; pl[k] = keep + __shfl_xor(send, 8); }
#pragma unroll
        for (int k = 0; k < 4; ++k) { const bool hi = (lane & 4) != 0; const float keep = hi ? pl[4 + k] : pl[k], send = hi ? pl[k] : pl[4 + k]; pl[k] = keep + __shfl_xor(send, 4); }
#pragma unroll
        for (int k = 0; k < 2; ++k) { const bool hi = (lane & 2) != 0; const float keep = hi ? pl[2 + k] : pl[k], send = hi ? pl[k] : pl[2 + k]; pl[k] = keep + __shfl_xor(send, 2); }
        { const bool hi = (lane & 1) != 0; const float keep = hi ? pl[1] : pl[0], send = hi ? pl[0] : pl[1]; pl[0] = keep + __shfl_xor(send, 1); }
        const float lg = pl[0];
        float mx = lg;
#pragma unroll
        for (int o = 1; o < 16; o <<= 1) mx = fmaxf(mx, __shfl_xor(mx, o));
        const float ex = __expf(lg - mx); float den = ex;
#pragma unroll
        for (int o = 1; o < 16; o <<= 1) den += __shfl_xor(den, o);
        const int t = (row0 + (lane >> 4)) & (T - 1);
        aff[((size_t)b * NE + (lane & 15)) * T + t] = ex / den;
    }
    __syncthreads();
}

__device__ __forceinline__ void topk_item(const Args& a, LAS uchar* lds, int b, int e, int tid, int wid, int lane) {
    LAS unsigned* key = (LAS unsigned*)lds;
    LAS unsigned* hist = key + 4096;
    LAS unsigned* ctl = hist + 256;
    LAS unsigned* wsum = ctl + 8;
    const float* affp = (const float*)(a.ws + WS_AFF) + ((size_t)b * NE + e) * T;
    unsigned kv[8];
    { const u32x4 k0 = *(const u32x4*)(affp + tid * 8), k1 = *(const u32x4*)(affp + tid * 8 + 4); kv[0] = k0.x; kv[1] = k0.y; kv[2] = k0.z; kv[3] = k0.w; kv[4] = k1.x; kv[5] = k1.y; kv[6] = k1.z; kv[7] = k1.w; }
    unsigned prefix = 0u, mask = 0u, need = CAP;
    for (int shift = 24; shift >= 0; shift -= 8) {
        if (tid < 256) hist[tid] = 0u;
        __syncthreads();
#pragma unroll
        for (int j = 0; j < 8; ++j) if ((kv[j] & mask) == prefix) __hip_atomic_fetch_add(&hist[(kv[j] >> shift) & 255u], 1u, __ATOMIC_RELAXED, __HIP_MEMORY_SCOPE_WORKGROUP);
        __syncthreads();
        if (tid < 256) { unsigned above = 0u; for (int bb = tid + 1; bb < 256; ++bb) above += hist[bb]; const unsigned mine = hist[tid];
            if (above < need && need <= above + mine) { ctl[0] = (unsigned)tid; ctl[1] = need - above; } }
        __syncthreads();
        prefix |= ctl[0] << shift; mask |= 255u << shift; need = ctl[1];
        __syncthreads();
    }
    unsigned cg_ = 0u, ce_ = 0u;
#pragma unroll
    for (int j = 0; j < 8; ++j) { cg_ += kv[j] > prefix; ce_ += kv[j] == prefix; }
    unsigned pk = cg_ | (ce_ << 16), incl = pk;
#pragma unroll
    for (int o = 1; o < 64; o <<= 1) { const unsigned t2 = __shfl_up(incl, o); if (lane >= o) incl += t2; }
    if (lane == 63) wsum[wid] = incl;
    __syncthreads();
    unsigned base = 0u;
    for (int w = 0; w < wid; ++w) base += wsum[w];
    unsigned excl = base + incl - pk; unsigned ng = excl & 0xffffu, neq = excl >> 16;
    int* seltok = (int*)(a.ws + WS_SELTOK); float* selgate = (float*)(a.ws + WS_SELGATE); short* pos = (short*)(a.ws + WS_POS);
#pragma unroll
    for (int j = 0; j < 8; ++j) { const int t = tid * 8 + j; const bool gt = kv[j] > prefix, eq = kv[j] == prefix; const bool sel = gt || (eq && neq < need);
        int slot = -1;
        if (sel) slot = (int)(ng + (neq < need ? neq : need));
        if (sel) { seltok[e * 4096 + b * 512 + slot] = b * T + t; selgate[e * 4096 + b * 512 + slot] = __uint_as_float(kv[j]); }
        pos[((size_t)b * T + t) * 16 + e] = (short)slot;
        ng += gt; neq += eq; }
    __syncthreads();
}
__device__ __forceinline__ void phase_topk_cvt(const Args& a, LAS uchar* lds, int bid, int G, int tid, int wid, int lane) {
    if (bid < 128) topk_item(a, lds, bid / 16, bid % 16, tid, wid, lane);
    LAS float* scr = (LAS float*)(lds + 32768) + wid * (64 * 33);
    uchar* wgu = a.ws + WS_WGU; uchar* wdn = a.ws + WS_WDN;
    constexpr int I_G = (D / 64) * (DFF / 32);
    constexpr int I_D = (DFF / 64) * (D / 32);
    constexpr int PER_E = 2 * I_G + I_D, TOTAL = NE * PER_E;
    static_assert(TOTAL == 1024 * 22 + 1024 * 26, "item split");
    const bool tk = bid < 128; const int wi = (tk ? bid : bid - 128) * 8 + wid;
    const int cnt = tk ? 22 : 26, base = tk ? 1024 * 26 : 0;
    for (int k = 0; k < cnt; ++k) { const int it = base + k * 1024 + wi;
        const int e = it / PER_E; int r = it % PER_E;
        if (r < 2 * I_G) { const int up = r >= I_G; if (up) r -= I_G; const int nblk = DFF / 32, kb = r / nblk, nb = r % nblk, n0 = nb * 32;
            const float* W = (up ? a.w_up : a.w_gate) + (size_t)e * D * DFF;
            cvt_item_fp8(W, DFF, wgu + (size_t)e * 4096 * D, D, kb * 64, n0, (n0 >> 7) * 256 + (n0 & 127) + (up ? 128 : 0), scr, lane); }
        else { r -= 2 * I_G; const int nblk = D / 32, kb = r / nblk, nb = r % nblk;
            cvt_item_fp8(a.w_down + (size_t)e * DFF * D, D, wdn + (size_t)e * D * DFF, DFF, kb * 64, nb * 32, nb * 32, scr, lane); }
    }
    __syncthreads();
}

__device__ __forceinline__ void phase_final(const Args& a, int bid, int G, int wid, int lane) {
    const float* modf = (const float*)(a.ws + WS_MODF); const short* pos = (const short*)(a.ws + WS_POS); const uchar* ys = a.ws + WS_YS;
    const bf16_t* x1b = (const bf16_t*)(a.ws + WS_X1B);
    f32x4 nf[4];
#pragma unroll
    for (int q = 0; q < 4; ++q) nf[q] = *(const f32x4*)(a.norm_final + (q >> 1) * 512 + 8 * lane + (q & 1) * 4);
    const int stride = G * 8;
#define FIN_SLOT(ROW) (((ROW) < M && lane < 16) ? (int)pos[(size_t)(ROW) * 16 + lane] : -1)
#define FIN_ISSUE(ROW, SLOTV, XW, W, EE, SL, REST) do { const int _b = (ROW) / T; const bf16_t* _x = x1b + (size_t)(ROW) * D; \
        XW[0] = __builtin_nontemporal_load((const u32x4*)(_x + 8 * lane)); XW[1] = __builtin_nontemporal_load((const u32x4*)(_x + 512 + 8 * lane)); \
        unsigned long long _m = __ballot((SLOTV) >= 0); \
        _Pragma("unroll") for (int _k = 0; _k < 4; ++_k) { if (_m) { EE[_k] = __builtin_ctzll(_m); _m &= _m - 1; SL[_k] = __shfl((SLOTV), EE[_k]); } else { EE[_k] = -1; SL[_k] = 0; } } \
        REST = _m; \
        _Pragma("unroll") for (int _k = 0; _k < 4; ++_k) if (EE[_k] >= 0) { const uchar* _yr = ys + ((size_t)EE[_k] * 4096 + _b * 512 + SL[_k]) * D + 8 * lane; \
            W[_k][0] = __builtin_nontemporal_load((const u32x2*)_yr); W[_k][1] = __builtin_nontemporal_load((const u32x2*)(_yr + 512)); } } while (0)
#define FIN_ACC(WW, HF) do { const f32x2 _p0 = __builtin_amdgcn_cvt_pk_f32_fp8((WW).x, false), _p1 = __builtin_amdgcn_cvt_pk_f32_fp8((WW).x, true), _p2 = __builtin_amdgcn_cvt_pk_f32_fp8((WW).y, false), _p3 = __builtin_amdgcn_cvt_pk_f32_fp8((WW).y, true); \
        acc[2 * (HF)].x += _p0.x; acc[2 * (HF)].y += _p0.y; acc[2 * (HF)].z += _p1.x; acc[2 * (HF)].w += _p1.y; \
        acc[2 * (HF) + 1].x += _p2.x; acc[2 * (HF) + 1].y += _p2.y; acc[2 * (HF) + 1].z += _p3.x; acc[2 * (HF) + 1].w += _p3.y; } while (0)
    int row = bid * 8 + wid;
    u32x4 xwC[2], xwN[2]; u32x2 wC[4][2], wN[4][2]; int eeC[4], slC[4], eeN[4], slN[4]; unsigned long long restC = 0ull, restN = 0ull;
    int slotC = FIN_SLOT(row), slotB = FIN_SLOT(row + stride);
    FIN_ISSUE(row, slotC, xwC, wC, eeC, slC, restC);
    for (; row < M; row += stride) {
        const int nrow = row + stride;
        const int slotN2 = FIN_SLOT(row + 2 * stride);
        if (nrow < M) FIN_ISSUE(nrow, slotB, xwN, wN, eeN, slN, restN);
        const int b = row / T; float* xrow = a.out + (size_t)row * D;
        f32x4 v[4], acc[4];
#pragma unroll
        for (int hf = 0; hf < 2; ++hf) { const u32x4 xw = xwC[hf];
            v[2 * hf] = (f32x4){bf_lo(xw.x), bf_hi(xw.x), bf_lo(xw.y), bf_hi(xw.y)}; v[2 * hf + 1] = (f32x4){bf_lo(xw.z), bf_hi(xw.z), bf_lo(xw.w), bf_hi(xw.w)}; acc[2 * hf] = (f32x4){0.f, 0.f, 0.f, 0.f}; acc[2 * hf + 1] = (f32x4){0.f, 0.f, 0.f, 0.f}; }
#pragma unroll
        for (int k = 0; k < 4; ++k) if (eeC[k] >= 0) { FIN_ACC(wC[k][0], 0); FIN_ACC(wC[k][1], 1); }
        while (restC) {
            const int e = __builtin_ctzll(restC); restC &= restC - 1; const int sl = __shfl(slotC, e);
            const uchar* yr = ys + ((size_t)e * 4096 + b * 512 + sl) * D + 8 * lane;
            const u32x2 w0 = *(const u32x2*)yr, w1 = *(const u32x2*)(yr + 512);
            FIN_ACC(w0, 0); FIN_ACC(w1, 1); }
        float ss = 0.f;
#pragma unroll
        for (int q = 0; q < 4; ++q) { const f32x4 g2 = *(const f32x4*)(modf + (size_t)b * NMOD + 5 * D + (q >> 1) * 512 + 8 * lane + (q & 1) * 4); v[q] = v[q] + g2 * acc[q] * 0.0625f;
            ss += (v[q].x * v[q].x + v[q].y * v[q].y) + (v[q].z * v[q].z + v[q].w * v[q].w); }
        const float rstd = rsqrtf(wave_sum(ss) * (1.f / D) + EPS);
#pragma unroll
        for (int q = 0; q < 4; ++q) __builtin_nontemporal_store(v[q] * rstd * nf[q], (f32x4*)(xrow + (q >> 1) * 512 + 8 * lane + (q & 1) * 4));
        xwC[0] = xwN[0]; xwC[1] = xwN[1]; restC = restN; slotC = slotB; slotB = slotN2;
#pragma unroll
        for (int k = 0; k < 4; ++k) { wC[k][0] = wN[k][0]; wC[k][1] = wN[k][1]; eeC[k] = eeN[k]; slC[k] = slN[k]; }
    }
#undef FIN_SLOT
#undef FIN_ISSUE
#undef FIN_ACC
}

__global__ void __launch_bounds__(512, 2) mega_fwd(Args a) {
    extern __shared__ __attribute__((aligned(16))) uchar lds_raw[];
    LAS uchar* lds = (LAS uchar*)lds_raw;
    const int tid = threadIdx.x, lane = tid & 63, wid = __builtin_amdgcn_readfirstlane(tid >> 6), bid = blockIdx.x, G = gridDim.x;
    const int lo = a.ph_lo, hi = a.ph_hi;
    uchar* ws = a.ws;
#define IN(k) (lo <= (k) && (k) < hi)
#define SEAM(k) do { if (IN(k) && IN((k) + 1)) xcd_barrier(xbar); } while (0)
    if (tid < 2) ((volatile LAS unsigned*)(lds + (LDS_BYTES - 16)))[tid] = 0u;
    __syncthreads();
    XcdBarrier xbar = xcd_barrier_post((unsigned*)(ws + WS_BAR), (volatile LAS unsigned*)(lds + (LDS_BYTES - 16)));
    if (IN(0)) phase_prep(a, lds, bid, G, tid, wid, lane);
    SEAM(0);
    if (IN(1)) phase_norm(a, lds, bid, G, tid, wid, lane);
    SEAM(1);
    if (IN(2)) {
        {
            pg8::Gemm g{(const bf16_t*)(ws + WS_ACT), (const bf16_t*)(ws + WS_WIN), D, 0, nullptr};
            pg8::GroupOrder S; S.init(M / 256, NIN / 256, 1, G, bid);
            pg8::EpiInproj E{ws + WS_ZQ, nullptr, (_Float16*)(ws + WS_LF), (_Float16*)(ws + WS_LBW), (const float*)(ws + WS_LB), 0, T};
            pg8::gemm_phase<pg8::EpiInproj, false>(lds, g, S, E);
        }
    }
    SEAM(2);
    if (IN(3)) {
        unsigned* cnt = (unsigned*)(ws + WS_BAR + 14336);
        if (bid >= 192 && bid < 240) {
            pg8::Gemm g{(const bf16_t*)(ws + WS_HC), (const bf16_t*)(ws + WS_WIN) + (size_t)512 * D, D, 0, nullptr};
            pg8::GroupOrder S; S.init(MC / 256, 1536 / 256, 1, 48, bid - 192);
            pg8::EpiInproj E{nullptr, (bf16_t*)(ws + WS_CI), (_Float16*)(ws + WS_CLF), (_Float16*)(ws + WS_CLB), (const float*)(ws + WS_LB), 1, CT};
            pg8::gemm_phase<pg8::EpiInproj, false>(lds, g, S, E);
            pg8::Unit u; S.next(0, u);
            asm volatile("s_waitcnt vmcnt(0)" ::: "memory"); __syncthreads();
            if (tid == 0) { __builtin_amdgcn_fence(__ATOMIC_RELEASE, "agent"); asm volatile("s_waitcnt vmcnt(0)" ::: "memory");
                __hip_atomic_fetch_add(cnt + 64 * u.pm, 1u, __ATOMIC_RELAXED, __HIP_MEMORY_SCOPE_AGENT); }
        }
        if (bid >= 192) {
            const int b = (bid - 192) >> 3;
            if (tid == 0) { unsigned sp = 0; while (__hip_atomic_load(cnt + 64 * b, __ATOMIC_RELAXED, __HIP_MEMORY_SCOPE_AGENT) < 6u && ++sp < (1u << 22)) __builtin_amdgcn_s_sleep(2);
                __builtin_amdgcn_fence(__ATOMIC_ACQUIRE, "agent"); asm volatile("s_waitcnt vmcnt(0)" ::: "memory"); }
            __syncthreads();
        }
        phase_gla_states(a, lds, bid, wid, lane);
    }
    SEAM(3);
    if (IN(4)) phase_gla_out(a, lds, bid, wid, lane);
    SEAM(4);
    if (IN(5)) phase_mixfin(a, bid, G, wid, lane);
    SEAM(5);
    if (IN(6)) {
        pg8::Gemm g{(const bf16_t*)(ws + WS_ACT), (const bf16_t*)(ws + WS_WOUT), D, 0, nullptr};
        pg8::GroupOrder S; S.init(M / 256, D / 256, 1, G, bid);
        pg8::EpiOut E{a.x, (bf16_t*)(ws + WS_X1B), (const float*)(ws + WS_MODF)};
        pg8::gemm_phase<pg8::EpiOut, false>(lds, g, S, E);
    }
    SEAM(6);
    if (IN(7)) phase_router(a, lds, bid, tid, wid, lane);
    SEAM(7);
    if (IN(8)) phase_topk_cvt(a, lds, bid, G, tid, wid, lane);
    SEAM(8);
    if (IN(9)) {
        pg8::Gemm g{(const bf16_t*)(ws + WS_ACT), (const bf16_t*)(ws + WS_WGU), D / 2, (size_t)4096 * D, (const int*)(ws + WS_SELTOK)};
        pg8::GroupOrder S; S.init(16, 16, NE, G, bid);
        pg8::EpiMoe1 E{ws + WS_HID};
        pg8::gemm_phase<pg8::EpiMoe1, true, pg8::GroupOrder, true>(lds, g, S, E);
    }
    SEAM(9);
    if (IN(10)) {
        pg8::Gemm g{(const bf16_t*)(ws + WS_HID), (const bf16_t*)(ws + WS_WDN), DFF / 2, (size_t)D * DFF, nullptr};
        pg8::Moe2Order S{bid};
        LAS float* lg = (LAS float*)(lds + pg8::STAGE_BYTES);
        { pg8::Unit tu; for (int uu = 0; uu < 4 && S.next(uu, tu); ++uu) if (tid < 256) lg[uu * 256 + tid] = ((const float*)(ws + WS_SELGATE))[tu.pm * 256 + tid]; }
        __syncthreads();
        pg8::EpiMoe2 E{ws + WS_YS, lg};
        pg8::gemm_phase<pg8::EpiMoe2, false, pg8::Moe2Order, true>(lds, g, S, E);
    }
    SEAM(10);
    if (IN(11)) phase_final(a, bid, G, wid, lane);

#undef IN
#undef SEAM
}

#ifndef N_LAUNCHES
#define N_LAUNCHES 1
#endif
extern "C" void kernel_launch(void* const* d_in, const int* in_sizes, int n_in, void* d_out, int out_size, void* d_ws, size_t ws_size, hipStream_t stream) {
    static int grid = 0;
    if (grid == 0) {
        if (n_in != 18 || out_size != M * D || ws_size < WS_END) { fprintf(stderr, "kernel_launch: unexpected shapes (n_in %d out %d ws %zu)\n", n_in, out_size, ws_size); grid = -1; return; }
        int dev = 0, cus = 0, per_cu = 0;
        (void)hipGetDevice(&dev); (void)hipDeviceGetAttribute(&cus, hipDeviceAttributeMultiprocessorCount, dev);
        (void)hipFuncSetAttribute((const void*)mega_fwd, hipFuncAttributeMaxDynamicSharedMemorySize, LDS_BYTES);
        (void)hipOccupancyMaxActiveBlocksPerMultiprocessor(&per_cu, (const void*)mega_fwd, 512, LDS_BYTES);
        if (per_cu < 1) { fprintf(stderr, "kernel_launch: occupancy query says %d blocks per CU\n", per_cu); grid = -1; return; }
        grid = 256;
        if (cus != 256) fprintf(stderr, "kernel_launch: note: %d CUs (built for 256)\n", cus);
    }
    if (grid < 0) return;
    Args a{};
    a.x = (const float*)d_in[0]; a.c = (const float*)d_in[1]; a.ctx = (const float*)d_in[2]; a.c_ctx = (const float*)d_in[3]; a.w_ada = (const float*)d_in[4]; a.b_ada = (const float*)d_in[5];
    a.norm_mix = (const float*)d_in[6]; a.norm_ffn = (const float*)d_in[7]; a.w_in = (const float*)d_in[8]; a.lb_logits = (const float*)d_in[9]; a.hg_norm = (const float*)d_in[10];
    a.conv_w = (const float*)d_in[11]; a.w_out = (const float*)d_in[12]; a.w_router = (const float*)d_in[13]; a.w_gate = (const float*)d_in[14]; a.w_up = (const float*)d_in[15];
    a.w_down = (const float*)d_in[16]; a.norm_final = (const float*)d_in[17]; a.out = (float*)d_out; a.ws = (uchar*)d_ws;
    if (N_LAUNCHES == 1) {
        (void)hipMemsetAsync((char*)d_ws + WS_BAR, 0, 16384, stream);
        a.ph_lo = 0; a.ph_hi = NPHASE;
        hipLaunchKernelGGL(mega_fwd, dim3(grid), dim3(512), LDS_BYTES, stream, a);
    } else {
        for (int p = 0; p < NPHASE; ++p) { a.ph_lo = p; a.ph_hi = p + 1; void* args[] = {&a};
            hipError_t e = hipLaunchCooperativeKernel((const void*)mega_fwd, dim3(grid), dim3(512), args, LDS_BYTES, stream);
            if (e != hipSuccess) { fprintf(stderr, "launch %d failed: %s\n", p, hipGetErrorString(e)); break; } }
    }
}
```

```cpp
#include <hip/hip_runtime.h>
#include <cstdio>

#define LAS __attribute__((address_space(3)))
#define GAS __attribute__((address_space(1)))
typedef unsigned short bf16_t;
typedef short bf16x8 __attribute__((ext_vector_type(8)));
typedef float f32x4 __attribute__((ext_vector_type(4)));
typedef float f32x2 __attribute__((ext_vector_type(2)));
typedef unsigned u32x4 __attribute__((ext_vector_type(4)));
typedef unsigned u32x2 __attribute__((ext_vector_type(2)));
typedef unsigned char uchar;
typedef int i32x8 __attribute__((ext_vector_type(8)));
typedef int i32x4 __attribute__((ext_vector_type(4)));

constexpr int D = 1024, NB = 8, T = 4096, M = NB * T, CT = 256, MC = NB * CT;
constexpr int NIN = 4096, HK = 512, NH = 4, NE = 16, CAP = 512, DFF = 2048, NMOD = 6 * D;
constexpr float EPS = 1e-6f;
constexpr int NPHASE = 12;

constexpr size_t MiB = 1u << 20;
constexpr size_t WS_ACT = 0;
constexpr size_t WS_WIN = 64 * MiB;
constexpr size_t WS_WOUT = 72 * MiB;
constexpr size_t WS_MODP = 74 * MiB;
constexpr size_t WS_MODF = 76 * MiB;
constexpr size_t WS_LB = 76 * MiB + 512 * 1024;
constexpr size_t WS_HC = 77 * MiB;
constexpr size_t WS_CLF = 81 * MiB;
constexpr size_t WS_CLB = 85 * MiB;
constexpr size_t WS_CI = 89 * MiB;
constexpr size_t WS_S0 = 91 * MiB;
constexpr size_t WS_AFF = 95 * MiB;
constexpr size_t WS_SELTOK = 97 * MiB;
constexpr size_t WS_SELGATE = 97 * MiB + 256 * 1024;
constexpr size_t WS_POS = 98 * MiB;
constexpr size_t WS_BAR = 100 * MiB;
constexpr size_t WS_SL = 488 * MiB;
constexpr size_t WS_DL = 500 * MiB;
constexpr size_t WS_ZQ = 104 * MiB;
constexpr size_t WS_LF = 136 * MiB;
constexpr size_t WS_LBW = 200 * MiB;
constexpr size_t WS_ZI = 264 * MiB;
constexpr size_t WS_ZG = 296 * MiB;
constexpr size_t WS_ZGB = 328 * MiB;
constexpr size_t WS_ZGC = 360 * MiB;
constexpr size_t WS_ZV = 392 * MiB;
constexpr size_t WS_OF = 424 * MiB;
constexpr size_t WS_OB = 456 * MiB;
constexpr size_t WS_WGU = 104 * MiB;
constexpr size_t WS_WDN = 232 * MiB;
constexpr size_t WS_HID = 296 * MiB;
constexpr size_t WS_YS = WS_WGU;
constexpr size_t WS_X1B = 424 * MiB;
constexpr size_t WS_END = 552 * MiB;
static_assert(WS_ZI == WS_ZQ + 160 * MiB && WS_ZG == WS_ZI + 32 * MiB && WS_ZGB == WS_ZG + 32 * MiB && WS_ZGC == WS_ZGB + 32 * MiB && WS_ZV == WS_ZGC + 32 * MiB, "z segment map");

constexpr int LDS_BYTES = 147456;

typedef __bf16 bf16x2_t __attribute__((ext_vector_type(2)));
__device__ __forceinline__ unsigned cvt_pk_bf16_safe(float lo, float hi) { typedef float f2_t __attribute__((ext_vector_type(2))); const bf16x2_t v = __builtin_convertvector((f2_t){lo, hi}, bf16x2_t); return __builtin_bit_cast(unsigned, v); }
__device__ __forceinline__ unsigned cvt_pk_bf16(float lo, float hi) { unsigned r; asm volatile("v_cvt_pk_bf16_f32 %0, %1, %2" : "=v"(r) : "v"(lo), "v"(hi)); return r; }
__device__ __forceinline__ unsigned cvt_pk4_fp8(float a, float b, float c, float d) { unsigned r = 0u; asm volatile("v_cvt_pk_fp8_f32 %0, %1, %2\n\tv_cvt_pk_fp8_f32 %0, %3, %4 op_sel:[0,0,1]" : "+v"(r) : "v"(a), "v"(b), "v"(c), "v"(d)); return r; }
__device__ __forceinline__ float bf_lo(unsigned u) { return __uint_as_float(u << 16); }
__device__ __forceinline__ float bf_hi(unsigned u) { return __uint_as_float(u & 0xffff0000u); }
__device__ __forceinline__ float wave_sum(float v) {
#pragma unroll
    for (int o = 1; o < 64; o <<= 1) v += __shfl_xor(v, o);
    return v;
}
__device__ __forceinline__ float silu_f(float x) { return x * __builtin_amdgcn_rcpf(1.f + __builtin_amdgcn_exp2f(x * -1.44269504f)); }
#define LDS_WAIT() asm volatile("s_waitcnt lgkmcnt(0)" ::: "memory")


#define XB_TMO      128
#define XB_XCNT(j)  (256  + 64 * (j))
#define XB_XSUB(j)  (1280 + 64 * (j))
#define XB_XGEN(j)  (2304 + 64 * (j))
#define XB_TOP      3328
#define XB_TOPGEN   3392
#define XCD_BAR_WORDS 3456
#define XB_SPIN_CAP (1u << 20)
__device__ __forceinline__ unsigned xb_ld(unsigned* p)              { return __hip_atomic_load(p, __ATOMIC_RELAXED, __HIP_MEMORY_SCOPE_AGENT); }
__device__ __forceinline__ unsigned xb_add(unsigned* p, unsigned v) { return __hip_atomic_fetch_add(p, v, __ATOMIC_RELAXED, __HIP_MEMORY_SCOPE_AGENT); }
__device__ __forceinline__ unsigned xb_xcc_id() { return (unsigned)__builtin_amdgcn_s_getreg((3 << 11) | 20) & 0xFu; }
#define XB_SPIN(cond, bar) do { unsigned _sp = 0; while (cond) { __builtin_amdgcn_s_sleep(1); \
    if ((++_sp & 255u) == 0u) { if (xb_ld(&(bar)[XB_TMO])) break; if (_sp > XB_SPIN_CAP) { atomicAdd(&(bar)[XB_TMO], 1u); break; } } } } while (0)
struct XcdBarrier { unsigned* bar; unsigned x; volatile LAS unsigned* st; };
__device__ __forceinline__ XcdBarrier xcd_barrier_post(unsigned* bar, volatile LAS unsigned* st) {
    XcdBarrier b; b.bar = bar; b.x = xb_xcc_id(); b.st = st;
    if (threadIdx.x == 0) (void)xb_add(&bar[XB_XCNT(b.x)], 1u);
    return b;
}
__device__ __forceinline__ void xcd_barrier_complete(unsigned* bar, unsigned x, unsigned& nloc, unsigned& nx) {
    const unsigned G = gridDim.x * gridDim.y * gridDim.z;
    unsigned sum, cnt, mine, sp = 0u;
    for (;;) {
        sum = 0u; cnt = 0u; mine = 0u;
#pragma unroll
        for (unsigned j = 0; j < 16; ++j) { const unsigned c = xb_ld(&bar[XB_XCNT(j)]); sum += c; cnt += (c > 0u) ? 1u : 0u; mine = (j == x) ? c : mine; }
        if (sum == G) break;
        __builtin_amdgcn_s_sleep(1);
        if ((++sp & 255u) == 0u) { if (xb_ld(&bar[XB_TMO])) break; if (sp > XB_SPIN_CAP) { atomicAdd(&bar[XB_TMO], 1u); break; } }
    }
    nloc = mine > 0u ? mine : 1u; nx = cnt > 0u ? cnt : 1u;
}
__device__ __forceinline__ void xcd_barrier(const XcdBarrier& b) {
    asm volatile("s_waitcnt vmcnt(0)" ::: "memory");
    __syncthreads();
    if (threadIdx.x == 0) {
        unsigned* bar = b.bar;
        __builtin_amdgcn_s_waitcnt(0);
        unsigned nloc = b.st[0], nx = b.st[1];
        if (nloc == 0u) { xcd_barrier_complete(bar, b.x, nloc, nx); b.st[0] = nloc; b.st[1] = nx; }
        const unsigned old = xb_add(&bar[XB_XSUB(b.x)], 1u);
        const unsigned gen = old / nloc;
        if (old + 1u == (gen + 1u) * nloc) {
            __builtin_amdgcn_fence(__ATOMIC_RELEASE, "agent");
            asm volatile("s_waitcnt vmcnt(0)" ::: "memory");
            const unsigned og = xb_add(&bar[XB_TOP], 1u);
            const unsigned tg = og / nx;
            if (og + 1u == (tg + 1u) * nx) xb_add(&bar[XB_TOPGEN], 1u);
            else XB_SPIN(xb_ld(&bar[XB_TOPGEN]) == tg, bar);
            __builtin_amdgcn_fence(__ATOMIC_ACQUIRE, "agent");
            xb_add(&bar[XB_XGEN(b.x)], 1u);
            asm volatile("s_waitcnt vmcnt(0)" ::: "memory");
        } else {
            XB_SPIN(xb_ld(&bar[XB_XGEN(b.x)]) == gen, bar);
            __builtin_amdgcn_fence(__ATOMIC_ACQUIRE, "agent");
            asm volatile("s_waitcnt vmcnt(0)" ::: "memory");
        }
    }
    __syncthreads();
}

namespace pg8 {
constexpr int BM = 256, BK = 64, HALF = 128, HTB = HALF * BK * 2, STAGE_BYTES = 8 * HTB, NXCD = 8, WGM = 8;
__device__ __forceinline__ int lds_byte(int r, int c) { const int st = (r >> 4) * 2 + (c >> 5), rr = r & 15, cc = c & 31, ob = rr * 64 + cc * 2; return st * 1024 + (ob ^ (((ob >> 9) & 1) << 5)); }
__device__ __forceinline__ void stage_rc(int b, int& R, int& C) { const int st = b / 1024, sb = b % 1024, swz = sb ^ (((sb >> 9) & 1) << 5); R = (st >> 1) * 16 + swz / 64; C = (st & 1) * 32 + (swz % 64) / 2; }
__device__ __forceinline__ int perm32(int rho) { const int n = rho >> 4, i = rho & 15; return 8 * (i >> 2) + 4 * n + (i & 3); }

struct Unit { int pm, pn, e; };
struct GroupOrder {
    int nM, nN, ng, G, c;
    __device__ __forceinline__ void init(int nM_, int nN_, int ng_, int G_, int c_) { nM = nM_; nN = nN_; ng = ng_; G = G_; c = c_; }
    __device__ __forceinline__ bool next(int i, Unit& u) const {
        const int nwg = nM * nN; const long L = (long)i * G + c; if (L >= (long)nwg * ng) return false;
        const int grp = (int)(L / nwg); int wgid = (int)(L % nwg);
        { const int q = nwg / NXCD, r = nwg % NXCD, xcd = wgid % NXCD, off = wgid / NXCD; wgid = (xcd < r ? xcd * (q + 1) : r * (q + 1) + (xcd - r) * q) + off; }
        const int nig = WGM * nN, gid = wgid / nig, fm = gid * WGM, gsz = (nM - fm) < WGM ? (nM - fm) : WGM;
        u.pm = grp * nM + fm + ((wgid % nig) % gsz); u.pn = (wgid % nig) / gsz; u.e = grp; return true;
    }
};
struct Moe2Order {
    int c;
    __device__ __forceinline__ bool next(int i, Unit& u) const { if (i >= 4) return false; const int x = c & 7, j = c >> 3; u.e = 4 * i + (j >> 3); u.pm = u.e * 16 + 2 * x + ((j & 7) >> 2); u.pn = j & 3; return true; }
};
struct Gemm { const bf16_t* A; const bf16_t* Bt; int K; size_t bgs; const int* rowidx; };

template <class Epi, bool GATHER, class Sched = GroupOrder, bool FP8 = false>
__device__ __forceinline__ void gemm_phase(LAS uchar* lds, const Gemm g, const Sched& S, const Epi& E) {
    const int tid = threadIdx.x, wid = __builtin_amdgcn_readfirstlane(tid >> 6), lane = tid & 63, wr = wid >> 2, wc = wid & 3, fr = lane & 15, fq = lane >> 4;
    const int K = g.K, nt = K / BK;
    unsigned voffA[2], voffB[2]; int Rr[2], Cc[2];
#pragma unroll
    for (int i = 0; i < 2; ++i) { int R, C; stage_rc(tid * 16 + i * 8192, R, C); const int Rb = Epi::PERM ? ((R & ~31) + perm32(R & 31)) : R; Rr[i] = R; Cc[i] = C;
        voffA[i] = (unsigned)(R * K + C) * 2u; voffB[i] = (unsigned)(Rb * K + C) * 2u; }
    const size_t kstep = (size_t)(BK * 2);
    const size_t hstep = (size_t)HALF * K * 2;
    const size_t tstep = 2 * hstep;
    const unsigned ldsw = (unsigned)wid * 1024u;
    const int aoff = lds_byte(wr * 64 + fr, fq * 8), boff = lds_byte(wc * 32 + fr, fq * 8);
#define PG8_SA(b, h) (((b) * 2 + (h)) * HTB)
#define PG8_SB(b, h) ((4 + (b) * 2 + (h)) * HTB)
#define PG8_STAGE(bufoff, gbase, voff) do { _Pragma("unroll") for (int _i = 0; _i < 2; ++_i) \
        __builtin_amdgcn_global_load_lds((const unsigned*)((const char*)(gbase) + (voff)[_i]), (LAS unsigned*)(lds + (bufoff) + ldsw + _i * 8192), 16, 0, 0); } while (0)
#define PG8_STAGE_A(bufoff, p, ofs, h) do { if constexpr (GATHER) { PG8_STAGE(bufoff, p, (ofs)[h]); } else { PG8_STAGE(bufoff, (p) + (h) * hstep, voffA); } } while (0)
#define PG8_LD8(p) __builtin_shufflevector(*(const LAS i32x4*)(p), *(const LAS i32x4*)((p) + 1024), 0, 1, 2, 3, 4, 5, 6, 7)
#define PG8_LDA(dst, b, h) do { _Pragma("unroll") for (int m = 0; m < 4; ++m) dst[m] = PG8_LD8(lds + PG8_SA(b, h) + aoff + m * 2048); } while (0)
#define PG8_LDB(dst, b, h) do { _Pragma("unroll") for (int n = 0; n < 2; ++n) dst[n] = PG8_LD8(lds + PG8_SB(b, h) + boff + n * 2048); } while (0)
#define PG8_HALF(x, k) __builtin_bit_cast(bf16x8, (k) ? __builtin_shufflevector(x, x, 4, 5, 6, 7) : __builtin_shufflevector(x, x, 0, 1, 2, 3))
#define PG8_MMA(ai, bj, At, Bt) do { __builtin_amdgcn_s_setprio(1); _Pragma("unroll") for (int m = 0; m < 4; ++m) _Pragma("unroll") for (int n = 0; n < 2; ++n) { \
        if constexpr (FP8) acc[ai][bj][m][n] = __builtin_amdgcn_mfma_scale_f32_16x16x128_f8f6f4(Bt[n], At[m], acc[ai][bj][m][n], 0, 0, 0, 0x7a7a7a7a, 0, 0x7f7f7f7f);   \
        else { acc[ai][bj][m][n] = __builtin_amdgcn_mfma_f32_16x16x32_bf16(PG8_HALF(Bt[n], 0), PG8_HALF(At[m], 0), acc[ai][bj][m][n], 0, 0, 0); \
               acc[ai][bj][m][n] = __builtin_amdgcn_mfma_f32_16x16x32_bf16(PG8_HALF(Bt[n], 1), PG8_HALF(At[m], 1), acc[ai][bj][m][n], 0, 0, 0); } } \
        if constexpr (FP8) { _Pragma("unroll") for (int m = 0; m < 4; ++m) _Pragma("unroll") for (int n = 0; n < 2; ++n) asm volatile("" : "+v"(acc[ai][bj][m][n])); }     \
        __builtin_amdgcn_s_setprio(0); } while (0)
#define PG8_WAIT_V(n) asm volatile("s_waitcnt vmcnt(" #n ")" ::: "memory")
#define PG8_WAIT_L(n) asm volatile("s_waitcnt lgkmcnt(" #n ")" ::: "memory")
#define PG8_BAR __builtin_amdgcn_s_barrier()
#define PG8_SCHED __builtin_amdgcn_sched_barrier(0)
    Unit cur, nxt; int ui = 0;
    if (!S.next(0, cur)) return;
    f32x4 acc[2][2][4][2];
#pragma unroll
    for (int a = 0; a < 2; ++a)
#pragma unroll
        for (int b = 0; b < 2; ++b)
#pragma unroll
            for (int m = 0; m < 4; ++m)
#pragma unroll
                for (int n = 0; n < 2; ++n) acc[a][b][m][n] = (f32x4){0.f, 0.f, 0.f, 0.f};
    i32x8 At[4], B0[2], B1[2];
    unsigned cofs[2][2], nofs[2][2];
    LAS unsigned short* ridx = (LAS unsigned short*)(lds + STAGE_BYTES);
    if constexpr (GATHER) {
        { Unit tu; for (int uu = 0; uu < 16 && S.next(uu, tu); ++uu) if (tid < BM) ridx[uu * BM + tid] = (unsigned short)g.rowidx[tu.pm * BM + tid]; }
        asm volatile("s_waitcnt vmcnt(0) lgkmcnt(0)" ::: "memory"); __builtin_amdgcn_s_barrier(); asm volatile("" ::: "memory");
#pragma unroll
        for (int h = 0; h < 2; ++h)
#pragma unroll
            for (int i = 0; i < 2; ++i) { const int row = ridx[h * HALF + Rr[i]]; cofs[h][i] = (unsigned)(row * K + Cc[i]) * 2u; nofs[h][i] = cofs[h][i]; }
    }
    const char* cA = GATHER ? (const char*)g.A : (const char*)g.A + (size_t)cur.pm * tstep;
    const char* cB = (const char*)g.Bt + (size_t)cur.e * g.bgs + (size_t)cur.pn * tstep;
    PG8_STAGE(PG8_SB(0, 0), cB, voffB); PG8_STAGE(PG8_SB(0, 1), cB + hstep, voffB); PG8_STAGE_A(PG8_SA(0, 0), cA, cofs, 0); PG8_STAGE_A(PG8_SA(0, 1), cA, cofs, 1);
    if (wr == 1) PG8_BAR;
    PG8_WAIT_V(2); PG8_BAR;
    PG8_STAGE(PG8_SB(1, 0), cB + kstep, voffB); PG8_STAGE_A(PG8_SA(1, 0), cA + kstep, cofs, 0); PG8_STAGE(PG8_SB(1, 1), cB + hstep + kstep, voffB);
    PG8_WAIT_V(6); PG8_BAR;
    for (;;) {
        const bool has_next = S.next(ui + 1, nxt);
        const char* nA = GATHER ? (const char*)g.A : (has_next ? (const char*)g.A + (size_t)nxt.pm * tstep : cA);
        const char* nB = has_next ? (const char*)g.Bt + (size_t)nxt.e * g.bgs + (size_t)nxt.pn * tstep : cB;
#pragma unroll 1
        for (int t = 0; t < nt; t += 2) {
            const bool last = (t == nt - 2);
            const char* a1 = cA + (size_t)(t + 1) * kstep;
            const char* a2 = last ? nA : cA + (size_t)(t + 2) * kstep; const char* b2 = last ? nB : cB + (size_t)(t + 2) * kstep;
            const char* a3 = a2 + kstep; const char* b3 = b2 + kstep;
            if constexpr (GATHER) {
                if (last && has_next) {
#pragma unroll
                    for (int h = 0; h < 2; ++h)
#pragma unroll
                        for (int i = 0; i < 2; ++i) { const int row = ridx[(ui + 1) * BM + h * HALF + Rr[i]]; nofs[h][i] = (unsigned)(row * K + Cc[i]) * 2u; }
                }
            }
            PG8_LDB(B0, 0, 0); PG8_LDB(B1, 0, 1); PG8_SCHED; PG8_LDA(At, 0, 0); PG8_STAGE_A(PG8_SA(1, 1), a1, cofs, 1);
            PG8_WAIT_V(8); PG8_WAIT_L(0); PG8_BAR; PG8_MMA(0, 0, At, B0); PG8_MMA(0, 1, At, B1); PG8_BAR; PG8_SCHED;
            PG8_LDA(At, 0, 1); PG8_STAGE(PG8_SB(0, 0), b2, voffB); PG8_STAGE(PG8_SB(0, 1), b2 + hstep, voffB);
            if (last) { PG8_STAGE_A(PG8_SA(0, 0), a2, nofs, 0); } else { PG8_STAGE_A(PG8_SA(0, 0), a2, cofs, 0); }
            PG8_WAIT_V(8); PG8_WAIT_L(0); PG8_BAR; PG8_MMA(1, 0, At, B0); PG8_MMA(1, 1, At, B1); PG8_BAR; PG8_SCHED;
            PG8_LDB(B0, 1, 0); PG8_LDB(B1, 1, 1); PG8_SCHED; PG8_LDA(At, 1, 0);
            if (last) { PG8_STAGE_A(PG8_SA(0, 1), a2, nofs, 1); } else { PG8_STAGE_A(PG8_SA(0, 1), a2, cofs, 1); }
            PG8_WAIT_V(8); PG8_WAIT_L(0); PG8_BAR; PG8_MMA(0, 0, At, B0); PG8_MMA(0, 1, At, B1); PG8_BAR; PG8_SCHED;
            PG8_LDA(At, 1, 1); PG8_STAGE(PG8_SB(1, 0), b3, voffB); PG8_STAGE(PG8_SB(1, 1), b3 + hstep, voffB);
            if (last) { PG8_STAGE_A(PG8_SA(1, 0), a3, nofs, 0); } else { PG8_STAGE_A(PG8_SA(1, 0), a3, cofs, 0); }
            PG8_WAIT_V(8); PG8_WAIT_L(0); PG8_BAR; PG8_MMA(1, 0, At, B0); PG8_MMA(1, 1, At, B1); PG8_BAR; PG8_SCHED;
        }
        if (wr == 0) PG8_BAR;
        E(acc, cur, wr, wc, fr, fq);
        if (!has_next) break;
#pragma unroll
        for (int a = 0; a < 2; ++a)
#pragma unroll
            for (int b = 0; b < 2; ++b)
#pragma unroll
                for (int m = 0; m < 4; ++m)
#pragma unroll
                    for (int n = 0; n < 2; ++n) acc[a][b][m][n] = (f32x4){0.f, 0.f, 0.f, 0.f};
        cur = nxt; cA = nA; cB = nB; ++ui;
        if constexpr (GATHER) {
#pragma unroll
            for (int h = 0; h < 2; ++h)
#pragma unroll
                for (int i = 0; i < 2; ++i) cofs[h][i] = nofs[h][i];
        }
        if (wr == 1) PG8_BAR;
    }
    PG8_WAIT_V(0);
    PG8_BAR;
#undef PG8_SA
#undef PG8_SB
#undef PG8_STAGE
#undef PG8_STAGE_A
#undef PG8_LD8
#undef PG8_HALF
#undef PG8_LDA
#undef PG8_LDB
#undef PG8_MMA
#undef PG8_WAIT_V
#undef PG8_WAIT_L
#undef PG8_BAR
#undef PG8_SCHED
}


struct EpiInproj {
    static constexpr bool PERM = true;
    uchar* zbase; bf16_t* ci; _Float16* olog0; _Float16* olog1; const float* lb; int seg0; int Tn;
    __device__ __forceinline__ void operator()(const f32x4 (&acc)[2][2][4][2], const Unit& u, int wr, int wc, int fr, int fq) const {
        const int seg = seg0 + (u.pn >> 1);
        const int row0 = u.pm * BM + wr * 64 + fr;
        if (seg <= 3) {
            const int b = (u.pm * BM) / Tn, t0 = row0 - b * Tn, dcol = wc * 32 + 8 * fq;
#pragma unroll
            for (int bj = 0; bj < 2; ++bj) { const int hh = (u.pn & 1) * 2 + bj; const size_t plane = (size_t)(b * NH + hh) * Tn;
                if (seg == 1 || seg == 2) {
                    _Float16* O = (seg == 1) ? olog0 : olog1; const float* lbp = lb + (seg - 1) * 512 + hh * 128 + dcol;
                    const f32x4 l0 = *(const f32x4*)lbp, l1 = *(const f32x4*)(lbp + 4);
#pragma unroll
                    for (int ai = 0; ai < 2; ++ai)
#pragma unroll
                        for (int m = 0; m < 4; ++m) { const f32x4 v0 = acc[ai][bj][m][0], v1 = acc[ai][bj][m][1]; _Float16 o[8];
#pragma unroll
                            for (int j = 0; j < 4; ++j) { const float s0 = __builtin_amdgcn_rcpf(1.f + __builtin_amdgcn_exp2f(v0[j] * -1.44269504f)), s1 = __builtin_amdgcn_rcpf(1.f + __builtin_amdgcn_exp2f(v1[j] * -1.44269504f));
                                o[j] = (_Float16)__builtin_amdgcn_logf(l0[j] + (1.f - l0[j]) * s0); o[4 + j] = (_Float16)__builtin_amdgcn_logf(l1[j] + (1.f - l1[j]) * s1); }
                            __builtin_nontemporal_store(__builtin_bit_cast(u32x4, o), (u32x4*)(O + (plane + t0 + ai * HALF + m * 16) * 128 + dcol)); }
                } else {
                    bf16_t* O = zbase ? (bf16_t*)(zbase + (size_t)(seg == 0 ? 0 : 160) * MiB) : ci;
#pragma unroll
                    for (int ai = 0; ai < 2; ++ai)
#pragma unroll
                        for (int m = 0; m < 4; ++m) { const f32x4 v0 = acc[ai][bj][m][0], v1 = acc[ai][bj][m][1];
                            u32x4 w; w.x = cvt_pk_bf16(v0[0], v0[1]); w.y = cvt_pk_bf16(v0[2], v0[3]); w.z = cvt_pk_bf16(v1[0], v1[1]); w.w = cvt_pk_bf16(v1[2], v1[3]);
                            __builtin_nontemporal_store(w, (u32x4*)(O + (plane + t0 + ai * HALF + m * 16) * 128 + dcol)); }
                }
            }
        } else if (seg >= 6) {
            const int col0 = (u.pn - 12) * 128 + wc * 32 + 8 * fq;
            bf16_t* O = (bf16_t*)(zbase + (size_t)(32 * 6 + 64) * MiB);
#pragma unroll
            for (int ai = 0; ai < 2; ++ai)
#pragma unroll
                for (int m = 0; m < 4; ++m) { const f32x4 v0 = acc[ai][0][m][0] * acc[ai][1][m][0], v1 = acc[ai][0][m][1] * acc[ai][1][m][1];
                    u32x4 w; w.x = cvt_pk_bf16(v0[0], v0[1]); w.y = cvt_pk_bf16(v0[2], v0[3]); w.z = cvt_pk_bf16(v1[0], v1[1]); w.w = cvt_pk_bf16(v1[2], v1[3]);
                    __builtin_nontemporal_store(w, (u32x4*)(O + (size_t)(row0 + ai * HALF + m * 16) * 512 + col0)); }
        } else {
            const int col0 = (u.pn & 1) * 256 + wc * 32 + 8 * fq;
            bf16_t* O = (bf16_t*)(zbase + (size_t)(32 * seg + 64) * MiB);
#pragma unroll
            for (int ai = 0; ai < 2; ++ai)
#pragma unroll
                for (int m = 0; m < 4; ++m) { bf16_t* rowp = O + (size_t)(row0 + ai * HALF + m * 16) * 512 + col0;
#pragma unroll
                    for (int bj = 0; bj < 2; ++bj) { const f32x4 v0 = acc[ai][bj][m][0], v1 = acc[ai][bj][m][1];
                        u32x4 w; w.x = cvt_pk_bf16(v0[0], v0[1]); w.y = cvt_pk_bf16(v0[2], v0[3]); w.z = cvt_pk_bf16(v1[0], v1[1]); w.w = cvt_pk_bf16(v1[2], v1[3]);
                        __builtin_nontemporal_store(w, (u32x4*)(rowp + bj * HALF)); } }
        }
    }
};
struct EpiOut {
    static constexpr bool PERM = true;
    const float* x; bf16_t* x1; const float* modf;
    __device__ __forceinline__ void operator()(const f32x4 (&acc)[2][2][4][2], const Unit& u, int wr, int wc, int fr, int fq) const {
        const int row0 = u.pm * BM + wr * 64 + fr, col0 = u.pn * BM + wc * 32 + 8 * fq;
        const int b = (u.pm * BM) / T;
        const float* g1 = modf + (size_t)b * NMOD + 2 * D;
        f32x4 gv[2][2];
#pragma unroll
        for (int bj = 0; bj < 2; ++bj)
#pragma unroll
            for (int n = 0; n < 2; ++n) gv[bj][n] = *(const f32x4*)(g1 + col0 + bj * HALF + 4 * n);
#pragma unroll
        for (int ai = 0; ai < 2; ++ai)
#pragma unroll
            for (int m = 0; m < 4; ++m) { const size_t off = (size_t)(row0 + ai * HALF + m * 16) * D + col0;
#pragma unroll
                for (int bj = 0; bj < 2; ++bj) {
                    const f32x4 x0 = __builtin_nontemporal_load((const f32x4*)(x + off + bj * HALF)), x1v = __builtin_nontemporal_load((const f32x4*)(x + off + bj * HALF + 4));
                    const f32x4 v0 = x0 + gv[bj][0] * acc[ai][bj][m][0], v1 = x1v + gv[bj][1] * acc[ai][bj][m][1];
                    u32x4 w; w.x = cvt_pk_bf16(v0[0], v0[1]); w.y = cvt_pk_bf16(v0[2], v0[3]); w.z = cvt_pk_bf16(v1[0], v1[1]); w.w = cvt_pk_bf16(v1[2], v1[3]);
                    __builtin_nontemporal_store(w, (u32x4*)(x1 + off + bj * HALF)); }
                asm volatile("" ::: "memory"); }
    }
};
struct EpiMoe1 {
    static constexpr bool PERM = true;
    uchar* hid;
    __device__ __forceinline__ void operator()(const f32x4 (&acc)[2][2][4][2], const Unit& u, int wr, int wc, int fr, int fq) const {
        const int row0 = u.pm * BM + wr * 64 + fr, col0 = u.pn * 128 + wc * 32 + 8 * fq;
#pragma unroll
        for (int ai = 0; ai < 2; ++ai)
#pragma unroll
            for (int m = 0; m < 4; ++m) { uchar* rowp = hid + (size_t)(row0 + ai * HALF + m * 16) * DFF + col0;
                float o[8];
#pragma unroll
                for (int n = 0; n < 2; ++n)
#pragma unroll
                    for (int h = 0; h < 2; ++h) {
                        const f32x2 gt = h ? __builtin_shufflevector(acc[ai][0][m][n], acc[ai][0][m][n], 2, 3) : __builtin_shufflevector(acc[ai][0][m][n], acc[ai][0][m][n], 0, 1);
                        const f32x2 up = h ? __builtin_shufflevector(acc[ai][1][m][n], acc[ai][1][m][n], 2, 3) : __builtin_shufflevector(acc[ai][1][m][n], acc[ai][1][m][n], 0, 1);
                        const f32x2 tt = gt * -1.44269504f; const f32x2 dd = (f32x2){__builtin_amdgcn_exp2f(tt.x), __builtin_amdgcn_exp2f(tt.y)} + 1.f;
                        const f32x2 rr = (f32x2){__builtin_amdgcn_rcpf(dd.x), __builtin_amdgcn_rcpf(dd.y)}; const f32x2 oo = (gt * up) * rr; o[n * 4 + 2 * h] = oo.x; o[n * 4 + 2 * h + 1] = oo.y; }
                u32x2 w; w.x = cvt_pk4_fp8(o[0], o[1], o[2], o[3]); w.y = cvt_pk4_fp8(o[4], o[5], o[6], o[7]);
                __builtin_nontemporal_store(w, (u32x2*)rowp); }
    }
};
struct EpiMoe2 {
    static constexpr bool PERM = true;
    uchar* ys; const LAS float* lgate;
    __device__ __forceinline__ void operator()(const f32x4 (&acc)[2][2][4][2], const Unit& u, int wr, int wc, int fr, int fq) const {
        const int row0 = u.pm * BM + wr * 64 + fr, col0 = u.pn * BM + wc * 32 + 8 * fq;
        const LAS float* gt_ = lgate + (u.e >> 2) * BM + wr * 64 + fr;
#pragma unroll
        for (int ai = 0; ai < 2; ++ai)
#pragma unroll
            for (int m = 0; m < 4; ++m) { const int row = row0 + ai * HALF + m * 16; const float gt = gt_[ai * HALF + m * 16] * 16.f; uchar* rowp = ys + (size_t)row * D + col0;
#pragma unroll
                for (int bj = 0; bj < 2; ++bj) { const f32x4 v0 = acc[ai][bj][m][0] * gt, v1 = acc[ai][bj][m][1] * gt;
                    u32x2 w; w.x = cvt_pk4_fp8(v0[0], v0[1], v0[2], v0[3]); w.y = cvt_pk4_fp8(v1[0], v1[1], v1[2], v1[3]);
                    __builtin_nontemporal_store(w, (u32x2*)(rowp + bj * HALF)); } }
    }
};
}

struct Args {
    const float *x, *c, *ctx, *c_ctx, *w_ada, *b_ada, *norm_mix, *norm_ffn, *w_in, *lb_logits, *hg_norm, *conv_w, *w_out, *w_router, *w_gate, *w_up, *w_down, *norm_final;
    float* out; uchar* ws; int ph_lo, ph_hi;
};

__device__ __forceinline__ void cvt_item(const float* W, int ldw, bf16_t* WT, int ldt, int k0, int n0, int nrow0, LAS float* scr, int lane) {
    const int r = lane >> 3, c4 = lane & 7;
    f32x4 v[8];
#pragma unroll
    for (int i = 0; i < 8; ++i) v[i] = __builtin_nontemporal_load((const f32x4*)(W + (size_t)(k0 + 8 * i + r) * ldw + n0 + 4 * c4));
#pragma unroll
    for (int i = 0; i < 8; ++i) { LAS float* d = scr + (8 * i + r) * 33 + 4 * c4; d[0] = v[i].x; d[1] = v[i].y; d[2] = v[i].z; d[3] = v[i].w; }
    LDS_WAIT(); asm volatile("" ::: "memory");
    const int c = lane & 7;
#pragma unroll
    for (int j = 0; j < 4; ++j) { const int n = (lane >> 3) + 8 * j; const LAS float* sp = scr + (8 * c) * 33 + n;
        u32x4 o; o.x = cvt_pk_bf16(sp[0 * 33], sp[1 * 33]); o.y = cvt_pk_bf16(sp[2 * 33], sp[3 * 33]); o.z = cvt_pk_bf16(sp[4 * 33], sp[5 * 33]); o.w = cvt_pk_bf16(sp[6 * 33], sp[7 * 33]);
        *(u32x4*)(WT + (size_t)(nrow0 + n) * ldt + k0 + 8 * c) = o; }
    LDS_WAIT(); asm volatile("" ::: "memory");
}

__device__ __forceinline__ void cvt_item_fp8(const float* W, int ldw, uchar* WT, int ldt, int k0, int n0, int nrow0, LAS float* scr, int lane) {
    const int r = lane >> 3, c4 = lane & 7;
    f32x4 v[8];
#pragma unroll
    for (int i = 0; i < 8; ++i) v[i] = __builtin_nontemporal_load((const f32x4*)(W + (size_t)(k0 + 8 * i + r) * ldw + n0 + 4 * c4));
#pragma unroll
    for (int i = 0; i < 8; ++i) { LAS float* d = scr + (8 * i + r) * 33 + 4 * c4; d[0] = v[i].x; d[1] = v[i].y; d[2] = v[i].z; d[3] = v[i].w; }
    LDS_WAIT(); asm volatile("" ::: "memory");
    const int c = lane & 7;
#pragma unroll
    for (int j = 0; j < 4; ++j) { const int n = (lane >> 3) + 8 * j; const LAS float* sp = scr + (8 * c) * 33 + n;
        u32x2 o; o.x = cvt_pk4_fp8(sp[0 * 33] * 32.f, sp[1 * 33] * 32.f, sp[2 * 33] * 32.f, sp[3 * 33] * 32.f); o.y = cvt_pk4_fp8(sp[4 * 33] * 32.f, sp[5 * 33] * 32.f, sp[6 * 33] * 32.f, sp[7 * 33] * 32.f);
        *(u32x2*)(WT + (size_t)(nrow0 + n) * ldt + k0 + 8 * c) = o; }
    LDS_WAIT(); asm volatile("" ::: "memory");
}

__device__ __forceinline__ void phase_prep(const Args& a, LAS uchar* lds, int bid, int G, int tid, int wid, int lane) {
    float* modp = (float*)(a.ws + WS_MODP);
    if (bid < 192) {
        const int cgp = bid % 24, ks = bid / 24, n0 = cgp * 256 + lane * 4, k0 = ks * 128 + wid * 16;
        LAS float* sc = (LAS float*)(lds + 81920);
        for (int i = tid; i < 9 * 128; i += 512) { const int r = i >> 7, kk = i & 127; sc[i] = silu_f((r < 8) ? a.c[r * D + ks * 128 + kk] : a.c_ctx[ks * 128 + kk]); }
        f32x4 w[16];
#pragma unroll
        for (int kk = 0; kk < 16; ++kk) w[kk] = __builtin_nontemporal_load((const f32x4*)(a.w_ada + (size_t)(k0 + kk) * NMOD + n0));
        __syncthreads();
        f32x4 acc[9];
#pragma unroll
        for (int r = 0; r < 9; ++r) acc[r] = (f32x4){0.f, 0.f, 0.f, 0.f};
#pragma unroll
        for (int kk = 0; kk < 16; ++kk) {
#pragma unroll
            for (int r = 0; r < 9; ++r) acc[r] += w[kk] * sc[r * 128 + wid * 16 + kk]; }
        LAS f32x4* red = (LAS f32x4*)lds;
#pragma unroll
        for (int r = 0; r < 9; ++r) red[(wid * 9 + r) * 64 + lane] = acc[r];
        __syncthreads();
        for (int o = tid; o < 9 * 64; o += 512) { const int r = o / 64, l = o % 64; f32x4 sm = red[(0 * 9 + r) * 64 + l];
#pragma unroll
            for (int w8 = 1; w8 < 8; ++w8) sm += red[(w8 * 9 + r) * 64 + l];
            if (ks == 0) sm += *(const f32x4*)(a.b_ada + cgp * 256 + l * 4);
            *(f32x4*)(modp + ((size_t)ks * 9 + r) * NMOD + cgp * 256 + l * 4) = sm; }
        __syncthreads();
    }
    if (bid == 255) {
        float* lb = (float*)(a.ws + WS_LB);
        for (int i = tid; i < 1024; i += 512) { const float l0 = a.lb_logits[i], l1 = a.lb_logits[1024 + i]; lb[i] = 1.f / (1.f + __expf(l1 - l0)); }
    }
    LAS float* scr = (LAS float*)lds + wid * (64 * 33);
    const int gw = (G - 1 - bid) * 8 + wid, NGW = G * 8;
    constexpr int I_IN = (D / 64) * (NIN / 32), I_OUT = (D / 64) * (D / 32);
    for (int it = gw; it < I_IN + I_OUT; it += NGW) {
        if (it < I_IN) { const int nblk = NIN / 32, kb = it / nblk, nb = it % nblk; const int n0 = nb * 32;
            const int nrow = (n0 < 3072) ? n0 : 3072 + (((n0 - 3072) & 511) >> 7) * 256 + ((n0 - 3072) & 127) + ((n0 >= 3584) ? 128 : 0);
            cvt_item(a.w_in, NIN, (bf16_t*)(a.ws + WS_WIN), D, kb * 64, n0, nrow, scr, lane); }
        else { const int r = it - I_IN, nblk = D / 32, kb = r / nblk, nb = r % nblk; cvt_item(a.w_out, D, (bf16_t*)(a.ws + WS_WOUT), D, kb * 64, nb * 32, nb * 32, scr, lane); }
    }
}

__device__ __forceinline__ float modp_sum(const float* modp, int r, int col) { float s = 0.f;
#pragma unroll
    for (int ks = 0; ks < 8; ++ks) s += modp[((size_t)ks * 9 + r) * NMOD + col];
    return s; }
template <int NR>
__device__ __forceinline__ void norm_rows(const float* xrow0, bf16_t* orow0, const LAS float* gm, const LAS float* sh, int lane) {
    f32x4 v[NR][4]; float ss[NR];
#pragma unroll
    for (int i = 0; i < NR; ++i) { ss[i] = 0.f;
#pragma unroll
        for (int j = 0; j < 4; ++j) v[i][j] = __builtin_nontemporal_load((const f32x4*)(xrow0 + (size_t)i * D) + lane + 64 * j); }
#pragma unroll
    for (int i = 0; i < NR; ++i) {
#pragma unroll
        for (int j = 0; j < 4; ++j) ss[i] += (v[i][j].x * v[i][j].x + v[i][j].y * v[i][j].y) + (v[i][j].z * v[i][j].z + v[i][j].w * v[i][j].w);
        ss[i] = rsqrtf(wave_sum(ss[i]) * (1.f / D) + EPS); }
#pragma unroll
    for (int j = 0; j < 4; ++j) { const f32x4 g4 = *((const LAS f32x4*)gm + lane + 64 * j), s4 = *((const LAS f32x4*)sh + lane + 64 * j);
#pragma unroll
        for (int i = 0; i < NR; ++i) { const f32x4 o = v[i][j] * ss[i] * g4 + s4;
            u32x2 w; w.x = cvt_pk_bf16(o.x, o.y); w.y = cvt_pk_bf16(o.z, o.w); *((u32x2*)(orow0 + (size_t)i * D) + lane + 64 * j) = w; } }
}
__device__ __forceinline__ void phase_norm(const Args& a, LAS uchar* lds, int bid, int G, int tid, int wid, int lane) {
    const float* modp = (const float*)(a.ws + WS_MODP); float* modf = (float*)(a.ws + WS_MODF);
    { const int gt = bid * 512 + tid; if (gt < 9 * NMOD) modf[gt] = modp_sum(modp, gt / NMOD, gt % NMOD); }
    LAS float* gm = (LAS float*)lds; LAS float* sh = gm + D; LAS float* cgm = sh + D; LAS float* csh = cgm + D;
    const int b = bid / 32;
    for (int cidx = tid; cidx < D; cidx += 512) { const float nm = a.norm_mix[cidx];
        sh[cidx] = modp_sum(modp, b, cidx); gm[cidx] = nm * (1.f + modp_sum(modp, b, D + cidx));
        csh[cidx] = modp_sum(modp, 8, cidx); cgm[cidx] = nm * (1.f + modp_sum(modp, 8, D + cidx)); }
    __syncthreads();
    bf16_t* hx = (bf16_t*)(a.ws + WS_ACT); bf16_t* hc = (bf16_t*)(a.ws + WS_HC);
    { const int row = bid * 8 + wid; norm_rows<1>(a.ctx + (size_t)row * D, hc + (size_t)row * D, cgm, csh, lane); }
    for (int j = 0; j < 16; j += 4) { const int row = bid * 128 + wid * 16 + j; norm_rows<4>(a.x + (size_t)row * D, hx + (size_t)row * D, gm, sh, lane); }
    __syncthreads();
}

constexpr int GL_QDP = 0, GL_KIP = 8704, GL_SET0 = 17408, GL_SETSZ = 20992, GL_VTPO = 10240, GL_DECO = 20480, GL_TOT = 59392, GL_RING = 61440, GL_SLOT = 24576;
static_assert(GL_RING + 3 * GL_SLOT <= LDS_BYTES - 16, "GLA LDS map");
#define GLA_BAR() do { asm volatile("s_waitcnt lgkmcnt(0)" ::: "memory"); __builtin_amdgcn_s_barrier(); asm volatile("" ::: "memory"); } while (0)
template <bool FULL>
__device__ __forceinline__ void gla_item(LAS uchar* lds, const bf16_t* qb, const _Float16* lfb, const bf16_t* vb, bf16_t* ob, f32x4 (&S)[8][2], float* dl_out,
                                         int row_base, int Tn, int tau0, int nch, int h, int dir, int wid, int lane) {
    const int fr = lane & 15, fq = lane >> 4;
    const bool prod = wid < 4; const int pw = wid & 3;
    constexpr int NT = FULL ? 6 : 4;
    f32x2 kk_[8], cs[8]; unsigned qv[8]; f32x2 dsum = (f32x2){0.f, 0.f};
    const int d0 = 2 * lane, pos0 = (d0 & ~31) + 8 * ((d0 >> 2) & 3) + 4 * ((d0 >> 4) & 1) + (d0 & 3);
#define GLA_ISSUE(c) do { LAS uchar* _sl = lds + GL_RING + ((c) % 3) * GL_SLOT + pw * 6144; \
        _Pragma("unroll") for (int _g = 0; _g < 2; ++_g) { const int _tau = tau0 + 32 * (c) + 8 * pw + 4 * _g + (lane >> 4); const size_t _o = (size_t)(dir ? (Tn - 1 - _tau) : _tau) * 128 + (lane & 15) * 8; \
            __builtin_amdgcn_global_load_lds((const unsigned*)(lfb + _o), (LAS unsigned*)(_sl + _g * 1024), 16, 0, 2); \
            if (FULL) __builtin_amdgcn_global_load_lds((const unsigned*)(qb + _o), (LAS unsigned*)(_sl + 2048 + _g * 1024), 16, 0, 2); \
            __builtin_amdgcn_global_load_lds((const unsigned*)(vb + _o), (LAS unsigned*)(_sl + 4096 + _g * 1024), 16, 0, 2); } } while (0)
#define GLA_P1(c) do { \
        if ((c) + 2 < nch) { if (FULL) asm volatile("s_waitcnt vmcnt(12)" ::: "memory"); else asm volatile("s_waitcnt vmcnt(8)" ::: "memory"); } \
        else if ((c) + 1 < nch) { if (FULL) asm volatile("s_waitcnt vmcnt(6)" ::: "memory"); else asm volatile("s_waitcnt vmcnt(4)" ::: "memory"); } \
        else asm volatile("s_waitcnt vmcnt(0)" ::: "memory"); \
        const LAS uchar* _sl = lds + GL_RING + ((c) % 3) * GL_SLOT + pw * 6144; \
        LAS uchar* _set1 = lds + GL_SET0 + ((c) & 1) * GL_SETSZ; \
        unsigned _vv[8]; f32x2 _lf[8]; \
        _Pragma("unroll") for (int _r = 0; _r < 8; ++_r) { typedef _Float16 h2_t __attribute__((ext_vector_type(2))); const h2_t _hv = *(const LAS h2_t*)(_sl + _r * 256 + lane * 4); _lf[_r] = (f32x2){(float)_hv.x, (float)_hv.y}; \
            _vv[_r] = *(const LAS unsigned*)(_sl + 4096 + _r * 256 + lane * 4); qv[_r] = FULL ? *(const LAS unsigned*)(_sl + 2048 + _r * 256 + lane * 4) : 0u; } \
        cs[0] = _lf[0]; _Pragma("unroll") for (int _r = 1; _r < 8; ++_r) cs[_r] = cs[_r - 1] + _lf[_r]; \
        ((LAS f32x2*)(lds + GL_TOT))[pw * 64 + lane] = cs[7]; \
        _Pragma("unroll") for (int _r = 0; _r < 8; ++_r) kk_[_r] = 1.f - (f32x2){__builtin_amdgcn_exp2f(_lf[_r].x), __builtin_amdgcn_exp2f(_lf[_r].y)}; \
        _Pragma("unroll") for (int _g = 0; _g < 2; ++_g) { const int _sp = 8 * ((2 * pw + _g) & 3) + 4 * (pw >> 1);     \
            u32x2 _v0, _v1; _v0.x = (_vv[4 * _g] & 0xffffu) | (_vv[4 * _g + 1] << 16); _v0.y = (_vv[4 * _g + 2] & 0xffffu) | (_vv[4 * _g + 3] << 16); \
            _v1.x = (_vv[4 * _g] >> 16) | (_vv[4 * _g + 1] & 0xffff0000u); _v1.y = (_vv[4 * _g + 2] >> 16) | (_vv[4 * _g + 3] & 0xffff0000u); \
            *(LAS u32x2*)(_set1 + GL_VTPO + (d0) * 80 + _sp * 2) = _v0; *(LAS u32x2*)(_set1 + GL_VTPO + (d0 + 1) * 80 + _sp * 2) = _v1; } } while (0)
#define GLA_P2(c) do { \
        if ((c) + 3 < nch) GLA_ISSUE((c) + 3);     \
        f32x2 _pre = (f32x2){0.f, 0.f}, _all = (f32x2){0.f, 0.f}; \
        _Pragma("unroll") for (int _w = 0; _w < 4; ++_w) { const f32x2 _tw = ((const LAS f32x2*)(lds + GL_TOT))[_w * 64 + lane]; _all += _tw; if (_w < pw) _pre += _tw; } \
        dsum += _all; \
        const f32x2 _dec = (f32x2){__builtin_amdgcn_exp2f(_all.x), __builtin_amdgcn_exp2f(_all.y)}; \
        LAS uchar* _set = lds + GL_SET0 + ((c) & 1) * GL_SETSZ; \
        f32x2 _kE[8]; \
        _Pragma("unroll") for (int _r = 0; _r < 8; ++_r) { \
            const f32x2 _cum = _pre + cs[_r]; \
            const f32x2 _ki = kk_[_r] * (f32x2){__builtin_amdgcn_exp2f(-_cum.x), __builtin_amdgcn_exp2f(-_cum.y)}; \
            _kE[_r] = _ki * _dec; \
            if (FULL) { const int _s = 8 * pw + _r; const f32x2 _qd = (f32x2){bf_lo(qv[_r]), bf_hi(qv[_r])} * (f32x2){__builtin_amdgcn_exp2f(_cum.x), __builtin_amdgcn_exp2f(_cum.y)}; \
                *(LAS unsigned*)(lds + GL_QDP + _s * 272 + pos0 * 2) = cvt_pk_bf16(_qd.x, _qd.y); \
                *(LAS unsigned*)(lds + GL_KIP + _s * 272 + pos0 * 2) = cvt_pk_bf16(_ki.x, _ki.y); } } \
        _Pragma("unroll") for (int _g = 0; _g < 2; ++_g) { const int _sp = 8 * ((2 * pw + _g) & 3) + 4 * (pw >> 1);     \
            u32x2 _w0, _w1; _w0.x = cvt_pk_bf16(_kE[4 * _g].x, _kE[4 * _g + 1].x); _w0.y = cvt_pk_bf16(_kE[4 * _g + 2].x, _kE[4 * _g + 3].x); \
            _w1.x = cvt_pk_bf16(_kE[4 * _g].y, _kE[4 * _g + 1].y); _w1.y = cvt_pk_bf16(_kE[4 * _g + 2].y, _kE[4 * _g + 3].y); \
            *(LAS u32x2*)(_set + (d0) * 80 + _sp * 2) = _w0; *(LAS u32x2*)(_set + (d0 + 1) * 80 + _sp * 2) = _w1; \
} \
        if (pw == 0) *(LAS f32x2*)(_set + GL_DECO + lane * 8) = _dec; } while (0)

    if (prod) {
        GLA_ISSUE(0); if (nch > 1) GLA_ISSUE(1); if (nch > 2) GLA_ISSUE(2);
        GLA_P1(0);
        GLA_BAR();
        GLA_P2(0);
        GLA_BAR();
        for (int n = 0; n < nch; ++n) {
            if (n + 1 < nch) GLA_P1(n + 1);
            GLA_BAR();
            if (n + 1 < nch) GLA_P2(n + 1);
            GLA_BAR();
        }
    } else {
        u32x4 sAp[4][2];
#define GLA_SCVT() do { _Pragma("unroll") for (int _kk = 0; _kk < 4; ++_kk) _Pragma("unroll") for (int _vt = 0; _vt < 2; ++_vt) { \
            sAp[_kk][_vt].x = cvt_pk_bf16_safe(S[2 * _kk][_vt][0], S[2 * _kk][_vt][1]); sAp[_kk][_vt].y = cvt_pk_bf16_safe(S[2 * _kk][_vt][2], S[2 * _kk][_vt][3]); \
            sAp[_kk][_vt].z = cvt_pk_bf16_safe(S[2 * _kk + 1][_vt][0], S[2 * _kk + 1][_vt][1]); sAp[_kk][_vt].w = cvt_pk_bf16_safe(S[2 * _kk + 1][_vt][2], S[2 * _kk + 1][_vt][3]); } } while (0)
        if (FULL) GLA_SCVT();
        GLA_BAR();
        GLA_BAR();
        for (int n = 0; n < nch; ++n) {
            const LAS uchar* set = lds + GL_SET0 + (n & 1) * GL_SETSZ;
            bf16x8 vtf[2];
#pragma unroll
            for (int vt = 0; vt < 2; ++vt) vtf[vt] = *(const LAS bf16x8*)(set + GL_VTPO + (32 * pw + 16 * vt + fr) * 80 + fq * 16);
            if (FULL) {
                bf16x8 qf[2][4];
#pragma unroll
                for (int ti = 0; ti < 2; ++ti)
#pragma unroll
                    for (int kk = 0; kk < 4; ++kk) qf[ti][kk] = *(const LAS bf16x8*)(lds + GL_QDP + (16 * ti + fr) * 272 + kk * 64 + fq * 16);
                f32x4 oT[2][2];
#pragma unroll
                for (int vt = 0; vt < 2; ++vt)
#pragma unroll
                    for (int ti = 0; ti < 2; ++ti) oT[vt][ti] = (f32x4){0.f, 0.f, 0.f, 0.f};
                f32x4 p00 = (f32x4){0.f, 0.f, 0.f, 0.f}, p01 = p00, p11 = p00;
#pragma unroll
                for (int kk = 0; kk < 4; ++kk) {
                    const bf16x8 kj0 = *(const LAS bf16x8*)(lds + GL_KIP + (fr) * 272 + kk * 64 + fq * 16);
                    const bf16x8 kj1 = *(const LAS bf16x8*)(lds + GL_KIP + (16 + fr) * 272 + kk * 64 + fq * 16);
                    p00 = __builtin_amdgcn_mfma_f32_16x16x32_bf16(kj0, qf[0][kk], p00, 0, 0, 0);
                    p01 = __builtin_amdgcn_mfma_f32_16x16x32_bf16(kj0, qf[1][kk], p01, 0, 0, 0);
                    p11 = __builtin_amdgcn_mfma_f32_16x16x32_bf16(kj1, qf[1][kk], p11, 0, 0, 0);
#pragma unroll
                    for (int vt = 0; vt < 2; ++vt) {
                        const bf16x8 sA = __builtin_bit_cast(bf16x8, sAp[kk][vt]);
                        oT[vt][0] = __builtin_amdgcn_mfma_f32_16x16x32_bf16(sA, qf[0][kk], oT[vt][0], 0, 0, 0);
                        oT[vt][1] = __builtin_amdgcn_mfma_f32_16x16x32_bf16(sA, qf[1][kk], oT[vt][1], 0, 0, 0); }
                }
                u32x4 pb0, pb1;
                { float m0[4], m1[4];
#pragma unroll
                  for (int r = 0; r < 4; ++r) { const bool ok = (4 * fq + r) <= fr; m0[r] = ok ? p00[r] : 0.f; m1[r] = ok ? p11[r] : 0.f; }
                  pb0.x = cvt_pk_bf16_safe(m0[0], m0[1]); pb0.y = cvt_pk_bf16_safe(m0[2], m0[3]); pb0.z = 0u; pb0.w = 0u;
                  pb1.x = cvt_pk_bf16_safe(p01[0], p01[1]); pb1.y = cvt_pk_bf16_safe(p01[2], p01[3]); pb1.z = cvt_pk_bf16_safe(m1[0], m1[1]); pb1.w = cvt_pk_bf16_safe(m1[2], m1[3]); }
#pragma unroll
                for (int vt = 0; vt < 2; ++vt) {
                    oT[vt][0] = __builtin_amdgcn_mfma_f32_16x16x32_bf16(vtf[vt], __builtin_bit_cast(bf16x8, pb0), oT[vt][0], 0, 0, 0);
                    oT[vt][1] = __builtin_amdgcn_mfma_f32_16x16x32_bf16(vtf[vt], __builtin_bit_cast(bf16x8, pb1), oT[vt][1], 0, 0, 0); }
#pragma unroll
                for (int ti = 0; ti < 2; ++ti) { const int tau = tau0 + 32 * n + 16 * ti + fr; const size_t row = (size_t)(row_base + (dir ? (Tn - 1 - tau) : tau));
#pragma unroll
                    for (int vt = 0; vt < 2; ++vt) { u32x2 w; w.x = cvt_pk_bf16_safe(oT[vt][ti][0], oT[vt][ti][1]); w.y = cvt_pk_bf16_safe(oT[vt][ti][2], oT[vt][ti][3]);
                        *(u32x2*)(ob + row * 512 + h * 128 + 32 * pw + 16 * vt + 4 * fq) = w; } }
            }
            GLA_BAR();
#pragma unroll
            for (int t8 = 0; t8 < 8; ++t8) {
                const f32x4 dc = *(const LAS f32x4*)(set + GL_DECO + (16 * t8 + 4 * fq) * 4);
                const bf16x8 ka = *(const LAS bf16x8*)(set + (16 * t8 + fr) * 80 + fq * 16);
#pragma unroll
                for (int vt = 0; vt < 2; ++vt) S[t8][vt] = __builtin_amdgcn_mfma_f32_16x16x32_bf16(ka, vtf[vt], S[t8][vt] * dc, 0, 0, 0);
            }
            if (FULL && n + 1 < nch) GLA_SCVT();
            GLA_BAR();
        }
#undef GLA_SCVT
    }
#undef GLA_ISSUE
#undef GLA_P1
#undef GLA_P2
    if (dl_out && wid == 0) *(f32x2*)(dl_out + 2 * lane) = dsum;
    asm volatile("s_waitcnt vmcnt(0)" ::: "memory");
    GLA_BAR();
}
__device__ __forceinline__ void gla_state_store(float* p, const f32x4 (&S)[8][2], int cw, int fr, int fq) {
#pragma unroll
    for (int t8 = 0; t8 < 8; ++t8)
#pragma unroll
        for (int vt = 0; vt < 2; ++vt)
#pragma unroll
            for (int r = 0; r < 4; ++r) p[(size_t)(16 * t8 + 4 * fq + r) * 128 + 32 * cw + 16 * vt + fr] = S[t8][vt][r];
}
__device__ __forceinline__ void phase_gla_states(const Args& a, LAS uchar* lds, int bid, int wid, int lane) {
    uchar* ws = a.ws; const int fr = lane & 15, fq = lane >> 4;
    f32x4 S[8][2];
#pragma unroll
    for (int t8 = 0; t8 < 8; ++t8) { S[t8][0] = (f32x4){0.f, 0.f, 0.f, 0.f}; S[t8][1] = (f32x4){0.f, 0.f, 0.f, 0.f}; }
    if (bid < 192) { const int bhd = bid / 3, seg = bid % 3, b = bhd >> 3, h = (bhd >> 1) & 3, dir = bhd & 1;
        const size_t pl = (size_t)(b * NH + h) * T * 128;
        gla_item<false>(lds, nullptr, (const _Float16*)(ws + (dir ? WS_LBW : WS_LF)) + pl, (const bf16_t*)(ws + WS_ZI) + pl, nullptr, S, (float*)(ws + WS_DL) + (size_t)bid * 128,
                        b * T, T, seg * 1024, 32, h, dir, wid, lane);
        if (wid >= 4) gla_state_store((float*)(ws + WS_SL) + (size_t)bid * 16384, S, wid - 4, fr, fq);
    } else { const int bhd = bid - 192, b = bhd >> 3, h = (bhd >> 1) & 3, dir = bhd & 1;
        const size_t pl = (size_t)(b * NH + h) * CT * 128;
        gla_item<false>(lds, nullptr, (const _Float16*)(ws + (dir ? WS_CLB : WS_CLF)) + pl, (const bf16_t*)(ws + WS_CI) + pl, nullptr, S, nullptr, b * CT, CT, 0, CT / 32, h, dir, wid, lane);
        if (wid >= 4) gla_state_store((float*)(ws + WS_S0) + (size_t)bhd * 16384, S, wid - 4, fr, fq);
    }
}
__device__ __forceinline__ void phase_gla_out(const Args& a, LAS uchar* lds, int bid, int wid, int lane) {
    uchar* ws = a.ws; const int fr = lane & 15, fq = lane >> 4;
    const int bhd = bid >> 2, seg = bid & 3, b = bhd >> 3, h = (bhd >> 1) & 3, dir = bhd & 1;
    f32x4 S[8][2];
    if (wid >= 4) { const int cw = wid - 4;
        { const float* p = (const float*)(ws + WS_S0) + (size_t)bhd * 16384;
#pragma unroll
          for (int t8 = 0; t8 < 8; ++t8)
#pragma unroll
              for (int vt = 0; vt < 2; ++vt)
#pragma unroll
                  for (int r = 0; r < 4; ++r) S[t8][vt][r] = p[(size_t)(16 * t8 + 4 * fq + r) * 128 + 32 * cw + 16 * vt + fr]; }
        for (int j = 0; j < seg; ++j) { const float* p = (const float*)(ws + WS_SL) + (size_t)(bhd * 3 + j) * 16384; const float* dl = (const float*)(ws + WS_DL) + (size_t)(bhd * 3 + j) * 128;
#pragma unroll
            for (int t8 = 0; t8 < 8; ++t8) { const f32x4 dv = *(const f32x4*)(dl + 16 * t8 + 4 * fq);
#pragma unroll
                for (int vt = 0; vt < 2; ++vt)
#pragma unroll
                    for (int r = 0; r < 4; ++r) S[t8][vt][r] = __builtin_amdgcn_exp2f(dv[r]) * S[t8][vt][r] + p[(size_t)(16 * t8 + 4 * fq + r) * 128 + 32 * cw + 16 * vt + fr]; } }
    } else {
#pragma unroll
        for (int t8 = 0; t8 < 8; ++t8) { S[t8][0] = (f32x4){0.f, 0.f, 0.f, 0.f}; S[t8][1] = (f32x4){0.f, 0.f, 0.f, 0.f}; }
    }
    asm volatile("s_waitcnt vmcnt(0)" ::: "memory");
    const size_t pl = (size_t)(b * NH + h) * T * 128;
    gla_item<true>(lds, (const bf16_t*)(ws + WS_ZQ) + pl, (const _Float16*)(ws + (dir ? WS_LBW : WS_LF)) + pl, (const bf16_t*)(ws + WS_ZI) + pl, (bf16_t*)(ws + (dir ? WS_OB : WS_OF)), S, nullptr,
                   b * T, T, seg * 1024, 32, h, dir, wid, lane);
}

__device__ __forceinline__ void unpack8(const u32x4 w, float (&f)[8]) { f[0] = bf_lo(w.x); f[1] = bf_hi(w.x); f[2] = bf_lo(w.y); f[3] = bf_hi(w.y); f[4] = bf_lo(w.z); f[5] = bf_hi(w.z); f[6] = bf_lo(w.w); f[7] = bf_hi(w.w); }
__device__ __forceinline__ void phase_mixfin(const Args& a, int bid, int G, int wid, int lane) {
    const bf16_t* of = (const bf16_t*)(a.ws + WS_OF); const bf16_t* obw = (const bf16_t*)(a.ws + WS_OB); const bf16_t* zg = (const bf16_t*)(a.ws + WS_ZG);
    const bf16_t* zgb = (const bf16_t*)(a.ws + WS_ZGB); const bf16_t* zgc = (const bf16_t*)(a.ws + WS_ZGC);
    bf16_t* A2 = (bf16_t*)(a.ws + WS_ACT);
    const int c0 = 8 * lane;
    float gain[8], cw0[8], cw1[8], cw2[8];
#pragma unroll
    for (int j = 0; j < 8; ++j) { gain[j] = a.hg_norm[(c0 + j) & 127]; cw0[j] = a.conv_w[c0 + j]; cw1[j] = a.conv_w[512 + c0 + j]; cw2[j] = a.conv_w[1024 + c0 + j]; }
    for (int row = bid * 8 + wid; row < M; row += G * 8) {
        const size_t ro = (size_t)row * 512 + c0;
        float f0[8], f1[8], gg[8], o[8];
        unpack8(__builtin_nontemporal_load((const u32x4*)(of + ro)), f0); unpack8(__builtin_nontemporal_load((const u32x4*)(obw + ro)), f1); unpack8(__builtin_nontemporal_load((const u32x4*)(zg + ro)), gg);
        float ss = 0.f;
#pragma unroll
        for (int j = 0; j < 8; ++j) { o[j] = f0[j] + f1[j]; ss += o[j] * o[j]; }
        ss += __shfl_xor(ss, 1); ss += __shfl_xor(ss, 2); ss += __shfl_xor(ss, 4); ss += __shfl_xor(ss, 8);
        const float rstd = rsqrtf(ss * (1.f / 128.f) + EPS);
#pragma unroll
        for (int j = 0; j < 8; ++j) o[j] = o[j] * rstd * gain[j] * silu_f(gg[j]);
        u32x4 w; w.x = cvt_pk_bf16(o[0], o[1]); w.y = cvt_pk_bf16(o[2], o[3]); w.z = cvt_pk_bf16(o[4], o[5]); w.w = cvt_pk_bf16(o[6], o[7]);
        *(u32x4*)(A2 + (size_t)row * D + c0) = w;
        const int tw = row & 63;
        float um[8], u0[8], up[8], gb[8], y[8];
        unpack8(*(const u32x4*)(zgc + ro), u0); unpack8(__builtin_nontemporal_load((const u32x4*)(zgb + ro)), gb);
        if (tw > 0) unpack8(*(const u32x4*)(zgc + ro - 512), um);
        else {
#pragma unroll
            for (int j = 0; j < 8; ++j) um[j] = 0.f; }
        if (tw < 63) unpack8(*(const u32x4*)(zgc + ro + 512), up);
        else {
#pragma unroll
            for (int j = 0; j < 8; ++j) up[j] = 0.f; }
#pragma unroll
        for (int j = 0; j < 8; ++j) y[j] = gb[j] * (cw0[j] * um[j] + cw1[j] * u0[j] + cw2[j] * up[j]);
        w.x = cvt_pk_bf16(y[0], y[1]); w.y = cvt_pk_bf16(y[2], y[3]); w.z = cvt_pk_bf16(y[4], y[5]); w.w = cvt_pk_bf16(y[6], y[7]);
        *(u32x4*)(A2 + (size_t)row * D + 512 + c0) = w;
    }
}

__device__ __forceinline__ void phase_router(const Args& a, LAS uchar* lds, int bid, int tid, int wid, int lane) {
    const float* modf = (const float*)(a.ws + WS_MODF);
    LAS float* gm = (LAS float*)lds; LAS float* sh = gm + D;
    LAS uchar* wrl = lds + 8192;
    const int b = bid / 32;
    for (int cidx = tid; cidx < D; cidx += 512) { sh[cidx] = modf[(size_t)b * NMOD + 3 * D + cidx]; gm[cidx] = a.norm_ffn[cidx] * (1.f + modf[(size_t)b * NMOD + 4 * D + cidx]); }
    for (int i = tid; i < D * 4; i += 512) { const int col = i >> 2, q4 = i & 3; *(LAS f32x4*)(wrl + col * 64 + (col >> 2) * 16 + q4 * 16) = *(const f32x4*)(a.w_router + col * 16 + q4 * 4); }
    __syncthreads();
    uchar* hx2 = a.ws + WS_ACT; float* aff = (float*)(a.ws + WS_AFF);
    u32x2 xn[4][4];
#define RT_LOAD(JB) do { const bf16_t* _x = (const bf16_t*)(a.ws + WS_X1B) + (size_t)(bid * 128 + wid * 16 + (JB) * 4) * D; \
        _Pragma("unroll") for (int _i = 0; _i < 4; ++_i) _Pragma("unroll") for (int _j = 0; _j < 4; ++_j) xn[_i][_j] = __builtin_nontemporal_load((const u32x2*)(_x + (size_t)_i * D) + lane + 64 * _j); } while (0)
    RT_LOAD(0);
    for (int jb = 0; jb < 4; ++jb) {
        const int row0 = bid * 128 + wid * 16 + jb * 4;
        f32x4 v[4][4]; float rstd[4];
#pragma unroll
        for (int i = 0; i < 4; ++i) { float ss = 0.f;
#pragma unroll
            for (int jj = 0; jj < 4; ++jj) { const u32x2 xw = xn[i][jj]; v[i][jj] = (f32x4){bf_lo(xw.x), bf_hi(xw.x), bf_lo(xw.y), bf_hi(xw.y)}; ss += (v[i][jj].x * v[i][jj].x + v[i][jj].y * v[i][jj].y) + (v[i][jj].z * v[i][jj].z + v[i][jj].w * v[i][jj].w); }
            rstd[i] = ss; }
        if (jb < 3) RT_LOAD(jb + 1);
#pragma unroll
        for (int i = 0; i < 4; ++i) rstd[i] = rsqrtf(wave_sum(rstd[i]) * (1.f / D) + EPS);
        f32x2 pl2[32];
#define pl(k) pl2[(k) >> 1][(k) & 1]
#pragma unroll
        for (int e = 0; e < 32; ++e) pl2[e] = (f32x2){0.f, 0.f};
#pragma unroll
        for (int jj = 0; jj < 4; ++jj) { const f32x4 g4 = *((const LAS f32x4*)gm + lane + 64 * jj), s4 = *((const LAS f32x4*)sh + lane + 64 * jj);
#pragma unroll
            for (int i = 0; i < 4; ++i) { v[i][jj] = v[i][jj] * rstd[i] * g4 + s4;
                *((unsigned*)(hx2 + (size_t)(row0 + i) * D) + lane + 64 * jj) = cvt_pk4_fp8(v[i][jj].x, v[i][jj].y, v[i][jj].z, v[i][jj].w); }
            const int colb = 4 * lane + 256 * jj;
#pragma unroll
            for (int cc = 0; cc < 4; ++cc) { const int col = colb + cc; const LAS uchar* wp = wrl + col * 64 + (col >> 2) * 16;
#pragma unroll
                for (int q4 = 0; q4 < 4; ++q4) { const f32x4 w4 = *(const LAS f32x4*)(wp + q4 * 16);
#pragma unroll
                    for (int i = 0; i < 4; ++i) { const float hvv = v[i][jj][cc]; const f32x2 h2 = (f32x2){hvv, hvv};
                        pl2[i * 8 + q4 * 2 + 0] = __builtin_elementwise_fma(h2, (f32x2){w4.x, w4.y}, pl2[i * 8 + q4 * 2 + 0]); pl2[i * 8 + q4 * 2 + 1] = __builtin_elementwise_fma(h2, (f32x2){w4.z, w4.w}, pl2[i * 8 + q4 * 2 + 1]); } } } }
#pragma unroll
        for (int k = 0; k < 32; ++k) { const bool hi = (lane & 32) != 0; const float keep = hi ? pl(32 + k) : pl(k), send = hi ? pl(k) : pl(32 + k); pl(k) = keep + __shfl_xor(send, 32); }
#pragma unroll
        for (int k = 0; k < 16; ++k) { const bool hi = (lane & 16) != 0; const float keep = hi ? pl(16 + k) : pl(k), send = hi ? pl(k) : pl(16 + k); pl(k) = keep + __shfl_xor(send, 16); }
#pragma unroll
        for (int k = 0; k < 8; ++k) { const bool hi = (lane & 8) != 0; const float keep = hi ? pl(8 + k) : pl(k), send = hi ? pl(k) : pl(8 + k); pl(k) = keep + __shfl_xor(send, 8); }
#pragma unroll
        for (int k = 0; k < 4; ++k) { const bool hi = (lane & 4) != 0; const float keep = hi ? pl(4 + k) : pl(k), send = hi ? pl(k) : pl(4 + k); pl(k) = keep + __shfl_xor(send, 4); }
#pragma unroll
        for (int k = 0; k < 2; ++k) { const bool hi = (lane & 2) != 0; const float keep = hi ? pl(2 + k) : pl(k), send = hi ? pl(k) : pl(2 + k); pl(k) = keep + __shfl_xor(send, 2); }
        { const bool hi = (lane & 1) != 0; const float keep = hi ? pl(1) : pl(0), send = hi ? pl(0) : pl(1); pl(0) = keep + __shfl_xor(send, 1); }
        const float lg = pl(0);
#undef pl
        float mx = lg;
#pragma unroll
        for (int o = 1; o < 16; o <<= 1) mx = fmaxf(mx, __shfl_xor(mx, o));
        const float ex = __expf(lg - mx); float den = ex;
#pragma unroll
        for (int o = 1; o < 16; o <<= 1) den += __shfl_xor(den, o);
        const int t = (row0 + (lane >> 4)) & (T - 1);
        aff[((size_t)b * NE + (lane & 15)) * T + t] = ex / den;
    }
#undef RT_LOAD
    __syncthreads();
}

__device__ __forceinline__ void topk_item(const Args& a, LAS uchar* lds, int b, int e, int tid, int wid, int lane) {
    LAS unsigned* key = (LAS unsigned*)lds;
    LAS unsigned* hist = key + 4096;
    LAS unsigned* ctl = hist + 256;
    LAS unsigned* wsum = ctl + 8;
    const float* affp = (const float*)(a.ws + WS_AFF) + ((size_t)b * NE + e) * T;
    unsigned kv[8];
    { const u32x4 k0 = *(const u32x4*)(affp + tid * 8), k1 = *(const u32x4*)(affp + tid * 8 + 4); kv[0] = k0.x; kv[1] = k0.y; kv[2] = k0.z; kv[3] = k0.w; kv[4] = k1.x; kv[5] = k1.y; kv[6] = k1.z; kv[7] = k1.w; }
    unsigned prefix = 0u, mask = 0u, need = CAP;
    for (int shift = 24; shift >= 0; shift -= 8) {
        if (tid < 256) hist[tid] = 0u;
        __syncthreads();
#pragma unroll
        for (int j = 0; j < 8; ++j) if ((kv[j] & mask) == prefix) __hip_atomic_fetch_add(&hist[(kv[j] >> shift) & 255u], 1u, __ATOMIC_RELAXED, __HIP_MEMORY_SCOPE_WORKGROUP);
        __syncthreads();
        if (tid < 256) { unsigned above = 0u; for (int bb = tid + 1; bb < 256; ++bb) above += hist[bb]; const unsigned mine = hist[tid];
            if (above < need && need <= above + mine) { ctl[0] = (unsigned)tid; ctl[1] = need - above; } }
        __syncthreads();
        prefix |= ctl[0] << shift; mask |= 255u << shift; need = ctl[1];
        __syncthreads();
    }
    unsigned cg_ = 0u, ce_ = 0u;
#pragma unroll
    for (int j = 0; j < 8; ++j) { cg_ += kv[j] > prefix; ce_ += kv[j] == prefix; }
    unsigned pk = cg_ | (ce_ << 16), incl = pk;
#pragma unroll
    for (int o = 1; o < 64; o <<= 1) { const unsigned t2 = __shfl_up(incl, o); if (lane >= o) incl += t2; }
    if (lane == 63) wsum[wid] = incl;
    __syncthreads();
    unsigned base = 0u;
    for (int w = 0; w < wid; ++w) base += wsum[w];
    unsigned excl = base + incl - pk; unsigned ng = excl & 0xffffu, neq = excl >> 16;
    int* seltok = (int*)(a.ws + WS_SELTOK); float* selgate = (float*)(a.ws + WS_SELGATE); short* pos = (short*)(a.ws + WS_POS);
#pragma unroll
    for (int j = 0; j < 8; ++j) { const int t = tid * 8 + j; const bool gt = kv[j] > prefix, eq = kv[j] == prefix; const bool sel = gt || (eq && neq < need);
        int slot = -1;
        if (sel) slot = (int)(ng + (neq < need ? neq : need));
        if (sel) { seltok[e * 4096 + b * 512 + slot] = b * T + t; selgate[e * 4096 + b * 512 + slot] = __uint_as_float(kv[j]); }
        pos[((size_t)b * T + t) * 16 + e] = (short)slot;
        ng += gt; neq += eq; }
    __syncthreads();
}
__device__ __forceinline__ void phase_topk_cvt(const Args& a, LAS uchar* lds, int bid, int G, int tid, int wid, int lane) {
    if (bid < 128) topk_item(a, lds, bid / 16, bid % 16, tid, wid, lane);
    LAS float* scr = (LAS float*)(lds + 32768) + wid * (64 * 33);
    uchar* wgu = a.ws + WS_WGU; uchar* wdn = a.ws + WS_WDN;
    constexpr int I_G = (D / 64) * (DFF / 32);
    constexpr int I_D = (DFF / 64) * (D / 32);
    constexpr int PER_E = 2 * I_G + I_D, TOTAL = NE * PER_E;
    static_assert(TOTAL == 1024 * 22 + 1024 * 26, "item split");
    const bool tk = bid < 128; const int wi = (tk ? bid : bid - 128) * 8 + wid;
    const int cnt = tk ? 22 : 26, base = tk ? 1024 * 26 : 0;
    for (int k = 0; k < cnt; ++k) { const int it = base + k * 1024 + wi;
        const int e = it / PER_E; int r = it % PER_E;
        if (r < 2 * I_G) { const int up = r >= I_G; if (up) r -= I_G; const int nblk = DFF / 32, kb = r / nblk, nb = r % nblk, n0 = nb * 32;
            const float* W = (up ? a.w_up : a.w_gate) + (size_t)e * D * DFF;
            cvt_item_fp8(W, DFF, wgu + (size_t)e * 4096 * D, D, kb * 64, n0, (n0 >> 7) * 256 + (n0 & 127) + (up ? 128 : 0), scr, lane); }
        else { r -= 2 * I_G; const int nblk = D / 32, kb = r / nblk, nb = r % nblk;
            cvt_item_fp8(a.w_down + (size_t)e * DFF * D, D, wdn + (size_t)e * D * DFF, DFF, kb * 64, nb * 32, nb * 32, scr, lane); }
    }
    __syncthreads();
}

__device__ __forceinline__ void phase_final(const Args& a, int bid, int G, int wid, int lane) {
    const float* modf = (const float*)(a.ws + WS_MODF); const short* pos = (const short*)(a.ws + WS_POS); const uchar* ys = a.ws + WS_YS;
    const bf16_t* x1b = (const bf16_t*)(a.ws + WS_X1B);
    f32x4 nf[4];
#pragma unroll
    for (int q = 0; q < 4; ++q) nf[q] = *(const f32x4*)(a.norm_final + (q >> 1) * 512 + 8 * lane + (q & 1) * 4);
    const int stride = G * 8;
#define FIN_SLOT(ROW) (((ROW) < M && lane < 16) ? (int)pos[(size_t)(ROW) * 16 + lane] : -1)
#define FIN_ISSUE(ROW, SLOTV, XW, W, EE, SL, REST) do { const int _b = (ROW) / T; const bf16_t* _x = x1b + (size_t)(ROW) * D; \
        XW[0] = __builtin_nontemporal_load((const u32x4*)(_x + 8 * lane)); XW[1] = __builtin_nontemporal_load((const u32x4*)(_x + 512 + 8 * lane)); \
        unsigned long long _m = __ballot((SLOTV) >= 0); \
        _Pragma("unroll") for (int _k = 0; _k < 4; ++_k) { if (_m) { EE[_k] = __builtin_ctzll(_m); _m &= _m - 1; SL[_k] = __shfl((SLOTV), EE[_k]); } else { EE[_k] = -1; SL[_k] = 0; } } \
        REST = _m; \
        _Pragma("unroll") for (int _k = 0; _k < 4; ++_k) if (EE[_k] >= 0) { const uchar* _yr = ys + ((size_t)EE[_k] * 4096 + _b * 512 + SL[_k]) * D + 8 * lane; \
            W[_k][0] = __builtin_nontemporal_load((const u32x2*)_yr); W[_k][1] = __builtin_nontemporal_load((const u32x2*)(_yr + 512)); } } while (0)
#define FIN_ACC(WW, HF) do { const f32x2 _p0 = __builtin_amdgcn_cvt_pk_f32_fp8((WW).x, false), _p1 = __builtin_amdgcn_cvt_pk_f32_fp8((WW).x, true), _p2 = __builtin_amdgcn_cvt_pk_f32_fp8((WW).y, false), _p3 = __builtin_amdgcn_cvt_pk_f32_fp8((WW).y, true); \
        acc[2 * (HF)].x += _p0.x; acc[2 * (HF)].y += _p0.y; acc[2 * (HF)].z += _p1.x; acc[2 * (HF)].w += _p1.y; \
        acc[2 * (HF) + 1].x += _p2.x; acc[2 * (HF) + 1].y += _p2.y; acc[2 * (HF) + 1].z += _p3.x; acc[2 * (HF) + 1].w += _p3.y; } while (0)
    int row = bid * 8 + wid;
    u32x4 xwC[2], xwN[2]; u32x2 wC[4][2], wN[4][2]; int eeC[4], slC[4], eeN[4], slN[4]; unsigned long long restC = 0ull, restN = 0ull;
    int slotC = FIN_SLOT(row), slotB = FIN_SLOT(row + stride);
    FIN_ISSUE(row, slotC, xwC, wC, eeC, slC, restC);
    for (; row < M; row += stride) {
        const int nrow = row + stride;
        const int slotN2 = FIN_SLOT(row + 2 * stride);
        if (nrow < M) FIN_ISSUE(nrow, slotB, xwN, wN, eeN, slN, restN);
        const int b = row / T; float* xrow = a.out + (size_t)row * D;
        f32x4 v[4], acc[4];
#pragma unroll
        for (int hf = 0; hf < 2; ++hf) { const u32x4 xw = xwC[hf];
            v[2 * hf] = (f32x4){bf_lo(xw.x), bf_hi(xw.x), bf_lo(xw.y), bf_hi(xw.y)}; v[2 * hf + 1] = (f32x4){bf_lo(xw.z), bf_hi(xw.z), bf_lo(xw.w), bf_hi(xw.w)}; acc[2 * hf] = (f32x4){0.f, 0.f, 0.f, 0.f}; acc[2 * hf + 1] = (f32x4){0.f, 0.f, 0.f, 0.f}; }
#pragma unroll
        for (int k = 0; k < 4; ++k) if (eeC[k] >= 0) { FIN_ACC(wC[k][0], 0); FIN_ACC(wC[k][1], 1); }
        while (restC) {
            const int e = __builtin_ctzll(restC); restC &= restC - 1; const int sl = __shfl(slotC, e);
            const uchar* yr = ys + ((size_t)e * 4096 + b * 512 + sl) * D + 8 * lane;
            const u32x2 w0 = *(const u32x2*)yr, w1 = *(const u32x2*)(yr + 512);
            FIN_ACC(w0, 0); FIN_ACC(w1, 1); }
        float ss = 0.f;
#pragma unroll
        for (int q = 0; q < 4; ++q) { const f32x4 g2 = *(const f32x4*)(modf + (size_t)b * NMOD + 5 * D + (q >> 1) * 512 + 8 * lane + (q & 1) * 4); v[q] = v[q] + g2 * acc[q] * 0.0625f;
            ss += (v[q].x * v[q].x + v[q].y * v[q].y) + (v[q].z * v[q].z + v[q].w * v[q].w); }
        const float rstd = rsqrtf(wave_sum(ss) * (1.f / D) + EPS);
#pragma unroll
        for (int q = 0; q < 4; ++q) __builtin_nontemporal_store(v[q] * rstd * nf[q], (f32x4*)(xrow + (q >> 1) * 512 + 8 * lane + (q & 1) * 4));
        xwC[0] = xwN[0]; xwC[1] = xwN[1]; restC = restN; slotC = slotB; slotB = slotN2;
#pragma unroll
        for (int k = 0; k < 4; ++k) { wC[k][0] = wN[k][0]; wC[k][1] = wN[k][1]; eeC[k] = eeN[k]; slC[k] = slN[k]; }
    }
#undef FIN_SLOT
#undef FIN_ISSUE
#undef FIN_ACC
}

__global__ void __launch_bounds__(512, 2) mega_fwd(Args a) {
    extern __shared__ __attribute__((aligned(16))) uchar lds_raw[];
    LAS uchar* lds = (LAS uchar*)lds_raw;
    const int tid = threadIdx.x, lane = tid & 63, wid = __builtin_amdgcn_readfirstlane(tid >> 6), bid = blockIdx.x, G = gridDim.x;
    const int lo = a.ph_lo, hi = a.ph_hi;
    uchar* ws = a.ws;
#define IN(k) (lo <= (k) && (k) < hi)
#define SEAM(k) do { if (IN(k) && IN((k) + 1)) xcd_barrier(xbar); } while (0)
    if (tid < 2) ((volatile LAS unsigned*)(lds + (LDS_BYTES - 16)))[tid] = 0u;
    __syncthreads();
    XcdBarrier xbar = xcd_barrier_post((unsigned*)(ws + WS_BAR), (volatile LAS unsigned*)(lds + (LDS_BYTES - 16)));
    if (IN(0)) phase_prep(a, lds, bid, G, tid, wid, lane);
    SEAM(0);
    if (IN(1)) phase_norm(a, lds, bid, G, tid, wid, lane);
    SEAM(1);
    if (IN(2)) {
        {
            pg8::Gemm g{(const bf16_t*)(ws + WS_ACT), (const bf16_t*)(ws + WS_WIN), D, 0, nullptr};
            pg8::GroupOrder S; S.init(M / 256, NIN / 256, 1, G, bid);
            pg8::EpiInproj E{ws + WS_ZQ, nullptr, (_Float16*)(ws + WS_LF), (_Float16*)(ws + WS_LBW), (const float*)(ws + WS_LB), 0, T};
            pg8::gemm_phase<pg8::EpiInproj, false>(lds, g, S, E);
        }
    }
    SEAM(2);
    if (IN(3)) {
        unsigned* cnt = (unsigned*)(ws + WS_BAR + 14336);
        if (bid >= 192 && bid < 240) {
            pg8::Gemm g{(const bf16_t*)(ws + WS_HC), (const bf16_t*)(ws + WS_WIN) + (size_t)512 * D, D, 0, nullptr};
            pg8::GroupOrder S; S.init(MC / 256, 1536 / 256, 1, 48, bid - 192);
            pg8::EpiInproj E{nullptr, (bf16_t*)(ws + WS_CI), (_Float16*)(ws + WS_CLF), (_Float16*)(ws + WS_CLB), (const float*)(ws + WS_LB), 1, CT};
            pg8::gemm_phase<pg8::EpiInproj, false>(lds, g, S, E);
            pg8::Unit u; S.next(0, u);
            asm volatile("s_waitcnt vmcnt(0)" ::: "memory"); __syncthreads();
            if (tid == 0) { __builtin_amdgcn_fence(__ATOMIC_RELEASE, "agent"); asm volatile("s_waitcnt vmcnt(0)" ::: "memory");
                __hip_atomic_fetch_add(cnt + 64 * u.pm, 1u, __ATOMIC_RELAXED, __HIP_MEMORY_SCOPE_AGENT); }
        }
        if (bid >= 192) {
            const int b = (bid - 192) >> 3;
            if (tid == 0) { unsigned sp = 0; while (__hip_atomic_load(cnt + 64 * b, __ATOMIC_RELAXED, __HIP_MEMORY_SCOPE_AGENT) < 6u && ++sp < (1u << 22)) __builtin_amdgcn_s_sleep(2);
                __builtin_amdgcn_fence(__ATOMIC_ACQUIRE, "agent"); asm volatile("s_waitcnt vmcnt(0)" ::: "memory"); }
            __syncthreads();
        }
        phase_gla_states(a, lds, bid, wid, lane);
    }
    SEAM(3);
    if (IN(4)) phase_gla_out(a, lds, bid, wid, lane);
    SEAM(4);
    if (IN(5)) phase_mixfin(a, bid, G, wid, lane);
    SEAM(5);
    if (IN(6)) {
        pg8::Gemm g{(const bf16_t*)(ws + WS_ACT), (const bf16_t*)(ws + WS_WOUT), D, 0, nullptr};
        pg8::GroupOrder S; S.init(M / 256, D / 256, 1, G, bid);
        pg8::EpiOut E{a.x, (bf16_t*)(ws + WS_X1B), (const float*)(ws + WS_MODF)};
        pg8::gemm_phase<pg8::EpiOut, false>(lds, g, S, E);
    }
    SEAM(6);
    if (IN(7)) phase_router(a, lds, bid, tid, wid, lane);
    SEAM(7);
    if (IN(8)) phase_topk_cvt(a, lds, bid, G, tid, wid, lane);
    SEAM(8);
    if (IN(9)) {
        pg8::Gemm g{(const bf16_t*)(ws + WS_ACT), (const bf16_t*)(ws + WS_WGU), D / 2, (size_t)4096 * D, (const int*)(ws + WS_SELTOK)};
        pg8::GroupOrder S; S.init(16, 16, NE, G, bid);
        pg8::EpiMoe1 E{ws + WS_HID};
        pg8::gemm_phase<pg8::EpiMoe1, true, pg8::GroupOrder, true>(lds, g, S, E);
    }
    SEAM(9);
    if (IN(10)) {
        pg8::Gemm g{(const bf16_t*)(ws + WS_HID), (const bf16_t*)(ws + WS_WDN), DFF / 2, (size_t)D * DFF, nullptr};
        pg8::Moe2Order S{bid};
        LAS float* lg = (LAS float*)(lds + pg8::STAGE_BYTES);
        { pg8::Unit tu; for (int uu = 0; uu < 4 && S.next(uu, tu); ++uu) if (tid < 256) lg[uu * 256 + tid] = ((const float*)(ws + WS_SELGATE))[tu.pm * 256 + tid]; }
        __syncthreads();
        pg8::EpiMoe2 E{ws + WS_YS, lg};
        pg8::gemm_phase<pg8::EpiMoe2, false, pg8::Moe2Order, true>(lds, g, S, E);
    }
    SEAM(10);
    if (IN(11)) phase_final(a, bid, G, wid, lane);

#undef IN
#undef SEAM
}

#ifndef N_LAUNCHES
#define N_LAUNCHES 1
#endif
extern "C" void kernel_launch(void* const* d_in, const int* in_sizes, int n_in, void* d_out, int out_size, void* d_ws, size_t ws_size, hipStream_t stream) {
    static int grid = 0;
    if (grid == 0) {
        if (n_in != 18 || out_size != M * D || ws_size < WS_END) { fprintf(stderr, "kernel_launch: unexpected shapes (n_in %d out %d ws %zu)\n", n_in, out_size, ws_size); grid = -1; return; }
        int dev = 0, cus = 0, per_cu = 0;
        (void)hipGetDevice(&dev); (void)hipDeviceGetAttribute(&cus, hipDeviceAttributeMultiprocessorCount, dev);
        (void)hipFuncSetAttribute((const void*)mega_fwd, hipFuncAttributeMaxDynamicSharedMemorySize, LDS_BYTES);
        (void)hipOccupancyMaxActiveBlocksPerMultiprocessor(&per_cu, (const void*)mega_fwd, 512, LDS_BYTES);
        if (per_cu < 1) { fprintf(stderr, "kernel_launch: occupancy query says %d blocks per CU\n", per_cu); grid = -1; return; }
        grid = 256;
        if (cus != 256) fprintf(stderr, "kernel_launch: note: %d CUs (built for 256)\n", cus);
    }
    if (grid < 0) return;
    Args a{};
    a.x = (const float*)d_in[0]; a.c = (const float*)d_in[1]; a.ctx = (const float*)d_in[2]; a.c_ctx = (const float*)d_in[3]; a.w_ada = (const float*)d_in[4]; a.b_ada = (const float*)d_in[5];
    a.norm_mix = (const float*)d_in[6]; a.norm_ffn = (const float*)d_in[7]; a.w_in = (const float*)d_in[8]; a.lb_logits = (const float*)d_in[9]; a.hg_norm = (const float*)d_in[10];
    a.conv_w = (const float*)d_in[11]; a.w_out = (const float*)d_in[12]; a.w_router = (const float*)d_in[13]; a.w_gate = (const float*)d_in[14]; a.w_up = (const float*)d_in[15];
    a.w_down = (const float*)d_in[16]; a.norm_final = (const float*)d_in[17]; a.out = (float*)d_out; a.ws = (uchar*)d_ws;
    if (N_LAUNCHES == 1) {
        (void)hipMemsetAsync((char*)d_ws + WS_BAR, 0, 16384, stream);
        a.ph_lo = 0; a.ph_hi = NPHASE;
        hipLaunchKernelGGL(mega_fwd, dim3(grid), dim3(512), LDS_BYTES, stream, a);
    } else {
        for (int p = 0; p < NPHASE; ++p) { a.ph_lo = p; a.ph_hi = p + 1; void* args[] = {&a};
            hipError_t e = hipLaunchCooperativeKernel((const void*)mega_fwd, dim3(grid), dim3(512), args, LDS_BYTES, stream);
            if (e != hipSuccess) { fprintf(stderr, "launch %d failed: %s\n", p, hipGetErrorString(e)); break; } }
    }
}
```

```cpp
#include <hip/hip_runtime.h>
#include <cstdio>

#define LAS __attribute__((address_space(3)))
#define GAS __attribute__((address_space(1)))
typedef unsigned short bf16_t;
typedef short bf16x8 __attribute__((ext_vector_type(8)));
typedef float f32x4 __attribute__((ext_vector_type(4)));
typedef float f32x2 __attribute__((ext_vector_type(2)));
typedef unsigned u32x4 __attribute__((ext_vector_type(4)));
typedef unsigned u32x2 __attribute__((ext_vector_type(2)));
typedef unsigned char uchar;
typedef int i32x8 __attribute__((ext_vector_type(8)));
typedef int i32x4 __attribute__((ext_vector_type(4)));

constexpr int D = 1024, NB = 8, T = 4096, M = NB * T, CT = 256, MC = NB * CT;
constexpr int NIN = 4096, HK = 512, NH = 4, NE = 16, CAP = 512, DFF = 2048, NMOD = 6 * D;
constexpr float EPS = 1e-6f;
constexpr int NPHASE = 12;

constexpr size_t MiB = 1u << 20;
constexpr size_t WS_ACT = 0;
constexpr size_t WS_WIN = 64 * MiB;
constexpr size_t WS_WOUT = 72 * MiB;
constexpr size_t WS_MODP = 74 * MiB;
constexpr size_t WS_MODF = 76 * MiB;
constexpr size_t WS_LB = 76 * MiB + 512 * 1024;
constexpr size_t WS_HC = 77 * MiB;
constexpr size_t WS_CLF = 81 * MiB;
constexpr size_t WS_CLB = 85 * MiB;
constexpr size_t WS_CI = 89 * MiB;
constexpr size_t WS_S0 = 91 * MiB;
constexpr size_t WS_AFF = 95 * MiB;
constexpr size_t WS_SELTOK = 97 * MiB;
constexpr size_t WS_SELGATE = 97 * MiB + 256 * 1024;
constexpr size_t WS_POS = 98 * MiB;
constexpr size_t WS_BAR = 100 * MiB;
constexpr size_t WS_SL = 488 * MiB;
constexpr size_t WS_DL = 500 * MiB;
constexpr size_t WS_ZQ = 104 * MiB;
constexpr size_t WS_LF = 136 * MiB;
constexpr size_t WS_LBW = 200 * MiB;
constexpr size_t WS_ZI = 264 * MiB;
constexpr size_t WS_ZG = 296 * MiB;
constexpr size_t WS_ZGB = 328 * MiB;
constexpr size_t WS_ZGC = 360 * MiB;
constexpr size_t WS_ZV = 392 * MiB;
constexpr size_t WS_OF = 424 * MiB;
constexpr size_t WS_OB = 456 * MiB;
constexpr size_t WS_WGU = 104 * MiB;
constexpr size_t WS_WDN = 232 * MiB;
constexpr size_t WS_HID = 296 * MiB;
constexpr size_t WS_YS = WS_WGU;
constexpr size_t WS_X1B = 424 * MiB;
constexpr size_t WS_END = 552 * MiB;
static_assert(WS_ZI == WS_ZQ + 160 * MiB && WS_ZG == WS_ZI + 32 * MiB && WS_ZGB == WS_ZG + 32 * MiB && WS_ZGC == WS_ZGB + 32 * MiB && WS_ZV == WS_ZGC + 32 * MiB, "z segment map");

constexpr int LDS_BYTES = 147456;

typedef __bf16 bf16x2_t __attribute__((ext_vector_type(2)));
__device__ __forceinline__ unsigned cvt_pk_bf16_safe(float lo, float hi) { typedef float f2_t __attribute__((ext_vector_type(2))); const bf16x2_t v = __builtin_convertvector((f2_t){lo, hi}, bf16x2_t); return __builtin_bit_cast(unsigned, v); }
__device__ __forceinline__ unsigned cvt_pk_bf16(float lo, float hi) { unsigned r; asm volatile("v_cvt_pk_bf16_f32 %0, %1, %2" : "=v"(r) : "v"(lo), "v"(hi)); return r; }
__device__ __forceinline__ unsigned cvt_pk4_fp8(float a, float b, float c, float d) { unsigned r = 0u; asm volatile("v_cvt_pk_fp8_f32 %0, %1, %2\n\tv_cvt_pk_fp8_f32 %0, %3, %4 op_sel:[0,0,1]" : "+v"(r) : "v"(a), "v"(b), "v"(c), "v"(d)); return r; }
__device__ __forceinline__ void st_wt8(void* p, u32x2 v) { asm volatile("global_store_dwordx2 %0, %1, off sc1\n\ts_nop 2" :: "v"(p), "v"(v) : "memory"); }
__device__ __forceinline__ void st_wt4(void* p, unsigned v) { asm volatile("global_store_dword %0, %1, off sc1\n\ts_nop 2" :: "v"(p), "v"(v) : "memory"); }
__device__ __forceinline__ void st_wt16(void* p, u32x4 v) { asm volatile("global_store_dwordx4 %0, %1, off sc1\n\ts_nop 2" :: "v"(p), "v"(v) : "memory"); }
__device__ __forceinline__ float bf_lo(unsigned u) { return __uint_as_float(u << 16); }
__device__ __forceinline__ float bf_hi(unsigned u) { return __uint_as_float(u & 0xffff0000u); }
__device__ __forceinline__ float wave_sum(float v) {
#pragma unroll
    for (int o = 1; o < 64; o <<= 1) v += __shfl_xor(v, o);
    return v;
}
__device__ __forceinline__ float silu_f(float x) { return x * __builtin_amdgcn_rcpf(1.f + __builtin_amdgcn_exp2f(x * -1.44269504f)); }
#define LDS_WAIT() asm volatile("s_waitcnt lgkmcnt(0)" ::: "memory")


#define XB_TMO      128
#define XB_XCNT(j)  (256  + 64 * (j))
#define XB_XSUB(j)  (1280 + 64 * (j))
#define XB_XGEN(j)  (2304 + 64 * (j))
#define XB_TOP      3328
#define XB_TOPGEN   3392
#define XCD_BAR_WORDS 3456
#define XB_SPIN_CAP (1u << 20)
__device__ __forceinline__ unsigned xb_ld(unsigned* p)              { return __hip_atomic_load(p, __ATOMIC_RELAXED, __HIP_MEMORY_SCOPE_AGENT); }
__device__ __forceinline__ unsigned xb_add(unsigned* p, unsigned v) { return __hip_atomic_fetch_add(p, v, __ATOMIC_RELAXED, __HIP_MEMORY_SCOPE_AGENT); }
__device__ __forceinline__ unsigned xb_xcc_id() { return (unsigned)__builtin_amdgcn_s_getreg((3 << 11) | 20) & 0xFu; }
#define XB_SPIN(cond, bar) do { unsigned _sp = 0; while (cond) { __builtin_amdgcn_s_sleep(1); \
    if ((++_sp & 255u) == 0u) { if (xb_ld(&(bar)[XB_TMO])) break; if (_sp > XB_SPIN_CAP) { atomicAdd(&(bar)[XB_TMO], 1u); break; } } } } while (0)
struct XcdBarrier { unsigned* bar; unsigned x; volatile LAS unsigned* st; };
__device__ __forceinline__ XcdBarrier xcd_barrier_post(unsigned* bar, volatile LAS unsigned* st) {
    XcdBarrier b; b.bar = bar; b.x = xb_xcc_id(); b.st = st;
    if (threadIdx.x == 0) (void)xb_add(&bar[XB_XCNT(b.x)], 1u);
    return b;
}
__device__ __forceinline__ void xcd_barrier_complete(unsigned* bar, unsigned x, unsigned& nloc, unsigned& nx) {
    const unsigned G = gridDim.x * gridDim.y * gridDim.z;
    unsigned sum, cnt, mine, sp = 0u;
    for (;;) {
        sum = 0u; cnt = 0u; mine = 0u;
#pragma unroll
        for (unsigned j = 0; j < 16; ++j) { const unsigned c = xb_ld(&bar[XB_XCNT(j)]); sum += c; cnt += (c > 0u) ? 1u : 0u; mine = (j == x) ? c : mine; }
        if (sum == G) break;
        __builtin_amdgcn_s_sleep(1);
        if ((++sp & 255u) == 0u) { if (xb_ld(&bar[XB_TMO])) break; if (sp > XB_SPIN_CAP) { atomicAdd(&bar[XB_TMO], 1u); break; } }
    }
    nloc = mine > 0u ? mine : 1u; nx = cnt > 0u ? cnt : 1u;
}
template <bool REL = true>
__device__ __forceinline__ void xcd_barrier(const XcdBarrier& b) {
    asm volatile("s_waitcnt vmcnt(0)" ::: "memory");
    __syncthreads();
    if (threadIdx.x == 0) {
        unsigned* bar = b.bar;
        __builtin_amdgcn_s_waitcnt(0);
        unsigned nloc = b.st[0], nx = b.st[1];
        if (nloc == 0u) { xcd_barrier_complete(bar, b.x, nloc, nx); b.st[0] = nloc; b.st[1] = nx; }
        const unsigned old = xb_add(&bar[XB_XSUB(b.x)], 1u);
        const unsigned gen = old / nloc;
        if (old + 1u == (gen + 1u) * nloc) {
            if (REL) __builtin_amdgcn_fence(__ATOMIC_RELEASE, "agent");
            asm volatile("buffer_inv sc1" ::: "memory");
            asm volatile("s_waitcnt vmcnt(0)" ::: "memory");
            const unsigned og = xb_add(&bar[XB_TOP], 1u);
            const unsigned tg = og / nx;
            if (og + 1u == (tg + 1u) * nx) xb_add(&bar[XB_TOPGEN], 1u);
            else XB_SPIN(xb_ld(&bar[XB_TOPGEN]) == tg, bar);
            asm volatile("" ::: "memory");
            asm volatile("s_waitcnt vmcnt(0)" ::: "memory");
        } else {
            asm volatile("buffer_inv sc1" ::: "memory");
            XB_SPIN(xb_ld(&bar[XB_TOPGEN]) == gen, bar);
            asm volatile("" ::: "memory");
            asm volatile("s_waitcnt vmcnt(0)" ::: "memory");
        }
    }
    __syncthreads();
}

namespace pg8 {
constexpr int BM = 256, BK = 64, HALF = 128, HTB = HALF * BK * 2, STAGE_BYTES = 8 * HTB, NXCD = 8, WGM = 8;
__device__ __forceinline__ int lds_byte(int r, int c) { const int st = (r >> 4) * 2 + (c >> 5), rr = r & 15, cc = c & 31, ob = rr * 64 + cc * 2; return st * 1024 + (ob ^ (((ob >> 9) & 1) << 5)); }
__device__ __forceinline__ void stage_rc(int b, int& R, int& C) { const int st = b / 1024, sb = b % 1024, swz = sb ^ (((sb >> 9) & 1) << 5); R = (st >> 1) * 16 + swz / 64; C = (st & 1) * 32 + (swz % 64) / 2; }
__device__ __forceinline__ int perm32(int rho) { const int n = rho >> 4, i = rho & 15; return 8 * (i >> 2) + 4 * n + (i & 3); }

struct Unit { int pm, pn, e; };
struct GroupOrder {
    int nM, nN, ng, G, c;
    __device__ __forceinline__ void init(int nM_, int nN_, int ng_, int G_, int c_) { nM = nM_; nN = nN_; ng = ng_; G = G_; c = c_; }
    __device__ __forceinline__ bool next(int i, Unit& u) const {
        const int nwg = nM * nN; const long L = (long)i * G + c; if (L >= (long)nwg * ng) return false;
        const int grp = (int)(L / nwg); int wgid = (int)(L % nwg);
        { const int q = nwg / NXCD, r = nwg % NXCD, xcd = wgid % NXCD, off = wgid / NXCD; wgid = (xcd < r ? xcd * (q + 1) : r * (q + 1) + (xcd - r) * q) + off; }
        const int nig = WGM * nN, gid = wgid / nig, fm = gid * WGM, gsz = (nM - fm) < WGM ? (nM - fm) : WGM;
        u.pm = grp * nM + fm + ((wgid % nig) % gsz); u.pn = (wgid % nig) / gsz; u.e = grp; return true;
    }
};
struct Moe2Order {
    int c;
    __device__ __forceinline__ bool next(int i, Unit& u) const { if (i >= 4) return false; const int x = c & 7, j = c >> 3; u.e = 4 * i + (x >> 1); u.pm = u.e * 16 + (x & 1) * 8 + (j >> 2); u.pn = j & 3; return true; }
};
struct Moe1Order {
    int c;
    __device__ __forceinline__ bool next(int i, Unit& u) const { if (i >= 16) return false; const int x = c & 7, j = c >> 3, s = i & 7; u.e = 2 * x + (i >> 3); u.pm = u.e * 16 + (s >> 2) * 8 + (j & 7); u.pn = (s & 3) * 4 + (j >> 3); return true; }
};
struct Gemm { const bf16_t* A; const bf16_t* Bt; int K; size_t bgs; const int* rowidx; };

template <class Epi, bool GATHER, class Sched = GroupOrder, bool FP8 = false>
__device__ __forceinline__ void gemm_phase(LAS uchar* lds, const Gemm g, const Sched& S, const Epi& E) {
    const int tid = threadIdx.x, wid = __builtin_amdgcn_readfirstlane(tid >> 6), lane = tid & 63, wr = wid >> 2, wc = wid & 3, fr = lane & 15, fq = lane >> 4;
    const int K = g.K, nt = K / BK;
    unsigned voffA[2], voffB[2]; int Rr[2], Cc[2];
#pragma unroll
    for (int i = 0; i < 2; ++i) { int R, C; stage_rc(tid * 16 + i * 8192, R, C); const int Rb = Epi::PERM16 ? (64 * (R >> 5) + 16 * ((R & 15) >> 2) + 4 * ((R >> 4) & 1) + (R & 3)) : (Epi::PERM ? ((R & ~31) + perm32(R & 31)) : R); Rr[i] = R; Cc[i] = C;
        voffA[i] = (unsigned)(R * K + C) * 2u; voffB[i] = (unsigned)(Rb * K + C) * 2u; }
    const size_t kstep = (size_t)(BK * 2);
    const size_t hstep = (size_t)HALF * K * 2;
    const size_t tstep = 2 * hstep;
    const size_t hstepB = Epi::PERM16 ? (size_t)8 * K * 2 : hstep;
    const unsigned ldsw = (unsigned)wid * 1024u;
    const int aoff = lds_byte(wr * 64 + fr, fq * 8), boff = lds_byte(wc * 32 + fr, fq * 8);
#define PG8_SA(b, h) (((b) * 2 + (h)) * HTB)
#define PG8_SB(b, h) ((4 + (b) * 2 + (h)) * HTB)
#define PG8_STAGE(bufoff, gbase, voff) do { _Pragma("unroll") for (int _i = 0; _i < 2; ++_i) \
        __builtin_amdgcn_global_load_lds((const unsigned*)((const char*)(gbase) + (voff)[_i]), (LAS unsigned*)(lds + (bufoff) + ldsw + _i * 8192), 16, 0, 0); } while (0)
#define PG8_STAGE_A(bufoff, p, ofs, h) do { if constexpr (GATHER) { PG8_STAGE(bufoff, p, (ofs)[h]); } else { PG8_STAGE(bufoff, (p) + (h) * hstep, voffA); } } while (0)
#define PG8_LD8(p) __builtin_shufflevector(*(const LAS i32x4*)(p), *(const LAS i32x4*)((p) + 1024), 0, 1, 2, 3, 4, 5, 6, 7)
#define PG8_LDA(dst, b, h) do { _Pragma("unroll") for (int m = 0; m < 4; ++m) dst[m] = PG8_LD8(lds + PG8_SA(b, h) + aoff + m * 2048); } while (0)
#define PG8_LDB(dst, b, h) do { _Pragma("unroll") for (int n = 0; n < 2; ++n) dst[n] = PG8_LD8(lds + PG8_SB(b, h) + boff + n * 2048); } while (0)
#define PG8_HALF(x, k) __builtin_bit_cast(bf16x8, (k) ? __builtin_shufflevector(x, x, 4, 5, 6, 7) : __builtin_shufflevector(x, x, 0, 1, 2, 3))
#define PG8_MMA(ai, bj, At, Bt) do { __builtin_amdgcn_s_setprio(1); _Pragma("unroll") for (int m = 0; m < 4; ++m) _Pragma("unroll") for (int n = 0; n < 2; ++n) { \
        if constexpr (FP8) acc[ai][bj][m][n] = __builtin_amdgcn_mfma_scale_f32_16x16x128_f8f6f4(Bt[n], At[m], acc[ai][bj][m][n], 0, 0, 0, 0x7a7a7a7a, 0, 0x7f7f7f7f);   \
        else { acc[ai][bj][m][n] = __builtin_amdgcn_mfma_f32_16x16x32_bf16(PG8_HALF(Bt[n], 0), PG8_HALF(At[m], 0), acc[ai][bj][m][n], 0, 0, 0); \
               acc[ai][bj][m][n] = __builtin_amdgcn_mfma_f32_16x16x32_bf16(PG8_HALF(Bt[n], 1), PG8_HALF(At[m], 1), acc[ai][bj][m][n], 0, 0, 0); } } \
        if constexpr (FP8) { _Pragma("unroll") for (int m = 0; m < 4; ++m) _Pragma("unroll") for (int n = 0; n < 2; ++n) asm volatile("" : "+v"(acc[ai][bj][m][n])); }     \
        __builtin_amdgcn_s_setprio(0); } while (0)
#define PG8_WAIT_V(n) asm volatile("s_waitcnt vmcnt(" #n ")" ::: "memory")
#define PG8_WAIT_L(n) asm volatile("s_waitcnt lgkmcnt(" #n ")" ::: "memory")
#define PG8_BAR __builtin_amdgcn_s_barrier()
#define PG8_SCHED __builtin_amdgcn_sched_barrier(0)
    Unit cur, nxt; int ui = 0;
    if (!S.next(0, cur)) return;
    f32x4 acc[2][2][4][2];
#pragma unroll
    for (int a = 0; a < 2; ++a)
#pragma unroll
        for (int b = 0; b < 2; ++b)
#pragma unroll
            for (int m = 0; m < 4; ++m)
#pragma unroll
                for (int n = 0; n < 2; ++n) acc[a][b][m][n] = (f32x4){0.f, 0.f, 0.f, 0.f};
    i32x8 At[4], B0[2], B1[2];
    unsigned cofs[2][2], nofs[2][2];
    LAS unsigned short* ridx = (LAS unsigned short*)(lds + STAGE_BYTES);
    if constexpr (GATHER) {
        { int rv[16];
#pragma unroll
          for (int uu = 0; uu < 16; ++uu) { Unit tu; const bool ok = S.next(uu, tu); rv[uu] = (ok && tid < BM) ? g.rowidx[tu.pm * BM + tid] : 0; }
#pragma unroll
          for (int uu = 0; uu < 16; ++uu) if (tid < BM) ridx[uu * BM + tid] = (unsigned short)rv[uu]; }
        asm volatile("s_waitcnt vmcnt(0) lgkmcnt(0)" ::: "memory"); __builtin_amdgcn_s_barrier(); asm volatile("" ::: "memory");
#pragma unroll
        for (int h = 0; h < 2; ++h)
#pragma unroll
            for (int i = 0; i < 2; ++i) { const int row = ridx[h * HALF + Rr[i]]; cofs[h][i] = (unsigned)(row * K + Cc[i]) * 2u; nofs[h][i] = cofs[h][i]; }
    }
    const char* cA = GATHER ? (const char*)g.A : (const char*)g.A + (size_t)cur.pm * tstep;
    const char* cB = (const char*)g.Bt + (size_t)cur.e * g.bgs + (size_t)cur.pn * tstep;
    PG8_STAGE(PG8_SB(0, 0), cB, voffB); PG8_STAGE(PG8_SB(0, 1), cB + hstepB, voffB); PG8_STAGE_A(PG8_SA(0, 0), cA, cofs, 0); PG8_STAGE_A(PG8_SA(0, 1), cA, cofs, 1);
    if (wr == 1) PG8_BAR;
    PG8_WAIT_V(2); PG8_BAR;
    PG8_STAGE(PG8_SB(1, 0), cB + kstep, voffB); PG8_STAGE_A(PG8_SA(1, 0), cA + kstep, cofs, 0); PG8_STAGE(PG8_SB(1, 1), cB + hstepB + kstep, voffB);
    PG8_WAIT_V(6); PG8_BAR;
    for (;;) {
        const bool has_next = S.next(ui + 1, nxt);
        const char* nA = GATHER ? (const char*)g.A : (has_next ? (const char*)g.A + (size_t)nxt.pm * tstep : cA);
        const char* nB = has_next ? (const char*)g.Bt + (size_t)nxt.e * g.bgs + (size_t)nxt.pn * tstep : cB;
#pragma unroll 1
        for (int t = 0; t < nt; t += 2) {
            const bool last = (t == nt - 2);
            const char* a1 = cA + (size_t)(t + 1) * kstep;
            const char* a2 = last ? nA : cA + (size_t)(t + 2) * kstep; const char* b2 = last ? nB : cB + (size_t)(t + 2) * kstep;
            const char* a3 = a2 + kstep; const char* b3 = b2 + kstep;
            if constexpr (GATHER) {
                if (last && has_next) {
#pragma unroll
                    for (int h = 0; h < 2; ++h)
#pragma unroll
                        for (int i = 0; i < 2; ++i) { const int row = ridx[(ui + 1) * BM + h * HALF + Rr[i]]; nofs[h][i] = (unsigned)(row * K + Cc[i]) * 2u; }
                }
            }
            PG8_LDB(B0, 0, 0); PG8_LDB(B1, 0, 1); PG8_SCHED; PG8_LDA(At, 0, 0); PG8_STAGE_A(PG8_SA(1, 1), a1, cofs, 1);
            PG8_WAIT_V(8); PG8_WAIT_L(0); PG8_BAR; PG8_MMA(0, 0, At, B0); PG8_MMA(0, 1, At, B1); PG8_BAR; PG8_SCHED;
            PG8_LDA(At, 0, 1); PG8_STAGE(PG8_SB(0, 0), b2, voffB); PG8_STAGE(PG8_SB(0, 1), b2 + hstepB, voffB);
            if (last) { PG8_STAGE_A(PG8_SA(0, 0), a2, nofs, 0); } else { PG8_STAGE_A(PG8_SA(0, 0), a2, cofs, 0); }
            PG8_WAIT_V(8); PG8_WAIT_L(0); PG8_BAR; PG8_MMA(1, 0, At, B0); PG8_MMA(1, 1, At, B1); PG8_BAR; PG8_SCHED;
            PG8_LDB(B0, 1, 0); PG8_LDB(B1, 1, 1); PG8_SCHED; PG8_LDA(At, 1, 0);
            if (last) { PG8_STAGE_A(PG8_SA(0, 1), a2, nofs, 1); } else { PG8_STAGE_A(PG8_SA(0, 1), a2, cofs, 1); }
            PG8_WAIT_V(8); PG8_WAIT_L(0); PG8_BAR; PG8_MMA(0, 0, At, B0); PG8_MMA(0, 1, At, B1); PG8_BAR; PG8_SCHED;
            PG8_LDA(At, 1, 1); PG8_STAGE(PG8_SB(1, 0), b3, voffB); PG8_STAGE(PG8_SB(1, 1), b3 + hstepB, voffB);
            if (last) { PG8_STAGE_A(PG8_SA(1, 0), a3, nofs, 0); } else { PG8_STAGE_A(PG8_SA(1, 0), a3, cofs, 0); }
            PG8_WAIT_V(8); PG8_WAIT_L(0); PG8_BAR; PG8_MMA(1, 0, At, B0); PG8_MMA(1, 1, At, B1); PG8_BAR; PG8_SCHED;
        }
        if (wr == 0) PG8_BAR;
        E(acc, cur, wr, wc, fr, fq);
        if (!has_next) break;
#pragma unroll
        for (int a = 0; a < 2; ++a)
#pragma unroll
            for (int b = 0; b < 2; ++b)
#pragma unroll
                for (int m = 0; m < 4; ++m)
#pragma unroll
                    for (int n = 0; n < 2; ++n) { f32x2 z0, z1; asm volatile("v_mov_b64 %0, 0" : "=v"(z0)); asm volatile("v_mov_b64 %0, 0" : "=v"(z1)); acc[a][b][m][n] = __builtin_shufflevector(z0, z1, 0, 1, 2, 3); }
        cur = nxt; cA = nA; cB = nB; ++ui;
        if constexpr (GATHER) {
#pragma unroll
            for (int h = 0; h < 2; ++h)
#pragma unroll
                for (int i = 0; i < 2; ++i) cofs[h][i] = nofs[h][i];
        }
        if (wr == 1) PG8_BAR;
    }
    PG8_WAIT_V(0);
    PG8_BAR;
#undef PG8_SA
#undef PG8_SB
#undef PG8_STAGE
#undef PG8_STAGE_A
#undef PG8_LD8
#undef PG8_HALF
#undef PG8_LDA
#undef PG8_LDB
#undef PG8_MMA
#undef PG8_WAIT_V
#undef PG8_WAIT_L
#undef PG8_BAR
#undef PG8_SCHED
}


struct EpiInproj {
    static constexpr bool PERM = true, PERM16 = false;
    uchar* zbase; bf16_t* ci; _Float16* olog0; _Float16* olog1; const float* lb; int seg0; int Tn;
    __device__ __forceinline__ void operator()(const f32x4 (&acc)[2][2][4][2], const Unit& u, int wr, int wc, int fr, int fq) const {
        const int seg = seg0 + (u.pn >> 1);
        const int row0 = u.pm * BM + wr * 64 + fr;
        if (seg <= 3) {
            const int b = (u.pm * BM) / Tn, t0 = row0 - b * Tn, dcol = wc * 32 + 8 * fq;
#pragma unroll
            for (int bj = 0; bj < 2; ++bj) { const int hh = (u.pn & 1) * 2 + bj; const size_t plane = (size_t)(b * NH + hh) * Tn;
                if (seg == 1 || seg == 2) {
                    _Float16* O = (seg == 1) ? olog0 : olog1; const float* lbp = lb + (seg - 1) * 512 + hh * 128 + dcol;
                    const f32x4 l0 = *(const f32x4*)lbp, l1 = *(const f32x4*)(lbp + 4);
#pragma unroll
                    for (int ai = 0; ai < 2; ++ai)
#pragma unroll
                        for (int m = 0; m < 4; ++m) { const f32x4 v0 = acc[ai][bj][m][0], v1 = acc[ai][bj][m][1]; _Float16 o[8];
#pragma unroll
                            for (int j = 0; j < 4; ++j) { const float s0 = __builtin_amdgcn_rcpf(1.f + __builtin_amdgcn_exp2f(v0[j] * -1.44269504f)), s1 = __builtin_amdgcn_rcpf(1.f + __builtin_amdgcn_exp2f(v1[j] * -1.44269504f));
                                o[j] = (_Float16)__builtin_amdgcn_logf(l0[j] + (1.f - l0[j]) * s0); o[4 + j] = (_Float16)__builtin_amdgcn_logf(l1[j] + (1.f - l1[j]) * s1); }
                            st_wt16(O + (plane + t0 + ai * HALF + m * 16) * 128 + dcol, __builtin_bit_cast(u32x4, o)); }
                } else {
                    bf16_t* O = zbase ? (bf16_t*)(zbase + (size_t)(seg == 0 ? 0 : 160) * MiB) : ci;
#pragma unroll
                    for (int ai = 0; ai < 2; ++ai)
#pragma unroll
                        for (int m = 0; m < 4; ++m) { const f32x4 v0 = acc[ai][bj][m][0], v1 = acc[ai][bj][m][1];
                            u32x4 w; w.x = cvt_pk_bf16(v0[0], v0[1]); w.y = cvt_pk_bf16(v0[2], v0[3]); w.z = cvt_pk_bf16(v1[0], v1[1]); w.w = cvt_pk_bf16(v1[2], v1[3]);
                            st_wt16(O + (plane + t0 + ai * HALF + m * 16) * 128 + dcol, w); }
                }
            }
        } else if (seg >= 6) {
            const int col0 = (u.pn - 12) * 128 + wc * 32 + 8 * fq;
            bf16_t* O = (bf16_t*)(zbase + (size_t)(32 * 6 + 64) * MiB);
#pragma unroll
            for (int ai = 0; ai < 2; ++ai)
#pragma unroll
                for (int m = 0; m < 4; ++m) { const f32x4 v0 = acc[ai][0][m][0] * acc[ai][1][m][0], v1 = acc[ai][0][m][1] * acc[ai][1][m][1];
                    u32x4 w; w.x = cvt_pk_bf16(v0[0], v0[1]); w.y = cvt_pk_bf16(v0[2], v0[3]); w.z = cvt_pk_bf16(v1[0], v1[1]); w.w = cvt_pk_bf16(v1[2], v1[3]);
                    st_wt16(O + (size_t)(row0 + ai * HALF + m * 16) * 512 + col0, w); }
        } else {
            const int col0 = (u.pn & 1) * 256 + wc * 32 + 8 * fq;
            bf16_t* O = (bf16_t*)(zbase + (size_t)(32 * seg + 64) * MiB);
#pragma unroll
            for (int ai = 0; ai < 2; ++ai)
#pragma unroll
                for (int m = 0; m < 4; ++m) { bf16_t* rowp = O + (size_t)(row0 + ai * HALF + m * 16) * 512 + col0;
#pragma unroll
                    for (int bj = 0; bj < 2; ++bj) { const f32x4 v0 = acc[ai][bj][m][0], v1 = acc[ai][bj][m][1];
                        u32x4 w; w.x = cvt_pk_bf16(v0[0], v0[1]); w.y = cvt_pk_bf16(v0[2], v0[3]); w.z = cvt_pk_bf16(v1[0], v1[1]); w.w = cvt_pk_bf16(v1[2], v1[3]);
                        st_wt16(rowp + bj * HALF, w); } }
        }
    }
};
struct EpiOut {
    static constexpr bool PERM = true, PERM16 = false;
    const float* x; bf16_t* x1; const float* modf;
    __device__ __forceinline__ void operator()(const f32x4 (&acc)[2][2][4][2], const Unit& u, int wr, int wc, int fr, int fq) const {
        const int row0 = u.pm * BM + wr * 64 + fr, col0 = u.pn * BM + wc * 32 + 8 * fq;
        const int b = (u.pm * BM) / T;
        const float* g1 = modf + (size_t)b * NMOD + 2 * D;
        f32x4 gv[2][2];
#pragma unroll
        for (int bj = 0; bj < 2; ++bj)
#pragma unroll
            for (int n = 0; n < 2; ++n) gv[bj][n] = *(const f32x4*)(g1 + col0 + bj * HALF + 4 * n);
#pragma unroll
        for (int ai = 0; ai < 2; ++ai)
#pragma unroll
            for (int m = 0; m < 4; ++m) { const size_t off = (size_t)(row0 + ai * HALF + m * 16) * D + col0;
#pragma unroll
                for (int bj = 0; bj < 2; ++bj) {
                    const f32x4 x0 = __builtin_nontemporal_load((const f32x4*)(x + off + bj * HALF)), x1v = __builtin_nontemporal_load((const f32x4*)(x + off + bj * HALF + 4));
                    const f32x4 v0 = x0 + gv[bj][0] * acc[ai][bj][m][0], v1 = x1v + gv[bj][1] * acc[ai][bj][m][1];
                    u32x4 w; w.x = cvt_pk_bf16(v0[0], v0[1]); w.y = cvt_pk_bf16(v0[2], v0[3]); w.z = cvt_pk_bf16(v1[0], v1[1]); w.w = cvt_pk_bf16(v1[2], v1[3]);
                    st_wt16(x1 + off + bj * HALF, w); }
                asm volatile("" ::: "memory"); }
    }
};
struct EpiMoe1 {
    static constexpr bool PERM = true, PERM16 = false;
    uchar* hid;
    __device__ __forceinline__ void operator()(const f32x4 (&acc)[2][2][4][2], const Unit& u, int wr, int wc, int fr, int fq) const {
        const int row0 = u.pm * BM + wr * 64 + fr, col0 = u.pn * 128 + wc * 32 + 8 * fq;
#pragma unroll
        for (int ai = 0; ai < 2; ++ai)
#pragma unroll
            for (int m = 0; m < 4; ++m) { uchar* rowp = hid + (size_t)(row0 + ai * HALF + m * 16) * DFF + col0;
                float o[8];
#pragma unroll
                for (int n = 0; n < 2; ++n)
#pragma unroll
                    for (int h = 0; h < 2; ++h) {
                        const f32x2 gt = h ? __builtin_shufflevector(acc[ai][0][m][n], acc[ai][0][m][n], 2, 3) : __builtin_shufflevector(acc[ai][0][m][n], acc[ai][0][m][n], 0, 1);
                        const f32x2 up = h ? __builtin_shufflevector(acc[ai][1][m][n], acc[ai][1][m][n], 2, 3) : __builtin_shufflevector(acc[ai][1][m][n], acc[ai][1][m][n], 0, 1);
                        const f32x2 tt = gt * -1.44269504f; const f32x2 dd = (f32x2){__builtin_amdgcn_exp2f(tt.x), __builtin_amdgcn_exp2f(tt.y)} + 1.f;
                        const f32x2 rr = (f32x2){__builtin_amdgcn_rcpf(dd.x), __builtin_amdgcn_rcpf(dd.y)}; const f32x2 oo = (gt * up) * rr; o[n * 4 + 2 * h] = oo.x; o[n * 4 + 2 * h + 1] = oo.y; }
                u32x2 w; w.x = cvt_pk4_fp8(o[0], o[1], o[2], o[3]); w.y = cvt_pk4_fp8(o[4], o[5], o[6], o[7]);
                __builtin_nontemporal_store(w, (u32x2*)rowp); }
    }
};
struct EpiMoe2 {
    static constexpr bool PERM = true, PERM16 = true;
    uchar* ys; const LAS float* lgate;
    __device__ __forceinline__ void operator()(const f32x4 (&acc)[2][2][4][2], const Unit& u, int wr, int wc, int fr, int fq) const {
        const int row0 = u.pm * BM + wr * 64 + fr, col0 = u.pn * BM + wc * 64 + 16 * fq;
        const LAS float* gt_ = lgate + (u.e >> 2) * BM + wr * 64 + fr;
#pragma unroll
        for (int ai = 0; ai < 2; ++ai)
#pragma unroll
            for (int m = 0; m < 4; ++m) { const int row = row0 + ai * HALF + m * 16; const float gt = gt_[ai * HALF + m * 16] * 16.f;
                const f32x4 v0 = acc[ai][0][m][0] * gt, v1 = acc[ai][0][m][1] * gt, v2 = acc[ai][1][m][0] * gt, v3 = acc[ai][1][m][1] * gt;
                u32x4 w; w.x = cvt_pk4_fp8(v0[0], v0[1], v0[2], v0[3]); w.y = cvt_pk4_fp8(v1[0], v1[1], v1[2], v1[3]); w.z = cvt_pk4_fp8(v2[0], v2[1], v2[2], v2[3]); w.w = cvt_pk4_fp8(v3[0], v3[1], v3[2], v3[3]);
                __builtin_nontemporal_store(w, (u32x4*)(ys + (size_t)row * D + col0)); }
    }
};
}

struct Args {
    const float *x, *c, *ctx, *c_ctx, *w_ada, *b_ada, *norm_mix, *norm_ffn, *w_in, *lb_logits, *hg_norm, *conv_w, *w_out, *w_router, *w_gate, *w_up, *w_down, *norm_final;
    float* out; uchar* ws; int ph_lo, ph_hi;
};

__device__ __forceinline__ void cvt_item(const float* W, int ldw, bf16_t* WT, int ldt, int k0, int n0, int nrow0, LAS float* scr, int lane) {
    const int r = lane >> 3, c4 = lane & 7;
    f32x4 v[8];
#pragma unroll
    for (int i = 0; i < 8; ++i) v[i] = __builtin_nontemporal_load((const f32x4*)(W + (size_t)(k0 + 8 * i + r) * ldw + n0 + 4 * c4));
#pragma unroll
    for (int i = 0; i < 8; ++i) { LAS float* d = scr + (8 * i + r) * 33 + 4 * c4; d[0] = v[i].x; d[1] = v[i].y; d[2] = v[i].z; d[3] = v[i].w; }
    LDS_WAIT(); asm volatile("" ::: "memory");
    const int c = lane & 7;
#pragma unroll
    for (int j = 0; j < 4; ++j) { const int n = (lane >> 3) + 8 * j; const LAS float* sp = scr + (8 * c) * 33 + n;
        u32x4 o; o.x = cvt_pk_bf16(sp[0 * 33], sp[1 * 33]); o.y = cvt_pk_bf16(sp[2 * 33], sp[3 * 33]); o.z = cvt_pk_bf16(sp[4 * 33], sp[5 * 33]); o.w = cvt_pk_bf16(sp[6 * 33], sp[7 * 33]);
        *(u32x4*)(WT + (size_t)(nrow0 + n) * ldt + k0 + 8 * c) = o; }
    LDS_WAIT(); asm volatile("" ::: "memory");
}

struct MoeCvt { const float* W; uchar* WT; int ldw, ldt, k0, n0, nrow0; };
__device__ __forceinline__ MoeCvt moe_cvt_desc(const Args& a, int id) {
    MoeCvt c;
    if (id < 32768) { const int e = id >> 11, up = (id >> 10) & 1, r = id & 1023, kb = r >> 6, nb = r & 63; c.n0 = nb * 32;
        c.W = (up ? a.w_up : a.w_gate) + (size_t)e * D * DFF; c.ldw = DFF; c.WT = a.ws + WS_WGU + (size_t)e * 4096 * D; c.ldt = D; c.k0 = kb * 64; c.nrow0 = (c.n0 >> 7) * 256 + (c.n0 & 127) + (up ? 128 : 0); }
    else { const int r0 = id - 32768, e = r0 >> 10, r = r0 & 1023, kb = r >> 5, nb = r & 31; c.n0 = nb * 32;
        c.W = a.w_down + (size_t)e * DFF * D; c.ldw = D; c.WT = a.ws + WS_WDN + (size_t)e * D * DFF; c.ldt = DFF; c.k0 = kb * 64; c.nrow0 = c.n0; }
    return c;
}
__device__ __forceinline__ void moe_cvt_issue(const MoeCvt& c, f32x4 (&v)[8], int lane) {
    const float* p = c.W + (size_t)(c.k0 + (lane >> 3)) * c.ldw + c.n0 + 4 * (lane & 7);
#pragma unroll
    for (int i = 0; i < 8; ++i) v[i] = __builtin_nontemporal_load((const f32x4*)(p + (size_t)(8 * i) * c.ldw));
}
__device__ __forceinline__ void moe_cvt_finish(const MoeCvt& c, const f32x4 (&v)[8], LAS float* scr, int lane) {
    const int r = lane >> 3, c4 = lane & 7;
#pragma unroll
    for (int i = 0; i < 8; ++i) { LAS float* d = scr + (8 * i + r) * 33 + 4 * c4; d[0] = v[i].x; d[1] = v[i].y; d[2] = v[i].z; d[3] = v[i].w; }
    LDS_WAIT(); asm volatile("" ::: "memory");
    const int cc = lane & 7;
#pragma unroll
    for (int j = 0; j < 4; ++j) { const int n = (lane >> 3) + 8 * j; const LAS float* sp = scr + (8 * cc) * 33 + n;
        u32x2 o; o.x = cvt_pk4_fp8(sp[0 * 33] * 32.f, sp[1 * 33] * 32.f, sp[2 * 33] * 32.f, sp[3 * 33] * 32.f); o.y = cvt_pk4_fp8(sp[4 * 33] * 32.f, sp[5 * 33] * 32.f, sp[6 * 33] * 32.f, sp[7 * 33] * 32.f);
        *(u32x2*)(c.WT + (size_t)(c.nrow0 + n) * c.ldt + c.k0 + 8 * cc) = o; }
    LDS_WAIT(); asm volatile("" ::: "memory");
}
__device__ __forceinline__ void moe_cvt_run(const Args& a, int base, int wi, int k0, int k1, LAS float* scr, int lane) {
    if (k0 >= k1) return;
    f32x4 va[8], vb[8];
    MoeCvt ca = moe_cvt_desc(a, base + k0 * 1024 + wi), cb = ca; moe_cvt_issue(ca, va, lane);
    for (int k = k0; k < k1; k += 2) {
        if (k + 1 < k1) { cb = moe_cvt_desc(a, base + (k + 1) * 1024 + wi); moe_cvt_issue(cb, vb, lane); }
        moe_cvt_finish(ca, va, scr, lane);
        if (k + 2 < k1) { ca = moe_cvt_desc(a, base + (k + 2) * 1024 + wi); moe_cvt_issue(ca, va, lane); }
        if (k + 1 < k1) moe_cvt_finish(cb, vb, scr, lane);
    }
}

__device__ __forceinline__ void phase_prep(const Args& a, LAS uchar* lds, int bid, int G, int tid, int wid, int lane) {
    float* modp = (float*)(a.ws + WS_MODP);
    if (bid < 192) {
        const int cgp = bid % 24, ks = bid / 24, n0 = cgp * 256 + lane * 4, k0 = ks * 128 + wid * 16;
        LAS float* sc = (LAS float*)(lds + 81920);
        for (int i = tid; i < 9 * 128; i += 512) { const int r = i >> 7, kk = i & 127; sc[i] = silu_f((r < 8) ? a.c[r * D + ks * 128 + kk] : a.c_ctx[ks * 128 + kk]); }
        f32x4 w[16];
#pragma unroll
        for (int kk = 0; kk < 16; ++kk) w[kk] = __builtin_nontemporal_load((const f32x4*)(a.w_ada + (size_t)(k0 + kk) * NMOD + n0));
        __syncthreads();
        f32x4 acc[9];
#pragma unroll
        for (int r = 0; r < 9; ++r) acc[r] = (f32x4){0.f, 0.f, 0.f, 0.f};
#pragma unroll
        for (int kk = 0; kk < 16; ++kk) {
#pragma unroll
            for (int r = 0; r < 9; ++r) acc[r] += w[kk] * sc[r * 128 + wid * 16 + kk]; }
        LAS f32x4* red = (LAS f32x4*)lds;
#pragma unroll
        for (int r = 0; r < 9; ++r) red[(wid * 9 + r) * 64 + lane] = acc[r];
        __syncthreads();
        for (int o = tid; o < 9 * 64; o += 512) { const int r = o / 64, l = o % 64; f32x4 sm = red[(0 * 9 + r) * 64 + l];
#pragma unroll
            for (int w8 = 1; w8 < 8; ++w8) sm += red[(w8 * 9 + r) * 64 + l];
            if (ks == 0) sm += *(const f32x4*)(a.b_ada + cgp * 256 + l * 4);
            *(f32x4*)(modp + ((size_t)ks * 9 + r) * NMOD + cgp * 256 + l * 4) = sm; }
        __syncthreads();
    }
    if (bid == 255) {
        float* lb = (float*)(a.ws + WS_LB);
        for (int i = tid; i < 1024; i += 512) { const float l0 = a.lb_logits[i], l1 = a.lb_logits[1024 + i]; lb[i] = 1.f / (1.f + __expf(l1 - l0)); }
    }
    LAS float* scr = (LAS float*)lds + wid * (64 * 33);
    const int gw = (G - 1 - bid) * 8 + wid, NGW = G * 8;
    constexpr int I_IN = (D / 64) * (NIN / 32), I_OUT = (D / 64) * (D / 32);
    for (int it = gw; it < I_IN + I_OUT; it += NGW) {
        if (it < I_IN) { const int nblk = NIN / 32, kb = it / nblk, nb = it % nblk; const int n0 = nb * 32;
            const int nrow = (n0 < 3072) ? n0 : 3072 + (((n0 - 3072) & 511) >> 7) * 256 + ((n0 - 3072) & 127) + ((n0 >= 3584) ? 128 : 0);
            cvt_item(a.w_in, NIN, (bf16_t*)(a.ws + WS_WIN), D, kb * 64, n0, nrow, scr, lane); }
        else { const int r = it - I_IN, nblk = D / 32, kb = r / nblk, nb = r % nblk; cvt_item(a.w_out, D, (bf16_t*)(a.ws + WS_WOUT), D, kb * 64, nb * 32, nb * 32, scr, lane); }
    }
}

__device__ __forceinline__ float modp_sum(const float* modp, int r, int col) { float s = 0.f;
#pragma unroll
    for (int ks = 0; ks < 8; ++ks) s += modp[((size_t)ks * 9 + r) * NMOD + col];
    return s; }
template <int NR>
__device__ __forceinline__ void norm_rows(const float* xrow0, bf16_t* orow0, const LAS float* gm, const LAS float* sh, int lane) {
    f32x4 v[NR][4]; float ss[NR];
#pragma unroll
    for (int i = 0; i < NR; ++i) { ss[i] = 0.f;
#pragma unroll
        for (int j = 0; j < 4; ++j) v[i][j] = __builtin_nontemporal_load((const f32x4*)(xrow0 + (size_t)i * D) + lane + 64 * j); }
#pragma unroll
    for (int i = 0; i < NR; ++i) {
#pragma unroll
        for (int j = 0; j < 4; ++j) ss[i] += (v[i][j].x * v[i][j].x + v[i][j].y * v[i][j].y) + (v[i][j].z * v[i][j].z + v[i][j].w * v[i][j].w);
        ss[i] = rsqrtf(wave_sum(ss[i]) * (1.f / D) + EPS); }
#pragma unroll
    for (int j = 0; j < 4; ++j) { const f32x4 g4 = *((const LAS f32x4*)gm + lane + 64 * j), s4 = *((const LAS f32x4*)sh + lane + 64 * j);
#pragma unroll
        for (int i = 0; i < NR; ++i) { const f32x4 o = v[i][j] * ss[i] * g4 + s4;
            u32x2 w; w.x = cvt_pk_bf16(o.x, o.y); w.y = cvt_pk_bf16(o.z, o.w); st_wt8((u32x2*)(orow0 + (size_t)i * D) + lane + 64 * j, w); } }
}
__device__ __forceinline__ void phase_norm(const Args& a, LAS uchar* lds, int bid, int G, int tid, int wid, int lane) {
    const float* modp = (const float*)(a.ws + WS_MODP); float* modf = (float*)(a.ws + WS_MODF);
    { const int gt = bid * 512 + tid; if (gt < 9 * NMOD) modf[gt] = modp_sum(modp, gt / NMOD, gt % NMOD); }
    LAS float* gm = (LAS float*)lds; LAS float* sh = gm + D; LAS float* cgm = sh + D; LAS float* csh = cgm + D;
    const int b = bid / 32;
    for (int cidx = tid; cidx < D; cidx += 512) { const float nm = a.norm_mix[cidx];
        sh[cidx] = modp_sum(modp, b, cidx); gm[cidx] = nm * (1.f + modp_sum(modp, b, D + cidx));
        csh[cidx] = modp_sum(modp, 8, cidx); cgm[cidx] = nm * (1.f + modp_sum(modp, 8, D + cidx)); }
    __syncthreads();
    bf16_t* hx = (bf16_t*)(a.ws + WS_ACT); bf16_t* hc = (bf16_t*)(a.ws + WS_HC);
    { const int row = bid * 8 + wid; norm_rows<1>(a.ctx + (size_t)row * D, hc + (size_t)row * D, cgm, csh, lane); }
    for (int j = 0; j < 16; j += 4) { const int row = bid * 128 + wid * 16 + j; norm_rows<4>(a.x + (size_t)row * D, hx + (size_t)row * D, gm, sh, lane); }
    __syncthreads();
}

constexpr int GL_QDP = 0, GL_KIP = 8704, GL_SET0 = 17408, GL_SETSZ = 20992, GL_VTPO = 10240, GL_DECO = 20480, GL_TOT = 59392, GL_RING = 61440, GL_SLOT = 24576, GL_TOT1 = GL_RING + 3 * GL_SLOT;
static_assert(GL_TOT1 + 2048 <= LDS_BYTES - 16, "GLA LDS map");
#define GLA_BAR() do { asm volatile("s_waitcnt lgkmcnt(0)" ::: "memory"); __builtin_amdgcn_s_barrier(); asm volatile("" ::: "memory"); } while (0)
template <bool FULL>
__device__ __forceinline__ void gla_item(LAS uchar* lds, const bf16_t* qb, const _Float16* lfb, const bf16_t* vb, bf16_t* ob, f32x4 (&S)[8][2], float* dl_out,
                                         int row_base, int Tn, int tau0, int nch, int h, int dir, int wid, int lane) {
    const int fr = lane & 15, fq = lane >> 4;
    const bool prod = wid < 4; const int pw = wid & 3;
    constexpr int NT = FULL ? 6 : 4;
    f32x2 kk_[8], cs[8]; unsigned qv[8], qdp[8], kip[8]; f32x2 dsum = (f32x2){0.f, 0.f};
    const int d0 = 2 * lane, pos0 = (d0 & ~31) + 8 * ((d0 >> 2) & 3) + 4 * ((d0 >> 4) & 1) + (d0 & 3);
#define GLA_ISSUE(c) do { LAS uchar* _sl = lds + GL_RING + ((c) % 3) * GL_SLOT + pw * 6144; \
        _Pragma("unroll") for (int _g = 0; _g < 2; ++_g) { const int _tau = tau0 + 32 * (c) + 8 * pw + 4 * _g + (lane >> 4); const size_t _o = (size_t)(dir ? (Tn - 1 - _tau) : _tau) * 128 + (lane & 15) * 8; \
            __builtin_amdgcn_global_load_lds((const unsigned*)(lfb + _o), (LAS unsigned*)(_sl + _g * 1024), 16, 0, 2); \
            if (FULL) __builtin_amdgcn_global_load_lds((const unsigned*)(qb + _o), (LAS unsigned*)(_sl + 2048 + _g * 1024), 16, 0, 2); \
            __builtin_amdgcn_global_load_lds((const unsigned*)(vb + _o), (LAS unsigned*)(_sl + 4096 + _g * 1024), 16, 0, 2); } } while (0)
#define GLA_P1(c) do { \
        if ((c) + 2 < nch) { if (FULL) asm volatile("s_waitcnt vmcnt(12)" ::: "memory"); else asm volatile("s_waitcnt vmcnt(8)" ::: "memory"); } \
        else if ((c) + 1 < nch) { if (FULL) asm volatile("s_waitcnt vmcnt(6)" ::: "memory"); else asm volatile("s_waitcnt vmcnt(4)" ::: "memory"); } \
        else asm volatile("s_waitcnt vmcnt(0)" ::: "memory"); \
        const LAS uchar* _sl = lds + GL_RING + ((c) % 3) * GL_SLOT + pw * 6144; \
        LAS uchar* _set1 = lds + GL_SET0 + ((c) & 1) * GL_SETSZ; \
        unsigned _vv[8]; f32x2 _lf[8]; \
        _Pragma("unroll") for (int _r = 0; _r < 8; ++_r) { typedef _Float16 h2_t __attribute__((ext_vector_type(2))); const h2_t _hv = *(const LAS h2_t*)(_sl + _r * 256 + lane * 4); _lf[_r] = (f32x2){(float)_hv.x, (float)_hv.y}; \
            _vv[_r] = *(const LAS unsigned*)(_sl + 4096 + _r * 256 + lane * 4); qv[_r] = FULL ? *(const LAS unsigned*)(_sl + 2048 + _r * 256 + lane * 4) : 0u; } \
        cs[0] = _lf[0]; _Pragma("unroll") for (int _r = 1; _r < 8; ++_r) cs[_r] = cs[_r - 1] + _lf[_r]; \
        ((LAS f32x2*)(lds + (((c) & 1) ? GL_TOT1 : GL_TOT)))[pw * 64 + lane] = cs[7]; \
        _Pragma("unroll") for (int _r = 0; _r < 8; ++_r) kk_[_r] = 1.f - (f32x2){__builtin_amdgcn_exp2f(_lf[_r].x), __builtin_amdgcn_exp2f(_lf[_r].y)}; \
        _Pragma("unroll") for (int _g = 0; _g < 2; ++_g) { const int _sp = 8 * ((2 * pw + _g) & 3) + 4 * (pw >> 1);     \
            u32x2 _v0, _v1; _v0.x = (_vv[4 * _g] & 0xffffu) | (_vv[4 * _g + 1] << 16); _v0.y = (_vv[4 * _g + 2] & 0xffffu) | (_vv[4 * _g + 3] << 16); \
            _v1.x = (_vv[4 * _g] >> 16) | (_vv[4 * _g + 1] & 0xffff0000u); _v1.y = (_vv[4 * _g + 2] >> 16) | (_vv[4 * _g + 3] & 0xffff0000u); \
            *(LAS u32x2*)(_set1 + GL_VTPO + (d0) * 80 + _sp * 2) = _v0; *(LAS u32x2*)(_set1 + GL_VTPO + (d0 + 1) * 80 + _sp * 2) = _v1; } \
        if ((c) + 3 < nch) GLA_ISSUE((c) + 3);     } while (0)
#define GLA_P2C(c) do { \
        f32x2 _pre = (f32x2){0.f, 0.f}, _all = (f32x2){0.f, 0.f}; \
        _Pragma("unroll") for (int _w = 0; _w < 4; ++_w) { const f32x2 _tw = ((const LAS f32x2*)(lds + (((c) & 1) ? GL_TOT1 : GL_TOT)))[_w * 64 + lane]; _all += _tw; if (_w < pw) _pre += _tw; } \
        dsum += _all; \
        const f32x2 _dec = (f32x2){__builtin_amdgcn_exp2f(_all.x), __builtin_amdgcn_exp2f(_all.y)}; \
        LAS uchar* _set = lds + GL_SET0 + ((c) & 1) * GL_SETSZ; \
        f32x2 _kE[8]; \
        _Pragma("unroll") for (int _r = 0; _r < 8; ++_r) { \
            const f32x2 _cum = _pre + cs[_r]; \
            const f32x2 _ki = kk_[_r] * (f32x2){__builtin_amdgcn_exp2f(-_cum.x), __builtin_amdgcn_exp2f(-_cum.y)}; \
            _kE[_r] = _ki * _dec; \
            if (FULL) { const f32x2 _qd = (f32x2){bf_lo(qv[_r]), bf_hi(qv[_r])} * (f32x2){__builtin_amdgcn_exp2f(_cum.x), __builtin_amdgcn_exp2f(_cum.y)}; \
                qdp[_r] = cvt_pk_bf16(_qd.x, _qd.y); kip[_r] = cvt_pk_bf16(_ki.x, _ki.y); } } \
        _Pragma("unroll") for (int _g = 0; _g < 2; ++_g) { const int _sp = 8 * ((2 * pw + _g) & 3) + 4 * (pw >> 1);     \
            u32x2 _w0, _w1; _w0.x = cvt_pk_bf16(_kE[4 * _g].x, _kE[4 * _g + 1].x); _w0.y = cvt_pk_bf16(_kE[4 * _g + 2].x, _kE[4 * _g + 3].x); \
            _w1.x = cvt_pk_bf16(_kE[4 * _g].y, _kE[4 * _g + 1].y); _w1.y = cvt_pk_bf16(_kE[4 * _g + 2].y, _kE[4 * _g + 3].y); \
            *(LAS u32x2*)(_set + (d0) * 80 + _sp * 2) = _w0; *(LAS u32x2*)(_set + (d0 + 1) * 80 + _sp * 2) = _w1; \
} \
        if (pw == 0) *(LAS f32x2*)(_set + GL_DECO + lane * 8) = _dec; } while (0)
#define GLA_P2W(c) do { if (FULL) { _Pragma("unroll") for (int _r = 0; _r < 8; ++_r) { const int _s = 8 * pw + _r; \
            *(LAS unsigned*)(lds + GL_QDP + _s * 272 + pos0 * 2) = qdp[_r]; *(LAS unsigned*)(lds + GL_KIP + _s * 272 + pos0 * 2) = kip[_r]; } } } while (0)

    if (prod) {
      if (FULL) {
        GLA_ISSUE(0); if (nch > 1) GLA_ISSUE(1); if (nch > 2) GLA_ISSUE(2);
        GLA_P1(0);
        GLA_BAR();
        GLA_P2C(0); GLA_P2W(0);
        if (nch > 1) GLA_P1(1);
        GLA_BAR();
        for (int n = 0; n < nch; ++n) {
            if (n + 1 < nch) GLA_P2C(n + 1);
            GLA_BAR();
            if (n + 1 < nch) GLA_P2W(n + 1);
            if (n + 2 < nch) GLA_P1(n + 2);
            GLA_BAR();
        }
      } else {
        GLA_ISSUE(0); if (nch > 1) GLA_ISSUE(1); if (nch > 2) GLA_ISSUE(2);
        GLA_P1(0);
        GLA_BAR();
        GLA_P2C(0);
        GLA_BAR();
        for (int n = 0; n < nch; ++n) {
            if (n + 1 < nch) GLA_P1(n + 1);
            GLA_BAR();
            if (n + 1 < nch) GLA_P2C(n + 1);
            GLA_BAR();
        }
      }
    } else {
        u32x4 sAp[4][2];
#define GLA_SCVT() do { _Pragma("unroll") for (int _kk = 0; _kk < 4; ++_kk) _Pragma("unroll") for (int _vt = 0; _vt < 2; ++_vt) { \
            sAp[_kk][_vt].x = cvt_pk_bf16_safe(S[2 * _kk][_vt][0], S[2 * _kk][_vt][1]); sAp[_kk][_vt].y = cvt_pk_bf16_safe(S[2 * _kk][_vt][2], S[2 * _kk][_vt][3]); \
            sAp[_kk][_vt].z = cvt_pk_bf16_safe(S[2 * _kk + 1][_vt][0], S[2 * _kk + 1][_vt][1]); sAp[_kk][_vt].w = cvt_pk_bf16_safe(S[2 * _kk + 1][_vt][2], S[2 * _kk + 1][_vt][3]); } } while (0)
        if (FULL) GLA_SCVT();
        GLA_BAR();
        GLA_BAR();
        for (int n = 0; n < nch; ++n) {
            const LAS uchar* set = lds + GL_SET0 + (n & 1) * GL_SETSZ;
            bf16x8 vtf[2];
#pragma unroll
            for (int vt = 0; vt < 2; ++vt) vtf[vt] = *(const LAS bf16x8*)(set + GL_VTPO + (32 * pw + 16 * vt + fr) * 80 + fq * 16);
            if (FULL) {
                bf16x8 qf[2][4];
#pragma unroll
                for (int ti = 0; ti < 2; ++ti)
#pragma unroll
                    for (int kk = 0; kk < 4; ++kk) qf[ti][kk] = *(const LAS bf16x8*)(lds + GL_QDP + (16 * ti + fr) * 272 + kk * 64 + fq * 16);
                f32x4 oT[2][2];
#pragma unroll
                for (int vt = 0; vt < 2; ++vt)
#pragma unroll
                    for (int ti = 0; ti < 2; ++ti) oT[vt][ti] = (f32x4){0.f, 0.f, 0.f, 0.f};
                f32x4 p00 = (f32x4){0.f, 0.f, 0.f, 0.f}, p01 = p00, p11 = p00;
#pragma unroll
                for (int kk = 0; kk < 4; ++kk) {
                    const bf16x8 kj0 = *(const LAS bf16x8*)(lds + GL_KIP + (fr) * 272 + kk * 64 + fq * 16);
                    const bf16x8 kj1 = *(const LAS bf16x8*)(lds + GL_KIP + (16 + fr) * 272 + kk * 64 + fq * 16);
                    p00 = __builtin_amdgcn_mfma_f32_16x16x32_bf16(kj0, qf[0][kk], p00, 0, 0, 0);
                    p01 = __builtin_amdgcn_mfma_f32_16x16x32_bf16(kj0, qf[1][kk], p01, 0, 0, 0);
                    p11 = __builtin_amdgcn_mfma_f32_16x16x32_bf16(kj1, qf[1][kk], p11, 0, 0, 0);
#pragma unroll
                    for (int vt = 0; vt < 2; ++vt) {
                        const bf16x8 sA = __builtin_bit_cast(bf16x8, sAp[kk][vt]);
                        oT[vt][0] = __builtin_amdgcn_mfma_f32_16x16x32_bf16(sA, qf[0][kk], oT[vt][0], 0, 0, 0);
                        oT[vt][1] = __builtin_amdgcn_mfma_f32_16x16x32_bf16(sA, qf[1][kk], oT[vt][1], 0, 0, 0); }
                }
                u32x4 pb0, pb1;
                { float m0[4], m1[4];
#pragma unroll
                  for (int r = 0; r < 4; ++r) { const bool ok = (4 * fq + r) <= fr; m0[r] = ok ? p00[r] : 0.f; m1[r] = ok ? p11[r] : 0.f; }
                  pb0.x = cvt_pk_bf16_safe(m0[0], m0[1]); pb0.y = cvt_pk_bf16_safe(m0[2], m0[3]); pb0.z = 0u; pb0.w = 0u;
                  pb1.x = cvt_pk_bf16_safe(p01[0], p01[1]); pb1.y = cvt_pk_bf16_safe(p01[2], p01[3]); pb1.z = cvt_pk_bf16_safe(m1[0], m1[1]); pb1.w = cvt_pk_bf16_safe(m1[2], m1[3]); }
#pragma unroll
                for (int vt = 0; vt < 2; ++vt) {
                    oT[vt][0] = __builtin_amdgcn_mfma_f32_16x16x32_bf16(vtf[vt], __builtin_bit_cast(bf16x8, pb0), oT[vt][0], 0, 0, 0);
                    oT[vt][1] = __builtin_amdgcn_mfma_f32_16x16x32_bf16(vtf[vt], __builtin_bit_cast(bf16x8, pb1), oT[vt][1], 0, 0, 0); }
#pragma unroll
                for (int ti = 0; ti < 2; ++ti) { const int tau = tau0 + 32 * n + 16 * ti + fr; const size_t row = (size_t)(row_base + (dir ? (Tn - 1 - tau) : tau));
#pragma unroll
                    for (int vt = 0; vt < 2; ++vt) { u32x2 w; w.x = cvt_pk_bf16_safe(oT[vt][ti][0], oT[vt][ti][1]); w.y = cvt_pk_bf16_safe(oT[vt][ti][2], oT[vt][ti][3]);
                        *(u32x2*)(ob + row * 512 + h * 128 + 32 * pw + 16 * vt + 4 * fq) = w; } }
            }
            GLA_BAR();
#pragma unroll
            for (int t8 = 0; t8 < 8; ++t8) {
                const f32x4 dc = *(const LAS f32x4*)(set + GL_DECO + (16 * t8 + 4 * fq) * 4);
                const bf16x8 ka = *(const LAS bf16x8*)(set + (16 * t8 + fr) * 80 + fq * 16);
#pragma unroll
                for (int vt = 0; vt < 2; ++vt) S[t8][vt] = __builtin_amdgcn_mfma_f32_16x16x32_bf16(ka, vtf[vt], S[t8][vt] * dc, 0, 0, 0);
            }
            if (FULL && n + 1 < nch) GLA_SCVT();
            GLA_BAR();
        }
#undef GLA_SCVT
    }
#undef GLA_ISSUE
#undef GLA_P1
#undef GLA_P2C
#undef GLA_P2W
    if (dl_out && wid == 0) *(f32x2*)(dl_out + 2 * lane) = dsum;
    asm volatile("s_waitcnt vmcnt(0)" ::: "memory");
    GLA_BAR();
}
__device__ __forceinline__ void gla_state_store(float* p, const f32x4 (&S)[8][2], int cw, int fr, int fq) {
#pragma unroll
    for (int t8 = 0; t8 < 8; ++t8)
#pragma unroll
        for (int vt = 0; vt < 2; ++vt)
#pragma unroll
            for (int r = 0; r < 4; ++r) p[(size_t)(16 * t8 + 4 * fq + r) * 128 + 32 * cw + 16 * vt + fr] = S[t8][vt][r];
}
__device__ __forceinline__ void phase_gla_states(const Args& a, LAS uchar* lds, int bid, int wid, int lane) {
    uchar* ws = a.ws; const int fr = lane & 15, fq = lane >> 4;
    f32x4 S[8][2];
#pragma unroll
    for (int t8 = 0; t8 < 8; ++t8) { S[t8][0] = (f32x4){0.f, 0.f, 0.f, 0.f}; S[t8][1] = (f32x4){0.f, 0.f, 0.f, 0.f}; }
    if (bid < 192) { const int bhd = bid / 3, seg = bid % 3, b = bhd >> 3, h = (bhd >> 1) & 3, dir = bhd & 1;
        const size_t pl = (size_t)(b * NH + h) * T * 128;
        gla_item<false>(lds, nullptr, (const _Float16*)(ws + (dir ? WS_LBW : WS_LF)) + pl, (const bf16_t*)(ws + WS_ZI) + pl, nullptr, S, (float*)(ws + WS_DL) + (size_t)bid * 128,
                        b * T, T, seg * 1024, 32, h, dir, wid, lane);
        if (wid >= 4) gla_state_store((float*)(ws + WS_SL) + (size_t)bid * 16384, S, wid - 4, fr, fq);
    } else { const int bhd = bid - 192, b = bhd >> 3, h = (bhd >> 1) & 3, dir = bhd & 1;
        const size_t pl = (size_t)(b * NH + h) * CT * 128;
        gla_item<false>(lds, nullptr, (const _Float16*)(ws + (dir ? WS_CLB : WS_CLF)) + pl, (const bf16_t*)(ws + WS_CI) + pl, nullptr, S, nullptr, b * CT, CT, 0, CT / 32, h, dir, wid, lane);
        if (wid >= 4) gla_state_store((float*)(ws + WS_S0) + (size_t)bhd * 16384, S, wid - 4, fr, fq);
    }
}
__device__ __forceinline__ void phase_gla_out(const Args& a, LAS uchar* lds, int bid, int wid, int lane) {
    uchar* ws = a.ws; const int fr = lane & 15, fq = lane >> 4;
    const int bhd = bid >> 2, seg = bid & 3, b = bhd >> 3, h = (bhd >> 1) & 3, dir = bhd & 1;
    f32x4 S[8][2];
    if (wid >= 4) { const int cw = wid - 4;
        { const float* p = (const float*)(ws + WS_S0) + (size_t)bhd * 16384;
#pragma unroll
          for (int t8 = 0; t8 < 8; ++t8)
#pragma unroll
              for (int vt = 0; vt < 2; ++vt)
#pragma unroll
                  for (int r = 0; r < 4; ++r) S[t8][vt][r] = p[(size_t)(16 * t8 + 4 * fq + r) * 128 + 32 * cw + 16 * vt + fr]; }
        for (int j = 0; j < seg; ++j) { const float* p = (const float*)(ws + WS_SL) + (size_t)(bhd * 3 + j) * 16384; const float* dl = (const float*)(ws + WS_DL) + (size_t)(bhd * 3 + j) * 128;
#pragma unroll
            for (int t8 = 0; t8 < 8; ++t8) { const f32x4 dv = *(const f32x4*)(dl + 16 * t8 + 4 * fq);
#pragma unroll
                for (int vt = 0; vt < 2; ++vt)
#pragma unroll
                    for (int r = 0; r < 4; ++r) S[t8][vt][r] = __builtin_amdgcn_exp2f(dv[r]) * S[t8][vt][r] + p[(size_t)(16 * t8 + 4 * fq + r) * 128 + 32 * cw + 16 * vt + fr]; } }
    } else {
#pragma unroll
        for (int t8 = 0; t8 < 8; ++t8) { S[t8][0] = (f32x4){0.f, 0.f, 0.f, 0.f}; S[t8][1] = (f32x4){0.f, 0.f, 0.f, 0.f}; }
    }
    asm volatile("s_waitcnt vmcnt(0)" ::: "memory");
    const size_t pl = (size_t)(b * NH + h) * T * 128;
    gla_item<true>(lds, (const bf16_t*)(ws + WS_ZQ) + pl, (const _Float16*)(ws + (dir ? WS_LBW : WS_LF)) + pl, (const bf16_t*)(ws + WS_ZI) + pl, (bf16_t*)(ws + (dir ? WS_OB : WS_OF)), S, nullptr,
                   b * T, T, seg * 1024, 32, h, dir, wid, lane);
}

__device__ __forceinline__ void unpack8(const u32x4 w, float (&f)[8]) { f[0] = bf_lo(w.x); f[1] = bf_hi(w.x); f[2] = bf_lo(w.y); f[3] = bf_hi(w.y); f[4] = bf_lo(w.z); f[5] = bf_hi(w.z); f[6] = bf_lo(w.w); f[7] = bf_hi(w.w); }
__device__ __forceinline__ void phase_mixfin(const Args& a, int bid, int G, int wid, int lane) {
    const bf16_t* of = (const bf16_t*)(a.ws + WS_OF); const bf16_t* obw = (const bf16_t*)(a.ws + WS_OB); const bf16_t* zg = (const bf16_t*)(a.ws + WS_ZG);
    const bf16_t* zgb = (const bf16_t*)(a.ws + WS_ZGB); const bf16_t* zgc = (const bf16_t*)(a.ws + WS_ZGC);
    bf16_t* A2 = (bf16_t*)(a.ws + WS_ACT);
    const int c0 = 8 * lane;
    float gain[8], cw0[8], cw1[8], cw2[8];
#pragma unroll
    for (int j = 0; j < 8; ++j) { gain[j] = a.hg_norm[(c0 + j) & 127]; cw0[j] = a.conv_w[c0 + j]; cw1[j] = a.conv_w[512 + c0 + j]; cw2[j] = a.conv_w[1024 + c0 + j]; }
    const u32x4 zero4 = (u32x4){0u, 0u, 0u, 0u};
    u32x4 cu[7], nx[7];
#define MF_LOAD(ROW, R) do { const size_t _ro = (size_t)(ROW) * 512 + c0; const int _tw = (ROW) & 63; \
        R[0] = __builtin_nontemporal_load((const u32x4*)(of + _ro)); R[1] = __builtin_nontemporal_load((const u32x4*)(obw + _ro)); R[2] = __builtin_nontemporal_load((const u32x4*)(zg + _ro)); \
        R[3] = *(const u32x4*)(zgc + _ro); R[4] = __builtin_nontemporal_load((const u32x4*)(zgb + _ro)); \
        R[5] = *(const u32x4*)(zgc + _ro - (_tw > 0 ? 512 : 0)); R[6] = *(const u32x4*)(zgc + _ro + (_tw < 63 ? 512 : 0)); } while (0)
    int row = bid * 8 + wid;
    if (row < M) MF_LOAD(row, cu);
    for (; row < M; row += G * 8) {
        const int nrow = row + G * 8;
        if (nrow < M) MF_LOAD(nrow, nx);
        float f0[8], f1[8], gg[8], o[8];
        unpack8(cu[0], f0); unpack8(cu[1], f1); unpack8(cu[2], gg);
        float ss = 0.f;
#pragma unroll
        for (int j = 0; j < 8; ++j) { o[j] = f0[j] + f1[j]; ss += o[j] * o[j]; }
        ss += __shfl_xor(ss, 1); ss += __shfl_xor(ss, 2); ss += __shfl_xor(ss, 4); ss += __shfl_xor(ss, 8);
        const float rstd = rsqrtf(ss * (1.f / 128.f) + EPS);
#pragma unroll
        for (int j = 0; j < 8; ++j) o[j] = o[j] * rstd * gain[j] * silu_f(gg[j]);
        u32x4 w; w.x = cvt_pk_bf16(o[0], o[1]); w.y = cvt_pk_bf16(o[2], o[3]); w.z = cvt_pk_bf16(o[4], o[5]); w.w = cvt_pk_bf16(o[6], o[7]);
        st_wt16(A2 + (size_t)row * D + c0, w);
        const int tw = row & 63;
        float um[8], u0[8], up[8], gb[8], y[8];
        unpack8(cu[3], u0); unpack8(cu[4], gb); unpack8(tw > 0 ? cu[5] : zero4, um); unpack8(tw < 63 ? cu[6] : zero4, up);
#pragma unroll
        for (int j = 0; j < 8; ++j) y[j] = gb[j] * (cw0[j] * um[j] + cw1[j] * u0[j] + cw2[j] * up[j]);
        w.x = cvt_pk_bf16(y[0], y[1]); w.y = cvt_pk_bf16(y[2], y[3]); w.z = cvt_pk_bf16(y[4], y[5]); w.w = cvt_pk_bf16(y[6], y[7]);
        st_wt16(A2 + (size_t)row * D + 512 + c0, w);
#pragma unroll
        for (int q = 0; q < 7; ++q) cu[q] = nx[q];
    }
#undef MF_LOAD
}

__device__ __forceinline__ void phase_router(const Args& a, LAS uchar* lds, int bid, int tid, int wid, int lane) {
    const float* modf = (const float*)(a.ws + WS_MODF);
    LAS float* gm = (LAS float*)lds; LAS float* sh = gm + D;
    LAS uchar* wrl = lds + 8192;
    const int b = bid / 32;
    for (int cidx = tid; cidx < D; cidx += 512) { sh[cidx] = modf[(size_t)b * NMOD + 3 * D + cidx]; gm[cidx] = a.norm_ffn[cidx] * (1.f + modf[(size_t)b * NMOD + 4 * D + cidx]); }
    for (int i = tid; i < D * 4; i += 512) { const int col = i >> 2, q4 = i & 3; *(LAS f32x4*)(wrl + col * 64 + (col >> 2) * 16 + q4 * 16) = *(const f32x4*)(a.w_router + col * 16 + q4 * 4); }
    __syncthreads();
    uchar* hx2 = a.ws + WS_ACT; float* aff = (float*)(a.ws + WS_AFF);
    u32x2 xn[4][4];
#define RT_LOAD(JB) do { const bf16_t* _x = (const bf16_t*)(a.ws + WS_X1B) + (size_t)(bid * 128 + wid * 16 + (JB) * 4) * D; \
        _Pragma("unroll") for (int _i = 0; _i < 4; ++_i) _Pragma("unroll") for (int _j = 0; _j < 4; ++_j) xn[_i][_j] = __builtin_nontemporal_load((const u32x2*)(_x + (size_t)_i * D) + lane + 64 * _j); } while (0)
    RT_LOAD(0);
    LAS float* cscr = (LAS float*)(lds + 77824) + wid * (64 * 33);
    f32x4 cvv[8];
    for (int jb = 0; jb < 4; ++jb) {
        const MoeCvt cdesc = moe_cvt_desc(a, jb * 2048 + bid * 8 + wid); moe_cvt_issue(cdesc, cvv, lane);
        const int row0 = bid * 128 + wid * 16 + jb * 4;
        f32x4 v[4][4]; float rstd[4];
#pragma unroll
        for (int i = 0; i < 4; ++i) { float ss = 0.f;
#pragma unroll
            for (int jj = 0; jj < 4; ++jj) { const u32x2 xw = xn[i][jj]; v[i][jj] = (f32x4){bf_lo(xw.x), bf_hi(xw.x), bf_lo(xw.y), bf_hi(xw.y)}; ss += (v[i][jj].x * v[i][jj].x + v[i][jj].y * v[i][jj].y) + (v[i][jj].z * v[i][jj].z + v[i][jj].w * v[i][jj].w); }
            rstd[i] = ss; }
        if (jb < 3) RT_LOAD(jb + 1);
#pragma unroll
        for (int i = 0; i < 4; ++i) rstd[i] = rsqrtf(wave_sum(rstd[i]) * (1.f / D) + EPS);
        f32x2 pl2[32];
#define pl(k) pl2[(k) >> 1][(k) & 1]
#pragma unroll
        for (int e = 0; e < 32; ++e) pl2[e] = (f32x2){0.f, 0.f};
#pragma unroll
        for (int jj = 0; jj < 4; ++jj) { const f32x4 g4 = *((const LAS f32x4*)gm + lane + 64 * jj), s4 = *((const LAS f32x4*)sh + lane + 64 * jj);
#pragma unroll
            for (int i = 0; i < 4; ++i) { v[i][jj] = v[i][jj] * rstd[i] * g4 + s4;
                st_wt4((unsigned*)(hx2 + (size_t)(row0 + i) * D) + lane + 64 * jj, cvt_pk4_fp8(v[i][jj].x, v[i][jj].y, v[i][jj].z, v[i][jj].w)); }
            const int colb = 4 * lane + 256 * jj;
#pragma unroll
            for (int cc = 0; cc < 4; ++cc) { const int col = colb + cc; const LAS uchar* wp = wrl + col * 64 + (col >> 2) * 16;
#pragma unroll
                for (int q4 = 0; q4 < 4; ++q4) { const f32x4 w4 = *(const LAS f32x4*)(wp + q4 * 16);
#pragma unroll
                    for (int i = 0; i < 4; ++i) { const float hvv = v[i][jj][cc]; const f32x2 h2 = (f32x2){hvv, hvv};
                        pl2[i * 8 + q4 * 2 + 0] = __builtin_elementwise_fma(h2, (f32x2){w4.x, w4.y}, pl2[i * 8 + q4 * 2 + 0]); pl2[i * 8 + q4 * 2 + 1] = __builtin_elementwise_fma(h2, (f32x2){w4.z, w4.w}, pl2[i * 8 + q4 * 2 + 1]); } } } }
#pragma unroll
        for (int k = 0; k < 32; ++k) { const bool hi = (lane & 32) != 0; const float keep = hi ? pl(32 + k) : pl(k), send = hi ? pl(k) : pl(32 + k); pl(k) = keep + __shfl_xor(send, 32); }
#pragma unroll
        for (int k = 0; k < 16; ++k) { const bool hi = (lane & 16) != 0; const float keep = hi ? pl(16 + k) : pl(k), send = hi ? pl(k) : pl(16 + k); pl(k) = keep + __shfl_xor(send, 16); }
#pragma unroll
        for (int k = 0; k < 8; ++k) { const bool hi = (lane & 8) != 0; const float keep = hi ? pl(8 + k) : pl(k), send = hi ? pl(k) : pl(8 + k); pl(k) = keep + __shfl_xor(send, 8); }
#pragma unroll
        for (int k = 0; k < 4; ++k) { const bool hi = (lane & 4) != 0; const float keep = hi ? pl(4 + k) : pl(k), send = hi ? pl(k) : pl(4 + k); pl(k) = keep + __shfl_xor(send, 4); }
#pragma unroll
        for (int k = 0; k < 2; ++k) { const bool hi = (lane & 2) != 0; const float keep = hi ? pl(2 + k) : pl(k), send = hi ? pl(k) : pl(2 + k); pl(k) = keep + __shfl_xor(send, 2); }
        { const bool hi = (lane & 1) != 0; const float keep = hi ? pl(1) : pl(0), send = hi ? pl(0) : pl(1); pl(0) = keep + __shfl_xor(send, 1); }
        const float lg = pl(0);
#undef pl
        float mx = lg;
#pragma unroll
        for (int o = 1; o < 16; o <<= 1) mx = fmaxf(mx, __shfl_xor(mx, o));
        const float ex = __expf(lg - mx); float den = ex;
#pragma unroll
        for (int o = 1; o < 16; o <<= 1) den += __shfl_xor(den, o);
        const int t = (row0 + (lane >> 4)) & (T - 1);
        st_wt4(aff + ((size_t)b * NE + (lane & 15)) * T + t, __float_as_uint(ex / den));
        moe_cvt_finish(cdesc, cvv, cscr, lane);
    }
#undef RT_LOAD
    asm volatile("s_waitcnt vmcnt(0)" ::: "memory"); __syncthreads();
    if (tid == 0) __hip_atomic_fetch_add((unsigned*)(a.ws + WS_BAR + 14336) + 64 * b + 8, 1u, __ATOMIC_RELAXED, __HIP_MEMORY_SCOPE_AGENT);
}

__device__ __forceinline__ void topk_item(const Args& a, LAS uchar* lds, int b, int e, int tid, int wid, int lane) {
    LAS unsigned* key = (LAS unsigned*)lds;
    LAS unsigned* hist = key + 4096;
    LAS unsigned* ctl = hist + 256;
    LAS unsigned* wsum = ctl + 8;
    const float* affp = (const float*)(a.ws + WS_AFF) + ((size_t)b * NE + e) * T;
    unsigned kv[8];
    { const u32x4 k0 = *(const u32x4*)(affp + tid * 8), k1 = *(const u32x4*)(affp + tid * 8 + 4); kv[0] = k0.x; kv[1] = k0.y; kv[2] = k0.z; kv[3] = k0.w; kv[4] = k1.x; kv[5] = k1.y; kv[6] = k1.z; kv[7] = k1.w; }
    unsigned prefix = 0u, mask = 0u, need = CAP;
    for (int shift = 24; shift >= 0; shift -= 8) {
        if (tid < 256) hist[tid] = 0u;
        __syncthreads();
#pragma unroll
        for (int j = 0; j < 8; ++j) if ((kv[j] & mask) == prefix) __hip_atomic_fetch_add(&hist[(kv[j] >> shift) & 255u], 1u, __ATOMIC_RELAXED, __HIP_MEMORY_SCOPE_WORKGROUP);
        __syncthreads();
        if (tid < 256) { unsigned above = 0u; for (int bb = tid + 1; bb < 256; ++bb) above += hist[bb]; const unsigned mine = hist[tid];
            if (above < need && need <= above + mine) { ctl[0] = (unsigned)tid; ctl[1] = need - above; } }
        __syncthreads();
        prefix |= ctl[0] << shift; mask |= 255u << shift; need = ctl[1];
        __syncthreads();
    }
    unsigned cg_ = 0u, ce_ = 0u;
#pragma unroll
    for (int j = 0; j < 8; ++j) { cg_ += kv[j] > prefix; ce_ += kv[j] == prefix; }
    unsigned pk = cg_ | (ce_ << 16), incl = pk;
#pragma unroll
    for (int o = 1; o < 64; o <<= 1) { const unsigned t2 = __shfl_up(incl, o); if (lane >= o) incl += t2; }
    if (lane == 63) wsum[wid] = incl;
    __syncthreads();
    unsigned base = 0u;
    for (int w = 0; w < wid; ++w) base += wsum[w];
    unsigned excl = base + incl - pk; unsigned ng = excl & 0xffffu, neq = excl >> 16;
    int* seltok = (int*)(a.ws + WS_SELTOK); float* selgate = (float*)(a.ws + WS_SELGATE); short* pos = (short*)(a.ws + WS_POS);
#pragma unroll
    for (int j = 0; j < 8; ++j) { const int t = tid * 8 + j; const bool gt = kv[j] > prefix, eq = kv[j] == prefix; const bool sel = gt || (eq && neq < need);
        int slot = -1;
        if (sel) slot = (int)(ng + (neq < need ? neq : need));
        if (sel) { seltok[e * 4096 + b * 512 + slot] = b * T + t; selgate[e * 4096 + b * 512 + slot] = __uint_as_float(kv[j]); }
        pos[((size_t)b * T + t) * 16 + e] = (short)slot;
        ng += gt; neq += eq; }
    __syncthreads();
}
__device__ __forceinline__ void phase_topk_cvt(const Args& a, LAS uchar* lds, int bid, int G, int tid, int wid, int lane) {
    if (bid < 128) {
        const int b = bid / 16; const unsigned* c7 = (const unsigned*)(a.ws + WS_BAR + 14336) + 64 * b + 8;
        if (tid == 0) { unsigned sp = 0; while (__hip_atomic_load(c7, __ATOMIC_RELAXED, __HIP_MEMORY_SCOPE_AGENT) < 32u && ++sp < (1u << 22)) __builtin_amdgcn_s_sleep(2);
            __builtin_amdgcn_fence(__ATOMIC_ACQUIRE, "agent"); asm volatile("s_waitcnt vmcnt(0)" ::: "memory"); }
        __syncthreads();
        topk_item(a, lds, b, bid % 16, tid, wid, lane);
    }
    LAS float* scr = (LAS float*)(lds + 32768) + wid * (64 * 33);
    static_assert(49152 - 8192 == 1024 * 18 + 1024 * 22, "item split");
    const bool tk = bid < 128; const int wi = (tk ? bid : bid - 128) * 8 + wid;
    moe_cvt_run(a, 8192 + (tk ? 1024 * 22 : 0), wi, 0, tk ? 18 : 22, scr, lane);
    __syncthreads();
}

__device__ __forceinline__ void phase_final(const Args& a, int bid, int G, int wid, int lane) {
    const float* modf = (const float*)(a.ws + WS_MODF); const short* pos = (const short*)(a.ws + WS_POS); const uchar* ys = a.ws + WS_YS;
    const bf16_t* x1b = (const bf16_t*)(a.ws + WS_X1B);
    f32x4 nf[4];
#pragma unroll
    for (int q = 0; q < 4; ++q) nf[q] = *(const f32x4*)(a.norm_final + (q >> 1) * 512 + 8 * lane + (q & 1) * 4);
    const int stride = G * 8;
#define FIN_SLOT(ROW) (((ROW) < M && lane < 16) ? (int)pos[(size_t)(ROW) * 16 + lane] : -1)
#define FIN_ISSUE(ROW, SLOTV, XW, W, EE, SL, REST, G2) do { const int _b = (ROW) / T; const bf16_t* _x = x1b + (size_t)(ROW) * D; \
        _Pragma("unroll") for (int _q = 0; _q < 4; ++_q) G2[_q] = *(const f32x4*)(modf + (size_t)_b * NMOD + 5 * D + (_q >> 1) * 512 + 8 * lane + (_q & 1) * 4); \
        XW[0] = __builtin_nontemporal_load((const u32x4*)(_x + 8 * lane)); XW[1] = __builtin_nontemporal_load((const u32x4*)(_x + 512 + 8 * lane)); \
        unsigned long long _m = __ballot((SLOTV) >= 0); \
        _Pragma("unroll") for (int _k = 0; _k < 4; ++_k) { if (_m) { EE[_k] = __builtin_ctzll(_m); _m &= _m - 1; SL[_k] = __shfl((SLOTV), EE[_k]); } else { EE[_k] = -1; SL[_k] = 0; } } \
        REST = _m; \
        _Pragma("unroll") for (int _k = 0; _k < 4; ++_k) if (EE[_k] >= 0) { const uchar* _yr = ys + ((size_t)EE[_k] * 4096 + _b * 512 + SL[_k]) * D + 8 * lane; \
            W[_k][0] = __builtin_nontemporal_load((const u32x2*)_yr); W[_k][1] = __builtin_nontemporal_load((const u32x2*)(_yr + 512)); } } while (0)
#define FIN_ACC(WW, HF) do { const f32x2 _p0 = __builtin_amdgcn_cvt_pk_f32_fp8((WW).x, false), _p1 = __builtin_amdgcn_cvt_pk_f32_fp8((WW).x, true), _p2 = __builtin_amdgcn_cvt_pk_f32_fp8((WW).y, false), _p3 = __builtin_amdgcn_cvt_pk_f32_fp8((WW).y, true); \
        acc[2 * (HF)].x += _p0.x; acc[2 * (HF)].y += _p0.y; acc[2 * (HF)].z += _p1.x; acc[2 * (HF)].w += _p1.y; \
        acc[2 * (HF) + 1].x += _p2.x; acc[2 * (HF) + 1].y += _p2.y; acc[2 * (HF) + 1].z += _p3.x; acc[2 * (HF) + 1].w += _p3.y; } while (0)
    int row = bid * 8 + wid;
    f32x4 g2C[4], g2N[4]; u32x4 xwC[2], xwN[2]; u32x2 wC[4][2], wN[4][2]; int eeC[4], slC[4], eeN[4], slN[4]; unsigned long long restC = 0ull, restN = 0ull;
    int slotC = FIN_SLOT(row), slotB = FIN_SLOT(row + stride);
    FIN_ISSUE(row, slotC, xwC, wC, eeC, slC, restC, g2C);
    for (; row < M; row += stride) {
        const int nrow = row + stride;
        const int slotN2 = FIN_SLOT(row + 2 * stride);
        if (nrow < M) FIN_ISSUE(nrow, slotB, xwN, wN, eeN, slN, restN, g2N);
        const int b = row / T; float* xrow = a.out + (size_t)row * D;
        f32x4 v[4], acc[4];
#pragma unroll
        for (int hf = 0; hf < 2; ++hf) { const u32x4 xw = xwC[hf];
            v[2 * hf] = (f32x4){bf_lo(xw.x), bf_hi(xw.x), bf_lo(xw.y), bf_hi(xw.y)}; v[2 * hf + 1] = (f32x4){bf_lo(xw.z), bf_hi(xw.z), bf_lo(xw.w), bf_hi(xw.w)}; acc[2 * hf] = (f32x4){0.f, 0.f, 0.f, 0.f}; acc[2 * hf + 1] = (f32x4){0.f, 0.f, 0.f, 0.f}; }
#pragma unroll
        for (int k = 0; k < 4; ++k) if (eeC[k] >= 0) { FIN_ACC(wC[k][0], 0); FIN_ACC(wC[k][1], 1); }
        while (restC) {
            const int e = __builtin_ctzll(restC); restC &= restC - 1; const int sl = __shfl(slotC, e);
            const uchar* yr = ys + ((size_t)e * 4096 + b * 512 + sl) * D + 8 * lane;
            const u32x2 w0 = *(const u32x2*)yr, w1 = *(const u32x2*)(yr + 512);
            FIN_ACC(w0, 0); FIN_ACC(w1, 1); }
        float ss = 0.f;
#pragma unroll
        for (int q = 0; q < 4; ++q) { v[q] = v[q] + g2C[q] * acc[q] * 0.0625f;
            ss += (v[q].x * v[q].x + v[q].y * v[q].y) + (v[q].z * v[q].z + v[q].w * v[q].w); }
        const float rstd = rsqrtf(wave_sum(ss) * (1.f / D) + EPS);
#pragma unroll
        for (int q = 0; q < 4; ++q) __builtin_nontemporal_store(v[q] * rstd * nf[q], (f32x4*)(xrow + (q >> 1) * 512 + 8 * lane + (q & 1) * 4));
        xwC[0] = xwN[0]; xwC[1] = xwN[1]; restC = restN; slotC = slotB; slotB = slotN2;
#pragma unroll
        for (int q = 0; q < 4; ++q) g2C[q] = g2N[q];
#pragma unroll
        for (int k = 0; k < 4; ++k) { wC[k][0] = wN[k][0]; wC[k][1] = wN[k][1]; eeC[k] = eeN[k]; slC[k] = slN[k]; }
    }
#undef FIN_SLOT
#undef FIN_ISSUE
#undef FIN_ACC
}

__global__ void __launch_bounds__(512, 2) mega_fwd(Args a) {
    extern __shared__ __attribute__((aligned(16))) uchar lds_raw[];
    LAS uchar* lds = (LAS uchar*)lds_raw;
    const int tid = threadIdx.x, lane = tid & 63, wid = __builtin_amdgcn_readfirstlane(tid >> 6), bid = blockIdx.x, G = gridDim.x;
    const int lo = a.ph_lo, hi = a.ph_hi;
    uchar* ws = a.ws;
#define IN(k) (lo <= (k) && (k) < hi)
#define SEAM(k) do { if (IN(k) && IN((k) + 1)) xcd_barrier(xbar); } while (0)
#define SEAM_NR(k) do { if (IN(k) && IN((k) + 1)) xcd_barrier<false>(xbar); } while (0)
    if (tid < 2) ((volatile LAS unsigned*)(lds + (LDS_BYTES - 16)))[tid] = 0u;
    __syncthreads();
    XcdBarrier xbar = xcd_barrier_post((unsigned*)(ws + WS_BAR), (volatile LAS unsigned*)(lds + (LDS_BYTES - 16)));
    if (IN(0)) phase_prep(a, lds, bid, G, tid, wid, lane);
    SEAM(0);
    if (IN(1)) phase_norm(a, lds, bid, G, tid, wid, lane);
    SEAM_NR(1);
    if (IN(2)) {
        {
            pg8::Gemm g{(const bf16_t*)(ws + WS_ACT), (const bf16_t*)(ws + WS_WIN), D, 0, nullptr};
            pg8::GroupOrder S; S.init(M / 256, NIN / 256, 1, G, bid);
            pg8::EpiInproj E{ws + WS_ZQ, nullptr, (_Float16*)(ws + WS_LF), (_Float16*)(ws + WS_LBW), (const float*)(ws + WS_LB), 0, T};
            pg8::gemm_phase<pg8::EpiInproj, false>(lds, g, S, E);
        }
    }
    SEAM(2);
    if (IN(3)) {
        unsigned* cnt = (unsigned*)(ws + WS_BAR + 14336);
        if (bid >= 192 && bid < 240) {
            pg8::Gemm g{(const bf16_t*)(ws + WS_HC), (const bf16_t*)(ws + WS_WIN) + (size_t)512 * D, D, 0, nullptr};
            pg8::GroupOrder S; S.init(MC / 256, 1536 / 256, 1, 48, bid - 192);
            pg8::EpiInproj E{nullptr, (bf16_t*)(ws + WS_CI), (_Float16*)(ws + WS_CLF), (_Float16*)(ws + WS_CLB), (const float*)(ws + WS_LB), 1, CT};
            pg8::gemm_phase<pg8::EpiInproj, false>(lds, g, S, E);
            pg8::Unit u; S.next(0, u);
            asm volatile("s_waitcnt vmcnt(0)" ::: "memory"); __syncthreads();
            if (tid == 0) { __builtin_amdgcn_fence(__ATOMIC_RELEASE, "agent"); asm volatile("s_waitcnt vmcnt(0)" ::: "memory");
                __hip_atomic_fetch_add(cnt + 64 * u.pm, 1u, __ATOMIC_RELAXED, __HIP_MEMORY_SCOPE_AGENT); }
        }
        if (bid >= 192) {
            const int b = (bid - 192) >> 3;
            if (tid == 0) { unsigned sp = 0; while (__hip_atomic_load(cnt + 64 * b, __ATOMIC_RELAXED, __HIP_MEMORY_SCOPE_AGENT) < 6u && ++sp < (1u << 22)) __builtin_amdgcn_s_sleep(2);
                __builtin_amdgcn_fence(__ATOMIC_ACQUIRE, "agent"); asm volatile("s_waitcnt vmcnt(0)" ::: "memory"); }
            __syncthreads();
        }
        phase_gla_states(a, lds, bid, wid, lane);
    }
    SEAM(3);
    if (IN(4)) phase_gla_out(a, lds, bid, wid, lane);
    SEAM(4);
    if (IN(5)) phase_mixfin(a, bid, G, wid, lane);
    SEAM_NR(5);
    if (IN(6)) {
        pg8::Gemm g{(const bf16_t*)(ws + WS_ACT), (const bf16_t*)(ws + WS_WOUT), D, 0, nullptr};
        pg8::GroupOrder S; S.init(M / 256, D / 256, 1, G, bid);
        pg8::EpiOut E{a.x, (bf16_t*)(ws + WS_X1B), (const float*)(ws + WS_MODF)};
        pg8::gemm_phase<pg8::EpiOut, false>(lds, g, S, E);
    }
    SEAM_NR(6);
    if (IN(7)) phase_router(a, lds, bid, tid, wid, lane);
    if (IN(8)) phase_topk_cvt(a, lds, bid, G, tid, wid, lane);
    SEAM(8);
    if (IN(9)) {
        pg8::Gemm g{(const bf16_t*)(ws + WS_ACT), (const bf16_t*)(ws + WS_WGU), D / 2, (size_t)4096 * D, (const int*)(ws + WS_SELTOK)};
        pg8::Moe1Order S{bid};
        pg8::EpiMoe1 E{ws + WS_HID};
        pg8::gemm_phase<pg8::EpiMoe1, true, pg8::Moe1Order, true>(lds, g, S, E);
    }
    SEAM(9);
    if (IN(10)) {
        pg8::Gemm g{(const bf16_t*)(ws + WS_HID), (const bf16_t*)(ws + WS_WDN), DFF / 2, (size_t)D * DFF, nullptr};
        pg8::Moe2Order S{bid};
        LAS float* lg = (LAS float*)(lds + pg8::STAGE_BYTES);
        { float gvv[4];
#pragma unroll
          for (int uu = 0; uu < 4; ++uu) { pg8::Unit tu; const bool ok = S.next(uu, tu); gvv[uu] = (ok && tid < 256) ? ((const float*)(ws + WS_SELGATE))[tu.pm * 256 + tid] : 0.f; }
#pragma unroll
          for (int uu = 0; uu < 4; ++uu) if (tid < 256) lg[uu * 256 + tid] = gvv[uu]; }
        __syncthreads();
        pg8::EpiMoe2 E{ws + WS_YS, lg};
        pg8::gemm_phase<pg8::EpiMoe2, false, pg8::Moe2Order, true>(lds, g, S, E);
    }
    SEAM(10);
    if (IN(11)) phase_final(a, bid, G, wid, lane);

#undef IN
#undef SEAM
}

#ifndef N_LAUNCHES
#define N_LAUNCHES 1
#endif
extern "C" void kernel_launch(void* const* d_in, const int* in_sizes, int n_in, void* d_out, int out_size, void* d_ws, size_t ws_size, hipStream_t stream) {
    static int grid = 0;
    if (grid == 0) {
        if (n_in != 18 || out_size != M * D || ws_size < WS_END) { fprintf(stderr, "kernel_launch: unexpected shapes (n_in %d out %d ws %zu)\n", n_in, out_size, ws_size); grid = -1; return; }
        int dev = 0, cus = 0, per_cu = 0;
        (void)hipGetDevice(&dev); (void)hipDeviceGetAttribute(&cus, hipDeviceAttributeMultiprocessorCount, dev);
        (void)hipFuncSetAttribute((const void*)mega_fwd, hipFuncAttributeMaxDynamicSharedMemorySize, LDS_BYTES);
        (void)hipOccupancyMaxActiveBlocksPerMultiprocessor(&per_cu, (const void*)mega_fwd, 512, LDS_BYTES);
        if (per_cu < 1) { fprintf(stderr, "kernel_launch: occupancy query says %d blocks per CU\n", per_cu); grid = -1; return; }
        grid = 256;
        if (cus != 256) fprintf(stderr, "kernel_launch: note: %d CUs (built for 256)\n", cus);
    }
    if (grid < 0) return;
    Args a{};
    a.x = (const float*)d_in[0]; a.c = (const float*)d_in[1]; a.ctx = (const float*)d_in[2]; a.c_ctx = (const float*)d_in[3]; a.w_ada = (const float*)d_in[4]; a.b_ada = (const float*)d_in[5];
    a.norm_mix = (const float*)d_in[6]; a.norm_ffn = (const float*)d_in[7]; a.w_in = (const float*)d_in[8]; a.lb_logits = (const float*)d_in[9]; a.hg_norm = (const float*)d_in[10];
    a.conv_w = (const float*)d_in[11]; a.w_out = (const float*)d_in[12]; a.w_router = (const float*)d_in[13]; a.w_gate = (const float*)d_in[14]; a.w_up = (const float*)d_in[15];
    a.w_down = (const float*)d_in[16]; a.norm_final = (const float*)d_in[17]; a.out = (float*)d_out; a.ws = (uchar*)d_ws;
    if (N_LAUNCHES == 1) {
        (void)hipMemsetAsync((char*)d_ws + WS_BAR, 0, 16384, stream);
        a.ph_lo = 0; a.ph_hi = NPHASE;
        hipLaunchKernelGGL(mega_fwd, dim3(grid), dim3(512), LDS_BYTES, stream, a);
    } else {
        for (int p = 0; p < NPHASE; ++p) { a.ph_lo = p; a.ph_hi = p + 1; void* args[] = {&a};
            hipError_t e = hipLaunchCooperativeKernel((const void*)mega_fwd, dim3(grid), dim3(512), args, LDS_BYTES, stream);
            if (e != hipSuccess) { fprintf(stderr, "launch %d failed: %s\n", p, hipGetErrorString(e)); break; } }
    }
}
```

```cpp
#include <hip/hip_runtime.h>
#include <cstdio>

#define LAS __attribute__((address_space(3)))
#define GAS __attribute__((address_space(1)))
typedef unsigned short bf16_t;
typedef short bf16x8 __attribute__((ext_vector_type(8)));
typedef float f32x4 __attribute__((ext_vector_type(4)));
typedef float f32x2 __attribute__((ext_vector_type(2)));
typedef unsigned u32x4 __attribute__((ext_vector_type(4)));
typedef unsigned u32x2 __attribute__((ext_vector_type(2)));
typedef unsigned char uchar;
typedef int i32x8 __attribute__((ext_vector_type(8)));
typedef int i32x4 __attribute__((ext_vector_type(4)));

constexpr int D = 1024, NB = 8, T = 4096, M = NB * T, CT = 256, MC = NB * CT;
constexpr int NIN = 4096, HK = 512, NH = 4, NE = 16, CAP = 512, DFF = 2048, NMOD = 6 * D;
constexpr float EPS = 1e-6f;
constexpr int NPHASE = 12;

constexpr size_t MiB = 1u << 20;
constexpr size_t WS_ACT = 0;
constexpr size_t WS_WIN = 64 * MiB;
constexpr size_t WS_WOUT = 72 * MiB;
constexpr size_t WS_MODP = 74 * MiB;
constexpr size_t WS_MODF = 76 * MiB;
constexpr size_t WS_LB = 76 * MiB + 512 * 1024;
constexpr size_t WS_HC = 77 * MiB;
constexpr size_t WS_CLF = 81 * MiB;
constexpr size_t WS_CLB = 85 * MiB;
constexpr size_t WS_CI = 89 * MiB;
constexpr size_t WS_S0 = 91 * MiB;
constexpr size_t WS_AFF = 95 * MiB;
constexpr size_t WS_SELTOK = 97 * MiB;
constexpr size_t WS_SELGATE = 97 * MiB + 256 * 1024;
constexpr size_t WS_POS = 98 * MiB;
constexpr size_t WS_BAR = 100 * MiB;
constexpr size_t WS_SL = 488 * MiB;
constexpr size_t WS_DL = 500 * MiB;
constexpr size_t WS_ZQ = 104 * MiB;
constexpr size_t WS_LF = 136 * MiB;
constexpr size_t WS_LBW = 200 * MiB;
constexpr size_t WS_ZI = 264 * MiB;
constexpr size_t WS_ZG = 296 * MiB;
constexpr size_t WS_ZGB = 328 * MiB;
constexpr size_t WS_ZGC = 360 * MiB;
constexpr size_t WS_ZV = 392 * MiB;
constexpr size_t WS_OF = 424 * MiB;
constexpr size_t WS_OB = 456 * MiB;
constexpr size_t WS_WGU = 104 * MiB;
constexpr size_t WS_WDN = 232 * MiB;
constexpr size_t WS_HID = 296 * MiB;
constexpr size_t WS_YS = WS_WGU;
constexpr size_t WS_X1B = 424 * MiB;
constexpr size_t WS_END = 552 * MiB;
static_assert(WS_ZI == WS_ZQ + 160 * MiB && WS_ZG == WS_ZI + 32 * MiB && WS_ZGB == WS_ZG + 32 * MiB && WS_ZGC == WS_ZGB + 32 * MiB && WS_ZV == WS_ZGC + 32 * MiB, "z segment map");

constexpr int LDS_BYTES = 147456;

typedef __bf16 bf16x2_t __attribute__((ext_vector_type(2)));
__device__ __forceinline__ unsigned cvt_pk_bf16_safe(float lo, float hi) { typedef float f2_t __attribute__((ext_vector_type(2))); const bf16x2_t v = __builtin_convertvector((f2_t){lo, hi}, bf16x2_t); return __builtin_bit_cast(unsigned, v); }
__device__ __forceinline__ unsigned cvt_pk_bf16(float lo, float hi) { unsigned r; asm volatile("v_cvt_pk_bf16_f32 %0, %1, %2" : "=v"(r) : "v"(lo), "v"(hi)); return r; }
__device__ __forceinline__ unsigned cvt_pk4_fp8(float a, float b, float c, float d) { unsigned r = 0u; asm volatile("v_cvt_pk_fp8_f32 %0, %1, %2\n\tv_cvt_pk_fp8_f32 %0, %3, %4 op_sel:[0,0,1]" : "+v"(r) : "v"(a), "v"(b), "v"(c), "v"(d)); return r; }
__device__ __forceinline__ void st_wt8(void* p, u32x2 v) { asm volatile("global_store_dwordx2 %0, %1, off sc1\n\ts_nop 2" :: "v"(p), "v"(v) : "memory"); }
__device__ __forceinline__ void st_wt4(void* p, unsigned v) { asm volatile("global_store_dword %0, %1, off sc1\n\ts_nop 2" :: "v"(p), "v"(v) : "memory"); }
__device__ __forceinline__ void st_wt16(void* p, u32x4 v) { asm volatile("global_store_dwordx4 %0, %1, off sc1\n\ts_nop 2" :: "v"(p), "v"(v) : "memory"); }
__device__ __forceinline__ float bf_lo(unsigned u) { return __uint_as_float(u << 16); }
__device__ __forceinline__ float bf_hi(unsigned u) { return __uint_as_float(u & 0xffff0000u); }
__device__ __forceinline__ float wave_sum(float v) {
#pragma unroll
    for (int o = 1; o < 64; o <<= 1) v += __shfl_xor(v, o);
    return v;
}
__device__ __forceinline__ float silu_f(float x) { return x * __builtin_amdgcn_rcpf(1.f + __builtin_amdgcn_exp2f(x * -1.44269504f)); }
#define LDS_WAIT() asm volatile("s_waitcnt lgkmcnt(0)" ::: "memory")


#define XB_TMO      128
#define XB_XCNT(j)  (256  + 64 * (j))
#define XB_XSUB(j)  (1280 + 64 * (j))
#define XB_XGEN(j)  (2304 + 64 * (j))
#define XB_TOP      3328
#define XB_TOPGEN   3392
#define XCD_BAR_WORDS 3456
#define XB_SPIN_CAP (1u << 20)
__device__ __forceinline__ unsigned xb_ld(unsigned* p)              { return __hip_atomic_load(p, __ATOMIC_RELAXED, __HIP_MEMORY_SCOPE_AGENT); }
__device__ __forceinline__ unsigned xb_add(unsigned* p, unsigned v) { return __hip_atomic_fetch_add(p, v, __ATOMIC_RELAXED, __HIP_MEMORY_SCOPE_AGENT); }
__device__ __forceinline__ unsigned xb_xcc_id() { return (unsigned)__builtin_amdgcn_s_getreg((3 << 11) | 20) & 0xFu; }
#define XB_SPIN(cond, bar) do { unsigned _sp = 0; while (cond) { __builtin_amdgcn_s_sleep(1); \
    if ((++_sp & 255u) == 0u) { if (xb_ld(&(bar)[XB_TMO])) break; if (_sp > XB_SPIN_CAP) { atomicAdd(&(bar)[XB_TMO], 1u); break; } } } } while (0)
struct XcdBarrier { unsigned* bar; unsigned x; volatile LAS unsigned* st; };
__device__ __forceinline__ XcdBarrier xcd_barrier_post(unsigned* bar, volatile LAS unsigned* st) {
    XcdBarrier b; b.bar = bar; b.x = xb_xcc_id(); b.st = st;
    if (threadIdx.x == 0) (void)xb_add(&bar[XB_XCNT(b.x)], 1u);
    return b;
}
__device__ __forceinline__ void xcd_barrier_complete(unsigned* bar, unsigned x, unsigned& nloc, unsigned& nx) {
    const unsigned G = gridDim.x * gridDim.y * gridDim.z;
    unsigned sum, cnt, mine, sp = 0u;
    for (;;) {
        sum = 0u; cnt = 0u; mine = 0u;
#pragma unroll
        for (unsigned j = 0; j < 16; ++j) { const unsigned c = xb_ld(&bar[XB_XCNT(j)]); sum += c; cnt += (c > 0u) ? 1u : 0u; mine = (j == x) ? c : mine; }
        if (sum == G) break;
        __builtin_amdgcn_s_sleep(1);
        if ((++sp & 255u) == 0u) { if (xb_ld(&bar[XB_TMO])) break; if (sp > XB_SPIN_CAP) { atomicAdd(&bar[XB_TMO], 1u); break; } }
    }
    nloc = mine > 0u ? mine : 1u; nx = cnt > 0u ? cnt : 1u;
}
template <bool REL = true>
__device__ __forceinline__ void xcd_barrier(const XcdBarrier& b) {
    asm volatile("s_waitcnt vmcnt(0)" ::: "memory");
    __syncthreads();
    if (threadIdx.x == 0) {
        unsigned* bar = b.bar;
        __builtin_amdgcn_s_waitcnt(0);
        unsigned nloc = b.st[0], nx = b.st[1];
        if (nloc == 0u) { xcd_barrier_complete(bar, b.x, nloc, nx); b.st[0] = nloc; b.st[1] = nx; }
        const unsigned old = xb_add(&bar[XB_XSUB(b.x)], 1u);
        const unsigned gen = old / nloc;
        if (old + 1u == (gen + 1u) * nloc) {
            if (REL) __builtin_amdgcn_fence(__ATOMIC_RELEASE, "agent");
            asm volatile("buffer_inv sc1" ::: "memory");
            asm volatile("s_waitcnt vmcnt(0)" ::: "memory");
            const unsigned og = xb_add(&bar[XB_TOP], 1u);
            const unsigned tg = og / nx;
            if (og + 1u == (tg + 1u) * nx) xb_add(&bar[XB_TOPGEN], 1u);
            else XB_SPIN(xb_ld(&bar[XB_TOPGEN]) == tg, bar);
            asm volatile("" ::: "memory");
            asm volatile("s_waitcnt vmcnt(0)" ::: "memory");
        } else {
            asm volatile("buffer_inv sc1" ::: "memory");
            XB_SPIN(xb_ld(&bar[XB_TOPGEN]) == gen, bar);
            asm volatile("" ::: "memory");
            asm volatile("s_waitcnt vmcnt(0)" ::: "memory");
        }
    }
    __syncthreads();
}

namespace pg8 {
constexpr int BM = 256, BK = 64, HALF = 128, HTB = HALF * BK * 2, STAGE_BYTES = 8 * HTB, NXCD = 8, WGM = 8;
__device__ __forceinline__ int lds_byte(int r, int c) { const int st = (r >> 4) * 2 + (c >> 5), rr = r & 15, cc = c & 31, ob = rr * 64 + cc * 2; return st * 1024 + (ob ^ (((ob >> 9) & 1) << 5)); }
__device__ __forceinline__ void stage_rc(int b, int& R, int& C) { const int st = b / 1024, sb = b % 1024, swz = sb ^ (((sb >> 9) & 1) << 5); R = (st >> 1) * 16 + swz / 64; C = (st & 1) * 32 + (swz % 64) / 2; }
__device__ __forceinline__ int perm32(int rho) { const int n = rho >> 4, i = rho & 15; return 8 * (i >> 2) + 4 * n + (i & 3); }

struct Unit { int pm, pn, e; };
struct GroupOrder {
    int nM, nN, ng, G, c;
    __device__ __forceinline__ void init(int nM_, int nN_, int ng_, int G_, int c_) { nM = nM_; nN = nN_; ng = ng_; G = G_; c = c_; }
    __device__ __forceinline__ bool next(int i, Unit& u) const {
        const int nwg = nM * nN; const long L = (long)i * G + c; if (L >= (long)nwg * ng) return false;
        const int grp = (int)(L / nwg); int wgid = (int)(L % nwg);
        { const int q = nwg / NXCD, r = nwg % NXCD, xcd = wgid % NXCD, off = wgid / NXCD; wgid = (xcd < r ? xcd * (q + 1) : r * (q + 1) + (xcd - r) * q) + off; }
        const int nig = WGM * nN, gid = wgid / nig, fm = gid * WGM, gsz = (nM - fm) < WGM ? (nM - fm) : WGM;
        u.pm = grp * nM + fm + ((wgid % nig) % gsz); u.pn = (wgid % nig) / gsz; u.e = grp; return true;
    }
};
struct Moe2Order {
    int c;
    __device__ __forceinline__ bool next(int i, Unit& u) const { if (i >= 4) return false; const int x = c & 7, j = c >> 3; u.e = 4 * i + (x >> 1); u.pm = u.e * 16 + (x & 1) * 8 + (j >> 2); u.pn = j & 3; return true; }
};
struct Moe1Order {
    int c;
    __device__ __forceinline__ bool next(int i, Unit& u) const { if (i >= 16) return false; const int x = c & 7, j = c >> 3, s = i & 7; u.e = 2 * x + (i >> 3); u.pm = u.e * 16 + (s >> 2) * 8 + (j & 7); u.pn = (s & 3) * 4 + (j >> 3); return true; }
};
struct Gemm { const bf16_t* A; const bf16_t* Bt; int K; size_t bgs; const int* rowidx; };

template <class Epi, bool GATHER, class Sched = GroupOrder, bool FP8 = false>
__device__ __forceinline__ void gemm_phase(LAS uchar* lds, const Gemm g, const Sched& S, const Epi& E) {
    const int tid = threadIdx.x, wid = __builtin_amdgcn_readfirstlane(tid >> 6), lane = tid & 63, wr = wid >> 2, wc = wid & 3, fr = lane & 15, fq = lane >> 4;
    const int K = g.K, nt = K / BK;
    unsigned voffA[2], voffB[2]; int Rr[2], Cc[2];
#pragma unroll
    for (int i = 0; i < 2; ++i) { int R, C; stage_rc(tid * 16 + i * 8192, R, C); const int Rb = Epi::PERM16 ? (64 * (R >> 5) + 16 * ((R & 15) >> 2) + 4 * ((R >> 4) & 1) + (R & 3)) : (Epi::PERM ? ((R & ~31) + perm32(R & 31)) : R); Rr[i] = R; Cc[i] = C;
        voffA[i] = (unsigned)(R * K + C) * 2u; voffB[i] = (unsigned)(Rb * K + C) * 2u; }
    const size_t kstep = (size_t)(BK * 2);
    const size_t hstep = (size_t)HALF * K * 2;
    const size_t tstep = 2 * hstep;
    const size_t hstepB = Epi::PERM16 ? (size_t)8 * K * 2 : hstep;
    const unsigned ldsw = (unsigned)wid * 1024u;
    const int aoff = lds_byte(wr * 64 + fr, fq * 8), boff = lds_byte(wc * 32 + fr, fq * 8);
#define PG8_SA(b, h) (((b) * 2 + (h)) * HTB)
#define PG8_SB(b, h) ((4 + (b) * 2 + (h)) * HTB)
#define PG8_STAGE(bufoff, gbase, voff) do { _Pragma("unroll") for (int _i = 0; _i < 2; ++_i) \
        __builtin_amdgcn_global_load_lds((const unsigned*)((const char*)(gbase) + (voff)[_i]), (LAS unsigned*)(lds + (bufoff) + ldsw + _i * 8192), 16, 0, 0); } while (0)
#define PG8_STAGE_A(bufoff, p, ofs, h) do { if constexpr (GATHER) { PG8_STAGE(bufoff, p, (ofs)[h]); } else { PG8_STAGE(bufoff, (p) + (h) * hstep, voffA); } } while (0)
#define PG8_LD8(p) __builtin_shufflevector(*(const LAS i32x4*)(p), *(const LAS i32x4*)((p) + 1024), 0, 1, 2, 3, 4, 5, 6, 7)
#define PG8_LDA(dst, b, h) do { _Pragma("unroll") for (int m = 0; m < 4; ++m) dst[m] = PG8_LD8(lds + PG8_SA(b, h) + aoff + m * 2048); } while (0)
#define PG8_LDB(dst, b, h) do { _Pragma("unroll") for (int n = 0; n < 2; ++n) dst[n] = PG8_LD8(lds + PG8_SB(b, h) + boff + n * 2048); } while (0)
#define PG8_HALF(x, k) __builtin_bit_cast(bf16x8, (k) ? __builtin_shufflevector(x, x, 4, 5, 6, 7) : __builtin_shufflevector(x, x, 0, 1, 2, 3))
#define PG8_MMA(ai, bj, At, Bt) do { __builtin_amdgcn_s_setprio(1); _Pragma("unroll") for (int m = 0; m < 4; ++m) _Pragma("unroll") for (int n = 0; n < 2; ++n) { \
        if constexpr (FP8) acc[ai][bj][m][n] = __builtin_amdgcn_mfma_scale_f32_16x16x128_f8f6f4(Bt[n], At[m], acc[ai][bj][m][n], 0, 0, 0, 0x7a7a7a7a, 0, 0x7f7f7f7f);   \
        else { acc[ai][bj][m][n] = __builtin_amdgcn_mfma_f32_16x16x32_bf16(PG8_HALF(Bt[n], 0), PG8_HALF(At[m], 0), acc[ai][bj][m][n], 0, 0, 0); \
               acc[ai][bj][m][n] = __builtin_amdgcn_mfma_f32_16x16x32_bf16(PG8_HALF(Bt[n], 1), PG8_HALF(At[m], 1), acc[ai][bj][m][n], 0, 0, 0); } } \
        if constexpr (FP8) { _Pragma("unroll") for (int m = 0; m < 4; ++m) _Pragma("unroll") for (int n = 0; n < 2; ++n) asm volatile("" : "+v"(acc[ai][bj][m][n])); }     \
        __builtin_amdgcn_s_setprio(0); } while (0)
#define PG8_WAIT_V(n) asm volatile("s_waitcnt vmcnt(" #n ")" ::: "memory")
#define PG8_WAIT_L(n) asm volatile("s_waitcnt lgkmcnt(" #n ")" ::: "memory")
#define PG8_BAR __builtin_amdgcn_s_barrier()
#define PG8_SCHED __builtin_amdgcn_sched_barrier(0)
    Unit cur, nxt; int ui = 0;
    if (!S.next(0, cur)) return;
    f32x4 acc[2][2][4][2];
#pragma unroll
    for (int a = 0; a < 2; ++a)
#pragma unroll
        for (int b = 0; b < 2; ++b)
#pragma unroll
            for (int m = 0; m < 4; ++m)
#pragma unroll
                for (int n = 0; n < 2; ++n) acc[a][b][m][n] = (f32x4){0.f, 0.f, 0.f, 0.f};
    i32x8 At[4], B0[2], B1[2];
    unsigned cofs[2][2], nofs[2][2];
    LAS unsigned short* ridx = (LAS unsigned short*)(lds + STAGE_BYTES);
    if constexpr (GATHER) {
        { int rv[16];
#pragma unroll
          for (int uu = 0; uu < 16; ++uu) { Unit tu; const bool ok = S.next(uu, tu); rv[uu] = (ok && tid < BM) ? g.rowidx[tu.pm * BM + tid] : 0; }
#pragma unroll
          for (int uu = 0; uu < 16; ++uu) if (tid < BM) ridx[uu * BM + tid] = (unsigned short)rv[uu]; }
        asm volatile("s_waitcnt vmcnt(0) lgkmcnt(0)" ::: "memory"); __builtin_amdgcn_s_barrier(); asm volatile("" ::: "memory");
#pragma unroll
        for (int h = 0; h < 2; ++h)
#pragma unroll
            for (int i = 0; i < 2; ++i) { const int row = ridx[h * HALF + Rr[i]]; cofs[h][i] = (unsigned)(row * K + Cc[i]) * 2u; nofs[h][i] = cofs[h][i]; }
    }
    const char* cA = GATHER ? (const char*)g.A : (const char*)g.A + (size_t)cur.pm * tstep;
    const char* cB = (const char*)g.Bt + (size_t)cur.e * g.bgs + (size_t)cur.pn * tstep;
    PG8_STAGE(PG8_SB(0, 0), cB, voffB); PG8_STAGE(PG8_SB(0, 1), cB + hstepB, voffB); PG8_STAGE_A(PG8_SA(0, 0), cA, cofs, 0); PG8_STAGE_A(PG8_SA(0, 1), cA, cofs, 1);
    if (wr == 1) PG8_BAR;
    PG8_WAIT_V(2); PG8_BAR;
    PG8_STAGE(PG8_SB(1, 0), cB + kstep, voffB); PG8_STAGE_A(PG8_SA(1, 0), cA + kstep, cofs, 0); PG8_STAGE(PG8_SB(1, 1), cB + hstepB + kstep, voffB);
    PG8_WAIT_V(6); PG8_BAR;
    for (;;) {
        const bool has_next = S.next(ui + 1, nxt);
        const char* nA = GATHER ? (const char*)g.A : (has_next ? (const char*)g.A + (size_t)nxt.pm * tstep : cA);
        const char* nB = has_next ? (const char*)g.Bt + (size_t)nxt.e * g.bgs + (size_t)nxt.pn * tstep : cB;
#pragma unroll 1
        for (int t = 0; t < nt; t += 2) {
            const bool last = (t == nt - 2);
            const char* a1 = cA + (size_t)(t + 1) * kstep;
            const char* a2 = last ? nA : cA + (size_t)(t + 2) * kstep; const char* b2 = last ? nB : cB + (size_t)(t + 2) * kstep;
            const char* a3 = a2 + kstep; const char* b3 = b2 + kstep;
            if constexpr (GATHER) {
                if (last && has_next) {
#pragma unroll
                    for (int h = 0; h < 2; ++h)
#pragma unroll
                        for (int i = 0; i < 2; ++i) { const int row = ridx[(ui + 1) * BM + h * HALF + Rr[i]]; nofs[h][i] = (unsigned)(row * K + Cc[i]) * 2u; }
                }
            }
            PG8_LDB(B0, 0, 0); PG8_LDB(B1, 0, 1); PG8_SCHED; PG8_LDA(At, 0, 0); PG8_STAGE_A(PG8_SA(1, 1), a1, cofs, 1);
            PG8_WAIT_V(8); PG8_WAIT_L(0); PG8_BAR; PG8_MMA(0, 0, At, B0); PG8_MMA(0, 1, At, B1); PG8_BAR; PG8_SCHED;
            PG8_LDA(At, 0, 1); PG8_STAGE(PG8_SB(0, 0), b2, voffB); PG8_STAGE(PG8_SB(0, 1), b2 + hstepB, voffB);
            if (last) { PG8_STAGE_A(PG8_SA(0, 0), a2, nofs, 0); } else { PG8_STAGE_A(PG8_SA(0, 0), a2, cofs, 0); }
            PG8_WAIT_V(8); PG8_WAIT_L(0); PG8_BAR; PG8_MMA(1, 0, At, B0); PG8_MMA(1, 1, At, B1); PG8_BAR; PG8_SCHED;
            PG8_LDB(B0, 1, 0); PG8_LDB(B1, 1, 1); PG8_SCHED; PG8_LDA(At, 1, 0);
            if (last) { PG8_STAGE_A(PG8_SA(0, 1), a2, nofs, 1); } else { PG8_STAGE_A(PG8_SA(0, 1), a2, cofs, 1); }
            PG8_WAIT_V(8); PG8_WAIT_L(0); PG8_BAR; PG8_MMA(0, 0, At, B0); PG8_MMA(0, 1, At, B1); PG8_BAR; PG8_SCHED;
            PG8_LDA(At, 1, 1); PG8_STAGE(PG8_SB(1, 0), b3, voffB); PG8_STAGE(PG8_SB(1, 1), b3 + hstepB, voffB);
            if (last) { PG8_STAGE_A(PG8_SA(1, 0), a3, nofs, 0); } else { PG8_STAGE_A(PG8_SA(1, 0), a3, cofs, 0); }
            PG8_WAIT_V(8); PG8_WAIT_L(0); PG8_BAR; PG8_MMA(1, 0, At, B0); PG8_MMA(1, 1, At, B1); PG8_BAR; PG8_SCHED;
        }
        if (wr == 0) PG8_BAR;
        E(acc, cur, wr, wc, fr, fq);
        if (!has_next) break;
#pragma unroll
        for (int a = 0; a < 2; ++a)
#pragma unroll
            for (int b = 0; b < 2; ++b)
#pragma unroll
                for (int m = 0; m < 4; ++m)
#pragma unroll
                    for (int n = 0; n < 2; ++n) { f32x2 z0, z1; asm volatile("v_mov_b64 %0, 0" : "=v"(z0)); asm volatile("v_mov_b64 %0, 0" : "=v"(z1)); acc[a][b][m][n] = __builtin_shufflevector(z0, z1, 0, 1, 2, 3); }
        cur = nxt; cA = nA; cB = nB; ++ui;
        if constexpr (GATHER) {
#pragma unroll
            for (int h = 0; h < 2; ++h)
#pragma unroll
                for (int i = 0; i < 2; ++i) cofs[h][i] = nofs[h][i];
        }
        if (wr == 1) PG8_BAR;
    }
    PG8_WAIT_V(0);
    PG8_BAR;
#undef PG8_SA
#undef PG8_SB
#undef PG8_STAGE
#undef PG8_STAGE_A
#undef PG8_LD8
#undef PG8_HALF
#undef PG8_LDA
#undef PG8_LDB
#undef PG8_MMA
#undef PG8_WAIT_V
#undef PG8_WAIT_L
#undef PG8_BAR
#undef PG8_SCHED
}


struct EpiInproj {
    static constexpr bool PERM = true, PERM16 = false;
    uchar* zbase; bf16_t* ci; _Float16* olog0; _Float16* olog1; const float* lb; int seg0; int Tn;
    __device__ __forceinline__ void operator()(const f32x4 (&acc)[2][2][4][2], const Unit& u, int wr, int wc, int fr, int fq) const {
        const int seg = seg0 + (u.pn >> 1);
        const int row0 = u.pm * BM + wr * 64 + fr;
        if (seg <= 3) {
            const int b = (u.pm * BM) / Tn, t0 = row0 - b * Tn, dcol = wc * 32 + 8 * fq;
#pragma unroll
            for (int bj = 0; bj < 2; ++bj) { const int hh = (u.pn & 1) * 2 + bj; const size_t plane = (size_t)(b * NH + hh) * Tn;
                if (seg == 1 || seg == 2) {
                    _Float16* O = (seg == 1) ? olog0 : olog1; const float* lbp = lb + (seg - 1) * 512 + hh * 128 + dcol;
                    const f32x4 l0 = *(const f32x4*)lbp, l1 = *(const f32x4*)(lbp + 4);
#pragma unroll
                    for (int ai = 0; ai < 2; ++ai)
#pragma unroll
                        for (int m = 0; m < 4; ++m) { const f32x4 v0 = acc[ai][bj][m][0], v1 = acc[ai][bj][m][1]; _Float16 o[8];
#pragma unroll
                            for (int j = 0; j < 4; ++j) { const float s0 = __builtin_amdgcn_rcpf(1.f + __builtin_amdgcn_exp2f(v0[j] * -1.44269504f)), s1 = __builtin_amdgcn_rcpf(1.f + __builtin_amdgcn_exp2f(v1[j] * -1.44269504f));
                                o[j] = (_Float16)__builtin_amdgcn_logf(l0[j] + (1.f - l0[j]) * s0); o[4 + j] = (_Float16)__builtin_amdgcn_logf(l1[j] + (1.f - l1[j]) * s1); }
                            __builtin_nontemporal_store(__builtin_bit_cast(u32x4, o), (u32x4*)(O + (plane + t0 + ai * HALF + m * 16) * 128 + dcol)); }
                } else {
                    bf16_t* O = zbase ? (bf16_t*)(zbase + (size_t)(seg == 0 ? 0 : 160) * MiB) : ci;
#pragma unroll
                    for (int ai = 0; ai < 2; ++ai)
#pragma unroll
                        for (int m = 0; m < 4; ++m) { const f32x4 v0 = acc[ai][bj][m][0], v1 = acc[ai][bj][m][1];
                            u32x4 w; w.x = cvt_pk_bf16(v0[0], v0[1]); w.y = cvt_pk_bf16(v0[2], v0[3]); w.z = cvt_pk_bf16(v1[0], v1[1]); w.w = cvt_pk_bf16(v1[2], v1[3]);
                            __builtin_nontemporal_store(w, (u32x4*)(O + (plane + t0 + ai * HALF + m * 16) * 128 + dcol)); }
                }
            }
        } else if (seg >= 6) {
            const int col0 = (u.pn - 12) * 128 + wc * 32 + 8 * fq;
            bf16_t* O = (bf16_t*)(zbase + (size_t)(32 * 6 + 64) * MiB);
#pragma unroll
            for (int ai = 0; ai < 2; ++ai)
#pragma unroll
                for (int m = 0; m < 4; ++m) { const f32x4 v0 = acc[ai][0][m][0] * acc[ai][1][m][0], v1 = acc[ai][0][m][1] * acc[ai][1][m][1];
                    u32x4 w; w.x = cvt_pk_bf16(v0[0], v0[1]); w.y = cvt_pk_bf16(v0[2], v0[3]); w.z = cvt_pk_bf16(v1[0], v1[1]); w.w = cvt_pk_bf16(v1[2], v1[3]);
                    __builtin_nontemporal_store(w, (u32x4*)(O + (size_t)(row0 + ai * HALF + m * 16) * 512 + col0)); }
        } else {
            const int col0 = (u.pn & 1) * 256 + wc * 32 + 8 * fq;
            bf16_t* O = (bf16_t*)(zbase + (size_t)(32 * seg + 64) * MiB);
#pragma unroll
            for (int ai = 0; ai < 2; ++ai)
#pragma unroll
                for (int m = 0; m < 4; ++m) { bf16_t* rowp = O + (size_t)(row0 + ai * HALF + m * 16) * 512 + col0;
#pragma unroll
                    for (int bj = 0; bj < 2; ++bj) { const f32x4 v0 = acc[ai][bj][m][0], v1 = acc[ai][bj][m][1];
                        u32x4 w; w.x = cvt_pk_bf16(v0[0], v0[1]); w.y = cvt_pk_bf16(v0[2], v0[3]); w.z = cvt_pk_bf16(v1[0], v1[1]); w.w = cvt_pk_bf16(v1[2], v1[3]);
                        __builtin_nontemporal_store(w, (u32x4*)(rowp + bj * HALF)); } }
        }
    }
};
struct EpiOut {
    static constexpr bool PERM = true, PERM16 = false;
    const float* x; bf16_t* x1; const float* modf;
    __device__ __forceinline__ void operator()(const f32x4 (&acc)[2][2][4][2], const Unit& u, int wr, int wc, int fr, int fq) const {
        const int row0 = u.pm * BM + wr * 64 + fr, col0 = u.pn * BM + wc * 32 + 8 * fq;
        const int b = (u.pm * BM) / T;
        const float* g1 = modf + (size_t)b * NMOD + 2 * D;
        f32x4 gv[2][2];
#pragma unroll
        for (int bj = 0; bj < 2; ++bj)
#pragma unroll
            for (int n = 0; n < 2; ++n) gv[bj][n] = *(const f32x4*)(g1 + col0 + bj * HALF + 4 * n);
#pragma unroll
        for (int ai = 0; ai < 2; ++ai)
#pragma unroll
            for (int m = 0; m < 4; ++m) { const size_t off = (size_t)(row0 + ai * HALF + m * 16) * D + col0;
#pragma unroll
                for (int bj = 0; bj < 2; ++bj) {
                    const f32x4 x0 = __builtin_nontemporal_load((const f32x4*)(x + off + bj * HALF)), x1v = __builtin_nontemporal_load((const f32x4*)(x + off + bj * HALF + 4));
                    const f32x4 v0 = x0 + gv[bj][0] * acc[ai][bj][m][0], v1 = x1v + gv[bj][1] * acc[ai][bj][m][1];
                    u32x4 w; w.x = cvt_pk_bf16(v0[0], v0[1]); w.y = cvt_pk_bf16(v0[2], v0[3]); w.z = cvt_pk_bf16(v1[0], v1[1]); w.w = cvt_pk_bf16(v1[2], v1[3]);
                    st_wt16(x1 + off + bj * HALF, w); }
                asm volatile("" ::: "memory"); }
    }
};
struct EpiMoe1 {
    static constexpr bool PERM = true, PERM16 = false;
    uchar* hid;
    __device__ __forceinline__ void operator()(const f32x4 (&acc)[2][2][4][2], const Unit& u, int wr, int wc, int fr, int fq) const {
        const int row0 = u.pm * BM + wr * 64 + fr, col0 = u.pn * 128 + wc * 32 + 8 * fq;
#pragma unroll
        for (int ai = 0; ai < 2; ++ai)
#pragma unroll
            for (int m = 0; m < 4; ++m) { uchar* rowp = hid + (size_t)(row0 + ai * HALF + m * 16) * DFF + col0;
                float o[8];
#pragma unroll
                for (int n = 0; n < 2; ++n)
#pragma unroll
                    for (int h = 0; h < 2; ++h) {
                        const f32x2 gt = h ? __builtin_shufflevector(acc[ai][0][m][n], acc[ai][0][m][n], 2, 3) : __builtin_shufflevector(acc[ai][0][m][n], acc[ai][0][m][n], 0, 1);
                        const f32x2 up = h ? __builtin_shufflevector(acc[ai][1][m][n], acc[ai][1][m][n], 2, 3) : __builtin_shufflevector(acc[ai][1][m][n], acc[ai][1][m][n], 0, 1);
                        const f32x2 tt = gt * -1.44269504f; const f32x2 dd = (f32x2){__builtin_amdgcn_exp2f(tt.x), __builtin_amdgcn_exp2f(tt.y)} + 1.f;
                        const f32x2 rr = (f32x2){__builtin_amdgcn_rcpf(dd.x), __builtin_amdgcn_rcpf(dd.y)}; const f32x2 oo = (gt * up) * rr; o[n * 4 + 2 * h] = oo.x; o[n * 4 + 2 * h + 1] = oo.y; }
                u32x2 w; w.x = cvt_pk4_fp8(o[0], o[1], o[2], o[3]); w.y = cvt_pk4_fp8(o[4], o[5], o[6], o[7]);
                __builtin_nontemporal_store(w, (u32x2*)rowp); }
    }
};
struct EpiMoe2 {
    static constexpr bool PERM = true, PERM16 = true;
    uchar* ys; const LAS float* lgate;
    __device__ __forceinline__ void operator()(const f32x4 (&acc)[2][2][4][2], const Unit& u, int wr, int wc, int fr, int fq) const {
        const int row0 = u.pm * BM + wr * 64 + fr, col0 = u.pn * BM + wc * 64 + 16 * fq;
        const LAS float* gt_ = lgate + (u.e >> 2) * BM + wr * 64 + fr;
#pragma unroll
        for (int ai = 0; ai < 2; ++ai)
#pragma unroll
            for (int m = 0; m < 4; ++m) { const int row = row0 + ai * HALF + m * 16; const float gt = gt_[ai * HALF + m * 16] * 16.f;
                const f32x4 v0 = acc[ai][0][m][0] * gt, v1 = acc[ai][0][m][1] * gt, v2 = acc[ai][1][m][0] * gt, v3 = acc[ai][1][m][1] * gt;
                u32x4 w; w.x = cvt_pk4_fp8(v0[0], v0[1], v0[2], v0[3]); w.y = cvt_pk4_fp8(v1[0], v1[1], v1[2], v1[3]); w.z = cvt_pk4_fp8(v2[0], v2[1], v2[2], v2[3]); w.w = cvt_pk4_fp8(v3[0], v3[1], v3[2], v3[3]);
                __builtin_nontemporal_store(w, (u32x4*)(ys + (size_t)row * D + col0)); }
    }
};
}

struct Args {
    const float *x, *c, *ctx, *c_ctx, *w_ada, *b_ada, *norm_mix, *norm_ffn, *w_in, *lb_logits, *hg_norm, *conv_w, *w_out, *w_router, *w_gate, *w_up, *w_down, *norm_final;
    float* out; uchar* ws; int ph_lo, ph_hi;
};

__device__ __forceinline__ void cvt_item(const float* W, int ldw, bf16_t* WT, int ldt, int k0, int n0, int nrow0, LAS float* scr, int lane) {
    const int r = lane >> 3, c4 = lane & 7;
    f32x4 v[8];
#pragma unroll
    for (int i = 0; i < 8; ++i) v[i] = __builtin_nontemporal_load((const f32x4*)(W + (size_t)(k0 + 8 * i + r) * ldw + n0 + 4 * c4));
#pragma unroll
    for (int i = 0; i < 8; ++i) { LAS float* d = scr + (8 * i + r) * 33 + 4 * c4; d[0] = v[i].x; d[1] = v[i].y; d[2] = v[i].z; d[3] = v[i].w; }
    LDS_WAIT(); asm volatile("" ::: "memory");
    const int c = lane & 7;
#pragma unroll
    for (int j = 0; j < 4; ++j) { const int n = (lane >> 3) + 8 * j; const LAS float* sp = scr + (8 * c) * 33 + n;
        u32x4 o; o.x = cvt_pk_bf16(sp[0 * 33], sp[1 * 33]); o.y = cvt_pk_bf16(sp[2 * 33], sp[3 * 33]); o.z = cvt_pk_bf16(sp[4 * 33], sp[5 * 33]); o.w = cvt_pk_bf16(sp[6 * 33], sp[7 * 33]);
        *(u32x4*)(WT + (size_t)(nrow0 + n) * ldt + k0 + 8 * c) = o; }
    LDS_WAIT(); asm volatile("" ::: "memory");
}

struct MoeCvt { const float* W; uchar* WT; int ldw, ldt, k0, n0, nrow0; };
__device__ __forceinline__ MoeCvt moe_cvt_desc(const Args& a, int id) {
    MoeCvt c;
    if (id < 32768) { const int e = id >> 11, up = (id >> 10) & 1, r = id & 1023, kb = r >> 6, nb = r & 63; c.n0 = nb * 32;
        c.W = (up ? a.w_up : a.w_gate) + (size_t)e * D * DFF; c.ldw = DFF; c.WT = a.ws + WS_WGU + (size_t)e * 4096 * D; c.ldt = D; c.k0 = kb * 64; c.nrow0 = (c.n0 >> 7) * 256 + (c.n0 & 127) + (up ? 128 : 0); }
    else { const int r0 = id - 32768, e = r0 >> 10, r = r0 & 1023, kb = r >> 5, nb = r & 31; c.n0 = nb * 32;
        c.W = a.w_down + (size_t)e * DFF * D; c.ldw = D; c.WT = a.ws + WS_WDN + (size_t)e * D * DFF; c.ldt = DFF; c.k0 = kb * 64; c.nrow0 = c.n0; }
    return c;
}
__device__ __forceinline__ void moe_cvt_issue(const MoeCvt& c, f32x4 (&v)[8], int lane) {
    const float* p = c.W + (size_t)(c.k0 + (lane >> 3)) * c.ldw + c.n0 + 4 * (lane & 7);
#pragma unroll
    for (int i = 0; i < 8; ++i) v[i] = __builtin_nontemporal_load((const f32x4*)(p + (size_t)(8 * i) * c.ldw));
}
__device__ __forceinline__ void moe_cvt_finish(const MoeCvt& c, const f32x4 (&v)[8], LAS float* scr, int lane) {
    const int r = lane >> 3, c4 = lane & 7;
#pragma unroll
    for (int i = 0; i < 8; ++i) { LAS float* d = scr + (8 * i + r) * 33 + 4 * c4; d[0] = v[i].x; d[1] = v[i].y; d[2] = v[i].z; d[3] = v[i].w; }
    LDS_WAIT(); asm volatile("" ::: "memory");
    const int cc = lane & 7;
#pragma unroll
    for (int j = 0; j < 4; ++j) { const int n = (lane >> 3) + 8 * j; const LAS float* sp = scr + (8 * cc) * 33 + n;
        u32x2 o; o.x = cvt_pk4_fp8(sp[0 * 33] * 32.f, sp[1 * 33] * 32.f, sp[2 * 33] * 32.f, sp[3 * 33] * 32.f); o.y = cvt_pk4_fp8(sp[4 * 33] * 32.f, sp[5 * 33] * 32.f, sp[6 * 33] * 32.f, sp[7 * 33] * 32.f);
        *(u32x2*)(c.WT + (size_t)(c.nrow0 + n) * c.ldt + c.k0 + 8 * cc) = o; }
    LDS_WAIT(); asm volatile("" ::: "memory");
}
__device__ __forceinline__ void moe_cvt_run(const Args& a, int base, int wi, int k0, int k1, LAS float* scr, int lane) {
    if (k0 >= k1) return;
    f32x4 va[8], vb[8];
    MoeCvt ca = moe_cvt_desc(a, base + k0 * 1024 + wi), cb = ca; moe_cvt_issue(ca, va, lane);
    for (int k = k0; k < k1; k += 2) {
        if (k + 1 < k1) { cb = moe_cvt_desc(a, base + (k + 1) * 1024 + wi); moe_cvt_issue(cb, vb, lane); }
        moe_cvt_finish(ca, va, scr, lane);
        if (k + 2 < k1) { ca = moe_cvt_desc(a, base + (k + 2) * 1024 + wi); moe_cvt_issue(ca, va, lane); }
        if (k + 1 < k1) moe_cvt_finish(cb, vb, scr, lane);
    }
}

__device__ __forceinline__ void phase_prep(const Args& a, LAS uchar* lds, int bid, int G, int tid, int wid, int lane) {
    float* modp = (float*)(a.ws + WS_MODP);
    if (bid < 192) {
        const int cgp = bid % 24, ks = bid / 24, n0 = cgp * 256 + lane * 4, k0 = ks * 128 + wid * 16;
        LAS float* sc = (LAS float*)(lds + 81920);
        for (int i = tid; i < 9 * 128; i += 512) { const int r = i >> 7, kk = i & 127; sc[i] = silu_f((r < 8) ? a.c[r * D + ks * 128 + kk] : a.c_ctx[ks * 128 + kk]); }
        f32x4 w[16];
#pragma unroll
        for (int kk = 0; kk < 16; ++kk) w[kk] = __builtin_nontemporal_load((const f32x4*)(a.w_ada + (size_t)(k0 + kk) * NMOD + n0));
        __syncthreads();
        f32x4 acc[9];
#pragma unroll
        for (int r = 0; r < 9; ++r) acc[r] = (f32x4){0.f, 0.f, 0.f, 0.f};
#pragma unroll
        for (int kk = 0; kk < 16; ++kk) {
#pragma unroll
            for (int r = 0; r < 9; ++r) acc[r] += w[kk] * sc[r * 128 + wid * 16 + kk]; }
        LAS f32x4* red = (LAS f32x4*)lds;
#pragma unroll
        for (int r = 0; r < 9; ++r) red[(wid * 9 + r) * 64 + lane] = acc[r];
        __syncthreads();
        for (int o = tid; o < 9 * 64; o += 512) { const int r = o / 64, l = o % 64; f32x4 sm = red[(0 * 9 + r) * 64 + l];
#pragma unroll
            for (int w8 = 1; w8 < 8; ++w8) sm += red[(w8 * 9 + r) * 64 + l];
            if (ks == 0) sm += *(const f32x4*)(a.b_ada + cgp * 256 + l * 4);
            *(f32x4*)(modp + ((size_t)ks * 9 + r) * NMOD + cgp * 256 + l * 4) = sm; }
        __syncthreads();
    }
    if (bid == 255) {
        float* lb = (float*)(a.ws + WS_LB);
        for (int i = tid; i < 1024; i += 512) { const float l0 = a.lb_logits[i], l1 = a.lb_logits[1024 + i]; lb[i] = 1.f / (1.f + __expf(l1 - l0)); }
    }
    LAS float* scr = (LAS float*)lds + wid * (64 * 33);
    const int gw = (G - 1 - bid) * 8 + wid, NGW = G * 8;
    constexpr int I_IN = (D / 64) * (NIN / 32), I_OUT = (D / 64) * (D / 32);
    for (int it = gw; it < I_IN + I_OUT; it += NGW) {
        if (it < I_IN) { const int nblk = NIN / 32, kb = it / nblk, nb = it % nblk; const int n0 = nb * 32;
            const int nrow = (n0 < 3072) ? n0 : 3072 + (((n0 - 3072) & 511) >> 7) * 256 + ((n0 - 3072) & 127) + ((n0 >= 3584) ? 128 : 0);
            cvt_item(a.w_in, NIN, (bf16_t*)(a.ws + WS_WIN), D, kb * 64, n0, nrow, scr, lane); }
        else { const int r = it - I_IN, nblk = D / 32, kb = r / nblk, nb = r % nblk; cvt_item(a.w_out, D, (bf16_t*)(a.ws + WS_WOUT), D, kb * 64, nb * 32, nb * 32, scr, lane); }
    }
}

__device__ __forceinline__ float modp_sum(const float* modp, int r, int col) { float s = 0.f;
#pragma unroll
    for (int ks = 0; ks < 8; ++ks) s += modp[((size_t)ks * 9 + r) * NMOD + col];
    return s; }
template <int NR>
__device__ __forceinline__ void norm_rows(const float* xrow0, bf16_t* orow0, const LAS float* gm, const LAS float* sh, int lane) {
    f32x4 v[NR][4]; float ss[NR];
#pragma unroll
    for (int i = 0; i < NR; ++i) { ss[i] = 0.f;
#pragma unroll
        for (int j = 0; j < 4; ++j) v[i][j] = __builtin_nontemporal_load((const f32x4*)(xrow0 + (size_t)i * D) + lane + 64 * j); }
#pragma unroll
    for (int i = 0; i < NR; ++i) {
#pragma unroll
        for (int j = 0; j < 4; ++j) ss[i] += (v[i][j].x * v[i][j].x + v[i][j].y * v[i][j].y) + (v[i][j].z * v[i][j].z + v[i][j].w * v[i][j].w);
        ss[i] = rsqrtf(wave_sum(ss[i]) * (1.f / D) + EPS); }
#pragma unroll
    for (int j = 0; j < 4; ++j) { const f32x4 g4 = *((const LAS f32x4*)gm + lane + 64 * j), s4 = *((const LAS f32x4*)sh + lane + 64 * j);
#pragma unroll
        for (int i = 0; i < NR; ++i) { const f32x4 o = v[i][j] * ss[i] * g4 + s4;
            u32x2 w; w.x = cvt_pk_bf16(o.x, o.y); w.y = cvt_pk_bf16(o.z, o.w); st_wt8((u32x2*)(orow0 + (size_t)i * D) + lane + 64 * j, w); } }
}
__device__ __forceinline__ void phase_norm(const Args& a, LAS uchar* lds, int bid, int G, int tid, int wid, int lane) {
    const float* modp = (const float*)(a.ws + WS_MODP); float* modf = (float*)(a.ws + WS_MODF);
    { const int gt = bid * 512 + tid; if (gt < 9 * NMOD) modf[gt] = modp_sum(modp, gt / NMOD, gt % NMOD); }
    LAS float* gm = (LAS float*)lds; LAS float* sh = gm + D; LAS float* cgm = sh + D; LAS float* csh = cgm + D;
    const int b = bid / 32;
    for (int cidx = tid; cidx < D; cidx += 512) { const float nm = a.norm_mix[cidx];
        sh[cidx] = modp_sum(modp, b, cidx); gm[cidx] = nm * (1.f + modp_sum(modp, b, D + cidx));
        csh[cidx] = modp_sum(modp, 8, cidx); cgm[cidx] = nm * (1.f + modp_sum(modp, 8, D + cidx)); }
    __syncthreads();
    bf16_t* hx = (bf16_t*)(a.ws + WS_ACT); bf16_t* hc = (bf16_t*)(a.ws + WS_HC);
    { const int row = bid * 8 + wid; norm_rows<1>(a.ctx + (size_t)row * D, hc + (size_t)row * D, cgm, csh, lane); }
    for (int j = 0; j < 16; j += 4) { const int row = bid * 128 + wid * 16 + j; norm_rows<4>(a.x + (size_t)row * D, hx + (size_t)row * D, gm, sh, lane); }
    __syncthreads();
}

constexpr int GL_QDP = 0, GL_KIP = 8704, GL_SET0 = 17408, GL_SETSZ = 20992, GL_VTPO = 10240, GL_DECO = 20480, GL_TOT = 59392, GL_RING = 61440, GL_SLOT = 24576, GL_TOT1 = GL_RING + 3 * GL_SLOT;
static_assert(GL_TOT1 + 2048 <= LDS_BYTES - 16, "GLA LDS map");
#define GLA_BAR() do { asm volatile("s_waitcnt lgkmcnt(0)" ::: "memory"); __builtin_amdgcn_s_barrier(); asm volatile("" ::: "memory"); } while (0)
template <bool FULL>
__device__ __forceinline__ void gla_item(LAS uchar* lds, const bf16_t* qb, const _Float16* lfb, const bf16_t* vb, bf16_t* ob, f32x4 (&S)[8][2], float* dl_out,
                                         int row_base, int Tn, int tau0, int nch, int h, int dir, int wid, int lane) {
    const int fr = lane & 15, fq = lane >> 4;
    const bool prod = wid < 4; const int pw = wid & 3;
    constexpr int NT = FULL ? 6 : 4;
    f32x2 kk_[8], cs[8]; unsigned qv[8], qdp[8], kip[8]; f32x2 dsum = (f32x2){0.f, 0.f};
    const int d0 = 2 * lane, pos0 = (d0 & ~31) + 8 * ((d0 >> 2) & 3) + 4 * ((d0 >> 4) & 1) + (d0 & 3);
#define GLA_ISSUE(c) do { LAS uchar* _sl = lds + GL_RING + ((c) % 3) * GL_SLOT + pw * 6144; \
        _Pragma("unroll") for (int _g = 0; _g < 2; ++_g) { const int _tau = tau0 + 32 * (c) + 8 * pw + 4 * _g + (lane >> 4); const size_t _o = (size_t)(dir ? (Tn - 1 - _tau) : _tau) * 128 + (lane & 15) * 8; \
            __builtin_amdgcn_global_load_lds((const unsigned*)(lfb + _o), (LAS unsigned*)(_sl + _g * 1024), 16, 0, 2); \
            if (FULL) __builtin_amdgcn_global_load_lds((const unsigned*)(qb + _o), (LAS unsigned*)(_sl + 2048 + _g * 1024), 16, 0, 2); \
            __builtin_amdgcn_global_load_lds((const unsigned*)(vb + _o), (LAS unsigned*)(_sl + 4096 + _g * 1024), 16, 0, 2); } } while (0)
#define GLA_P1(c) do { \
        if ((c) + 2 < nch) { if (FULL) asm volatile("s_waitcnt vmcnt(12)" ::: "memory"); else asm volatile("s_waitcnt vmcnt(8)" ::: "memory"); } \
        else if ((c) + 1 < nch) { if (FULL) asm volatile("s_waitcnt vmcnt(6)" ::: "memory"); else asm volatile("s_waitcnt vmcnt(4)" ::: "memory"); } \
        else asm volatile("s_waitcnt vmcnt(0)" ::: "memory"); \
        const LAS uchar* _sl = lds + GL_RING + ((c) % 3) * GL_SLOT + pw * 6144; \
        LAS uchar* _set1 = lds + GL_SET0 + ((c) & 1) * GL_SETSZ; \
        unsigned _vv[8]; f32x2 _lf[8]; \
        _Pragma("unroll") for (int _r = 0; _r < 8; ++_r) { typedef _Float16 h2_t __attribute__((ext_vector_type(2))); const h2_t _hv = *(const LAS h2_t*)(_sl + _r * 256 + lane * 4); _lf[_r] = (f32x2){(float)_hv.x, (float)_hv.y}; \
            _vv[_r] = *(const LAS unsigned*)(_sl + 4096 + _r * 256 + lane * 4); qv[_r] = FULL ? *(const LAS unsigned*)(_sl + 2048 + _r * 256 + lane * 4) : 0u; } \
        cs[0] = _lf[0]; _Pragma("unroll") for (int _r = 1; _r < 8; ++_r) cs[_r] = cs[_r - 1] + _lf[_r]; \
        ((LAS f32x2*)(lds + (((c) & 1) ? GL_TOT1 : GL_TOT)))[pw * 64 + lane] = cs[7]; \
        _Pragma("unroll") for (int _r = 0; _r < 8; ++_r) kk_[_r] = 1.f - (f32x2){__builtin_amdgcn_exp2f(_lf[_r].x), __builtin_amdgcn_exp2f(_lf[_r].y)}; \
        _Pragma("unroll") for (int _g = 0; _g < 2; ++_g) { const int _sp = 8 * ((2 * pw + _g) & 3) + 4 * (pw >> 1);     \
            u32x2 _v0, _v1; _v0.x = (_vv[4 * _g] & 0xffffu) | (_vv[4 * _g + 1] << 16); _v0.y = (_vv[4 * _g + 2] & 0xffffu) | (_vv[4 * _g + 3] << 16); \
            _v1.x = (_vv[4 * _g] >> 16) | (_vv[4 * _g + 1] & 0xffff0000u); _v1.y = (_vv[4 * _g + 2] >> 16) | (_vv[4 * _g + 3] & 0xffff0000u); \
            *(LAS u32x2*)(_set1 + GL_VTPO + (d0) * 80 + _sp * 2) = _v0; *(LAS u32x2*)(_set1 + GL_VTPO + (d0 + 1) * 80 + _sp * 2) = _v1; } \
        if ((c) + 3 < nch) GLA_ISSUE((c) + 3);     } while (0)
#define GLA_P2C(c) do { \
        f32x2 _pre = (f32x2){0.f, 0.f}, _all = (f32x2){0.f, 0.f}; \
        _Pragma("unroll") for (int _w = 0; _w < 4; ++_w) { const f32x2 _tw = ((const LAS f32x2*)(lds + (((c) & 1) ? GL_TOT1 : GL_TOT)))[_w * 64 + lane]; _all += _tw; if (_w < pw) _pre += _tw; } \
        dsum += _all; \
        const f32x2 _dec = (f32x2){__builtin_amdgcn_exp2f(_all.x), __builtin_amdgcn_exp2f(_all.y)}; \
        LAS uchar* _set = lds + GL_SET0 + ((c) & 1) * GL_SETSZ; \
        f32x2 _kE[8]; \
        _Pragma("unroll") for (int _r = 0; _r < 8; ++_r) { \
            const f32x2 _cum = _pre + cs[_r]; \
            const f32x2 _ki = kk_[_r] * (f32x2){__builtin_amdgcn_exp2f(-_cum.x), __builtin_amdgcn_exp2f(-_cum.y)}; \
            _kE[_r] = _ki * _dec; \
            if (FULL) { const f32x2 _qd = (f32x2){bf_lo(qv[_r]), bf_hi(qv[_r])} * (f32x2){__builtin_amdgcn_exp2f(_cum.x), __builtin_amdgcn_exp2f(_cum.y)}; \
                qdp[_r] = cvt_pk_bf16(_qd.x, _qd.y); kip[_r] = cvt_pk_bf16(_ki.x, _ki.y); } } \
        _Pragma("unroll") for (int _g = 0; _g < 2; ++_g) { const int _sp = 8 * ((2 * pw + _g) & 3) + 4 * (pw >> 1);     \
            u32x2 _w0, _w1; _w0.x = cvt_pk_bf16(_kE[4 * _g].x, _kE[4 * _g + 1].x); _w0.y = cvt_pk_bf16(_kE[4 * _g + 2].x, _kE[4 * _g + 3].x); \
            _w1.x = cvt_pk_bf16(_kE[4 * _g].y, _kE[4 * _g + 1].y); _w1.y = cvt_pk_bf16(_kE[4 * _g + 2].y, _kE[4 * _g + 3].y); \
            *(LAS u32x2*)(_set + (d0) * 80 + _sp * 2) = _w0; *(LAS u32x2*)(_set + (d0 + 1) * 80 + _sp * 2) = _w1; \
} \
        if (pw == 0) *(LAS f32x2*)(_set + GL_DECO + lane * 8) = _dec; } while (0)
#define GLA_P2W(c) do { if (FULL) { _Pragma("unroll") for (int _r = 0; _r < 8; ++_r) { const int _s = 8 * pw + _r; \
            *(LAS unsigned*)(lds + GL_QDP + _s * 272 + pos0 * 2) = qdp[_r]; *(LAS unsigned*)(lds + GL_KIP + _s * 272 + pos0 * 2) = kip[_r]; } } } while (0)

    if (prod) {
      if (FULL) {
        GLA_ISSUE(0); if (nch > 1) GLA_ISSUE(1); if (nch > 2) GLA_ISSUE(2);
        GLA_P1(0);
        GLA_BAR();
        GLA_P2C(0); GLA_P2W(0);
        if (nch > 1) GLA_P1(1);
        GLA_BAR();
        for (int n = 0; n < nch; ++n) {
            if (n + 1 < nch) GLA_P2C(n + 1);
            GLA_BAR();
            if (n + 1 < nch) GLA_P2W(n + 1);
            if (n + 2 < nch) GLA_P1(n + 2);
            GLA_BAR();
        }
      } else {
        GLA_ISSUE(0); if (nch > 1) GLA_ISSUE(1); if (nch > 2) GLA_ISSUE(2);
        GLA_P1(0);
        GLA_BAR();
        GLA_P2C(0);
        GLA_BAR();
        for (int n = 0; n < nch; ++n) {
            if (n + 1 < nch) GLA_P1(n + 1);
            GLA_BAR();
            if (n + 1 < nch) GLA_P2C(n + 1);
            GLA_BAR();
        }
      }
    } else {
        u32x4 sAp[4][2];
#define GLA_SCVT() do { _Pragma("unroll") for (int _kk = 0; _kk < 4; ++_kk) _Pragma("unroll") for (int _vt = 0; _vt < 2; ++_vt) { \
            sAp[_kk][_vt].x = cvt_pk_bf16_safe(S[2 * _kk][_vt][0], S[2 * _kk][_vt][1]); sAp[_kk][_vt].y = cvt_pk_bf16_safe(S[2 * _kk][_vt][2], S[2 * _kk][_vt][3]); \
            sAp[_kk][_vt].z = cvt_pk_bf16_safe(S[2 * _kk + 1][_vt][0], S[2 * _kk + 1][_vt][1]); sAp[_kk][_vt].w = cvt_pk_bf16_safe(S[2 * _kk + 1][_vt][2], S[2 * _kk + 1][_vt][3]); } } while (0)
        if (FULL) GLA_SCVT();
        GLA_BAR();
        GLA_BAR();
        for (int n = 0; n < nch; ++n) {
            const LAS uchar* set = lds + GL_SET0 + (n & 1) * GL_SETSZ;
            bf16x8 vtf[2];
#pragma unroll
            for (int vt = 0; vt < 2; ++vt) vtf[vt] = *(const LAS bf16x8*)(set + GL_VTPO + (32 * pw + 16 * vt + fr) * 80 + fq * 16);
            if (FULL) {
                bf16x8 qf[2][4];
#pragma unroll
                for (int ti = 0; ti < 2; ++ti)
#pragma unroll
                    for (int kk = 0; kk < 4; ++kk) qf[ti][kk] = *(const LAS bf16x8*)(lds + GL_QDP + (16 * ti + fr) * 272 + kk * 64 + fq * 16);
                f32x4 oT[2][2];
#pragma unroll
                for (int vt = 0; vt < 2; ++vt)
#pragma unroll
                    for (int ti = 0; ti < 2; ++ti) oT[vt][ti] = (f32x4){0.f, 0.f, 0.f, 0.f};
                f32x4 p00 = (f32x4){0.f, 0.f, 0.f, 0.f}, p01 = p00, p11 = p00;
#pragma unroll
                for (int kk = 0; kk < 4; ++kk) {
                    const bf16x8 kj0 = *(const LAS bf16x8*)(lds + GL_KIP + (fr) * 272 + kk * 64 + fq * 16);
                    const bf16x8 kj1 = *(const LAS bf16x8*)(lds + GL_KIP + (16 + fr) * 272 + kk * 64 + fq * 16);
                    p00 = __builtin_amdgcn_mfma_f32_16x16x32_bf16(kj0, qf[0][kk], p00, 0, 0, 0);
                    p01 = __builtin_amdgcn_mfma_f32_16x16x32_bf16(kj0, qf[1][kk], p01, 0, 0, 0);
                    p11 = __builtin_amdgcn_mfma_f32_16x16x32_bf16(kj1, qf[1][kk], p11, 0, 0, 0);
#pragma unroll
                    for (int vt = 0; vt < 2; ++vt) {
                        const bf16x8 sA = __builtin_bit_cast(bf16x8, sAp[kk][vt]);
                        oT[vt][0] = __builtin_amdgcn_mfma_f32_16x16x32_bf16(sA, qf[0][kk], oT[vt][0], 0, 0, 0);
                        oT[vt][1] = __builtin_amdgcn_mfma_f32_16x16x32_bf16(sA, qf[1][kk], oT[vt][1], 0, 0, 0); }
                }
                u32x4 pb0, pb1;
                { float m0[4], m1[4];
#pragma unroll
                  for (int r = 0; r < 4; ++r) { const bool ok = (4 * fq + r) <= fr; m0[r] = ok ? p00[r] : 0.f; m1[r] = ok ? p11[r] : 0.f; }
                  pb0.x = cvt_pk_bf16_safe(m0[0], m0[1]); pb0.y = cvt_pk_bf16_safe(m0[2], m0[3]); pb0.z = 0u; pb0.w = 0u;
                  pb1.x = cvt_pk_bf16_safe(p01[0], p01[1]); pb1.y = cvt_pk_bf16_safe(p01[2], p01[3]); pb1.z = cvt_pk_bf16_safe(m1[0], m1[1]); pb1.w = cvt_pk_bf16_safe(m1[2], m1[3]); }
#pragma unroll
                for (int vt = 0; vt < 2; ++vt) {
                    oT[vt][0] = __builtin_amdgcn_mfma_f32_16x16x32_bf16(vtf[vt], __builtin_bit_cast(bf16x8, pb0), oT[vt][0], 0, 0, 0);
                    oT[vt][1] = __builtin_amdgcn_mfma_f32_16x16x32_bf16(vtf[vt], __builtin_bit_cast(bf16x8, pb1), oT[vt][1], 0, 0, 0); }
#pragma unroll
                for (int ti = 0; ti < 2; ++ti) { const int tau = tau0 + 32 * n + 16 * ti + fr; const size_t row = (size_t)(row_base + (dir ? (Tn - 1 - tau) : tau));
#pragma unroll
                    for (int vt = 0; vt < 2; ++vt) { u32x2 w; w.x = cvt_pk_bf16_safe(oT[vt][ti][0], oT[vt][ti][1]); w.y = cvt_pk_bf16_safe(oT[vt][ti][2], oT[vt][ti][3]);
                        *(u32x2*)(ob + row * 512 + h * 128 + 32 * pw + 16 * vt + 4 * fq) = w; } }
            }
            GLA_BAR();
#pragma unroll
            for (int t8 = 0; t8 < 8; ++t8) {
                const f32x4 dc = *(const LAS f32x4*)(set + GL_DECO + (16 * t8 + 4 * fq) * 4);
                const bf16x8 ka = *(const LAS bf16x8*)(set + (16 * t8 + fr) * 80 + fq * 16);
#pragma unroll
                for (int vt = 0; vt < 2; ++vt) S[t8][vt] = __builtin_amdgcn_mfma_f32_16x16x32_bf16(ka, vtf[vt], S[t8][vt] * dc, 0, 0, 0);
            }
            if (FULL && n + 1 < nch) GLA_SCVT();
            GLA_BAR();
        }
#undef GLA_SCVT
    }
#undef GLA_ISSUE
#undef GLA_P1
#undef GLA_P2C
#undef GLA_P2W
    if (dl_out && wid == 0) *(f32x2*)(dl_out + 2 * lane) = dsum;
    asm volatile("s_waitcnt vmcnt(0)" ::: "memory");
    GLA_BAR();
}
__device__ __forceinline__ void gla_state_store(float* p, const f32x4 (&S)[8][2], int cw, int fr, int fq) {
#pragma unroll
    for (int t8 = 0; t8 < 8; ++t8)
#pragma unroll
        for (int vt = 0; vt < 2; ++vt)
#pragma unroll
            for (int r = 0; r < 4; ++r) p[(size_t)(16 * t8 + 4 * fq + r) * 128 + 32 * cw + 16 * vt + fr] = S[t8][vt][r];
}
__device__ __forceinline__ void phase_gla_states(const Args& a, LAS uchar* lds, int bid, int wid, int lane) {
    uchar* ws = a.ws; const int fr = lane & 15, fq = lane >> 4;
    f32x4 S[8][2];
#pragma unroll
    for (int t8 = 0; t8 < 8; ++t8) { S[t8][0] = (f32x4){0.f, 0.f, 0.f, 0.f}; S[t8][1] = (f32x4){0.f, 0.f, 0.f, 0.f}; }
    if (bid < 192) { const int bhd = bid / 3, seg = bid % 3, b = bhd >> 3, h = (bhd >> 1) & 3, dir = bhd & 1;
        const size_t pl = (size_t)(b * NH + h) * T * 128;
        gla_item<false>(lds, nullptr, (const _Float16*)(ws + (dir ? WS_LBW : WS_LF)) + pl, (const bf16_t*)(ws + WS_ZI) + pl, nullptr, S, (float*)(ws + WS_DL) + (size_t)bid * 128,
                        b * T, T, seg * 1024, 32, h, dir, wid, lane);
        if (wid >= 4) gla_state_store((float*)(ws + WS_SL) + (size_t)bid * 16384, S, wid - 4, fr, fq);
    } else { const int bhd = bid - 192, b = bhd >> 3, h = (bhd >> 1) & 3, dir = bhd & 1;
        const size_t pl = (size_t)(b * NH + h) * CT * 128;
        gla_item<false>(lds, nullptr, (const _Float16*)(ws + (dir ? WS_CLB : WS_CLF)) + pl, (const bf16_t*)(ws + WS_CI) + pl, nullptr, S, nullptr, b * CT, CT, 0, CT / 32, h, dir, wid, lane);
        if (wid >= 4) gla_state_store((float*)(ws + WS_S0) + (size_t)bhd * 16384, S, wid - 4, fr, fq);
    }
}
__device__ __forceinline__ void phase_gla_out(const Args& a, LAS uchar* lds, int bid, int wid, int lane) {
    uchar* ws = a.ws; const int fr = lane & 15, fq = lane >> 4;
    const int bhd = bid >> 2, seg = bid & 3, b = bhd >> 3, h = (bhd >> 1) & 3, dir = bhd & 1;
    f32x4 S[8][2];
    if (wid >= 4) { const int cw = wid - 4;
        { const float* p = (const float*)(ws + WS_S0) + (size_t)bhd * 16384;
#pragma unroll
          for (int t8 = 0; t8 < 8; ++t8)
#pragma unroll
              for (int vt = 0; vt < 2; ++vt)
#pragma unroll
                  for (int r = 0; r < 4; ++r) S[t8][vt][r] = p[(size_t)(16 * t8 + 4 * fq + r) * 128 + 32 * cw + 16 * vt + fr]; }
        for (int j = 0; j < seg; ++j) { const float* p = (const float*)(ws + WS_SL) + (size_t)(bhd * 3 + j) * 16384; const float* dl = (const float*)(ws + WS_DL) + (size_t)(bhd * 3 + j) * 128;
#pragma unroll
            for (int t8 = 0; t8 < 8; ++t8) { const f32x4 dv = *(const f32x4*)(dl + 16 * t8 + 4 * fq);
#pragma unroll
                for (int vt = 0; vt < 2; ++vt)
#pragma unroll
                    for (int r = 0; r < 4; ++r) S[t8][vt][r] = __builtin_amdgcn_exp2f(dv[r]) * S[t8][vt][r] + p[(size_t)(16 * t8 + 4 * fq + r) * 128 + 32 * cw + 16 * vt + fr]; } }
    } else {
#pragma unroll
        for (int t8 = 0; t8 < 8; ++t8) { S[t8][0] = (f32x4){0.f, 0.f, 0.f, 0.f}; S[t8][1] = (f32x4){0.f, 0.f, 0.f, 0.f}; }
    }
    asm volatile("s_waitcnt vmcnt(0)" ::: "memory");
    const size_t pl = (size_t)(b * NH + h) * T * 128;
    gla_item<true>(lds, (const bf16_t*)(ws + WS_ZQ) + pl, (const _Float16*)(ws + (dir ? WS_LBW : WS_LF)) + pl, (const bf16_t*)(ws + WS_ZI) + pl, (bf16_t*)(ws + (dir ? WS_OB : WS_OF)), S, nullptr,
                   b * T, T, seg * 1024, 32, h, dir, wid, lane);
}

__device__ __forceinline__ void unpack8(const u32x4 w, float (&f)[8]) { f[0] = bf_lo(w.x); f[1] = bf_hi(w.x); f[2] = bf_lo(w.y); f[3] = bf_hi(w.y); f[4] = bf_lo(w.z); f[5] = bf_hi(w.z); f[6] = bf_lo(w.w); f[7] = bf_hi(w.w); }
__device__ __forceinline__ void phase_mixfin(const Args& a, int bid, int G, int wid, int lane) {
    const bf16_t* of = (const bf16_t*)(a.ws + WS_OF); const bf16_t* obw = (const bf16_t*)(a.ws + WS_OB); const bf16_t* zg = (const bf16_t*)(a.ws + WS_ZG);
    const bf16_t* zgb = (const bf16_t*)(a.ws + WS_ZGB); const bf16_t* zgc = (const bf16_t*)(a.ws + WS_ZGC);
    bf16_t* A2 = (bf16_t*)(a.ws + WS_ACT);
    const int c0 = 8 * lane;
    float gain[8], cw0[8], cw1[8], cw2[8];
#pragma unroll
    for (int j = 0; j < 8; ++j) { gain[j] = a.hg_norm[(c0 + j) & 127]; cw0[j] = a.conv_w[c0 + j]; cw1[j] = a.conv_w[512 + c0 + j]; cw2[j] = a.conv_w[1024 + c0 + j]; }
    const u32x4 zero4 = (u32x4){0u, 0u, 0u, 0u};
    u32x4 cu[7], nx[7];
#define MF_LOAD(ROW, R) do { const size_t _ro = (size_t)(ROW) * 512 + c0; const int _tw = (ROW) & 63; \
        R[0] = __builtin_nontemporal_load((const u32x4*)(of + _ro)); R[1] = __builtin_nontemporal_load((const u32x4*)(obw + _ro)); R[2] = __builtin_nontemporal_load((const u32x4*)(zg + _ro)); \
        R[3] = *(const u32x4*)(zgc + _ro); R[4] = __builtin_nontemporal_load((const u32x4*)(zgb + _ro)); \
        R[5] = *(const u32x4*)(zgc + _ro - (_tw > 0 ? 512 : 0)); R[6] = *(const u32x4*)(zgc + _ro + (_tw < 63 ? 512 : 0)); } while (0)
    int row = bid * 8 + wid;
    if (row < M) MF_LOAD(row, cu);
    for (; row < M; row += G * 8) {
        const int nrow = row + G * 8;
        if (nrow < M) MF_LOAD(nrow, nx);
        float f0[8], f1[8], gg[8], o[8];
        unpack8(cu[0], f0); unpack8(cu[1], f1); unpack8(cu[2], gg);
        float ss = 0.f;
#pragma unroll
        for (int j = 0; j < 8; ++j) { o[j] = f0[j] + f1[j]; ss += o[j] * o[j]; }
        ss += __shfl_xor(ss, 1); ss += __shfl_xor(ss, 2); ss += __shfl_xor(ss, 4); ss += __shfl_xor(ss, 8);
        const float rstd = rsqrtf(ss * (1.f / 128.f) + EPS);
#pragma unroll
        for (int j = 0; j < 8; ++j) o[j] = o[j] * rstd * gain[j] * silu_f(gg[j]);
        u32x4 w; w.x = cvt_pk_bf16(o[0], o[1]); w.y = cvt_pk_bf16(o[2], o[3]); w.z = cvt_pk_bf16(o[4], o[5]); w.w = cvt_pk_bf16(o[6], o[7]);
        st_wt16(A2 + (size_t)row * D + c0, w);
        const int tw = row & 63;
        float um[8], u0[8], up[8], gb[8], y[8];
        unpack8(cu[3], u0); unpack8(cu[4], gb); unpack8(tw > 0 ? cu[5] : zero4, um); unpack8(tw < 63 ? cu[6] : zero4, up);
#pragma unroll
        for (int j = 0; j < 8; ++j) y[j] = gb[j] * (cw0[j] * um[j] + cw1[j] * u0[j] + cw2[j] * up[j]);
        w.x = cvt_pk_bf16(y[0], y[1]); w.y = cvt_pk_bf16(y[2], y[3]); w.z = cvt_pk_bf16(y[4], y[5]); w.w = cvt_pk_bf16(y[6], y[7]);
        st_wt16(A2 + (size_t)row * D + 512 + c0, w);
#pragma unroll
        for (int q = 0; q < 7; ++q) cu[q] = nx[q];
    }
#undef MF_LOAD
}

__device__ __forceinline__ void phase_router(const Args& a, LAS uchar* lds, int bid, int tid, int wid, int lane) {
    const float* modf = (const float*)(a.ws + WS_MODF);
    LAS float* gm = (LAS float*)lds; LAS float* sh = gm + D;
    LAS uchar* wrl = lds + 8192;
    const int b = bid / 32;
    for (int cidx = tid; cidx < D; cidx += 512) { sh[cidx] = modf[(size_t)b * NMOD + 3 * D + cidx]; gm[cidx] = a.norm_ffn[cidx] * (1.f + modf[(size_t)b * NMOD + 4 * D + cidx]); }
    for (int i = tid; i < D * 4; i += 512) { const int col = i >> 2, q4 = i & 3; *(LAS f32x4*)(wrl + col * 64 + (col >> 2) * 16 + q4 * 16) = *(const f32x4*)(a.w_router + col * 16 + q4 * 4); }
    __syncthreads();
    uchar* hx2 = a.ws + WS_ACT; float* aff = (float*)(a.ws + WS_AFF);
    u32x2 xn[4][4];
#define RT_LOAD(JB) do { const bf16_t* _x = (const bf16_t*)(a.ws + WS_X1B) + (size_t)(bid * 128 + wid * 16 + (JB) * 4) * D; \
        _Pragma("unroll") for (int _i = 0; _i < 4; ++_i) _Pragma("unroll") for (int _j = 0; _j < 4; ++_j) xn[_i][_j] = __builtin_nontemporal_load((const u32x2*)(_x + (size_t)_i * D) + lane + 64 * _j); } while (0)
    RT_LOAD(0);
    LAS float* cscr = (LAS float*)(lds + 77824) + wid * (64 * 33);
    f32x4 cvv[8];
    for (int jb = 0; jb < 4; ++jb) {
        const MoeCvt cdesc = moe_cvt_desc(a, jb * 2048 + bid * 8 + wid); moe_cvt_issue(cdesc, cvv, lane);
        const int row0 = bid * 128 + wid * 16 + jb * 4;
        f32x4 v[4][4]; float rstd[4];
#pragma unroll
        for (int i = 0; i < 4; ++i) { float ss = 0.f;
#pragma unroll
            for (int jj = 0; jj < 4; ++jj) { const u32x2 xw = xn[i][jj]; v[i][jj] = (f32x4){bf_lo(xw.x), bf_hi(xw.x), bf_lo(xw.y), bf_hi(xw.y)}; ss += (v[i][jj].x * v[i][jj].x + v[i][jj].y * v[i][jj].y) + (v[i][jj].z * v[i][jj].z + v[i][jj].w * v[i][jj].w); }
            rstd[i] = ss; }
        if (jb < 3) RT_LOAD(jb + 1);
#pragma unroll
        for (int i = 0; i < 4; ++i) rstd[i] = rsqrtf(wave_sum(rstd[i]) * (1.f / D) + EPS);
        f32x2 pl2[32];
#define pl(k) pl2[(k) >> 1][(k) & 1]
#pragma unroll
        for (int e = 0; e < 32; ++e) pl2[e] = (f32x2){0.f, 0.f};
#pragma unroll
        for (int jj = 0; jj < 4; ++jj) { const f32x4 g4 = *((const LAS f32x4*)gm + lane + 64 * jj), s4 = *((const LAS f32x4*)sh + lane + 64 * jj);
#pragma unroll
            for (int i = 0; i < 4; ++i) { v[i][jj] = v[i][jj] * rstd[i] * g4 + s4;
                st_wt4((unsigned*)(hx2 + (size_t)(row0 + i) * D) + lane + 64 * jj, cvt_pk4_fp8(v[i][jj].x, v[i][jj].y, v[i][jj].z, v[i][jj].w)); }
            const int colb = 4 * lane + 256 * jj;
#pragma unroll
            for (int cc = 0; cc < 4; ++cc) { const int col = colb + cc; const LAS uchar* wp = wrl + col * 64 + (col >> 2) * 16;
#pragma unroll
                for (int q4 = 0; q4 < 4; ++q4) { const f32x4 w4 = *(const LAS f32x4*)(wp + q4 * 16);
#pragma unroll
                    for (int i = 0; i < 4; ++i) { const float hvv = v[i][jj][cc]; const f32x2 h2 = (f32x2){hvv, hvv};
                        pl2[i * 8 + q4 * 2 + 0] = __builtin_elementwise_fma(h2, (f32x2){w4.x, w4.y}, pl2[i * 8 + q4 * 2 + 0]); pl2[i * 8 + q4 * 2 + 1] = __builtin_elementwise_fma(h2, (f32x2){w4.z, w4.w}, pl2[i * 8 + q4 * 2 + 1]); } } } }
#pragma unroll
        for (int k = 0; k < 32; ++k) { const bool hi = (lane & 32) != 0; const float keep = hi ? pl(32 + k) : pl(k), send = hi ? pl(k) : pl(32 + k); pl(k) = keep + __shfl_xor(send, 32); }
#pragma unroll
        for (int k = 0; k < 16; ++k) { const bool hi = (lane & 16) != 0; const float keep = hi ? pl(16 + k) : pl(k), send = hi ? pl(k) : pl(16 + k); pl(k) = keep + __shfl_xor(send, 16); }
#pragma unroll
        for (int k = 0; k < 8; ++k) { const bool hi = (lane & 8) != 0; const float keep = hi ? pl(8 + k) : pl(k), send = hi ? pl(k) : pl(8 + k); pl(k) = keep + __shfl_xor(send, 8); }
#pragma unroll
        for (int k = 0; k < 4; ++k) { const bool hi = (lane & 4) != 0; const float keep = hi ? pl(4 + k) : pl(k), send = hi ? pl(k) : pl(4 + k); pl(k) = keep + __shfl_xor(send, 4); }
#pragma unroll
        for (int k = 0; k < 2; ++k) { const bool hi = (lane & 2) != 0; const float keep = hi ? pl(2 + k) : pl(k), send = hi ? pl(k) : pl(2 + k); pl(k) = keep + __shfl_xor(send, 2); }
        { const bool hi = (lane & 1) != 0; const float keep = hi ? pl(1) : pl(0), send = hi ? pl(0) : pl(1); pl(0) = keep + __shfl_xor(send, 1); }
        const float lg = pl(0);
#undef pl
        float mx = lg;
#pragma unroll
        for (int o = 1; o < 16; o <<= 1) mx = fmaxf(mx, __shfl_xor(mx, o));
        const float ex = __expf(lg - mx); float den = ex;
#pragma unroll
        for (int o = 1; o < 16; o <<= 1) den += __shfl_xor(den, o);
        const int t = (row0 + (lane >> 4)) & (T - 1);
        st_wt4(aff + ((size_t)b * NE + (lane & 15)) * T + t, __float_as_uint(ex / den));
        moe_cvt_finish(cdesc, cvv, cscr, lane);
    }
#undef RT_LOAD
    asm volatile("s_waitcnt vmcnt(0)" ::: "memory"); __syncthreads();
    if (tid == 0) __hip_atomic_fetch_add((unsigned*)(a.ws + WS_BAR + 14336) + 64 * b + 8, 1u, __ATOMIC_RELAXED, __HIP_MEMORY_SCOPE_AGENT);
}

__device__ __forceinline__ void topk_item(const Args& a, LAS uchar* lds, int b, int e, int tid, int wid, int lane) {
    LAS unsigned* key = (LAS unsigned*)lds;
    LAS unsigned* hist = key + 4096;
    LAS unsigned* ctl = hist + 256;
    LAS unsigned* wsum = ctl + 8;
    const float* affp = (const float*)(a.ws + WS_AFF) + ((size_t)b * NE + e) * T;
    unsigned kv[8];
    { const u32x4 k0 = *(const u32x4*)(affp + tid * 8), k1 = *(const u32x4*)(affp + tid * 8 + 4); kv[0] = k0.x; kv[1] = k0.y; kv[2] = k0.z; kv[3] = k0.w; kv[4] = k1.x; kv[5] = k1.y; kv[6] = k1.z; kv[7] = k1.w; }
    unsigned prefix = 0u, mask = 0u, need = CAP;
    for (int shift = 24; shift >= 0; shift -= 8) {
        if (tid < 256) hist[tid] = 0u;
        __syncthreads();
#pragma unroll
        for (int j = 0; j < 8; ++j) if ((kv[j] & mask) == prefix) __hip_atomic_fetch_add(&hist[(kv[j] >> shift) & 255u], 1u, __ATOMIC_RELAXED, __HIP_MEMORY_SCOPE_WORKGROUP);
        __syncthreads();
        if (tid < 256) { unsigned above = 0u; for (int bb = tid + 1; bb < 256; ++bb) above += hist[bb]; const unsigned mine = hist[tid];
            if (above < need && need <= above + mine) { ctl[0] = (unsigned)tid; ctl[1] = need - above; } }
        __syncthreads();
        prefix |= ctl[0] << shift; mask |= 255u << shift; need = ctl[1];
        __syncthreads();
    }
    unsigned cg_ = 0u, ce_ = 0u;
#pragma unroll
    for (int j = 0; j < 8; ++j) { cg_ += kv[j] > prefix; ce_ += kv[j] == prefix; }
    unsigned pk = cg_ | (ce_ << 16), incl = pk;
#pragma unroll
    for (int o = 1; o < 64; o <<= 1) { const unsigned t2 = __shfl_up(incl, o); if (lane >= o) incl += t2; }
    if (lane == 63) wsum[wid] = incl;
    __syncthreads();
    unsigned base = 0u;
    for (int w = 0; w < wid; ++w) base += wsum[w];
    unsigned excl = base + incl - pk; unsigned ng = excl & 0xffffu, neq = excl >> 16;
    int* seltok = (int*)(a.ws + WS_SELTOK); float* selgate = (float*)(a.ws + WS_SELGATE); short* pos = (short*)(a.ws + WS_POS);
#pragma unroll
    for (int j = 0; j < 8; ++j) { const int t = tid * 8 + j; const bool gt = kv[j] > prefix, eq = kv[j] == prefix; const bool sel = gt || (eq && neq < need);
        int slot = -1;
        if (sel) slot = (int)(ng + (neq < need ? neq : need));
        if (sel) { seltok[e * 4096 + b * 512 + slot] = b * T + t; selgate[e * 4096 + b * 512 + slot] = __uint_as_float(kv[j]); }
        pos[((size_t)b * T + t) * 16 + e] = (short)slot;
        ng += gt; neq += eq; }
    __syncthreads();
}
__device__ __forceinline__ void phase_topk_cvt(const Args& a, LAS uchar* lds, int bid, int G, int tid, int wid, int lane) {
    if (bid < 128) {
        const int b = bid / 16; const unsigned* c7 = (const unsigned*)(a.ws + WS_BAR + 14336) + 64 * b + 8;
        if (tid == 0) { unsigned sp = 0; while (__hip_atomic_load(c7, __ATOMIC_RELAXED, __HIP_MEMORY_SCOPE_AGENT) < 32u && ++sp < (1u << 22)) __builtin_amdgcn_s_sleep(2);
            __builtin_amdgcn_fence(__ATOMIC_ACQUIRE, "agent"); asm volatile("s_waitcnt vmcnt(0)" ::: "memory"); }
        __syncthreads();
        topk_item(a, lds, b, bid % 16, tid, wid, lane);
    }
    LAS float* scr = (LAS float*)(lds + 32768) + wid * (64 * 33);
    static_assert(49152 - 8192 == 1024 * 18 + 1024 * 22, "item split");
    const bool tk = bid < 128; const int wi = (tk ? bid : bid - 128) * 8 + wid;
    moe_cvt_run(a, 8192 + (tk ? 1024 * 22 : 0), wi, 0, tk ? 18 : 22, scr, lane);
    __syncthreads();
}

__device__ __forceinline__ void phase_final(const Args& a, int bid, int G, int wid, int lane) {
    const float* modf = (const float*)(a.ws + WS_MODF); const short* pos = (const short*)(a.ws + WS_POS); const uchar* ys = a.ws + WS_YS;
    const bf16_t* x1b = (const bf16_t*)(a.ws + WS_X1B);
    f32x4 nf[4];
#pragma unroll
    for (int q = 0; q < 4; ++q) nf[q] = *(const f32x4*)(a.norm_final + (q >> 1) * 512 + 8 * lane + (q & 1) * 4);
    const int stride = G * 8;
#define FIN_SLOT(ROW) (((ROW) < M && lane < 16) ? (int)pos[(size_t)(ROW) * 16 + lane] : -1)
#define FIN_ISSUE(ROW, SLOTV, XW, W, EE, SL, REST, G2) do { const int _b = (ROW) / T; const bf16_t* _x = x1b + (size_t)(ROW) * D; \
        _Pragma("unroll") for (int _q = 0; _q < 4; ++_q) G2[_q] = *(const f32x4*)(modf + (size_t)_b * NMOD + 5 * D + (_q >> 1) * 512 + 8 * lane + (_q & 1) * 4); \
        XW[0] = __builtin_nontemporal_load((const u32x4*)(_x + 8 * lane)); XW[1] = __builtin_nontemporal_load((const u32x4*)(_x + 512 + 8 * lane)); \
        unsigned long long _m = __ballot((SLOTV) >= 0); \
        _Pragma("unroll") for (int _k = 0; _k < 4; ++_k) { if (_m) { EE[_k] = __builtin_ctzll(_m); _m &= _m - 1; SL[_k] = __shfl((SLOTV), EE[_k]); } else { EE[_k] = -1; SL[_k] = 0; } } \
        REST = _m; \
        _Pragma("unroll") for (int _k = 0; _k < 4; ++_k) if (EE[_k] >= 0) { const uchar* _yr = ys + ((size_t)EE[_k] * 4096 + _b * 512 + SL[_k]) * D + 8 * lane; \
            W[_k][0] = __builtin_nontemporal_load((const u32x2*)_yr); W[_k][1] = __builtin_nontemporal_load((const u32x2*)(_yr + 512)); } } while (0)
#define FIN_ACC(WW, HF) do { const f32x2 _p0 = __builtin_amdgcn_cvt_pk_f32_fp8((WW).x, false), _p1 = __builtin_amdgcn_cvt_pk_f32_fp8((WW).x, true), _p2 = __builtin_amdgcn_cvt_pk_f32_fp8((WW).y, false), _p3 = __builtin_amdgcn_cvt_pk_f32_fp8((WW).y, true); \
        acc[2 * (HF)].x += _p0.x; acc[2 * (HF)].y += _p0.y; acc[2 * (HF)].z += _p1.x; acc[2 * (HF)].w += _p1.y; \
        acc[2 * (HF) + 1].x += _p2.x; acc[2 * (HF) + 1].y += _p2.y; acc[2 * (HF) + 1].z += _p3.x; acc[2 * (HF) + 1].w += _p3.y; } while (0)
    int row = bid * 8 + wid;
    f32x4 g2C[4], g2N[4]; u32x4 xwC[2], xwN[2]; u32x2 wC[4][2], wN[4][2]; int eeC[4], slC[4], eeN[4], slN[4]; unsigned long long restC = 0ull, restN = 0ull;
    int slotC = FIN_SLOT(row), slotB = FIN_SLOT(row + stride);
    FIN_ISSUE(row, slotC, xwC, wC, eeC, slC, restC, g2C);
    for (; row < M; row += stride) {
        const int nrow = row + stride;
        const int slotN2 = FIN_SLOT(row + 2 * stride);
        if (nrow < M) FIN_ISSUE(nrow, slotB, xwN, wN, eeN, slN, restN, g2N);
        const int b = row / T; float* xrow = a.out + (size_t)row * D;
        f32x4 v[4], acc[4];
#pragma unroll
        for (int hf = 0; hf < 2; ++hf) { const u32x4 xw = xwC[hf];
            v[2 * hf] = (f32x4){bf_lo(xw.x), bf_hi(xw.x), bf_lo(xw.y), bf_hi(xw.y)}; v[2 * hf + 1] = (f32x4){bf_lo(xw.z), bf_hi(xw.z), bf_lo(xw.w), bf_hi(xw.w)}; acc[2 * hf] = (f32x4){0.f, 0.f, 0.f, 0.f}; acc[2 * hf + 1] = (f32x4){0.f, 0.f, 0.f, 0.f}; }
#pragma unroll
        for (int k = 0; k < 4; ++k) if (eeC[k] >= 0) { FIN_ACC(wC[k][0], 0); FIN_ACC(wC[k][1], 1); }
        while (restC) {
            const int e = __builtin_ctzll(restC); restC &= restC - 1; const int sl = __shfl(slotC, e);
            const uchar* yr = ys + ((size_t)e * 4096 + b * 512 + sl) * D + 8 * lane;
            const u32x2 w0 = *(const u32x2*)yr, w1 = *(const u32x2*)(yr + 512);
            FIN_ACC(w0, 0); FIN_ACC(w1, 1); }
        float ss = 0.f;
#pragma unroll
        for (int q = 0; q < 4; ++q) { v[q] = v[q] + g2C[q] * acc[q] * 0.0625f;
            ss += (v[q].x * v[q].x + v[q].y * v[q].y) + (v[q].z * v[q].z + v[q].w * v[q].w); }
        const float rstd = rsqrtf(wave_sum(ss) * (1.f / D) + EPS);
#pragma unroll
        for (int q = 0; q < 4; ++q) __builtin_nontemporal_store(v[q] * rstd * nf[q], (f32x4*)(xrow + (q >> 1) * 512 + 8 * lane + (q & 1) * 4));
        xwC[0] = xwN[0]; xwC[1] = xwN[1]; restC = restN; slotC = slotB; slotB = slotN2;
#pragma unroll
        for (int q = 0; q < 4; ++q) g2C[q] = g2N[q];
#pragma unroll
        for (int k = 0; k < 4; ++k) { wC[k][0] = wN[k][0]; wC[k][1] = wN[k][1]; eeC[k] = eeN[k]; slC[k] = slN[k]; }
    }
#undef FIN_SLOT
#undef FIN_ISSUE
#undef FIN_ACC
}

__global__ void __launch_bounds__(512, 2) mega_fwd(Args a) {
    extern __shared__ __attribute__((aligned(16))) uchar lds_raw[];
    LAS uchar* lds = (LAS uchar*)lds_raw;
    const int tid = threadIdx.x, lane = tid & 63, wid = __builtin_amdgcn_readfirstlane(tid >> 6), bid = blockIdx.x, G = gridDim.x;
    const int lo = a.ph_lo, hi = a.ph_hi;
    uchar* ws = a.ws;
#define IN(k) (lo <= (k) && (k) < hi)
#define SEAM(k) do { if (IN(k) && IN((k) + 1)) xcd_barrier(xbar); } while (0)
#define SEAM_NR(k) do { if (IN(k) && IN((k) + 1)) xcd_barrier<false>(xbar); } while (0)
    if (tid < 2) ((volatile LAS unsigned*)(lds + (LDS_BYTES - 16)))[tid] = 0u;
    __syncthreads();
    XcdBarrier xbar = xcd_barrier_post((unsigned*)(ws + WS_BAR), (volatile LAS unsigned*)(lds + (LDS_BYTES - 16)));
    if (IN(0)) phase_prep(a, lds, bid, G, tid, wid, lane);
    SEAM(0);
    if (IN(1)) phase_norm(a, lds, bid, G, tid, wid, lane);
    SEAM_NR(1);
    if (IN(2)) {
        {
            pg8::Gemm g{(const bf16_t*)(ws + WS_ACT), (const bf16_t*)(ws + WS_WIN), D, 0, nullptr};
            pg8::GroupOrder S; S.init(M / 256, NIN / 256, 1, G, bid);
            pg8::EpiInproj E{ws + WS_ZQ, nullptr, (_Float16*)(ws + WS_LF), (_Float16*)(ws + WS_LBW), (const float*)(ws + WS_LB), 0, T};
            pg8::gemm_phase<pg8::EpiInproj, false>(lds, g, S, E);
        }
    }
    SEAM(2);
    if (IN(3)) {
        unsigned* cnt = (unsigned*)(ws + WS_BAR + 14336);
        if (bid >= 192 && bid < 240) {
            pg8::Gemm g{(const bf16_t*)(ws + WS_HC), (const bf16_t*)(ws + WS_WIN) + (size_t)512 * D, D, 0, nullptr};
            pg8::GroupOrder S; S.init(MC / 256, 1536 / 256, 1, 48, bid - 192);
            pg8::EpiInproj E{nullptr, (bf16_t*)(ws + WS_CI), (_Float16*)(ws + WS_CLF), (_Float16*)(ws + WS_CLB), (const float*)(ws + WS_LB), 1, CT};
            pg8::gemm_phase<pg8::EpiInproj, false>(lds, g, S, E);
            pg8::Unit u; S.next(0, u);
            asm volatile("s_waitcnt vmcnt(0)" ::: "memory"); __syncthreads();
            if (tid == 0) { __builtin_amdgcn_fence(__ATOMIC_RELEASE, "agent"); asm volatile("s_waitcnt vmcnt(0)" ::: "memory");
                __hip_atomic_fetch_add(cnt + 64 * u.pm, 1u, __ATOMIC_RELAXED, __HIP_MEMORY_SCOPE_AGENT); }
        }
        if (bid >= 192) {
            const int b = (bid - 192) >> 3;
            if (tid == 0) { unsigned sp = 0; while (__hip_atomic_load(cnt + 64 * b, __ATOMIC_RELAXED, __HIP_MEMORY_SCOPE_AGENT) < 6u && ++sp < (1u << 22)) __builtin_amdgcn_s_sleep(2);
                __builtin_amdgcn_fence(__ATOMIC_ACQUIRE, "agent"); asm volatile("s_waitcnt vmcnt(0)" ::: "memory"); }
            __syncthreads();
        }
        phase_gla_states(a, lds, bid, wid, lane);
    }
    SEAM(3);
    if (IN(4)) phase_gla_out(a, lds, bid, wid, lane);
    SEAM(4);
    if (IN(5)) phase_mixfin(a, bid, G, wid, lane);
    SEAM_NR(5);
    if (IN(6)) {
        pg8::Gemm g{(const bf16_t*)(ws + WS_ACT), (const bf16_t*)(ws + WS_WOUT), D, 0, nullptr};
        pg8::GroupOrder S; S.init(M / 256, D / 256, 1, G, bid);
        pg8::EpiOut E{a.x, (bf16_t*)(ws + WS_X1B), (const float*)(ws + WS_MODF)};
        pg8::gemm_phase<pg8::EpiOut, false>(lds, g, S, E);
    }
    SEAM_NR(6);
    if (IN(7)) phase_router(a, lds, bid, tid, wid, lane);
    if (IN(8)) phase_topk_cvt(a, lds, bid, G, tid, wid, lane);
    SEAM(8);
    if (IN(9)) {
        pg8::Gemm g{(const bf16_t*)(ws + WS_ACT), (const bf16_t*)(ws + WS_WGU), D / 2, (size_t)4096 * D, (const int*)(ws + WS_SELTOK)};
        pg8::Moe1Order S{bid};
        pg8::EpiMoe1 E{ws + WS_HID};
        pg8::gemm_phase<pg8::EpiMoe1, true, pg8::Moe1Order, true>(lds, g, S, E);
    }
    SEAM(9);
    if (IN(10)) {
        pg8::Gemm g{(const bf16_t*)(ws + WS_HID), (const bf16_t*)(ws + WS_WDN), DFF / 2, (size_t)D * DFF, nullptr};
        pg8::Moe2Order S{bid};
        LAS float* lg = (LAS float*)(lds + pg8::STAGE_BYTES);
        { float gvv[4];
#pragma unroll
          for (int uu = 0; uu < 4; ++uu) { pg8::Unit tu; const bool ok = S.next(uu, tu); gvv[uu] = (ok && tid < 256) ? ((const float*)(ws + WS_SELGATE))[tu.pm * 256 + tid] : 0.f; }
#pragma unroll
          for (int uu = 0; uu < 4; ++uu) if (tid < 256) lg[uu * 256 + tid] = gvv[uu]; }
        __syncthreads();
        pg8::EpiMoe2 E{ws + WS_YS, lg};
        pg8::gemm_phase<pg8::EpiMoe2, false, pg8::Moe2Order, true>(lds, g, S, E);
    }
    SEAM(10);
    if (IN(11)) phase_final(a, bid, G, wid, lane);

#undef IN
#undef SEAM
}

#ifndef N_LAUNCHES
#define N_LAUNCHES 1
#endif
extern "C" void kernel_launch(void* const* d_in, const int* in_sizes, int n_in, void* d_out, int out_size, void* d_ws, size_t ws_size, hipStream_t stream) {
    static int grid = 0;
    if (grid == 0) {
        if (n_in != 18 || out_size != M * D || ws_size < WS_END) { fprintf(stderr, "kernel_launch: unexpected shapes (n_in %d out %d ws %zu)\n", n_in, out_size, ws_size); grid = -1; return; }
        int dev = 0, cus = 0, per_cu = 0;
        (void)hipGetDevice(&dev); (void)hipDeviceGetAttribute(&cus, hipDeviceAttributeMultiprocessorCount, dev);
        (void)hipFuncSetAttribute((const void*)mega_fwd, hipFuncAttributeMaxDynamicSharedMemorySize, LDS_BYTES);
        (void)hipOccupancyMaxActiveBlocksPerMultiprocessor(&per_cu, (const void*)mega_fwd, 512, LDS_BYTES);
        if (per_cu < 1) { fprintf(stderr, "kernel_launch: occupancy query says %d blocks per CU\n", per_cu); grid = -1; return; }
        grid = 256;
        if (cus != 256) fprintf(stderr, "kernel_launch: note: %d CUs (built for 256)\n", cus);
    }
    if (grid < 0) return;
    Args a{};
    a.x = (const float*)d_in[0]; a.c = (const float*)d_in[1]; a.ctx = (const float*)d_in[2]; a.c_ctx = (const float*)d_in[3]; a.w_ada = (const float*)d_in[4]; a.b_ada = (const float*)d_in[5];
    a.norm_mix = (const float*)d_in[6]; a.norm_ffn = (const float*)d_in[7]; a.w_in = (const float*)d_in[8]; a.lb_logits = (const float*)d_in[9]; a.hg_norm = (const float*)d_in[10];
    a.conv_w = (const float*)d_in[11]; a.w_out = (const float*)d_in[12]; a.w_router = (const float*)d_in[13]; a.w_gate = (const float*)d_in[14]; a.w_up = (const float*)d_in[15];
    a.w_down = (const float*)d_in[16]; a.norm_final = (const float*)d_in[17]; a.out = (float*)d_out; a.ws = (uchar*)d_ws;
    if (N_LAUNCHES == 1) {
        (void)hipMemsetAsync((char*)d_ws + WS_BAR, 0, 16384, stream);
        a.ph_lo = 0; a.ph_hi = NPHASE;
        hipLaunchKernelGGL(mega_fwd, dim3(grid), dim3(512), LDS_BYTES, stream, a);
    } else {
        for (int p = 0; p < NPHASE; ++p) { a.ph_lo = p; a.ph_hi = p + 1; void* args[] = {&a};
            hipError_t e = hipLaunchCooperativeKernel((const void*)mega_fwd, dim3(grid), dim3(512), args, LDS_BYTES, stream);
            if (e != hipSuccess) { fprintf(stderr, "launch %d failed: %s\n", p, hipGetErrorString(e)); break; } }
    }
}
```
